# Optimizing an MI355X kernel written in HIP

```python
import math
import jax, jax.numpy as jnp
from jax import lax
import numpy as np

D_MODEL = 2048
BATCH = 4
SEQ = 2048
DEPTH = 2
DEC_BATCH = 8
DEC_SEQ = 4
PAST_LEN = 16384
PAGE_SIZE = 128

N_BRANCH = 4
RMS_EPS = 1e-6
CONV_WIDTH = 4
POOL_WINDOWS = (2, 4, 8, 16)
POOL_GROUPS = 4
POOL_WIDTH = D_MODEL // 4
POOL_GW = POOL_WIDTH // POOL_GROUPS
POOL_BUF = max(POOL_WINDOWS) - 1
DN_HEADS = 4
DN_DK = 128
DN_DV = 128
DN_QK = DN_HEADS * DN_DK
DN_VW = DN_HEADS * DN_DV
DN_CONV_DIM = 2 * DN_QK + DN_VW
DN_CHUNK = 64
SB_HEADS = 4
SB_HEAD_DIM = 128
SB_WIDTH = SB_HEADS * SB_HEAD_DIM
SB_BLOCK = 128
SB_BIAS_INIT = -6.0
SSM_D_INNER = D_MODEL // 2
SSM_HEAD_DIM = 64
SSM_HEADS = SSM_D_INNER // SSM_HEAD_DIM
SSM_GROUPS = 2
SSM_HPG = SSM_HEADS // SSM_GROUPS
SSM_STATE = 128
SSM_CONV_DIM = SSM_D_INNER + 2 * SSM_GROUPS * SSM_STATE
SSM_CHUNK = 64
D_FF = 4 * D_MODEL
IN_SPLITS = (POOL_WIDTH, DN_CONV_DIM, DN_VW, DN_HEADS, DN_HEADS, 3 * SB_WIDTH, SSM_D_INNER, SSM_CONV_DIM, SSM_HEADS, N_BRANCH * D_MODEL)
IN_COLS = sum(IN_SPLITS)
BRANCH_WIDTHS = (POOL_WIDTH, DN_VW, SB_WIDTH, SSM_D_INNER)
BRANCH_ROWS = sum(BRANCH_WIDTHS)

kernel_name = 'hybrid_pool_delta_stickbreak_ssd_step'


def rmsnorm(x, g):
    xf = x.astype(jnp.float32)
    y = xf * lax.rsqrt(jnp.mean(xf * xf, axis=-1, keepdims=True) + RMS_EPS)
    return (y * g.astype(jnp.float32)).astype(x.dtype)


def split_sizes(a, sizes, axis):
    return jnp.split(a, np.cumsum(sizes)[:-1].tolist(), axis=axis)


def causal_conv_silu(u, buf, w, b):
    L = u.shape[1]
    ext = jnp.concatenate([buf.astype(u.dtype), u], axis=1)
    ef = ext.astype(jnp.float32)
    wf = w.astype(jnp.float32)
    out = sum(ef[:, i:i + L] * wf[i] for i in range(CONV_WIDTH))
    if b is not None:
        out = out + b.astype(jnp.float32)
    return jax.nn.silu(out), ext[:, L:]


def pool_mixer(u, buf, pos0, w_grp, scale):
    B, L, _ = u.shape
    uf = u.astype(jnp.float32)
    ext = jnp.concatenate([buf.astype(jnp.float32), uf], axis=1)
    csum = jnp.concatenate([jnp.zeros((B, 1, POOL_WIDTH), jnp.float32), jnp.cumsum(ext, axis=1)], axis=1)
    hi = csum[:, POOL_BUF + 1:]
    pos = pos0 + jnp.arange(L)
    outs = []
    for gi, w in enumerate(POOL_WINDOWS):
        cols = slice(gi * POOL_GW, (gi + 1) * POOL_GW)
        lo = csum[:, POOL_BUF + 1 - w:POOL_BUF + 1 - w + L, cols]
        cnt = jnp.minimum(pos + 1, w).astype(jnp.float32)[None, :, None]
        outs.append((hi[..., cols] - lo) / cnt - uf[..., cols])
    y = jnp.stack(outs, axis=2)
    y = jnp.einsum('blgc,gcd->blgd', y, w_grp.astype(jnp.float32)).reshape(B, L, POOL_WIDTH)
    y = y * scale.astype(jnp.float32)
    return y.astype(u.dtype), ext[:, L:].astype(u.dtype)


def l2norm(x):
    return x * lax.rsqrt(jnp.sum(x * x, axis=-1, keepdims=True) + 1e-6)


def gated_delta_chunked(q, k, v, g, beta, s0):
    B, L, H, _ = q.shape
    DV = v.shape[-1]
    C = math.gcd(L, DN_CHUNK)
    n = L // C

    def chunks(t):
        return jnp.moveaxis(t.reshape((B, n, C, H) + t.shape[3:]), (1, 3), (0, 2))

    tri = jnp.tril(jnp.ones((C, C), bool))
    stri = jnp.tril(jnp.ones((C, C), bool), -1)

    def step(S, inp):
        qc, kc, vc, gc, bc = inp
        gcum = jnp.cumsum(gc, axis=-1)
        decay = jnp.exp(jnp.where(tri, gcum[..., :, None] - gcum[..., None, :], -jnp.inf))
        kb = kc * bc[..., None]
        lmat = jnp.where(stri, jnp.einsum('bhcd,bhed->bhce', kb, kc) * decay, 0.0)
        rhs = jnp.concatenate([vc * bc[..., None], kb * jnp.exp(gcum)[..., None]], axis=-1)
        sol = lax.linalg.triangular_solve(lmat, rhs, left_side=True, lower=True, unit_diagonal=True)
        u_c, w_c = sol[..., :DV], sol[..., DV:]
        v_new = u_c - jnp.einsum('bhck,bhkv->bhcv', w_c, S)
        attn = jnp.einsum('bhck,bhek->bhce', qc, kc) * decay
        o = jnp.einsum('bhck,bhkv->bhcv', qc * jnp.exp(gcum)[..., None], S) + jnp.einsum('bhce,bhev->bhcv', attn, v_new)
        glast = gcum[..., -1:]
        S = S * jnp.exp(glast)[..., None] + jnp.einsum('bhck,bhcv->bhkv', kc * jnp.exp(glast - gcum)[..., None], v_new)
        return S, o

    S, o = lax.scan(step, s0, (chunks(q), chunks(k), chunks(v), chunks(g), chunks(beta)))
    o = jnp.moveaxis(o, (0, 2), (1, 3)).reshape(B, L, H, DV)
    return o, S


def deltanet_branch(u_qkv, u_z, u_b, u_a, conv_buf, s0, conv_w, a_log, dt_bias, norm_w):
    B, L, _ = u_qkv.shape
    qkv, conv_new = causal_conv_silu(u_qkv, conv_buf, conv_w, None)
    q, k, v = split_sizes(qkv, (DN_QK, DN_QK, DN_VW), -1)
    q = l2norm(q.reshape(B, L, DN_HEADS, DN_DK)) * (DN_DK ** -0.5)
    k = l2norm(k.reshape(B, L, DN_HEADS, DN_DK))
    v = v.reshape(B, L, DN_HEADS, DN_DV)
    beta = jax.nn.sigmoid(u_b.astype(jnp.float32))
    g = -jnp.exp(a_log.astype(jnp.float32)) * jax.nn.softplus(u_a.astype(jnp.float32) + dt_bias.astype(jnp.float32))
    o, s_new = gated_delta_chunked(q, k, v, g, beta, s0.astype(jnp.float32))
    zf = u_z.astype(jnp.float32).reshape(B, L, DN_HEADS, DN_DV)
    o = rmsnorm(o, norm_w) * jax.nn.silu(zf)
    dt_ = u_qkv.dtype
    return o.reshape(B, L, DN_VW).astype(dt_), conv_new.astype(dt_), s_new.astype(dt_)


def ssd_chunked(x, dt, a, bm, cm, h0):
    B, L = x.shape[:2]
    C = math.gcd(L, SSM_CHUNK)
    n = L // C

    def chunks(t):
        return jnp.moveaxis(t.reshape((B, n, C) + t.shape[2:]), 1, 0)

    tri = jnp.tril(jnp.ones((C, C), bool))[None, :, :, None, None]

    def step(h, inp):
        xc, dtc, bc, cc = inp
        cum = jnp.cumsum(dtc * a, axis=1)
        lmat = jnp.exp(jnp.where(tri, cum[:, :, None] - cum[:, None, :], -jnp.inf))
        cb = jnp.einsum('btgn,bsgn->btsg', cc, bc)
        wts = cb[..., None] * lmat * dtc[:, None]
        y = jnp.einsum('btsgr,bsgrp->btgrp', wts, xc)
        y = y + jnp.einsum('btgn,bgrpn->btgrp', cc, h) * jnp.exp(cum)[..., None]
        last = cum[:, -1]
        h = h * jnp.exp(last)[..., None, None] + jnp.einsum('bsgr,bsgrp,bsgn->bgrpn', jnp.exp(last[:, None] - cum) * dtc, xc, bc)
        return h, y

    h, y = lax.scan(step, h0, (chunks(x), chunks(dt), chunks(bm), chunks(cm)))
    return jnp.moveaxis(y, 0, 1).reshape(x.shape), h


def mamba_branch(u_z, u_xbc, u_dt, conv_buf, h0, conv_w, conv_b, a_log, dt_bias, d_skip, norm_w):
    B, L, _ = u_xbc.shape
    xbc, conv_new = causal_conv_silu(u_xbc, conv_buf, conv_w, conv_b)
    xs, bm, cm = split_sizes(xbc, (SSM_D_INNER, SSM_GROUPS * SSM_STATE, SSM_GROUPS * SSM_STATE), -1)
    xs = xs.reshape(B, L, SSM_GROUPS, SSM_HPG, SSM_HEAD_DIM)
    bm = bm.reshape(B, L, SSM_GROUPS, SSM_STATE)
    cm = cm.reshape(B, L, SSM_GROUPS, SSM_STATE)
    dt = jax.nn.softplus(u_dt.astype(jnp.float32) + dt_bias.astype(jnp.float32)).reshape(B, L, SSM_GROUPS, SSM_HPG)
    a = -jnp.exp(a_log.astype(jnp.float32)).reshape(SSM_GROUPS, SSM_HPG)
    h0f = h0.astype(jnp.float32).reshape(B, SSM_GROUPS, SSM_HPG, SSM_HEAD_DIM, SSM_STATE)
    y, h = ssd_chunked(xs, dt, a, bm, cm, h0f)
    y = y + d_skip.astype(jnp.float32).reshape(SSM_GROUPS, SSM_HPG)[..., None] * xs
    y = y.reshape(B, L, SSM_D_INNER) * jax.nn.silu(u_z.astype(jnp.float32))
    gw = SSM_D_INNER // SSM_GROUPS
    y = rmsnorm(y.reshape(B, L, SSM_GROUPS, gw), norm_w.reshape(SSM_GROUPS, gw)).reshape(B, L, SSM_D_INNER)
    dt_ = u_xbc.dtype
    return y.astype(dt_), conv_new.astype(dt_), h.reshape(B, SSM_HEADS, SSM_HEAD_DIM, SSM_STATE).astype(dt_)


def stick_breaking_block(q, qpos, k, v, kpos, bias):
    z = jnp.einsum('bqhd,bkhd->bhqk', q.astype(jnp.float32), k.astype(jnp.float32)) * (SB_HEAD_DIM ** -0.5)
    z = z + bias.astype(jnp.float32)[None, :, None, None]
    valid = kpos[None, :] < qpos[:, None]
    la = jnp.where(valid, jax.nn.log_sigmoid(-z), 0.0)
    surv = lax.cumsum(la, axis=3, reverse=True) - la
    att = jnp.where(valid, jnp.exp(jax.nn.log_sigmoid(z) + surv), 0.0)
    return jnp.einsum('bhqk,bkhd->bqhd', att, v.astype(jnp.float32))


def stick_breaking(q, k, v, qpos, kpos, bias):
    B, Lq, H, Dh = q.shape
    blk = SB_BLOCK if Lq % SB_BLOCK == 0 else Lq
    nb = Lq // blk
    qb = jnp.moveaxis(q.reshape(B, nb, blk, H, Dh), 1, 0)
    pb = qpos.reshape(nb, blk)
    o = lax.map(lambda qp: stick_breaking_block(qp[0], qp[1], k, v, kpos, bias), (qb, pb))
    return jnp.moveaxis(o, 0, 1).reshape(B, Lq, H * Dh)


def trunk_layer(x, past_k, past_v, pool_buf, dn_conv, dn_s, ssm_conv, ssm_h, lw):
    (n_mix_pre, n_mix_post, n_mlp_pre, n_mlp_post, w_in, pool_w, pool_scale,
     dn_conv_w, dn_a_log, dn_dt_bias, dn_norm_w, sb_bias, ssm_conv_w, ssm_conv_b,
     ssm_a_log, ssm_dt_bias, ssm_d, ssm_norm_w, w_branch, w_out, w_up, w_down) = lw
    B, L, _ = x.shape
    past = 0 if past_k is None else past_k.shape[1]
    h = rmsnorm(x, n_mix_pre)
    u = jnp.einsum('bld,dc->blc', h, w_in)
    (u_pool, u_dn_qkv, u_dn_z, u_dn_b, u_dn_a, u_sb, u_ss_z, u_ss_xbc, u_ss_dt, u_gate) = split_sizes(u, IN_SPLITS, -1)
    o_pool, pool_new = pool_mixer(u_pool, pool_buf, past, pool_w, pool_scale)
    o_dn, dn_conv_new, dn_s_new = deltanet_branch(u_dn_qkv, u_dn_z, u_dn_b, u_dn_a, dn_conv, dn_s, dn_conv_w, dn_a_log, dn_dt_bias, dn_norm_w)
    q, k, v = [t.reshape(B, L, SB_HEADS, SB_HEAD_DIM) for t in jnp.split(u_sb, 3, axis=-1)]
    k_all = k if past_k is None else jnp.concatenate([past_k.astype(k.dtype), k], axis=1)
    v_all = v if past_v is None else jnp.concatenate([past_v.astype(v.dtype), v], axis=1)
    o_sb = stick_breaking(q, k_all, v_all, past + jnp.arange(L), jnp.arange(past + L), sb_bias).astype(x.dtype)
    o_ss, ss_conv_new, ss_h_new = mamba_branch(u_ss_z, u_ss_xbc, u_ss_dt, ssm_conv, ssm_h, ssm_conv_w, ssm_conv_b, ssm_a_log, ssm_dt_bias, ssm_d, ssm_norm_w)
    gates = jax.nn.sigmoid(u_gate.astype(jnp.float32)).reshape(B, L, N_BRANCH, D_MODEL)
    w_rows = split_sizes(w_branch, BRANCH_WIDTHS, 0)
    outs = (o_pool, o_dn, o_sb, o_ss)
    merged = sum(gates[:, :, i] * jnp.einsum('blc,cd->bld', o, wr).astype(jnp.float32) for i, (o, wr) in enumerate(zip(outs, w_rows)))
    mix = jnp.einsum('bld,de->ble', merged.astype(x.dtype), w_out)
    x = x + rmsnorm(mix, n_mix_post)
    h2 = rmsnorm(x, n_mlp_pre)
    f = jnp.einsum('blf,fd->bld', jnp.square(jax.nn.relu(jnp.einsum('bld,df->blf', h2, w_up))), w_down)
    x = x + rmsnorm(f, n_mlp_post)
    return x, (k, v, pool_new, dn_conv_new, dn_s_new, ss_conv_new, ss_h_new)


def _dt_bias_init(key, shape):
    dt = jnp.exp(jax.random.uniform(key, shape, jnp.float32, minval=math.log(1e-3), maxval=math.log(1e-1)))
    return dt + jnp.log(-jnp.expm1(-dt))


def setup_inputs(seed: int = 0) -> dict:
    key = jax.random.key(seed)
    ks = jax.random.split(key, 40)
    kit = iter(range(40))
    f32 = jnp.float32

    def nrm(shape, s):
        return jax.random.normal(ks[next(kit)], shape, f32) * s

    n_pages = PAST_LEN // PAGE_SIZE
    n_used = DEC_BATCH * n_pages
    n_pool = n_used + n_used // 4
    x_prompt = nrm((BATCH, SEQ, D_MODEL), 1.0)
    x_sample = nrm((DEC_BATCH, DEC_SEQ, D_MODEL), 1.0)
    cache_sb_k = nrm((DEPTH, n_pool, PAGE_SIZE, SB_HEADS, SB_HEAD_DIM), 1.0)
    cache_sb_v = nrm((DEPTH, n_pool, PAGE_SIZE, SB_HEADS, SB_HEAD_DIM), 1.0)
    state_pool = nrm((DEPTH, DEC_BATCH, POOL_BUF, POOL_WIDTH), 1.0)
    state_dn_conv = nrm((DEPTH, DEC_BATCH, CONV_WIDTH - 1, DN_CONV_DIM), 1.0)
    state_dn_s = nrm((DEPTH, DEC_BATCH, DN_HEADS, DN_DK, DN_DV), 0.1)
    state_ssm_conv = nrm((DEPTH, DEC_BATCH, CONV_WIDTH - 1, SSM_CONV_DIM), 1.0)
    state_ssm_h = nrm((DEPTH, DEC_BATCH, SSM_HEADS, SSM_HEAD_DIM, SSM_STATE), 0.1)
    page_table = jax.random.permutation(ks[next(kit)], n_pool)[:n_used].reshape(DEC_BATCH, n_pages).astype(jnp.int32)
    norm_mix_pre = 1.0 + nrm((DEPTH, D_MODEL), 0.02)
    norm_mix_post = 1.0 + nrm((DEPTH, D_MODEL), 0.02)
    norm_mlp_pre = 1.0 + nrm((DEPTH, D_MODEL), 0.02)
    norm_mlp_post = 1.0 + nrm((DEPTH, D_MODEL), 0.02)
    w_in = nrm((DEPTH, D_MODEL, IN_COLS), D_MODEL ** -0.5)
    pool_w = nrm((DEPTH, POOL_GROUPS, POOL_GW, POOL_GW), POOL_GW ** -0.5)
    pool_scale = 1.0 + nrm((DEPTH, POOL_WIDTH), 0.1)
    dn_conv_w = nrm((DEPTH, CONV_WIDTH, DN_CONV_DIM), CONV_WIDTH ** -0.5)
    dn_a_log = jnp.log(jax.random.uniform(ks[next(kit)], (DEPTH, DN_HEADS), f32, minval=1.0, maxval=16.0))
    dn_dt_bias = _dt_bias_init(ks[next(kit)], (DEPTH, DN_HEADS))
    dn_norm_w = 1.0 + nrm((DEPTH, DN_DV), 0.02)
    sb_bias = SB_BIAS_INIT + nrm((DEPTH, SB_HEADS), 0.5)
    ssm_conv_w = nrm((DEPTH, CONV_WIDTH, SSM_CONV_DIM), CONV_WIDTH ** -0.5)
    ssm_conv_b = nrm((DEPTH, SSM_CONV_DIM), 0.01)
    ssm_a_log = jnp.log(jax.random.uniform(ks[next(kit)], (DEPTH, SSM_HEADS), f32, minval=1.0, maxval=16.0))
    ssm_dt_bias = _dt_bias_init(ks[next(kit)], (DEPTH, SSM_HEADS))
    ssm_d = 1.0 + nrm((DEPTH, SSM_HEADS), 0.1)
    ssm_norm_w = 1.0 + nrm((DEPTH, SSM_D_INNER), 0.02)
    w_branch = nrm((DEPTH, BRANCH_ROWS, D_MODEL), POOL_WIDTH ** -0.5)
    w_out = nrm((DEPTH, D_MODEL, D_MODEL), D_MODEL ** -0.5)
    w_up = nrm((DEPTH, D_MODEL, D_FF), D_MODEL ** -0.5)
    w_down = nrm((DEPTH, D_FF, D_MODEL), D_FF ** -0.5)
    return {'x_prompt': x_prompt, 'x_sample': x_sample, 'cache_sb_k': cache_sb_k, 'cache_sb_v': cache_sb_v,
            'state_pool': state_pool, 'state_dn_conv': state_dn_conv, 'state_dn_s': state_dn_s,
            'state_ssm_conv': state_ssm_conv, 'state_ssm_h': state_ssm_h, 'page_table': page_table,
            'norm_mix_pre': norm_mix_pre, 'norm_mix_post': norm_mix_post, 'norm_mlp_pre': norm_mlp_pre,
            'norm_mlp_post': norm_mlp_post, 'w_in': w_in, 'pool_w': pool_w, 'pool_scale': pool_scale,
            'dn_conv_w': dn_conv_w, 'dn_a_log': dn_a_log, 'dn_dt_bias': dn_dt_bias, 'dn_norm_w': dn_norm_w,
            'sb_bias': sb_bias,
            'ssm_conv_w': ssm_conv_w, 'ssm_conv_b': ssm_conv_b, 'ssm_a_log': ssm_a_log, 'ssm_dt_bias': ssm_dt_bias,
            'ssm_d': ssm_d, 'ssm_norm_w': ssm_norm_w, 'w_branch': w_branch, 'w_out': w_out,
            'w_up': w_up, 'w_down': w_down}


def reference(x_prompt, x_sample, cache_sb_k, cache_sb_v, state_pool, state_dn_conv, state_dn_s,
              state_ssm_conv, state_ssm_h, page_table, norm_mix_pre, norm_mix_post, norm_mlp_pre,
              norm_mlp_post, w_in, pool_w, pool_scale, dn_conv_w, dn_a_log, dn_dt_bias, dn_norm_w,
              sb_bias, ssm_conv_w, ssm_conv_b, ssm_a_log, ssm_dt_bias, ssm_d, ssm_norm_w, w_branch, w_out,
              w_up, w_down):
    bp = x_prompt.shape[0]
    bs = page_table.shape[0]
    dt_ = x_prompt.dtype
    zero_states = (jnp.zeros((bp, POOL_BUF, POOL_WIDTH), dt_),
                   jnp.zeros((bp, CONV_WIDTH - 1, DN_CONV_DIM), dt_),
                   jnp.zeros((bp, DN_HEADS, DN_DK, DN_DV), dt_),
                   jnp.zeros((bp, CONV_WIDTH - 1, SSM_CONV_DIM), dt_),
                   jnp.zeros((bp, SSM_HEADS, SSM_HEAD_DIM, SSM_STATE), dt_))
    y_prompt = x_prompt
    y_sample = x_sample
    new_p = []
    new_s = []
    for l in range(DEPTH):
        lw = (norm_mix_pre[l], norm_mix_post[l], norm_mlp_pre[l], norm_mlp_post[l], w_in[l], pool_w[l],
              pool_scale[l], dn_conv_w[l], dn_a_log[l], dn_dt_bias[l], dn_norm_w[l], sb_bias[l], ssm_conv_w[l],
              ssm_conv_b[l], ssm_a_log[l], ssm_dt_bias[l], ssm_d[l], ssm_norm_w[l], w_branch[l],
              w_out[l], w_up[l], w_down[l])
        y_prompt, st_p = trunk_layer(y_prompt, None, None, *zero_states, lw)
        past_k = jnp.take(cache_sb_k[l], page_table, axis=0).reshape(bs, -1, SB_HEADS, SB_HEAD_DIM)
        past_v = jnp.take(cache_sb_v[l], page_table, axis=0).reshape(bs, -1, SB_HEADS, SB_HEAD_DIM)
        y_sample, st_s = trunk_layer(y_sample, past_k, past_v, state_pool[l], state_dn_conv[l], state_dn_s[l],
                                     state_ssm_conv[l], state_ssm_h[l], lw)
        new_p.append(st_p)
        new_s.append(st_s)
    k_p, v_p, pool_p, dnc_p, dns_p, ssc_p, ssh_p = [jnp.stack(t) for t in zip(*new_p)]
    k_s, v_s, pool_s, dnc_s, dns_s, ssc_s, ssh_s = [jnp.stack(t) for t in zip(*new_s)]
    return (y_prompt, y_sample, k_p, v_p, pool_p, dnc_p, dns_p, ssc_p, ssh_p,
            k_s, v_s, pool_s, dnc_s, dns_s, ssc_s, ssh_s)
```

```cpp
#include <hip/hip_runtime.h>
#include <cstdio>
#include <cstdint>
__device__ __forceinline__ int lane_opaque() { unsigned m = ~0u; asm volatile("" : "+s"(m)); return (int)__builtin_amdgcn_mbcnt_hi(m, __builtin_amdgcn_mbcnt_lo(m, 0u)); }
__device__ __forceinline__ int tid_opaque(int wv) { return wv * 64 + lane_opaque(); }
__device__ __forceinline__ int blk_opaque() { int t = blockIdx.x; asm volatile("" : "+s"(t)); return t; }
namespace pg8 {
#define PG8_LAS __attribute__((address_space(3)))
typedef unsigned short bf16_t;
typedef short bf16x8 __attribute__((ext_vector_type(8)));
typedef float f32x4 __attribute__((ext_vector_type(4)));
typedef unsigned u32x4 __attribute__((ext_vector_type(4)));
constexpr int BM = 256, BK = 64, HALF = 128, HTB = HALF * BK * 2  , STAGE_BYTES = 8 * HTB, NXCD = 8, WGM = 8;

__host__ __device__ __forceinline__ int lds_byte(int r, int c) { const int st = (r >> 4) * 2 + (c >> 5), rr = r & 15, cc = c & 31, ob = rr * 64 + cc * 2; return st * 1024 + (ob ^ (((ob >> 9) & 1) << 5)); }
__host__ __device__ __forceinline__ void stage_rc(int b, int& R, int& C) { const int st = b / 1024, sb = b % 1024, swz = sb ^ (((sb >> 9) & 1) << 5); R = (st >> 1) * 16 + swz / 64; C = (st & 1) * 32 + (swz % 64) / 2; }
__host__ __device__ __forceinline__ int perm32(int rho) { const int n = rho >> 4, i = rho & 15; return 8 * (i >> 2) + 4 * n + (i & 3); }

struct Unit { int pm, pn; };
struct Gemm { const bf16_t* A; const bf16_t* Bt; int M, N, K; };

struct StaticOrder {
    int nM, nN, nwg, G, c;
    __host__ __device__ void init(int M, int N, int G_, int c_) { nM = M / BM; nN = N / BM; nwg = nM * nN; G = G_; c = c_; }
    __host__ __device__ bool next(int i, Unit& u) const {
        const long L = (long)i * G + c; if (L >= nwg) return false;
        int wgid = (int)L; { const int q = nwg / NXCD, r = nwg % NXCD, xcd = wgid % NXCD, off = wgid / NXCD; wgid = (xcd < r ? xcd * (q + 1) : r * (q + 1) + (xcd - r) * q) + off; }
        const int nig = WGM * nN, gid = wgid / nig, fm = gid * WGM, gsz = (nM - fm) < WGM ? (nM - fm) : WGM;
        u.pm = fm + ((wgid % nig) % gsz); u.pn = (wgid % nig) / gsz; return true;
    }
    __device__ __forceinline__ void a_ready(const Unit&) const {}
    __device__ __forceinline__ void done(const Unit&) const {}
};
__device__ __forceinline__ unsigned cvt_pk_bf16(float lo, float hi) { unsigned r; asm volatile("v_cvt_pk_bf16_f32 %0, %1, %2" : "=v"(r) : "v"(lo), "v"(hi)); return r; }
typedef float f32x2 __attribute__((ext_vector_type(2)));
template <class Epi, class Sched, bool ALIGN_EPI = false, bool SP2 = false>
__device__ __forceinline__ void gemm_phase(PG8_LAS unsigned char* lds, const Gemm g, const Sched& S, const Epi& E, const int wv) {
    const int lane = lane_opaque(), tid = wv * 64 + lane, wid = wv, wr = wid >> 2, wc = wid & 3, fr = lane & 15, fq = lane >> 4;
    const int K = g.K, nt = K / BK;
    unsigned voffA[2], voffB[2];
#pragma unroll
    for (int i = 0; i < 2; ++i) { int R, C; stage_rc(tid * 16 + i * 8192, R, C); const int Rb = Epi::PERM ? ((R & ~31) + perm32(R & 31)) : R;
        voffA[i] = (unsigned)(R * K + C) * 2u; voffB[i] = (unsigned)(Rb * K + C) * 2u; }
    const size_t kstep = (size_t)(BK * 2);
    const size_t hstep = (size_t)HALF * K * 2;
    const size_t tstep = 2 * hstep;
    const unsigned ldsw = (unsigned)wid * 1024u;
    const int aoff = lds_byte(wr * 64 + fr, fq * 8), boff = lds_byte(wc * 32 + fr, fq * 8);
#define PG8_SA(b, h) (((b) * 2 + (h)) * HTB)
#define PG8_SB(b, h) ((4 + (b) * 2 + (h)) * HTB)
#define PG8_STAGE(bufoff, gbase, voff) do { _Pragma("unroll") for (int _i = 0; _i < 2; ++_i) \
        __builtin_amdgcn_global_load_lds((const unsigned*)((const char*)(gbase) + (voff)[_i]), (PG8_LAS unsigned*)(lds + (bufoff) + ldsw + _i * 8192), 16, 0, 0); } while (0)
#define PG8_LDA(dst, b, h) do { _Pragma("unroll") for (int m = 0; m < 4; ++m) _Pragma("unroll") for (int k = 0; k < 2; ++k) dst[m][k] = *(const PG8_LAS bf16x8*)(lds + PG8_SA(b, h) + aoff + m * 2048 + k * 1024); } while (0)
#define PG8_LDB(dst, b, h) do { _Pragma("unroll") for (int n = 0; n < 2; ++n) _Pragma("unroll") for (int k = 0; k < 2; ++k) dst[n][k] = *(const PG8_LAS bf16x8*)(lds + PG8_SB(b, h) + boff + n * 2048 + k * 1024); } while (0)
#define PG8_MMA(ai, bj, At, Bt) do { __builtin_amdgcn_s_setprio(1); _Pragma("unroll") for (int m = 0; m < 4; ++m) _Pragma("unroll") for (int n = 0; n < 2; ++n) _Pragma("unroll") for (int k = 0; k < 2; ++k) \
        acc[ai][bj][m][n] = __builtin_amdgcn_mfma_f32_16x16x32_bf16(Bt[n][k], At[m][k], acc[ai][bj][m][n], 0, 0, 0); __builtin_amdgcn_s_setprio(0); } while (0)
#define PG8_WAIT_V(n) asm volatile("s_waitcnt vmcnt(" #n ")" ::: "memory")
#define PG8_WAIT_L(n) asm volatile("s_waitcnt lgkmcnt(" #n ")" ::: "memory")
#define PG8_BAR __builtin_amdgcn_s_barrier()
#define PG8_SCHED __builtin_amdgcn_sched_barrier(0)
    Unit cur, nxt; int ui = 0;
    if (!S.next(0, cur)) return;
    f32x4 acc[2][2][4][2];
#pragma unroll
    for (int a = 0; a < 2; ++a)
#pragma unroll
        for (int b = 0; b < 2; ++b)
#pragma unroll
            for (int m = 0; m < 4; ++m)
#pragma unroll
                for (int n = 0; n < 2; ++n) acc[a][b][m][n] = (f32x4){0.f, 0.f, 0.f, 0.f};
    bf16x8 At[4][2], B0[2][2], B1[2][2];
    const char* cA = (const char*)g.A + (size_t)cur.pm * tstep; const char* cB = (const char*)g.Bt + (size_t)cur.pn * tstep;
    S.a_ready(cur);
    if constexpr (SP2) {
        PG8_STAGE(PG8_SB(0, 0), cB, voffB); PG8_STAGE(PG8_SB(0, 1), cB + hstep, voffB); PG8_STAGE(PG8_SA(0, 0), cA, voffA); PG8_STAGE(PG8_SA(0, 1), cA + hstep, voffA);
        if (wr == 1) PG8_BAR;
        PG8_WAIT_V(2); PG8_BAR;
        PG8_STAGE(PG8_SB(1, 0), cB + kstep, voffB); PG8_STAGE(PG8_SA(1, 0), cA + kstep, voffA); PG8_STAGE(PG8_SB(1, 1), cB + hstep + kstep, voffB);
        PG8_WAIT_V(6); PG8_BAR;
    } else {
        PG8_STAGE(PG8_SB(0, 0), cB, voffB); PG8_STAGE(PG8_SA(0, 0), cA, voffA); PG8_STAGE(PG8_SB(0, 1), cB + hstep, voffB); PG8_STAGE(PG8_SA(0, 1), cA + hstep, voffA);
        if (wr == 1) PG8_BAR;
        PG8_WAIT_V(4); PG8_BAR;
        PG8_STAGE(PG8_SB(1, 0), cB + kstep, voffB); PG8_STAGE(PG8_SA(1, 0), cA + kstep, voffA); PG8_STAGE(PG8_SB(1, 1), cB + hstep + kstep, voffB);
        PG8_WAIT_V(6); PG8_BAR;
    }
    for (;;) {
        const bool has_next = S.next(ui + 1, nxt);
        const char* nA = has_next ? (const char*)g.A + (size_t)nxt.pm * tstep : cA; const char* nB = has_next ? (const char*)g.Bt + (size_t)nxt.pn * tstep : cB;
        for (int t = 0; t < nt; t += 2) {
            const bool last = (t == nt - 2);
            const char* a1 = cA + (size_t)(t + 1) * kstep;
            const char* a2 = last ? nA : cA + (size_t)(t + 2) * kstep; const char* b2 = last ? nB : cB + (size_t)(t + 2) * kstep;
            const char* a3 = a2 + kstep; const char* b3 = b2 + kstep;
            if (last && has_next) S.a_ready(nxt);
            if constexpr (SP2) {
            PG8_LDB(B0, 0, 0); PG8_LDB(B1, 0, 1); PG8_SCHED; PG8_LDA(At, 0, 0); PG8_STAGE(PG8_SA(1, 1), a1 + hstep, voffA);
            PG8_WAIT_V(8); PG8_WAIT_L(0); PG8_BAR; PG8_MMA(0, 0, At, B0); PG8_MMA(0, 1, At, B1); PG8_BAR; PG8_SCHED;
            PG8_LDA(At, 0, 1); PG8_STAGE(PG8_SB(0, 0), b2, voffB); PG8_STAGE(PG8_SB(0, 1), b2 + hstep, voffB); PG8_STAGE(PG8_SA(0, 0), a2, voffA);
            PG8_WAIT_V(8); PG8_WAIT_L(0); PG8_BAR; PG8_MMA(1, 0, At, B0); PG8_MMA(1, 1, At, B1); PG8_BAR; PG8_SCHED;
            PG8_LDB(B0, 1, 0); PG8_LDB(B1, 1, 1); PG8_SCHED; PG8_LDA(At, 1, 0); PG8_STAGE(PG8_SA(0, 1), a2 + hstep, voffA);
            PG8_WAIT_V(8); PG8_WAIT_L(0); PG8_BAR; PG8_MMA(0, 0, At, B0); PG8_MMA(0, 1, At, B1); PG8_BAR; PG8_SCHED;
            PG8_LDA(At, 1, 1); PG8_STAGE(PG8_SB(1, 0), b3, voffB); PG8_STAGE(PG8_SB(1, 1), b3 + hstep, voffB); PG8_STAGE(PG8_SA(1, 0), a3, voffA);
            PG8_WAIT_V(8); PG8_WAIT_L(0); PG8_BAR; PG8_MMA(1, 0, At, B0); PG8_MMA(1, 1, At, B1); PG8_BAR; PG8_SCHED;
            } else {
            PG8_LDB(B0, 0, 0); PG8_SCHED; PG8_LDA(At, 0, 0); PG8_STAGE(PG8_SA(1, 1), a1 + hstep, voffA);
            PG8_WAIT_L(8); PG8_BAR; PG8_WAIT_L(0); PG8_MMA(0, 0, At, B0); PG8_BAR; PG8_SCHED;
            PG8_LDB(B1, 0, 1); PG8_STAGE(PG8_SB(0, 0), b2, voffB);
            PG8_BAR; PG8_WAIT_L(0); PG8_MMA(0, 1, At, B1); PG8_BAR;
            PG8_LDA(At, 0, 1); PG8_STAGE(PG8_SA(0, 0), a2, voffA);
            PG8_BAR; PG8_WAIT_L(0); PG8_MMA(1, 0, At, B0); PG8_BAR; PG8_SCHED;
            PG8_STAGE(PG8_SB(0, 1), b2 + hstep, voffB);
            PG8_WAIT_V(6); PG8_BAR; PG8_MMA(1, 1, At, B1); PG8_BAR;
            PG8_LDB(B0, 1, 0); PG8_SCHED; PG8_LDA(At, 1, 0); PG8_STAGE(PG8_SA(0, 1), a2 + hstep, voffA);
            PG8_WAIT_L(8); PG8_BAR; PG8_WAIT_L(0); PG8_MMA(0, 0, At, B0); PG8_BAR; PG8_SCHED;
            PG8_LDB(B1, 1, 1); PG8_STAGE(PG8_SB(1, 0), b3, voffB);
            PG8_BAR; PG8_WAIT_L(0); PG8_MMA(0, 1, At, B1); PG8_BAR;
            PG8_LDA(At, 1, 1); PG8_STAGE(PG8_SA(1, 0), a3, voffA);
            PG8_BAR; PG8_WAIT_L(0); PG8_MMA(1, 0, At, B0); PG8_BAR; PG8_SCHED;
            PG8_STAGE(PG8_SB(1, 1), b3 + hstep, voffB);
            PG8_WAIT_V(6); PG8_BAR; PG8_MMA(1, 1, At, B1); PG8_BAR;
            }
        }
        if constexpr (ALIGN_EPI) { if (wr == 0) PG8_BAR; }
        if constexpr (!Epi::AFTER_DRAIN) { E(acc, cur, wr, wc, fr, fq); S.done(cur); }
        if (!has_next) break;
#pragma unroll
        for (int a = 0; a < 2; ++a)
#pragma unroll
            for (int b = 0; b < 2; ++b)
#pragma unroll
                for (int m = 0; m < 4; ++m)
#pragma unroll
                    for (int n = 0; n < 2; ++n) acc[a][b][m][n] = (f32x4){0.f, 0.f, 0.f, 0.f};
        cur = nxt; cA = nA; cB = nB; ++ui;
        if constexpr (ALIGN_EPI) { if (wr == 1) PG8_BAR; }
    }
    PG8_WAIT_V(0);
    if constexpr (!ALIGN_EPI) { if (wr == 0) PG8_BAR; }
    PG8_BAR;
    if constexpr (Epi::AFTER_DRAIN) { E.fused(acc, cur, wr, wc, fr, fq, lds, wid, lane); S.done(cur); }
#undef PG8_SA
#undef PG8_SB
#undef PG8_STAGE
#undef PG8_LDA
#undef PG8_LDB
#undef PG8_MMA
#undef PG8_WAIT_V
#undef PG8_WAIT_L
#undef PG8_BAR
#undef PG8_SCHED
}
}

constexpr int DM = 2048, NBATCH = 4, SEQ = 2048, DEPTH = 2, DBATCH = 8, DSEQ = 4, PAST = 16384, PAGE = 128;
constexpr int TP = NBATCH * SEQ;
constexpr int TS = DBATCH * DSEQ;
constexpr int TT = TP + TS;
constexpr int MP = 8448;
constexpr int NPAGES = PAST / PAGE;
constexpr int NPOOL = 1280;
constexpr int POOLW = 512, DNC = 1536, SBW = 512, SSI = 1024, SSC = 1536, DFF = 8192;
constexpr int INCOLS = 14872, NIN = 15104;
constexpr int UFW = 5376;
constexpr int UF_POOL = 0, UF_DNQKV = 512, UF_DNZ = 2048, UF_SSZ = 2560, UF_XBC = 3584, UF_SMALL = 5120;
constexpr float RMS_EPS = 1e-6f;
constexpr float LOG2E = 1.4426950408889634f;
constexpr int NWAVES = 8, NTHR = 512;

constexpr size_t O_Y = 0;
constexpr size_t O_KP = O_Y + (size_t)TT * DM;
constexpr size_t O_VP = O_KP + (size_t)DEPTH * TP * 512;
constexpr size_t O_POOLP = O_VP + (size_t)DEPTH * TP * 512;
constexpr size_t O_DNCP = O_POOLP + (size_t)DEPTH * NBATCH * 15 * 512;
constexpr size_t O_DNSP = O_DNCP + (size_t)DEPTH * NBATCH * 3 * 1536;
constexpr size_t O_SSCP = O_DNSP + (size_t)DEPTH * NBATCH * 4 * 128 * 128;
constexpr size_t O_SSHP = O_SSCP + (size_t)DEPTH * NBATCH * 3 * 1536;
constexpr size_t O_KS = O_SSHP + (size_t)DEPTH * NBATCH * 16 * 64 * 128;
constexpr size_t O_VS = O_KS + (size_t)DEPTH * TS * 512;
constexpr size_t O_POOLS = O_VS + (size_t)DEPTH * TS * 512;
constexpr size_t O_DNCS = O_POOLS + (size_t)DEPTH * DBATCH * 15 * 512;
constexpr size_t O_DNSS = O_DNCS + (size_t)DEPTH * DBATCH * 3 * 1536;
constexpr size_t O_SSCS = O_DNSS + (size_t)DEPTH * DBATCH * 4 * 128 * 128;
constexpr size_t O_SSHS = O_SSCS + (size_t)DEPTH * DBATCH * 3 * 1536;
constexpr size_t O_END = O_SSHS + (size_t)DEPTH * DBATCH * 16 * 64 * 128;

constexpr size_t al256(size_t x) { return (x + 255) & ~(size_t)255; }
constexpr size_t WS_CTL = 0, CTL_BYTES = 1u << 20;
constexpr size_t SZ_WIN = (size_t)NIN * DM * 2, SZ_WBR = (size_t)5 * DM * 512 * 2, SZ_WOUT = (size_t)DM * DM * 2, SZ_WUP = (size_t)DFF * DM * 2, SZ_WDN = (size_t)DM * DFF * 2;
constexpr size_t WS_WIN = WS_CTL + CTL_BYTES;
constexpr size_t WS_WBR = WS_WIN + 2 * SZ_WIN;
constexpr size_t WS_WOUT = WS_WBR + 2 * SZ_WBR;
constexpr size_t WS_WUP = WS_WOUT + 2 * SZ_WOUT;
constexpr size_t WS_WDN = WS_WUP + 2 * SZ_WUP;
constexpr size_t WS_H = WS_WDN + 2 * SZ_WDN;
constexpr size_t WS_UF = WS_H + (size_t)MP * DM * 2;
constexpr size_t WS_QKV = WS_UF + (size_t)MP * UFW * 4;
constexpr size_t WS_GATE = WS_QKV + (size_t)MP * 1536 * 2;
constexpr size_t WS_DNQ = WS_GATE + (size_t)MP * 8192 * 2;
constexpr size_t WS_XBC = WS_DNQ + (size_t)MP * 1536 * 4;
constexpr size_t WS_SCAL = WS_XBC + (size_t)MP * 1536 * 4;
constexpr size_t WS_OBR = WS_SCAL + (size_t)MP * 32 * 4;
constexpr size_t SZ_OBR = (size_t)MP * 512 * 2;
constexpr size_t WS_SSQ = WS_OBR + 5 * SZ_OBR;
constexpr size_t WS_MG32 = WS_SSQ + (size_t)MP * 16 * 4;
constexpr size_t WS_MGB = WS_MG32 + (size_t)MP * DM * 4;
constexpr size_t WS_MIX = WS_MGB + (size_t)MP * DM * 2;
constexpr size_t WS_F = WS_MIX + (size_t)MP * DM * 4;
constexpr size_t WS_FD = WS_F + (size_t)MP * DFF * 2;
constexpr size_t WS_PART = WS_FD + (size_t)MP * DM * 4;
constexpr size_t WS_PR = WS_PART + (size_t)256 * 2048 * 4;
constexpr size_t WS_END = WS_PR + (size_t)256 * 16 * 4;
static_assert(WS_WIN % 256 == 0 && WS_H % 256 == 0 && WS_UF % 256 == 0 && WS_OBR % 256 == 0 && WS_MG32 % 256 == 0 && WS_PART % 256 == 0, "ws alignment");

constexpr int CW_QUEUE = 64;
constexpr int CW_BAR = 4096;

constexpr int LDS_BYTES = 147456;
constexpr int RING_BYTES = 131072;
constexpr int MISC_OFF = RING_BYTES;

#define GAS __attribute__((address_space(1)))
#define LAS __attribute__((address_space(3)))
typedef unsigned short bf16;
typedef unsigned v4u __attribute__((ext_vector_type(4)));
typedef unsigned v2u __attribute__((ext_vector_type(2)));
typedef float f32x4 __attribute__((ext_vector_type(4)));
typedef float f32x2 __attribute__((ext_vector_type(2)));
typedef float f32x16 __attribute__((ext_vector_type(16)));
typedef short bf16x8 __attribute__((ext_vector_type(8)));
__device__ __forceinline__ unsigned f2bf(float f) { unsigned u = __builtin_bit_cast(unsigned, f); return (u + 0x7fffu + ((u >> 16) & 1u)) >> 16; }
__device__ __forceinline__ unsigned pk2(float lo, float hi) { return f2bf(lo) | (f2bf(hi) << 16); }
__device__ __forceinline__ float bflo(unsigned w) { return __builtin_bit_cast(float, w << 16); }
__device__ __forceinline__ float bfhi(unsigned w) { return __builtin_bit_cast(float, w & 0xffff0000u); }
__device__ __forceinline__ float wave_sum(float v) {
#pragma unroll
    for (int o = 1; o < 64; o <<= 1) v += __shfl_xor(v, o);
    return v;
}
__device__ __forceinline__ float sigmoidf_(float x) { return 1.0f / (1.0f + __expf(-x)); }
__device__ __forceinline__ float siluf_(float x) { return x / (1.0f + __expf(-x)); }
__device__ __forceinline__ float softplusf_(float x) { return x > 20.f ? x : log1pf(expf(x)); }
__device__ __forceinline__ float ex2(float x) { return __builtin_amdgcn_exp2f(x); }
__device__ __forceinline__ float lg2(float x) { return __builtin_amdgcn_logf(x); }
#define XB_TMO      128
#define XB_XCNT(j)  (256  + 64 * (j))
#define XB_XSUB(j)  (1280 + 64 * (j))
#define XB_XGEN(j)  (2304 + 64 * (j))
#define XB_TOP      3328
#define XB_TOPGEN   3392
#define XCD_BAR_WORDS 3456
#define XB_SPIN_CAP (1u << 18)

__device__ __forceinline__ unsigned xb_ld(unsigned* p)              { return __hip_atomic_load(p, __ATOMIC_RELAXED, __HIP_MEMORY_SCOPE_AGENT); }
__device__ __forceinline__ unsigned xb_add(unsigned* p, unsigned v) { return __hip_atomic_fetch_add(p, v, __ATOMIC_RELAXED, __HIP_MEMORY_SCOPE_AGENT); }
__device__ __forceinline__ unsigned xb_xcc_id() { return (unsigned)__builtin_amdgcn_s_getreg((3 << 11) | 20) & 0xFu; }
#define XB_SPIN(cond, bar) do { unsigned _sp = 0; while (cond) { __builtin_amdgcn_s_sleep(1); \
    if ((++_sp & 255u) == 0u) { if (xb_ld(&(bar)[XB_TMO])) break; if (_sp > XB_SPIN_CAP) { atomicAdd(&(bar)[XB_TMO], 1u); break; } } } } while (0)

struct XcdBarrier {
    unsigned* bar; unsigned x;
    volatile LAS unsigned* st;
};

__device__ __forceinline__ XcdBarrier xcd_barrier_post(unsigned* bar, volatile LAS unsigned* st, const int tid) {
    XcdBarrier b; b.bar = bar; b.x = xb_xcc_id(); b.st = st;
    if (tid == 0) (void)xb_add(&bar[XB_XCNT(b.x)], 1u);
    return b;
}
__device__ __forceinline__ void xcd_barrier_complete(unsigned* bar, unsigned x, unsigned& nloc, unsigned& nx) {
    const unsigned G = gridDim.x * gridDim.y * gridDim.z;
    unsigned sum, cnt, mine, sp = 0u;
    for (;;) {
        sum = 0u; cnt = 0u; mine = 0u;
#pragma unroll
        for (unsigned j = 0; j < 16; ++j) { const unsigned c = xb_ld(&bar[XB_XCNT(j)]); sum += c; cnt += (c > 0u) ? 1u : 0u; mine = (j == x) ? c : mine; }
        if (sum == G) break;
        __builtin_amdgcn_s_sleep(1);
        if ((++sp & 255u) == 0u) { if (xb_ld(&bar[XB_TMO])) break; if (sp > XB_SPIN_CAP) { atomicAdd(&bar[XB_TMO], 1u); break; } }
    }
    nloc = mine > 0u ? mine : 1u; nx = cnt > 0u ? cnt : 1u;
}

__device__ __forceinline__ void xcd_barrier(const XcdBarrier& b, const int tid) {
    asm volatile("s_waitcnt vmcnt(0)" ::: "memory");
    __syncthreads();
    if (tid == 0) {
        unsigned* bar = b.bar;
        __builtin_amdgcn_s_waitcnt(0);
        unsigned nloc = b.st[0], nx = b.st[1];
        if (nloc == 0u) { xcd_barrier_complete(bar, b.x, nloc, nx); b.st[0] = nloc; b.st[1] = nx; }
        const unsigned old = xb_add(&bar[XB_XSUB(b.x)], 1u);
        const unsigned gen = old / nloc;
        if (old + 1u == (gen + 1u) * nloc) {
            __builtin_amdgcn_fence(__ATOMIC_RELEASE, "agent");
            asm volatile("s_waitcnt vmcnt(0)" ::: "memory");
            const unsigned og = xb_add(&bar[XB_TOP], 1u);
            const unsigned tg = og / nx;
            if (og + 1u == (tg + 1u) * nx) xb_add(&bar[XB_TOPGEN], 1u);
            else XB_SPIN(xb_ld(&bar[XB_TOPGEN]) == tg, bar);
            __builtin_amdgcn_fence(__ATOMIC_ACQUIRE, "agent");
            xb_add(&bar[XB_XGEN(b.x)], 1u);
            asm volatile("s_waitcnt vmcnt(0)" ::: "memory");
        } else {
            XB_SPIN(xb_ld(&bar[XB_XGEN(b.x)]) == gen, bar);
            __builtin_amdgcn_fence(__ATOMIC_ACQUIRE, "agent");
            asm volatile("s_waitcnt vmcnt(0)" ::: "memory");
        }
    }
    __syncthreads();
}

enum { I_XP = 0, I_XS, I_CK, I_CV, I_SPOOL, I_SDNC, I_SDNS, I_SSSC, I_SSSH, I_PT, I_NMPRE, I_NMPOST, I_NLPRE, I_NLPOST, I_WIN, I_POOLW, I_POOLSC, I_DNCW, I_DNALOG, I_DNDTB, I_DNNW, I_SBBIAS,
       I_SSCW, I_SSCB, I_SSALOG, I_SSDTB, I_SSD, I_SSNW, I_WBR, I_WOUT, I_WUP, I_WDN, N_IN };
struct Args { const void* in[N_IN]; float* out; unsigned char* ws; int ph_lo, ph_hi, li, pad; };
#define IN_F(i) ((const float*)A->in[i])
#define WSP(T, off) ((T*)(A->ws + (off)))
typedef const __attribute__((opencl_constant)) Args* CA;
__device__ __forceinline__ CA args_opaque() { auto p = __builtin_amdgcn_kernarg_segment_ptr(); asm volatile("" : "+s"(p)); return (CA)p; }

struct EpiIn {
    static constexpr bool PERM = true, AFTER_DRAIN = false;
    float* UF; bf16* QKV; bf16* GATE; float *kp, *vp, *ks, *vs; float qscale;
    __device__ __forceinline__ void operator()(const f32x4 (&acc)[2][2][4][2], const pg8::Unit& u, int wr, int wc, int fr, int fq) const {
        const int pn = u.pn, row0 = u.pm * 256 + wr * 64 + fr, cl = wc * 32 + 8 * fq;
        if (pn < 10 || (pn >= 16 && pn < 26) || pn == 58) {
            const int col0 = pn * 256 + (pn < 10 ? 0 : (pn < 26 ? -1536 : -9728)) + cl;
#pragma unroll
            for (int ai = 0; ai < 2; ++ai)
#pragma unroll
                for (int m = 0; m < 4; ++m) { float* rowp = UF + (size_t)(row0 + ai * 128 + m * 16) * UFW + col0;
#pragma unroll
                    for (int bj = 0; bj < 2; ++bj) { *(f32x4*)(rowp + bj * 128) = acc[ai][bj][m][0]; *(f32x4*)(rowp + bj * 128 + 4) = acc[ai][bj][m][1]; } }
        } else if (pn < 16) {
            const int which = (pn - 10) >> 1, c512 = ((pn - 10) & 1) * 256 + cl; const float sc = which == 0 ? qscale : 1.f;
#pragma unroll
            for (int ai = 0; ai < 2; ++ai)
#pragma unroll
                for (int m = 0; m < 4; ++m) { const int r = row0 + ai * 128 + m * 16; bf16* rowp = QKV + (size_t)r * 1536 + which * 512 + c512;
                    float* fo = nullptr;
                    if (which) { if (r < TP) fo = (which == 1 ? kp : vp) + (size_t)r * 512 + c512; else if (r < TT) fo = (which == 1 ? ks : vs) + (size_t)(r - TP) * 512 + c512; }
#pragma unroll
                    for (int bj = 0; bj < 2; ++bj) { const f32x4 v0 = acc[ai][bj][m][0], v1 = acc[ai][bj][m][1];
                        v4u w; w.x = pk2(v0[0] * sc, v0[1] * sc); w.y = pk2(v0[2] * sc, v0[3] * sc); w.z = pk2(v1[0] * sc, v1[1] * sc); w.w = pk2(v1[2] * sc, v1[3] * sc);
                        *(v4u*)(rowp + bj * 128) = w;
                        if (fo) { *(f32x4*)(fo + bj * 128) = v0; *(f32x4*)(fo + bj * 128 + 4) = v1; } } }
        } else {
            const int col0 = (pn - 26) * 256 + cl;
#pragma unroll
            for (int ai = 0; ai < 2; ++ai)
#pragma unroll
                for (int m = 0; m < 4; ++m) { bf16* rowp = GATE + (size_t)(row0 + ai * 128 + m * 16) * 8192 + col0;
#pragma unroll
                    for (int bj = 0; bj < 2; ++bj) { const f32x4 v0 = acc[ai][bj][m][0], v1 = acc[ai][bj][m][1];
                        v4u w; w.x = pk2(sigmoidf_(v0[0]), sigmoidf_(v0[1])); w.y = pk2(sigmoidf_(v0[2]), sigmoidf_(v0[3])); w.z = pk2(sigmoidf_(v1[0]), sigmoidf_(v1[1])); w.w = pk2(sigmoidf_(v1[2]), sigmoidf_(v1[3]));
                        *(v4u*)(rowp + bj * 128) = w; } }
        }
    }
};
template <int S> struct EpiMerge {
    static constexpr bool PERM = true, AFTER_DRAIN = false;
    const bf16* GATE; const float* SSQ; float* MG32; bf16* MGB;
    __device__ __forceinline__ void operator()(const f32x4 (&acc)[2][2][4][2], const pg8::Unit& u, int wr, int wc, int fr, int fq) const {
        const int row0 = u.pm * 256 + wr * 64 + fr, col0 = u.pn * 256 + wc * 32 + 8 * fq; constexpr int GS = S < 3 ? S : 3;
#pragma unroll
        for (int ai = 0; ai < 2; ++ai)
#pragma unroll
            for (int m = 0; m < 4; ++m) { const int r = row0 + ai * 128 + m * 16; float rs = 1.f;
                if (S >= 3) { const f32x4 q0 = *(const f32x4*)(SSQ + (size_t)r * 16 + 8 * (S - 3)), q1 = *(const f32x4*)(SSQ + (size_t)r * 16 + 8 * (S - 3) + 4);
                    const float ss = (q0[0] + q0[1]) + (q0[2] + q0[3]) + (q1[0] + q1[1]) + (q1[2] + q1[3]); rs = 1.0f / sqrtf(ss * (1.0f / 512.0f) + RMS_EPS); }
#pragma unroll
                for (int bj = 0; bj < 2; ++bj) { const size_t o = (size_t)r * DM + col0 + bj * 128;
                    const v4u g = *(const v4u*)(GATE + (size_t)r * 8192 + GS * 2048 + col0 + bj * 128);
                    f32x4 v0 = acc[ai][bj][m][0], v1 = acc[ai][bj][m][1];
                    v0[0] *= bflo(g.x) * rs; v0[1] *= bfhi(g.x) * rs; v0[2] *= bflo(g.y) * rs; v0[3] *= bfhi(g.y) * rs;
                    v1[0] *= bflo(g.z) * rs; v1[1] *= bfhi(g.z) * rs; v1[2] *= bflo(g.w) * rs; v1[3] *= bfhi(g.w) * rs;
                    if (S > 0) { v0 += *(const f32x4*)(MG32 + o); v1 += *(const f32x4*)(MG32 + o + 4); }
                    if (S < 4) { *(f32x4*)(MG32 + o) = v0; *(f32x4*)(MG32 + o + 4) = v1; }
                    else { v4u w; w.x = pk2(v0[0], v0[1]); w.y = pk2(v0[2], v0[3]); w.z = pk2(v1[0], v1[1]); w.w = pk2(v1[2], v1[3]); *(v4u*)(MGB + o) = w; } } }
    }
};
struct EpiF32 {
    static constexpr bool PERM = true, AFTER_DRAIN = false;
    float* C; int ldc;
    __device__ __forceinline__ void operator()(const f32x4 (&acc)[2][2][4][2], const pg8::Unit& u, int wr, int wc, int fr, int fq) const {
        const int row0 = u.pm * 256 + wr * 64 + fr, col0 = u.pn * 256 + wc * 32 + 8 * fq;
#pragma unroll
        for (int ai = 0; ai < 2; ++ai)
#pragma unroll
            for (int m = 0; m < 4; ++m) { float* rowp = C + (size_t)(row0 + ai * 128 + m * 16) * ldc + col0;
#pragma unroll
                for (int bj = 0; bj < 2; ++bj) { *(f32x4*)(rowp + bj * 128) = acc[ai][bj][m][0]; *(f32x4*)(rowp + bj * 128 + 4) = acc[ai][bj][m][1]; } }
    }
};
struct EpiRelu2 {
    static constexpr bool PERM = true, AFTER_DRAIN = false;
    bf16* O; int ldc;
    __device__ __forceinline__ void operator()(const f32x4 (&acc)[2][2][4][2], const pg8::Unit& u, int wr, int wc, int fr, int fq) const {
        const int row0 = u.pm * 256 + wr * 64 + fr, col0 = u.pn * 256 + wc * 32 + 8 * fq;
#pragma unroll
        for (int ai = 0; ai < 2; ++ai)
#pragma unroll
            for (int m = 0; m < 4; ++m) { bf16* rowp = O + (size_t)(row0 + ai * 128 + m * 16) * ldc + col0;
#pragma unroll
                for (int bj = 0; bj < 2; ++bj) { f32x4 v0 = acc[ai][bj][m][0], v1 = acc[ai][bj][m][1];
#pragma unroll
                    for (int e = 0; e < 4; ++e) { const float a = fmaxf(v0[e], 0.f), b = fmaxf(v1[e], 0.f); v0[e] = a * a; v1[e] = b * b; }
                    v4u w; w.x = pk2(v0[0], v0[1]); w.y = pk2(v0[2], v0[3]); w.z = pk2(v1[0], v1[1]); w.w = pk2(v1[2], v1[3]); *(v4u*)(rowp + bj * 128) = w; } }
    }
};

__device__ __forceinline__ int win_src_col(int n) {
    if (n < 2560) return n;
    if (n < 6656) return n + 8;
    if (n < 14848) return n + 24;
    if (n < 14856) return n - 14848 + 2560;
    if (n < 14872) return n - 14856 + 6664;
    return -1;
}
template <int MODE>
__device__ __forceinline__ void transpose_item(const float* W, int ldw, int K, bf16* WT, int n0, int k0, const float* kscale, LAS float* scr, int lane) {
    const int n = n0 + (lane & 31); const int sc = MODE ? win_src_col(n) : n;
#pragma unroll 8
    for (int i = 0; i < 32; ++i) { const int kk = 2 * i + (lane >> 5); float v = sc >= 0 ? W[(size_t)(k0 + kk) * ldw + sc] : 0.f; if (kscale) v *= kscale[k0 + kk]; scr[kk * 33 + (lane & 31)] = v; }
    asm volatile("s_waitcnt lgkmcnt(0)" ::: "memory");
    const int c = lane & 7;
#pragma unroll
    for (int j = 0; j < 4; ++j) { const int nn = (lane >> 3) + 8 * j; const LAS float* s = scr + (8 * c) * 33 + nn;
        v4u o; o.x = pk2(s[0 * 33], s[1 * 33]); o.y = pk2(s[2 * 33], s[3 * 33]); o.z = pk2(s[4 * 33], s[5 * 33]); o.w = pk2(s[6 * 33], s[7 * 33]);
        *(v4u*)(WT + (size_t)(n0 + nn) * K + k0 + 8 * c) = o; }
    asm volatile("s_waitcnt lgkmcnt(0)" ::: "memory");
}
__device__ __forceinline__ void p0_prologue(CA A, LAS unsigned char* lds, const int wv) {
    const int tid = tid_opaque(wv), lane = tid & 63, wave = tid >> 6, G = gridDim.x;
    LAS float* scr = (LAS float*)(lds + wave * 8704);
    const int gw = blk_opaque() * NWAVES + wave, NGW = G * NWAVES;
    constexpr int I_IN = (NIN / 32) * (DM / 64), I_BR = (DM / 32) * (512 / 64), I_OUT = (DM / 32) * (DM / 64), I_UP = (DFF / 32) * (DM / 64), I_DN = (DM / 32) * (DFF / 64);
    constexpr int PER_LAYER = I_IN + 4 * I_BR + I_OUT + I_UP + I_DN;
    for (int it = gw; it < 2 * PER_LAYER; it += NGW) {
        const int L = it / PER_LAYER; int r = it % PER_LAYER;
        if (r < I_IN) { const int nb = r % (NIN / 32), kb = r / (NIN / 32);
            transpose_item<1>(IN_F(I_WIN) + (size_t)L * DM * INCOLS, INCOLS, DM, WSP(bf16, WS_WIN) + (size_t)L * NIN * DM, nb * 32, kb * 64, nullptr, scr, lane); continue; }
        r -= I_IN;
        if (r < 4 * I_BR) { const int s = 1 + r / I_BR, q = r % I_BR, nb = q % (DM / 32), kb = q / (DM / 32);
            transpose_item<0>(IN_F(I_WBR) + ((size_t)L * 2560 + 512 * s) * DM, DM, 512, WSP(bf16, WS_WBR) + (size_t)(L * 5 + s) * DM * 512, nb * 32, kb * 64,
                              s >= 3 ? IN_F(I_SSNW) + L * 1024 + (s - 3) * 512 : nullptr, scr, lane); continue; }
        r -= 4 * I_BR;
        if (r < I_OUT) { const int nb = r % (DM / 32), kb = r / (DM / 32);
            transpose_item<0>(IN_F(I_WOUT) + (size_t)L * DM * DM, DM, DM, WSP(bf16, WS_WOUT) + (size_t)L * DM * DM, nb * 32, kb * 64, nullptr, scr, lane); continue; }
        r -= I_OUT;
        if (r < I_UP) { const int nb = r % (DFF / 32), kb = r / (DFF / 32);
            transpose_item<0>(IN_F(I_WUP) + (size_t)L * DM * DFF, DFF, DM, WSP(bf16, WS_WUP) + (size_t)L * DFF * DM, nb * 32, kb * 64, nullptr, scr, lane); continue; }
        r -= I_UP;
        { const int nb = r % (DM / 32), kb = r / (DM / 32);
            transpose_item<0>(IN_F(I_WDN) + (size_t)L * DFF * DM, DM, DFF, WSP(bf16, WS_WDN) + (size_t)L * DM * DFF, nb * 32, kb * 64, nullptr, scr, lane); }
    }
    for (int idx = blk_opaque() * NTHR + tid; idx < 2 * DM * 64; idx += G * NTHR) {
        const int L = idx / (DM * 64), q = idx % (DM * 64), n = q & (DM - 1), kc = q >> 11, k0 = kc * 8, g = k0 >> 7, c0 = k0 & 127;
        const float* pw = IN_F(I_POOLW) + ((size_t)(L * 4 + g) * 128 + c0) * 128; const float* psc = IN_F(I_POOLSC) + L * 512 + g * 128;
        const float* wb = IN_F(I_WBR) + ((size_t)L * 2560 + g * 128) * DM + n;
        float acc[8] = {0.f, 0.f, 0.f, 0.f, 0.f, 0.f, 0.f, 0.f};
        for (int d = 0; d < 128; ++d) { const float wv = wb[(size_t)d * DM] * psc[d];
#pragma unroll
            for (int i = 0; i < 8; ++i) acc[i] += pw[i * 128 + d] * wv; }
        v4u o; o.x = pk2(acc[0], acc[1]); o.y = pk2(acc[2], acc[3]); o.z = pk2(acc[4], acc[5]); o.w = pk2(acc[6], acc[7]);
        *(v4u*)(WSP(bf16, WS_WBR) + (size_t)(L * 5) * DM * 512 + (size_t)n * 512 + k0) = o;
    }
}

__device__ __forceinline__ const float* xin_row(CA A, int m) { return m < TP ? IN_F(I_XP) + (size_t)m * DM : IN_F(I_XS) + (size_t)(m - TP) * DM; }
__device__ __forceinline__ void store_bf16_row(bf16* orow, const f32x4 (&v)[8], float rstd, const float* g, int lane) {
#pragma unroll
    for (int j = 0; j < 8; ++j) { const f32x4 gj = ((const f32x4*)g)[lane + 64 * j]; const f32x4 o = v[j] * rstd * gj;
        v2u w; w.x = pk2(o[0], o[1]); w.y = pk2(o[2], o[3]); ((v2u*)orow)[lane + 64 * j] = w; }
}
__device__ __forceinline__ void norm1_phase(CA A, const int wv) {
    const int tid = tid_opaque(wv), lane = tid & 63, gw = blk_opaque() * NWAVES + (tid >> 6), NGW = gridDim.x * NWAVES;
    bf16* H = WSP(bf16, WS_H);
    for (int m = gw; m < MP; m += NGW) {
        if (m >= TT) { for (int j = 0; j < 8; ++j) ((v2u*)(H + (size_t)m * DM))[lane + 64 * j] = (v2u){0u, 0u}; continue; }
        const f32x4* xr = (const f32x4*)xin_row(A, m); f32x4 v[8]; float s = 0.f;
#pragma unroll
        for (int j = 0; j < 8; ++j) { v[j] = xr[lane + 64 * j]; s += (v[j][0] * v[j][0] + v[j][1] * v[j][1]) + (v[j][2] * v[j][2] + v[j][3] * v[j][3]); }
        const float rstd = 1.0f / sqrtf(wave_sum(s) * (1.0f / DM) + RMS_EPS);
        store_bf16_row(H + (size_t)m * DM, v, rstd, IN_F(I_NMPRE), lane);
    }
}
__device__ __forceinline__ void resid_phase(CA A, const float* Y, const float* gpost, const float* gnext, bool from_input, const int wv) {
    const int tid = tid_opaque(wv), lane = tid & 63, gw = blk_opaque() * NWAVES + (tid >> 6), NGW = gridDim.x * NWAVES;
    bf16* H = WSP(bf16, WS_H);
    for (int m = gw; m < TT; m += NGW) {
        const f32x4* yr = (const f32x4*)(Y + (size_t)m * DM); const f32x4* xr = from_input ? (const f32x4*)xin_row(A, m) : (const f32x4*)(A->out + O_Y + (size_t)m * DM);
        f32x4 v[8]; float s = 0.f;
#pragma unroll
        for (int j = 0; j < 8; ++j) { v[j] = yr[lane + 64 * j]; s += (v[j][0] * v[j][0] + v[j][1] * v[j][1]) + (v[j][2] * v[j][2] + v[j][3] * v[j][3]); }
        const float rstd = 1.0f / sqrtf(wave_sum(s) * (1.0f / DM) + RMS_EPS); float s2 = 0.f;
        f32x4* orow = (f32x4*)(A->out + O_Y + (size_t)m * DM);
#pragma unroll
        for (int j = 0; j < 8; ++j) { const f32x4 gj = ((const f32x4*)gpost)[lane + 64 * j]; v[j] = xr[lane + 64 * j] + v[j] * rstd * gj; orow[lane + 64 * j] = v[j];
            s2 += (v[j][0] * v[j][0] + v[j][1] * v[j][1]) + (v[j][2] * v[j][2] + v[j][3] * v[j][3]); }
        if (gnext) { const float rstd2 = 1.0f / sqrtf(wave_sum(s2) * (1.0f / DM) + RMS_EPS); store_bf16_row(H + (size_t)m * DM, v, rstd2, gnext, lane); }
    }
}

__device__ __forceinline__ float conv_tap(const float* UF, const float* state, int row, int j, int ucol, int c) {
    if (row < TP) { const int t = row & (SEQ - 1); return (t - 3 + j) >= 0 ? UF[(size_t)(row - 3 + j) * UFW + ucol + c] : 0.f; }
    const int s = row - TP, sb = s >> 2, e = (s & 3) + j;
    return e < 3 ? state[(size_t)(sb * 3 + e) * 1536 + c] : UF[(size_t)(TP + sb * 4 + e - 3) * UFW + ucol + c];
}
__device__ __forceinline__ void prep_phase(CA A, int layer, const int wv) {
    const int tid = tid_opaque(wv), lane = tid & 63, G = gridDim.x, gt = blk_opaque() * NTHR + tid, NGT = G * NTHR, gw = blk_opaque() * NWAVES + (tid >> 6), NGW = G * NWAVES;
    const float* UF = WSP(float, WS_UF); float* SC = WSP(float, WS_SCAL);
    for (int idx = gt; idx < TT * 24; idx += NGT) { const int row = idx / 24, j = idx % 24; const float u = UF[(size_t)row * UFW + UF_SMALL + j]; float r;
        if (j < 4) r = sigmoidf_(u);
        else if (j < 8) r = -expf(IN_F(I_DNALOG)[layer * 4 + j - 4]) * softplusf_(u + IN_F(I_DNDTB)[layer * 4 + j - 4]);
        else r = softplusf_(u + IN_F(I_SSDTB)[layer * 16 + j - 8]);
        SC[(size_t)row * 32 + j] = r; }
    { bf16* O0 = WSP(bf16, WS_OBR); const float* spool = IN_F(I_SPOOL) + (size_t)layer * DBATCH * 15 * 512;
      for (int idx = gt; idx < TT * 512; idx += NGT) { const int row = idx >> 9, ch = idx & 511, w = 2 << (ch >> 7); float s = 0.f, cnt;
          if (row < TP) { const int t = row & (SEQ - 1); const int n = (t + 1) < w ? (t + 1) : w; cnt = (float)n; for (int j = 0; j < n; ++j) s += UF[(size_t)(row - j) * UFW + ch]; }
          else { const int q = row - TP, sb = q >> 2, e = 15 + (q & 3); cnt = (float)w;
              for (int j = 0; j < w; ++j) { const int ee = e - j; s += ee < 15 ? spool[(size_t)(sb * 15 + ee) * 512 + ch] : UF[(size_t)(TP + sb * 4 + ee - 15) * UFW + ch]; } }
          O0[(size_t)row * 512 + ch] = (bf16)f2bf(s / cnt - UF[(size_t)row * UFW + ch]); } }
    { float* DNQ = WSP(float, WS_DNQ); const float* st = IN_F(I_SDNC) + (size_t)layer * DBATCH * 3 * 1536; const float* cw = IN_F(I_DNCW) + (size_t)layer * 4 * 1536;
      for (int it = gw; it < TT * 12; it += NGW) { const int row = it / 12, hd = it % 12, c = hd * 128 + 2 * lane; float a0 = 0.f, a1 = 0.f;
#pragma unroll
          for (int j = 0; j < 4; ++j) { a0 += conv_tap(UF, st, row, j, UF_DNQKV, c) * cw[j * 1536 + c]; a1 += conv_tap(UF, st, row, j, UF_DNQKV, c + 1) * cw[j * 1536 + c + 1]; }
          a0 = siluf_(a0); a1 = siluf_(a1);
          if (hd < 8) { const float ss = wave_sum(a0 * a0 + a1 * a1); float sc = 1.0f / sqrtf(ss + 1e-6f); if (hd < 4) sc *= 0.08838834764831845f; a0 *= sc; a1 *= sc; }
          *(f32x2*)(DNQ + (size_t)row * 1536 + c) = (f32x2){a0, a1}; } }
    { float* XBC = WSP(float, WS_XBC); const float* st = IN_F(I_SSSC) + (size_t)layer * DBATCH * 3 * 1536; const float* cw = IN_F(I_SSCW) + (size_t)layer * 4 * 1536; const float* cb = IN_F(I_SSCB) + layer * 1536;
      for (int idx = gt; idx < TT * 1536; idx += NGT) { const int row = idx / 1536, c = idx % 1536; float a = cb[c];
#pragma unroll
          for (int j = 0; j < 4; ++j) a += conv_tap(UF, st, row, j, UF_XBC, c) * cw[j * 1536 + c];
          XBC[(size_t)row * 1536 + c] = siluf_(a); } }
    for (int idx = gt; idx < NBATCH * 3 * 1536; idx += NGT) { const int b = idx / (3 * 1536), q = idx % (3 * 1536), j = q / 1536, c = q % 1536; const size_t src = (size_t)(b * SEQ + SEQ - 3 + j) * UFW;
        A->out[O_DNCP + (size_t)layer * NBATCH * 3 * 1536 + idx] = UF[src + UF_DNQKV + c]; A->out[O_SSCP + (size_t)layer * NBATCH * 3 * 1536 + idx] = UF[src + UF_XBC + c]; }
    for (int idx = gt; idx < DBATCH * 3 * 1536; idx += NGT) { const int sb = idx / (3 * 1536), q = idx % (3 * 1536), j = q / 1536, c = q % 1536; const size_t src = (size_t)(TP + sb * 4 + 1 + j) * UFW;
        A->out[O_DNCS + (size_t)layer * DBATCH * 3 * 1536 + idx] = UF[src + UF_DNQKV + c]; A->out[O_SSCS + (size_t)layer * DBATCH * 3 * 1536 + idx] = UF[src + UF_XBC + c]; }
    for (int idx = gt; idx < NBATCH * 15 * 512; idx += NGT) { const int b = idx / (15 * 512), q = idx % (15 * 512), j = q >> 9, ch = q & 511;
        A->out[O_POOLP + (size_t)layer * NBATCH * 15 * 512 + idx] = UF[(size_t)(b * SEQ + SEQ - 15 + j) * UFW + ch]; }
    { const float* spool = IN_F(I_SPOOL) + (size_t)layer * DBATCH * 15 * 512;
      for (int idx = gt; idx < DBATCH * 15 * 512; idx += NGT) { const int sb = idx / (15 * 512), q = idx % (15 * 512), j = q >> 9, ch = q & 511, e = 4 + j;
          A->out[O_POOLS + (size_t)layer * DBATCH * 15 * 512 + idx] = e < 15 ? spool[(size_t)(sb * 15 + e) * 512 + ch] : UF[(size_t)(TP + sb * 4 + e - 15) * UFW + ch]; } }
}

__device__ __forceinline__ void dn_seq(CA A, LAS unsigned char* lds, int layer, int unit, const int wv) {
    const int tid = tid_opaque(wv), lane = tid & 63, wid = tid >> 6, v = tid & 127, kq = tid >> 7;
    int row0, L, h; const float* s0 = nullptr; float* sout;
    if (unit < 16) { const int b = unit >> 2; h = unit & 3; row0 = b * SEQ; L = SEQ; sout = A->out + O_DNSP + ((size_t)(layer * NBATCH + b) * 4 + h) * 16384; }
    else { const int u = unit - 16, sb = u >> 2; h = u & 3; row0 = TP + sb * 4; L = DSEQ; s0 = IN_F(I_SDNS) + ((size_t)(layer * DBATCH + sb) * 4 + h) * 16384; sout = A->out + O_DNSS + ((size_t)(layer * DBATCH + sb) * 4 + h) * 16384; }
    constexpr int CH = 32;
    LAS float* qs = (LAS float*)lds; LAS float* ks = qs + CH * 128; LAS float* vs = ks + CH * 128; LAS float* ob = vs + CH * 128;
    LAS float* red = ob + CH * 128;
    LAS float* egs = red + 2 * 2 * 4 * 128; LAS float* bts = egs + CH; LAS float* kqd = bts + CH;
    const float* DNQ = WSP(float, WS_DNQ); const float* SC = WSP(float, WS_SCAL); const float* UF = WSP(float, WS_UF); bf16* O1 = WSP(bf16, WS_OBR) + (size_t)MP * 512;
    const float* nw = IN_F(I_DNNW) + layer * 128;
    float S[32];
#pragma unroll
    for (int i = 0; i < 32; ++i) S[i] = s0 ? s0[(size_t)(32 * kq + i) * 128 + v] : 0.f;
    for (int c0 = 0; c0 < L; c0 += CH) {
        const int n = (L - c0) < CH ? (L - c0) : CH;
        __syncthreads();
        for (int idx = tid; idx < n * 128; idx += NTHR) { const int t = idx >> 7, c = idx & 127; const float* src = DNQ + (size_t)(row0 + c0 + t) * 1536 + h * 128 + c;
            qs[idx] = src[0]; ks[idx] = src[512]; vs[idx] = src[1024]; }
        if (tid < n) { const float* sc = SC + (size_t)(row0 + c0 + tid) * 32; bts[tid] = sc[h]; egs[tid] = expf(sc[4 + h]); }
        __syncthreads();
        for (int t = wid; t < n; t += NWAVES) { const float s = wave_sum(ks[t * 128 + lane] * qs[t * 128 + lane] + ks[t * 128 + 64 + lane] * qs[t * 128 + 64 + lane]); if (lane == 0) kqd[t] = s; }
        __syncthreads();
        for (int t = 0; t < n; ++t) {
            const float eg = egs[t], bt = bts[t]; float kk[32]; float r = 0.f, pp = 0.f;
#pragma unroll
            for (int i4 = 0; i4 < 8; ++i4) { const f32x4 k4 = *(const LAS f32x4*)(ks + t * 128 + 32 * kq + 4 * i4), q4 = *(const LAS f32x4*)(qs + t * 128 + 32 * kq + 4 * i4);
#pragma unroll
                for (int e = 0; e < 4; ++e) { const int i = 4 * i4 + e; S[i] *= eg; kk[i] = k4[e]; r += S[i] * k4[e]; pp += S[i] * q4[e]; } }
            LAS float* rd = red + (t & 1) * 1024;
            rd[kq * 128 + v] = r; rd[512 + kq * 128 + v] = pp;
            __syncthreads();
            const float rt = (rd[v] + rd[128 + v]) + (rd[256 + v] + rd[384 + v]), pt = (rd[512 + v] + rd[640 + v]) + (rd[768 + v] + rd[896 + v]);
            const float dd = bt * (vs[t * 128 + v] - rt);
#pragma unroll
            for (int i = 0; i < 32; ++i) S[i] += kk[i] * dd;
            if (kq == 0) ob[t * 128 + v] = pt + kqd[t] * dd;
        }
        __syncthreads();
        for (int t = wid; t < n; t += NWAVES) { const int row = row0 + c0 + t; const float o0 = ob[t * 128 + lane], o1 = ob[t * 128 + 64 + lane];
            const float rstd = 1.0f / sqrtf(wave_sum(o0 * o0 + o1 * o1) * (1.0f / 128.0f) + RMS_EPS);
            const float z0 = UF[(size_t)row * UFW + UF_DNZ + h * 128 + lane], z1 = UF[(size_t)row * UFW + UF_DNZ + h * 128 + 64 + lane];
            O1[(size_t)row * 512 + h * 128 + lane] = (bf16)f2bf(o0 * rstd * nw[lane] * siluf_(z0)); O1[(size_t)row * 512 + h * 128 + 64 + lane] = (bf16)f2bf(o1 * rstd * nw[64 + lane] * siluf_(z1)); }
    }
#pragma unroll
    for (int i = 0; i < 32; ++i) sout[(size_t)(32 * kq + i) * 128 + v] = S[i];
    __syncthreads();
}

__device__ __forceinline__ void ssd_seq(CA A, LAS unsigned char* lds, int layer, int unit, const int wv) {
    const int tid = tid_opaque(wv), lane = tid & 63, wid = tid >> 6, p = tid >> 3, nq = tid & 7;
    int row0, L, hd; const float* h0 = nullptr; float* hout;
    if (unit < 64) { const int b = unit >> 4; hd = unit & 15; row0 = b * SEQ; L = SEQ; hout = A->out + O_SSHP + ((size_t)(layer * NBATCH + b) * 16 + hd) * 8192; }
    else { const int u = unit - 64, sb = u >> 4; hd = u & 15; row0 = TP + sb * 4; L = DSEQ; h0 = IN_F(I_SSSH) + ((size_t)(layer * DBATCH + sb) * 16 + hd) * 8192; hout = A->out + O_SSHS + ((size_t)(layer * DBATCH + sb) * 16 + hd) * 8192; }
    const int g = hd >> 3; constexpr int CH = 64;
    LAS float* Bs = (LAS float*)lds; LAS float* Cs = Bs + CH * 128; LAS float* xs = Cs + CH * 128; LAS float* yb = xs + CH * 64; LAS float* dts = yb + CH * 64;
    const float* XBC = WSP(float, WS_XBC); const float* SC = WSP(float, WS_SCAL); const float* UF = WSP(float, WS_UF); float* SSQ = WSP(float, WS_SSQ);
    bf16* Og = WSP(bf16, WS_OBR) + (size_t)(3 + g) * MP * 512;
    const float a = -expf(IN_F(I_SSALOG)[layer * 16 + hd]), Dk = IN_F(I_SSD)[layer * 16 + hd];
    float hs[16];
#pragma unroll
    for (int j = 0; j < 16; ++j) hs[j] = h0 ? h0[(size_t)p * 128 + 16 * nq + j] : 0.f;
    for (int c0 = 0; c0 < L; c0 += CH) {
        const int n = (L - c0) < CH ? (L - c0) : CH;
        __syncthreads();
        for (int idx = tid; idx < n * 128; idx += NTHR) { const int t = idx >> 7, c = idx & 127; const float* src = XBC + (size_t)(row0 + c0 + t) * 1536; Bs[idx] = src[1024 + g * 128 + c]; Cs[idx] = src[1280 + g * 128 + c]; }
        for (int idx = tid; idx < n * 64; idx += NTHR) { const int t = idx >> 6, c = idx & 63; xs[idx] = XBC[(size_t)(row0 + c0 + t) * 1536 + hd * 64 + c]; }
        if (tid < n) dts[tid] = SC[(size_t)(row0 + c0 + tid) * 32 + 8 + hd];
        __syncthreads();
        for (int t = 0; t < n; ++t) {
            const float dt = dts[t], dA = expf(dt * a), xv = xs[t * 64 + p], cx = dt * xv; float y = 0.f;
#pragma unroll
            for (int j4 = 0; j4 < 4; ++j4) { const f32x4 b4 = *(const LAS f32x4*)(Bs + t * 128 + 16 * nq + 4 * j4), c4 = *(const LAS f32x4*)(Cs + t * 128 + 16 * nq + 4 * j4);
#pragma unroll
                for (int e = 0; e < 4; ++e) { const int j = 4 * j4 + e; hs[j] = hs[j] * dA + cx * b4[e]; y += hs[j] * c4[e]; } }
            y += __shfl_xor(y, 1); y += __shfl_xor(y, 2); y += __shfl_xor(y, 4);
            if (nq == 0) yb[t * 64 + p] = y + Dk * xv;
        }
        __syncthreads();
        for (int t = wid; t < n; t += NWAVES) { const int row = row0 + c0 + t; const float z = UF[(size_t)row * UFW + UF_SSZ + hd * 64 + lane]; const float yg = yb[t * 64 + lane] * siluf_(z);
            const float ss = wave_sum(yg * yg); if (lane == 0) SSQ[(size_t)row * 16 + hd] = ss;
            Og[(size_t)row * 512 + (hd & 7) * 64 + lane] = (bf16)f2bf(yg); }
    }
#pragma unroll
    for (int j = 0; j < 16; ++j) hout[(size_t)p * 128 + 16 * nq + j] = hs[j];
    __syncthreads();
}

constexpr int KS_PITCH = 272, VT_PITCH = 136;
constexpr int ATT_KS = 0, ATT_VT = 64 * KS_PITCH;
__device__ __forceinline__ void attn_prompt_unit(CA A, LAS unsigned char* lds, int layer, int unit, const int wv) {
    const int tid = tid_opaque(wv), lane = tid & 63, wid = tid >> 6, r = lane & 31, hh = lane >> 5;
    const int qb = 7 - (unit >> 4), bh = unit & 15, b = bh >> 2, h = bh & 3;
    const int q0 = qb * 256 + wid * 32, qpos = q0 + r;
    const bf16* QKV = WSP(bf16, WS_QKV) + (size_t)(b * SEQ) * 1536;
    bf16x8 Qf[8];
    { const bf16* qrow = QKV + (size_t)qpos * 1536 + h * 128 + 8 * hh;
#pragma unroll
      for (int s = 0; s < 8; ++s) Qf[s] = *(const bf16x8*)(qrow + 16 * s); }
    f32x16 O[4];
#pragma unroll
    for (int d = 0; d < 4; ++d)
#pragma unroll
        for (int i = 0; i < 16; ++i) O[d][i] = 0.f;
    float R = 0.f;
    const float bias2 = IN_F(I_SBBIAS)[layer * 4 + h] * LOG2E;
    const int ntile = qb * 4 + 4, srow = tid >> 3, sch = tid & 7;
    LAS unsigned char* Ks = lds + ATT_KS; LAS unsigned char* Vt = lds + ATT_VT;
    v4u kreg[2], vreg[2];
    { const bf16* src = QKV + (size_t)((ntile - 1) * 64 + srow) * 1536 + h * 128 + sch * 8;
      kreg[0] = *(const v4u*)(src + 512); kreg[1] = *(const v4u*)(src + 512 + 64); vreg[0] = *(const v4u*)(src + 1024); vreg[1] = *(const v4u*)(src + 1024 + 64); }
    for (int kt = ntile - 1; kt >= 0; --kt) {
        __syncthreads();
#pragma unroll
        for (int i = 0; i < 2; ++i) { *(LAS v4u*)(Ks + srow * KS_PITCH + (sch + 8 * i) * 16) = kreg[i];
            LAS unsigned short* vt = (LAS unsigned short*)Vt + ((sch + 8 * i) * 8) * (VT_PITCH / 2) + srow;
            const unsigned w[4] = {vreg[i].x, vreg[i].y, vreg[i].z, vreg[i].w};
#pragma unroll
            for (int e = 0; e < 4; ++e) { vt[(2 * e) * (VT_PITCH / 2)] = (unsigned short)(w[e] & 0xffffu); vt[(2 * e + 1) * (VT_PITCH / 2)] = (unsigned short)(w[e] >> 16); } }
        __syncthreads();
        if (kt > 0) { const bf16* src = QKV + (size_t)((kt - 1) * 64 + srow) * 1536 + h * 128 + sch * 8;
            kreg[0] = *(const v4u*)(src + 512); kreg[1] = *(const v4u*)(src + 512 + 64); vreg[0] = *(const v4u*)(src + 1024); vreg[1] = *(const v4u*)(src + 1024 + 64); }
        if (kt * 64 > q0 + 30) continue;
        const bool diag = (kt * 64 + 63 >= q0);
        const int kbase = kt * 64 + 4 * hh;
        bf16x8 Pf[4];
#pragma unroll
        for (int sub = 1; sub >= 0; --sub) {
            f32x16 sa;
#pragma unroll
            for (int i = 0; i < 16; ++i) sa[i] = bias2;
#pragma unroll
            for (int s = 0; s < 8; ++s) { const bf16x8 a = *(const LAS bf16x8*)(Ks + (32 * sub + r) * KS_PITCH + (16 * s + 8 * hh) * 2);
                sa = __builtin_amdgcn_mfma_f32_32x32x16_bf16(a, Qf[s], sa, 0, 0, 0); }
            float sp[16], Gs[4], Gp[4];
#pragma unroll
            for (int i = 0; i < 16; ++i) { const float z = fminf(sa[i], 60.f); sa[i] = z; float s1 = lg2(1.0f + ex2(z));
                if (diag && (kbase + 32 * sub + 8 * (i >> 2) + (i & 3) >= qpos)) s1 = 0.f;
                sp[i] = s1; }
#pragma unroll
            for (int g = 0; g < 4; ++g) { Gs[g] = (sp[4 * g] + sp[4 * g + 1]) + (sp[4 * g + 2] + sp[4 * g + 3]); Gp[g] = __shfl_xor(Gs[g], 32); }
            float run = R;
#pragma unroll
            for (int g = 3; g >= 0; --g) { float a = run + (hh == 0 ? Gp[g] : 0.f);
#pragma unroll
                for (int e = 3; e >= 0; --e) { const int i = 4 * g + e; float pv = ex2(sa[i] - sp[i] - a);
                    if (diag && (kbase + 32 * sub + 8 * g + e >= qpos)) pv = 0.f;
                    a += sp[i]; sp[i] = pv; }
                run += Gs[g] + Gp[g]; }
            R = run;
#pragma unroll
            for (int q2 = 0; q2 < 2; ++q2) { const int bs = 8 * q2; v4u w;
                w.x = pk2(sp[bs + 0], sp[bs + 1]); w.y = pk2(sp[bs + 2], sp[bs + 3]); w.z = pk2(sp[bs + 4], sp[bs + 5]); w.w = pk2(sp[bs + 6], sp[bs + 7]);
                Pf[2 * sub + q2] = __builtin_bit_cast(bf16x8, w); }
        }
#pragma unroll
        for (int d = 0; d < 4; ++d)
#pragma unroll
            for (int s4 = 0; s4 < 4; ++s4) { const LAS unsigned char* vp = Vt + (32 * d + r) * VT_PITCH + (16 * s4 + 4 * hh) * 2;
                const v2u lo = *(const LAS v2u*)vp, hi = *(const LAS v2u*)(vp + 16); v4u w; w.x = lo.x; w.y = lo.y; w.z = hi.x; w.w = hi.y;
                O[d] = __builtin_amdgcn_mfma_f32_32x32x16_bf16(__builtin_bit_cast(bf16x8, w), Pf[s4], O[d], 0, 0, 0); }
    }
    bf16* orow = WSP(bf16, WS_OBR) + (size_t)2 * MP * 512 + (size_t)(b * SEQ + qpos) * 512 + h * 128 + 4 * hh;
#pragma unroll
    for (int d = 0; d < 4; ++d)
#pragma unroll
        for (int g = 0; g < 4; ++g) { v2u w; w.x = pk2(O[d][4 * g], O[d][4 * g + 1]); w.y = pk2(O[d][4 * g + 2], O[d][4 * g + 3]); *(v2u*)(orow + 32 * d + 8 * g) = w; }
}

__device__ __forceinline__ void attn_sample_unit(CA A, LAS unsigned char* lds, int layer, int unit, const int wv) {
    const int tid = tid_opaque(wv), lane = tid & 63, wid = tid >> 6, sb = unit >> 5, pg4 = unit & 31, hd = lane >> 4;
    const int lp = 4 * pg4 + (wid >> 1), phys = ((const int*)A->in[I_PT])[sb * NPAGES + lp];
    const size_t pbase = ((size_t)(layer * NPOOL + phys) * PAGE + (wid & 1) * 64) * 512 + lane * 8;
    const float* Kc = IN_F(I_CK) + pbase; const float* Vc = IN_F(I_CV) + pbase;
    const bf16* QKV = WSP(bf16, WS_QKV);
    float qf[4][8], O[4][8], R[4];
#pragma unroll
    for (int i = 0; i < 4; ++i) { const v4u w = *(const v4u*)(QKV + (size_t)(TP + sb * 4 + i) * 1536 + lane * 8);
        qf[i][0] = bflo(w.x); qf[i][1] = bfhi(w.x); qf[i][2] = bflo(w.y); qf[i][3] = bfhi(w.y); qf[i][4] = bflo(w.z); qf[i][5] = bfhi(w.z); qf[i][6] = bflo(w.w); qf[i][7] = bfhi(w.w);
        R[i] = 0.f;
#pragma unroll
        for (int j = 0; j < 8; ++j) O[i][j] = 0.f; }
    const float bias2 = IN_F(I_SBBIAS)[layer * 4 + hd] * LOG2E;
#pragma unroll 4
    for (int t = 63; t >= 0; --t) {
        const f32x4 k0 = *(const f32x4*)(Kc + (size_t)t * 512), k1 = *(const f32x4*)(Kc + (size_t)t * 512 + 4), v0 = *(const f32x4*)(Vc + (size_t)t * 512), v1 = *(const f32x4*)(Vc + (size_t)t * 512 + 4);
#pragma unroll
        for (int i = 0; i < 4; ++i) {
            float s = (qf[i][0] * k0[0] + qf[i][1] * k0[1]) + (qf[i][2] * k0[2] + qf[i][3] * k0[3]) + (qf[i][4] * k1[0] + qf[i][5] * k1[1]) + (qf[i][6] * k1[2] + qf[i][7] * k1[3]);
            s += __shfl_xor(s, 1); s += __shfl_xor(s, 2); s += __shfl_xor(s, 4); s += __shfl_xor(s, 8);
            const float z = fminf(s + bias2, 60.f), s1 = lg2(1.0f + ex2(z)), pv = ex2(z - s1 - R[i]); R[i] += s1;
#pragma unroll
            for (int e = 0; e < 4; ++e) { O[i][e] += pv * v0[e]; O[i][4 + e] += pv * v1[e]; } }
    }
    LAS float* Ow = (LAS float*)lds;
    LAS float* Rw = Ow + 8 * 4 * 512;
    __syncthreads();
#pragma unroll
    for (int i = 0; i < 4; ++i) { *(LAS f32x4*)(Ow + (wid * 4 + i) * 512 + lane * 8) = (f32x4){O[i][0], O[i][1], O[i][2], O[i][3]}; *(LAS f32x4*)(Ow + (wid * 4 + i) * 512 + lane * 8 + 4) = (f32x4){O[i][4], O[i][5], O[i][6], O[i][7]};
        if ((lane & 15) == 0) Rw[(wid * 4 + i) * 4 + hd] = R[i]; }
    __syncthreads();
    float* PART = WSP(float, WS_PART) + (size_t)unit * 2048; float* PR = WSP(float, WS_PR) + (size_t)unit * 16;
    for (int idx = tid; idx < 2048; idx += NTHR) { const int i = idx >> 9, c = idx & 511, hc = c >> 7; float acc = 0.f, racc = 0.f;
#pragma unroll
        for (int w = 7; w >= 0; --w) { acc += ex2(-racc) * Ow[(w * 4 + i) * 512 + c]; racc += Rw[(w * 4 + i) * 4 + hc]; }
        PART[idx] = acc; if ((c & 127) == 0) PR[i * 4 + hc] = racc; }
}
__device__ __forceinline__ void attn_sample_combine(CA A, int layer, const int wv) {
    const int tid = tid_opaque(wv), lane = tid & 63, gw = blk_opaque() * NWAVES + (tid >> 6), NGW = gridDim.x * NWAVES;
    const bf16* QKV = WSP(bf16, WS_QKV); const float* PART = WSP(float, WS_PART); const float* PR = WSP(float, WS_PR);
    const float* kn = A->out + O_KS + (size_t)layer * TS * 512; const float* vn = A->out + O_VS + (size_t)layer * TS * 512;
    bf16* O2 = WSP(bf16, WS_OBR) + (size_t)2 * MP * 512;
    for (int it = gw; it < TS * 4; it += NGW) { const int sb = it >> 4, i = (it >> 2) & 3, hd = it & 3, row = TP + sb * 4 + i, c = hd * 128 + 2 * lane;
        const unsigned qw = *(const unsigned*)(QKV + (size_t)row * 1536 + c); const float q0 = bflo(qw), q1 = bfhi(qw);
        const float bias2 = IN_F(I_SBBIAS)[layer * 4 + hd] * LOG2E; float o0 = 0.f, o1 = 0.f, racc = 0.f;
        for (int j = i - 1; j >= 0; --j) { const float* kr = kn + (size_t)(sb * 4 + j) * 512 + c; const float* vr = vn + (size_t)(sb * 4 + j) * 512 + c;
            const float z = fminf(wave_sum(q0 * kr[0] + q1 * kr[1]) + bias2, 60.f), s1 = lg2(1.0f + ex2(z)), pv = ex2(z - s1 - racc); racc += s1; o0 += pv * vr[0]; o1 += pv * vr[1]; }
        for (int u = 31; u >= 0; --u) { const float* pr = PART + ((size_t)(sb * 32 + u) * 4 + i) * 512 + c; const float sc = ex2(-racc); o0 += sc * pr[0]; o1 += sc * pr[1]; racc += PR[(size_t)(sb * 32 + u) * 16 + i * 4 + hd]; }
        *(unsigned*)(O2 + (size_t)row * 512 + c) = pk2(o0, o1); }
}

#ifndef MK_ONE_LAUNCH
#define MK_ONE_LAUNCH 1
#endif
constexpr int N_PHASES = 22;
__device__ __forceinline__ int queue_pop(unsigned* head, volatile LAS unsigned* slot, const int wv) {
    __syncthreads();
    if (tid_opaque(wv) == 0) *slot = __hip_atomic_fetch_add(head, 1u, __ATOMIC_RELAXED, __HIP_MEMORY_SCOPE_AGENT);
    __syncthreads();
    return (int)*slot;
}
__global__ void __launch_bounds__(NTHR, 2) mega(Args Araw) {
    extern __shared__ __attribute__((aligned(16))) unsigned char lds_raw[];
    LAS unsigned char* lds = (LAS unsigned char*)lds_raw;
    volatile LAS unsigned* MISC = (volatile LAS unsigned*)(lds + MISC_OFF);
    const int wv = __builtin_amdgcn_readfirstlane(threadIdx.x >> 6); const int tid = tid_opaque(wv), G = gridDim.x, blk = blk_opaque();
    if (tid < 16) MISC[tid] = 0u;
    __syncthreads();
    unsigned* ctl = (unsigned*)(Araw.ws + WS_CTL);
    XcdBarrier bar = xcd_barrier_post(ctl + CW_BAR + Araw.li * XCD_BAR_WORDS, MISC, tid);
    const int lo = Araw.ph_lo, hi = Araw.ph_hi;
#define IN(gp) (lo <= (gp) && (gp) < hi)
#define SEAM(gp) do { if (lo <= (gp) && (gp) + 1 < hi) xcd_barrier(bar, tid_opaque(wv)); } while (0)

    if (IN(0)) { CA A = args_opaque(); p0_prologue(A, lds, wv); }
    SEAM(0);
    if (IN(1)) { CA A = args_opaque(); norm1_phase(A, wv); }
    SEAM(1);
    for (int layer = 0; layer < DEPTH; ++layer) {
        const int gb = layer == 0 ? 1 : 11;
        if (IN(gb + 1)) { CA A = args_opaque();
            pg8::Gemm g{WSP(bf16, WS_H), WSP(bf16, WS_WIN) + (size_t)layer * NIN * DM, MP, NIN, DM}; pg8::StaticOrder S; S.init(MP, NIN, G, blk);
            EpiIn E{WSP(float, WS_UF), WSP(bf16, WS_QKV), WSP(bf16, WS_GATE), A->out + O_KP + (size_t)layer * TP * 512, A->out + O_VP + (size_t)layer * TP * 512,
                    A->out + O_KS + (size_t)layer * TS * 512, A->out + O_VS + (size_t)layer * TS * 512, 0.08838834764831845f * LOG2E};
            pg8::gemm_phase<EpiIn, pg8::StaticOrder, true, true>(lds, g, S, E, wv);
        }
        SEAM(gb + 1);
        if (IN(gb + 2)) { CA A = args_opaque(); prep_phase(A, layer, wv); }
        SEAM(gb + 2);
        if (IN(gb + 3)) { CA A = args_opaque();
            for (int t = blk; t < 48; t += G) dn_seq(A, lds, layer, t, wv);
            for (int t = blk; t < 240; t += G) if (t >= 48) ssd_seq(A, lds, layer, t - 48, wv);
            { unsigned* qh = ctl + CW_QUEUE + 64 * (layer * 4 + 0);
              for (;;) { const int u = queue_pop(qh, MISC + 4, wv); if (u >= 128) break; attn_prompt_unit(A, lds, layer, u, wv); } }
            { unsigned* qh = ctl + CW_QUEUE + 64 * (layer * 4 + 1);
              for (;;) { const int u = queue_pop(qh, MISC + 4, wv); if (u >= 256) break; attn_sample_unit(A, lds, layer, u, wv); } }
        }
        SEAM(gb + 3);
        if (IN(gb + 4)) { CA A = args_opaque(); attn_sample_combine(A, layer, wv); }
        SEAM(gb + 4);
        if (IN(gb + 5)) { CA A = args_opaque();
            pg8::StaticOrder S; S.init(MP, DM, G, blk);
            const bf16* Wb = WSP(bf16, WS_WBR) + (size_t)layer * 5 * DM * 512; const bf16* Ob = WSP(bf16, WS_OBR);
            const bf16* GT = WSP(bf16, WS_GATE); const float* SQ = WSP(float, WS_SSQ); float* MG = WSP(float, WS_MG32); bf16* MB = WSP(bf16, WS_MGB);
            { pg8::Gemm g{Ob + (size_t)0 * MP * 512, Wb + (size_t)0 * DM * 512, MP, DM, 512}; EpiMerge<0> E{GT, SQ, MG, MB}; pg8::gemm_phase<EpiMerge<0>, pg8::StaticOrder, true, true>(lds, g, S, E, wv); }
            { pg8::Gemm g{Ob + (size_t)1 * MP * 512, Wb + (size_t)1 * DM * 512, MP, DM, 512}; EpiMerge<1> E{GT, SQ, MG, MB}; pg8::gemm_phase<EpiMerge<1>, pg8::StaticOrder, true, true>(lds, g, S, E, wv); }
            { pg8::Gemm g{Ob + (size_t)2 * MP * 512, Wb + (size_t)2 * DM * 512, MP, DM, 512}; EpiMerge<2> E{GT, SQ, MG, MB}; pg8::gemm_phase<EpiMerge<2>, pg8::StaticOrder, true, true>(lds, g, S, E, wv); }
            { pg8::Gemm g{Ob + (size_t)3 * MP * 512, Wb + (size_t)3 * DM * 512, MP, DM, 512}; EpiMerge<3> E{GT, SQ, MG, MB}; pg8::gemm_phase<EpiMerge<3>, pg8::StaticOrder, true, true>(lds, g, S, E, wv); }
            { pg8::Gemm g{Ob + (size_t)4 * MP * 512, Wb + (size_t)4 * DM * 512, MP, DM, 512}; EpiMerge<4> E{GT, SQ, MG, MB}; pg8::gemm_phase<EpiMerge<4>, pg8::StaticOrder, true, true>(lds, g, S, E, wv); }
        }
        SEAM(gb + 5);
        if (IN(gb + 6)) { CA A = args_opaque();
            pg8::Gemm g{WSP(bf16, WS_MGB), WSP(bf16, WS_WOUT) + (size_t)layer * DM * DM, MP, DM, DM}; pg8::StaticOrder S; S.init(MP, DM, G, blk);
            EpiF32 E{WSP(float, WS_MIX), DM}; pg8::gemm_phase<EpiF32, pg8::StaticOrder, true, true>(lds, g, S, E, wv);
        }
        SEAM(gb + 6);
        if (IN(gb + 7)) { CA A = args_opaque(); resid_phase(A, WSP(float, WS_MIX), IN_F(I_NMPOST) + layer * DM, IN_F(I_NLPRE) + layer * DM, layer == 0, wv); }
        SEAM(gb + 7);
        if (IN(gb + 8)) { CA A = args_opaque();
            pg8::Gemm g{WSP(bf16, WS_H), WSP(bf16, WS_WUP) + (size_t)layer * DFF * DM, MP, DFF, DM}; pg8::StaticOrder S; S.init(MP, DFF, G, blk);
            EpiRelu2 E{WSP(bf16, WS_F), DFF}; pg8::gemm_phase<EpiRelu2, pg8::StaticOrder, true, true>(lds, g, S, E, wv);
        }
        SEAM(gb + 8);
        if (IN(gb + 9)) { CA A = args_opaque();
            pg8::Gemm g{WSP(bf16, WS_F), WSP(bf16, WS_WDN) + (size_t)layer * DM * DFF, MP, DM, DFF}; pg8::StaticOrder S; S.init(MP, DM, G, blk);
            EpiF32 E{WSP(float, WS_FD), DM}; pg8::gemm_phase<EpiF32, pg8::StaticOrder, true, true>(lds, g, S, E, wv);
        }
        SEAM(gb + 9);
        if (IN(gb + 10)) { CA A = args_opaque(); resid_phase(A, WSP(float, WS_FD), IN_F(I_NLPOST) + layer * DM, layer + 1 < DEPTH ? IN_F(I_NMPRE) + (layer + 1) * DM : nullptr, false, wv); }
        SEAM(gb + 10);
    }
#undef IN
#undef SEAM
}

extern "C" void kernel_launch(void* const* d_in, const int* in_sizes, int n_in, void* d_out, int out_size, void* d_ws, size_t ws_size, hipStream_t stream) {
    static int grid = 0;
    if (grid == 0) {
        if (n_in != N_IN || (size_t)out_size != O_END || ws_size < WS_END) { fprintf(stderr, "kernel_launch: unexpected problem (n_in %d, out %d vs %zu, ws %zu vs %zu); nothing launched\n", n_in, out_size, (size_t)O_END, ws_size, (size_t)WS_END); grid = -1; return; }
        int dev = 0, cus = 0, per_cu = 0;
        if (hipGetDevice(&dev) != hipSuccess || hipDeviceGetAttribute(&cus, hipDeviceAttributeMultiprocessorCount, dev) != hipSuccess) { grid = -1; return; }
        if (hipFuncSetAttribute((const void*)mega, hipFuncAttributeMaxDynamicSharedMemorySize, LDS_BYTES) != hipSuccess) { fprintf(stderr, "kernel_launch: hipFuncSetAttribute failed\n"); grid = -1; return; }
        if (hipOccupancyMaxActiveBlocksPerMultiprocessor(&per_cu, (const void*)mega, NTHR, LDS_BYTES) != hipSuccess || per_cu < 1) fprintf(stderr, "kernel_launch: occupancy query says %d blocks per CU\n", per_cu);
        (void)hipGetLastError();
        grid = cus;
    }
    if (grid < 0) return;
    (void)in_sizes;
    hipMemsetAsync((char*)d_ws + WS_CTL, 0, CTL_BYTES, stream);
    Args a{};
    for (int i = 0; i < N_IN; ++i) a.in[i] = d_in[i];
    a.out = (float*)d_out; a.ws = (unsigned char*)d_ws; a.pad = 0;
#if MK_ONE_LAUNCH
    a.ph_lo = 0; a.ph_hi = N_PHASES; a.li = 0;
    hipLaunchKernelGGL(mega, dim3(grid), dim3(NTHR), LDS_BYTES, stream, a);
#else
    for (int gp = 0; gp < N_PHASES; ++gp) { a.ph_lo = gp; a.ph_hi = gp + 1; a.li = 0; hipLaunchKernelGGL(mega, dim3(grid), dim3(NTHR), LDS_BYTES, stream, a); }
#endif
}
```

```cpp
#include <hip/hip_runtime.h>
#include <cstdio>
#include <cstdint>
__device__ __forceinline__ int lane_opaque() { unsigned m = ~0u; asm volatile("" : "+s"(m)); return (int)__builtin_amdgcn_mbcnt_hi(m, __builtin_amdgcn_mbcnt_lo(m, 0u)); }
__device__ __forceinline__ int tid_opaque(int wv) { return wv * 64 + lane_opaque(); }
__device__ __forceinline__ int blk_opaque() { int t = blockIdx.x; asm volatile("" : "+s"(t)); return t; }
namespace pg8 {
#define PG8_LAS __attribute__((address_space(3)))
typedef unsigned short bf16_t;
typedef short bf16x8 __attribute__((ext_vector_type(8)));
typedef float f32x4 __attribute__((ext_vector_type(4)));
typedef unsigned u32x4 __attribute__((ext_vector_type(4)));
constexpr int BM = 256, BK = 64, HALF = 128, HTB = HALF * BK * 2  , STAGE_BYTES = 8 * HTB, NXCD = 8, WGM = 8;

__host__ __device__ __forceinline__ int lds_byte(int r, int c) { const int st = (r >> 4) * 2 + (c >> 5), rr = r & 15, cc = c & 31, ob = rr * 64 + cc * 2; return st * 1024 + (ob ^ (((ob >> 9) & 1) << 5)); }
__host__ __device__ __forceinline__ void stage_rc(int b, int& R, int& C) { const int st = b / 1024, sb = b % 1024, swz = sb ^ (((sb >> 9) & 1) << 5); R = (st >> 1) * 16 + swz / 64; C = (st & 1) * 32 + (swz % 64) / 2; }
__host__ __device__ __forceinline__ int perm32(int rho) { const int n = rho >> 4, i = rho & 15; return 8 * (i >> 2) + 4 * n + (i & 3); }

struct Unit { int pm, pn; };
struct Gemm { const bf16_t* A; const bf16_t* Bt; int M, N, K; };

struct StaticOrder {
    int nM, nN, nwg, G, c;
    __host__ __device__ void init(int M, int N, int G_, int c_) { nM = M / BM; nN = N / BM; nwg = nM * nN; G = G_; c = c_; }
    __host__ __device__ bool next(int i, Unit& u) const {
        const long L = (long)i * G + c; if (L >= nwg) return false;
        int wgid = (int)L; { const int q = nwg / NXCD, r = nwg % NXCD, xcd = wgid % NXCD, off = wgid / NXCD; wgid = (xcd < r ? xcd * (q + 1) : r * (q + 1) + (xcd - r) * q) + off; }
        const int nig = WGM * nN, gid = wgid / nig, fm = gid * WGM, gsz = (nM - fm) < WGM ? (nM - fm) : WGM;
        u.pm = fm + ((wgid % nig) % gsz); u.pn = (wgid % nig) / gsz; return true;
    }
    __device__ __forceinline__ void a_ready(const Unit&) const {}
    __device__ __forceinline__ void done(const Unit&) const {}
};
__device__ __forceinline__ unsigned cvt_pk_bf16(float lo, float hi) { unsigned r; asm volatile("v_cvt_pk_bf16_f32 %0, %1, %2" : "=v"(r) : "v"(lo), "v"(hi)); return r; }
typedef float f32x2 __attribute__((ext_vector_type(2)));
template <class Epi, class Sched, bool ALIGN_EPI = false, bool SP2 = false>
__device__ __forceinline__ void gemm_phase(PG8_LAS unsigned char* lds, const Gemm g, const Sched& S, const Epi& E, const int wv) {
    const int lane = lane_opaque(), tid = wv * 64 + lane, wid = wv, wr = wid >> 2, wc = wid & 3, fr = lane & 15, fq = lane >> 4;
    const int K = g.K, nt = K / BK;
    unsigned voffA[2], voffB[2];
#pragma unroll
    for (int i = 0; i < 2; ++i) { int R, C; stage_rc(tid * 16 + i * 8192, R, C); const int Rb = Epi::PERM ? ((R & ~31) + perm32(R & 31)) : R;
        voffA[i] = (unsigned)(R * K + C) * 2u; voffB[i] = (unsigned)(Rb * K + C) * 2u; }
    const size_t kstep = (size_t)(BK * 2);
    const size_t hstep = (size_t)HALF * K * 2;
    const size_t tstep = 2 * hstep;
    const unsigned ldsw = (unsigned)wid * 1024u;
    const int aoff = lds_byte(wr * 64 + fr, fq * 8), boff = lds_byte(wc * 32 + fr, fq * 8);
#define PG8_SA(b, h) (((b) * 2 + (h)) * HTB)
#define PG8_SB(b, h) ((4 + (b) * 2 + (h)) * HTB)
#define PG8_STAGE(bufoff, gbase, voff) do { _Pragma("unroll") for (int _i = 0; _i < 2; ++_i) \
        __builtin_amdgcn_global_load_lds((const unsigned*)((const char*)(gbase) + (voff)[_i]), (PG8_LAS unsigned*)(lds + (bufoff) + ldsw + _i * 8192), 16, 0, 0); } while (0)
#define PG8_LDA(dst, b, h) do { _Pragma("unroll") for (int m = 0; m < 4; ++m) _Pragma("unroll") for (int k = 0; k < 2; ++k) dst[m][k] = *(const PG8_LAS bf16x8*)(lds + PG8_SA(b, h) + aoff + m * 2048 + k * 1024); } while (0)
#define PG8_LDB(dst, b, h) do { _Pragma("unroll") for (int n = 0; n < 2; ++n) _Pragma("unroll") for (int k = 0; k < 2; ++k) dst[n][k] = *(const PG8_LAS bf16x8*)(lds + PG8_SB(b, h) + boff + n * 2048 + k * 1024); } while (0)
#define PG8_MMA(ai, bj, At, Bt) do { __builtin_amdgcn_s_setprio(1); _Pragma("unroll") for (int m = 0; m < 4; ++m) _Pragma("unroll") for (int n = 0; n < 2; ++n) _Pragma("unroll") for (int k = 0; k < 2; ++k) \
        acc[ai][bj][m][n] = __builtin_amdgcn_mfma_f32_16x16x32_bf16(Bt[n][k], At[m][k], acc[ai][bj][m][n], 0, 0, 0); __builtin_amdgcn_s_setprio(0); } while (0)
#define PG8_WAIT_V(n) asm volatile("s_waitcnt vmcnt(" #n ")" ::: "memory")
#define PG8_WAIT_L(n) asm volatile("s_waitcnt lgkmcnt(" #n ")" ::: "memory")
#define PG8_BAR __builtin_amdgcn_s_barrier()
#define PG8_SCHED __builtin_amdgcn_sched_barrier(0)
    Unit cur, nxt; int ui = 0;
    if (!S.next(0, cur)) return;
    f32x4 acc[2][2][4][2];
#pragma unroll
    for (int a = 0; a < 2; ++a)
#pragma unroll
        for (int b = 0; b < 2; ++b)
#pragma unroll
            for (int m = 0; m < 4; ++m)
#pragma unroll
                for (int n = 0; n < 2; ++n) acc[a][b][m][n] = (f32x4){0.f, 0.f, 0.f, 0.f};
    bf16x8 At[4][2], B0[2][2], B1[2][2];
    const char* cA = (const char*)g.A + (size_t)cur.pm * tstep; const char* cB = (const char*)g.Bt + (size_t)cur.pn * tstep;
    S.a_ready(cur);
    if constexpr (SP2) {
        PG8_STAGE(PG8_SB(0, 0), cB, voffB); PG8_STAGE(PG8_SB(0, 1), cB + hstep, voffB); PG8_STAGE(PG8_SA(0, 0), cA, voffA); PG8_STAGE(PG8_SA(0, 1), cA + hstep, voffA);
        if (wr == 1) PG8_BAR;
        PG8_WAIT_V(2); PG8_BAR;
        PG8_STAGE(PG8_SB(1, 0), cB + kstep, voffB); PG8_STAGE(PG8_SA(1, 0), cA + kstep, voffA); PG8_STAGE(PG8_SB(1, 1), cB + hstep + kstep, voffB);
        PG8_WAIT_V(6); PG8_BAR;
    } else {
        PG8_STAGE(PG8_SB(0, 0), cB, voffB); PG8_STAGE(PG8_SA(0, 0), cA, voffA); PG8_STAGE(PG8_SB(0, 1), cB + hstep, voffB); PG8_STAGE(PG8_SA(0, 1), cA + hstep, voffA);
        if (wr == 1) PG8_BAR;
        PG8_WAIT_V(4); PG8_BAR;
        PG8_STAGE(PG8_SB(1, 0), cB + kstep, voffB); PG8_STAGE(PG8_SA(1, 0), cA + kstep, voffA); PG8_STAGE(PG8_SB(1, 1), cB + hstep + kstep, voffB);
        PG8_WAIT_V(6); PG8_BAR;
    }
    for (;;) {
        const bool has_next = S.next(ui + 1, nxt);
        const char* nA = has_next ? (const char*)g.A + (size_t)nxt.pm * tstep : cA; const char* nB = has_next ? (const char*)g.Bt + (size_t)nxt.pn * tstep : cB;
        for (int t = 0; t < nt; t += 2) {
            const bool last = (t == nt - 2);
            const char* a1 = cA + (size_t)(t + 1) * kstep;
            const char* a2 = last ? nA : cA + (size_t)(t + 2) * kstep; const char* b2 = last ? nB : cB + (size_t)(t + 2) * kstep;
            const char* a3 = a2 + kstep; const char* b3 = b2 + kstep;
            if (last && has_next) S.a_ready(nxt);
            if constexpr (SP2) {
            PG8_LDB(B0, 0, 0); PG8_LDB(B1, 0, 1); PG8_SCHED; PG8_LDA(At, 0, 0); PG8_STAGE(PG8_SA(1, 1), a1 + hstep, voffA);
            PG8_WAIT_V(8); PG8_WAIT_L(0); PG8_BAR; PG8_MMA(0, 0, At, B0); PG8_MMA(0, 1, At, B1); PG8_BAR; PG8_SCHED;
            PG8_LDA(At, 0, 1); PG8_STAGE(PG8_SB(0, 0), b2, voffB); PG8_STAGE(PG8_SB(0, 1), b2 + hstep, voffB); PG8_STAGE(PG8_SA(0, 0), a2, voffA);
            PG8_WAIT_V(8); PG8_WAIT_L(0); PG8_BAR; PG8_MMA(1, 0, At, B0); PG8_MMA(1, 1, At, B1); PG8_BAR; PG8_SCHED;
            PG8_LDB(B0, 1, 0); PG8_LDB(B1, 1, 1); PG8_SCHED; PG8_LDA(At, 1, 0); PG8_STAGE(PG8_SA(0, 1), a2 + hstep, voffA);
            PG8_WAIT_V(8); PG8_WAIT_L(0); PG8_BAR; PG8_MMA(0, 0, At, B0); PG8_MMA(0, 1, At, B1); PG8_BAR; PG8_SCHED;
            PG8_LDA(At, 1, 1); PG8_STAGE(PG8_SB(1, 0), b3, voffB); PG8_STAGE(PG8_SB(1, 1), b3 + hstep, voffB); PG8_STAGE(PG8_SA(1, 0), a3, voffA);
            PG8_WAIT_V(8); PG8_WAIT_L(0); PG8_BAR; PG8_MMA(1, 0, At, B0); PG8_MMA(1, 1, At, B1); PG8_BAR; PG8_SCHED;
            } else {
            PG8_LDB(B0, 0, 0); PG8_SCHED; PG8_LDA(At, 0, 0); PG8_STAGE(PG8_SA(1, 1), a1 + hstep, voffA);
            PG8_WAIT_L(8); PG8_BAR; PG8_WAIT_L(0); PG8_MMA(0, 0, At, B0); PG8_BAR; PG8_SCHED;
            PG8_LDB(B1, 0, 1); PG8_STAGE(PG8_SB(0, 0), b2, voffB);
            PG8_BAR; PG8_WAIT_L(0); PG8_MMA(0, 1, At, B1); PG8_BAR;
            PG8_LDA(At, 0, 1); PG8_STAGE(PG8_SA(0, 0), a2, voffA);
            PG8_BAR; PG8_WAIT_L(0); PG8_MMA(1, 0, At, B0); PG8_BAR; PG8_SCHED;
            PG8_STAGE(PG8_SB(0, 1), b2 + hstep, voffB);
            PG8_WAIT_V(6); PG8_BAR; PG8_MMA(1, 1, At, B1); PG8_BAR;
            PG8_LDB(B0, 1, 0); PG8_SCHED; PG8_LDA(At, 1, 0); PG8_STAGE(PG8_SA(0, 1), a2 + hstep, voffA);
            PG8_WAIT_L(8); PG8_BAR; PG8_WAIT_L(0); PG8_MMA(0, 0, At, B0); PG8_BAR; PG8_SCHED;
            PG8_LDB(B1, 1, 1); PG8_STAGE(PG8_SB(1, 0), b3, voffB);
            PG8_BAR; PG8_WAIT_L(0); PG8_MMA(0, 1, At, B1); PG8_BAR;
            PG8_LDA(At, 1, 1); PG8_STAGE(PG8_SA(1, 0), a3, voffA);
            PG8_BAR; PG8_WAIT_L(0); PG8_MMA(1, 0, At, B0); PG8_BAR; PG8_SCHED;
            PG8_STAGE(PG8_SB(1, 1), b3 + hstep, voffB);
            PG8_WAIT_V(6); PG8_BAR; PG8_MMA(1, 1, At, B1); PG8_BAR;
            }
        }
        if constexpr (ALIGN_EPI) { if (wr == 0) PG8_BAR; }
        if constexpr (!Epi::AFTER_DRAIN) { E(acc, cur, wr, wc, fr, fq); S.done(cur); }
        if (!has_next) break;
#pragma unroll
        for (int a = 0; a < 2; ++a)
#pragma unroll
            for (int b = 0; b < 2; ++b)
#pragma unroll
                for (int m = 0; m < 4; ++m)
#pragma unroll
                    for (int n = 0; n < 2; ++n) acc[a][b][m][n] = (f32x4){0.f, 0.f, 0.f, 0.f};
        cur = nxt; cA = nA; cB = nB; ++ui;
        if constexpr (ALIGN_EPI) { if (wr == 1) PG8_BAR; }
    }
    PG8_WAIT_V(0);
    if constexpr (!ALIGN_EPI) { if (wr == 0) PG8_BAR; }
    PG8_BAR;
    if constexpr (Epi::AFTER_DRAIN) { E.fused(acc, cur, wr, wc, fr, fq, lds, wid, lane); S.done(cur); }
#undef PG8_SA
#undef PG8_SB
#undef PG8_STAGE
#undef PG8_LDA
#undef PG8_LDB
#undef PG8_MMA
#undef PG8_WAIT_V
#undef PG8_WAIT_L
#undef PG8_BAR
#undef PG8_SCHED
}
}

constexpr int DM = 2048, NBATCH = 4, SEQ = 2048, DEPTH = 2, DBATCH = 8, DSEQ = 4, PAST = 16384, PAGE = 128;
constexpr int TP = NBATCH * SEQ;
constexpr int TS = DBATCH * DSEQ;
constexpr int TT = TP + TS;
constexpr int MP = 8448;
constexpr int NPAGES = PAST / PAGE;
constexpr int NPOOL = 1280;
constexpr int POOLW = 512, DNC = 1536, SBW = 512, SSI = 1024, SSC = 1536, DFF = 8192;
constexpr int INCOLS = 14872, NIN = 15104;
constexpr int UFW = 5376;
constexpr int UF_POOL = 0, UF_DNQKV = 512, UF_DNZ = 2048, UF_SSZ = 2560, UF_XBC = 3584, UF_SMALL = 5120;
constexpr float RMS_EPS = 1e-6f;
constexpr float LOG2E = 1.4426950408889634f;
constexpr int NWAVES = 8, NTHR = 512;

constexpr size_t O_Y = 0;
constexpr size_t O_KP = O_Y + (size_t)TT * DM;
constexpr size_t O_VP = O_KP + (size_t)DEPTH * TP * 512;
constexpr size_t O_POOLP = O_VP + (size_t)DEPTH * TP * 512;
constexpr size_t O_DNCP = O_POOLP + (size_t)DEPTH * NBATCH * 15 * 512;
constexpr size_t O_DNSP = O_DNCP + (size_t)DEPTH * NBATCH * 3 * 1536;
constexpr size_t O_SSCP = O_DNSP + (size_t)DEPTH * NBATCH * 4 * 128 * 128;
constexpr size_t O_SSHP = O_SSCP + (size_t)DEPTH * NBATCH * 3 * 1536;
constexpr size_t O_KS = O_SSHP + (size_t)DEPTH * NBATCH * 16 * 64 * 128;
constexpr size_t O_VS = O_KS + (size_t)DEPTH * TS * 512;
constexpr size_t O_POOLS = O_VS + (size_t)DEPTH * TS * 512;
constexpr size_t O_DNCS = O_POOLS + (size_t)DEPTH * DBATCH * 15 * 512;
constexpr size_t O_DNSS = O_DNCS + (size_t)DEPTH * DBATCH * 3 * 1536;
constexpr size_t O_SSCS = O_DNSS + (size_t)DEPTH * DBATCH * 4 * 128 * 128;
constexpr size_t O_SSHS = O_SSCS + (size_t)DEPTH * DBATCH * 3 * 1536;
constexpr size_t O_END = O_SSHS + (size_t)DEPTH * DBATCH * 16 * 64 * 128;

constexpr size_t al256(size_t x) { return (x + 255) & ~(size_t)255; }
constexpr size_t WS_CTL = 0, CTL_BYTES = 1u << 20;
constexpr size_t SZ_WIN = (size_t)NIN * DM * 2, SZ_WBR = (size_t)5 * DM * 512 * 2, SZ_WOUT = (size_t)DM * DM * 2, SZ_WUP = (size_t)DFF * DM * 2, SZ_WDN = (size_t)DM * DFF * 2;
constexpr size_t WS_WIN = WS_CTL + CTL_BYTES;
constexpr size_t WS_WBR = WS_WIN + 2 * SZ_WIN;
constexpr size_t WS_WOUT = WS_WBR + 2 * SZ_WBR;
constexpr size_t WS_WUP = WS_WOUT + 2 * SZ_WOUT;
constexpr size_t WS_WDN = WS_WUP + 2 * SZ_WUP;
constexpr size_t WS_H = WS_WDN + 2 * SZ_WDN;
constexpr size_t WS_UF = WS_H + (size_t)MP * DM * 2;
constexpr size_t WS_QKV = WS_UF + (size_t)MP * UFW * 4;
constexpr size_t WS_GATE = WS_QKV + (size_t)MP * 1536 * 2;
constexpr size_t WS_DNQ = WS_GATE + (size_t)MP * 8192 * 2;
constexpr size_t WS_XBC = WS_DNQ + (size_t)MP * 1536 * 4;
constexpr size_t WS_SCAL = WS_XBC + (size_t)MP * 1536 * 4;
constexpr size_t WS_OBR = WS_SCAL + (size_t)MP * 32 * 4;
constexpr size_t SZ_OBR = (size_t)MP * 512 * 2;
constexpr size_t WS_SSQ = WS_OBR + 5 * SZ_OBR;
constexpr size_t WS_MG32 = WS_SSQ + (size_t)MP * 16 * 4;
constexpr size_t WS_MGB = WS_MG32 + (size_t)MP * DM * 4;
constexpr size_t WS_MIX = WS_MGB + (size_t)MP * DM * 2;
constexpr size_t WS_F = WS_MIX + (size_t)MP * DM * 4;
constexpr size_t WS_FD = WS_F + (size_t)MP * DFF * 2;
constexpr size_t WS_PART = WS_FD + (size_t)MP * DM * 4;
constexpr size_t WS_PR = WS_PART + (size_t)256 * 2048 * 4;
constexpr size_t WS_DNU = WS_PR + (size_t)256 * 16 * 4;
constexpr size_t WS_SSU = WS_DNU + (size_t)512 * 90368;
constexpr size_t WS_SSG = WS_SSU + (size_t)2048 * 16896;
constexpr size_t WS_END = WS_SSG + (size_t)256 * 49152;
static_assert(WS_WIN % 256 == 0 && WS_H % 256 == 0 && WS_UF % 256 == 0 && WS_OBR % 256 == 0 && WS_MG32 % 256 == 0 && WS_PART % 256 == 0, "ws alignment");

constexpr int CW_QUEUE = 64;
constexpr int CW_BAR = 4096;

constexpr int LDS_BYTES = 147456;
constexpr int RING_BYTES = 131072;
constexpr int MISC_OFF = RING_BYTES;

#define GAS __attribute__((address_space(1)))
#define LAS __attribute__((address_space(3)))
typedef unsigned short bf16;
typedef unsigned v4u __attribute__((ext_vector_type(4)));
typedef unsigned v2u __attribute__((ext_vector_type(2)));
typedef float f32x4 __attribute__((ext_vector_type(4)));
typedef float f32x2 __attribute__((ext_vector_type(2)));
typedef float f32x16 __attribute__((ext_vector_type(16)));
typedef short bf16x8 __attribute__((ext_vector_type(8)));
__device__ __forceinline__ unsigned f2bf(float f) { unsigned u = __builtin_bit_cast(unsigned, f); return (u + 0x7fffu + ((u >> 16) & 1u)) >> 16; }
__device__ __forceinline__ unsigned pk2(float lo, float hi) { return f2bf(lo) | (f2bf(hi) << 16); }
__device__ __forceinline__ float bflo(unsigned w) { return __builtin_bit_cast(float, w << 16); }
__device__ __forceinline__ float bfhi(unsigned w) { return __builtin_bit_cast(float, w & 0xffff0000u); }
__device__ __forceinline__ float wave_sum(float v) {
#pragma unroll
    for (int o = 1; o < 64; o <<= 1) v += __shfl_xor(v, o);
    return v;
}
__device__ __forceinline__ float sigmoidf_(float x) { return 1.0f / (1.0f + __expf(-x)); }
__device__ __forceinline__ float siluf_(float x) { return x / (1.0f + __expf(-x)); }
__device__ __forceinline__ float softplusf_(float x) { return x > 20.f ? x : log1pf(expf(x)); }
__device__ __forceinline__ float ex2(float x) { return __builtin_amdgcn_exp2f(x); }
__device__ __forceinline__ float lg2(float x) { return __builtin_amdgcn_logf(x); }
#define XB_TMO      128
#define XB_XCNT(j)  (256  + 64 * (j))
#define XB_XSUB(j)  (1280 + 64 * (j))
#define XB_XGEN(j)  (2304 + 64 * (j))
#define XB_TOP      3328
#define XB_TOPGEN   3392
#define XCD_BAR_WORDS 3456
#define XB_SPIN_CAP (1u << 18)

__device__ __forceinline__ unsigned xb_ld(unsigned* p)              { return __hip_atomic_load(p, __ATOMIC_RELAXED, __HIP_MEMORY_SCOPE_AGENT); }
__device__ __forceinline__ unsigned xb_add(unsigned* p, unsigned v) { return __hip_atomic_fetch_add(p, v, __ATOMIC_RELAXED, __HIP_MEMORY_SCOPE_AGENT); }
__device__ __forceinline__ unsigned xb_xcc_id() { return (unsigned)__builtin_amdgcn_s_getreg((3 << 11) | 20) & 0xFu; }
#define XB_SPIN(cond, bar) do { unsigned _sp = 0; while (cond) { __builtin_amdgcn_s_sleep(1); \
    if ((++_sp & 255u) == 0u) { if (xb_ld(&(bar)[XB_TMO])) break; if (_sp > XB_SPIN_CAP) { atomicAdd(&(bar)[XB_TMO], 1u); break; } } } } while (0)

struct XcdBarrier {
    unsigned* bar; unsigned x;
    volatile LAS unsigned* st;
};

__device__ __forceinline__ XcdBarrier xcd_barrier_post(unsigned* bar, volatile LAS unsigned* st, const int tid) {
    XcdBarrier b; b.bar = bar; b.x = xb_xcc_id(); b.st = st;
    if (tid == 0) (void)xb_add(&bar[XB_XCNT(b.x)], 1u);
    return b;
}
__device__ __forceinline__ void xcd_barrier_complete(unsigned* bar, unsigned x, unsigned& nloc, unsigned& nx) {
    const unsigned G = gridDim.x * gridDim.y * gridDim.z;
    unsigned sum, cnt, mine, sp = 0u;
    for (;;) {
        sum = 0u; cnt = 0u; mine = 0u;
#pragma unroll
        for (unsigned j = 0; j < 16; ++j) { const unsigned c = xb_ld(&bar[XB_XCNT(j)]); sum += c; cnt += (c > 0u) ? 1u : 0u; mine = (j == x) ? c : mine; }
        if (sum == G) break;
        __builtin_amdgcn_s_sleep(1);
        if ((++sp & 255u) == 0u) { if (xb_ld(&bar[XB_TMO])) break; if (sp > XB_SPIN_CAP) { atomicAdd(&bar[XB_TMO], 1u); break; } }
    }
    nloc = mine > 0u ? mine : 1u; nx = cnt > 0u ? cnt : 1u;
}

__device__ __forceinline__ void xcd_barrier(const XcdBarrier& b, const int tid) {
    asm volatile("s_waitcnt vmcnt(0)" ::: "memory");
    __syncthreads();
    if (tid == 0) {
        unsigned* bar = b.bar;
        __builtin_amdgcn_s_waitcnt(0);
        unsigned nloc = b.st[0], nx = b.st[1];
        if (nloc == 0u) { xcd_barrier_complete(bar, b.x, nloc, nx); b.st[0] = nloc; b.st[1] = nx; }
        const unsigned old = xb_add(&bar[XB_XSUB(b.x)], 1u);
        const unsigned gen = old / nloc;
        if (old + 1u == (gen + 1u) * nloc) {
            __builtin_amdgcn_fence(__ATOMIC_RELEASE, "agent");
            asm volatile("s_waitcnt vmcnt(0)" ::: "memory");
            const unsigned og = xb_add(&bar[XB_TOP], 1u);
            const unsigned tg = og / nx;
            if (og + 1u == (tg + 1u) * nx) xb_add(&bar[XB_TOPGEN], 1u);
            else XB_SPIN(xb_ld(&bar[XB_TOPGEN]) == tg, bar);
            __builtin_amdgcn_fence(__ATOMIC_ACQUIRE, "agent");
            xb_add(&bar[XB_XGEN(b.x)], 1u);
            asm volatile("s_waitcnt vmcnt(0)" ::: "memory");
        } else {
            XB_SPIN(xb_ld(&bar[XB_XGEN(b.x)]) == gen, bar);
            __builtin_amdgcn_fence(__ATOMIC_ACQUIRE, "agent");
            asm volatile("s_waitcnt vmcnt(0)" ::: "memory");
        }
    }
    __syncthreads();
}

enum { I_XP = 0, I_XS, I_CK, I_CV, I_SPOOL, I_SDNC, I_SDNS, I_SSSC, I_SSSH, I_PT, I_NMPRE, I_NMPOST, I_NLPRE, I_NLPOST, I_WIN, I_POOLW, I_POOLSC, I_DNCW, I_DNALOG, I_DNDTB, I_DNNW, I_SBBIAS,
       I_SSCW, I_SSCB, I_SSALOG, I_SSDTB, I_SSD, I_SSNW, I_WBR, I_WOUT, I_WUP, I_WDN, N_IN };
struct Args { const void* in[N_IN]; float* out; unsigned char* ws; int ph_lo, ph_hi, li, pad; };
#define IN_F(i) ((const float*)A->in[i])
#define WSP(T, off) ((T*)(A->ws + (off)))
typedef const __attribute__((opencl_constant)) Args* CA;
__device__ __forceinline__ CA args_opaque() { auto p = __builtin_amdgcn_kernarg_segment_ptr(); asm volatile("" : "+s"(p)); return (CA)p; }

struct EpiIn {
    static constexpr bool PERM = true, AFTER_DRAIN = false;
    float* UF; bf16* QKV; bf16* GATE; float *kp, *vp, *ks, *vs; float qscale;
    __device__ __forceinline__ void operator()(const f32x4 (&acc)[2][2][4][2], const pg8::Unit& u, int wr, int wc, int fr, int fq) const {
        const int pn = u.pn, row0 = u.pm * 256 + wr * 64 + fr, cl = wc * 32 + 8 * fq;
        if (pn < 10 || (pn >= 16 && pn < 26) || pn == 58) {
            const int col0 = pn * 256 + (pn < 10 ? 0 : (pn < 26 ? -1536 : -9728)) + cl;
#pragma unroll
            for (int ai = 0; ai < 2; ++ai)
#pragma unroll
                for (int m = 0; m < 4; ++m) { float* rowp = UF + (size_t)(row0 + ai * 128 + m * 16) * UFW + col0;
#pragma unroll
                    for (int bj = 0; bj < 2; ++bj) { *(f32x4*)(rowp + bj * 128) = acc[ai][bj][m][0]; *(f32x4*)(rowp + bj * 128 + 4) = acc[ai][bj][m][1]; } }
        } else if (pn < 16) {
            const int which = (pn - 10) >> 1, c512 = ((pn - 10) & 1) * 256 + cl; const float sc = which == 0 ? qscale : 1.f;
#pragma unroll
            for (int ai = 0; ai < 2; ++ai)
#pragma unroll
                for (int m = 0; m < 4; ++m) { const int r = row0 + ai * 128 + m * 16; bf16* rowp = QKV + (size_t)r * 1536 + which * 512 + c512;
                    float* fo = nullptr;
                    if (which) { if (r < TP) fo = (which == 1 ? kp : vp) + (size_t)r * 512 + c512; else if (r < TT) fo = (which == 1 ? ks : vs) + (size_t)(r - TP) * 512 + c512; }
#pragma unroll
                    for (int bj = 0; bj < 2; ++bj) { const f32x4 v0 = acc[ai][bj][m][0], v1 = acc[ai][bj][m][1];
                        v4u w; w.x = pk2(v0[0] * sc, v0[1] * sc); w.y = pk2(v0[2] * sc, v0[3] * sc); w.z = pk2(v1[0] * sc, v1[1] * sc); w.w = pk2(v1[2] * sc, v1[3] * sc);
                        *(v4u*)(rowp + bj * 128) = w;
                        if (fo) { *(f32x4*)(fo + bj * 128) = v0; *(f32x4*)(fo + bj * 128 + 4) = v1; } } }
        } else {
            const int col0 = (pn - 26) * 256 + cl;
#pragma unroll
            for (int ai = 0; ai < 2; ++ai)
#pragma unroll
                for (int m = 0; m < 4; ++m) { bf16* rowp = GATE + (size_t)(row0 + ai * 128 + m * 16) * 8192 + col0;
#pragma unroll
                    for (int bj = 0; bj < 2; ++bj) { const f32x4 v0 = acc[ai][bj][m][0], v1 = acc[ai][bj][m][1];
                        v4u w; w.x = pk2(sigmoidf_(v0[0]), sigmoidf_(v0[1])); w.y = pk2(sigmoidf_(v0[2]), sigmoidf_(v0[3])); w.z = pk2(sigmoidf_(v1[0]), sigmoidf_(v1[1])); w.w = pk2(sigmoidf_(v1[2]), sigmoidf_(v1[3]));
                        *(v4u*)(rowp + bj * 128) = w; } }
        }
    }
};
template <int S> struct EpiMerge {
    static constexpr bool PERM = true, AFTER_DRAIN = false;
    const bf16* GATE; const float* SSQ; float* MG32; bf16* MGB;
    __device__ __forceinline__ void operator()(const f32x4 (&acc)[2][2][4][2], const pg8::Unit& u, int wr, int wc, int fr, int fq) const {
        const int row0 = u.pm * 256 + wr * 64 + fr, col0 = u.pn * 256 + wc * 32 + 8 * fq; constexpr int GS = S < 3 ? S : 3;
#pragma unroll
        for (int ai = 0; ai < 2; ++ai)
#pragma unroll
            for (int m = 0; m < 4; ++m) { const int r = row0 + ai * 128 + m * 16; float rs = 1.f;
                if (S >= 3) { const f32x4 q0 = *(const f32x4*)(SSQ + (size_t)r * 16 + 8 * (S - 3)), q1 = *(const f32x4*)(SSQ + (size_t)r * 16 + 8 * (S - 3) + 4);
                    const float ss = (q0[0] + q0[1]) + (q0[2] + q0[3]) + (q1[0] + q1[1]) + (q1[2] + q1[3]); rs = 1.0f / sqrtf(ss * (1.0f / 512.0f) + RMS_EPS); }
#pragma unroll
                for (int bj = 0; bj < 2; ++bj) { const size_t o = (size_t)r * DM + col0 + bj * 128;
                    const v4u g = *(const v4u*)(GATE + (size_t)r * 8192 + GS * 2048 + col0 + bj * 128);
                    f32x4 v0 = acc[ai][bj][m][0], v1 = acc[ai][bj][m][1];
                    v0[0] *= bflo(g.x) * rs; v0[1] *= bfhi(g.x) * rs; v0[2] *= bflo(g.y) * rs; v0[3] *= bfhi(g.y) * rs;
                    v1[0] *= bflo(g.z) * rs; v1[1] *= bfhi(g.z) * rs; v1[2] *= bflo(g.w) * rs; v1[3] *= bfhi(g.w) * rs;
                    if (S > 0) { v0 += *(const f32x4*)(MG32 + o); v1 += *(const f32x4*)(MG32 + o + 4); }
                    if (S < 4) { *(f32x4*)(MG32 + o) = v0; *(f32x4*)(MG32 + o + 4) = v1; }
                    else { v4u w; w.x = pk2(v0[0], v0[1]); w.y = pk2(v0[2], v0[3]); w.z = pk2(v1[0], v1[1]); w.w = pk2(v1[2], v1[3]); *(v4u*)(MGB + o) = w; } } }
    }
};
struct EpiF32 {
    static constexpr bool PERM = true, AFTER_DRAIN = false;
    float* C; int ldc;
    __device__ __forceinline__ void operator()(const f32x4 (&acc)[2][2][4][2], const pg8::Unit& u, int wr, int wc, int fr, int fq) const {
        const int row0 = u.pm * 256 + wr * 64 + fr, col0 = u.pn * 256 + wc * 32 + 8 * fq;
#pragma unroll
        for (int ai = 0; ai < 2; ++ai)
#pragma unroll
            for (int m = 0; m < 4; ++m) { float* rowp = C + (size_t)(row0 + ai * 128 + m * 16) * ldc + col0;
#pragma unroll
                for (int bj = 0; bj < 2; ++bj) { *(f32x4*)(rowp + bj * 128) = acc[ai][bj][m][0]; *(f32x4*)(rowp + bj * 128 + 4) = acc[ai][bj][m][1]; } }
    }
};
struct EpiRelu2 {
    static constexpr bool PERM = true, AFTER_DRAIN = false;
    bf16* O; int ldc;
    __device__ __forceinline__ void operator()(const f32x4 (&acc)[2][2][4][2], const pg8::Unit& u, int wr, int wc, int fr, int fq) const {
        const int row0 = u.pm * 256 + wr * 64 + fr, col0 = u.pn * 256 + wc * 32 + 8 * fq;
#pragma unroll
        for (int ai = 0; ai < 2; ++ai)
#pragma unroll
            for (int m = 0; m < 4; ++m) { bf16* rowp = O + (size_t)(row0 + ai * 128 + m * 16) * ldc + col0;
#pragma unroll
                for (int bj = 0; bj < 2; ++bj) { f32x4 v0 = acc[ai][bj][m][0], v1 = acc[ai][bj][m][1];
#pragma unroll
                    for (int e = 0; e < 4; ++e) { const float a = fmaxf(v0[e], 0.f), b = fmaxf(v1[e], 0.f); v0[e] = a * a; v1[e] = b * b; }
                    v4u w; w.x = pk2(v0[0], v0[1]); w.y = pk2(v0[2], v0[3]); w.z = pk2(v1[0], v1[1]); w.w = pk2(v1[2], v1[3]); *(v4u*)(rowp + bj * 128) = w; } }
    }
};

__device__ __forceinline__ int win_src_col(int n) {
    if (n < 2560) return n;
    if (n < 6656) return n + 8;
    if (n < 14848) return n + 24;
    if (n < 14856) return n - 14848 + 2560;
    if (n < 14872) return n - 14856 + 6664;
    return -1;
}
template <int MODE>
__device__ __forceinline__ void transpose_item(const float* W, int ldw, int K, bf16* WT, int n0, int k0, const float* kscale, LAS float* scr, int lane) {
    const int n = n0 + (lane & 31); const int sc = MODE ? win_src_col(n) : n;
#pragma unroll 8
    for (int i = 0; i < 32; ++i) { const int kk = 2 * i + (lane >> 5); float v = sc >= 0 ? W[(size_t)(k0 + kk) * ldw + sc] : 0.f; if (kscale) v *= kscale[k0 + kk]; scr[kk * 33 + (lane & 31)] = v; }
    asm volatile("s_waitcnt lgkmcnt(0)" ::: "memory");
    const int c = lane & 7;
#pragma unroll
    for (int j = 0; j < 4; ++j) { const int nn = (lane >> 3) + 8 * j; const LAS float* s = scr + (8 * c) * 33 + nn;
        v4u o; o.x = pk2(s[0 * 33], s[1 * 33]); o.y = pk2(s[2 * 33], s[3 * 33]); o.z = pk2(s[4 * 33], s[5 * 33]); o.w = pk2(s[6 * 33], s[7 * 33]);
        *(v4u*)(WT + (size_t)(n0 + nn) * K + k0 + 8 * c) = o; }
    asm volatile("s_waitcnt lgkmcnt(0)" ::: "memory");
}
__device__ __forceinline__ void p0_prologue(CA A, LAS unsigned char* lds, const int wv) {
    const int tid = tid_opaque(wv), lane = tid & 63, wave = tid >> 6, G = gridDim.x;
    LAS float* scr = (LAS float*)(lds + wave * 8704);
    const int gw = blk_opaque() * NWAVES + wave, NGW = G * NWAVES;
    constexpr int I_IN = (NIN / 32) * (DM / 64), I_BR = (DM / 32) * (512 / 64), I_OUT = (DM / 32) * (DM / 64), I_UP = (DFF / 32) * (DM / 64), I_DN = (DM / 32) * (DFF / 64);
    constexpr int PER_LAYER = I_IN + 4 * I_BR + I_OUT + I_UP + I_DN;
    for (int it = gw; it < 2 * PER_LAYER; it += NGW) {
        const int L = it / PER_LAYER; int r = it % PER_LAYER;
        if (r < I_IN) { const int nb = r % (NIN / 32), kb = r / (NIN / 32);
            transpose_item<1>(IN_F(I_WIN) + (size_t)L * DM * INCOLS, INCOLS, DM, WSP(bf16, WS_WIN) + (size_t)L * NIN * DM, nb * 32, kb * 64, nullptr, scr, lane); continue; }
        r -= I_IN;
        if (r < 4 * I_BR) { const int s = 1 + r / I_BR, q = r % I_BR, nb = q % (DM / 32), kb = q / (DM / 32);
            transpose_item<0>(IN_F(I_WBR) + ((size_t)L * 2560 + 512 * s) * DM, DM, 512, WSP(bf16, WS_WBR) + (size_t)(L * 5 + s) * DM * 512, nb * 32, kb * 64,
                              s >= 3 ? IN_F(I_SSNW) + L * 1024 + (s - 3) * 512 : nullptr, scr, lane); continue; }
        r -= 4 * I_BR;
        if (r < I_OUT) { const int nb = r % (DM / 32), kb = r / (DM / 32);
            transpose_item<0>(IN_F(I_WOUT) + (size_t)L * DM * DM, DM, DM, WSP(bf16, WS_WOUT) + (size_t)L * DM * DM, nb * 32, kb * 64, nullptr, scr, lane); continue; }
        r -= I_OUT;
        if (r < I_UP) { const int nb = r % (DFF / 32), kb = r / (DFF / 32);
            transpose_item<0>(IN_F(I_WUP) + (size_t)L * DM * DFF, DFF, DM, WSP(bf16, WS_WUP) + (size_t)L * DFF * DM, nb * 32, kb * 64, nullptr, scr, lane); continue; }
        r -= I_UP;
        { const int nb = r % (DM / 32), kb = r / (DM / 32);
            transpose_item<0>(IN_F(I_WDN) + (size_t)L * DFF * DM, DM, DFF, WSP(bf16, WS_WDN) + (size_t)L * DM * DFF, nb * 32, kb * 64, nullptr, scr, lane); }
    }
    for (int idx = blk_opaque() * NTHR + tid; idx < 2 * DM * 64; idx += G * NTHR) {
        const int L = idx / (DM * 64), q = idx % (DM * 64), n = q & (DM - 1), kc = q >> 11, k0 = kc * 8, g = k0 >> 7, c0 = k0 & 127;
        const float* pw = IN_F(I_POOLW) + ((size_t)(L * 4 + g) * 128 + c0) * 128; const float* psc = IN_F(I_POOLSC) + L * 512 + g * 128;
        const float* wb = IN_F(I_WBR) + ((size_t)L * 2560 + g * 128) * DM + n;
        float acc[8] = {0.f, 0.f, 0.f, 0.f, 0.f, 0.f, 0.f, 0.f};
        for (int d = 0; d < 128; ++d) { const float wv = wb[(size_t)d * DM] * psc[d];
#pragma unroll
            for (int i = 0; i < 8; ++i) acc[i] += pw[i * 128 + d] * wv; }
        v4u o; o.x = pk2(acc[0], acc[1]); o.y = pk2(acc[2], acc[3]); o.z = pk2(acc[4], acc[5]); o.w = pk2(acc[6], acc[7]);
        *(v4u*)(WSP(bf16, WS_WBR) + (size_t)(L * 5) * DM * 512 + (size_t)n * 512 + k0) = o;
    }
}

__device__ __forceinline__ const float* xin_row(CA A, int m) { return m < TP ? IN_F(I_XP) + (size_t)m * DM : IN_F(I_XS) + (size_t)(m - TP) * DM; }
__device__ __forceinline__ void store_bf16_row(bf16* orow, const f32x4 (&v)[8], float rstd, const float* g, int lane) {
#pragma unroll
    for (int j = 0; j < 8; ++j) { const f32x4 gj = ((const f32x4*)g)[lane + 64 * j]; const f32x4 o = v[j] * rstd * gj;
        v2u w; w.x = pk2(o[0], o[1]); w.y = pk2(o[2], o[3]); ((v2u*)orow)[lane + 64 * j] = w; }
}
__device__ __forceinline__ void norm1_phase(CA A, const int wv) {
    const int tid = tid_opaque(wv), lane = tid & 63, gw = blk_opaque() * NWAVES + (tid >> 6), NGW = gridDim.x * NWAVES;
    bf16* H = WSP(bf16, WS_H);
    for (int m = gw; m < MP; m += NGW) {
        if (m >= TT) { for (int j = 0; j < 8; ++j) ((v2u*)(H + (size_t)m * DM))[lane + 64 * j] = (v2u){0u, 0u}; continue; }
        const f32x4* xr = (const f32x4*)xin_row(A, m); f32x4 v[8]; float s = 0.f;
#pragma unroll
        for (int j = 0; j < 8; ++j) { v[j] = xr[lane + 64 * j]; s += (v[j][0] * v[j][0] + v[j][1] * v[j][1]) + (v[j][2] * v[j][2] + v[j][3] * v[j][3]); }
        const float rstd = 1.0f / sqrtf(wave_sum(s) * (1.0f / DM) + RMS_EPS);
        store_bf16_row(H + (size_t)m * DM, v, rstd, IN_F(I_NMPRE), lane);
    }
}
__device__ __forceinline__ void resid_phase(CA A, const float* Y, const float* gpost, const float* gnext, bool from_input, const int wv) {
    const int tid = tid_opaque(wv), lane = tid & 63, gw = blk_opaque() * NWAVES + (tid >> 6), NGW = gridDim.x * NWAVES;
    bf16* H = WSP(bf16, WS_H);
    for (int m = gw; m < TT; m += NGW) {
        const f32x4* yr = (const f32x4*)(Y + (size_t)m * DM); const f32x4* xr = from_input ? (const f32x4*)xin_row(A, m) : (const f32x4*)(A->out + O_Y + (size_t)m * DM);
        f32x4 v[8]; float s = 0.f;
#pragma unroll
        for (int j = 0; j < 8; ++j) { v[j] = yr[lane + 64 * j]; s += (v[j][0] * v[j][0] + v[j][1] * v[j][1]) + (v[j][2] * v[j][2] + v[j][3] * v[j][3]); }
        const float rstd = 1.0f / sqrtf(wave_sum(s) * (1.0f / DM) + RMS_EPS); float s2 = 0.f;
        f32x4* orow = (f32x4*)(A->out + O_Y + (size_t)m * DM);
#pragma unroll
        for (int j = 0; j < 8; ++j) { const f32x4 gj = ((const f32x4*)gpost)[lane + 64 * j]; v[j] = xr[lane + 64 * j] + v[j] * rstd * gj; orow[lane + 64 * j] = v[j];
            s2 += (v[j][0] * v[j][0] + v[j][1] * v[j][1]) + (v[j][2] * v[j][2] + v[j][3] * v[j][3]); }
        if (gnext) { const float rstd2 = 1.0f / sqrtf(wave_sum(s2) * (1.0f / DM) + RMS_EPS); store_bf16_row(H + (size_t)m * DM, v, rstd2, gnext, lane); }
    }
}

__device__ __forceinline__ float conv_tap(const float* UF, const float* state, int row, int j, int ucol, int c) {
    if (row < TP) { const int t = row & (SEQ - 1); return (t - 3 + j) >= 0 ? UF[(size_t)(row - 3 + j) * UFW + ucol + c] : 0.f; }
    const int s = row - TP, sb = s >> 2, e = (s & 3) + j;
    return e < 3 ? state[(size_t)(sb * 3 + e) * 1536 + c] : UF[(size_t)(TP + sb * 4 + e - 3) * UFW + ucol + c];
}
__device__ __forceinline__ void prep_phase(CA A, int layer, const int wv) {
    const int tid = tid_opaque(wv), lane = tid & 63, G = gridDim.x, gt = blk_opaque() * NTHR + tid, NGT = G * NTHR, gw = blk_opaque() * NWAVES + (tid >> 6), NGW = G * NWAVES;
    const float* UF = WSP(float, WS_UF); float* SC = WSP(float, WS_SCAL);
    for (int idx = gt; idx < TT * 24; idx += NGT) { const int row = idx / 24, j = idx % 24; const float u = UF[(size_t)row * UFW + UF_SMALL + j]; float r;
        if (j < 4) r = sigmoidf_(u);
        else if (j < 8) r = -expf(IN_F(I_DNALOG)[layer * 4 + j - 4]) * softplusf_(u + IN_F(I_DNDTB)[layer * 4 + j - 4]);
        else r = softplusf_(u + IN_F(I_SSDTB)[layer * 16 + j - 8]);
        SC[(size_t)row * 32 + j] = r; }
    { bf16* O0 = WSP(bf16, WS_OBR); const float* spool = IN_F(I_SPOOL) + (size_t)layer * DBATCH * 15 * 512;
      for (int idx = gt; idx < TT * 512; idx += NGT) { const int row = idx >> 9, ch = idx & 511, w = 2 << (ch >> 7); float s = 0.f, cnt;
          if (row < TP) { const int t = row & (SEQ - 1); const int n = (t + 1) < w ? (t + 1) : w; cnt = (float)n; for (int j = 0; j < n; ++j) s += UF[(size_t)(row - j) * UFW + ch]; }
          else { const int q = row - TP, sb = q >> 2, e = 15 + (q & 3); cnt = (float)w;
              for (int j = 0; j < w; ++j) { const int ee = e - j; s += ee < 15 ? spool[(size_t)(sb * 15 + ee) * 512 + ch] : UF[(size_t)(TP + sb * 4 + ee - 15) * UFW + ch]; } }
          O0[(size_t)row * 512 + ch] = (bf16)f2bf(s / cnt - UF[(size_t)row * UFW + ch]); } }
    { float* DNQ = WSP(float, WS_DNQ); const float* st = IN_F(I_SDNC) + (size_t)layer * DBATCH * 3 * 1536; const float* cw = IN_F(I_DNCW) + (size_t)layer * 4 * 1536;
      for (int it = gw; it < TT * 12; it += NGW) { const int row = it / 12, hd = it % 12, c = hd * 128 + 2 * lane; float a0 = 0.f, a1 = 0.f;
#pragma unroll
          for (int j = 0; j < 4; ++j) { a0 += conv_tap(UF, st, row, j, UF_DNQKV, c) * cw[j * 1536 + c]; a1 += conv_tap(UF, st, row, j, UF_DNQKV, c + 1) * cw[j * 1536 + c + 1]; }
          a0 = siluf_(a0); a1 = siluf_(a1);
          if (hd < 8) { const float ss = wave_sum(a0 * a0 + a1 * a1); float sc = 1.0f / sqrtf(ss + 1e-6f); if (hd < 4) sc *= 0.08838834764831845f; a0 *= sc; a1 *= sc; }
          *(f32x2*)(DNQ + (size_t)row * 1536 + c) = (f32x2){a0, a1}; } }
    { float* XBC = WSP(float, WS_XBC); const float* st = IN_F(I_SSSC) + (size_t)layer * DBATCH * 3 * 1536; const float* cw = IN_F(I_SSCW) + (size_t)layer * 4 * 1536; const float* cb = IN_F(I_SSCB) + layer * 1536;
      for (int idx = gt; idx < TT * 1536; idx += NGT) { const int row = idx / 1536, c = idx % 1536; float a = cb[c];
#pragma unroll
          for (int j = 0; j < 4; ++j) a += conv_tap(UF, st, row, j, UF_XBC, c) * cw[j * 1536 + c];
          XBC[(size_t)row * 1536 + c] = siluf_(a); } }
    for (int idx = gt; idx < NBATCH * 3 * 1536; idx += NGT) { const int b = idx / (3 * 1536), q = idx % (3 * 1536), j = q / 1536, c = q % 1536; const size_t src = (size_t)(b * SEQ + SEQ - 3 + j) * UFW;
        A->out[O_DNCP + (size_t)layer * NBATCH * 3 * 1536 + idx] = UF[src + UF_DNQKV + c]; A->out[O_SSCP + (size_t)layer * NBATCH * 3 * 1536 + idx] = UF[src + UF_XBC + c]; }
    for (int idx = gt; idx < DBATCH * 3 * 1536; idx += NGT) { const int sb = idx / (3 * 1536), q = idx % (3 * 1536), j = q / 1536, c = q % 1536; const size_t src = (size_t)(TP + sb * 4 + 1 + j) * UFW;
        A->out[O_DNCS + (size_t)layer * DBATCH * 3 * 1536 + idx] = UF[src + UF_DNQKV + c]; A->out[O_SSCS + (size_t)layer * DBATCH * 3 * 1536 + idx] = UF[src + UF_XBC + c]; }
    for (int idx = gt; idx < NBATCH * 15 * 512; idx += NGT) { const int b = idx / (15 * 512), q = idx % (15 * 512), j = q >> 9, ch = q & 511;
        A->out[O_POOLP + (size_t)layer * NBATCH * 15 * 512 + idx] = UF[(size_t)(b * SEQ + SEQ - 15 + j) * UFW + ch]; }
    { const float* spool = IN_F(I_SPOOL) + (size_t)layer * DBATCH * 15 * 512;
      for (int idx = gt; idx < DBATCH * 15 * 512; idx += NGT) { const int sb = idx / (15 * 512), q = idx % (15 * 512), j = q >> 9, ch = q & 511, e = 4 + j;
          A->out[O_POOLS + (size_t)layer * DBATCH * 15 * 512 + idx] = e < 15 ? spool[(size_t)(sb * 15 + e) * 512 + ch] : UF[(size_t)(TP + sb * 4 + e - 15) * UFW + ch]; } }
}

__device__ __forceinline__ void dn_seq(CA A, LAS unsigned char* lds, int layer, int unit, const int wv) {
    const int tid = tid_opaque(wv), lane = tid & 63, wid = tid >> 6, v = tid & 127, kq = tid >> 7;
    int row0, L, h; const float* s0 = nullptr; float* sout;
    if (unit < 16) { const int b = unit >> 2; h = unit & 3; row0 = b * SEQ; L = SEQ; sout = A->out + O_DNSP + ((size_t)(layer * NBATCH + b) * 4 + h) * 16384; }
    else { const int u = unit - 16, sb = u >> 2; h = u & 3; row0 = TP + sb * 4; L = DSEQ; s0 = IN_F(I_SDNS) + ((size_t)(layer * DBATCH + sb) * 4 + h) * 16384; sout = A->out + O_DNSS + ((size_t)(layer * DBATCH + sb) * 4 + h) * 16384; }
    constexpr int CH = 32;
    LAS float* qs = (LAS float*)lds; LAS float* ks = qs + CH * 128; LAS float* vs = ks + CH * 128; LAS float* ob = vs + CH * 128;
    LAS float* red = ob + CH * 128;
    LAS float* egs = red + 2 * 2 * 4 * 128; LAS float* bts = egs + CH; LAS float* kqd = bts + CH;
    const float* DNQ = WSP(float, WS_DNQ); const float* SC = WSP(float, WS_SCAL); const float* UF = WSP(float, WS_UF); bf16* O1 = WSP(bf16, WS_OBR) + (size_t)MP * 512;
    const float* nw = IN_F(I_DNNW) + layer * 128;
    float S[32];
#pragma unroll
    for (int i = 0; i < 32; ++i) S[i] = s0 ? s0[(size_t)(32 * kq + i) * 128 + v] : 0.f;
    for (int c0 = 0; c0 < L; c0 += CH) {
        const int n = (L - c0) < CH ? (L - c0) : CH;
        __syncthreads();
        for (int idx = tid; idx < n * 128; idx += NTHR) { const int t = idx >> 7, c = idx & 127; const float* src = DNQ + (size_t)(row0 + c0 + t) * 1536 + h * 128 + c;
            qs[idx] = src[0]; ks[idx] = src[512]; vs[idx] = src[1024]; }
        if (tid < n) { const float* sc = SC + (size_t)(row0 + c0 + tid) * 32; bts[tid] = sc[h]; egs[tid] = expf(sc[4 + h]); }
        __syncthreads();
        for (int t = wid; t < n; t += NWAVES) { const float s = wave_sum(ks[t * 128 + lane] * qs[t * 128 + lane] + ks[t * 128 + 64 + lane] * qs[t * 128 + 64 + lane]); if (lane == 0) kqd[t] = s; }
        __syncthreads();
        for (int t = 0; t < n; ++t) {
            const float eg = egs[t], bt = bts[t]; float kk[32]; float r = 0.f, pp = 0.f;
#pragma unroll
            for (int i4 = 0; i4 < 8; ++i4) { const f32x4 k4 = *(const LAS f32x4*)(ks + t * 128 + 32 * kq + 4 * i4), q4 = *(const LAS f32x4*)(qs + t * 128 + 32 * kq + 4 * i4);
#pragma unroll
                for (int e = 0; e < 4; ++e) { const int i = 4 * i4 + e; S[i] *= eg; kk[i] = k4[e]; r += S[i] * k4[e]; pp += S[i] * q4[e]; } }
            LAS float* rd = red + (t & 1) * 1024;
            rd[kq * 128 + v] = r; rd[512 + kq * 128 + v] = pp;
            __syncthreads();
            const float rt = (rd[v] + rd[128 + v]) + (rd[256 + v] + rd[384 + v]), pt = (rd[512 + v] + rd[640 + v]) + (rd[768 + v] + rd[896 + v]);
            const float dd = bt * (vs[t * 128 + v] - rt);
#pragma unroll
            for (int i = 0; i < 32; ++i) S[i] += kk[i] * dd;
            if (kq == 0) ob[t * 128 + v] = pt + kqd[t] * dd;
        }
        __syncthreads();
        for (int t = wid; t < n; t += NWAVES) { const int row = row0 + c0 + t; const float o0 = ob[t * 128 + lane], o1 = ob[t * 128 + 64 + lane];
            const float rstd = 1.0f / sqrtf(wave_sum(o0 * o0 + o1 * o1) * (1.0f / 128.0f) + RMS_EPS);
            const float z0 = UF[(size_t)row * UFW + UF_DNZ + h * 128 + lane], z1 = UF[(size_t)row * UFW + UF_DNZ + h * 128 + 64 + lane];
            O1[(size_t)row * 512 + h * 128 + lane] = (bf16)f2bf(o0 * rstd * nw[lane] * siluf_(z0)); O1[(size_t)row * 512 + h * 128 + 64 + lane] = (bf16)f2bf(o1 * rstd * nw[64 + lane] * siluf_(z1)); }
    }
#pragma unroll
    for (int i = 0; i < 32; ++i) sout[(size_t)(32 * kq + i) * 128 + v] = S[i];
    __syncthreads();
}

__device__ __forceinline__ void ssd_seq(CA A, LAS unsigned char* lds, int layer, int unit, const int wv) {
    const int tid = tid_opaque(wv), lane = tid & 63, wid = tid >> 6, p = tid >> 3, nq = tid & 7;
    int row0, L, hd; const float* h0 = nullptr; float* hout;
    if (unit < 64) { const int b = unit >> 4; hd = unit & 15; row0 = b * SEQ; L = SEQ; hout = A->out + O_SSHP + ((size_t)(layer * NBATCH + b) * 16 + hd) * 8192; }
    else { const int u = unit - 64, sb = u >> 4; hd = u & 15; row0 = TP + sb * 4; L = DSEQ; h0 = IN_F(I_SSSH) + ((size_t)(layer * DBATCH + sb) * 16 + hd) * 8192; hout = A->out + O_SSHS + ((size_t)(layer * DBATCH + sb) * 16 + hd) * 8192; }
    const int g = hd >> 3; constexpr int CH = 64;
    LAS float* Bs = (LAS float*)lds; LAS float* Cs = Bs + CH * 128; LAS float* xs = Cs + CH * 128; LAS float* yb = xs + CH * 64; LAS float* dts = yb + CH * 64;
    const float* XBC = WSP(float, WS_XBC); const float* SC = WSP(float, WS_SCAL); const float* UF = WSP(float, WS_UF); float* SSQ = WSP(float, WS_SSQ);
    bf16* Og = WSP(bf16, WS_OBR) + (size_t)(3 + g) * MP * 512;
    const float a = -expf(IN_F(I_SSALOG)[layer * 16 + hd]), Dk = IN_F(I_SSD)[layer * 16 + hd];
    float hs[16];
#pragma unroll
    for (int j = 0; j < 16; ++j) hs[j] = h0 ? h0[(size_t)p * 128 + 16 * nq + j] : 0.f;
    for (int c0 = 0; c0 < L; c0 += CH) {
        const int n = (L - c0) < CH ? (L - c0) : CH;
        __syncthreads();
        for (int idx = tid; idx < n * 128; idx += NTHR) { const int t = idx >> 7, c = idx & 127; const float* src = XBC + (size_t)(row0 + c0 + t) * 1536; Bs[idx] = src[1024 + g * 128 + c]; Cs[idx] = src[1280 + g * 128 + c]; }
        for (int idx = tid; idx < n * 64; idx += NTHR) { const int t = idx >> 6, c = idx & 63; xs[idx] = XBC[(size_t)(row0 + c0 + t) * 1536 + hd * 64 + c]; }
        if (tid < n) dts[tid] = SC[(size_t)(row0 + c0 + tid) * 32 + 8 + hd];
        __syncthreads();
        for (int t = 0; t < n; ++t) {
            const float dt = dts[t], dA = expf(dt * a), xv = xs[t * 64 + p], cx = dt * xv; float y = 0.f;
#pragma unroll
            for (int j4 = 0; j4 < 4; ++j4) { const f32x4 b4 = *(const LAS f32x4*)(Bs + t * 128 + 16 * nq + 4 * j4), c4 = *(const LAS f32x4*)(Cs + t * 128 + 16 * nq + 4 * j4);
#pragma unroll
                for (int e = 0; e < 4; ++e) { const int j = 4 * j4 + e; hs[j] = hs[j] * dA + cx * b4[e]; y += hs[j] * c4[e]; } }
            y += __shfl_xor(y, 1); y += __shfl_xor(y, 2); y += __shfl_xor(y, 4);
            if (nq == 0) yb[t * 64 + p] = y + Dk * xv;
        }
        __syncthreads();
        for (int t = wid; t < n; t += NWAVES) { const int row = row0 + c0 + t; const float z = UF[(size_t)row * UFW + UF_SSZ + hd * 64 + lane]; const float yg = yb[t * 64 + lane] * siluf_(z);
            const float ss = wave_sum(yg * yg); if (lane == 0) SSQ[(size_t)row * 16 + hd] = ss;
            Og[(size_t)row * 512 + (hd & 7) * 64 + lane] = (bf16)f2bf(yg); }
    }
#pragma unroll
    for (int j = 0; j < 16; ++j) hout[(size_t)p * 128 + 16 * nq + j] = hs[j];
    __syncthreads();
}

constexpr size_t DNU_NW = 0, DNU_QG = 16384, DNU_AT = 32768, DNU_KGT = 40960, DNU_UP = 57344, DNU_EG = 90112, DNU_BYTES = 90368;
__device__ __forceinline__ float dpp_swap1(float x) { return __builtin_bit_cast(float, __builtin_amdgcn_mov_dpp(__builtin_bit_cast(int, x), 0xB1, 0xf, 0xf, true)); }
__device__ __forceinline__ void dn_chunk_unit(CA A, LAS unsigned char* lds, int layer, int unit, const int wv) {
    const int tid = tid_opaque(wv), lane = tid & 63, wid = tid >> 6, q4 = lane >> 4, l15 = lane & 15;
    const int bh = unit >> 5, ck = unit & 31, b = bh >> 2, h = bh & 3, row0 = b * SEQ + ck * 64;
    constexpr int FP = 132;
    LAS float* kf = (LAS float*)lds; LAS float* vf = kf + 64 * FP;
    LAS unsigned char* qb = lds + 2 * 64 * FP * 4; LAS unsigned char* kb = qb + 64 * 272;
    LAS float* Lp = (LAS float*)(kb + 64 * 272);
    LAS float* gcs = Lp + 2 * 64 * 32; LAS float* bts = gcs + 64;
    const float* DNQ = WSP(float, WS_DNQ); const float* SC = WSP(float, WS_SCAL);
    unsigned char* rec = A->ws + WS_DNU + (size_t)unit * DNU_BYTES;
    __syncthreads();
    if (tid < 64) { const float* sc = SC + (size_t)(row0 + tid) * 32; float g = sc[4 + h]; bts[tid] = sc[h];
#pragma unroll
        for (int o = 1; o < 64; o <<= 1) { const float t = __shfl_up(g, o); if (lane >= o) g += t; }
        gcs[tid] = g; }
    __syncthreads();
    const float glast = gcs[63];
    if (tid == 0) *(float*)(rec + DNU_EG) = expf(glast);
#pragma unroll
    for (int it = 0; it < 4; ++it) { const int idx = tid + 512 * it, t = idx >> 5, d4 = (idx & 31) * 4; const float* src = DNQ + (size_t)(row0 + t) * 1536 + h * 128 + d4;
        const f32x4 qv = *(const f32x4*)src, kv = *(const f32x4*)(src + 512), vv = *(const f32x4*)(src + 1024);
        *(LAS f32x4*)(kf + t * FP + d4) = kv; *(LAS f32x4*)(vf + t * FP + d4) = vv;
        v2u w; w.x = pk2(qv[0], qv[1]); w.y = pk2(qv[2], qv[3]); *(LAS v2u*)(qb + t * 272 + d4 * 2) = w;
        w.x = pk2(kv[0], kv[1]); w.y = pk2(kv[2], kv[3]); *(LAS v2u*)(kb + t * 272 + d4 * 2) = w;
        const float eg = expf(gcs[t]); w.x = pk2(qv[0] * eg, qv[1] * eg); w.y = pk2(qv[2] * eg, qv[3] * eg); *(v2u*)(rec + DNU_QG + (size_t)(t * 128 + d4) * 2) = w; }
    __syncthreads();
    { const int c = lane, dg = wid; const float f = expf(glast - gcs[c]); bf16* KGT = (bf16*)(rec + DNU_KGT);
#pragma unroll
      for (int i = 0; i < 16; ++i) { const int d = dg * 16 + i; KGT[d * 64 + c] = (bf16)f2bf(kf[c * FP + d] * f); } }
    { const int ct = wid >> 1; bf16* AT = (bf16*)(rec + DNU_AT);
#pragma unroll
      for (int e2 = 0; e2 < 2; ++e2) { const int et = 2 * (wid & 1) + e2; f32x4 aKK = {0.f, 0.f, 0.f, 0.f}, aQK = {0.f, 0.f, 0.f, 0.f};
#pragma unroll
          for (int ks = 0; ks < 4; ++ks) { const bf16x8 bfr = *(const LAS bf16x8*)(kb + (16 * et + l15) * 272 + (32 * ks + 8 * q4) * 2);
              const bf16x8 ak = *(const LAS bf16x8*)(kb + (16 * ct + l15) * 272 + (32 * ks + 8 * q4) * 2), aq = *(const LAS bf16x8*)(qb + (16 * ct + l15) * 272 + (32 * ks + 8 * q4) * 2);
              aKK = __builtin_amdgcn_mfma_f32_16x16x32_bf16(ak, bfr, aKK, 0, 0, 0); aQK = __builtin_amdgcn_mfma_f32_16x16x32_bf16(aq, bfr, aQK, 0, 0, 0); }
          const int e = 16 * et + l15; const float ge = gcs[e];
#pragma unroll
          for (int r = 0; r < 4; ++r) { const int c = 16 * ct + 4 * q4 + r; const float dec = e <= c ? expf(gcs[c] - ge) : 0.f;
              Lp[((e & 1) * 64 + c) * 32 + (e >> 1)] = e < c ? bts[c] * aKK[r] * dec : 0.f;
              AT[c * 64 + e] = (bf16)f2bf(aQK[r] * dec); } } }
    __syncthreads();
    { const int j = tid >> 1, par = tid & 1; float x[32];
#pragma unroll
      for (int i = 0; i < 32; ++i) x[i] = 0.f;
      const LAS float* src = j < 128 ? vf + j : kf + (j - 128);
      float* UP = (float*)(rec + DNU_UP); bf16* NW = (bf16*)(rec + DNU_NW);
#pragma unroll
      for (int c = 0; c < 64; ++c) {
          constexpr int dummy = 0; (void)dummy;
          const int ni = (c + 1) >> 1; float a0 = 0.f, a1 = 0.f, a2 = 0.f, a3 = 0.f;
#pragma unroll
          for (int i4 = 0; i4 < (ni + 3) / 4; ++i4) { const f32x4 l4 = *(const LAS f32x4*)(Lp + (par * 64 + c) * 32 + 4 * i4);
              a0 += l4[0] * x[4 * i4]; if (4 * i4 + 1 < ni) a1 += l4[1] * x[4 * i4 + 1]; if (4 * i4 + 2 < ni) a2 += l4[2] * x[4 * i4 + 2]; if (4 * i4 + 3 < ni) a3 += l4[3] * x[4 * i4 + 3]; }
          float acc = (a0 + a1) + (a2 + a3); acc += dpp_swap1(acc);
          float rhs = src[c * FP] * bts[c]; if (j >= 128) rhs *= expf(gcs[c]);
          const float xc = rhs - acc;
          x[c >> 1] = ((c & 1) == par) ? xc : x[c >> 1];
          if (par == 0) { if (j < 128) UP[(((j >> 4) * 4 + (c >> 4)) * 4 + (c & 3)) * 64 + ((c >> 2) & 3) * 16 + (j & 15)] = xc; else NW[c * 128 + (j - 128)] = (bf16)f2bf(-xc); }
      } }
}

constexpr int D2_NW = 0, D2_QG = 17408, D2_AT = 34816, D2_KGT = 44032, D2_BUF = 62464, D2_RED = 2 * D2_BUF;
__device__ __forceinline__ bf16x8 ld_frag_perm(const LAS unsigned char* p) {
    const v2u lo = *(const LAS v2u*)p, hi = *(const LAS v2u*)(p + 32); v4u w; w.x = lo.x; w.y = lo.y; w.z = hi.x; w.w = hi.y; return __builtin_bit_cast(bf16x8, w);
}
__device__ __forceinline__ bf16x8 pack_b(const f32x4& t0, const f32x4& t1) { v4u w; w.x = pk2(t0[0], t0[1]); w.y = pk2(t0[2], t0[3]); w.z = pk2(t1[0], t1[1]); w.w = pk2(t1[2], t1[3]); return __builtin_bit_cast(bf16x8, w); }
__device__ __forceinline__ void dn_seq2(CA A, LAS unsigned char* lds, int layer, int bh, const int wv) {
    const int tid = tid_opaque(wv), lane = tid & 63, w = tid >> 6, q4 = lane >> 4, l15 = lane & 15;
    const int b = bh >> 2, h = bh & 3;
    const unsigned char* recs = A->ws + WS_DNU + (size_t)(bh * 32) * DNU_BYTES;
    const float* UF = WSP(float, WS_UF); bf16* O1 = WSP(bf16, WS_OBR) + (size_t)MP * 512; const float* nw = IN_F(I_DNNW) + layer * 128;
    LAS float* red = (LAS float*)(lds + D2_RED);
    f32x4 S[8];
#pragma unroll
    for (int i = 0; i < 8; ++i) S[i] = (f32x4){0.f, 0.f, 0.f, 0.f};
    v4u st[7];
#define D2_LOAD(rec_) do { const v4u* g_ = (const v4u*)(rec_); _Pragma("unroll") for (int i_ = 0; i_ < 7; ++i_) st[i_] = g_[tid + 512 * i_]; } while (0)
#define D2_STORE(buf_) do { LAS unsigned char* b_ = lds + (buf_) * D2_BUF; \
        *(LAS v4u*)(b_ + D2_NW + (tid >> 4) * 272 + (tid & 15) * 16) = st[0]; *(LAS v4u*)(b_ + D2_NW + (32 + (tid >> 4)) * 272 + (tid & 15) * 16) = st[1]; \
        *(LAS v4u*)(b_ + D2_QG + (tid >> 4) * 272 + (tid & 15) * 16) = st[2]; *(LAS v4u*)(b_ + D2_QG + (32 + (tid >> 4)) * 272 + (tid & 15) * 16) = st[3]; \
        *(LAS v4u*)(b_ + D2_AT + (tid >> 3) * 144 + (tid & 7) * 16) = st[4]; \
        *(LAS v4u*)(b_ + D2_KGT + (tid >> 3) * 144 + (tid & 7) * 16) = st[5]; *(LAS v4u*)(b_ + D2_KGT + (64 + (tid >> 3)) * 144 + (tid & 7) * 16) = st[6]; } while (0)
    __syncthreads();
    D2_LOAD(recs); D2_STORE(0);
    __syncthreads();
    for (int ck = 0; ck < 32; ++ck) {
        const unsigned char* rec = recs + (size_t)ck * DNU_BYTES; const int row0 = b * SEQ + ck * 64;
        const LAS unsigned char* bf = lds + (ck & 1) * D2_BUF;
        if (ck + 1 < 32) D2_LOAD(rec + DNU_BYTES);
        const float egl = *(const float*)(rec + DNU_EG);
        const float* UP = (const float*)(rec + DNU_UP) + (size_t)w * 1024 + lane;
        f32x4 vn[4];
#pragma unroll
        for (int mt = 0; mt < 4; ++mt)
#pragma unroll
            for (int r = 0; r < 4; ++r) vn[mt][r] = UP[(mt * 4 + r) * 64];
        bf16x8 Sb[4];
#pragma unroll
        for (int ks = 0; ks < 4; ++ks) Sb[ks] = pack_b(S[2 * ks], S[2 * ks + 1]);
        const int aoff = l15 * 272 + 8 * q4, aoff2 = l15 * 144 + 8 * q4;
#pragma unroll
        for (int mt = 0; mt < 4; ++mt)
#pragma unroll
            for (int ks = 0; ks < 4; ++ks) vn[mt] = __builtin_amdgcn_mfma_f32_16x16x32_bf16(ld_frag_perm(bf + D2_NW + mt * 16 * 272 + aoff + ks * 64), Sb[ks], vn[mt], 0, 0, 0);
        bf16x8 vb[2];
        vb[0] = pack_b(vn[0], vn[1]); vb[1] = pack_b(vn[2], vn[3]);
        f32x4 o[4];
#pragma unroll
        for (int mt = 0; mt < 4; ++mt) { o[mt] = (f32x4){0.f, 0.f, 0.f, 0.f};
#pragma unroll
            for (int ks = 0; ks < 4; ++ks) o[mt] = __builtin_amdgcn_mfma_f32_16x16x32_bf16(ld_frag_perm(bf + D2_QG + mt * 16 * 272 + aoff + ks * 64), Sb[ks], o[mt], 0, 0, 0);
#pragma unroll
            for (int ke = 0; ke < 2; ++ke) o[mt] = __builtin_amdgcn_mfma_f32_16x16x32_bf16(ld_frag_perm(bf + D2_AT + mt * 16 * 144 + aoff2 + ke * 64), vb[ke], o[mt], 0, 0, 0); }
#pragma unroll
        for (int m8 = 0; m8 < 8; ++m8) { S[m8] = S[m8] * egl;
#pragma unroll
            for (int ke = 0; ke < 2; ++ke) S[m8] = __builtin_amdgcn_mfma_f32_16x16x32_bf16(ld_frag_perm(bf + D2_KGT + m8 * 16 * 144 + aoff2 + ke * 64), vb[ke], S[m8], 0, 0, 0); }
        LAS float* rd = red + (ck & 1) * 512;
#pragma unroll
        for (int mt = 0; mt < 4; ++mt)
#pragma unroll
            for (int r = 0; r < 4; ++r) { float s = o[mt][r] * o[mt][r]; s += __shfl_xor(s, 1); s += __shfl_xor(s, 2); s += __shfl_xor(s, 4); s += __shfl_xor(s, 8);
                if (l15 == 0) rd[(16 * mt + 4 * q4 + r) * 8 + w] = s; }
        if (ck + 1 < 32) D2_STORE((ck + 1) & 1);
        __syncthreads();
#pragma unroll
        for (int mt = 0; mt < 4; ++mt)
#pragma unroll
            for (int r = 0; r < 4; ++r) { const int c = 16 * mt + 4 * q4 + r; const f32x4 s0 = *(const LAS f32x4*)(rd + c * 8), s1 = *(const LAS f32x4*)(rd + c * 8 + 4);
                const float rstd = 1.0f / sqrtf(((s0[0] + s0[1]) + (s0[2] + s0[3]) + (s1[0] + s1[1]) + (s1[2] + s1[3])) * (1.0f / 128.0f) + RMS_EPS);
                const int dv = 16 * w + l15; const float z = UF[(size_t)(row0 + c) * UFW + UF_DNZ + h * 128 + dv];
                O1[(size_t)(row0 + c) * 512 + h * 128 + dv] = (bf16)f2bf(o[mt][r] * rstd * nw[dv] * siluf_(z)); }
    }
    float* sout = A->out + O_DNSP + ((size_t)(layer * NBATCH + b) * 4 + h) * 16384;
#pragma unroll
    for (int m8 = 0; m8 < 8; ++m8)
#pragma unroll
        for (int r = 0; r < 4; ++r) sout[(size_t)(16 * m8 + 4 * q4 + r) * 128 + 16 * w + l15] = S[m8][r];
    __syncthreads();
#undef D2_LOAD
#undef D2_STORE
}

constexpr size_t SSU_XT = 0, SSU_XTW = 8192, SSU_CUM = 16384, SSU_DT = 16640, SSU_BYTES = 16896;
constexpr size_t SSG_C = 0, SSG_B = 16384, SSG_BT = 32768, SSG_BYTES = 49152;
__device__ __forceinline__ void ssd_prep_unit(CA A, LAS unsigned char* lds, int layer, int unit, const int wv) {
    const int tid = tid_opaque(wv), lane = tid & 63;
    const int hd = unit & 15, bc = unit >> 4, b = bc >> 5, ck = bc & 31, g = hd >> 3, row0 = b * SEQ + ck * 64;
    const float* XBC = WSP(float, WS_XBC); const float* SC = WSP(float, WS_SCAL);
    unsigned char* rec = A->ws + WS_SSU + (size_t)unit * SSU_BYTES;
    LAS float* xl = (LAS float*)lds;
    LAS float* bl = xl + 64 * 65;
    LAS float* cums = bl + 64 * 129; LAS float* ws_ = cums + 64;
    const float a = -expf(IN_F(I_SSALOG)[layer * 16 + hd]);
    __syncthreads();
    if (tid < 64) { const float dt = SC[(size_t)(row0 + tid) * 32 + 8 + hd]; float c = dt * a;
#pragma unroll
        for (int o = 1; o < 64; o <<= 1) { const float t = __shfl_up(c, o); if (lane >= o) c += t; }
        cums[tid] = c; const float c63 = __shfl(c, 63); ws_[tid] = expf(c63 - c) * dt;
        ((float*)(rec + SSU_CUM))[tid] = c; ((float*)(rec + SSU_DT))[tid] = dt; }
    { const int s = tid >> 3, p8 = (tid & 7) * 8; const float* src = XBC + (size_t)(row0 + s) * 1536 + hd * 64 + p8; const f32x4 x0 = *(const f32x4*)src, x1 = *(const f32x4*)(src + 4);
#pragma unroll
      for (int e = 0; e < 4; ++e) { xl[s * 65 + p8 + e] = x0[e]; xl[s * 65 + p8 + 4 + e] = x1[e]; } }
    __syncthreads();
    { const int p = tid >> 3, s8 = (tid & 7) * 8; float xv[8], xw[8];
#pragma unroll
      for (int i = 0; i < 8; ++i) { xv[i] = xl[(s8 + i) * 65 + p]; xw[i] = xv[i] * ws_[s8 + i]; }
      v4u o; o.x = pk2(xv[0], xv[1]); o.y = pk2(xv[2], xv[3]); o.z = pk2(xv[4], xv[5]); o.w = pk2(xv[6], xv[7]); *(v4u*)(rec + SSU_XT + (size_t)(p * 64 + s8) * 2) = o;
      o.x = pk2(xw[0], xw[1]); o.y = pk2(xw[2], xw[3]); o.z = pk2(xw[4], xw[5]); o.w = pk2(xw[6], xw[7]); *(v4u*)(rec + SSU_XTW + (size_t)(p * 64 + s8) * 2) = o; }
    if ((hd & 7) == 0) {
        unsigned char* grec = A->ws + WS_SSG + (size_t)(bc * 2 + g) * SSG_BYTES;
        const int s = tid >> 3, n16 = (tid & 7) * 16; const float* src = XBC + (size_t)(row0 + s) * 1536 + 1024 + g * 128 + n16;
        f32x4 bv[4], cv[4];
#pragma unroll
        for (int i = 0; i < 4; ++i) { bv[i] = *(const f32x4*)(src + 4 * i); cv[i] = *(const f32x4*)(src + 256 + 4 * i); }
#pragma unroll
        for (int i = 0; i < 2; ++i) { v4u o; o.x = pk2(bv[2 * i][0], bv[2 * i][1]); o.y = pk2(bv[2 * i][2], bv[2 * i][3]); o.z = pk2(bv[2 * i + 1][0], bv[2 * i + 1][1]); o.w = pk2(bv[2 * i + 1][2], bv[2 * i + 1][3]);
            *(v4u*)(grec + SSG_B + (size_t)(s * 128 + n16 + 8 * i) * 2) = o;
            o.x = pk2(cv[2 * i][0], cv[2 * i][1]); o.y = pk2(cv[2 * i][2], cv[2 * i][3]); o.z = pk2(cv[2 * i + 1][0], cv[2 * i + 1][1]); o.w = pk2(cv[2 * i + 1][2], cv[2 * i + 1][3]);
            *(v4u*)(grec + SSG_C + (size_t)(s * 128 + n16 + 8 * i) * 2) = o; }
#pragma unroll
        for (int i = 0; i < 4; ++i)
#pragma unroll
            for (int e = 0; e < 4; ++e) bl[s * 129 + n16 + 4 * i + e] = bv[i][e];
        __syncthreads();
        const int n = tid >> 2, s16 = (tid & 3) * 16; float t[16];
#pragma unroll
        for (int i = 0; i < 16; ++i) t[i] = bl[(s16 + i) * 129 + n];
#pragma unroll
        for (int i = 0; i < 2; ++i) { v4u o; o.x = pk2(t[8 * i], t[8 * i + 1]); o.y = pk2(t[8 * i + 2], t[8 * i + 3]); o.z = pk2(t[8 * i + 4], t[8 * i + 5]); o.w = pk2(t[8 * i + 6], t[8 * i + 7]);
            *(v4u*)(grec + SSG_BT + (size_t)(n * 64 + s16 + 8 * i) * 2) = o; }
    }
}

constexpr int S2_C = 0, S2_B = 17408, S2_BT = 34816, S2_XT = 53248, S2_XTW = 62464, S2_WM = 71680, S2_HB = 80896, S2_YB = 98304, S2_CUM = 114688, S2_DT = 114944;
__device__ __forceinline__ void ssd_seq2(CA A, LAS unsigned char* lds, int layer, int unit, const int wv) {
    const int tid = tid_opaque(wv), lane = tid & 63, w = tid >> 6, q4 = lane >> 4, l15 = lane & 15;
    const int b = unit >> 4, hd = unit & 15, g = hd >> 3;
    const unsigned char* hrec = A->ws + WS_SSU + (size_t)((b * 32) * 16 + hd) * SSU_BYTES;
    const unsigned char* grec = A->ws + WS_SSG + (size_t)((b * 32) * 2 + g) * SSG_BYTES;
    const float* UF = WSP(float, WS_UF); float* SSQ = WSP(float, WS_SSQ); bf16* Og = WSP(bf16, WS_OBR) + (size_t)(3 + g) * MP * 512;
    const float Dk = IN_F(I_SSD)[layer * 16 + hd];
    LAS float* yb = (LAS float*)(lds + S2_YB); LAS float* cums = (LAS float*)(lds + S2_CUM); LAS float* dts = (LAS float*)(lds + S2_DT);
    f32x4 hacc[4];
#pragma unroll
    for (int i = 0; i < 4; ++i) hacc[i] = (f32x4){0.f, 0.f, 0.f, 0.f};
    v4u st[8]; float sc1 = 0.f;
#define S2_LOAD(ck_) do { const v4u* gg_ = (const v4u*)(grec + (size_t)(ck_) * 2 * SSG_BYTES); const v4u* hh_ = (const v4u*)(hrec + (size_t)(ck_) * 16 * SSU_BYTES); \
        st[0] = gg_[tid]; st[1] = gg_[tid + 512]; st[2] = gg_[tid + 1024]; st[3] = gg_[tid + 1536]; st[4] = gg_[tid + 2048]; st[5] = gg_[tid + 2560]; st[6] = hh_[tid]; st[7] = hh_[tid + 512]; \
        if (tid < 128) sc1 = ((const float*)(hrec + (size_t)(ck_) * 16 * SSU_BYTES + SSU_CUM))[tid]; } while (0)
#define S2_STORE() do { \
        *(LAS v4u*)(lds + S2_C + (tid >> 4) * 272 + (tid & 15) * 16) = st[0]; *(LAS v4u*)(lds + S2_C + (32 + (tid >> 4)) * 272 + (tid & 15) * 16) = st[1]; \
        *(LAS v4u*)(lds + S2_B + (tid >> 4) * 272 + (tid & 15) * 16) = st[2]; *(LAS v4u*)(lds + S2_B + (32 + (tid >> 4)) * 272 + (tid & 15) * 16) = st[3]; \
        *(LAS v4u*)(lds + S2_BT + (tid >> 3) * 144 + (tid & 7) * 16) = st[4]; *(LAS v4u*)(lds + S2_BT + (64 + (tid >> 3)) * 144 + (tid & 7) * 16) = st[5]; \
        *(LAS v4u*)(lds + S2_XT + (tid >> 3) * 144 + (tid & 7) * 16) = st[6]; *(LAS v4u*)(lds + S2_XTW + (tid >> 3) * 144 + (tid & 7) * 16) = st[7]; \
        if (tid < 128) cums[tid] = sc1; } while (0)
    S2_LOAD(0);
    const int tt = w >> 1, aoffC = l15 * 272 + 16 * q4, aoffS = l15 * 144 + 16 * q4;
    for (int ck = 0; ck < 32; ++ck) {
        const int row0 = b * SEQ + ck * 64;
        __syncthreads();
        S2_STORE();
        __syncthreads();
        if (ck + 1 < 32) S2_LOAD(ck + 1);
#pragma unroll
        for (int e2 = 0; e2 < 2; ++e2) { const int stl = 2 * (w & 1) + e2; f32x4 acc = {0.f, 0.f, 0.f, 0.f};
            if (stl <= tt) {
#pragma unroll
                for (int ks = 0; ks < 4; ++ks) acc = __builtin_amdgcn_mfma_f32_16x16x32_bf16(*(const LAS bf16x8*)(lds + S2_C + tt * 16 * 272 + aoffC + ks * 64), *(const LAS bf16x8*)(lds + S2_B + stl * 16 * 272 + aoffC + ks * 64), acc, 0, 0, 0); }
            const int s = 16 * stl + l15; const float cs = cums[s], ds = dts[s];
#pragma unroll
            for (int r = 0; r < 4; ++r) { const int t = 16 * tt + 4 * q4 + r; const float v = s <= t ? acc[r] * expf(cums[t] - cs) * ds : 0.f;
                *(LAS unsigned short*)(lds + S2_WM + t * 144 + s * 2) = (unsigned short)f2bf(v); } }
#pragma unroll
        for (int mt = 0; mt < 4; ++mt)
#pragma unroll
            for (int r = 0; r < 4; ++r) *(LAS unsigned short*)(lds + S2_HB + (16 * mt + 4 * q4 + r) * 272 + (16 * w + l15) * 2) = (unsigned short)f2bf(hacc[mt][r]);
        __syncthreads();
#pragma unroll
        for (int e2 = 0; e2 < 2; ++e2) { const int pt = 2 * (w & 1) + e2; f32x4 y = {0.f, 0.f, 0.f, 0.f};
#pragma unroll
            for (int ks = 0; ks < 4; ++ks) y = __builtin_amdgcn_mfma_f32_16x16x32_bf16(*(const LAS bf16x8*)(lds + S2_C + tt * 16 * 272 + aoffC + ks * 64), *(const LAS bf16x8*)(lds + S2_HB + pt * 16 * 272 + aoffC + ks * 64), y, 0, 0, 0);
#pragma unroll
            for (int r = 0; r < 4; ++r) y[r] *= expf(cums[16 * tt + 4 * q4 + r]);
#pragma unroll
            for (int ke = 0; ke < 2; ++ke) y = __builtin_amdgcn_mfma_f32_16x16x32_bf16(*(const LAS bf16x8*)(lds + S2_WM + tt * 16 * 144 + aoffS + ke * 64), *(const LAS bf16x8*)(lds + S2_XT + pt * 16 * 144 + aoffS + ke * 64), y, 0, 0, 0);
            const int p = 16 * pt + l15;
#pragma unroll
            for (int r = 0; r < 4; ++r) { const int t = 16 * tt + 4 * q4 + r; const float xv = bflo((unsigned)*(const LAS unsigned short*)(lds + S2_XT + p * 144 + t * 2)); yb[t * 64 + p] = y[r] + Dk * xv; } }
        { const float e63 = expf(cums[63]);
#pragma unroll
          for (int mt = 0; mt < 4; ++mt) { hacc[mt] = hacc[mt] * e63;
#pragma unroll
              for (int ke = 0; ke < 2; ++ke) hacc[mt] = __builtin_amdgcn_mfma_f32_16x16x32_bf16(*(const LAS bf16x8*)(lds + S2_XTW + mt * 16 * 144 + aoffS + ke * 64), *(const LAS bf16x8*)(lds + S2_BT + w * 16 * 144 + aoffS + ke * 64), hacc[mt], 0, 0, 0); } }
        __syncthreads();
        for (int t = w; t < 64; t += NWAVES) { const int row = row0 + t; const float z = UF[(size_t)row * UFW + UF_SSZ + hd * 64 + lane]; const float yg = yb[t * 64 + lane] * siluf_(z);
            const float ss = wave_sum(yg * yg); if (lane == 0) SSQ[(size_t)row * 16 + hd] = ss;
            Og[(size_t)row * 512 + (hd & 7) * 64 + lane] = (bf16)f2bf(yg); }
    }
    float* hout = A->out + O_SSHP + ((size_t)(layer * NBATCH + b) * 16 + hd) * 8192;
#pragma unroll
    for (int mt = 0; mt < 4; ++mt)
#pragma unroll
        for (int r = 0; r < 4; ++r) hout[(size_t)(16 * mt + 4 * q4 + r) * 128 + 16 * w + l15] = hacc[mt][r];
    __syncthreads();
#undef S2_LOAD
#undef S2_STORE
}

constexpr int KS_PITCH = 272, VT_PITCH = 136;
constexpr int ATT_KS = 0, ATT_VT = 64 * KS_PITCH;
__device__ __forceinline__ void attn_prompt_unit(CA A, LAS unsigned char* lds, int layer, int unit, const int wv) {
    const int tid = tid_opaque(wv), lane = tid & 63, wid = tid >> 6, r = lane & 31, hh = lane >> 5;
    const int qb = 7 - (unit >> 4), bh = unit & 15, b = bh >> 2, h = bh & 3;
    const int q0 = qb * 256 + wid * 32, qpos = q0 + r;
    const bf16* QKV = WSP(bf16, WS_QKV) + (size_t)(b * SEQ) * 1536;
    bf16x8 Qf[8];
    { const bf16* qrow = QKV + (size_t)qpos * 1536 + h * 128 + 8 * hh;
#pragma unroll
      for (int s = 0; s < 8; ++s) Qf[s] = *(const bf16x8*)(qrow + 16 * s); }
    f32x16 O[4];
#pragma unroll
    for (int d = 0; d < 4; ++d)
#pragma unroll
        for (int i = 0; i < 16; ++i) O[d][i] = 0.f;
    float R = 0.f;
    const float bias2 = IN_F(I_SBBIAS)[layer * 4 + h] * LOG2E;
    const int ntile = qb * 4 + 4, srow = tid >> 3, sch = tid & 7;
    LAS unsigned char* Ks = lds + ATT_KS; LAS unsigned char* Vt = lds + ATT_VT;
    v4u kreg[2], vreg[2];
    { const bf16* src = QKV + (size_t)((ntile - 1) * 64 + srow) * 1536 + h * 128 + sch * 8;
      kreg[0] = *(const v4u*)(src + 512); kreg[1] = *(const v4u*)(src + 512 + 64); vreg[0] = *(const v4u*)(src + 1024); vreg[1] = *(const v4u*)(src + 1024 + 64); }
    for (int kt = ntile - 1; kt >= 0; --kt) {
        __syncthreads();
#pragma unroll
        for (int i = 0; i < 2; ++i) { *(LAS v4u*)(Ks + srow * KS_PITCH + (sch + 8 * i) * 16) = kreg[i];
            LAS unsigned short* vt = (LAS unsigned short*)Vt + ((sch + 8 * i) * 8) * (VT_PITCH / 2) + srow;
            const unsigned w[4] = {vreg[i].x, vreg[i].y, vreg[i].z, vreg[i].w};
#pragma unroll
            for (int e = 0; e < 4; ++e) { vt[(2 * e) * (VT_PITCH / 2)] = (unsigned short)(w[e] & 0xffffu); vt[(2 * e + 1) * (VT_PITCH / 2)] = (unsigned short)(w[e] >> 16); } }
        __syncthreads();
        if (kt > 0) { const bf16* src = QKV + (size_t)((kt - 1) * 64 + srow) * 1536 + h * 128 + sch * 8;
            kreg[0] = *(const v4u*)(src + 512); kreg[1] = *(const v4u*)(src + 512 + 64); vreg[0] = *(const v4u*)(src + 1024); vreg[1] = *(const v4u*)(src + 1024 + 64); }
        if (kt * 64 > q0 + 30) continue;
        const bool diag = (kt * 64 + 63 >= q0);
        const int kbase = kt * 64 + 4 * hh;
        bf16x8 Pf[4];
#pragma unroll
        for (int sub = 1; sub >= 0; --sub) {
            f32x16 sa;
#pragma unroll
            for (int i = 0; i < 16; ++i) sa[i] = bias2;
#pragma unroll
            for (int s = 0; s < 8; ++s) { const bf16x8 a = *(const LAS bf16x8*)(Ks + (32 * sub + r) * KS_PITCH + (16 * s + 8 * hh) * 2);
                sa = __builtin_amdgcn_mfma_f32_32x32x16_bf16(a, Qf[s], sa, 0, 0, 0); }
            float sp[16], Gs[4], Gp[4];
#pragma unroll
            for (int i = 0; i < 16; ++i) { const float z = fminf(sa[i], 60.f); sa[i] = z; float s1 = lg2(1.0f + ex2(z));
                if (diag && (kbase + 32 * sub + 8 * (i >> 2) + (i & 3) >= qpos)) s1 = 0.f;
                sp[i] = s1; }
#pragma unroll
            for (int g = 0; g < 4; ++g) { Gs[g] = (sp[4 * g] + sp[4 * g + 1]) + (sp[4 * g + 2] + sp[4 * g + 3]); Gp[g] = __shfl_xor(Gs[g], 32); }
            float run = R;
#pragma unroll
            for (int g = 3; g >= 0; --g) { float a = run + (hh == 0 ? Gp[g] : 0.f);
#pragma unroll
                for (int e = 3; e >= 0; --e) { const int i = 4 * g + e; float pv = ex2(sa[i] - sp[i] - a);
                    if (diag && (kbase + 32 * sub + 8 * g + e >= qpos)) pv = 0.f;
                    a += sp[i]; sp[i] = pv; }
                run += Gs[g] + Gp[g]; }
            R = run;
#pragma unroll
            for (int q2 = 0; q2 < 2; ++q2) { const int bs = 8 * q2; v4u w;
                w.x = pk2(sp[bs + 0], sp[bs + 1]); w.y = pk2(sp[bs + 2], sp[bs + 3]); w.z = pk2(sp[bs + 4], sp[bs + 5]); w.w = pk2(sp[bs + 6], sp[bs + 7]);
                Pf[2 * sub + q2] = __builtin_bit_cast(bf16x8, w); }
        }
#pragma unroll
        for (int d = 0; d < 4; ++d)
#pragma unroll
            for (int s4 = 0; s4 < 4; ++s4) { const LAS unsigned char* vp = Vt + (32 * d + r) * VT_PITCH + (16 * s4 + 4 * hh) * 2;
                const v2u lo = *(const LAS v2u*)vp, hi = *(const LAS v2u*)(vp + 16); v4u w; w.x = lo.x; w.y = lo.y; w.z = hi.x; w.w = hi.y;
                O[d] = __builtin_amdgcn_mfma_f32_32x32x16_bf16(__builtin_bit_cast(bf16x8, w), Pf[s4], O[d], 0, 0, 0); }
    }
    bf16* orow = WSP(bf16, WS_OBR) + (size_t)2 * MP * 512 + (size_t)(b * SEQ + qpos) * 512 + h * 128 + 4 * hh;
#pragma unroll
    for (int d = 0; d < 4; ++d)
#pragma unroll
        for (int g = 0; g < 4; ++g) { v2u w; w.x = pk2(O[d][4 * g], O[d][4 * g + 1]); w.y = pk2(O[d][4 * g + 2], O[d][4 * g + 3]); *(v2u*)(orow + 32 * d + 8 * g) = w; }
}

__device__ __forceinline__ void attn_sample_unit(CA A, LAS unsigned char* lds, int layer, int unit, const int wv) {
    const int tid = tid_opaque(wv), lane = tid & 63, wid = tid >> 6, sb = unit >> 5, pg4 = unit & 31, hd = lane >> 4;
    const int lp = 4 * pg4 + (wid >> 1), phys = ((const int*)A->in[I_PT])[sb * NPAGES + lp];
    const size_t pbase = ((size_t)(layer * NPOOL + phys) * PAGE + (wid & 1) * 64) * 512 + lane * 8;
    const float* Kc = IN_F(I_CK) + pbase; const float* Vc = IN_F(I_CV) + pbase;
    const bf16* QKV = WSP(bf16, WS_QKV);
    float qf[4][8], O[4][8], R[4];
#pragma unroll
    for (int i = 0; i < 4; ++i) { const v4u w = *(const v4u*)(QKV + (size_t)(TP + sb * 4 + i) * 1536 + lane * 8);
        qf[i][0] = bflo(w.x); qf[i][1] = bfhi(w.x); qf[i][2] = bflo(w.y); qf[i][3] = bfhi(w.y); qf[i][4] = bflo(w.z); qf[i][5] = bfhi(w.z); qf[i][6] = bflo(w.w); qf[i][7] = bfhi(w.w);
        R[i] = 0.f;
#pragma unroll
        for (int j = 0; j < 8; ++j) O[i][j] = 0.f; }
    const float bias2 = IN_F(I_SBBIAS)[layer * 4 + hd] * LOG2E;
#pragma unroll 4
    for (int t = 63; t >= 0; --t) {
        const f32x4 k0 = *(const f32x4*)(Kc + (size_t)t * 512), k1 = *(const f32x4*)(Kc + (size_t)t * 512 + 4), v0 = *(const f32x4*)(Vc + (size_t)t * 512), v1 = *(const f32x4*)(Vc + (size_t)t * 512 + 4);
#pragma unroll
        for (int i = 0; i < 4; ++i) {
            float s = (qf[i][0] * k0[0] + qf[i][1] * k0[1]) + (qf[i][2] * k0[2] + qf[i][3] * k0[3]) + (qf[i][4] * k1[0] + qf[i][5] * k1[1]) + (qf[i][6] * k1[2] + qf[i][7] * k1[3]);
            s += __shfl_xor(s, 1); s += __shfl_xor(s, 2); s += __shfl_xor(s, 4); s += __shfl_xor(s, 8);
            const float z = fminf(s + bias2, 60.f), s1 = lg2(1.0f + ex2(z)), pv = ex2(z - s1 - R[i]); R[i] += s1;
#pragma unroll
            for (int e = 0; e < 4; ++e) { O[i][e] += pv * v0[e]; O[i][4 + e] += pv * v1[e]; } }
    }
    LAS float* Ow = (LAS float*)lds;
    LAS float* Rw = Ow + 8 * 4 * 512;
    __syncthreads();
#pragma unroll
    for (int i = 0; i < 4; ++i) { *(LAS f32x4*)(Ow + (wid * 4 + i) * 512 + lane * 8) = (f32x4){O[i][0], O[i][1], O[i][2], O[i][3]}; *(LAS f32x4*)(Ow + (wid * 4 + i) * 512 + lane * 8 + 4) = (f32x4){O[i][4], O[i][5], O[i][6], O[i][7]};
        if ((lane & 15) == 0) Rw[(wid * 4 + i) * 4 + hd] = R[i]; }
    __syncthreads();
    float* PART = WSP(float, WS_PART) + (size_t)unit * 2048; float* PR = WSP(float, WS_PR) + (size_t)unit * 16;
    for (int idx = tid; idx < 2048; idx += NTHR) { const int i = idx >> 9, c = idx & 511, hc = c >> 7; float acc = 0.f, racc = 0.f;
#pragma unroll
        for (int w = 7; w >= 0; --w) { acc += ex2(-racc) * Ow[(w * 4 + i) * 512 + c]; racc += Rw[(w * 4 + i) * 4 + hc]; }
        PART[idx] = acc; if ((c & 127) == 0) PR[i * 4 + hc] = racc; }
}
__device__ __forceinline__ void attn_sample_combine(CA A, int layer, const int wv) {
    const int tid = tid_opaque(wv), lane = tid & 63, gw = blk_opaque() * NWAVES + (tid >> 6), NGW = gridDim.x * NWAVES;
    const bf16* QKV = WSP(bf16, WS_QKV); const float* PART = WSP(float, WS_PART); const float* PR = WSP(float, WS_PR);
    const float* kn = A->out + O_KS + (size_t)layer * TS * 512; const float* vn = A->out + O_VS + (size_t)layer * TS * 512;
    bf16* O2 = WSP(bf16, WS_OBR) + (size_t)2 * MP * 512;
    for (int it = gw; it < TS * 4; it += NGW) { const int sb = it >> 4, i = (it >> 2) & 3, hd = it & 3, row = TP + sb * 4 + i, c = hd * 128 + 2 * lane;
        const unsigned qw = *(const unsigned*)(QKV + (size_t)row * 1536 + c); const float q0 = bflo(qw), q1 = bfhi(qw);
        const float bias2 = IN_F(I_SBBIAS)[layer * 4 + hd] * LOG2E; float o0 = 0.f, o1 = 0.f, racc = 0.f;
        for (int j = i - 1; j >= 0; --j) { const float* kr = kn + (size_t)(sb * 4 + j) * 512 + c; const float* vr = vn + (size_t)(sb * 4 + j) * 512 + c;
            const float z = fminf(wave_sum(q0 * kr[0] + q1 * kr[1]) + bias2, 60.f), s1 = lg2(1.0f + ex2(z)), pv = ex2(z - s1 - racc); racc += s1; o0 += pv * vr[0]; o1 += pv * vr[1]; }
        for (int u = 31; u >= 0; --u) { const float* pr = PART + ((size_t)(sb * 32 + u) * 4 + i) * 512 + c; const float sc = ex2(-racc); o0 += sc * pr[0]; o1 += sc * pr[1]; racc += PR[(size_t)(sb * 32 + u) * 16 + i * 4 + hd]; }
        *(unsigned*)(O2 + (size_t)row * 512 + c) = pk2(o0, o1); }
}

#ifndef MK_ONE_LAUNCH
#define MK_ONE_LAUNCH 1
#endif
constexpr int N_PHASES = 24;
__device__ __forceinline__ int queue_pop(unsigned* head, volatile LAS unsigned* slot, const int wv) {
    __syncthreads();
    if (tid_opaque(wv) == 0) *slot = __hip_atomic_fetch_add(head, 1u, __ATOMIC_RELAXED, __HIP_MEMORY_SCOPE_AGENT);
    __syncthreads();
    return (int)*slot;
}
__global__ void __launch_bounds__(NTHR, 2) mega(Args Araw) {
    extern __shared__ __attribute__((aligned(16))) unsigned char lds_raw[];
    LAS unsigned char* lds = (LAS unsigned char*)lds_raw;
    volatile LAS unsigned* MISC = (volatile LAS unsigned*)(lds + MISC_OFF);
    const int wv = __builtin_amdgcn_readfirstlane(threadIdx.x >> 6); const int tid = tid_opaque(wv), G = gridDim.x, blk = blk_opaque();
    if (tid < 16) MISC[tid] = 0u;
    __syncthreads();
    unsigned* ctl = (unsigned*)(Araw.ws + WS_CTL);
    XcdBarrier bar = xcd_barrier_post(ctl + CW_BAR + Araw.li * XCD_BAR_WORDS, MISC, tid);
    const int lo = Araw.ph_lo, hi = Araw.ph_hi;
#define IN(gp) (lo <= (gp) && (gp) < hi)
#define SEAM(gp) do { if (lo <= (gp) && (gp) + 1 < hi) xcd_barrier(bar, tid_opaque(wv)); } while (0)

    if (IN(0)) { CA A = args_opaque(); p0_prologue(A, lds, wv); }
    SEAM(0);
    if (IN(1)) { CA A = args_opaque(); norm1_phase(A, wv); }
    SEAM(1);
    for (int layer = 0; layer < DEPTH; ++layer) {
        const int gb = 1 + 11 * layer;
        if (IN(gb + 1)) { CA A = args_opaque();
            pg8::Gemm g{WSP(bf16, WS_H), WSP(bf16, WS_WIN) + (size_t)layer * NIN * DM, MP, NIN, DM}; pg8::StaticOrder S; S.init(MP, NIN, G, blk);
            EpiIn E{WSP(float, WS_UF), WSP(bf16, WS_QKV), WSP(bf16, WS_GATE), A->out + O_KP + (size_t)layer * TP * 512, A->out + O_VP + (size_t)layer * TP * 512,
                    A->out + O_KS + (size_t)layer * TS * 512, A->out + O_VS + (size_t)layer * TS * 512, 0.08838834764831845f * LOG2E};
            pg8::gemm_phase<EpiIn, pg8::StaticOrder, true, true>(lds, g, S, E, wv);
        }
        SEAM(gb + 1);
        if (IN(gb + 2)) { CA A = args_opaque(); prep_phase(A, layer, wv); }
        SEAM(gb + 2);
        if (IN(gb + 3)) { CA A = args_opaque();
            { unsigned* qh = ctl + CW_QUEUE + 64 * (layer * 4 + 3);
              for (;;) { const int u = queue_pop(qh, MISC + 4, wv); if (u >= 2048) break; ssd_prep_unit(A, lds, layer, u, wv); } }
            { unsigned* qh = ctl + CW_QUEUE + 64 * (layer * 4 + 2);
              for (;;) { const int u = queue_pop(qh, MISC + 4, wv); if (u >= 512) break; dn_chunk_unit(A, lds, layer, u, wv); } }
            { unsigned* qh = ctl + CW_QUEUE + 64 * (layer * 4 + 0);
              for (;;) { const int u = queue_pop(qh, MISC + 4, wv); if (u >= 128) break; attn_prompt_unit(A, lds, layer, u, wv); } }
        }
        SEAM(gb + 3);
        if (IN(gb + 4)) { CA A = args_opaque();
            for (int t = blk; t < 16; t += G) dn_seq2(A, lds, layer, t, wv);
            for (int t = blk; t < 80; t += G) if (t >= 16) ssd_seq2(A, lds, layer, t - 16, wv);
            for (int t = blk; t < 112; t += G) if (t >= 80) dn_seq(A, lds, layer, t - 80 + 16, wv);
            for (int t = blk; t < 240; t += G) if (t >= 112) ssd_seq(A, lds, layer, t - 112 + 64, wv);
            { unsigned* qh = ctl + CW_QUEUE + 64 * (layer * 4 + 1);
              for (;;) { const int u = queue_pop(qh, MISC + 4, wv); if (u >= 256) break; attn_sample_unit(A, lds, layer, u, wv); } }
        }
        SEAM(gb + 4);
        if (IN(gb + 5)) { CA A = args_opaque(); attn_sample_combine(A, layer, wv); }
        SEAM(gb + 5);
        if (IN(gb + 6)) { CA A = args_opaque();
            pg8::StaticOrder S; S.init(MP, DM, G, blk);
            const bf16* Wb = WSP(bf16, WS_WBR) + (size_t)layer * 5 * DM * 512; const bf16* Ob = WSP(bf16, WS_OBR);
            const bf16* GT = WSP(bf16, WS_GATE); const float* SQ = WSP(float, WS_SSQ); float* MG = WSP(float, WS_MG32); bf16* MB = WSP(bf16, WS_MGB);
            { pg8::Gemm g{Ob + (size_t)0 * MP * 512, Wb + (size_t)0 * DM * 512, MP, DM, 512}; EpiMerge<0> E{GT, SQ, MG, MB}; pg8::gemm_phase<EpiMerge<0>, pg8::StaticOrder, true, true>(lds, g, S, E, wv); }
            { pg8::Gemm g{Ob + (size_t)1 * MP * 512, Wb + (size_t)1 * DM * 512, MP, DM, 512}; EpiMerge<1> E{GT, SQ, MG, MB}; pg8::gemm_phase<EpiMerge<1>, pg8::StaticOrder, true, true>(lds, g, S, E, wv); }
            { pg8::Gemm g{Ob + (size_t)2 * MP * 512, Wb + (size_t)2 * DM * 512, MP, DM, 512}; EpiMerge<2> E{GT, SQ, MG, MB}; pg8::gemm_phase<EpiMerge<2>, pg8::StaticOrder, true, true>(lds, g, S, E, wv); }
            { pg8::Gemm g{Ob + (size_t)3 * MP * 512, Wb + (size_t)3 * DM * 512, MP, DM, 512}; EpiMerge<3> E{GT, SQ, MG, MB}; pg8::gemm_phase<EpiMerge<3>, pg8::StaticOrder, true, true>(lds, g, S, E, wv); }
            { pg8::Gemm g{Ob + (size_t)4 * MP * 512, Wb + (size_t)4 * DM * 512, MP, DM, 512}; EpiMerge<4> E{GT, SQ, MG, MB}; pg8::gemm_phase<EpiMerge<4>, pg8::StaticOrder, true, true>(lds, g, S, E, wv); }
        }
        SEAM(gb + 6);
        if (IN(gb + 7)) { CA A = args_opaque();
            pg8::Gemm g{WSP(bf16, WS_MGB), WSP(bf16, WS_WOUT) + (size_t)layer * DM * DM, MP, DM, DM}; pg8::StaticOrder S; S.init(MP, DM, G, blk);
            EpiF32 E{WSP(float, WS_MIX), DM}; pg8::gemm_phase<EpiF32, pg8::StaticOrder, true, true>(lds, g, S, E, wv);
        }
        SEAM(gb + 7);
        if (IN(gb + 8)) { CA A = args_opaque(); resid_phase(A, WSP(float, WS_MIX), IN_F(I_NMPOST) + layer * DM, IN_F(I_NLPRE) + layer * DM, layer == 0, wv); }
        SEAM(gb + 8);
        if (IN(gb + 9)) { CA A = args_opaque();
            pg8::Gemm g{WSP(bf16, WS_H), WSP(bf16, WS_WUP) + (size_t)layer * DFF * DM, MP, DFF, DM}; pg8::StaticOrder S; S.init(MP, DFF, G, blk);
            EpiRelu2 E{WSP(bf16, WS_F), DFF}; pg8::gemm_phase<EpiRelu2, pg8::StaticOrder, true, true>(lds, g, S, E, wv);
        }
        SEAM(gb + 9);
        if (IN(gb + 10)) { CA A = args_opaque();
            pg8::Gemm g{WSP(bf16, WS_F), WSP(bf16, WS_WDN) + (size_t)layer * DM * DFF, MP, DM, DFF}; pg8::StaticOrder S; S.init(MP, DM, G, blk);
            EpiF32 E{WSP(float, WS_FD), DM}; pg8::gemm_phase<EpiF32, pg8::StaticOrder, true, true>(lds, g, S, E, wv);
        }
        SEAM(gb + 10);
        if (IN(gb + 11)) { CA A = args_opaque(); resid_phase(A, WSP(float, WS_FD), IN_F(I_NLPOST) + layer * DM, layer + 1 < DEPTH ? IN_F(I_NMPRE) + (layer + 1) * DM : nullptr, false, wv); }
        SEAM(gb + 11);
    }
#undef IN
#undef SEAM
}

extern "C" void kernel_launch(void* const* d_in, const int* in_sizes, int n_in, void* d_out, int out_size, void* d_ws, size_t ws_size, hipStream_t stream) {
    static int grid = 0;
    if (grid == 0) {
        if (n_in != N_IN || (size_t)out_size != O_END || ws_size < WS_END) { fprintf(stderr, "kernel_launch: unexpected problem (n_in %d, out %d vs %zu, ws %zu vs %zu); nothing launched\n", n_in, out_size, (size_t)O_END, ws_size, (size_t)WS_END); grid = -1; return; }
        int dev = 0, cus = 0, per_cu = 0;
        if (hipGetDevice(&dev) != hipSuccess || hipDeviceGetAttribute(&cus, hipDeviceAttributeMultiprocessorCount, dev) != hipSuccess) { grid = -1; return; }
        if (hipFuncSetAttribute((const void*)mega, hipFuncAttributeMaxDynamicSharedMemorySize, LDS_BYTES) != hipSuccess) { fprintf(stderr, "kernel_launch: hipFuncSetAttribute failed\n"); grid = -1; return; }
        if (hipOccupancyMaxActiveBlocksPerMultiprocessor(&per_cu, (const void*)mega, NTHR, LDS_BYTES) != hipSuccess || per_cu < 1) fprintf(stderr, "kernel_launch: occupancy query says %d blocks per CU\n", per_cu);
        (void)hipGetLastError();
        grid = cus;
    }
    if (grid < 0) return;
    (void)in_sizes;
    hipMemsetAsync((char*)d_ws + WS_CTL, 0, CTL_BYTES, stream);
    Args a{};
    for (int i = 0; i < N_IN; ++i) a.in[i] = d_in[i];
    a.out = (float*)d_out; a.ws = (unsigned char*)d_ws; a.pad = 0;
#if MK_ONE_LAUNCH
    a.ph_lo = 0; a.ph_hi = N_PHASES; a.li = 0;
    hipLaunchKernelGGL(mega, dim3(grid), dim3(NTHR), LDS_BYTES, stream, a);
#else
    for (int gp = 0; gp < N_PHASES; ++gp) { a.ph_lo = gp; a.ph_hi = gp + 1; a.li = 0; hipLaunchKernelGGL(mega, dim3(grid), dim3(NTHR), LDS_BYTES, stream, a); }
#endif
}
```

```cpp
#include <hip/hip_runtime.h>
#include <cstdio>
#include <cstdint>
__device__ __forceinline__ int lane_opaque() { unsigned m = ~0u; asm volatile("" : "+s"(m)); return (int)__builtin_amdgcn_mbcnt_hi(m, __builtin_amdgcn_mbcnt_lo(m, 0u)); }
__device__ __forceinline__ int tid_opaque(int wv) { return wv * 64 + lane_opaque(); }
__device__ __forceinline__ int blk_opaque() { int t = blockIdx.x; asm volatile("" : "+s"(t)); return t; }
namespace pg8 {
#define PG8_LAS __attribute__((address_space(3)))
typedef unsigned short bf16_t;
typedef short bf16x8 __attribute__((ext_vector_type(8)));
typedef float f32x4 __attribute__((ext_vector_type(4)));
typedef unsigned u32x4 __attribute__((ext_vector_type(4)));
constexpr int BM = 256, BK = 64, HALF = 128, HTB = HALF * BK * 2  , STAGE_BYTES = 8 * HTB, NXCD = 8, WGM = 8;

__host__ __device__ __forceinline__ int lds_byte(int r, int c) { const int st = (r >> 4) * 2 + (c >> 5), rr = r & 15, cc = c & 31, ob = rr * 64 + cc * 2; return st * 1024 + (ob ^ (((ob >> 9) & 1) << 5)); }
__host__ __device__ __forceinline__ void stage_rc(int b, int& R, int& C) { const int st = b / 1024, sb = b % 1024, swz = sb ^ (((sb >> 9) & 1) << 5); R = (st >> 1) * 16 + swz / 64; C = (st & 1) * 32 + (swz % 64) / 2; }
__host__ __device__ __forceinline__ int perm32(int rho) { const int n = rho >> 4, i = rho & 15; return 8 * (i >> 2) + 4 * n + (i & 3); }

struct Unit { int pm, pn; };
struct Gemm { const bf16_t* A; const bf16_t* Bt; int M, N, K; };

struct StaticOrder {
    int nM, nN, nwg, G, c;
    __host__ __device__ void init(int M, int N, int G_, int c_) { nM = M / BM; nN = N / BM; nwg = nM * nN; G = G_; c = c_; }
    __host__ __device__ bool next(int i, Unit& u) const {
        const long L = (long)i * G + c; if (L >= nwg) return false;
        int wgid = (int)L; { const int q = nwg / NXCD, r = nwg % NXCD, xcd = wgid % NXCD, off = wgid / NXCD; wgid = (xcd < r ? xcd * (q + 1) : r * (q + 1) + (xcd - r) * q) + off; }
        const int nig = WGM * nN, gid = wgid / nig, fm = gid * WGM, gsz = (nM - fm) < WGM ? (nM - fm) : WGM;
        u.pm = fm + ((wgid % nig) % gsz); u.pn = (wgid % nig) / gsz; return true;
    }
    __device__ __forceinline__ void a_ready(const Unit&) const {}
    __device__ __forceinline__ void done(const Unit&) const {}
};
__device__ __forceinline__ unsigned cvt_pk_bf16(float lo, float hi) { unsigned r; asm volatile("v_cvt_pk_bf16_f32 %0, %1, %2" : "=v"(r) : "v"(lo), "v"(hi)); return r; }
typedef float f32x2 __attribute__((ext_vector_type(2)));
template <class Epi, class Sched, bool ALIGN_EPI = false, bool SP2 = false>
__device__ __forceinline__ void gemm_phase(PG8_LAS unsigned char* lds, const Gemm g, const Sched& S, const Epi& E, const int wv) {
    const int lane = lane_opaque(), tid = wv * 64 + lane, wid = wv, wr = wid >> 2, wc = wid & 3, fr = lane & 15, fq = lane >> 4;
    const int K = g.K, nt = K / BK;
    unsigned voffA[2], voffB[2];
#pragma unroll
    for (int i = 0; i < 2; ++i) { int R, C; stage_rc(tid * 16 + i * 8192, R, C); const int Rb = Epi::PERM ? ((R & ~31) + perm32(R & 31)) : R;
        voffA[i] = (unsigned)(R * K + C) * 2u; voffB[i] = (unsigned)(Rb * K + C) * 2u; }
    const size_t kstep = (size_t)(BK * 2);
    const size_t hstep = (size_t)HALF * K * 2;
    const size_t tstep = 2 * hstep;
    const unsigned ldsw = (unsigned)wid * 1024u;
    const int aoff = lds_byte(wr * 64 + fr, fq * 8), boff = lds_byte(wc * 32 + fr, fq * 8);
#define PG8_SA(b, h) (((b) * 2 + (h)) * HTB)
#define PG8_SB(b, h) ((4 + (b) * 2 + (h)) * HTB)
#define PG8_STAGE(bufoff, gbase, voff) do { _Pragma("unroll") for (int _i = 0; _i < 2; ++_i) \
        __builtin_amdgcn_global_load_lds((const unsigned*)((const char*)(gbase) + (voff)[_i]), (PG8_LAS unsigned*)(lds + (bufoff) + ldsw + _i * 8192), 16, 0, 0); } while (0)
#define PG8_LDA(dst, b, h) do { _Pragma("unroll") for (int m = 0; m < 4; ++m) _Pragma("unroll") for (int k = 0; k < 2; ++k) dst[m][k] = *(const PG8_LAS bf16x8*)(lds + PG8_SA(b, h) + aoff + m * 2048 + k * 1024); } while (0)
#define PG8_LDB(dst, b, h) do { _Pragma("unroll") for (int n = 0; n < 2; ++n) _Pragma("unroll") for (int k = 0; k < 2; ++k) dst[n][k] = *(const PG8_LAS bf16x8*)(lds + PG8_SB(b, h) + boff + n * 2048 + k * 1024); } while (0)
#define PG8_MMA(ai, bj, At, Bt) do { __builtin_amdgcn_s_setprio(1); _Pragma("unroll") for (int m = 0; m < 4; ++m) _Pragma("unroll") for (int n = 0; n < 2; ++n) _Pragma("unroll") for (int k = 0; k < 2; ++k) \
        acc[ai][bj][m][n] = __builtin_amdgcn_mfma_f32_16x16x32_bf16(Bt[n][k], At[m][k], acc[ai][bj][m][n], 0, 0, 0); __builtin_amdgcn_s_setprio(0); } while (0)
#define PG8_WAIT_V(n) asm volatile("s_waitcnt vmcnt(" #n ")" ::: "memory")
#define PG8_WAIT_L(n) asm volatile("s_waitcnt lgkmcnt(" #n ")" ::: "memory")
#define PG8_BAR __builtin_amdgcn_s_barrier()
#define PG8_SCHED __builtin_amdgcn_sched_barrier(0)
    Unit cur, nxt; int ui = 0;
    if (!S.next(0, cur)) return;
    f32x4 acc[2][2][4][2];
#pragma unroll
    for (int a = 0; a < 2; ++a)
#pragma unroll
        for (int b = 0; b < 2; ++b)
#pragma unroll
            for (int m = 0; m < 4; ++m)
#pragma unroll
                for (int n = 0; n < 2; ++n) acc[a][b][m][n] = (f32x4){0.f, 0.f, 0.f, 0.f};
    bf16x8 At[4][2], B0[2][2], B1[2][2];
    const char* cA = (const char*)g.A + (size_t)cur.pm * tstep; const char* cB = (const char*)g.Bt + (size_t)cur.pn * tstep;
    S.a_ready(cur);
    if constexpr (SP2) {
        PG8_STAGE(PG8_SB(0, 0), cB, voffB); PG8_STAGE(PG8_SB(0, 1), cB + hstep, voffB); PG8_STAGE(PG8_SA(0, 0), cA, voffA); PG8_STAGE(PG8_SA(0, 1), cA + hstep, voffA);
        if (wr == 1) PG8_BAR;
        PG8_WAIT_V(2); PG8_BAR;
        PG8_STAGE(PG8_SB(1, 0), cB + kstep, voffB); PG8_STAGE(PG8_SA(1, 0), cA + kstep, voffA); PG8_STAGE(PG8_SB(1, 1), cB + hstep + kstep, voffB);
        PG8_WAIT_V(6); PG8_BAR;
    } else {
        PG8_STAGE(PG8_SB(0, 0), cB, voffB); PG8_STAGE(PG8_SA(0, 0), cA, voffA); PG8_STAGE(PG8_SB(0, 1), cB + hstep, voffB); PG8_STAGE(PG8_SA(0, 1), cA + hstep, voffA);
        if (wr == 1) PG8_BAR;
        PG8_WAIT_V(4); PG8_BAR;
        PG8_STAGE(PG8_SB(1, 0), cB + kstep, voffB); PG8_STAGE(PG8_SA(1, 0), cA + kstep, voffA); PG8_STAGE(PG8_SB(1, 1), cB + hstep + kstep, voffB);
        PG8_WAIT_V(6); PG8_BAR;
    }
    for (;;) {
        const bool has_next = S.next(ui + 1, nxt);
        const char* nA = has_next ? (const char*)g.A + (size_t)nxt.pm * tstep : cA; const char* nB = has_next ? (const char*)g.Bt + (size_t)nxt.pn * tstep : cB;
        for (int t = 0; t < nt; t += 2) {
            const bool last = (t == nt - 2);
            const char* a1 = cA + (size_t)(t + 1) * kstep;
            const char* a2 = last ? nA : cA + (size_t)(t + 2) * kstep; const char* b2 = last ? nB : cB + (size_t)(t + 2) * kstep;
            const char* a3 = a2 + kstep; const char* b3 = b2 + kstep;
            if (last && has_next) S.a_ready(nxt);
            if constexpr (SP2) {
            PG8_LDB(B0, 0, 0); PG8_LDB(B1, 0, 1); PG8_SCHED; PG8_LDA(At, 0, 0); PG8_STAGE(PG8_SA(1, 1), a1 + hstep, voffA);
            PG8_WAIT_V(8); PG8_WAIT_L(0); PG8_BAR; PG8_MMA(0, 0, At, B0); PG8_MMA(0, 1, At, B1); PG8_BAR; PG8_SCHED;
            PG8_LDA(At, 0, 1); PG8_STAGE(PG8_SB(0, 0), b2, voffB); PG8_STAGE(PG8_SB(0, 1), b2 + hstep, voffB); PG8_STAGE(PG8_SA(0, 0), a2, voffA);
            PG8_WAIT_V(8); PG8_WAIT_L(0); PG8_BAR; PG8_MMA(1, 0, At, B0); PG8_MMA(1, 1, At, B1); PG8_BAR; PG8_SCHED;
            PG8_LDB(B0, 1, 0); PG8_LDB(B1, 1, 1); PG8_SCHED; PG8_LDA(At, 1, 0); PG8_STAGE(PG8_SA(0, 1), a2 + hstep, voffA);
            PG8_WAIT_V(8); PG8_WAIT_L(0); PG8_BAR; PG8_MMA(0, 0, At, B0); PG8_MMA(0, 1, At, B1); PG8_BAR; PG8_SCHED;
            PG8_LDA(At, 1, 1); PG8_STAGE(PG8_SB(1, 0), b3, voffB); PG8_STAGE(PG8_SB(1, 1), b3 + hstep, voffB); PG8_STAGE(PG8_SA(1, 0), a3, voffA);
            PG8_WAIT_V(8); PG8_WAIT_L(0); PG8_BAR; PG8_MMA(1, 0, At, B0); PG8_MMA(1, 1, At, B1); PG8_BAR; PG8_SCHED;
            } else {
            PG8_LDB(B0, 0, 0); PG8_SCHED; PG8_LDA(At, 0, 0); PG8_STAGE(PG8_SA(1, 1), a1 + hstep, voffA);
            PG8_WAIT_L(8); PG8_BAR; PG8_WAIT_L(0); PG8_MMA(0, 0, At, B0); PG8_BAR; PG8_SCHED;
            PG8_LDB(B1, 0, 1); PG8_STAGE(PG8_SB(0, 0), b2, voffB);
            PG8_BAR; PG8_WAIT_L(0); PG8_MMA(0, 1, At, B1); PG8_BAR;
            PG8_LDA(At, 0, 1); PG8_STAGE(PG8_SA(0, 0), a2, voffA);
            PG8_BAR; PG8_WAIT_L(0); PG8_MMA(1, 0, At, B0); PG8_BAR; PG8_SCHED;
            PG8_STAGE(PG8_SB(0, 1), b2 + hstep, voffB);
            PG8_WAIT_V(6); PG8_BAR; PG8_MMA(1, 1, At, B1); PG8_BAR;
            PG8_LDB(B0, 1, 0); PG8_SCHED; PG8_LDA(At, 1, 0); PG8_STAGE(PG8_SA(0, 1), a2 + hstep, voffA);
            PG8_WAIT_L(8); PG8_BAR; PG8_WAIT_L(0); PG8_MMA(0, 0, At, B0); PG8_BAR; PG8_SCHED;
            PG8_LDB(B1, 1, 1); PG8_STAGE(PG8_SB(1, 0), b3, voffB);
            PG8_BAR; PG8_WAIT_L(0); PG8_MMA(0, 1, At, B1); PG8_BAR;
            PG8_LDA(At, 1, 1); PG8_STAGE(PG8_SA(1, 0), a3, voffA);
            PG8_BAR; PG8_WAIT_L(0); PG8_MMA(1, 0, At, B0); PG8_BAR; PG8_SCHED;
            PG8_STAGE(PG8_SB(1, 1), b3 + hstep, voffB);
            PG8_WAIT_V(6); PG8_BAR; PG8_MMA(1, 1, At, B1); PG8_BAR;
            }
        }
        if constexpr (ALIGN_EPI) { if (wr == 0) PG8_BAR; }
        if constexpr (!Epi::AFTER_DRAIN) { E(acc, cur, wr, wc, fr, fq); S.done(cur); }
        if (!has_next) break;
#pragma unroll
        for (int a = 0; a < 2; ++a)
#pragma unroll
            for (int b = 0; b < 2; ++b)
#pragma unroll
                for (int m = 0; m < 4; ++m)
#pragma unroll
                    for (int n = 0; n < 2; ++n) acc[a][b][m][n] = (f32x4){0.f, 0.f, 0.f, 0.f};
        cur = nxt; cA = nA; cB = nB; ++ui;
        if constexpr (ALIGN_EPI) { if (wr == 1) PG8_BAR; }
    }
    PG8_WAIT_V(0);
    if constexpr (!ALIGN_EPI) { if (wr == 0) PG8_BAR; }
    PG8_BAR;
    if constexpr (Epi::AFTER_DRAIN) { E.fused(acc, cur, wr, wc, fr, fq, lds, wid, lane); S.done(cur); }
#undef PG8_SA
#undef PG8_SB
#undef PG8_STAGE
#undef PG8_LDA
#undef PG8_LDB
#undef PG8_MMA
#undef PG8_WAIT_V
#undef PG8_WAIT_L
#undef PG8_BAR
#undef PG8_SCHED
}
}

constexpr int DM = 2048, NBATCH = 4, SEQ = 2048, DEPTH = 2, DBATCH = 8, DSEQ = 4, PAST = 16384, PAGE = 128;
constexpr int TP = NBATCH * SEQ;
constexpr int TS = DBATCH * DSEQ;
constexpr int TT = TP + TS;
constexpr int MP = 8448;
constexpr int NPAGES = PAST / PAGE;
constexpr int NPOOL = 1280;
constexpr int POOLW = 512, DNC = 1536, SBW = 512, SSI = 1024, SSC = 1536, DFF = 8192;
constexpr int INCOLS = 14872, NIN = 15104;
constexpr int UFW = 5376;
constexpr int UF_POOL = 0, UF_DNQKV = 512, UF_DNZ = 2048, UF_SSZ = 2560, UF_XBC = 3584, UF_SMALL = 5120;
constexpr float RMS_EPS = 1e-6f;
constexpr float LOG2E = 1.4426950408889634f;
constexpr int NWAVES = 8, NTHR = 512;

constexpr size_t O_Y = 0;
constexpr size_t O_KP = O_Y + (size_t)TT * DM;
constexpr size_t O_VP = O_KP + (size_t)DEPTH * TP * 512;
constexpr size_t O_POOLP = O_VP + (size_t)DEPTH * TP * 512;
constexpr size_t O_DNCP = O_POOLP + (size_t)DEPTH * NBATCH * 15 * 512;
constexpr size_t O_DNSP = O_DNCP + (size_t)DEPTH * NBATCH * 3 * 1536;
constexpr size_t O_SSCP = O_DNSP + (size_t)DEPTH * NBATCH * 4 * 128 * 128;
constexpr size_t O_SSHP = O_SSCP + (size_t)DEPTH * NBATCH * 3 * 1536;
constexpr size_t O_KS = O_SSHP + (size_t)DEPTH * NBATCH * 16 * 64 * 128;
constexpr size_t O_VS = O_KS + (size_t)DEPTH * TS * 512;
constexpr size_t O_POOLS = O_VS + (size_t)DEPTH * TS * 512;
constexpr size_t O_DNCS = O_POOLS + (size_t)DEPTH * DBATCH * 15 * 512;
constexpr size_t O_DNSS = O_DNCS + (size_t)DEPTH * DBATCH * 3 * 1536;
constexpr size_t O_SSCS = O_DNSS + (size_t)DEPTH * DBATCH * 4 * 128 * 128;
constexpr size_t O_SSHS = O_SSCS + (size_t)DEPTH * DBATCH * 3 * 1536;
constexpr size_t O_END = O_SSHS + (size_t)DEPTH * DBATCH * 16 * 64 * 128;

constexpr size_t al256(size_t x) { return (x + 255) & ~(size_t)255; }
constexpr size_t WS_CTL = 0, CTL_BYTES = 1u << 20;
constexpr size_t SZ_WIN = (size_t)NIN * DM * 2, SZ_WBR = (size_t)5 * DM * 512 * 2, SZ_WOUT = (size_t)DM * DM * 2, SZ_WUP = (size_t)DFF * DM * 2, SZ_WDN = (size_t)DM * DFF * 2;
constexpr size_t WS_WIN = WS_CTL + CTL_BYTES;
constexpr size_t WS_WBR = WS_WIN + 2 * SZ_WIN;
constexpr size_t WS_WOUT = WS_WBR + 2 * SZ_WBR;
constexpr size_t WS_WUP = WS_WOUT + 2 * SZ_WOUT;
constexpr size_t WS_WDN = WS_WUP + 2 * SZ_WUP;
constexpr size_t WS_H = WS_WDN + 2 * SZ_WDN;
constexpr size_t WS_UF = WS_H + (size_t)MP * DM * 2;
constexpr size_t WS_QKV = WS_UF + (size_t)MP * UFW * 4;
constexpr size_t WS_GATE = WS_QKV + (size_t)MP * 1536 * 2;
constexpr size_t WS_DNQ = WS_GATE + (size_t)MP * 8192 * 2;
constexpr size_t WS_XBC = WS_DNQ + (size_t)MP * 1536 * 4;
constexpr size_t WS_SCAL = WS_XBC + (size_t)MP * 1536 * 4;
constexpr size_t WS_OBR = WS_SCAL + (size_t)MP * 32 * 4;
constexpr size_t SZ_OBR = (size_t)MP * 512 * 2;
constexpr size_t WS_SSQ = WS_OBR + 5 * SZ_OBR;
constexpr size_t WS_MG32 = WS_SSQ + (size_t)MP * 32 * 4;
constexpr size_t WS_MGB = WS_MG32 + (size_t)MP * DM * 4;
constexpr size_t WS_MIX = WS_MGB + (size_t)MP * DM * 2;
constexpr size_t WS_F = WS_MIX + (size_t)MP * DM * 4;
constexpr size_t WS_FD = WS_F + (size_t)MP * DFF * 2;
constexpr size_t WS_PART = WS_FD + (size_t)MP * DM * 4;
constexpr size_t WS_PR = WS_PART + (size_t)256 * 2048 * 4;
constexpr size_t WS_DNU = WS_PR + (size_t)256 * 16 * 4;
constexpr size_t WS_SSU = WS_DNU + (size_t)512 * 90368;
constexpr size_t WS_SSG = WS_SSU + (size_t)2048 * 16896;
constexpr size_t WS_END = WS_SSG + (size_t)256 * 49152;
static_assert(WS_WIN % 256 == 0 && WS_H % 256 == 0 && WS_UF % 256 == 0 && WS_OBR % 256 == 0 && WS_MG32 % 256 == 0 && WS_PART % 256 == 0, "ws alignment");

constexpr int CW_QUEUE = 64;
constexpr int CW_BAR = 4096;

constexpr int LDS_BYTES = 147456;
constexpr int RING_BYTES = 131072;
constexpr int MISC_OFF = RING_BYTES;

#define GAS __attribute__((address_space(1)))
#define LAS __attribute__((address_space(3)))
typedef unsigned short bf16;
typedef unsigned v4u __attribute__((ext_vector_type(4)));
typedef unsigned v2u __attribute__((ext_vector_type(2)));
typedef float f32x4 __attribute__((ext_vector_type(4)));
typedef float f32x2 __attribute__((ext_vector_type(2)));
typedef float f32x16 __attribute__((ext_vector_type(16)));
typedef short bf16x8 __attribute__((ext_vector_type(8)));
__device__ __forceinline__ unsigned f2bf(float f) { unsigned u = __builtin_bit_cast(unsigned, f); return (u + 0x7fffu + ((u >> 16) & 1u)) >> 16; }
__device__ __forceinline__ unsigned pk2(float lo, float hi) { return f2bf(lo) | (f2bf(hi) << 16); }
__device__ __forceinline__ float bflo(unsigned w) { return __builtin_bit_cast(float, w << 16); }
__device__ __forceinline__ float bfhi(unsigned w) { return __builtin_bit_cast(float, w & 0xffff0000u); }
__device__ __forceinline__ float wave_sum(float v) {
#pragma unroll
    for (int o = 1; o < 64; o <<= 1) v += __shfl_xor(v, o);
    return v;
}
__device__ __forceinline__ float row16_sum(float x) {
    x += __builtin_bit_cast(float, __builtin_amdgcn_update_dpp(0, __builtin_bit_cast(int, x), 0x128, 0xf, 0xf, false));
    x += __builtin_bit_cast(float, __builtin_amdgcn_update_dpp(0, __builtin_bit_cast(int, x), 0x124, 0xf, 0xf, false));
    x += __builtin_bit_cast(float, __builtin_amdgcn_update_dpp(0, __builtin_bit_cast(int, x), 0x122, 0xf, 0xf, false));
    x += __builtin_bit_cast(float, __builtin_amdgcn_update_dpp(0, __builtin_bit_cast(int, x), 0x121, 0xf, 0xf, false));
    return x;
}
__device__ __forceinline__ float sigmoidf_(float x) { return 1.0f / (1.0f + __expf(-x)); }
__device__ __forceinline__ float siluf_(float x) { return x / (1.0f + __expf(-x)); }
__device__ __forceinline__ float softplusf_(float x) { return x > 20.f ? x : log1pf(expf(x)); }
__device__ __forceinline__ float ex2(float x) { return __builtin_amdgcn_exp2f(x); }
__device__ __forceinline__ float lg2(float x) { return __builtin_amdgcn_logf(x); }
#define XB_TMO      128
#define XB_XCNT(j)  (256  + 64 * (j))
#define XB_XSUB(j)  (1280 + 64 * (j))
#define XB_XGEN(j)  (2304 + 64 * (j))
#define XB_TOP      3328
#define XB_TOPGEN   3392
#define XCD_BAR_WORDS 3456
#define XB_SPIN_CAP (1u << 18)

__device__ __forceinline__ unsigned xb_ld(unsigned* p)              { return __hip_atomic_load(p, __ATOMIC_RELAXED, __HIP_MEMORY_SCOPE_AGENT); }
__device__ __forceinline__ unsigned xb_add(unsigned* p, unsigned v) { return __hip_atomic_fetch_add(p, v, __ATOMIC_RELAXED, __HIP_MEMORY_SCOPE_AGENT); }
__device__ __forceinline__ unsigned xb_xcc_id() { return (unsigned)__builtin_amdgcn_s_getreg((3 << 11) | 20) & 0xFu; }
#define XB_SPIN(cond, bar) do { unsigned _sp = 0; while (cond) { __builtin_amdgcn_s_sleep(1); \
    if ((++_sp & 255u) == 0u) { if (xb_ld(&(bar)[XB_TMO])) break; if (_sp > XB_SPIN_CAP) { atomicAdd(&(bar)[XB_TMO], 1u); break; } } } } while (0)

struct XcdBarrier {
    unsigned* bar; unsigned x;
    volatile LAS unsigned* st;
};

__device__ __forceinline__ XcdBarrier xcd_barrier_post(unsigned* bar, volatile LAS unsigned* st, const int tid) {
    XcdBarrier b; b.bar = bar; b.x = xb_xcc_id(); b.st = st;
    if (tid == 0) (void)xb_add(&bar[XB_XCNT(b.x)], 1u);
    return b;
}
__device__ __forceinline__ void xcd_barrier_complete(unsigned* bar, unsigned x, unsigned& nloc, unsigned& nx) {
    const unsigned G = gridDim.x * gridDim.y * gridDim.z;
    unsigned sum, cnt, mine, sp = 0u;
    for (;;) {
        sum = 0u; cnt = 0u; mine = 0u;
#pragma unroll
        for (unsigned j = 0; j < 16; ++j) { const unsigned c = xb_ld(&bar[XB_XCNT(j)]); sum += c; cnt += (c > 0u) ? 1u : 0u; mine = (j == x) ? c : mine; }
        if (sum == G) break;
        __builtin_amdgcn_s_sleep(1);
        if ((++sp & 255u) == 0u) { if (xb_ld(&bar[XB_TMO])) break; if (sp > XB_SPIN_CAP) { atomicAdd(&bar[XB_TMO], 1u); break; } }
    }
    nloc = mine > 0u ? mine : 1u; nx = cnt > 0u ? cnt : 1u;
}

__device__ __forceinline__ void xcd_barrier(const XcdBarrier& b, const int tid) {
    asm volatile("s_waitcnt vmcnt(0)" ::: "memory");
    __syncthreads();
    if (tid == 0) {
        unsigned* bar = b.bar;
        __builtin_amdgcn_s_waitcnt(0);
        unsigned nloc = b.st[0], nx = b.st[1];
        if (nloc == 0u) { xcd_barrier_complete(bar, b.x, nloc, nx); b.st[0] = nloc; b.st[1] = nx; }
        const unsigned old = xb_add(&bar[XB_XSUB(b.x)], 1u);
        const unsigned gen = old / nloc;
        if (old + 1u == (gen + 1u) * nloc) {
            __builtin_amdgcn_fence(__ATOMIC_RELEASE, "agent");
            asm volatile("s_waitcnt vmcnt(0)" ::: "memory");
            const unsigned og = xb_add(&bar[XB_TOP], 1u);
            const unsigned tg = og / nx;
            if (og + 1u == (tg + 1u) * nx) xb_add(&bar[XB_TOPGEN], 1u);
            else XB_SPIN(xb_ld(&bar[XB_TOPGEN]) == tg, bar);
            __builtin_amdgcn_fence(__ATOMIC_ACQUIRE, "agent");
            xb_add(&bar[XB_XGEN(b.x)], 1u);
            asm volatile("s_waitcnt vmcnt(0)" ::: "memory");
        } else {
            XB_SPIN(xb_ld(&bar[XB_XGEN(b.x)]) == gen, bar);
            __builtin_amdgcn_fence(__ATOMIC_ACQUIRE, "agent");
            asm volatile("s_waitcnt vmcnt(0)" ::: "memory");
        }
    }
    __syncthreads();
}

enum { I_XP = 0, I_XS, I_CK, I_CV, I_SPOOL, I_SDNC, I_SDNS, I_SSSC, I_SSSH, I_PT, I_NMPRE, I_NMPOST, I_NLPRE, I_NLPOST, I_WIN, I_POOLW, I_POOLSC, I_DNCW, I_DNALOG, I_DNDTB, I_DNNW, I_SBBIAS,
       I_SSCW, I_SSCB, I_SSALOG, I_SSDTB, I_SSD, I_SSNW, I_WBR, I_WOUT, I_WUP, I_WDN, N_IN };
struct Args { const void* in[N_IN]; float* out; unsigned char* ws; int ph_lo, ph_hi, li, pad; };
#define IN_F(i) ((const float*)A->in[i])
#define WSP(T, off) ((T*)(A->ws + (off)))
typedef const __attribute__((opencl_constant)) Args* CA;
__device__ __forceinline__ CA args_opaque() { auto p = __builtin_amdgcn_kernarg_segment_ptr(); asm volatile("" : "+s"(p)); return (CA)p; }

struct EpiIn {
    static constexpr bool PERM = true, AFTER_DRAIN = false;
    float* UF; bf16* QKV; bf16* GATE; float *kp, *vp, *ks, *vs; float qscale;
    __device__ __forceinline__ void operator()(const f32x4 (&acc)[2][2][4][2], const pg8::Unit& u, int wr, int wc, int fr, int fq) const {
        const int pn = u.pn, row0 = u.pm * 256 + wr * 64 + fr, cl = wc * 32 + 8 * fq;
        if (pn < 10 || (pn >= 16 && pn < 26) || pn == 58) {
            const int col0 = pn * 256 + (pn < 10 ? 0 : (pn < 26 ? -1536 : -9728)) + cl;
#pragma unroll
            for (int ai = 0; ai < 2; ++ai)
#pragma unroll
                for (int m = 0; m < 4; ++m) { float* rowp = UF + (size_t)(row0 + ai * 128 + m * 16) * UFW + col0;
#pragma unroll
                    for (int bj = 0; bj < 2; ++bj) { *(f32x4*)(rowp + bj * 128) = acc[ai][bj][m][0]; *(f32x4*)(rowp + bj * 128 + 4) = acc[ai][bj][m][1]; } }
        } else if (pn < 16) {
            const int which = (pn - 10) >> 1, c512 = ((pn - 10) & 1) * 256 + cl; const float sc = which == 0 ? qscale : 1.f;
#pragma unroll
            for (int ai = 0; ai < 2; ++ai)
#pragma unroll
                for (int m = 0; m < 4; ++m) { const int r = row0 + ai * 128 + m * 16; bf16* rowp = QKV + (size_t)r * 1536 + which * 512 + c512;
                    float* fo = nullptr;
                    if (which) { if (r < TP) fo = (which == 1 ? kp : vp) + (size_t)r * 512 + c512; else if (r < TT) fo = (which == 1 ? ks : vs) + (size_t)(r - TP) * 512 + c512; }
#pragma unroll
                    for (int bj = 0; bj < 2; ++bj) { const f32x4 v0 = acc[ai][bj][m][0], v1 = acc[ai][bj][m][1];
                        v4u w; w.x = pk2(v0[0] * sc, v0[1] * sc); w.y = pk2(v0[2] * sc, v0[3] * sc); w.z = pk2(v1[0] * sc, v1[1] * sc); w.w = pk2(v1[2] * sc, v1[3] * sc);
                        *(v4u*)(rowp + bj * 128) = w;
                        if (fo) { *(f32x4*)(fo + bj * 128) = v0; *(f32x4*)(fo + bj * 128 + 4) = v1; } } }
        } else {
            const int col0 = (pn - 26) * 256 + cl;
#pragma unroll
            for (int ai = 0; ai < 2; ++ai)
#pragma unroll
                for (int m = 0; m < 4; ++m) { bf16* rowp = GATE + (size_t)(row0 + ai * 128 + m * 16) * 8192 + col0;
#pragma unroll
                    for (int bj = 0; bj < 2; ++bj) { const f32x4 v0 = acc[ai][bj][m][0], v1 = acc[ai][bj][m][1];
                        v4u w; w.x = pk2(sigmoidf_(v0[0]), sigmoidf_(v0[1])); w.y = pk2(sigmoidf_(v0[2]), sigmoidf_(v0[3])); w.z = pk2(sigmoidf_(v1[0]), sigmoidf_(v1[1])); w.w = pk2(sigmoidf_(v1[2]), sigmoidf_(v1[3]));
                        *(v4u*)(rowp + bj * 128) = w; } }
        }
    }
};
template <int S> struct EpiMerge {
    static constexpr bool PERM = true, AFTER_DRAIN = false;
    const bf16* GATE; const float* SSQ; float* MG32; bf16* MGB;
    __device__ __forceinline__ void operator()(const f32x4 (&acc)[2][2][4][2], const pg8::Unit& u, int wr, int wc, int fr, int fq) const {
        const int row0 = u.pm * 256 + wr * 64 + fr, col0 = u.pn * 256 + wc * 32 + 8 * fq; constexpr int GS = S < 3 ? S : 3;
#pragma unroll
        for (int ai = 0; ai < 2; ++ai)
#pragma unroll
            for (int m = 0; m < 4; ++m) { const int r = row0 + ai * 128 + m * 16; float rs = 1.f;
                if (S >= 3) { const f32x4* sq = (const f32x4*)(SSQ + (size_t)r * 32 + 16 * (S - 3)); const f32x4 q0 = sq[0], q1 = sq[1], q2 = sq[2], q3 = sq[3];
                    const float ss = ((q0[0] + q0[1]) + (q0[2] + q0[3]) + (q1[0] + q1[1]) + (q1[2] + q1[3])) + ((q2[0] + q2[1]) + (q2[2] + q2[3]) + (q3[0] + q3[1]) + (q3[2] + q3[3])); rs = 1.0f / sqrtf(ss * (1.0f / 512.0f) + RMS_EPS); }
#pragma unroll
                for (int bj = 0; bj < 2; ++bj) { const size_t o = (size_t)r * DM + col0 + bj * 128;
                    const v4u g = *(const v4u*)(GATE + (size_t)r * 8192 + GS * 2048 + col0 + bj * 128);
                    f32x4 v0 = acc[ai][bj][m][0], v1 = acc[ai][bj][m][1];
                    v0[0] *= bflo(g.x) * rs; v0[1] *= bfhi(g.x) * rs; v0[2] *= bflo(g.y) * rs; v0[3] *= bfhi(g.y) * rs;
                    v1[0] *= bflo(g.z) * rs; v1[1] *= bfhi(g.z) * rs; v1[2] *= bflo(g.w) * rs; v1[3] *= bfhi(g.w) * rs;
                    if (S > 0) { v0 += *(const f32x4*)(MG32 + o); v1 += *(const f32x4*)(MG32 + o + 4); }
                    if (S < 4) { *(f32x4*)(MG32 + o) = v0; *(f32x4*)(MG32 + o + 4) = v1; }
                    else { v4u w; w.x = pk2(v0[0], v0[1]); w.y = pk2(v0[2], v0[3]); w.z = pk2(v1[0], v1[1]); w.w = pk2(v1[2], v1[3]); *(v4u*)(MGB + o) = w; } } }
    }
};
struct EpiF32 {
    static constexpr bool PERM = true, AFTER_DRAIN = false;
    float* C; int ldc;
    __device__ __forceinline__ void operator()(const f32x4 (&acc)[2][2][4][2], const pg8::Unit& u, int wr, int wc, int fr, int fq) const {
        const int row0 = u.pm * 256 + wr * 64 + fr, col0 = u.pn * 256 + wc * 32 + 8 * fq;
#pragma unroll
        for (int ai = 0; ai < 2; ++ai)
#pragma unroll
            for (int m = 0; m < 4; ++m) { float* rowp = C + (size_t)(row0 + ai * 128 + m * 16) * ldc + col0;
#pragma unroll
                for (int bj = 0; bj < 2; ++bj) { *(f32x4*)(rowp + bj * 128) = acc[ai][bj][m][0]; *(f32x4*)(rowp + bj * 128 + 4) = acc[ai][bj][m][1]; } }
    }
};
struct EpiRelu2 {
    static constexpr bool PERM = true, AFTER_DRAIN = false;
    bf16* O; int ldc;
    __device__ __forceinline__ void operator()(const f32x4 (&acc)[2][2][4][2], const pg8::Unit& u, int wr, int wc, int fr, int fq) const {
        const int row0 = u.pm * 256 + wr * 64 + fr, col0 = u.pn * 256 + wc * 32 + 8 * fq;
#pragma unroll
        for (int ai = 0; ai < 2; ++ai)
#pragma unroll
            for (int m = 0; m < 4; ++m) { bf16* rowp = O + (size_t)(row0 + ai * 128 + m * 16) * ldc + col0;
#pragma unroll
                for (int bj = 0; bj < 2; ++bj) { f32x4 v0 = acc[ai][bj][m][0], v1 = acc[ai][bj][m][1];
#pragma unroll
                    for (int e = 0; e < 4; ++e) { const float a = fmaxf(v0[e], 0.f), b = fmaxf(v1[e], 0.f); v0[e] = a * a; v1[e] = b * b; }
                    v4u w; w.x = pk2(v0[0], v0[1]); w.y = pk2(v0[2], v0[3]); w.z = pk2(v1[0], v1[1]); w.w = pk2(v1[2], v1[3]); *(v4u*)(rowp + bj * 128) = w; } }
    }
};

__device__ __forceinline__ int win_src_col(int n) {
    if (n < 2560) return n;
    if (n < 6656) return n + 8;
    if (n < 14848) return n + 24;
    if (n < 14856) return n - 14848 + 2560;
    if (n < 14872) return n - 14856 + 6664;
    return -1;
}
template <int MODE>
__device__ __forceinline__ void transpose_item(const float* W, int ldw, int K, bf16* WT, int n0, int k0, const float* kscale, LAS float* scr, int lane) {
    const int n = n0 + (lane & 31); const int sc = MODE ? win_src_col(n) : n;
#pragma unroll 8
    for (int i = 0; i < 32; ++i) { const int kk = 2 * i + (lane >> 5); float v = sc >= 0 ? W[(size_t)(k0 + kk) * ldw + sc] : 0.f; if (kscale) v *= kscale[k0 + kk]; scr[kk * 33 + (lane & 31)] = v; }
    asm volatile("s_waitcnt lgkmcnt(0)" ::: "memory");
    const int c = lane & 7;
#pragma unroll
    for (int j = 0; j < 4; ++j) { const int nn = (lane >> 3) + 8 * j; const LAS float* s = scr + (8 * c) * 33 + nn;
        v4u o; o.x = pk2(s[0 * 33], s[1 * 33]); o.y = pk2(s[2 * 33], s[3 * 33]); o.z = pk2(s[4 * 33], s[5 * 33]); o.w = pk2(s[6 * 33], s[7 * 33]);
        *(v4u*)(WT + (size_t)(n0 + nn) * K + k0 + 8 * c) = o; }
    asm volatile("s_waitcnt lgkmcnt(0)" ::: "memory");
}
__device__ __forceinline__ void p0_prologue(CA A, LAS unsigned char* lds, const int wv) {
    const int tid = tid_opaque(wv), lane = tid & 63, wave = tid >> 6, G = gridDim.x;
    LAS float* scr = (LAS float*)(lds + wave * 8704);
    const int gw = blk_opaque() * NWAVES + wave, NGW = G * NWAVES;
    constexpr int I_IN = (NIN / 32) * (DM / 64), I_BR = (DM / 32) * (512 / 64), I_OUT = (DM / 32) * (DM / 64), I_UP = (DFF / 32) * (DM / 64), I_DN = (DM / 32) * (DFF / 64);
    constexpr int PER_LAYER = I_IN + 4 * I_BR + I_OUT + I_UP + I_DN;
    for (int it = gw; it < 2 * PER_LAYER; it += NGW) {
        const int L = it / PER_LAYER; int r = it % PER_LAYER;
        if (r < I_IN) { const int nb = r % (NIN / 32), kb = r / (NIN / 32);
            transpose_item<1>(IN_F(I_WIN) + (size_t)L * DM * INCOLS, INCOLS, DM, WSP(bf16, WS_WIN) + (size_t)L * NIN * DM, nb * 32, kb * 64, nullptr, scr, lane); continue; }
        r -= I_IN;
        if (r < 4 * I_BR) { const int s = 1 + r / I_BR, q = r % I_BR, nb = q % (DM / 32), kb = q / (DM / 32);
            transpose_item<0>(IN_F(I_WBR) + ((size_t)L * 2560 + 512 * s) * DM, DM, 512, WSP(bf16, WS_WBR) + (size_t)(L * 5 + s) * DM * 512, nb * 32, kb * 64,
                              s >= 3 ? IN_F(I_SSNW) + L * 1024 + (s - 3) * 512 : nullptr, scr, lane); continue; }
        r -= 4 * I_BR;
        if (r < I_OUT) { const int nb = r % (DM / 32), kb = r / (DM / 32);
            transpose_item<0>(IN_F(I_WOUT) + (size_t)L * DM * DM, DM, DM, WSP(bf16, WS_WOUT) + (size_t)L * DM * DM, nb * 32, kb * 64, nullptr, scr, lane); continue; }
        r -= I_OUT;
        if (r < I_UP) { const int nb = r % (DFF / 32), kb = r / (DFF / 32);
            transpose_item<0>(IN_F(I_WUP) + (size_t)L * DM * DFF, DFF, DM, WSP(bf16, WS_WUP) + (size_t)L * DFF * DM, nb * 32, kb * 64, nullptr, scr, lane); continue; }
        r -= I_UP;
        { const int nb = r % (DM / 32), kb = r / (DM / 32);
            transpose_item<0>(IN_F(I_WDN) + (size_t)L * DFF * DM, DM, DFF, WSP(bf16, WS_WDN) + (size_t)L * DM * DFF, nb * 32, kb * 64, nullptr, scr, lane); }
    }
    for (int idx = blk_opaque() * NTHR + tid; idx < 2 * DM * 64; idx += G * NTHR) {
        const int L = idx / (DM * 64), q = idx % (DM * 64), n = q & (DM - 1), kc = q >> 11, k0 = kc * 8, g = k0 >> 7, c0 = k0 & 127;
        const float* pw = IN_F(I_POOLW) + ((size_t)(L * 4 + g) * 128 + c0) * 128; const float* psc = IN_F(I_POOLSC) + L * 512 + g * 128;
        const float* wb = IN_F(I_WBR) + ((size_t)L * 2560 + g * 128) * DM + n;
        float acc[8] = {0.f, 0.f, 0.f, 0.f, 0.f, 0.f, 0.f, 0.f};
        for (int d = 0; d < 128; ++d) { const float wv = wb[(size_t)d * DM] * psc[d];
#pragma unroll
            for (int i = 0; i < 8; ++i) acc[i] += pw[i * 128 + d] * wv; }
        v4u o; o.x = pk2(acc[0], acc[1]); o.y = pk2(acc[2], acc[3]); o.z = pk2(acc[4], acc[5]); o.w = pk2(acc[6], acc[7]);
        *(v4u*)(WSP(bf16, WS_WBR) + (size_t)(L * 5) * DM * 512 + (size_t)n * 512 + k0) = o;
    }
}

__device__ __forceinline__ const float* xin_row(CA A, int m) { return m < TP ? IN_F(I_XP) + (size_t)m * DM : IN_F(I_XS) + (size_t)(m - TP) * DM; }
__device__ __forceinline__ void store_bf16_row(bf16* orow, const f32x4 (&v)[8], float rstd, const float* g, int lane) {
#pragma unroll
    for (int j = 0; j < 8; ++j) { const f32x4 gj = ((const f32x4*)g)[lane + 64 * j]; const f32x4 o = v[j] * rstd * gj;
        v2u w; w.x = pk2(o[0], o[1]); w.y = pk2(o[2], o[3]); ((v2u*)orow)[lane + 64 * j] = w; }
}
__device__ __forceinline__ void norm1_phase(CA A, const int wv) {
    const int tid = tid_opaque(wv), lane = tid & 63, gw = blk_opaque() * NWAVES + (tid >> 6), NGW = gridDim.x * NWAVES;
    bf16* H = WSP(bf16, WS_H);
    for (int m = gw; m < MP; m += NGW) {
        if (m >= TT) { for (int j = 0; j < 8; ++j) ((v2u*)(H + (size_t)m * DM))[lane + 64 * j] = (v2u){0u, 0u}; continue; }
        const f32x4* xr = (const f32x4*)xin_row(A, m); f32x4 v[8]; float s = 0.f;
#pragma unroll
        for (int j = 0; j < 8; ++j) { v[j] = xr[lane + 64 * j]; s += (v[j][0] * v[j][0] + v[j][1] * v[j][1]) + (v[j][2] * v[j][2] + v[j][3] * v[j][3]); }
        const float rstd = 1.0f / sqrtf(wave_sum(s) * (1.0f / DM) + RMS_EPS);
        store_bf16_row(H + (size_t)m * DM, v, rstd, IN_F(I_NMPRE), lane);
    }
}
__device__ __forceinline__ void resid_phase(CA A, const float* Y, const float* gpost, const float* gnext, bool from_input, const int wv) {
    const int tid = tid_opaque(wv), lane = tid & 63, gw = blk_opaque() * NWAVES + (tid >> 6), NGW = gridDim.x * NWAVES;
    bf16* H = WSP(bf16, WS_H);
    for (int m = gw; m < TT; m += NGW) {
        const f32x4* yr = (const f32x4*)(Y + (size_t)m * DM); const f32x4* xr = from_input ? (const f32x4*)xin_row(A, m) : (const f32x4*)(A->out + O_Y + (size_t)m * DM);
        f32x4 v[8]; float s = 0.f;
#pragma unroll
        for (int j = 0; j < 8; ++j) { v[j] = yr[lane + 64 * j]; s += (v[j][0] * v[j][0] + v[j][1] * v[j][1]) + (v[j][2] * v[j][2] + v[j][3] * v[j][3]); }
        const float rstd = 1.0f / sqrtf(wave_sum(s) * (1.0f / DM) + RMS_EPS); float s2 = 0.f;
        f32x4* orow = (f32x4*)(A->out + O_Y + (size_t)m * DM);
#pragma unroll
        for (int j = 0; j < 8; ++j) { const f32x4 gj = ((const f32x4*)gpost)[lane + 64 * j]; v[j] = xr[lane + 64 * j] + v[j] * rstd * gj; orow[lane + 64 * j] = v[j];
            s2 += (v[j][0] * v[j][0] + v[j][1] * v[j][1]) + (v[j][2] * v[j][2] + v[j][3] * v[j][3]); }
        if (gnext) { const float rstd2 = 1.0f / sqrtf(wave_sum(s2) * (1.0f / DM) + RMS_EPS); store_bf16_row(H + (size_t)m * DM, v, rstd2, gnext, lane); }
    }
}

__device__ __forceinline__ float conv_tap(const float* UF, const float* state, int row, int j, int ucol, int c) {
    if (row < TP) { const int t = row & (SEQ - 1); return (t - 3 + j) >= 0 ? UF[(size_t)(row - 3 + j) * UFW + ucol + c] : 0.f; }
    const int s = row - TP, sb = s >> 2, e = (s & 3) + j;
    return e < 3 ? state[(size_t)(sb * 3 + e) * 1536 + c] : UF[(size_t)(TP + sb * 4 + e - 3) * UFW + ucol + c];
}
__device__ __forceinline__ void prep_phase(CA A, int layer, const int wv) {
    const int tid = tid_opaque(wv), lane = tid & 63, G = gridDim.x, gt = blk_opaque() * NTHR + tid, NGT = G * NTHR, gw = blk_opaque() * NWAVES + (tid >> 6), NGW = G * NWAVES;
    const float* UF = WSP(float, WS_UF); float* SC = WSP(float, WS_SCAL);
    for (int idx = gt; idx < TT * 24; idx += NGT) { const int row = idx / 24, j = idx % 24; const float u = UF[(size_t)row * UFW + UF_SMALL + j]; float r;
        if (j < 4) r = sigmoidf_(u);
        else if (j < 8) r = -expf(IN_F(I_DNALOG)[layer * 4 + j - 4]) * softplusf_(u + IN_F(I_DNDTB)[layer * 4 + j - 4]);
        else r = softplusf_(u + IN_F(I_SSDTB)[layer * 16 + j - 8]);
        SC[(size_t)row * 32 + j] = r; }
    { bf16* O0 = WSP(bf16, WS_OBR); const float* spool = IN_F(I_SPOOL) + (size_t)layer * DBATCH * 15 * 512;
      for (int it = gw; it < (TP / 64 + DBATCH) * 4; it += NGW) { const int gi = it & 3, sc = it >> 2, w = 2 << gi, ch = gi * 128 + lane;
          if (sc < TP / 64) { const int row0 = sc * 64, t0 = row0 & (SEQ - 1); float s0 = 0.f, s1 = 0.f;
              for (int j = 1; j < w; ++j) if (t0 - j >= 0) { s0 += UF[(size_t)(row0 - j) * UFW + ch]; s1 += UF[(size_t)(row0 - j) * UFW + ch + 64]; }
#pragma unroll 8
              for (int i = 0; i < 64; ++i) { const int row = row0 + i, t = t0 + i; const float u0 = UF[(size_t)row * UFW + ch], u1 = UF[(size_t)row * UFW + ch + 64];
                  s0 += u0; s1 += u1; const float inv = 1.0f / (float)((t + 1) < w ? (t + 1) : w);
                  O0[(size_t)row * 512 + ch] = (bf16)f2bf(s0 * inv - u0); O0[(size_t)row * 512 + ch + 64] = (bf16)f2bf(s1 * inv - u1);
                  if (t - w + 1 >= 0) { s0 -= UF[(size_t)(row - w + 1) * UFW + ch]; s1 -= UF[(size_t)(row - w + 1) * UFW + ch + 64]; } } }
          else { const int sb = sc - TP / 64; const float inv = 1.0f / (float)w;
              for (int i = 0; i < DSEQ; ++i) { const int row = TP + sb * 4 + i, e = 15 + i; float s0 = 0.f, s1 = 0.f;
                  for (int j = 0; j < w; ++j) { const int ee = e - j; const float* src = ee < 15 ? spool + (size_t)(sb * 15 + ee) * 512 + ch : UF + (size_t)(TP + sb * 4 + ee - 15) * UFW + ch; s0 += src[0]; s1 += src[64]; }
                  O0[(size_t)row * 512 + ch] = (bf16)f2bf(s0 * inv - UF[(size_t)row * UFW + ch]); O0[(size_t)row * 512 + ch + 64] = (bf16)f2bf(s1 * inv - UF[(size_t)row * UFW + ch + 64]); } } } }
    for (int it = gw; it < (TP / 64 + DBATCH) * 24; it += NGW) { const int grp = it % 12, strm = (it / 12) & 1, sc = it / 24, c0 = grp * 128 + lane;
        const int ucol = strm ? UF_XBC : UF_DNQKV; float* OUTB = strm ? WSP(float, WS_XBC) : WSP(float, WS_DNQ);
        const float* cw = (strm ? IN_F(I_SSCW) : IN_F(I_DNCW)) + (size_t)layer * 4 * 1536; const float* st = (strm ? IN_F(I_SSSC) : IN_F(I_SDNC)) + (size_t)layer * DBATCH * 3 * 1536;
        const float wa0 = cw[c0], wa1 = cw[1536 + c0], wa2 = cw[3072 + c0], wa3 = cw[4608 + c0], wb0 = cw[c0 + 64], wb1 = cw[1536 + c0 + 64], wb2 = cw[3072 + c0 + 64], wb3 = cw[4608 + c0 + 64];
        const float ba = strm ? IN_F(I_SSCB)[layer * 1536 + c0] : 0.f, bb = strm ? IN_F(I_SSCB)[layer * 1536 + c0 + 64] : 0.f;
        const bool nrm = (strm == 0) && grp < 8; const float qs = grp < 4 ? 0.08838834764831845f : 1.0f;
        float ha0, ha1, ha2, hb0, hb1, hb2; int row0, n;
        if (sc < TP / 64) { row0 = sc * 64; n = 64; const int t0 = row0 & (SEQ - 1);
            if (t0 == 0) { ha0 = ha1 = ha2 = hb0 = hb1 = hb2 = 0.f; }
            else { const float* p = UF + (size_t)(row0 - 3) * UFW + ucol + c0; ha0 = p[0]; hb0 = p[64]; ha1 = p[UFW]; hb1 = p[UFW + 64]; ha2 = p[2 * UFW]; hb2 = p[2 * UFW + 64]; } }
        else { const int sb = sc - TP / 64; row0 = TP + sb * 4; n = DSEQ; const float* p = st + (size_t)(sb * 3) * 1536 + c0; ha0 = p[0]; hb0 = p[64]; ha1 = p[1536]; hb1 = p[1536 + 64]; ha2 = p[3072]; hb2 = p[3072 + 64]; }
#pragma unroll 8
        for (int i = 0; i < n; ++i) { const float* p = UF + (size_t)(row0 + i) * UFW + ucol + c0; const float ua = p[0], ub = p[64];
            float a = siluf_(ba + wa0 * ha0 + wa1 * ha1 + wa2 * ha2 + wa3 * ua), b = siluf_(bb + wb0 * hb0 + wb1 * hb1 + wb2 * hb2 + wb3 * ub);
            ha0 = ha1; ha1 = ha2; ha2 = ua; hb0 = hb1; hb1 = hb2; hb2 = ub;
            if (nrm) { const float rs = row16_sum(a * a + b * b);
                const float tot = (__builtin_bit_cast(float, __builtin_amdgcn_readlane(__builtin_bit_cast(int, rs), 0)) + __builtin_bit_cast(float, __builtin_amdgcn_readlane(__builtin_bit_cast(int, rs), 16)))
                                + (__builtin_bit_cast(float, __builtin_amdgcn_readlane(__builtin_bit_cast(int, rs), 32)) + __builtin_bit_cast(float, __builtin_amdgcn_readlane(__builtin_bit_cast(int, rs), 48)));
                const float sc2 = qs / sqrtf(tot + 1e-6f); a *= sc2; b *= sc2; }
            float* o = OUTB + (size_t)(row0 + i) * 1536 + c0; o[0] = a; o[64] = b; } }
    for (int idx = gt; idx < NBATCH * 3 * 1536; idx += NGT) { const int b = idx / (3 * 1536), q = idx % (3 * 1536), j = q / 1536, c = q % 1536; const size_t src = (size_t)(b * SEQ + SEQ - 3 + j) * UFW;
        A->out[O_DNCP + (size_t)layer * NBATCH * 3 * 1536 + idx] = UF[src + UF_DNQKV + c]; A->out[O_SSCP + (size_t)layer * NBATCH * 3 * 1536 + idx] = UF[src + UF_XBC + c]; }
    for (int idx = gt; idx < DBATCH * 3 * 1536; idx += NGT) { const int sb = idx / (3 * 1536), q = idx % (3 * 1536), j = q / 1536, c = q % 1536; const size_t src = (size_t)(TP + sb * 4 + 1 + j) * UFW;
        A->out[O_DNCS + (size_t)layer * DBATCH * 3 * 1536 + idx] = UF[src + UF_DNQKV + c]; A->out[O_SSCS + (size_t)layer * DBATCH * 3 * 1536 + idx] = UF[src + UF_XBC + c]; }
    for (int idx = gt; idx < NBATCH * 15 * 512; idx += NGT) { const int b = idx / (15 * 512), q = idx % (15 * 512), j = q >> 9, ch = q & 511;
        A->out[O_POOLP + (size_t)layer * NBATCH * 15 * 512 + idx] = UF[(size_t)(b * SEQ + SEQ - 15 + j) * UFW + ch]; }
    { const float* spool = IN_F(I_SPOOL) + (size_t)layer * DBATCH * 15 * 512;
      for (int idx = gt; idx < DBATCH * 15 * 512; idx += NGT) { const int sb = idx / (15 * 512), q = idx % (15 * 512), j = q >> 9, ch = q & 511, e = 4 + j;
          A->out[O_POOLS + (size_t)layer * DBATCH * 15 * 512 + idx] = e < 15 ? spool[(size_t)(sb * 15 + e) * 512 + ch] : UF[(size_t)(TP + sb * 4 + e - 15) * UFW + ch]; } }
}

__device__ __forceinline__ void dn_seq(CA A, LAS unsigned char* lds, int layer, int unit, const int wv) {
    const int tid = tid_opaque(wv), lane = tid & 63, wid = tid >> 6, v = tid & 127, kq = tid >> 7;
    int row0, L, h; const float* s0 = nullptr; float* sout;
    if (unit < 16) { const int b = unit >> 2; h = unit & 3; row0 = b * SEQ; L = SEQ; sout = A->out + O_DNSP + ((size_t)(layer * NBATCH + b) * 4 + h) * 16384; }
    else { const int u = unit - 16, sb = u >> 2; h = u & 3; row0 = TP + sb * 4; L = DSEQ; s0 = IN_F(I_SDNS) + ((size_t)(layer * DBATCH + sb) * 4 + h) * 16384; sout = A->out + O_DNSS + ((size_t)(layer * DBATCH + sb) * 4 + h) * 16384; }
    constexpr int CH = 32;
    LAS float* qs = (LAS float*)lds; LAS float* ks = qs + CH * 128; LAS float* vs = ks + CH * 128; LAS float* ob = vs + CH * 128;
    LAS float* red = ob + CH * 128;
    LAS float* egs = red + 2 * 2 * 4 * 128; LAS float* bts = egs + CH; LAS float* kqd = bts + CH;
    const float* DNQ = WSP(float, WS_DNQ); const float* SC = WSP(float, WS_SCAL); const float* UF = WSP(float, WS_UF); bf16* O1 = WSP(bf16, WS_OBR) + (size_t)MP * 512;
    const float* nw = IN_F(I_DNNW) + layer * 128;
    float S[32];
#pragma unroll
    for (int i = 0; i < 32; ++i) S[i] = s0 ? s0[(size_t)(32 * kq + i) * 128 + v] : 0.f;
    for (int c0 = 0; c0 < L; c0 += CH) {
        const int n = (L - c0) < CH ? (L - c0) : CH;
        __syncthreads();
        for (int idx = tid; idx < n * 128; idx += NTHR) { const int t = idx >> 7, c = idx & 127; const float* src = DNQ + (size_t)(row0 + c0 + t) * 1536 + h * 128 + c;
            qs[idx] = src[0]; ks[idx] = src[512]; vs[idx] = src[1024]; }
        if (tid < n) { const float* sc = SC + (size_t)(row0 + c0 + tid) * 32; bts[tid] = sc[h]; egs[tid] = expf(sc[4 + h]); }
        __syncthreads();
        for (int t = wid; t < n; t += NWAVES) { const float s = wave_sum(ks[t * 128 + lane] * qs[t * 128 + lane] + ks[t * 128 + 64 + lane] * qs[t * 128 + 64 + lane]); if (lane == 0) kqd[t] = s; }
        __syncthreads();
        for (int t = 0; t < n; ++t) {
            const float eg = egs[t], bt = bts[t]; float kk[32]; float r = 0.f, pp = 0.f;
#pragma unroll
            for (int i4 = 0; i4 < 8; ++i4) { const f32x4 k4 = *(const LAS f32x4*)(ks + t * 128 + 32 * kq + 4 * i4), q4 = *(const LAS f32x4*)(qs + t * 128 + 32 * kq + 4 * i4);
#pragma unroll
                for (int e = 0; e < 4; ++e) { const int i = 4 * i4 + e; S[i] *= eg; kk[i] = k4[e]; r += S[i] * k4[e]; pp += S[i] * q4[e]; } }
            LAS float* rd = red + (t & 1) * 1024;
            rd[kq * 128 + v] = r; rd[512 + kq * 128 + v] = pp;
            __syncthreads();
            const float rt = (rd[v] + rd[128 + v]) + (rd[256 + v] + rd[384 + v]), pt = (rd[512 + v] + rd[640 + v]) + (rd[768 + v] + rd[896 + v]);
            const float dd = bt * (vs[t * 128 + v] - rt);
#pragma unroll
            for (int i = 0; i < 32; ++i) S[i] += kk[i] * dd;
            if (kq == 0) ob[t * 128 + v] = pt + kqd[t] * dd;
        }
        __syncthreads();
        for (int t = wid; t < n; t += NWAVES) { const int row = row0 + c0 + t; const float o0 = ob[t * 128 + lane], o1 = ob[t * 128 + 64 + lane];
            const float rstd = 1.0f / sqrtf(wave_sum(o0 * o0 + o1 * o1) * (1.0f / 128.0f) + RMS_EPS);
            const float z0 = UF[(size_t)row * UFW + UF_DNZ + h * 128 + lane], z1 = UF[(size_t)row * UFW + UF_DNZ + h * 128 + 64 + lane];
            O1[(size_t)row * 512 + h * 128 + lane] = (bf16)f2bf(o0 * rstd * nw[lane] * siluf_(z0)); O1[(size_t)row * 512 + h * 128 + 64 + lane] = (bf16)f2bf(o1 * rstd * nw[64 + lane] * siluf_(z1)); }
    }
#pragma unroll
    for (int i = 0; i < 32; ++i) sout[(size_t)(32 * kq + i) * 128 + v] = S[i];
    __syncthreads();
}

__device__ __forceinline__ void ssd_seq(CA A, LAS unsigned char* lds, int layer, int unit, const int wv) {
    const int tid = tid_opaque(wv), lane = tid & 63, wid = tid >> 6, p = tid >> 3, nq = tid & 7;
    int row0, L, hd; const float* h0 = nullptr; float* hout;
    if (unit < 64) { const int b = unit >> 4; hd = unit & 15; row0 = b * SEQ; L = SEQ; hout = A->out + O_SSHP + ((size_t)(layer * NBATCH + b) * 16 + hd) * 8192; }
    else { const int u = unit - 64, sb = u >> 4; hd = u & 15; row0 = TP + sb * 4; L = DSEQ; h0 = IN_F(I_SSSH) + ((size_t)(layer * DBATCH + sb) * 16 + hd) * 8192; hout = A->out + O_SSHS + ((size_t)(layer * DBATCH + sb) * 16 + hd) * 8192; }
    const int g = hd >> 3; constexpr int CH = 64;
    LAS float* Bs = (LAS float*)lds; LAS float* Cs = Bs + CH * 128; LAS float* xs = Cs + CH * 128; LAS float* yb = xs + CH * 64; LAS float* dts = yb + CH * 64;
    const float* XBC = WSP(float, WS_XBC); const float* SC = WSP(float, WS_SCAL); const float* UF = WSP(float, WS_UF); float* SSQ = WSP(float, WS_SSQ);
    bf16* Og = WSP(bf16, WS_OBR) + (size_t)(3 + g) * MP * 512;
    const float a = -expf(IN_F(I_SSALOG)[layer * 16 + hd]), Dk = IN_F(I_SSD)[layer * 16 + hd];
    float hs[16];
#pragma unroll
    for (int j = 0; j < 16; ++j) hs[j] = h0 ? h0[(size_t)p * 128 + 16 * nq + j] : 0.f;
    for (int c0 = 0; c0 < L; c0 += CH) {
        const int n = (L - c0) < CH ? (L - c0) : CH;
        __syncthreads();
        for (int idx = tid; idx < n * 128; idx += NTHR) { const int t = idx >> 7, c = idx & 127; const float* src = XBC + (size_t)(row0 + c0 + t) * 1536; Bs[idx] = src[1024 + g * 128 + c]; Cs[idx] = src[1280 + g * 128 + c]; }
        for (int idx = tid; idx < n * 64; idx += NTHR) { const int t = idx >> 6, c = idx & 63; xs[idx] = XBC[(size_t)(row0 + c0 + t) * 1536 + hd * 64 + c]; }
        if (tid < n) dts[tid] = SC[(size_t)(row0 + c0 + tid) * 32 + 8 + hd];
        __syncthreads();
        for (int t = 0; t < n; ++t) {
            const float dt = dts[t], dA = expf(dt * a), xv = xs[t * 64 + p], cx = dt * xv; float y = 0.f;
#pragma unroll
            for (int j4 = 0; j4 < 4; ++j4) { const f32x4 b4 = *(const LAS f32x4*)(Bs + t * 128 + 16 * nq + 4 * j4), c4 = *(const LAS f32x4*)(Cs + t * 128 + 16 * nq + 4 * j4);
#pragma unroll
                for (int e = 0; e < 4; ++e) { const int j = 4 * j4 + e; hs[j] = hs[j] * dA + cx * b4[e]; y += hs[j] * c4[e]; } }
            y += __shfl_xor(y, 1); y += __shfl_xor(y, 2); y += __shfl_xor(y, 4);
            if (nq == 0) yb[t * 64 + p] = y + Dk * xv;
        }
        __syncthreads();
        for (int t = wid; t < n; t += NWAVES) { const int row = row0 + c0 + t; const float z = UF[(size_t)row * UFW + UF_SSZ + hd * 64 + lane]; const float yg = yb[t * 64 + lane] * siluf_(z);
            const float ss = wave_sum(yg * yg); if (lane == 0) { SSQ[(size_t)row * 32 + hd * 2] = ss; SSQ[(size_t)row * 32 + hd * 2 + 1] = 0.f; }
            Og[(size_t)row * 512 + (hd & 7) * 64 + lane] = (bf16)f2bf(yg); }
    }
#pragma unroll
    for (int j = 0; j < 16; ++j) hout[(size_t)p * 128 + 16 * nq + j] = hs[j];
    __syncthreads();
}

constexpr size_t DNU_NW = 0, DNU_QG = 16384, DNU_AT = 32768, DNU_KGT = 40960, DNU_UP = 57344, DNU_EG = 90112, DNU_BYTES = 90368;
__device__ __forceinline__ float dpp_swap1(float x) { return __builtin_bit_cast(float, __builtin_amdgcn_mov_dpp(__builtin_bit_cast(int, x), 0xB1, 0xf, 0xf, true)); }
__device__ __forceinline__ void dn_chunk_unit(CA A, LAS unsigned char* lds, int layer, int unit, const int wv) {
    const int tid = tid_opaque(wv), lane = tid & 63, wid = tid >> 6, q4 = lane >> 4, l15 = lane & 15;
    const int bh = unit >> 5, ck = unit & 31, b = bh >> 2, h = bh & 3, row0 = b * SEQ + ck * 64;
    constexpr int FP = 132;
    LAS float* kf = (LAS float*)lds; LAS float* vf = kf + 64 * FP;
    LAS unsigned char* qb = lds + 2 * 64 * FP * 4; LAS unsigned char* kb = qb + 64 * 272;
    LAS float* Lp = (LAS float*)(kb + 64 * 272);
    LAS float* gcs = Lp + 2 * 64 * 32; LAS float* bts = gcs + 64;
    const float* DNQ = WSP(float, WS_DNQ); const float* SC = WSP(float, WS_SCAL);
    unsigned char* rec = A->ws + WS_DNU + (size_t)unit * DNU_BYTES;
    __syncthreads();
    if (tid < 64) { const float* sc = SC + (size_t)(row0 + tid) * 32; float g = sc[4 + h]; bts[tid] = sc[h];
#pragma unroll
        for (int o = 1; o < 64; o <<= 1) { const float t = __shfl_up(g, o); if (lane >= o) g += t; }
        gcs[tid] = g; }
    __syncthreads();
    const float glast = gcs[63];
    if (tid == 0) *(float*)(rec + DNU_EG) = expf(glast);
#pragma unroll
    for (int it = 0; it < 4; ++it) { const int idx = tid + 512 * it, t = idx >> 5, d4 = (idx & 31) * 4; const float* src = DNQ + (size_t)(row0 + t) * 1536 + h * 128 + d4;
        const f32x4 qv = *(const f32x4*)src, kv = *(const f32x4*)(src + 512), vv = *(const f32x4*)(src + 1024);
        *(LAS f32x4*)(kf + t * FP + d4) = kv; *(LAS f32x4*)(vf + t * FP + d4) = vv;
        v2u w; w.x = pk2(qv[0], qv[1]); w.y = pk2(qv[2], qv[3]); *(LAS v2u*)(qb + t * 272 + d4 * 2) = w;
        w.x = pk2(kv[0], kv[1]); w.y = pk2(kv[2], kv[3]); *(LAS v2u*)(kb + t * 272 + d4 * 2) = w;
        const float eg = expf(gcs[t]); w.x = pk2(qv[0] * eg, qv[1] * eg); w.y = pk2(qv[2] * eg, qv[3] * eg); *(v2u*)(rec + DNU_QG + (size_t)(t * 128 + d4) * 2) = w; }
    __syncthreads();
    { const int c = lane, dg = wid; const float f = expf(glast - gcs[c]); bf16* KGT = (bf16*)(rec + DNU_KGT);
#pragma unroll
      for (int i = 0; i < 16; ++i) { const int d = dg * 16 + i; KGT[d * 64 + c] = (bf16)f2bf(kf[c * FP + d] * f); } }
    { const int ct = wid >> 1; bf16* AT = (bf16*)(rec + DNU_AT);
#pragma unroll
      for (int e2 = 0; e2 < 2; ++e2) { const int et = 2 * (wid & 1) + e2; f32x4 aKK = {0.f, 0.f, 0.f, 0.f}, aQK = {0.f, 0.f, 0.f, 0.f};
#pragma unroll
          for (int ks = 0; ks < 4; ++ks) { const bf16x8 bfr = *(const LAS bf16x8*)(kb + (16 * et + l15) * 272 + (32 * ks + 8 * q4) * 2);
              const bf16x8 ak = *(const LAS bf16x8*)(kb + (16 * ct + l15) * 272 + (32 * ks + 8 * q4) * 2), aq = *(const LAS bf16x8*)(qb + (16 * ct + l15) * 272 + (32 * ks + 8 * q4) * 2);
              aKK = __builtin_amdgcn_mfma_f32_16x16x32_bf16(ak, bfr, aKK, 0, 0, 0); aQK = __builtin_amdgcn_mfma_f32_16x16x32_bf16(aq, bfr, aQK, 0, 0, 0); }
          const int e = 16 * et + l15; const float ge = gcs[e];
#pragma unroll
          for (int r = 0; r < 4; ++r) { const int c = 16 * ct + 4 * q4 + r; const float dec = e <= c ? expf(gcs[c] - ge) : 0.f;
              Lp[((e & 1) * 64 + c) * 32 + (e >> 1)] = e < c ? bts[c] * aKK[r] * dec : 0.f;
              AT[c * 64 + e] = (bf16)f2bf(aQK[r] * dec); } } }
    __syncthreads();
    { const int j = tid >> 1, par = tid & 1; float x[32];
#pragma unroll
      for (int i = 0; i < 32; ++i) x[i] = 0.f;
      const LAS float* src = j < 128 ? vf + j : kf + (j - 128);
      float* UP = (float*)(rec + DNU_UP); bf16* NW = (bf16*)(rec + DNU_NW);
#pragma unroll
      for (int c = 0; c < 64; ++c) {
          constexpr int dummy = 0; (void)dummy;
          const int ni = (c + 1) >> 1; float a0 = 0.f, a1 = 0.f, a2 = 0.f, a3 = 0.f;
#pragma unroll
          for (int i4 = 0; i4 < (ni + 3) / 4; ++i4) { const f32x4 l4 = *(const LAS f32x4*)(Lp + (par * 64 + c) * 32 + 4 * i4);
              a0 += l4[0] * x[4 * i4]; if (4 * i4 + 1 < ni) a1 += l4[1] * x[4 * i4 + 1]; if (4 * i4 + 2 < ni) a2 += l4[2] * x[4 * i4 + 2]; if (4 * i4 + 3 < ni) a3 += l4[3] * x[4 * i4 + 3]; }
          float acc = (a0 + a1) + (a2 + a3); acc += dpp_swap1(acc);
          float rhs = src[c * FP] * bts[c]; if (j >= 128) rhs *= expf(gcs[c]);
          const float xc = rhs - acc;
          x[c >> 1] = ((c & 1) == par) ? xc : x[c >> 1];
          if (par == 0) { if (j < 128) UP[(((j >> 4) * 4 + (c >> 4)) * 4 + (c & 3)) * 64 + ((c >> 2) & 3) * 16 + (j & 15)] = xc; else NW[c * 128 + (j - 128)] = (bf16)f2bf(-xc); }
      } }
}

constexpr int D2_NW = 0, D2_QG = 17408, D2_AT = 34816, D2_KGT = 44032, D2_BUF = 62464, D2_RED = 2 * D2_BUF;
__device__ __forceinline__ bf16x8 ld_frag_perm(const LAS unsigned char* p) {
    const v2u lo = *(const LAS v2u*)p, hi = *(const LAS v2u*)(p + 32); v4u w; w.x = lo.x; w.y = lo.y; w.z = hi.x; w.w = hi.y; return __builtin_bit_cast(bf16x8, w);
}
__device__ __forceinline__ bf16x8 pack_b(const f32x4& t0, const f32x4& t1) { v4u w; w.x = pk2(t0[0], t0[1]); w.y = pk2(t0[2], t0[3]); w.z = pk2(t1[0], t1[1]); w.w = pk2(t1[2], t1[3]); return __builtin_bit_cast(bf16x8, w); }
__device__ __forceinline__ void dn_seq2(CA A, LAS unsigned char* lds, int layer, int bh, const int wv) {
    const int tid = tid_opaque(wv), lane = tid & 63, w = tid >> 6, q4 = lane >> 4, l15 = lane & 15;
    const int b = bh >> 2, h = bh & 3;
    const unsigned char* recs = A->ws + WS_DNU + (size_t)(bh * 32) * DNU_BYTES;
    const float* UF = WSP(float, WS_UF); bf16* O1 = WSP(bf16, WS_OBR) + (size_t)MP * 512; const float* nw = IN_F(I_DNNW) + layer * 128;
    LAS float* red = (LAS float*)(lds + D2_RED);
    f32x4 S[8];
#pragma unroll
    for (int i = 0; i < 8; ++i) S[i] = (f32x4){0.f, 0.f, 0.f, 0.f};
    v4u st[7];
#define D2_LOAD(rec_) do { const v4u* g_ = (const v4u*)(rec_); _Pragma("unroll") for (int i_ = 0; i_ < 7; ++i_) st[i_] = g_[tid + 512 * i_]; } while (0)
#define D2_STORE(buf_) do { LAS unsigned char* b_ = lds + (buf_) * D2_BUF; \
        *(LAS v4u*)(b_ + D2_NW + (tid >> 4) * 272 + (tid & 15) * 16) = st[0]; *(LAS v4u*)(b_ + D2_NW + (32 + (tid >> 4)) * 272 + (tid & 15) * 16) = st[1]; \
        *(LAS v4u*)(b_ + D2_QG + (tid >> 4) * 272 + (tid & 15) * 16) = st[2]; *(LAS v4u*)(b_ + D2_QG + (32 + (tid >> 4)) * 272 + (tid & 15) * 16) = st[3]; \
        *(LAS v4u*)(b_ + D2_AT + (tid >> 3) * 144 + (tid & 7) * 16) = st[4]; \
        *(LAS v4u*)(b_ + D2_KGT + (tid >> 3) * 144 + (tid & 7) * 16) = st[5]; *(LAS v4u*)(b_ + D2_KGT + (64 + (tid >> 3)) * 144 + (tid & 7) * 16) = st[6]; } while (0)
    __syncthreads();
    D2_LOAD(recs); D2_STORE(0);
    f32x4 vnx[4]; float eglx = *(const float*)(recs + DNU_EG);
    { const float* UP0 = (const float*)(recs + DNU_UP) + (size_t)w * 1024 + lane;
#pragma unroll
      for (int mt = 0; mt < 4; ++mt)
#pragma unroll
          for (int r = 0; r < 4; ++r) vnx[mt][r] = UP0[(mt * 4 + r) * 64]; }
    __syncthreads();
    for (int ck = 0; ck < 32; ++ck) {
        const unsigned char* rec = recs + (size_t)ck * DNU_BYTES; const int row0 = b * SEQ + ck * 64;
        const LAS unsigned char* bf = lds + (ck & 1) * D2_BUF;
        if (ck + 1 < 32) D2_LOAD(rec + DNU_BYTES);
        const float egl = eglx;
        f32x4 vn[4];
#pragma unroll
        for (int mt = 0; mt < 4; ++mt) vn[mt] = vnx[mt];
        if (ck + 1 < 32) { eglx = *(const float*)(rec + DNU_BYTES + DNU_EG); const float* UP = (const float*)(rec + DNU_BYTES + DNU_UP) + (size_t)w * 1024 + lane;
#pragma unroll
            for (int mt = 0; mt < 4; ++mt)
#pragma unroll
                for (int r = 0; r < 4; ++r) vnx[mt][r] = UP[(mt * 4 + r) * 64]; }
        f32x4 zz[4];
#pragma unroll
        for (int mt = 0; mt < 4; ++mt)
#pragma unroll
            for (int r = 0; r < 4; ++r) zz[mt][r] = UF[(size_t)(row0 + 16 * mt + 4 * q4 + r) * UFW + UF_DNZ + h * 128 + 16 * w + l15];
        bf16x8 Sb[4];
#pragma unroll
        for (int ks = 0; ks < 4; ++ks) Sb[ks] = pack_b(S[2 * ks], S[2 * ks + 1]);
        const int aoff = l15 * 272 + 8 * q4, aoff2 = l15 * 144 + 8 * q4;
#pragma unroll
        for (int mt = 0; mt < 4; ++mt)
#pragma unroll
            for (int ks = 0; ks < 4; ++ks) vn[mt] = __builtin_amdgcn_mfma_f32_16x16x32_bf16(ld_frag_perm(bf + D2_NW + mt * 16 * 272 + aoff + ks * 64), Sb[ks], vn[mt], 0, 0, 0);
        bf16x8 vb[2];
        vb[0] = pack_b(vn[0], vn[1]); vb[1] = pack_b(vn[2], vn[3]);
        f32x4 o[4];
#pragma unroll
        for (int mt = 0; mt < 4; ++mt) { o[mt] = (f32x4){0.f, 0.f, 0.f, 0.f};
#pragma unroll
            for (int ks = 0; ks < 4; ++ks) o[mt] = __builtin_amdgcn_mfma_f32_16x16x32_bf16(ld_frag_perm(bf + D2_QG + mt * 16 * 272 + aoff + ks * 64), Sb[ks], o[mt], 0, 0, 0);
#pragma unroll
            for (int ke = 0; ke < 2; ++ke) o[mt] = __builtin_amdgcn_mfma_f32_16x16x32_bf16(ld_frag_perm(bf + D2_AT + mt * 16 * 144 + aoff2 + ke * 64), vb[ke], o[mt], 0, 0, 0); }
#pragma unroll
        for (int m8 = 0; m8 < 8; ++m8) { S[m8] = S[m8] * egl;
#pragma unroll
            for (int ke = 0; ke < 2; ++ke) S[m8] = __builtin_amdgcn_mfma_f32_16x16x32_bf16(ld_frag_perm(bf + D2_KGT + m8 * 16 * 144 + aoff2 + ke * 64), vb[ke], S[m8], 0, 0, 0); }
        LAS float* rd = red + (ck & 1) * 512;
#pragma unroll
        for (int mt = 0; mt < 4; ++mt)
#pragma unroll
            for (int r = 0; r < 4; ++r) { const float s = row16_sum(o[mt][r] * o[mt][r]);
                if (l15 == 0) rd[(16 * mt + 4 * q4 + r) * 8 + w] = s; }
        if (ck + 1 < 32) D2_STORE((ck + 1) & 1);
        __syncthreads();
#pragma unroll
        for (int mt = 0; mt < 4; ++mt)
#pragma unroll
            for (int r = 0; r < 4; ++r) { const int c = 16 * mt + 4 * q4 + r; const f32x4 s0 = *(const LAS f32x4*)(rd + c * 8), s1 = *(const LAS f32x4*)(rd + c * 8 + 4);
                const float rstd = 1.0f / sqrtf(((s0[0] + s0[1]) + (s0[2] + s0[3]) + (s1[0] + s1[1]) + (s1[2] + s1[3])) * (1.0f / 128.0f) + RMS_EPS);
                const int dv = 16 * w + l15;
                O1[(size_t)(row0 + c) * 512 + h * 128 + dv] = (bf16)f2bf(o[mt][r] * rstd * nw[dv] * siluf_(zz[mt][r])); }
    }
    float* sout = A->out + O_DNSP + ((size_t)(layer * NBATCH + b) * 4 + h) * 16384;
#pragma unroll
    for (int m8 = 0; m8 < 8; ++m8)
#pragma unroll
        for (int r = 0; r < 4; ++r) sout[(size_t)(16 * m8 + 4 * q4 + r) * 128 + 16 * w + l15] = S[m8][r];
    __syncthreads();
#undef D2_LOAD
#undef D2_STORE
}

constexpr size_t SSU_XT = 0, SSU_XTW = 8192, SSU_CUM = 16384, SSU_DT = 16640, SSU_BYTES = 16896;
constexpr size_t SSG_C = 0, SSG_B = 16384, SSG_BT = 32768, SSG_BYTES = 49152;
__device__ __forceinline__ void ssd_prep_unit(CA A, LAS unsigned char* lds, int layer, int unit, const int wv) {
    const int tid = tid_opaque(wv), lane = tid & 63;
    const int hd = unit & 15, bc = unit >> 4, b = bc >> 5, ck = bc & 31, g = hd >> 3, row0 = b * SEQ + ck * 64;
    const float* XBC = WSP(float, WS_XBC); const float* SC = WSP(float, WS_SCAL);
    unsigned char* rec = A->ws + WS_SSU + (size_t)unit * SSU_BYTES;
    LAS float* xl = (LAS float*)lds;
    LAS float* bl = xl + 64 * 65;
    LAS float* cums = bl + 64 * 129; LAS float* ws_ = cums + 64;
    const float a = -expf(IN_F(I_SSALOG)[layer * 16 + hd]);
    __syncthreads();
    if (tid < 64) { const float dt = SC[(size_t)(row0 + tid) * 32 + 8 + hd]; float c = dt * a;
#pragma unroll
        for (int o = 1; o < 64; o <<= 1) { const float t = __shfl_up(c, o); if (lane >= o) c += t; }
        cums[tid] = c; const float c63 = __shfl(c, 63); ws_[tid] = expf(c63 - c) * dt;
        ((float*)(rec + SSU_CUM))[tid] = c; ((float*)(rec + SSU_DT))[tid] = dt; }
    { const int s = tid >> 3, p8 = (tid & 7) * 8; const float* src = XBC + (size_t)(row0 + s) * 1536 + hd * 64 + p8; const f32x4 x0 = *(const f32x4*)src, x1 = *(const f32x4*)(src + 4);
#pragma unroll
      for (int e = 0; e < 4; ++e) { xl[s * 65 + p8 + e] = x0[e]; xl[s * 65 + p8 + 4 + e] = x1[e]; } }
    __syncthreads();
    { const int p = tid >> 3, s8 = (tid & 7) * 8; float xv[8], xw[8];
#pragma unroll
      for (int i = 0; i < 8; ++i) { xv[i] = xl[(s8 + i) * 65 + p]; xw[i] = xv[i] * ws_[s8 + i]; }
      v4u o; o.x = pk2(xv[0], xv[1]); o.y = pk2(xv[2], xv[3]); o.z = pk2(xv[4], xv[5]); o.w = pk2(xv[6], xv[7]); *(v4u*)(rec + SSU_XT + (size_t)(p * 64 + s8) * 2) = o;
      o.x = pk2(xw[0], xw[1]); o.y = pk2(xw[2], xw[3]); o.z = pk2(xw[4], xw[5]); o.w = pk2(xw[6], xw[7]); *(v4u*)(rec + SSU_XTW + (size_t)(p * 64 + s8) * 2) = o; }
    if ((hd & 7) == 0) {
        unsigned char* grec = A->ws + WS_SSG + (size_t)(bc * 2 + g) * SSG_BYTES;
        const int s = tid >> 3, n16 = (tid & 7) * 16; const float* src = XBC + (size_t)(row0 + s) * 1536 + 1024 + g * 128 + n16;
        f32x4 bv[4], cv[4];
#pragma unroll
        for (int i = 0; i < 4; ++i) { bv[i] = *(const f32x4*)(src + 4 * i); cv[i] = *(const f32x4*)(src + 256 + 4 * i); }
#pragma unroll
        for (int i = 0; i < 2; ++i) { v4u o; o.x = pk2(bv[2 * i][0], bv[2 * i][1]); o.y = pk2(bv[2 * i][2], bv[2 * i][3]); o.z = pk2(bv[2 * i + 1][0], bv[2 * i + 1][1]); o.w = pk2(bv[2 * i + 1][2], bv[2 * i + 1][3]);
            *(v4u*)(grec + SSG_B + (size_t)(s * 128 + n16 + 8 * i) * 2) = o;
            o.x = pk2(cv[2 * i][0], cv[2 * i][1]); o.y = pk2(cv[2 * i][2], cv[2 * i][3]); o.z = pk2(cv[2 * i + 1][0], cv[2 * i + 1][1]); o.w = pk2(cv[2 * i + 1][2], cv[2 * i + 1][3]);
            *(v4u*)(grec + SSG_C + (size_t)(s * 128 + n16 + 8 * i) * 2) = o; }
#pragma unroll
        for (int i = 0; i < 4; ++i)
#pragma unroll
            for (int e = 0; e < 4; ++e) bl[s * 129 + n16 + 4 * i + e] = bv[i][e];
        __syncthreads();
        const int n = tid >> 2, s16 = (tid & 3) * 16; float t[16];
#pragma unroll
        for (int i = 0; i < 16; ++i) t[i] = bl[(s16 + i) * 129 + n];
#pragma unroll
        for (int i = 0; i < 2; ++i) { v4u o; o.x = pk2(t[8 * i], t[8 * i + 1]); o.y = pk2(t[8 * i + 2], t[8 * i + 3]); o.z = pk2(t[8 * i + 4], t[8 * i + 5]); o.w = pk2(t[8 * i + 6], t[8 * i + 7]);
            *(v4u*)(grec + SSG_BT + (size_t)(n * 64 + s16 + 8 * i) * 2) = o; }
    }
}

constexpr int S2_C = 0, S2_B = 17408, S2_BT = 34816, S2_XT = 53248, S2_XTW = 62464, S2_WM = 71680, S2_HB = 80896, S2_YB = 98304, S2_CUM = 114688, S2_DT = 114944;
__device__ __forceinline__ void ssd_seq2(CA A, LAS unsigned char* lds, int layer, int unit, const int wv) {
    const int tid = tid_opaque(wv), lane = tid & 63, w = tid >> 6, q4 = lane >> 4, l15 = lane & 15;
    const int b = unit >> 4, hd = unit & 15, g = hd >> 3;
    const unsigned char* hrec = A->ws + WS_SSU + (size_t)((b * 32) * 16 + hd) * SSU_BYTES;
    const unsigned char* grec = A->ws + WS_SSG + (size_t)((b * 32) * 2 + g) * SSG_BYTES;
    const float* UF = WSP(float, WS_UF); float* SSQ = WSP(float, WS_SSQ); bf16* Og = WSP(bf16, WS_OBR) + (size_t)(3 + g) * MP * 512;
    const float Dk = IN_F(I_SSD)[layer * 16 + hd];
    LAS float* yb = (LAS float*)(lds + S2_YB); LAS float* cums = (LAS float*)(lds + S2_CUM); LAS float* dts = (LAS float*)(lds + S2_DT);
    f32x4 hacc[4];
#pragma unroll
    for (int i = 0; i < 4; ++i) hacc[i] = (f32x4){0.f, 0.f, 0.f, 0.f};
    v4u st[8]; float sc1 = 0.f;
#define S2_LOAD(ck_) do { const v4u* gg_ = (const v4u*)(grec + (size_t)(ck_) * 2 * SSG_BYTES); const v4u* hh_ = (const v4u*)(hrec + (size_t)(ck_) * 16 * SSU_BYTES); \
        st[0] = gg_[tid]; st[1] = gg_[tid + 512]; st[2] = gg_[tid + 1024]; st[3] = gg_[tid + 1536]; st[4] = gg_[tid + 2048]; st[5] = gg_[tid + 2560]; st[6] = hh_[tid]; st[7] = hh_[tid + 512]; \
        if (tid < 128) sc1 = ((const float*)(hrec + (size_t)(ck_) * 16 * SSU_BYTES + SSU_CUM))[tid]; } while (0)
#define S2_STORE() do { \
        *(LAS v4u*)(lds + S2_C + (tid >> 4) * 272 + (tid & 15) * 16) = st[0]; *(LAS v4u*)(lds + S2_C + (32 + (tid >> 4)) * 272 + (tid & 15) * 16) = st[1]; \
        *(LAS v4u*)(lds + S2_B + (tid >> 4) * 272 + (tid & 15) * 16) = st[2]; *(LAS v4u*)(lds + S2_B + (32 + (tid >> 4)) * 272 + (tid & 15) * 16) = st[3]; \
        *(LAS v4u*)(lds + S2_BT + (tid >> 3) * 144 + (tid & 7) * 16) = st[4]; *(LAS v4u*)(lds + S2_BT + (64 + (tid >> 3)) * 144 + (tid & 7) * 16) = st[5]; \
        *(LAS v4u*)(lds + S2_XT + (tid >> 3) * 144 + (tid & 7) * 16) = st[6]; *(LAS v4u*)(lds + S2_XTW + (tid >> 3) * 144 + (tid & 7) * 16) = st[7]; \
        if (tid < 128) cums[tid] = sc1; } while (0)
    S2_LOAD(0);
    const int tt = w >> 1, aoffC = l15 * 272 + 16 * q4, aoffS = l15 * 144 + 16 * q4;
    for (int ck = 0; ck < 32; ++ck) {
        const int row0 = b * SEQ + ck * 64;
        __syncthreads();
        S2_STORE();
        __syncthreads();
        if (ck + 1 < 32) S2_LOAD(ck + 1);
        float zv[2][4];
#pragma unroll
        for (int e2 = 0; e2 < 2; ++e2)
#pragma unroll
            for (int r = 0; r < 4; ++r) zv[e2][r] = UF[(size_t)(row0 + 16 * tt + 4 * q4 + r) * UFW + UF_SSZ + hd * 64 + 16 * (2 * (w & 1) + e2) + l15];
#pragma unroll
        for (int e2 = 0; e2 < 2; ++e2) { const int stl = 2 * (w & 1) + e2; f32x4 acc = {0.f, 0.f, 0.f, 0.f};
            if (stl <= tt) {
#pragma unroll
                for (int ks = 0; ks < 4; ++ks) acc = __builtin_amdgcn_mfma_f32_16x16x32_bf16(*(const LAS bf16x8*)(lds + S2_C + tt * 16 * 272 + aoffC + ks * 64), *(const LAS bf16x8*)(lds + S2_B + stl * 16 * 272 + aoffC + ks * 64), acc, 0, 0, 0); }
            const int s = 16 * stl + l15; const float cs = cums[s], ds = dts[s];
#pragma unroll
            for (int r = 0; r < 4; ++r) { const int t = 16 * tt + 4 * q4 + r; const float v = s <= t ? acc[r] * expf(cums[t] - cs) * ds : 0.f;
                *(LAS unsigned short*)(lds + S2_WM + t * 144 + s * 2) = (unsigned short)f2bf(v); } }
#pragma unroll
        for (int mt = 0; mt < 4; ++mt)
#pragma unroll
            for (int r = 0; r < 4; ++r) *(LAS unsigned short*)(lds + S2_HB + (16 * mt + 4 * q4 + r) * 272 + (16 * w + l15) * 2) = (unsigned short)f2bf(hacc[mt][r]);
        __syncthreads();
        float ssq[4] = {0.f, 0.f, 0.f, 0.f};
#pragma unroll
        for (int e2 = 0; e2 < 2; ++e2) { const int pt = 2 * (w & 1) + e2; f32x4 y = {0.f, 0.f, 0.f, 0.f};
#pragma unroll
            for (int ks = 0; ks < 4; ++ks) y = __builtin_amdgcn_mfma_f32_16x16x32_bf16(*(const LAS bf16x8*)(lds + S2_C + tt * 16 * 272 + aoffC + ks * 64), *(const LAS bf16x8*)(lds + S2_HB + pt * 16 * 272 + aoffC + ks * 64), y, 0, 0, 0);
#pragma unroll
            for (int r = 0; r < 4; ++r) y[r] *= expf(cums[16 * tt + 4 * q4 + r]);
#pragma unroll
            for (int ke = 0; ke < 2; ++ke) y = __builtin_amdgcn_mfma_f32_16x16x32_bf16(*(const LAS bf16x8*)(lds + S2_WM + tt * 16 * 144 + aoffS + ke * 64), *(const LAS bf16x8*)(lds + S2_XT + pt * 16 * 144 + aoffS + ke * 64), y, 0, 0, 0);
            const int p = 16 * pt + l15;
#pragma unroll
            for (int r = 0; r < 4; ++r) { const int t = 16 * tt + 4 * q4 + r; const float xv = bflo((unsigned)*(const LAS unsigned short*)(lds + S2_XT + p * 144 + t * 2));
                const float yg = (y[r] + Dk * xv) * siluf_(zv[e2][r]); ssq[r] += yg * yg;
                Og[(size_t)(row0 + t) * 512 + (hd & 7) * 64 + p] = (bf16)f2bf(yg); } }
#pragma unroll
        for (int r = 0; r < 4; ++r) { const float s = row16_sum(ssq[r]); if (l15 == 0) SSQ[(size_t)(row0 + 16 * tt + 4 * q4 + r) * 32 + hd * 2 + (w & 1)] = s; }
        { const float e63 = expf(cums[63]);
#pragma unroll
          for (int mt = 0; mt < 4; ++mt) { hacc[mt] = hacc[mt] * e63;
#pragma unroll
              for (int ke = 0; ke < 2; ++ke) hacc[mt] = __builtin_amdgcn_mfma_f32_16x16x32_bf16(*(const LAS bf16x8*)(lds + S2_XTW + mt * 16 * 144 + aoffS + ke * 64), *(const LAS bf16x8*)(lds + S2_BT + w * 16 * 144 + aoffS + ke * 64), hacc[mt], 0, 0, 0); } }
    }
    float* hout = A->out + O_SSHP + ((size_t)(layer * NBATCH + b) * 16 + hd) * 8192;
#pragma unroll
    for (int mt = 0; mt < 4; ++mt)
#pragma unroll
        for (int r = 0; r < 4; ++r) hout[(size_t)(16 * mt + 4 * q4 + r) * 128 + 16 * w + l15] = hacc[mt][r];
    __syncthreads();
#undef S2_LOAD
#undef S2_STORE
}

constexpr int KS_PITCH = 272, VT_PITCH = 136;
constexpr int ATT_KS = 0, ATT_VT = 64 * KS_PITCH;
__device__ __forceinline__ void attn_prompt_unit(CA A, LAS unsigned char* lds, int layer, int unit, const int wv) {
    const int tid = tid_opaque(wv), lane = tid & 63, wid = tid >> 6, r = lane & 31, hh = lane >> 5;
    const int qb = 7 - (unit >> 4), bh = unit & 15, b = bh >> 2, h = bh & 3;
    const int q0 = qb * 256 + wid * 32, qpos = q0 + r;
    const bf16* QKV = WSP(bf16, WS_QKV) + (size_t)(b * SEQ) * 1536;
    bf16x8 Qf[8];
    { const bf16* qrow = QKV + (size_t)qpos * 1536 + h * 128 + 8 * hh;
#pragma unroll
      for (int s = 0; s < 8; ++s) Qf[s] = *(const bf16x8*)(qrow + 16 * s); }
    f32x16 O[4];
#pragma unroll
    for (int d = 0; d < 4; ++d)
#pragma unroll
        for (int i = 0; i < 16; ++i) O[d][i] = 0.f;
    float R = 0.f;
    const float bias2 = IN_F(I_SBBIAS)[layer * 4 + h] * LOG2E;
    const int ntile = qb * 4 + 4, srow = tid >> 3, sch = tid & 7;
    LAS unsigned char* Ks = lds + ATT_KS; LAS unsigned char* Vt = lds + ATT_VT;
    v4u kreg[2], vreg[2];
    { const bf16* src = QKV + (size_t)((ntile - 1) * 64 + srow) * 1536 + h * 128 + sch * 8;
      kreg[0] = *(const v4u*)(src + 512); kreg[1] = *(const v4u*)(src + 512 + 64); vreg[0] = *(const v4u*)(src + 1024); vreg[1] = *(const v4u*)(src + 1024 + 64); }
    for (int kt = ntile - 1; kt >= 0; --kt) {
        __syncthreads();
#pragma unroll
        for (int i = 0; i < 2; ++i) { *(LAS v4u*)(Ks + srow * KS_PITCH + (sch + 8 * i) * 16) = kreg[i];
            LAS unsigned short* vt = (LAS unsigned short*)Vt + ((sch + 8 * i) * 8) * (VT_PITCH / 2) + srow;
            const unsigned w[4] = {vreg[i].x, vreg[i].y, vreg[i].z, vreg[i].w};
#pragma unroll
            for (int e = 0; e < 4; ++e) { vt[(2 * e) * (VT_PITCH / 2)] = (unsigned short)(w[e] & 0xffffu); vt[(2 * e + 1) * (VT_PITCH / 2)] = (unsigned short)(w[e] >> 16); } }
        __syncthreads();
        if (kt > 0) { const bf16* src = QKV + (size_t)((kt - 1) * 64 + srow) * 1536 + h * 128 + sch * 8;
            kreg[0] = *(const v4u*)(src + 512); kreg[1] = *(const v4u*)(src + 512 + 64); vreg[0] = *(const v4u*)(src + 1024); vreg[1] = *(const v4u*)(src + 1024 + 64); }
        if (kt * 64 > q0 + 30) continue;
        const bool diag = (kt * 64 + 63 >= q0);
        const int kbase = kt * 64 + 4 * hh;
        bf16x8 Pf[4];
#pragma unroll
        for (int sub = 1; sub >= 0; --sub) {
            f32x16 sa;
#pragma unroll
            for (int i = 0; i < 16; ++i) sa[i] = bias2;
#pragma unroll
            for (int s = 0; s < 8; ++s) { const bf16x8 a = *(const LAS bf16x8*)(Ks + (32 * sub + r) * KS_PITCH + (16 * s + 8 * hh) * 2);
                sa = __builtin_amdgcn_mfma_f32_32x32x16_bf16(a, Qf[s], sa, 0, 0, 0); }
            float sp[16], Gs[4], Gp[4];
#pragma unroll
            for (int i = 0; i < 16; ++i) { const float z = fminf(sa[i], 60.f); sa[i] = z; float s1 = lg2(1.0f + ex2(z));
                if (diag && (kbase + 32 * sub + 8 * (i >> 2) + (i & 3) >= qpos)) s1 = 0.f;
                sp[i] = s1; }
#pragma unroll
            for (int g = 0; g < 4; ++g) { Gs[g] = (sp[4 * g] + sp[4 * g + 1]) + (sp[4 * g + 2] + sp[4 * g + 3]); Gp[g] = __shfl_xor(Gs[g], 32); }
            float run = R;
#pragma unroll
            for (int g = 3; g >= 0; --g) { float a = run + (hh == 0 ? Gp[g] : 0.f);
#pragma unroll
                for (int e = 3; e >= 0; --e) { const int i = 4 * g + e; float pv = ex2(sa[i] - sp[i] - a);
                    if (diag && (kbase + 32 * sub + 8 * g + e >= qpos)) pv = 0.f;
                    a += sp[i]; sp[i] = pv; }
                run += Gs[g] + Gp[g]; }
            R = run;
#pragma unroll
            for (int q2 = 0; q2 < 2; ++q2) { const int bs = 8 * q2; v4u w;
                w.x = pk2(sp[bs + 0], sp[bs + 1]); w.y = pk2(sp[bs + 2], sp[bs + 3]); w.z = pk2(sp[bs + 4], sp[bs + 5]); w.w = pk2(sp[bs + 6], sp[bs + 7]);
                Pf[2 * sub + q2] = __builtin_bit_cast(bf16x8, w); }
        }
#pragma unroll
        for (int d = 0; d < 4; ++d)
#pragma unroll
            for (int s4 = 0; s4 < 4; ++s4) { const LAS unsigned char* vp = Vt + (32 * d + r) * VT_PITCH + (16 * s4 + 4 * hh) * 2;
                const v2u lo = *(const LAS v2u*)vp, hi = *(const LAS v2u*)(vp + 16); v4u w; w.x = lo.x; w.y = lo.y; w.z = hi.x; w.w = hi.y;
                O[d] = __builtin_amdgcn_mfma_f32_32x32x16_bf16(__builtin_bit_cast(bf16x8, w), Pf[s4], O[d], 0, 0, 0); }
    }
    bf16* orow = WSP(bf16, WS_OBR) + (size_t)2 * MP * 512 + (size_t)(b * SEQ + qpos) * 512 + h * 128 + 4 * hh;
#pragma unroll
    for (int d = 0; d < 4; ++d)
#pragma unroll
        for (int g = 0; g < 4; ++g) { v2u w; w.x = pk2(O[d][4 * g], O[d][4 * g + 1]); w.y = pk2(O[d][4 * g + 2], O[d][4 * g + 3]); *(v2u*)(orow + 32 * d + 8 * g) = w; }
}

__device__ __forceinline__ void attn_sample_unit(CA A, LAS unsigned char* lds, int layer, int unit, const int wv) {
    const int tid = tid_opaque(wv), lane = tid & 63, wid = tid >> 6, sb = unit >> 5, pg4 = unit & 31, hd = lane >> 4;
    const int lp = 4 * pg4 + (wid >> 1), phys = ((const int*)A->in[I_PT])[sb * NPAGES + lp];
    const size_t pbase = ((size_t)(layer * NPOOL + phys) * PAGE + (wid & 1) * 64) * 512 + lane * 8;
    const float* Kc = IN_F(I_CK) + pbase; const float* Vc = IN_F(I_CV) + pbase;
    const bf16* QKV = WSP(bf16, WS_QKV);
    float qf[4][8], O[4][8], R[4];
#pragma unroll
    for (int i = 0; i < 4; ++i) { const v4u w = *(const v4u*)(QKV + (size_t)(TP + sb * 4 + i) * 1536 + lane * 8);
        qf[i][0] = bflo(w.x); qf[i][1] = bfhi(w.x); qf[i][2] = bflo(w.y); qf[i][3] = bfhi(w.y); qf[i][4] = bflo(w.z); qf[i][5] = bfhi(w.z); qf[i][6] = bflo(w.w); qf[i][7] = bfhi(w.w);
        R[i] = 0.f;
#pragma unroll
        for (int j = 0; j < 8; ++j) O[i][j] = 0.f; }
    const float bias2 = IN_F(I_SBBIAS)[layer * 4 + hd] * LOG2E;
#pragma unroll 4
    for (int t = 63; t >= 0; --t) {
        const f32x4 k0 = *(const f32x4*)(Kc + (size_t)t * 512), k1 = *(const f32x4*)(Kc + (size_t)t * 512 + 4), v0 = *(const f32x4*)(Vc + (size_t)t * 512), v1 = *(const f32x4*)(Vc + (size_t)t * 512 + 4);
#pragma unroll
        for (int i = 0; i < 4; ++i) {
            float s = (qf[i][0] * k0[0] + qf[i][1] * k0[1]) + (qf[i][2] * k0[2] + qf[i][3] * k0[3]) + (qf[i][4] * k1[0] + qf[i][5] * k1[1]) + (qf[i][6] * k1[2] + qf[i][7] * k1[3]);
            s = row16_sum(s);
            const float z = fminf(s + bias2, 60.f), s1 = lg2(1.0f + ex2(z)), pv = ex2(z - s1 - R[i]); R[i] += s1;
#pragma unroll
            for (int e = 0; e < 4; ++e) { O[i][e] += pv * v0[e]; O[i][4 + e] += pv * v1[e]; } }
    }
    LAS float* Ow = (LAS float*)lds;
    LAS float* Rw = Ow + 8 * 4 * 512;
    __syncthreads();
#pragma unroll
    for (int i = 0; i < 4; ++i) { *(LAS f32x4*)(Ow + (wid * 4 + i) * 512 + lane * 8) = (f32x4){O[i][0], O[i][1], O[i][2], O[i][3]}; *(LAS f32x4*)(Ow + (wid * 4 + i) * 512 + lane * 8 + 4) = (f32x4){O[i][4], O[i][5], O[i][6], O[i][7]};
        if ((lane & 15) == 0) Rw[(wid * 4 + i) * 4 + hd] = R[i]; }
    __syncthreads();
    float* PART = WSP(float, WS_PART) + (size_t)unit * 2048; float* PR = WSP(float, WS_PR) + (size_t)unit * 16;
    for (int idx = tid; idx < 2048; idx += NTHR) { const int i = idx >> 9, c = idx & 511, hc = c >> 7; float acc = 0.f, racc = 0.f;
#pragma unroll
        for (int w = 7; w >= 0; --w) { acc += ex2(-racc) * Ow[(w * 4 + i) * 512 + c]; racc += Rw[(w * 4 + i) * 4 + hc]; }
        PART[idx] = acc; if ((c & 127) == 0) PR[i * 4 + hc] = racc; }
}
__device__ __forceinline__ void attn_sample_combine(CA A, int layer, const int wv) {
    const int tid = tid_opaque(wv), lane = tid & 63, gw = blk_opaque() * NWAVES + (tid >> 6), NGW = gridDim.x * NWAVES;
    const bf16* QKV = WSP(bf16, WS_QKV); const float* PART = WSP(float, WS_PART); const float* PR = WSP(float, WS_PR);
    const float* kn = A->out + O_KS + (size_t)layer * TS * 512; const float* vn = A->out + O_VS + (size_t)layer * TS * 512;
    bf16* O2 = WSP(bf16, WS_OBR) + (size_t)2 * MP * 512;
    for (int it = gw; it < TS * 4; it += NGW) { const int sb = it >> 4, i = (it >> 2) & 3, hd = it & 3, row = TP + sb * 4 + i, c = hd * 128 + 2 * lane;
        const unsigned qw = *(const unsigned*)(QKV + (size_t)row * 1536 + c); const float q0 = bflo(qw), q1 = bfhi(qw);
        const float bias2 = IN_F(I_SBBIAS)[layer * 4 + hd] * LOG2E; float o0 = 0.f, o1 = 0.f, racc = 0.f;
        for (int j = i - 1; j >= 0; --j) { const float* kr = kn + (size_t)(sb * 4 + j) * 512 + c; const float* vr = vn + (size_t)(sb * 4 + j) * 512 + c;
            const float z = fminf(wave_sum(q0 * kr[0] + q1 * kr[1]) + bias2, 60.f), s1 = lg2(1.0f + ex2(z)), pv = ex2(z - s1 - racc); racc += s1; o0 += pv * vr[0]; o1 += pv * vr[1]; }
        for (int u = 31; u >= 0; --u) { const float* pr = PART + ((size_t)(sb * 32 + u) * 4 + i) * 512 + c; const float sc = ex2(-racc); o0 += sc * pr[0]; o1 += sc * pr[1]; racc += PR[(size_t)(sb * 32 + u) * 16 + i * 4 + hd]; }
        *(unsigned*)(O2 + (size_t)row * 512 + c) = pk2(o0, o1); }
}

#ifndef MK_ONE_LAUNCH
#define MK_ONE_LAUNCH 1
#endif
#ifndef REP_P0
#define REP_P0 1
#endif
#ifndef REP_IN
#define REP_IN 1
#endif
#ifndef REP_PREP
#define REP_PREP 1
#endif
#ifndef REP_MIXA
#define REP_MIXA 1
#endif
#ifndef REP_MIXB
#define REP_MIXB 1
#endif
#ifndef REP_MERGE
#define REP_MERGE 1
#endif
#ifndef REP_OUT
#define REP_OUT 1
#endif
#ifndef REP_UP
#define REP_UP 1
#endif
#ifndef REP_DOWN
#define REP_DOWN 1
#endif
constexpr int N_PHASES = 24;
__device__ __forceinline__ int queue_pop(unsigned* head, volatile LAS unsigned* slot, const int wv) {
    __syncthreads();
    if (tid_opaque(wv) == 0) *slot = __hip_atomic_fetch_add(head, 1u, __ATOMIC_RELAXED, __HIP_MEMORY_SCOPE_AGENT);
    __syncthreads();
    return (int)*slot;
}
__global__ void __launch_bounds__(NTHR, 2) mega(Args Araw) {
    extern __shared__ __attribute__((aligned(16))) unsigned char lds_raw[];
    LAS unsigned char* lds = (LAS unsigned char*)lds_raw;
    volatile LAS unsigned* MISC = (volatile LAS unsigned*)(lds + MISC_OFF);
    const int wv = __builtin_amdgcn_readfirstlane(threadIdx.x >> 6); const int tid = tid_opaque(wv), G = gridDim.x, blk = blk_opaque();
    if (tid < 16) MISC[tid] = 0u;
    __syncthreads();
    unsigned* ctl = (unsigned*)(Araw.ws + WS_CTL);
    XcdBarrier bar = xcd_barrier_post(ctl + CW_BAR + Araw.li * XCD_BAR_WORDS, MISC, tid);
    const int lo = Araw.ph_lo, hi = Araw.ph_hi;
#define IN(gp) (lo <= (gp) && (gp) < hi)
#define SEAM(gp) do { if (lo <= (gp) && (gp) + 1 < hi) xcd_barrier(bar, tid_opaque(wv)); } while (0)

    if (IN(0)) for (int rep = 0; rep < REP_P0; ++rep) { CA A = args_opaque(); p0_prologue(A, lds, wv); }
    SEAM(0);
    if (IN(1)) { CA A = args_opaque(); norm1_phase(A, wv); }
    SEAM(1);
    for (int layer = 0; layer < DEPTH; ++layer) {
        const int gb = 1 + 11 * layer;
        if (IN(gb + 1)) for (int rep = 0; rep < REP_IN; ++rep) { CA A = args_opaque();
            pg8::Gemm g{WSP(bf16, WS_H), WSP(bf16, WS_WIN) + (size_t)layer * NIN * DM, MP, NIN, DM}; pg8::StaticOrder S; S.init(MP, NIN, G, blk_opaque());
            EpiIn E{WSP(float, WS_UF), WSP(bf16, WS_QKV), WSP(bf16, WS_GATE), A->out + O_KP + (size_t)layer * TP * 512, A->out + O_VP + (size_t)layer * TP * 512,
                    A->out + O_KS + (size_t)layer * TS * 512, A->out + O_VS + (size_t)layer * TS * 512, 0.08838834764831845f * LOG2E};
            pg8::gemm_phase<EpiIn, pg8::StaticOrder, true, true>(lds, g, S, E, wv);
        }
        SEAM(gb + 1);
        if (IN(gb + 2)) for (int rep = 0; rep < REP_PREP; ++rep) { CA A = args_opaque(); prep_phase(A, layer, wv); }
        SEAM(gb + 2);
        if (IN(gb + 3)) for (int rep = 0; rep < REP_MIXA; ++rep) { CA A = args_opaque();
            { unsigned* qh = ctl + CW_QUEUE + 64 * (layer * 4 + 3) + 1024 * rep;
              for (;;) { const int u = queue_pop(qh, MISC + 4, wv); if (u >= 2048) break; ssd_prep_unit(A, lds, layer, u, wv); } }
            { unsigned* qh = ctl + CW_QUEUE + 64 * (layer * 4 + 2) + 1024 * rep;
              for (;;) { const int u = queue_pop(qh, MISC + 4, wv); if (u >= 512) break; dn_chunk_unit(A, lds, layer, u, wv); } }
            { unsigned* qh = ctl + CW_QUEUE + 64 * (layer * 4 + 0) + 1024 * rep;
              for (;;) { const int u = queue_pop(qh, MISC + 4, wv); if (u >= 128) break; attn_prompt_unit(A, lds, layer, u, wv); } }
        }
        SEAM(gb + 3);
        if (IN(gb + 4)) for (int rep = 0; rep < REP_MIXB; ++rep) { CA A = args_opaque();
            for (int t = blk; t < 16; t += G) dn_seq2(A, lds, layer, t, wv);
            for (int t = blk; t < 80; t += G) if (t >= 16) ssd_seq2(A, lds, layer, t - 16, wv);
            for (int t = blk; t < 112; t += G) if (t >= 80) dn_seq(A, lds, layer, t - 80 + 16, wv);
            for (int t = blk; t < 240; t += G) if (t >= 112) ssd_seq(A, lds, layer, t - 112 + 64, wv);
            { unsigned* qh = ctl + CW_QUEUE + 64 * (layer * 4 + 1) + 1024 * rep;
              for (;;) { const int u = queue_pop(qh, MISC + 4, wv); if (u >= 256) break; attn_sample_unit(A, lds, layer, u, wv); } }
        }
        SEAM(gb + 4);
        if (IN(gb + 5)) { CA A = args_opaque(); attn_sample_combine(A, layer, wv); }
        SEAM(gb + 5);
        if (IN(gb + 6)) for (int rep = 0; rep < REP_MERGE; ++rep) { CA A = args_opaque();
            pg8::StaticOrder S; S.init(MP, DM, G, blk_opaque());
            const bf16* Wb = WSP(bf16, WS_WBR) + (size_t)layer * 5 * DM * 512; const bf16* Ob = WSP(bf16, WS_OBR);
            const bf16* GT = WSP(bf16, WS_GATE); const float* SQ = WSP(float, WS_SSQ); float* MG = WSP(float, WS_MG32); bf16* MB = WSP(bf16, WS_MGB);
            { pg8::Gemm g{Ob + (size_t)0 * MP * 512, Wb + (size_t)0 * DM * 512, MP, DM, 512}; EpiMerge<0> E{GT, SQ, MG, MB}; pg8::gemm_phase<EpiMerge<0>, pg8::StaticOrder, true, true>(lds, g, S, E, wv); }
            { pg8::Gemm g{Ob + (size_t)1 * MP * 512, Wb + (size_t)1 * DM * 512, MP, DM, 512}; EpiMerge<1> E{GT, SQ, MG, MB}; pg8::gemm_phase<EpiMerge<1>, pg8::StaticOrder, true, true>(lds, g, S, E, wv); }
            { pg8::Gemm g{Ob + (size_t)2 * MP * 512, Wb + (size_t)2 * DM * 512, MP, DM, 512}; EpiMerge<2> E{GT, SQ, MG, MB}; pg8::gemm_phase<EpiMerge<2>, pg8::StaticOrder, true, true>(lds, g, S, E, wv); }
            { pg8::Gemm g{Ob + (size_t)3 * MP * 512, Wb + (size_t)3 * DM * 512, MP, DM, 512}; EpiMerge<3> E{GT, SQ, MG, MB}; pg8::gemm_phase<EpiMerge<3>, pg8::StaticOrder, true, true>(lds, g, S, E, wv); }
            { pg8::Gemm g{Ob + (size_t)4 * MP * 512, Wb + (size_t)4 * DM * 512, MP, DM, 512}; EpiMerge<4> E{GT, SQ, MG, MB}; pg8::gemm_phase<EpiMerge<4>, pg8::StaticOrder, true, true>(lds, g, S, E, wv); }
        }
        SEAM(gb + 6);
        if (IN(gb + 7)) for (int rep = 0; rep < REP_OUT; ++rep) { CA A = args_opaque();
            pg8::Gemm g{WSP(bf16, WS_MGB), WSP(bf16, WS_WOUT) + (size_t)layer * DM * DM, MP, DM, DM}; pg8::StaticOrder S; S.init(MP, DM, G, blk_opaque());
            EpiF32 E{WSP(float, WS_MIX), DM}; pg8::gemm_phase<EpiF32, pg8::StaticOrder, true, true>(lds, g, S, E, wv);
        }
        SEAM(gb + 7);
        if (IN(gb + 8)) { CA A = args_opaque(); resid_phase(A, WSP(float, WS_MIX), IN_F(I_NMPOST) + layer * DM, IN_F(I_NLPRE) + layer * DM, layer == 0, wv); }
        SEAM(gb + 8);
        if (IN(gb + 9)) for (int rep = 0; rep < REP_UP; ++rep) { CA A = args_opaque();
            pg8::Gemm g{WSP(bf16, WS_H), WSP(bf16, WS_WUP) + (size_t)layer * DFF * DM, MP, DFF, DM}; pg8::StaticOrder S; S.init(MP, DFF, G, blk_opaque());
            EpiRelu2 E{WSP(bf16, WS_F), DFF}; pg8::gemm_phase<EpiRelu2, pg8::StaticOrder, true, true>(lds, g, S, E, wv);
        }
        SEAM(gb + 9);
        if (IN(gb + 10)) for (int rep = 0; rep < REP_DOWN; ++rep) { CA A = args_opaque();
            pg8::Gemm g{WSP(bf16, WS_F), WSP(bf16, WS_WDN) + (size_t)layer * DM * DFF, MP, DM, DFF}; pg8::StaticOrder S; S.init(MP, DM, G, blk_opaque());
            EpiF32 E{WSP(float, WS_FD), DM}; pg8::gemm_phase<EpiF32, pg8::StaticOrder, true, true>(lds, g, S, E, wv);
        }
        SEAM(gb + 10);
        if (IN(gb + 11)) { CA A = args_opaque(); resid_phase(A, WSP(float, WS_FD), IN_F(I_NLPOST) + layer * DM, layer + 1 < DEPTH ? IN_F(I_NMPRE) + (layer + 1) * DM : nullptr, false, wv); }
        SEAM(gb + 11);
    }
#undef IN
#undef SEAM
}

extern "C" void kernel_launch(void* const* d_in, const int* in_sizes, int n_in, void* d_out, int out_size, void* d_ws, size_t ws_size, hipStream_t stream) {
    static int grid = 0;
    if (grid == 0) {
        if (n_in != N_IN || (size_t)out_size != O_END || ws_size < WS_END) { fprintf(stderr, "kernel_launch: unexpected problem (n_in %d, out %d vs %zu, ws %zu vs %zu); nothing launched\n", n_in, out_size, (size_t)O_END, ws_size, (size_t)WS_END); grid = -1; return; }
        int dev = 0, cus = 0, per_cu = 0;
        if (hipGetDevice(&dev) != hipSuccess || hipDeviceGetAttribute(&cus, hipDeviceAttributeMultiprocessorCount, dev) != hipSuccess) { grid = -1; return; }
        if (hipFuncSetAttribute((const void*)mega, hipFuncAttributeMaxDynamicSharedMemorySize, LDS_BYTES) != hipSuccess) { fprintf(stderr, "kernel_launch: hipFuncSetAttribute failed\n"); grid = -1; return; }
        if (hipOccupancyMaxActiveBlocksPerMultiprocessor(&per_cu, (const void*)mega, NTHR, LDS_BYTES) != hipSuccess || per_cu < 1) fprintf(stderr, "kernel_launch: occupancy query says %d blocks per CU\n", per_cu);
        (void)hipGetLastError();
        grid = cus;
    }
    if (grid < 0) return;
    (void)in_sizes;
    hipMemsetAsync((char*)d_ws + WS_CTL, 0, CTL_BYTES, stream);
    Args a{};
    for (int i = 0; i < N_IN; ++i) a.in[i] = d_in[i];
    a.out = (float*)d_out; a.ws = (unsigned char*)d_ws; a.pad = 0;
#if MK_ONE_LAUNCH
    a.ph_lo = 0; a.ph_hi = N_PHASES; a.li = 0;
    hipLaunchKernelGGL(mega, dim3(grid), dim3(NTHR), LDS_BYTES, stream, a);
#else
    for (int gp = 0; gp < N_PHASES; ++gp) { a.ph_lo = gp; a.ph_hi = gp + 1; a.li = 0; hipLaunchKernelGGL(mega, dim3(grid), dim3(NTHR), LDS_BYTES, stream, a); }
#endif
}
```

```cpp
#include <hip/hip_runtime.h>
#include <cstdio>
#include <cstdint>
__device__ __forceinline__ int lane_opaque() { unsigned m = ~0u; asm volatile("" : "+s"(m)); return (int)__builtin_amdgcn_mbcnt_hi(m, __builtin_amdgcn_mbcnt_lo(m, 0u)); }
__device__ __forceinline__ int tid_opaque(int wv) { return wv * 64 + lane_opaque(); }
__device__ __forceinline__ int blk_opaque() { int t = blockIdx.x; asm volatile("" : "+s"(t)); return t; }
namespace pg8 {
#define PG8_LAS __attribute__((address_space(3)))
typedef unsigned short bf16_t;
typedef short bf16x8 __attribute__((ext_vector_type(8)));
typedef float f32x4 __attribute__((ext_vector_type(4)));
typedef unsigned u32x4 __attribute__((ext_vector_type(4)));
constexpr int BM = 256, BK = 64, HALF = 128, HTB = HALF * BK * 2  , STAGE_BYTES = 8 * HTB, NXCD = 8, WGM = 8;

__host__ __device__ __forceinline__ int lds_byte(int r, int c) { const int st = (r >> 4) * 2 + (c >> 5), rr = r & 15, cc = c & 31, ob = rr * 64 + cc * 2; return st * 1024 + (ob ^ (((ob >> 9) & 1) << 5)); }
__host__ __device__ __forceinline__ void stage_rc(int b, int& R, int& C) { const int st = b / 1024, sb = b % 1024, swz = sb ^ (((sb >> 9) & 1) << 5); R = (st >> 1) * 16 + swz / 64; C = (st & 1) * 32 + (swz % 64) / 2; }
__host__ __device__ __forceinline__ int perm32(int rho) { const int n = rho >> 4, i = rho & 15; return 8 * (i >> 2) + 4 * n + (i & 3); }

struct Unit { int pm, pn; };
struct Gemm { const bf16_t* A; const bf16_t* Bt; int M, N, K; };

struct StaticOrder {
    int nM, nN, nwg, G, c;
    __host__ __device__ void init(int M, int N, int G_, int c_) { nM = M / BM; nN = N / BM; nwg = nM * nN; G = G_; c = c_; }
    __host__ __device__ bool next(int i, Unit& u) const {
        const long L = (long)i * G + c; if (L >= nwg) return false;
        int wgid = (int)L; { const int q = nwg / NXCD, r = nwg % NXCD, xcd = wgid % NXCD, off = wgid / NXCD; wgid = (xcd < r ? xcd * (q + 1) : r * (q + 1) + (xcd - r) * q) + off; }
        const int nig = WGM * nN, gid = wgid / nig, fm = gid * WGM, gsz = (nM - fm) < WGM ? (nM - fm) : WGM;
        u.pm = fm + ((wgid % nig) % gsz); u.pn = (wgid % nig) / gsz; return true;
    }
    __device__ __forceinline__ void a_ready(const Unit&) const {}
    __device__ __forceinline__ void done(const Unit&) const {}
};
__device__ __forceinline__ unsigned cvt_pk_bf16(float lo, float hi) { unsigned r; asm volatile("v_cvt_pk_bf16_f32 %0, %1, %2" : "=v"(r) : "v"(lo), "v"(hi)); return r; }
typedef float f32x2 __attribute__((ext_vector_type(2)));
template <class Epi, class Sched, bool ALIGN_EPI = false, bool SP2 = false>
__device__ __forceinline__ void gemm_phase(PG8_LAS unsigned char* lds, const Gemm g, const Sched& S, const Epi& E, const int wv) {
    const int lane = lane_opaque(), tid = wv * 64 + lane, wid = wv, wr = wid >> 2, wc = wid & 3, fr = lane & 15, fq = lane >> 4;
    const int K = g.K, nt = K / BK;
    unsigned voffA[2], voffB[2];
#pragma unroll
    for (int i = 0; i < 2; ++i) { int R, C; stage_rc(tid * 16 + i * 8192, R, C); const int Rb = Epi::PERM ? ((R & ~31) + perm32(R & 31)) : R;
        voffA[i] = (unsigned)(R * K + C) * 2u; voffB[i] = (unsigned)(Rb * K + C) * 2u; }
    const size_t kstep = (size_t)(BK * 2);
    const size_t hstep = (size_t)HALF * K * 2;
    const size_t tstep = 2 * hstep;
    const unsigned ldsw = (unsigned)wid * 1024u;
    const int aoff = lds_byte(wr * 64 + fr, fq * 8), boff = lds_byte(wc * 32 + fr, fq * 8);
#define PG8_SA(b, h) (((b) * 2 + (h)) * HTB)
#define PG8_SB(b, h) ((4 + (b) * 2 + (h)) * HTB)
#define PG8_STAGE(bufoff, gbase, voff) do { _Pragma("unroll") for (int _i = 0; _i < 2; ++_i) \
        __builtin_amdgcn_global_load_lds((const unsigned*)((const char*)(gbase) + (voff)[_i]), (PG8_LAS unsigned*)(lds + (bufoff) + ldsw + _i * 8192), 16, 0, 0); } while (0)
#define PG8_LDA(dst, b, h) do { _Pragma("unroll") for (int m = 0; m < 4; ++m) _Pragma("unroll") for (int k = 0; k < 2; ++k) dst[m][k] = *(const PG8_LAS bf16x8*)(lds + PG8_SA(b, h) + aoff + m * 2048 + k * 1024); } while (0)
#define PG8_LDB(dst, b, h) do { _Pragma("unroll") for (int n = 0; n < 2; ++n) _Pragma("unroll") for (int k = 0; k < 2; ++k) dst[n][k] = *(const PG8_LAS bf16x8*)(lds + PG8_SB(b, h) + boff + n * 2048 + k * 1024); } while (0)
#define PG8_MMA(ai, bj, At, Bt) do { __builtin_amdgcn_s_setprio(1); _Pragma("unroll") for (int m = 0; m < 4; ++m) _Pragma("unroll") for (int n = 0; n < 2; ++n) _Pragma("unroll") for (int k = 0; k < 2; ++k) \
        acc[ai][bj][m][n] = __builtin_amdgcn_mfma_f32_16x16x32_bf16(Bt[n][k], At[m][k], acc[ai][bj][m][n], 0, 0, 0); __builtin_amdgcn_s_setprio(0); } while (0)
#define PG8_WAIT_V(n) asm volatile("s_waitcnt vmcnt(" #n ")" ::: "memory")
#define PG8_WAIT_L(n) asm volatile("s_waitcnt lgkmcnt(" #n ")" ::: "memory")
#define PG8_BAR __builtin_amdgcn_s_barrier()
#define PG8_SCHED __builtin_amdgcn_sched_barrier(0)
    Unit cur, nxt; int ui = 0;
    if (!S.next(0, cur)) return;
    f32x4 acc[2][2][4][2];
#pragma unroll
    for (int a = 0; a < 2; ++a)
#pragma unroll
        for (int b = 0; b < 2; ++b)
#pragma unroll
            for (int m = 0; m < 4; ++m)
#pragma unroll
                for (int n = 0; n < 2; ++n) acc[a][b][m][n] = (f32x4){0.f, 0.f, 0.f, 0.f};
    bf16x8 At[4][2], B0[2][2], B1[2][2];
    const char* cA = (const char*)g.A + (size_t)cur.pm * tstep; const char* cB = (const char*)g.Bt + (size_t)cur.pn * tstep;
    S.a_ready(cur);
    if constexpr (SP2) {
        PG8_STAGE(PG8_SB(0, 0), cB, voffB); PG8_STAGE(PG8_SB(0, 1), cB + hstep, voffB); PG8_STAGE(PG8_SA(0, 0), cA, voffA); PG8_STAGE(PG8_SA(0, 1), cA + hstep, voffA);
        if (wr == 1) PG8_BAR;
        PG8_WAIT_V(2); PG8_BAR;
        PG8_STAGE(PG8_SB(1, 0), cB + kstep, voffB); PG8_STAGE(PG8_SA(1, 0), cA + kstep, voffA); PG8_STAGE(PG8_SB(1, 1), cB + hstep + kstep, voffB);
        PG8_WAIT_V(6); PG8_BAR;
    } else {
        PG8_STAGE(PG8_SB(0, 0), cB, voffB); PG8_STAGE(PG8_SA(0, 0), cA, voffA); PG8_STAGE(PG8_SB(0, 1), cB + hstep, voffB); PG8_STAGE(PG8_SA(0, 1), cA + hstep, voffA);
        if (wr == 1) PG8_BAR;
        PG8_WAIT_V(4); PG8_BAR;
        PG8_STAGE(PG8_SB(1, 0), cB + kstep, voffB); PG8_STAGE(PG8_SA(1, 0), cA + kstep, voffA); PG8_STAGE(PG8_SB(1, 1), cB + hstep + kstep, voffB);
        PG8_WAIT_V(6); PG8_BAR;
    }
    for (;;) {
        const bool has_next = S.next(ui + 1, nxt);
        const char* nA = has_next ? (const char*)g.A + (size_t)nxt.pm * tstep : cA; const char* nB = has_next ? (const char*)g.Bt + (size_t)nxt.pn * tstep : cB;
        for (int t = 0; t < nt; t += 2) {
            const bool last = (t == nt - 2);
            const char* a1 = cA + (size_t)(t + 1) * kstep;
            const char* a2 = last ? nA : cA + (size_t)(t + 2) * kstep; const char* b2 = last ? nB : cB + (size_t)(t + 2) * kstep;
            const char* a3 = a2 + kstep; const char* b3 = b2 + kstep;
            if (last && has_next) S.a_ready(nxt);
            if constexpr (SP2) {
            PG8_LDB(B0, 0, 0); PG8_LDB(B1, 0, 1); PG8_SCHED; PG8_LDA(At, 0, 0); PG8_STAGE(PG8_SA(1, 1), a1 + hstep, voffA);
            PG8_WAIT_V(8); PG8_WAIT_L(0); PG8_BAR; PG8_MMA(0, 0, At, B0); PG8_MMA(0, 1, At, B1); PG8_BAR; PG8_SCHED;
            PG8_LDA(At, 0, 1); PG8_STAGE(PG8_SB(0, 0), b2, voffB); PG8_STAGE(PG8_SB(0, 1), b2 + hstep, voffB); PG8_STAGE(PG8_SA(0, 0), a2, voffA);
            PG8_WAIT_V(8); PG8_WAIT_L(0); PG8_BAR; PG8_MMA(1, 0, At, B0); PG8_MMA(1, 1, At, B1); PG8_BAR; PG8_SCHED;
            PG8_LDB(B0, 1, 0); PG8_LDB(B1, 1, 1); PG8_SCHED; PG8_LDA(At, 1, 0); PG8_STAGE(PG8_SA(0, 1), a2 + hstep, voffA);
            PG8_WAIT_V(8); PG8_WAIT_L(0); PG8_BAR; PG8_MMA(0, 0, At, B0); PG8_MMA(0, 1, At, B1); PG8_BAR; PG8_SCHED;
            PG8_LDA(At, 1, 1); PG8_STAGE(PG8_SB(1, 0), b3, voffB); PG8_STAGE(PG8_SB(1, 1), b3 + hstep, voffB); PG8_STAGE(PG8_SA(1, 0), a3, voffA);
            PG8_WAIT_V(8); PG8_WAIT_L(0); PG8_BAR; PG8_MMA(1, 0, At, B0); PG8_MMA(1, 1, At, B1); PG8_BAR; PG8_SCHED;
            } else {
            PG8_LDB(B0, 0, 0); PG8_SCHED; PG8_LDA(At, 0, 0); PG8_STAGE(PG8_SA(1, 1), a1 + hstep, voffA);
            PG8_WAIT_L(8); PG8_BAR; PG8_WAIT_L(0); PG8_MMA(0, 0, At, B0); PG8_BAR; PG8_SCHED;
            PG8_LDB(B1, 0, 1); PG8_STAGE(PG8_SB(0, 0), b2, voffB);
            PG8_BAR; PG8_WAIT_L(0); PG8_MMA(0, 1, At, B1); PG8_BAR;
            PG8_LDA(At, 0, 1); PG8_STAGE(PG8_SA(0, 0), a2, voffA);
            PG8_BAR; PG8_WAIT_L(0); PG8_MMA(1, 0, At, B0); PG8_BAR; PG8_SCHED;
            PG8_STAGE(PG8_SB(0, 1), b2 + hstep, voffB);
            PG8_WAIT_V(6); PG8_BAR; PG8_MMA(1, 1, At, B1); PG8_BAR;
            PG8_LDB(B0, 1, 0); PG8_SCHED; PG8_LDA(At, 1, 0); PG8_STAGE(PG8_SA(0, 1), a2 + hstep, voffA);
            PG8_WAIT_L(8); PG8_BAR; PG8_WAIT_L(0); PG8_MMA(0, 0, At, B0); PG8_BAR; PG8_SCHED;
            PG8_LDB(B1, 1, 1); PG8_STAGE(PG8_SB(1, 0), b3, voffB);
            PG8_BAR; PG8_WAIT_L(0); PG8_MMA(0, 1, At, B1); PG8_BAR;
            PG8_LDA(At, 1, 1); PG8_STAGE(PG8_SA(1, 0), a3, voffA);
            PG8_BAR; PG8_WAIT_L(0); PG8_MMA(1, 0, At, B0); PG8_BAR; PG8_SCHED;
            PG8_STAGE(PG8_SB(1, 1), b3 + hstep, voffB);
            PG8_WAIT_V(6); PG8_BAR; PG8_MMA(1, 1, At, B1); PG8_BAR;
            }
        }
        if constexpr (ALIGN_EPI) { if (wr == 0) PG8_BAR; }
        if constexpr (!Epi::AFTER_DRAIN) { E(acc, cur, wr, wc, fr, fq); S.done(cur); }
        if (!has_next) break;
#pragma unroll
        for (int a = 0; a < 2; ++a)
#pragma unroll
            for (int b = 0; b < 2; ++b)
#pragma unroll
                for (int m = 0; m < 4; ++m)
#pragma unroll
                    for (int n = 0; n < 2; ++n) acc[a][b][m][n] = (f32x4){0.f, 0.f, 0.f, 0.f};
        cur = nxt; cA = nA; cB = nB; ++ui;
        if constexpr (ALIGN_EPI) { if (wr == 1) PG8_BAR; }
    }
    PG8_WAIT_V(0);
    if constexpr (!ALIGN_EPI) { if (wr == 0) PG8_BAR; }
    PG8_BAR;
    if constexpr (Epi::AFTER_DRAIN) { E.fused(acc, cur, wr, wc, fr, fq, lds, wid, lane); S.done(cur); }
#undef PG8_SA
#undef PG8_SB
#undef PG8_STAGE
#undef PG8_LDA
#undef PG8_LDB
#undef PG8_MMA
#undef PG8_WAIT_V
#undef PG8_WAIT_L
#undef PG8_BAR
#undef PG8_SCHED
}
}

constexpr int DM = 2048, NBATCH = 4, SEQ = 2048, DEPTH = 2, DBATCH = 8, DSEQ = 4, PAST = 16384, PAGE = 128;
constexpr int TP = NBATCH * SEQ;
constexpr int TS = DBATCH * DSEQ;
constexpr int TT = TP + TS;
constexpr int MP = 8448;
constexpr int NPAGES = PAST / PAGE;
constexpr int NPOOL = 1280;
constexpr int POOLW = 512, DNC = 1536, SBW = 512, SSI = 1024, SSC = 1536, DFF = 8192;
constexpr int INCOLS = 14872, NIN = 15104;
constexpr int UFW = 5376;
constexpr int UF_POOL = 0, UF_DNQKV = 512, UF_DNZ = 2048, UF_SSZ = 2560, UF_XBC = 3584, UF_SMALL = 5120;
constexpr float RMS_EPS = 1e-6f;
constexpr float LOG2E = 1.4426950408889634f;
constexpr int NWAVES = 8, NTHR = 512;

constexpr size_t O_Y = 0;
constexpr size_t O_KP = O_Y + (size_t)TT * DM;
constexpr size_t O_VP = O_KP + (size_t)DEPTH * TP * 512;
constexpr size_t O_POOLP = O_VP + (size_t)DEPTH * TP * 512;
constexpr size_t O_DNCP = O_POOLP + (size_t)DEPTH * NBATCH * 15 * 512;
constexpr size_t O_DNSP = O_DNCP + (size_t)DEPTH * NBATCH * 3 * 1536;
constexpr size_t O_SSCP = O_DNSP + (size_t)DEPTH * NBATCH * 4 * 128 * 128;
constexpr size_t O_SSHP = O_SSCP + (size_t)DEPTH * NBATCH * 3 * 1536;
constexpr size_t O_KS = O_SSHP + (size_t)DEPTH * NBATCH * 16 * 64 * 128;
constexpr size_t O_VS = O_KS + (size_t)DEPTH * TS * 512;
constexpr size_t O_POOLS = O_VS + (size_t)DEPTH * TS * 512;
constexpr size_t O_DNCS = O_POOLS + (size_t)DEPTH * DBATCH * 15 * 512;
constexpr size_t O_DNSS = O_DNCS + (size_t)DEPTH * DBATCH * 3 * 1536;
constexpr size_t O_SSCS = O_DNSS + (size_t)DEPTH * DBATCH * 4 * 128 * 128;
constexpr size_t O_SSHS = O_SSCS + (size_t)DEPTH * DBATCH * 3 * 1536;
constexpr size_t O_END = O_SSHS + (size_t)DEPTH * DBATCH * 16 * 64 * 128;

constexpr size_t al256(size_t x) { return (x + 255) & ~(size_t)255; }
constexpr size_t WS_CTL = 0, CTL_BYTES = 1u << 20;
constexpr size_t SZ_WIN = (size_t)NIN * DM * 2, SZ_WBR = (size_t)5 * DM * 512 * 2, SZ_WOUT = (size_t)DM * DM * 2, SZ_WUP = (size_t)DFF * DM * 2, SZ_WDN = (size_t)DM * DFF * 2;
constexpr size_t WS_WIN = WS_CTL + CTL_BYTES;
constexpr size_t WS_WBR = WS_WIN + 2 * SZ_WIN;
constexpr size_t WS_WOUT = WS_WBR + 2 * SZ_WBR;
constexpr size_t WS_WUP = WS_WOUT + 2 * SZ_WOUT;
constexpr size_t WS_WDN = WS_WUP + 2 * SZ_WUP;
constexpr size_t WS_H = WS_WDN + 2 * SZ_WDN;
constexpr size_t WS_UF = WS_H + (size_t)MP * DM * 2;
constexpr size_t WS_QKV = WS_UF + (size_t)MP * UFW * 4;
constexpr size_t WS_GATE = WS_QKV + (size_t)MP * 1536 * 2;
constexpr size_t WS_DNQ = WS_GATE + (size_t)MP * 8192 * 2;
constexpr size_t WS_XBC = WS_DNQ + (size_t)MP * 1536 * 4;
constexpr size_t WS_SCAL = WS_XBC + (size_t)MP * 1536 * 4;
constexpr size_t WS_OBR = WS_SCAL + (size_t)MP * 32 * 4;
constexpr size_t SZ_OBR = (size_t)MP * 512 * 2;
constexpr size_t WS_SSQ = WS_OBR + 5 * SZ_OBR;
constexpr size_t WS_MG32 = WS_SSQ + (size_t)MP * 32 * 4;
constexpr size_t WS_MGB = WS_MG32 + (size_t)MP * DM * 4;
constexpr size_t WS_MIX = WS_MGB + (size_t)MP * DM * 2;
constexpr size_t WS_F = WS_MIX + (size_t)MP * DM * 4;
constexpr size_t WS_FD = WS_F + (size_t)MP * DFF * 2;
constexpr size_t WS_PART = WS_FD + (size_t)MP * DM * 4;
constexpr size_t WS_PR = WS_PART + (size_t)256 * 2048 * 4;
constexpr size_t WS_DNU = WS_PR + (size_t)256 * 16 * 4;
constexpr size_t WS_SSU = WS_DNU + (size_t)512 * 90368;
constexpr size_t WS_SSG = WS_SSU + (size_t)2048 * 16896;
constexpr size_t WS_MGS = WS_SSG + (size_t)256 * 49152;
constexpr size_t WS_OUTS = WS_MGS + (size_t)5 * TS * DM * 4;
constexpr size_t WS_UPS = WS_OUTS + (size_t)16 * TS * DM * 4;
constexpr size_t WS_DNS = WS_UPS + (size_t)4 * TS * DFF * 4;
constexpr size_t WS_END = WS_DNS + (size_t)16 * TS * DM * 4;
static_assert(WS_WIN % 256 == 0 && WS_H % 256 == 0 && WS_UF % 256 == 0 && WS_OBR % 256 == 0 && WS_MG32 % 256 == 0 && WS_PART % 256 == 0, "ws alignment");

constexpr int CW_QUEUE = 64;
constexpr int CW_BAR = 4096;

constexpr int LDS_BYTES = 147456;
constexpr int RING_BYTES = 131072;
constexpr int MISC_OFF = RING_BYTES;

#define GAS __attribute__((address_space(1)))
#define LAS __attribute__((address_space(3)))
typedef unsigned short bf16;
typedef unsigned v4u __attribute__((ext_vector_type(4)));
typedef unsigned v2u __attribute__((ext_vector_type(2)));
typedef float f32x4 __attribute__((ext_vector_type(4)));
typedef float f32x2 __attribute__((ext_vector_type(2)));
typedef float f32x16 __attribute__((ext_vector_type(16)));
typedef short bf16x8 __attribute__((ext_vector_type(8)));
__device__ __forceinline__ unsigned f2bf(float f) { unsigned u = __builtin_bit_cast(unsigned, f); return (u + 0x7fffu + ((u >> 16) & 1u)) >> 16; }
__device__ __forceinline__ unsigned pk2(float lo, float hi) { return f2bf(lo) | (f2bf(hi) << 16); }
__device__ __forceinline__ float bflo(unsigned w) { return __builtin_bit_cast(float, w << 16); }
__device__ __forceinline__ float bfhi(unsigned w) { return __builtin_bit_cast(float, w & 0xffff0000u); }
__device__ __forceinline__ float wave_sum(float v) {
#pragma unroll
    for (int o = 1; o < 64; o <<= 1) v += __shfl_xor(v, o);
    return v;
}
__device__ __forceinline__ float row16_sum(float x) {
    x += __builtin_bit_cast(float, __builtin_amdgcn_update_dpp(0, __builtin_bit_cast(int, x), 0x128, 0xf, 0xf, false));
    x += __builtin_bit_cast(float, __builtin_amdgcn_update_dpp(0, __builtin_bit_cast(int, x), 0x124, 0xf, 0xf, false));
    x += __builtin_bit_cast(float, __builtin_amdgcn_update_dpp(0, __builtin_bit_cast(int, x), 0x122, 0xf, 0xf, false));
    x += __builtin_bit_cast(float, __builtin_amdgcn_update_dpp(0, __builtin_bit_cast(int, x), 0x121, 0xf, 0xf, false));
    return x;
}
__device__ __forceinline__ float sigmoidf_(float x) { return 1.0f / (1.0f + __expf(-x)); }
__device__ __forceinline__ float siluf_(float x) { return x / (1.0f + __expf(-x)); }
__device__ __forceinline__ float softplusf_(float x) { return x > 20.f ? x : log1pf(expf(x)); }
__device__ __forceinline__ float ex2(float x) { return __builtin_amdgcn_exp2f(x); }
__device__ __forceinline__ float lg2(float x) { return __builtin_amdgcn_logf(x); }
#define XB_TMO      128
#define XB_XCNT(j)  (256  + 64 * (j))
#define XB_XSUB(j)  (1280 + 64 * (j))
#define XB_XGEN(j)  (2304 + 64 * (j))
#define XB_TOP      3328
#define XB_TOPGEN   3392
#define XCD_BAR_WORDS 3456
#define XB_SPIN_CAP (1u << 18)

__device__ __forceinline__ unsigned xb_ld(unsigned* p)              { return __hip_atomic_load(p, __ATOMIC_RELAXED, __HIP_MEMORY_SCOPE_AGENT); }
__device__ __forceinline__ unsigned xb_add(unsigned* p, unsigned v) { return __hip_atomic_fetch_add(p, v, __ATOMIC_RELAXED, __HIP_MEMORY_SCOPE_AGENT); }
__device__ __forceinline__ unsigned xb_xcc_id() { return (unsigned)__builtin_amdgcn_s_getreg((3 << 11) | 20) & 0xFu; }
#define XB_SPIN(cond, bar) do { unsigned _sp = 0; while (cond) { __builtin_amdgcn_s_sleep(1); \
    if ((++_sp & 255u) == 0u) { if (xb_ld(&(bar)[XB_TMO])) break; if (_sp > XB_SPIN_CAP) { atomicAdd(&(bar)[XB_TMO], 1u); break; } } } } while (0)

struct XcdBarrier {
    unsigned* bar; unsigned x;
    volatile LAS unsigned* st;
};

__device__ __forceinline__ XcdBarrier xcd_barrier_post(unsigned* bar, volatile LAS unsigned* st, const int tid) {
    XcdBarrier b; b.bar = bar; b.x = xb_xcc_id(); b.st = st;
    if (tid == 0) (void)xb_add(&bar[XB_XCNT(b.x)], 1u);
    return b;
}
__device__ __forceinline__ void xcd_barrier_complete(unsigned* bar, unsigned x, unsigned& nloc, unsigned& nx) {
    const unsigned G = gridDim.x * gridDim.y * gridDim.z;
    unsigned sum, cnt, mine, sp = 0u;
    for (;;) {
        sum = 0u; cnt = 0u; mine = 0u;
#pragma unroll
        for (unsigned j = 0; j < 16; ++j) { const unsigned c = xb_ld(&bar[XB_XCNT(j)]); sum += c; cnt += (c > 0u) ? 1u : 0u; mine = (j == x) ? c : mine; }
        if (sum == G) break;
        __builtin_amdgcn_s_sleep(1);
        if ((++sp & 255u) == 0u) { if (xb_ld(&bar[XB_TMO])) break; if (sp > XB_SPIN_CAP) { atomicAdd(&bar[XB_TMO], 1u); break; } }
    }
    nloc = mine > 0u ? mine : 1u; nx = cnt > 0u ? cnt : 1u;
}

__device__ __forceinline__ void xcd_barrier(const XcdBarrier& b, const int tid) {
    asm volatile("s_waitcnt vmcnt(0)" ::: "memory");
    __syncthreads();
    if (tid == 0) {
        unsigned* bar = b.bar;
        __builtin_amdgcn_s_waitcnt(0);
        unsigned nloc = b.st[0], nx = b.st[1];
        if (nloc == 0u) { xcd_barrier_complete(bar, b.x, nloc, nx); b.st[0] = nloc; b.st[1] = nx; }
        const unsigned old = xb_add(&bar[XB_XSUB(b.x)], 1u);
        const unsigned gen = old / nloc;
        if (old + 1u == (gen + 1u) * nloc) {
            __builtin_amdgcn_fence(__ATOMIC_RELEASE, "agent");
            asm volatile("s_waitcnt vmcnt(0)" ::: "memory");
            const unsigned og = xb_add(&bar[XB_TOP], 1u);
            const unsigned tg = og / nx;
            if (og + 1u == (tg + 1u) * nx) xb_add(&bar[XB_TOPGEN], 1u);
            else XB_SPIN(xb_ld(&bar[XB_TOPGEN]) == tg, bar);
            __builtin_amdgcn_fence(__ATOMIC_ACQUIRE, "agent");
            xb_add(&bar[XB_XGEN(b.x)], 1u);
            asm volatile("s_waitcnt vmcnt(0)" ::: "memory");
        } else {
            XB_SPIN(xb_ld(&bar[XB_XGEN(b.x)]) == gen, bar);
            __builtin_amdgcn_fence(__ATOMIC_ACQUIRE, "agent");
            asm volatile("s_waitcnt vmcnt(0)" ::: "memory");
        }
    }
    __syncthreads();
}

enum { I_XP = 0, I_XS, I_CK, I_CV, I_SPOOL, I_SDNC, I_SDNS, I_SSSC, I_SSSH, I_PT, I_NMPRE, I_NMPOST, I_NLPRE, I_NLPOST, I_WIN, I_POOLW, I_POOLSC, I_DNCW, I_DNALOG, I_DNDTB, I_DNNW, I_SBBIAS,
       I_SSCW, I_SSCB, I_SSALOG, I_SSDTB, I_SSD, I_SSNW, I_WBR, I_WOUT, I_WUP, I_WDN, N_IN };
struct Args { const void* in[N_IN]; float* out; unsigned char* ws; int ph_lo, ph_hi, li, pad; };
#define IN_F(i) ((const float*)A->in[i])
#define WSP(T, off) ((T*)(A->ws + (off)))
typedef const __attribute__((opencl_constant)) Args* CA;
__device__ __forceinline__ CA args_opaque() { auto p = __builtin_amdgcn_kernarg_segment_ptr(); asm volatile("" : "+s"(p)); return (CA)p; }

struct EpiIn {
    static constexpr bool PERM = true, AFTER_DRAIN = false;
    float* UF; bf16* QKV; bf16* GATE; float *kp, *vp, *ks, *vs; float qscale;
    __device__ __forceinline__ void operator()(const f32x4 (&acc)[2][2][4][2], const pg8::Unit& u, int wr, int wc, int fr, int fq) const {
        const int pn = u.pn, row0 = u.pm * 256 + wr * 64 + fr, cl = wc * 32 + 8 * fq;
        if (pn < 10 || (pn >= 16 && pn < 26) || pn == 58) {
            const int col0 = pn * 256 + (pn < 10 ? 0 : (pn < 26 ? -1536 : -9728)) + cl;
#pragma unroll
            for (int ai = 0; ai < 2; ++ai)
#pragma unroll
                for (int m = 0; m < 4; ++m) { float* rowp = UF + (size_t)(row0 + ai * 128 + m * 16) * UFW + col0;
#pragma unroll
                    for (int bj = 0; bj < 2; ++bj) { *(f32x4*)(rowp + bj * 128) = acc[ai][bj][m][0]; *(f32x4*)(rowp + bj * 128 + 4) = acc[ai][bj][m][1]; } }
        } else if (pn < 16) {
            const int which = (pn - 10) >> 1, c512 = ((pn - 10) & 1) * 256 + cl; const float sc = which == 0 ? qscale : 1.f;
#pragma unroll
            for (int ai = 0; ai < 2; ++ai)
#pragma unroll
                for (int m = 0; m < 4; ++m) { const int r = row0 + ai * 128 + m * 16; bf16* rowp = QKV + (size_t)r * 1536 + which * 512 + c512;
                    float* fo = nullptr;
                    if (which) { if (r < TP) fo = (which == 1 ? kp : vp) + (size_t)r * 512 + c512; else if (r < TT) fo = (which == 1 ? ks : vs) + (size_t)(r - TP) * 512 + c512; }
#pragma unroll
                    for (int bj = 0; bj < 2; ++bj) { const f32x4 v0 = acc[ai][bj][m][0], v1 = acc[ai][bj][m][1];
                        v4u w; w.x = pk2(v0[0] * sc, v0[1] * sc); w.y = pk2(v0[2] * sc, v0[3] * sc); w.z = pk2(v1[0] * sc, v1[1] * sc); w.w = pk2(v1[2] * sc, v1[3] * sc);
                        *(v4u*)(rowp + bj * 128) = w;
                        if (fo) { *(f32x4*)(fo + bj * 128) = v0; *(f32x4*)(fo + bj * 128 + 4) = v1; } } }
        } else {
            const int col0 = (pn - 26) * 256 + cl;
#pragma unroll
            for (int ai = 0; ai < 2; ++ai)
#pragma unroll
                for (int m = 0; m < 4; ++m) { bf16* rowp = GATE + (size_t)(row0 + ai * 128 + m * 16) * 8192 + col0;
#pragma unroll
                    for (int bj = 0; bj < 2; ++bj) { const f32x4 v0 = acc[ai][bj][m][0], v1 = acc[ai][bj][m][1];
                        v4u w; w.x = pk2(sigmoidf_(v0[0]), sigmoidf_(v0[1])); w.y = pk2(sigmoidf_(v0[2]), sigmoidf_(v0[3])); w.z = pk2(sigmoidf_(v1[0]), sigmoidf_(v1[1])); w.w = pk2(sigmoidf_(v1[2]), sigmoidf_(v1[3]));
                        *(v4u*)(rowp + bj * 128) = w; } }
        }
    }
};
template <int S> struct EpiMerge {
    static constexpr bool PERM = true, AFTER_DRAIN = false;
    const bf16* GATE; const float* SSQ; float* MG32; bf16* MGB;
    __device__ __forceinline__ void operator()(const f32x4 (&acc)[2][2][4][2], const pg8::Unit& u, int wr, int wc, int fr, int fq) const {
        const int row0 = u.pm * 256 + wr * 64 + fr, col0 = u.pn * 256 + wc * 32 + 8 * fq; constexpr int GS = S < 3 ? S : 3;
#pragma unroll
        for (int ai = 0; ai < 2; ++ai)
#pragma unroll
            for (int m = 0; m < 4; ++m) { const int r = row0 + ai * 128 + m * 16; float rs = 1.f;
                if (S >= 3) { const f32x4* sq = (const f32x4*)(SSQ + (size_t)r * 32 + 16 * (S - 3)); const f32x4 q0 = sq[0], q1 = sq[1], q2 = sq[2], q3 = sq[3];
                    const float ss = ((q0[0] + q0[1]) + (q0[2] + q0[3]) + (q1[0] + q1[1]) + (q1[2] + q1[3])) + ((q2[0] + q2[1]) + (q2[2] + q2[3]) + (q3[0] + q3[1]) + (q3[2] + q3[3])); rs = 1.0f / sqrtf(ss * (1.0f / 512.0f) + RMS_EPS); }
#pragma unroll
                for (int bj = 0; bj < 2; ++bj) { const size_t o = (size_t)r * DM + col0 + bj * 128;
                    const v4u g = *(const v4u*)(GATE + (size_t)r * 8192 + GS * 2048 + col0 + bj * 128);
                    f32x4 v0 = acc[ai][bj][m][0], v1 = acc[ai][bj][m][1];
                    v0[0] *= bflo(g.x) * rs; v0[1] *= bfhi(g.x) * rs; v0[2] *= bflo(g.y) * rs; v0[3] *= bfhi(g.y) * rs;
                    v1[0] *= bflo(g.z) * rs; v1[1] *= bfhi(g.z) * rs; v1[2] *= bflo(g.w) * rs; v1[3] *= bfhi(g.w) * rs;
                    if (S > 0) { v0 += *(const f32x4*)(MG32 + o); v1 += *(const f32x4*)(MG32 + o + 4); }
                    if (S < 4) { *(f32x4*)(MG32 + o) = v0; *(f32x4*)(MG32 + o + 4) = v1; }
                    else { v4u w; w.x = pk2(v0[0], v0[1]); w.y = pk2(v0[2], v0[3]); w.z = pk2(v1[0], v1[1]); w.w = pk2(v1[2], v1[3]); *(v4u*)(MGB + o) = w; } } }
    }
};
struct EpiF32 {
    static constexpr bool PERM = true, AFTER_DRAIN = false;
    float* C; int ldc;
    __device__ __forceinline__ void operator()(const f32x4 (&acc)[2][2][4][2], const pg8::Unit& u, int wr, int wc, int fr, int fq) const {
        const int row0 = u.pm * 256 + wr * 64 + fr, col0 = u.pn * 256 + wc * 32 + 8 * fq;
#pragma unroll
        for (int ai = 0; ai < 2; ++ai)
#pragma unroll
            for (int m = 0; m < 4; ++m) { float* rowp = C + (size_t)(row0 + ai * 128 + m * 16) * ldc + col0;
#pragma unroll
                for (int bj = 0; bj < 2; ++bj) { *(f32x4*)(rowp + bj * 128) = acc[ai][bj][m][0]; *(f32x4*)(rowp + bj * 128 + 4) = acc[ai][bj][m][1]; } }
    }
};
struct EpiRelu2 {
    static constexpr bool PERM = true, AFTER_DRAIN = false;
    bf16* O; int ldc;
    __device__ __forceinline__ void operator()(const f32x4 (&acc)[2][2][4][2], const pg8::Unit& u, int wr, int wc, int fr, int fq) const {
        const int row0 = u.pm * 256 + wr * 64 + fr, col0 = u.pn * 256 + wc * 32 + 8 * fq;
#pragma unroll
        for (int ai = 0; ai < 2; ++ai)
#pragma unroll
            for (int m = 0; m < 4; ++m) { bf16* rowp = O + (size_t)(row0 + ai * 128 + m * 16) * ldc + col0;
#pragma unroll
                for (int bj = 0; bj < 2; ++bj) { f32x4 v0 = acc[ai][bj][m][0], v1 = acc[ai][bj][m][1];
#pragma unroll
                    for (int e = 0; e < 4; ++e) { const float a = fmaxf(v0[e], 0.f), b = fmaxf(v1[e], 0.f); v0[e] = a * a; v1[e] = b * b; }
                    v4u w; w.x = pk2(v0[0], v0[1]); w.y = pk2(v0[2], v0[3]); w.z = pk2(v1[0], v1[1]); w.w = pk2(v1[2], v1[3]); *(v4u*)(rowp + bj * 128) = w; } }
    }
};

__device__ __forceinline__ int win_src_col(int n) {
    if (n < 2560) return n;
    if (n < 6656) return n + 8;
    if (n < 14848) return n + 24;
    if (n < 14856) return n - 14848 + 2560;
    if (n < 14872) return n - 14856 + 6664;
    return -1;
}
template <int MODE>
__device__ __forceinline__ void transpose_item(const float* W, int ldw, int K, bf16* WT, int n0, int k0, const float* kscale, LAS float* scr, int lane) {
    const int n = n0 + (lane & 31); const int sc = MODE ? win_src_col(n) : n;
#pragma unroll 8
    for (int i = 0; i < 32; ++i) { const int kk = 2 * i + (lane >> 5); float v = sc >= 0 ? W[(size_t)(k0 + kk) * ldw + sc] : 0.f; if (kscale) v *= kscale[k0 + kk]; scr[kk * 33 + (lane & 31)] = v; }
    asm volatile("s_waitcnt lgkmcnt(0)" ::: "memory");
    const int c = lane & 7;
#pragma unroll
    for (int j = 0; j < 4; ++j) { const int nn = (lane >> 3) + 8 * j; const LAS float* s = scr + (8 * c) * 33 + nn;
        v4u o; o.x = pk2(s[0 * 33], s[1 * 33]); o.y = pk2(s[2 * 33], s[3 * 33]); o.z = pk2(s[4 * 33], s[5 * 33]); o.w = pk2(s[6 * 33], s[7 * 33]);
        *(v4u*)(WT + (size_t)(n0 + nn) * K + k0 + 8 * c) = o; }
    asm volatile("s_waitcnt lgkmcnt(0)" ::: "memory");
}
__device__ __forceinline__ void p0_prologue(CA A, LAS unsigned char* lds, const int wv) {
    const int tid = tid_opaque(wv), lane = tid & 63, wave = tid >> 6, G = gridDim.x;
    LAS float* scr = (LAS float*)(lds + wave * 8704);
    const int gw = blk_opaque() * NWAVES + wave, NGW = G * NWAVES;
    constexpr int I_IN = (NIN / 32) * (DM / 64), I_BR = (DM / 32) * (512 / 64), I_OUT = (DM / 32) * (DM / 64), I_UP = (DFF / 32) * (DM / 64), I_DN = (DM / 32) * (DFF / 64);
    constexpr int PER_LAYER = I_IN + 4 * I_BR + I_OUT + I_UP + I_DN;
    for (int it = gw; it < 2 * PER_LAYER; it += NGW) {
        const int L = it / PER_LAYER; int r = it % PER_LAYER;
        if (r < I_IN) { const int nb = r % (NIN / 32), kb = r / (NIN / 32);
            transpose_item<1>(IN_F(I_WIN) + (size_t)L * DM * INCOLS, INCOLS, DM, WSP(bf16, WS_WIN) + (size_t)L * NIN * DM, nb * 32, kb * 64, nullptr, scr, lane); continue; }
        r -= I_IN;
        if (r < 4 * I_BR) { const int s = 1 + r / I_BR, q = r % I_BR, nb = q % (DM / 32), kb = q / (DM / 32);
            transpose_item<0>(IN_F(I_WBR) + ((size_t)L * 2560 + 512 * s) * DM, DM, 512, WSP(bf16, WS_WBR) + (size_t)(L * 5 + s) * DM * 512, nb * 32, kb * 64,
                              s >= 3 ? IN_F(I_SSNW) + L * 1024 + (s - 3) * 512 : nullptr, scr, lane); continue; }
        r -= 4 * I_BR;
        if (r < I_OUT) { const int nb = r % (DM / 32), kb = r / (DM / 32);
            transpose_item<0>(IN_F(I_WOUT) + (size_t)L * DM * DM, DM, DM, WSP(bf16, WS_WOUT) + (size_t)L * DM * DM, nb * 32, kb * 64, nullptr, scr, lane); continue; }
        r -= I_OUT;
        if (r < I_UP) { const int nb = r % (DFF / 32), kb = r / (DFF / 32);
            transpose_item<0>(IN_F(I_WUP) + (size_t)L * DM * DFF, DFF, DM, WSP(bf16, WS_WUP) + (size_t)L * DFF * DM, nb * 32, kb * 64, nullptr, scr, lane); continue; }
        r -= I_UP;
        { const int nb = r % (DM / 32), kb = r / (DM / 32);
            transpose_item<0>(IN_F(I_WDN) + (size_t)L * DFF * DM, DM, DFF, WSP(bf16, WS_WDN) + (size_t)L * DM * DFF, nb * 32, kb * 64, nullptr, scr, lane); }
    }
    for (int idx = blk_opaque() * NTHR + tid; idx < 2 * DM * 64; idx += G * NTHR) {
        const int L = idx / (DM * 64), q = idx % (DM * 64), n = q & (DM - 1), kc = q >> 11, k0 = kc * 8, g = k0 >> 7, c0 = k0 & 127;
        const float* pw = IN_F(I_POOLW) + ((size_t)(L * 4 + g) * 128 + c0) * 128; const float* psc = IN_F(I_POOLSC) + L * 512 + g * 128;
        const float* wb = IN_F(I_WBR) + ((size_t)L * 2560 + g * 128) * DM + n;
        float acc[8] = {0.f, 0.f, 0.f, 0.f, 0.f, 0.f, 0.f, 0.f};
        for (int d = 0; d < 128; ++d) { const float wv = wb[(size_t)d * DM] * psc[d];
#pragma unroll
            for (int i = 0; i < 8; ++i) acc[i] += pw[i * 128 + d] * wv; }
        v4u o; o.x = pk2(acc[0], acc[1]); o.y = pk2(acc[2], acc[3]); o.z = pk2(acc[4], acc[5]); o.w = pk2(acc[6], acc[7]);
        *(v4u*)(WSP(bf16, WS_WBR) + (size_t)(L * 5) * DM * 512 + (size_t)n * 512 + k0) = o;
    }
}

__device__ __forceinline__ const float* xin_row(CA A, int m) { return m < TP ? IN_F(I_XP) + (size_t)m * DM : IN_F(I_XS) + (size_t)(m - TP) * DM; }
__device__ __forceinline__ void store_bf16_row(bf16* orow, const f32x4 (&v)[8], float rstd, const float* g, int lane) {
#pragma unroll
    for (int j = 0; j < 8; ++j) { const f32x4 gj = ((const f32x4*)g)[lane + 64 * j]; const f32x4 o = v[j] * rstd * gj;
        v2u w; w.x = pk2(o[0], o[1]); w.y = pk2(o[2], o[3]); ((v2u*)orow)[lane + 64 * j] = w; }
}
__device__ __forceinline__ void norm1_phase(CA A, const int wv) {
    const int tid = tid_opaque(wv), lane = tid & 63, gw = blk_opaque() * NWAVES + (tid >> 6), NGW = gridDim.x * NWAVES;
    bf16* H = WSP(bf16, WS_H);
    for (int m = gw; m < MP; m += NGW) {
        if (m >= TT) { for (int j = 0; j < 8; ++j) ((v2u*)(H + (size_t)m * DM))[lane + 64 * j] = (v2u){0u, 0u}; continue; }
        const f32x4* xr = (const f32x4*)xin_row(A, m); f32x4 v[8]; float s = 0.f;
#pragma unroll
        for (int j = 0; j < 8; ++j) { v[j] = xr[lane + 64 * j]; s += (v[j][0] * v[j][0] + v[j][1] * v[j][1]) + (v[j][2] * v[j][2] + v[j][3] * v[j][3]); }
        const float rstd = 1.0f / sqrtf(wave_sum(s) * (1.0f / DM) + RMS_EPS);
        store_bf16_row(H + (size_t)m * DM, v, rstd, IN_F(I_NMPRE), lane);
    }
}
__device__ __forceinline__ void resid_phase(CA A, const float* Y, const float* PS, const float* gpost, const float* gnext, bool from_input, const int wv) {
    const int tid = tid_opaque(wv), lane = tid & 63, gw = blk_opaque() * NWAVES + (tid >> 6), NGW = gridDim.x * NWAVES;
    bf16* H = WSP(bf16, WS_H);
    for (int m = gw; m < TT; m += NGW) {
        const f32x4* yr = (const f32x4*)(Y + (size_t)m * DM); const f32x4* xr = from_input ? (const f32x4*)xin_row(A, m) : (const f32x4*)(A->out + O_Y + (size_t)m * DM);
        f32x4 v[8]; float s = 0.f;
        if (m < TP) {
#pragma unroll
            for (int j = 0; j < 8; ++j) v[j] = yr[lane + 64 * j];
        } else {
#pragma unroll
            for (int j = 0; j < 8; ++j) v[j] = (f32x4){0.f, 0.f, 0.f, 0.f};
            for (int sp = 0; sp < 16; ++sp) { const f32x4* pr = (const f32x4*)(PS + ((size_t)sp * TS + (m - TP)) * DM);
#pragma unroll
                for (int j = 0; j < 8; ++j) v[j] += pr[lane + 64 * j]; }
        }
#pragma unroll
        for (int j = 0; j < 8; ++j) s += (v[j][0] * v[j][0] + v[j][1] * v[j][1]) + (v[j][2] * v[j][2] + v[j][3] * v[j][3]);
        const float rstd = 1.0f / sqrtf(wave_sum(s) * (1.0f / DM) + RMS_EPS); float s2 = 0.f;
        f32x4* orow = (f32x4*)(A->out + O_Y + (size_t)m * DM);
#pragma unroll
        for (int j = 0; j < 8; ++j) { const f32x4 gj = ((const f32x4*)gpost)[lane + 64 * j]; v[j] = xr[lane + 64 * j] + v[j] * rstd * gj; orow[lane + 64 * j] = v[j];
            s2 += (v[j][0] * v[j][0] + v[j][1] * v[j][1]) + (v[j][2] * v[j][2] + v[j][3] * v[j][3]); }
        if (gnext) { const float rstd2 = 1.0f / sqrtf(wave_sum(s2) * (1.0f / DM) + RMS_EPS); store_bf16_row(H + (size_t)m * DM, v, rstd2, gnext, lane); }
    }
}

__device__ __forceinline__ float conv_tap(const float* UF, const float* state, int row, int j, int ucol, int c) {
    if (row < TP) { const int t = row & (SEQ - 1); return (t - 3 + j) >= 0 ? UF[(size_t)(row - 3 + j) * UFW + ucol + c] : 0.f; }
    const int s = row - TP, sb = s >> 2, e = (s & 3) + j;
    return e < 3 ? state[(size_t)(sb * 3 + e) * 1536 + c] : UF[(size_t)(TP + sb * 4 + e - 3) * UFW + ucol + c];
}
__device__ __forceinline__ void prep_phase(CA A, int layer, const int wv) {
    const int tid = tid_opaque(wv), lane = tid & 63, G = gridDim.x, gt = blk_opaque() * NTHR + tid, NGT = G * NTHR, gw = blk_opaque() * NWAVES + (tid >> 6), NGW = G * NWAVES;
    const float* UF = WSP(float, WS_UF); float* SC = WSP(float, WS_SCAL);
    for (int idx = gt; idx < TT * 24; idx += NGT) { const int row = idx / 24, j = idx % 24; const float u = UF[(size_t)row * UFW + UF_SMALL + j]; float r;
        if (j < 4) r = sigmoidf_(u);
        else if (j < 8) r = -expf(IN_F(I_DNALOG)[layer * 4 + j - 4]) * softplusf_(u + IN_F(I_DNDTB)[layer * 4 + j - 4]);
        else r = softplusf_(u + IN_F(I_SSDTB)[layer * 16 + j - 8]);
        SC[(size_t)row * 32 + j] = r; }
    { bf16* O0 = WSP(bf16, WS_OBR); const float* spool = IN_F(I_SPOOL) + (size_t)layer * DBATCH * 15 * 512;
      for (int it = gw; it < (TP / 64 + DBATCH) * 4; it += NGW) { const int gi = it & 3, sc = it >> 2, w = 2 << gi, ch = gi * 128 + lane;
          if (sc < TP / 64) { const int row0 = sc * 64, t0 = row0 & (SEQ - 1); float s0 = 0.f, s1 = 0.f;
              for (int j = 1; j < w; ++j) if (t0 - j >= 0) { s0 += UF[(size_t)(row0 - j) * UFW + ch]; s1 += UF[(size_t)(row0 - j) * UFW + ch + 64]; }
#pragma unroll 8
              for (int i = 0; i < 64; ++i) { const int row = row0 + i, t = t0 + i; const float u0 = UF[(size_t)row * UFW + ch], u1 = UF[(size_t)row * UFW + ch + 64];
                  s0 += u0; s1 += u1; const float inv = 1.0f / (float)((t + 1) < w ? (t + 1) : w);
                  O0[(size_t)row * 512 + ch] = (bf16)f2bf(s0 * inv - u0); O0[(size_t)row * 512 + ch + 64] = (bf16)f2bf(s1 * inv - u1);
                  if (t - w + 1 >= 0) { s0 -= UF[(size_t)(row - w + 1) * UFW + ch]; s1 -= UF[(size_t)(row - w + 1) * UFW + ch + 64]; } } }
          else { const int sb = sc - TP / 64; const float inv = 1.0f / (float)w;
              for (int i = 0; i < DSEQ; ++i) { const int row = TP + sb * 4 + i, e = 15 + i; float s0 = 0.f, s1 = 0.f;
                  for (int j = 0; j < w; ++j) { const int ee = e - j; const float* src = ee < 15 ? spool + (size_t)(sb * 15 + ee) * 512 + ch : UF + (size_t)(TP + sb * 4 + ee - 15) * UFW + ch; s0 += src[0]; s1 += src[64]; }
                  O0[(size_t)row * 512 + ch] = (bf16)f2bf(s0 * inv - UF[(size_t)row * UFW + ch]); O0[(size_t)row * 512 + ch + 64] = (bf16)f2bf(s1 * inv - UF[(size_t)row * UFW + ch + 64]); } } } }
    for (int it = gw; it < (TP / 64 + DBATCH) * 24; it += NGW) { const int grp = it % 12, strm = (it / 12) & 1, sc = it / 24, c0 = grp * 128 + lane;
        const int ucol = strm ? UF_XBC : UF_DNQKV; float* OUTB = strm ? WSP(float, WS_XBC) : WSP(float, WS_DNQ);
        const float* cw = (strm ? IN_F(I_SSCW) : IN_F(I_DNCW)) + (size_t)layer * 4 * 1536; const float* st = (strm ? IN_F(I_SSSC) : IN_F(I_SDNC)) + (size_t)layer * DBATCH * 3 * 1536;
        const float wa0 = cw[c0], wa1 = cw[1536 + c0], wa2 = cw[3072 + c0], wa3 = cw[4608 + c0], wb0 = cw[c0 + 64], wb1 = cw[1536 + c0 + 64], wb2 = cw[3072 + c0 + 64], wb3 = cw[4608 + c0 + 64];
        const float ba = strm ? IN_F(I_SSCB)[layer * 1536 + c0] : 0.f, bb = strm ? IN_F(I_SSCB)[layer * 1536 + c0 + 64] : 0.f;
        const bool nrm = (strm == 0) && grp < 8; const float qs = grp < 4 ? 0.08838834764831845f : 1.0f;
        float ha0, ha1, ha2, hb0, hb1, hb2; int row0, n;
        if (sc < TP / 64) { row0 = sc * 64; n = 64; const int t0 = row0 & (SEQ - 1);
            if (t0 == 0) { ha0 = ha1 = ha2 = hb0 = hb1 = hb2 = 0.f; }
            else { const float* p = UF + (size_t)(row0 - 3) * UFW + ucol + c0; ha0 = p[0]; hb0 = p[64]; ha1 = p[UFW]; hb1 = p[UFW + 64]; ha2 = p[2 * UFW]; hb2 = p[2 * UFW + 64]; } }
        else { const int sb = sc - TP / 64; row0 = TP + sb * 4; n = DSEQ; const float* p = st + (size_t)(sb * 3) * 1536 + c0; ha0 = p[0]; hb0 = p[64]; ha1 = p[1536]; hb1 = p[1536 + 64]; ha2 = p[3072]; hb2 = p[3072 + 64]; }
#pragma unroll 8
        for (int i = 0; i < n; ++i) { const float* p = UF + (size_t)(row0 + i) * UFW + ucol + c0; const float ua = p[0], ub = p[64];
            float a = siluf_(ba + wa0 * ha0 + wa1 * ha1 + wa2 * ha2 + wa3 * ua), b = siluf_(bb + wb0 * hb0 + wb1 * hb1 + wb2 * hb2 + wb3 * ub);
            ha0 = ha1; ha1 = ha2; ha2 = ua; hb0 = hb1; hb1 = hb2; hb2 = ub;
            if (nrm) { const float rs = row16_sum(a * a + b * b);
                const float tot = (__builtin_bit_cast(float, __builtin_amdgcn_readlane(__builtin_bit_cast(int, rs), 0)) + __builtin_bit_cast(float, __builtin_amdgcn_readlane(__builtin_bit_cast(int, rs), 16)))
                                + (__builtin_bit_cast(float, __builtin_amdgcn_readlane(__builtin_bit_cast(int, rs), 32)) + __builtin_bit_cast(float, __builtin_amdgcn_readlane(__builtin_bit_cast(int, rs), 48)));
                const float sc2 = qs / sqrtf(tot + 1e-6f); a *= sc2; b *= sc2; }
            float* o = OUTB + (size_t)(row0 + i) * 1536 + c0; o[0] = a; o[64] = b; } }
    for (int idx = gt; idx < NBATCH * 3 * 1536; idx += NGT) { const int b = idx / (3 * 1536), q = idx % (3 * 1536), j = q / 1536, c = q % 1536; const size_t src = (size_t)(b * SEQ + SEQ - 3 + j) * UFW;
        A->out[O_DNCP + (size_t)layer * NBATCH * 3 * 1536 + idx] = UF[src + UF_DNQKV + c]; A->out[O_SSCP + (size_t)layer * NBATCH * 3 * 1536 + idx] = UF[src + UF_XBC + c]; }
    for (int idx = gt; idx < DBATCH * 3 * 1536; idx += NGT) { const int sb = idx / (3 * 1536), q = idx % (3 * 1536), j = q / 1536, c = q % 1536; const size_t src = (size_t)(TP + sb * 4 + 1 + j) * UFW;
        A->out[O_DNCS + (size_t)layer * DBATCH * 3 * 1536 + idx] = UF[src + UF_DNQKV + c]; A->out[O_SSCS + (size_t)layer * DBATCH * 3 * 1536 + idx] = UF[src + UF_XBC + c]; }
    for (int idx = gt; idx < NBATCH * 15 * 512; idx += NGT) { const int b = idx / (15 * 512), q = idx % (15 * 512), j = q >> 9, ch = q & 511;
        A->out[O_POOLP + (size_t)layer * NBATCH * 15 * 512 + idx] = UF[(size_t)(b * SEQ + SEQ - 15 + j) * UFW + ch]; }
    { const float* spool = IN_F(I_SPOOL) + (size_t)layer * DBATCH * 15 * 512;
      for (int idx = gt; idx < DBATCH * 15 * 512; idx += NGT) { const int sb = idx / (15 * 512), q = idx % (15 * 512), j = q >> 9, ch = q & 511, e = 4 + j;
          A->out[O_POOLS + (size_t)layer * DBATCH * 15 * 512 + idx] = e < 15 ? spool[(size_t)(sb * 15 + e) * 512 + ch] : UF[(size_t)(TP + sb * 4 + e - 15) * UFW + ch]; } }
}

__device__ __forceinline__ void dn_seq(CA A, LAS unsigned char* lds, int layer, int unit, const int wv) {
    const int tid = tid_opaque(wv), lane = tid & 63, wid = tid >> 6, v = tid & 127, kq = tid >> 7;
    int row0, L, h; const float* s0 = nullptr; float* sout;
    if (unit < 16) { const int b = unit >> 2; h = unit & 3; row0 = b * SEQ; L = SEQ; sout = A->out + O_DNSP + ((size_t)(layer * NBATCH + b) * 4 + h) * 16384; }
    else { const int u = unit - 16, sb = u >> 2; h = u & 3; row0 = TP + sb * 4; L = DSEQ; s0 = IN_F(I_SDNS) + ((size_t)(layer * DBATCH + sb) * 4 + h) * 16384; sout = A->out + O_DNSS + ((size_t)(layer * DBATCH + sb) * 4 + h) * 16384; }
    constexpr int CH = 32;
    LAS float* qs = (LAS float*)lds; LAS float* ks = qs + CH * 128; LAS float* vs = ks + CH * 128; LAS float* ob = vs + CH * 128;
    LAS float* red = ob + CH * 128;
    LAS float* egs = red + 2 * 2 * 4 * 128; LAS float* bts = egs + CH; LAS float* kqd = bts + CH;
    const float* DNQ = WSP(float, WS_DNQ); const float* SC = WSP(float, WS_SCAL); const float* UF = WSP(float, WS_UF); bf16* O1 = WSP(bf16, WS_OBR) + (size_t)MP * 512;
    const float* nw = IN_F(I_DNNW) + layer * 128;
    float S[32];
#pragma unroll
    for (int i = 0; i < 32; ++i) S[i] = s0 ? s0[(size_t)(32 * kq + i) * 128 + v] : 0.f;
    for (int c0 = 0; c0 < L; c0 += CH) {
        const int n = (L - c0) < CH ? (L - c0) : CH;
        __syncthreads();
        for (int idx = tid; idx < n * 128; idx += NTHR) { const int t = idx >> 7, c = idx & 127; const float* src = DNQ + (size_t)(row0 + c0 + t) * 1536 + h * 128 + c;
            qs[idx] = src[0]; ks[idx] = src[512]; vs[idx] = src[1024]; }
        if (tid < n) { const float* sc = SC + (size_t)(row0 + c0 + tid) * 32; bts[tid] = sc[h]; egs[tid] = expf(sc[4 + h]); }
        __syncthreads();
        for (int t = wid; t < n; t += NWAVES) { const float s = wave_sum(ks[t * 128 + lane] * qs[t * 128 + lane] + ks[t * 128 + 64 + lane] * qs[t * 128 + 64 + lane]); if (lane == 0) kqd[t] = s; }
        __syncthreads();
        for (int t = 0; t < n; ++t) {
            const float eg = egs[t], bt = bts[t]; float kk[32]; float r = 0.f, pp = 0.f;
#pragma unroll
            for (int i4 = 0; i4 < 8; ++i4) { const f32x4 k4 = *(const LAS f32x4*)(ks + t * 128 + 32 * kq + 4 * i4), q4 = *(const LAS f32x4*)(qs + t * 128 + 32 * kq + 4 * i4);
#pragma unroll
                for (int e = 0; e < 4; ++e) { const int i = 4 * i4 + e; S[i] *= eg; kk[i] = k4[e]; r += S[i] * k4[e]; pp += S[i] * q4[e]; } }
            LAS float* rd = red + (t & 1) * 1024;
            rd[kq * 128 + v] = r; rd[512 + kq * 128 + v] = pp;
            __syncthreads();
            const float rt = (rd[v] + rd[128 + v]) + (rd[256 + v] + rd[384 + v]), pt = (rd[512 + v] + rd[640 + v]) + (rd[768 + v] + rd[896 + v]);
            const float dd = bt * (vs[t * 128 + v] - rt);
#pragma unroll
            for (int i = 0; i < 32; ++i) S[i] += kk[i] * dd;
            if (kq == 0) ob[t * 128 + v] = pt + kqd[t] * dd;
        }
        __syncthreads();
        for (int t = wid; t < n; t += NWAVES) { const int row = row0 + c0 + t; const float o0 = ob[t * 128 + lane], o1 = ob[t * 128 + 64 + lane];
            const float rstd = 1.0f / sqrtf(wave_sum(o0 * o0 + o1 * o1) * (1.0f / 128.0f) + RMS_EPS);
            const float z0 = UF[(size_t)row * UFW + UF_DNZ + h * 128 + lane], z1 = UF[(size_t)row * UFW + UF_DNZ + h * 128 + 64 + lane];
            O1[(size_t)row * 512 + h * 128 + lane] = (bf16)f2bf(o0 * rstd * nw[lane] * siluf_(z0)); O1[(size_t)row * 512 + h * 128 + 64 + lane] = (bf16)f2bf(o1 * rstd * nw[64 + lane] * siluf_(z1)); }
    }
#pragma unroll
    for (int i = 0; i < 32; ++i) sout[(size_t)(32 * kq + i) * 128 + v] = S[i];
    __syncthreads();
}

__device__ __forceinline__ void ssd_seq(CA A, LAS unsigned char* lds, int layer, int unit, const int wv) {
    const int tid = tid_opaque(wv), lane = tid & 63, wid = tid >> 6, p = tid >> 3, nq = tid & 7;
    int row0, L, hd; const float* h0 = nullptr; float* hout;
    if (unit < 64) { const int b = unit >> 4; hd = unit & 15; row0 = b * SEQ; L = SEQ; hout = A->out + O_SSHP + ((size_t)(layer * NBATCH + b) * 16 + hd) * 8192; }
    else { const int u = unit - 64, sb = u >> 4; hd = u & 15; row0 = TP + sb * 4; L = DSEQ; h0 = IN_F(I_SSSH) + ((size_t)(layer * DBATCH + sb) * 16 + hd) * 8192; hout = A->out + O_SSHS + ((size_t)(layer * DBATCH + sb) * 16 + hd) * 8192; }
    const int g = hd >> 3; constexpr int CH = 64;
    LAS float* Bs = (LAS float*)lds; LAS float* Cs = Bs + CH * 128; LAS float* xs = Cs + CH * 128; LAS float* yb = xs + CH * 64; LAS float* dts = yb + CH * 64;
    const float* XBC = WSP(float, WS_XBC); const float* SC = WSP(float, WS_SCAL); const float* UF = WSP(float, WS_UF); float* SSQ = WSP(float, WS_SSQ);
    bf16* Og = WSP(bf16, WS_OBR) + (size_t)(3 + g) * MP * 512;
    const float a = -expf(IN_F(I_SSALOG)[layer * 16 + hd]), Dk = IN_F(I_SSD)[layer * 16 + hd];
    float hs[16];
#pragma unroll
    for (int j = 0; j < 16; ++j) hs[j] = h0 ? h0[(size_t)p * 128 + 16 * nq + j] : 0.f;
    for (int c0 = 0; c0 < L; c0 += CH) {
        const int n = (L - c0) < CH ? (L - c0) : CH;
        __syncthreads();
        for (int idx = tid; idx < n * 128; idx += NTHR) { const int t = idx >> 7, c = idx & 127; const float* src = XBC + (size_t)(row0 + c0 + t) * 1536; Bs[idx] = src[1024 + g * 128 + c]; Cs[idx] = src[1280 + g * 128 + c]; }
        for (int idx = tid; idx < n * 64; idx += NTHR) { const int t = idx >> 6, c = idx & 63; xs[idx] = XBC[(size_t)(row0 + c0 + t) * 1536 + hd * 64 + c]; }
        if (tid < n) dts[tid] = SC[(size_t)(row0 + c0 + tid) * 32 + 8 + hd];
        __syncthreads();
        for (int t = 0; t < n; ++t) {
            const float dt = dts[t], dA = expf(dt * a), xv = xs[t * 64 + p], cx = dt * xv; float y = 0.f;
#pragma unroll
            for (int j4 = 0; j4 < 4; ++j4) { const f32x4 b4 = *(const LAS f32x4*)(Bs + t * 128 + 16 * nq + 4 * j4), c4 = *(const LAS f32x4*)(Cs + t * 128 + 16 * nq + 4 * j4);
#pragma unroll
                for (int e = 0; e < 4; ++e) { const int j = 4 * j4 + e; hs[j] = hs[j] * dA + cx * b4[e]; y += hs[j] * c4[e]; } }
            y += __shfl_xor(y, 1); y += __shfl_xor(y, 2); y += __shfl_xor(y, 4);
            if (nq == 0) yb[t * 64 + p] = y + Dk * xv;
        }
        __syncthreads();
        for (int t = wid; t < n; t += NWAVES) { const int row = row0 + c0 + t; const float z = UF[(size_t)row * UFW + UF_SSZ + hd * 64 + lane]; const float yg = yb[t * 64 + lane] * siluf_(z);
            const float ss = wave_sum(yg * yg); if (lane == 0) { SSQ[(size_t)row * 32 + hd * 2] = ss; SSQ[(size_t)row * 32 + hd * 2 + 1] = 0.f; }
            Og[(size_t)row * 512 + (hd & 7) * 64 + lane] = (bf16)f2bf(yg); }
    }
#pragma unroll
    for (int j = 0; j < 16; ++j) hout[(size_t)p * 128 + 16 * nq + j] = hs[j];
    __syncthreads();
}

constexpr size_t DNU_NW = 0, DNU_QG = 16384, DNU_AT = 32768, DNU_KGT = 40960, DNU_UP = 57344, DNU_EG = 90112, DNU_BYTES = 90368;
__device__ __forceinline__ float dpp_swap1(float x) { return __builtin_bit_cast(float, __builtin_amdgcn_mov_dpp(__builtin_bit_cast(int, x), 0xB1, 0xf, 0xf, true)); }
__device__ __forceinline__ void dn_chunk_unit(CA A, LAS unsigned char* lds, int layer, int unit, const int wv) {
    const int tid = tid_opaque(wv), lane = tid & 63, wid = tid >> 6, q4 = lane >> 4, l15 = lane & 15;
    const int bh = unit >> 5, ck = unit & 31, b = bh >> 2, h = bh & 3, row0 = b * SEQ + ck * 64;
    constexpr int FP = 132;
    LAS float* kf = (LAS float*)lds; LAS float* vf = kf + 64 * FP;
    LAS unsigned char* qb = lds + 2 * 64 * FP * 4; LAS unsigned char* kb = qb + 64 * 272;
    LAS float* Lp = (LAS float*)(kb + 64 * 272);
    LAS float* gcs = Lp + 2 * 64 * 32; LAS float* bts = gcs + 64;
    const float* DNQ = WSP(float, WS_DNQ); const float* SC = WSP(float, WS_SCAL);
    unsigned char* rec = A->ws + WS_DNU + (size_t)unit * DNU_BYTES;
    __syncthreads();
    if (tid < 64) { const float* sc = SC + (size_t)(row0 + tid) * 32; float g = sc[4 + h]; bts[tid] = sc[h];
#pragma unroll
        for (int o = 1; o < 64; o <<= 1) { const float t = __shfl_up(g, o); if (lane >= o) g += t; }
        gcs[tid] = g; }
    __syncthreads();
    const float glast = gcs[63];
    if (tid == 0) *(float*)(rec + DNU_EG) = expf(glast);
#pragma unroll
    for (int it = 0; it < 4; ++it) { const int idx = tid + 512 * it, t = idx >> 5, d4 = (idx & 31) * 4; const float* src = DNQ + (size_t)(row0 + t) * 1536 + h * 128 + d4;
        const f32x4 qv = *(const f32x4*)src, kv = *(const f32x4*)(src + 512), vv = *(const f32x4*)(src + 1024);
        *(LAS f32x4*)(kf + t * FP + d4) = kv; *(LAS f32x4*)(vf + t * FP + d4) = vv;
        v2u w; w.x = pk2(qv[0], qv[1]); w.y = pk2(qv[2], qv[3]); *(LAS v2u*)(qb + t * 272 + d4 * 2) = w;
        w.x = pk2(kv[0], kv[1]); w.y = pk2(kv[2], kv[3]); *(LAS v2u*)(kb + t * 272 + d4 * 2) = w;
        const float eg = expf(gcs[t]); w.x = pk2(qv[0] * eg, qv[1] * eg); w.y = pk2(qv[2] * eg, qv[3] * eg); *(v2u*)(rec + DNU_QG + (size_t)(t * 128 + d4) * 2) = w; }
    __syncthreads();
    { const int c = lane, dg = wid; const float f = expf(glast - gcs[c]); bf16* KGT = (bf16*)(rec + DNU_KGT);
#pragma unroll
      for (int i = 0; i < 16; ++i) { const int d = dg * 16 + i; KGT[d * 64 + c] = (bf16)f2bf(kf[c * FP + d] * f); } }
    { const int ct = wid >> 1; bf16* AT = (bf16*)(rec + DNU_AT);
#pragma unroll
      for (int e2 = 0; e2 < 2; ++e2) { const int et = 2 * (wid & 1) + e2; f32x4 aKK = {0.f, 0.f, 0.f, 0.f}, aQK = {0.f, 0.f, 0.f, 0.f};
#pragma unroll
          for (int ks = 0; ks < 4; ++ks) { const bf16x8 bfr = *(const LAS bf16x8*)(kb + (16 * et + l15) * 272 + (32 * ks + 8 * q4) * 2);
              const bf16x8 ak = *(const LAS bf16x8*)(kb + (16 * ct + l15) * 272 + (32 * ks + 8 * q4) * 2), aq = *(const LAS bf16x8*)(qb + (16 * ct + l15) * 272 + (32 * ks + 8 * q4) * 2);
              aKK = __builtin_amdgcn_mfma_f32_16x16x32_bf16(ak, bfr, aKK, 0, 0, 0); aQK = __builtin_amdgcn_mfma_f32_16x16x32_bf16(aq, bfr, aQK, 0, 0, 0); }
          const int e = 16 * et + l15; const float ge = gcs[e];
#pragma unroll
          for (int r = 0; r < 4; ++r) { const int c = 16 * ct + 4 * q4 + r; const float dec = e <= c ? expf(gcs[c] - ge) : 0.f;
              Lp[((e & 1) * 64 + c) * 32 + (e >> 1)] = e < c ? bts[c] * aKK[r] * dec : 0.f;
              AT[c * 64 + e] = (bf16)f2bf(aQK[r] * dec); } } }
    __syncthreads();
    { const int j = tid >> 1, par = tid & 1; float x[32];
#pragma unroll
      for (int i = 0; i < 32; ++i) x[i] = 0.f;
      const LAS float* src = j < 128 ? vf + j : kf + (j - 128);
      float* UP = (float*)(rec + DNU_UP); bf16* NW = (bf16*)(rec + DNU_NW);
#pragma unroll
      for (int c = 0; c < 64; ++c) {
          constexpr int dummy = 0; (void)dummy;
          const int ni = (c + 1) >> 1; float a0 = 0.f, a1 = 0.f, a2 = 0.f, a3 = 0.f;
#pragma unroll
          for (int i4 = 0; i4 < (ni + 3) / 4; ++i4) { const f32x4 l4 = *(const LAS f32x4*)(Lp + (par * 64 + c) * 32 + 4 * i4);
              a0 += l4[0] * x[4 * i4]; if (4 * i4 + 1 < ni) a1 += l4[1] * x[4 * i4 + 1]; if (4 * i4 + 2 < ni) a2 += l4[2] * x[4 * i4 + 2]; if (4 * i4 + 3 < ni) a3 += l4[3] * x[4 * i4 + 3]; }
          float acc = (a0 + a1) + (a2 + a3); acc += dpp_swap1(acc);
          float rhs = src[c * FP] * bts[c]; if (j >= 128) rhs *= expf(gcs[c]);
          const float xc = rhs - acc;
          x[c >> 1] = ((c & 1) == par) ? xc : x[c >> 1];
          if (par == 0) { if (j < 128) UP[(((j >> 4) * 4 + (c >> 4)) * 4 + (c & 3)) * 64 + ((c >> 2) & 3) * 16 + (j & 15)] = xc; else NW[c * 128 + (j - 128)] = (bf16)f2bf(-xc); }
      } }
}

constexpr int D2_NW = 0, D2_QG = 17408, D2_AT = 34816, D2_KGT = 44032, D2_BUF = 62464, D2_RED = 2 * D2_BUF;
__device__ __forceinline__ bf16x8 ld_frag_perm(const LAS unsigned char* p) {
    const v2u lo = *(const LAS v2u*)p, hi = *(const LAS v2u*)(p + 32); v4u w; w.x = lo.x; w.y = lo.y; w.z = hi.x; w.w = hi.y; return __builtin_bit_cast(bf16x8, w);
}
__device__ __forceinline__ bf16x8 pack_b(const f32x4& t0, const f32x4& t1) { v4u w; w.x = pk2(t0[0], t0[1]); w.y = pk2(t0[2], t0[3]); w.z = pk2(t1[0], t1[1]); w.w = pk2(t1[2], t1[3]); return __builtin_bit_cast(bf16x8, w); }
__device__ __forceinline__ void dn_seq2(CA A, LAS unsigned char* lds, int layer, int bh, const int wv) {
    const int tid = tid_opaque(wv), lane = tid & 63, w = tid >> 6, q4 = lane >> 4, l15 = lane & 15;
    const int b = bh >> 2, h = bh & 3;
    const unsigned char* recs = A->ws + WS_DNU + (size_t)(bh * 32) * DNU_BYTES;
    const float* UF = WSP(float, WS_UF); bf16* O1 = WSP(bf16, WS_OBR) + (size_t)MP * 512; const float* nw = IN_F(I_DNNW) + layer * 128;
    LAS float* red = (LAS float*)(lds + D2_RED);
    f32x4 S[8];
#pragma unroll
    for (int i = 0; i < 8; ++i) S[i] = (f32x4){0.f, 0.f, 0.f, 0.f};
    v4u st[7];
#define D2_LOAD(rec_) do { const v4u* g_ = (const v4u*)(rec_); _Pragma("unroll") for (int i_ = 0; i_ < 7; ++i_) st[i_] = g_[tid + 512 * i_]; } while (0)
#define D2_STORE(buf_) do { LAS unsigned char* b_ = lds + (buf_) * D2_BUF; \
        *(LAS v4u*)(b_ + D2_NW + (tid >> 4) * 272 + (tid & 15) * 16) = st[0]; *(LAS v4u*)(b_ + D2_NW + (32 + (tid >> 4)) * 272 + (tid & 15) * 16) = st[1]; \
        *(LAS v4u*)(b_ + D2_QG + (tid >> 4) * 272 + (tid & 15) * 16) = st[2]; *(LAS v4u*)(b_ + D2_QG + (32 + (tid >> 4)) * 272 + (tid & 15) * 16) = st[3]; \
        *(LAS v4u*)(b_ + D2_AT + (tid >> 3) * 144 + (tid & 7) * 16) = st[4]; \
        *(LAS v4u*)(b_ + D2_KGT + (tid >> 3) * 144 + (tid & 7) * 16) = st[5]; *(LAS v4u*)(b_ + D2_KGT + (64 + (tid >> 3)) * 144 + (tid & 7) * 16) = st[6]; } while (0)
    __syncthreads();
    D2_LOAD(recs); D2_STORE(0);
    f32x4 vnx[4]; float eglx = *(const float*)(recs + DNU_EG);
    { const float* UP0 = (const float*)(recs + DNU_UP) + (size_t)w * 1024 + lane;
#pragma unroll
      for (int mt = 0; mt < 4; ++mt)
#pragma unroll
          for (int r = 0; r < 4; ++r) vnx[mt][r] = UP0[(mt * 4 + r) * 64]; }
    __syncthreads();
    for (int ck = 0; ck < 32; ++ck) {
        const unsigned char* rec = recs + (size_t)ck * DNU_BYTES; const int row0 = b * SEQ + ck * 64;
        const LAS unsigned char* bf = lds + (ck & 1) * D2_BUF;
        if (ck + 1 < 32) D2_LOAD(rec + DNU_BYTES);
        const float egl = eglx;
        f32x4 vn[4];
#pragma unroll
        for (int mt = 0; mt < 4; ++mt) vn[mt] = vnx[mt];
        if (ck + 1 < 32) { eglx = *(const float*)(rec + DNU_BYTES + DNU_EG); const float* UP = (const float*)(rec + DNU_BYTES + DNU_UP) + (size_t)w * 1024 + lane;
#pragma unroll
            for (int mt = 0; mt < 4; ++mt)
#pragma unroll
                for (int r = 0; r < 4; ++r) vnx[mt][r] = UP[(mt * 4 + r) * 64]; }
        f32x4 zz[4];
#pragma unroll
        for (int mt = 0; mt < 4; ++mt)
#pragma unroll
            for (int r = 0; r < 4; ++r) zz[mt][r] = UF[(size_t)(row0 + 16 * mt + 4 * q4 + r) * UFW + UF_DNZ + h * 128 + 16 * w + l15];
        bf16x8 Sb[4];
#pragma unroll
        for (int ks = 0; ks < 4; ++ks) Sb[ks] = pack_b(S[2 * ks], S[2 * ks + 1]);
        const int aoff = l15 * 272 + 8 * q4, aoff2 = l15 * 144 + 8 * q4;
#pragma unroll
        for (int mt = 0; mt < 4; ++mt)
#pragma unroll
            for (int ks = 0; ks < 4; ++ks) vn[mt] = __builtin_amdgcn_mfma_f32_16x16x32_bf16(ld_frag_perm(bf + D2_NW + mt * 16 * 272 + aoff + ks * 64), Sb[ks], vn[mt], 0, 0, 0);
        bf16x8 vb[2];
        vb[0] = pack_b(vn[0], vn[1]); vb[1] = pack_b(vn[2], vn[3]);
        f32x4 o[4];
#pragma unroll
        for (int mt = 0; mt < 4; ++mt) { o[mt] = (f32x4){0.f, 0.f, 0.f, 0.f};
#pragma unroll
            for (int ks = 0; ks < 4; ++ks) o[mt] = __builtin_amdgcn_mfma_f32_16x16x32_bf16(ld_frag_perm(bf + D2_QG + mt * 16 * 272 + aoff + ks * 64), Sb[ks], o[mt], 0, 0, 0);
#pragma unroll
            for (int ke = 0; ke < 2; ++ke) o[mt] = __builtin_amdgcn_mfma_f32_16x16x32_bf16(ld_frag_perm(bf + D2_AT + mt * 16 * 144 + aoff2 + ke * 64), vb[ke], o[mt], 0, 0, 0); }
#pragma unroll
        for (int m8 = 0; m8 < 8; ++m8) { S[m8] = S[m8] * egl;
#pragma unroll
            for (int ke = 0; ke < 2; ++ke) S[m8] = __builtin_amdgcn_mfma_f32_16x16x32_bf16(ld_frag_perm(bf + D2_KGT + m8 * 16 * 144 + aoff2 + ke * 64), vb[ke], S[m8], 0, 0, 0); }
        LAS float* rd = red + (ck & 1) * 512;
#pragma unroll
        for (int mt = 0; mt < 4; ++mt)
#pragma unroll
            for (int r = 0; r < 4; ++r) { const float s = row16_sum(o[mt][r] * o[mt][r]);
                if (l15 == 0) rd[(16 * mt + 4 * q4 + r) * 8 + w] = s; }
        if (ck + 1 < 32) D2_STORE((ck + 1) & 1);
        __syncthreads();
#pragma unroll
        for (int mt = 0; mt < 4; ++mt)
#pragma unroll
            for (int r = 0; r < 4; ++r) { const int c = 16 * mt + 4 * q4 + r; const f32x4 s0 = *(const LAS f32x4*)(rd + c * 8), s1 = *(const LAS f32x4*)(rd + c * 8 + 4);
                const float rstd = 1.0f / sqrtf(((s0[0] + s0[1]) + (s0[2] + s0[3]) + (s1[0] + s1[1]) + (s1[2] + s1[3])) * (1.0f / 128.0f) + RMS_EPS);
                const int dv = 16 * w + l15;
                O1[(size_t)(row0 + c) * 512 + h * 128 + dv] = (bf16)f2bf(o[mt][r] * rstd * nw[dv] * siluf_(zz[mt][r])); }
    }
    float* sout = A->out + O_DNSP + ((size_t)(layer * NBATCH + b) * 4 + h) * 16384;
#pragma unroll
    for (int m8 = 0; m8 < 8; ++m8)
#pragma unroll
        for (int r = 0; r < 4; ++r) sout[(size_t)(16 * m8 + 4 * q4 + r) * 128 + 16 * w + l15] = S[m8][r];
    __syncthreads();
#undef D2_LOAD
#undef D2_STORE
}

constexpr size_t SSU_XT = 0, SSU_XTW = 8192, SSU_CUM = 16384, SSU_DT = 16640, SSU_BYTES = 16896;
constexpr size_t SSG_C = 0, SSG_B = 16384, SSG_BT = 32768, SSG_BYTES = 49152;
__device__ __forceinline__ void ssd_prep_unit(CA A, LAS unsigned char* lds, int layer, int unit, const int wv) {
    const int tid = tid_opaque(wv), lane = tid & 63;
    const int hd = unit & 15, bc = unit >> 4, b = bc >> 5, ck = bc & 31, g = hd >> 3, row0 = b * SEQ + ck * 64;
    const float* XBC = WSP(float, WS_XBC); const float* SC = WSP(float, WS_SCAL);
    unsigned char* rec = A->ws + WS_SSU + (size_t)unit * SSU_BYTES;
    LAS float* xl = (LAS float*)lds;
    LAS float* bl = xl + 64 * 65;
    LAS float* cums = bl + 64 * 129; LAS float* ws_ = cums + 64;
    const float a = -expf(IN_F(I_SSALOG)[layer * 16 + hd]);
    __syncthreads();
    if (tid < 64) { const float dt = SC[(size_t)(row0 + tid) * 32 + 8 + hd]; float c = dt * a;
#pragma unroll
        for (int o = 1; o < 64; o <<= 1) { const float t = __shfl_up(c, o); if (lane >= o) c += t; }
        cums[tid] = c; const float c63 = __shfl(c, 63); ws_[tid] = expf(c63 - c) * dt;
        ((float*)(rec + SSU_CUM))[tid] = c; ((float*)(rec + SSU_DT))[tid] = dt; }
    { const int s = tid >> 3, p8 = (tid & 7) * 8; const float* src = XBC + (size_t)(row0 + s) * 1536 + hd * 64 + p8; const f32x4 x0 = *(const f32x4*)src, x1 = *(const f32x4*)(src + 4);
#pragma unroll
      for (int e = 0; e < 4; ++e) { xl[s * 65 + p8 + e] = x0[e]; xl[s * 65 + p8 + 4 + e] = x1[e]; } }
    __syncthreads();
    { const int p = tid >> 3, s8 = (tid & 7) * 8; float xv[8], xw[8];
#pragma unroll
      for (int i = 0; i < 8; ++i) { xv[i] = xl[(s8 + i) * 65 + p]; xw[i] = xv[i] * ws_[s8 + i]; }
      v4u o; o.x = pk2(xv[0], xv[1]); o.y = pk2(xv[2], xv[3]); o.z = pk2(xv[4], xv[5]); o.w = pk2(xv[6], xv[7]); *(v4u*)(rec + SSU_XT + (size_t)(p * 64 + s8) * 2) = o;
      o.x = pk2(xw[0], xw[1]); o.y = pk2(xw[2], xw[3]); o.z = pk2(xw[4], xw[5]); o.w = pk2(xw[6], xw[7]); *(v4u*)(rec + SSU_XTW + (size_t)(p * 64 + s8) * 2) = o; }
    if ((hd & 7) == 0) {
        unsigned char* grec = A->ws + WS_SSG + (size_t)(bc * 2 + g) * SSG_BYTES;
        const int s = tid >> 3, n16 = (tid & 7) * 16; const float* src = XBC + (size_t)(row0 + s) * 1536 + 1024 + g * 128 + n16;
        f32x4 bv[4], cv[4];
#pragma unroll
        for (int i = 0; i < 4; ++i) { bv[i] = *(const f32x4*)(src + 4 * i); cv[i] = *(const f32x4*)(src + 256 + 4 * i); }
#pragma unroll
        for (int i = 0; i < 2; ++i) { v4u o; o.x = pk2(bv[2 * i][0], bv[2 * i][1]); o.y = pk2(bv[2 * i][2], bv[2 * i][3]); o.z = pk2(bv[2 * i + 1][0], bv[2 * i + 1][1]); o.w = pk2(bv[2 * i + 1][2], bv[2 * i + 1][3]);
            *(v4u*)(grec + SSG_B + (size_t)(s * 128 + n16 + 8 * i) * 2) = o;
            o.x = pk2(cv[2 * i][0], cv[2 * i][1]); o.y = pk2(cv[2 * i][2], cv[2 * i][3]); o.z = pk2(cv[2 * i + 1][0], cv[2 * i + 1][1]); o.w = pk2(cv[2 * i + 1][2], cv[2 * i + 1][3]);
            *(v4u*)(grec + SSG_C + (size_t)(s * 128 + n16 + 8 * i) * 2) = o; }
#pragma unroll
        for (int i = 0; i < 4; ++i)
#pragma unroll
            for (int e = 0; e < 4; ++e) bl[s * 129 + n16 + 4 * i + e] = bv[i][e];
        __syncthreads();
        const int n = tid >> 2, s16 = (tid & 3) * 16; float t[16];
#pragma unroll
        for (int i = 0; i < 16; ++i) t[i] = bl[(s16 + i) * 129 + n];
#pragma unroll
        for (int i = 0; i < 2; ++i) { v4u o; o.x = pk2(t[8 * i], t[8 * i + 1]); o.y = pk2(t[8 * i + 2], t[8 * i + 3]); o.z = pk2(t[8 * i + 4], t[8 * i + 5]); o.w = pk2(t[8 * i + 6], t[8 * i + 7]);
            *(v4u*)(grec + SSG_BT + (size_t)(n * 64 + s16 + 8 * i) * 2) = o; }
    }
}

constexpr int S2_C = 0, S2_B = 17408, S2_BT = 34816, S2_XT = 53248, S2_XTW = 62464, S2_WM = 71680, S2_HB = 80896, S2_YB = 98304, S2_CUM = 114688, S2_DT = 114944;
__device__ __forceinline__ void ssd_seq2(CA A, LAS unsigned char* lds, int layer, int unit, const int wv) {
    const int tid = tid_opaque(wv), lane = tid & 63, w = tid >> 6, q4 = lane >> 4, l15 = lane & 15;
    const int b = unit >> 4, hd = unit & 15, g = hd >> 3;
    const unsigned char* hrec = A->ws + WS_SSU + (size_t)((b * 32) * 16 + hd) * SSU_BYTES;
    const unsigned char* grec = A->ws + WS_SSG + (size_t)((b * 32) * 2 + g) * SSG_BYTES;
    const float* UF = WSP(float, WS_UF); float* SSQ = WSP(float, WS_SSQ); bf16* Og = WSP(bf16, WS_OBR) + (size_t)(3 + g) * MP * 512;
    const float Dk = IN_F(I_SSD)[layer * 16 + hd];
    LAS float* yb = (LAS float*)(lds + S2_YB); LAS float* cums = (LAS float*)(lds + S2_CUM); LAS float* dts = (LAS float*)(lds + S2_DT);
    f32x4 hacc[4];
#pragma unroll
    for (int i = 0; i < 4; ++i) hacc[i] = (f32x4){0.f, 0.f, 0.f, 0.f};
    v4u st[8]; float sc1 = 0.f;
#define S2_LOAD(ck_) do { const v4u* gg_ = (const v4u*)(grec + (size_t)(ck_) * 2 * SSG_BYTES); const v4u* hh_ = (const v4u*)(hrec + (size_t)(ck_) * 16 * SSU_BYTES); \
        st[0] = gg_[tid]; st[1] = gg_[tid + 512]; st[2] = gg_[tid + 1024]; st[3] = gg_[tid + 1536]; st[4] = gg_[tid + 2048]; st[5] = gg_[tid + 2560]; st[6] = hh_[tid]; st[7] = hh_[tid + 512]; \
        if (tid < 128) sc1 = ((const float*)(hrec + (size_t)(ck_) * 16 * SSU_BYTES + SSU_CUM))[tid]; } while (0)
#define S2_STORE() do { \
        *(LAS v4u*)(lds + S2_C + (tid >> 4) * 272 + (tid & 15) * 16) = st[0]; *(LAS v4u*)(lds + S2_C + (32 + (tid >> 4)) * 272 + (tid & 15) * 16) = st[1]; \
        *(LAS v4u*)(lds + S2_B + (tid >> 4) * 272 + (tid & 15) * 16) = st[2]; *(LAS v4u*)(lds + S2_B + (32 + (tid >> 4)) * 272 + (tid & 15) * 16) = st[3]; \
        *(LAS v4u*)(lds + S2_BT + (tid >> 3) * 144 + (tid & 7) * 16) = st[4]; *(LAS v4u*)(lds + S2_BT + (64 + (tid >> 3)) * 144 + (tid & 7) * 16) = st[5]; \
        *(LAS v4u*)(lds + S2_XT + (tid >> 3) * 144 + (tid & 7) * 16) = st[6]; *(LAS v4u*)(lds + S2_XTW + (tid >> 3) * 144 + (tid & 7) * 16) = st[7]; \
        if (tid < 128) cums[tid] = sc1; } while (0)
    S2_LOAD(0);
    const int tt = w >> 1, aoffC = l15 * 272 + 16 * q4, aoffS = l15 * 144 + 16 * q4;
    for (int ck = 0; ck < 32; ++ck) {
        const int row0 = b * SEQ + ck * 64;
        __syncthreads();
        S2_STORE();
        __syncthreads();
        if (ck + 1 < 32) S2_LOAD(ck + 1);
        float zv[2][4];
#pragma unroll
        for (int e2 = 0; e2 < 2; ++e2)
#pragma unroll
            for (int r = 0; r < 4; ++r) zv[e2][r] = UF[(size_t)(row0 + 16 * tt + 4 * q4 + r) * UFW + UF_SSZ + hd * 64 + 16 * (2 * (w & 1) + e2) + l15];
#pragma unroll
        for (int e2 = 0; e2 < 2; ++e2) { const int stl = 2 * (w & 1) + e2; f32x4 acc = {0.f, 0.f, 0.f, 0.f};
            if (stl <= tt) {
#pragma unroll
                for (int ks = 0; ks < 4; ++ks) acc = __builtin_amdgcn_mfma_f32_16x16x32_bf16(*(const LAS bf16x8*)(lds + S2_C + tt * 16 * 272 + aoffC + ks * 64), *(const LAS bf16x8*)(lds + S2_B + stl * 16 * 272 + aoffC + ks * 64), acc, 0, 0, 0); }
            const int s = 16 * stl + l15; const float cs = cums[s], ds = dts[s];
#pragma unroll
            for (int r = 0; r < 4; ++r) { const int t = 16 * tt + 4 * q4 + r; const float v = s <= t ? acc[r] * expf(cums[t] - cs) * ds : 0.f;
                *(LAS unsigned short*)(lds + S2_WM + t * 144 + s * 2) = (unsigned short)f2bf(v); } }
#pragma unroll
        for (int mt = 0; mt < 4; ++mt)
#pragma unroll
            for (int r = 0; r < 4; ++r) *(LAS unsigned short*)(lds + S2_HB + (16 * mt + 4 * q4 + r) * 272 + (16 * w + l15) * 2) = (unsigned short)f2bf(hacc[mt][r]);
        __syncthreads();
        float ssq[4] = {0.f, 0.f, 0.f, 0.f};
#pragma unroll
        for (int e2 = 0; e2 < 2; ++e2) { const int pt = 2 * (w & 1) + e2; f32x4 y = {0.f, 0.f, 0.f, 0.f};
#pragma unroll
            for (int ks = 0; ks < 4; ++ks) y = __builtin_amdgcn_mfma_f32_16x16x32_bf16(*(const LAS bf16x8*)(lds + S2_C + tt * 16 * 272 + aoffC + ks * 64), *(const LAS bf16x8*)(lds + S2_HB + pt * 16 * 272 + aoffC + ks * 64), y, 0, 0, 0);
#pragma unroll
            for (int r = 0; r < 4; ++r) y[r] *= expf(cums[16 * tt + 4 * q4 + r]);
#pragma unroll
            for (int ke = 0; ke < 2; ++ke) y = __builtin_amdgcn_mfma_f32_16x16x32_bf16(*(const LAS bf16x8*)(lds + S2_WM + tt * 16 * 144 + aoffS + ke * 64), *(const LAS bf16x8*)(lds + S2_XT + pt * 16 * 144 + aoffS + ke * 64), y, 0, 0, 0);
            const int p = 16 * pt + l15;
#pragma unroll
            for (int r = 0; r < 4; ++r) { const int t = 16 * tt + 4 * q4 + r; const float xv = bflo((unsigned)*(const LAS unsigned short*)(lds + S2_XT + p * 144 + t * 2));
                const float yg = (y[r] + Dk * xv) * siluf_(zv[e2][r]); ssq[r] += yg * yg;
                Og[(size_t)(row0 + t) * 512 + (hd & 7) * 64 + p] = (bf16)f2bf(yg); } }
#pragma unroll
        for (int r = 0; r < 4; ++r) { const float s = row16_sum(ssq[r]); if (l15 == 0) SSQ[(size_t)(row0 + 16 * tt + 4 * q4 + r) * 32 + hd * 2 + (w & 1)] = s; }
        { const float e63 = expf(cums[63]);
#pragma unroll
          for (int mt = 0; mt < 4; ++mt) { hacc[mt] = hacc[mt] * e63;
#pragma unroll
              for (int ke = 0; ke < 2; ++ke) hacc[mt] = __builtin_amdgcn_mfma_f32_16x16x32_bf16(*(const LAS bf16x8*)(lds + S2_XTW + mt * 16 * 144 + aoffS + ke * 64), *(const LAS bf16x8*)(lds + S2_BT + w * 16 * 144 + aoffS + ke * 64), hacc[mt], 0, 0, 0); } }
    }
    float* hout = A->out + O_SSHP + ((size_t)(layer * NBATCH + b) * 16 + hd) * 8192;
#pragma unroll
    for (int mt = 0; mt < 4; ++mt)
#pragma unroll
        for (int r = 0; r < 4; ++r) hout[(size_t)(16 * mt + 4 * q4 + r) * 128 + 16 * w + l15] = hacc[mt][r];
    __syncthreads();
#undef S2_LOAD
#undef S2_STORE
}

struct ALBf16 { const bf16* A; int lda; __device__ __forceinline__ bf16x8 operator()(int row, int k) const { return *(const bf16x8*)(A + (size_t)row * lda + k); } };
template <class AL> __device__ __forceinline__ void sgemm_task(const AL& al, const bf16* Wt, int ldw, int n0, int k0, int nks, f32x4 (&acc)[2], int l15, int q4) {
    const bf16* bp = Wt + (size_t)(n0 + l15) * ldw + k0 + 8 * q4;
    int nks_ = nks; asm volatile("" : "+s"(nks_));
#pragma unroll 4
    for (int ks = 0; ks < nks_; ++ks) { const bf16x8 b = *(const bf16x8*)(bp + 32 * ks); const bf16x8 a0 = al(l15, k0 + 32 * ks + 8 * q4), a1 = al(16 + l15, k0 + 32 * ks + 8 * q4);
        acc[0] = __builtin_amdgcn_mfma_f32_16x16x32_bf16(a0, b, acc[0], 0, 0, 0); acc[1] = __builtin_amdgcn_mfma_f32_16x16x32_bf16(a1, b, acc[1], 0, 0, 0); }
}
#define SAMPLE_IDS() const int tid = tid_opaque(wv), lane = tid & 63, l15 = lane & 15, q4 = lane >> 4, NGW = gridDim.x * NWAVES, gw = (tid >> 6) * gridDim.x + blk_opaque()
__device__ __forceinline__ void sample_merge(CA A, int layer, const int wv) {
    SAMPLE_IDS();
    const bf16* GT = WSP(bf16, WS_GATE); const float* SQ = WSP(float, WS_SSQ); bf16* MB = WSP(bf16, WS_MGB);
    for (int it = gw; it < 128; it += NGW) { const int n0 = it * 16, col = n0 + l15;
        f32x4 tot[2] = {{0.f, 0.f, 0.f, 0.f}, {0.f, 0.f, 0.f, 0.f}};
#pragma unroll 1
        for (int s = 0; s < 5; ++s) { const int gs = s < 3 ? s : 3;
            f32x4 acc[2] = {{0.f, 0.f, 0.f, 0.f}, {0.f, 0.f, 0.f, 0.f}};
            ALBf16 al{WSP(bf16, WS_OBR) + (size_t)s * MP * 512 + (size_t)TP * 512, 512};
            sgemm_task(al, WSP(bf16, WS_WBR) + (size_t)(layer * 5 + s) * DM * 512, 512, n0, 0, 16, acc, l15, q4);
#pragma unroll
            for (int mt = 0; mt < 2; ++mt)
#pragma unroll
                for (int r = 0; r < 4; ++r) { const int grow = TP + 16 * mt + 4 * q4 + r; float rs = 1.f;
                    if (s >= 3) { const f32x4* sq = (const f32x4*)(SQ + (size_t)grow * 32 + 16 * (s - 3)); const f32x4 a = sq[0], b = sq[1], c = sq[2], d = sq[3];
                        rs = 1.0f / sqrtf((((a[0] + a[1]) + (a[2] + a[3]) + (b[0] + b[1]) + (b[2] + b[3])) + ((c[0] + c[1]) + (c[2] + c[3]) + (d[0] + d[1]) + (d[2] + d[3]))) * (1.0f / 512.0f) + RMS_EPS); }
                    tot[mt][r] += acc[mt][r] * bflo((unsigned)GT[(size_t)grow * 8192 + gs * 2048 + col]) * rs; } }
#pragma unroll
        for (int mt = 0; mt < 2; ++mt)
#pragma unroll
            for (int r = 0; r < 4; ++r) MB[(size_t)(TP + 16 * mt + 4 * q4 + r) * DM + col] = (bf16)f2bf(tot[mt][r]); }
}
__device__ __forceinline__ void sample_up(CA A, int layer, const int wv) {
    SAMPLE_IDS();
    bf16* F = WSP(bf16, WS_F);
    for (int it = gw; it < 512; it += NGW) { const int n0 = it * 16;
        f32x4 acc[2] = {{0.f, 0.f, 0.f, 0.f}, {0.f, 0.f, 0.f, 0.f}};
        ALBf16 al{WSP(bf16, WS_H) + (size_t)TP * DM, DM};
        sgemm_task(al, WSP(bf16, WS_WUP) + (size_t)layer * DFF * DM, DM, n0, 0, 64, acc, l15, q4);
#pragma unroll
        for (int mt = 0; mt < 2; ++mt)
#pragma unroll
            for (int r = 0; r < 4; ++r) { const float v = fmaxf(acc[mt][r], 0.f); F[(size_t)(TP + 16 * mt + 4 * q4 + r) * DFF + n0 + l15] = (bf16)f2bf(v * v); } }
}
template <class AL> __device__ __forceinline__ void sample_splitk(const AL& al, const bf16* Wt, int ldw, int nstrips, int nsplit, int nks, float* PART, int ldp, const int wv) {
    SAMPLE_IDS();
    for (int it = gw; it < nstrips * nsplit; it += NGW) { const int ns = it % nstrips, sp = it / nstrips, n0 = ns * 16;
        f32x4 acc[2] = {{0.f, 0.f, 0.f, 0.f}, {0.f, 0.f, 0.f, 0.f}};
        sgemm_task(al, Wt, ldw, n0, sp * nks * 32, nks, acc, l15, q4);
#pragma unroll
        for (int mt = 0; mt < 2; ++mt)
#pragma unroll
            for (int r = 0; r < 4; ++r) PART[((size_t)sp * TS + 16 * mt + 4 * q4 + r) * ldp + n0 + l15] = acc[mt][r]; }
}

constexpr int KS_PITCH = 272, VT_PITCH = 136;
constexpr int ATT_KS = 0, ATT_VT = 64 * KS_PITCH;
__device__ __forceinline__ void attn_prompt_unit(CA A, LAS unsigned char* lds, int layer, int unit, const int wv) {
    const int tid = tid_opaque(wv), lane = tid & 63, wid = tid >> 6, r = lane & 31, hh = lane >> 5;
    const int qb = 7 - (unit >> 4), bh = unit & 15, b = bh >> 2, h = bh & 3;
    const int q0 = qb * 256 + wid * 32, qpos = q0 + r;
    const bf16* QKV = WSP(bf16, WS_QKV) + (size_t)(b * SEQ) * 1536;
    bf16x8 Qf[8];
    { const bf16* qrow = QKV + (size_t)qpos * 1536 + h * 128 + 8 * hh;
#pragma unroll
      for (int s = 0; s < 8; ++s) Qf[s] = *(const bf16x8*)(qrow + 16 * s); }
    f32x16 O[4];
#pragma unroll
    for (int d = 0; d < 4; ++d)
#pragma unroll
        for (int i = 0; i < 16; ++i) O[d][i] = 0.f;
    float R = 0.f;
    const float bias2 = IN_F(I_SBBIAS)[layer * 4 + h] * LOG2E;
    const int ntile = qb * 4 + 4, srow = tid >> 3, sch = tid & 7;
    LAS unsigned char* Ks = lds + ATT_KS; LAS unsigned char* Vt = lds + ATT_VT;
    v4u kreg[2], vreg[2];
    { const bf16* src = QKV + (size_t)((ntile - 1) * 64 + srow) * 1536 + h * 128 + sch * 8;
      kreg[0] = *(const v4u*)(src + 512); kreg[1] = *(const v4u*)(src + 512 + 64); vreg[0] = *(const v4u*)(src + 1024); vreg[1] = *(const v4u*)(src + 1024 + 64); }
    for (int kt = ntile - 1; kt >= 0; --kt) {
        __syncthreads();
#pragma unroll
        for (int i = 0; i < 2; ++i) { *(LAS v4u*)(Ks + srow * KS_PITCH + (sch + 8 * i) * 16) = kreg[i];
            LAS unsigned short* vt = (LAS unsigned short*)Vt + ((sch + 8 * i) * 8) * (VT_PITCH / 2) + srow;
            const unsigned w[4] = {vreg[i].x, vreg[i].y, vreg[i].z, vreg[i].w};
#pragma unroll
            for (int e = 0; e < 4; ++e) { vt[(2 * e) * (VT_PITCH / 2)] = (unsigned short)(w[e] & 0xffffu); vt[(2 * e + 1) * (VT_PITCH / 2)] = (unsigned short)(w[e] >> 16); } }
        __syncthreads();
        if (kt > 0) { const bf16* src = QKV + (size_t)((kt - 1) * 64 + srow) * 1536 + h * 128 + sch * 8;
            kreg[0] = *(const v4u*)(src + 512); kreg[1] = *(const v4u*)(src + 512 + 64); vreg[0] = *(const v4u*)(src + 1024); vreg[1] = *(const v4u*)(src + 1024 + 64); }
        if (kt * 64 > q0 + 30) continue;
        const bool diag = (kt * 64 + 63 >= q0);
        const int kbase = kt * 64 + 4 * hh;
        bf16x8 Pf[4];
#pragma unroll
        for (int sub = 1; sub >= 0; --sub) {
            f32x16 sa;
#pragma unroll
            for (int i = 0; i < 16; ++i) sa[i] = bias2;
#pragma unroll
            for (int s = 0; s < 8; ++s) { const bf16x8 a = *(const LAS bf16x8*)(Ks + (32 * sub + r) * KS_PITCH + (16 * s + 8 * hh) * 2);
                sa = __builtin_amdgcn_mfma_f32_32x32x16_bf16(a, Qf[s], sa, 0, 0, 0); }
            float sp[16], Gs[4], Gp[4];
#pragma unroll
            for (int i = 0; i < 16; ++i) { const float z = fminf(sa[i], 60.f); sa[i] = z; float s1 = lg2(1.0f + ex2(z));
                if (diag && (kbase + 32 * sub + 8 * (i >> 2) + (i & 3) >= qpos)) s1 = 0.f;
                sp[i] = s1; }
#pragma unroll
            for (int g = 0; g < 4; ++g) { Gs[g] = (sp[4 * g] + sp[4 * g + 1]) + (sp[4 * g + 2] + sp[4 * g + 3]); Gp[g] = __shfl_xor(Gs[g], 32); }
            float run = R;
#pragma unroll
            for (int g = 3; g >= 0; --g) { float a = run + (hh == 0 ? Gp[g] : 0.f);
#pragma unroll
                for (int e = 3; e >= 0; --e) { const int i = 4 * g + e; float pv = ex2(sa[i] - sp[i] - a);
                    if (diag && (kbase + 32 * sub + 8 * g + e >= qpos)) pv = 0.f;
                    a += sp[i]; sp[i] = pv; }
                run += Gs[g] + Gp[g]; }
            R = run;
#pragma unroll
            for (int q2 = 0; q2 < 2; ++q2) { const int bs = 8 * q2; v4u w;
                w.x = pk2(sp[bs + 0], sp[bs + 1]); w.y = pk2(sp[bs + 2], sp[bs + 3]); w.z = pk2(sp[bs + 4], sp[bs + 5]); w.w = pk2(sp[bs + 6], sp[bs + 7]);
                Pf[2 * sub + q2] = __builtin_bit_cast(bf16x8, w); }
        }
#pragma unroll
        for (int d = 0; d < 4; ++d)
#pragma unroll
            for (int s4 = 0; s4 < 4; ++s4) { const LAS unsigned char* vp = Vt + (32 * d + r) * VT_PITCH + (16 * s4 + 4 * hh) * 2;
                const v2u lo = *(const LAS v2u*)vp, hi = *(const LAS v2u*)(vp + 16); v4u w; w.x = lo.x; w.y = lo.y; w.z = hi.x; w.w = hi.y;
                O[d] = __builtin_amdgcn_mfma_f32_32x32x16_bf16(__builtin_bit_cast(bf16x8, w), Pf[s4], O[d], 0, 0, 0); }
    }
    bf16* orow = WSP(bf16, WS_OBR) + (size_t)2 * MP * 512 + (size_t)(b * SEQ + qpos) * 512 + h * 128 + 4 * hh;
#pragma unroll
    for (int d = 0; d < 4; ++d)
#pragma unroll
        for (int g = 0; g < 4; ++g) { v2u w; w.x = pk2(O[d][4 * g], O[d][4 * g + 1]); w.y = pk2(O[d][4 * g + 2], O[d][4 * g + 3]); *(v2u*)(orow + 32 * d + 8 * g) = w; }
}

__device__ __forceinline__ void attn_sample_unit(CA A, LAS unsigned char* lds, int layer, int unit, const int wv) {
    const int tid = tid_opaque(wv), lane = tid & 63, wid = tid >> 6, sb = unit >> 5, pg4 = unit & 31, hd = lane >> 4;
    const int lp = 4 * pg4 + (wid >> 1), phys = ((const int*)A->in[I_PT])[sb * NPAGES + lp];
    const size_t pbase = ((size_t)(layer * NPOOL + phys) * PAGE + (wid & 1) * 64) * 512 + lane * 8;
    const float* Kc = IN_F(I_CK) + pbase; const float* Vc = IN_F(I_CV) + pbase;
    const bf16* QKV = WSP(bf16, WS_QKV);
    float qf[4][8], O[4][8], R[4];
#pragma unroll
    for (int i = 0; i < 4; ++i) { const v4u w = *(const v4u*)(QKV + (size_t)(TP + sb * 4 + i) * 1536 + lane * 8);
        qf[i][0] = bflo(w.x); qf[i][1] = bfhi(w.x); qf[i][2] = bflo(w.y); qf[i][3] = bfhi(w.y); qf[i][4] = bflo(w.z); qf[i][5] = bfhi(w.z); qf[i][6] = bflo(w.w); qf[i][7] = bfhi(w.w);
        R[i] = 0.f;
#pragma unroll
        for (int j = 0; j < 8; ++j) O[i][j] = 0.f; }
    const float bias2 = IN_F(I_SBBIAS)[layer * 4 + hd] * LOG2E;
#pragma unroll 4
    for (int t = 63; t >= 0; --t) {
        const f32x4 k0 = *(const f32x4*)(Kc + (size_t)t * 512), k1 = *(const f32x4*)(Kc + (size_t)t * 512 + 4), v0 = *(const f32x4*)(Vc + (size_t)t * 512), v1 = *(const f32x4*)(Vc + (size_t)t * 512 + 4);
#pragma unroll
        for (int i = 0; i < 4; ++i) {
            float s = (qf[i][0] * k0[0] + qf[i][1] * k0[1]) + (qf[i][2] * k0[2] + qf[i][3] * k0[3]) + (qf[i][4] * k1[0] + qf[i][5] * k1[1]) + (qf[i][6] * k1[2] + qf[i][7] * k1[3]);
            s = row16_sum(s);
            const float z = fminf(s + bias2, 60.f), s1 = lg2(1.0f + ex2(z)), pv = ex2(z - s1 - R[i]); R[i] += s1;
#pragma unroll
            for (int e = 0; e < 4; ++e) { O[i][e] += pv * v0[e]; O[i][4 + e] += pv * v1[e]; } }
    }
    LAS float* Ow = (LAS float*)lds;
    LAS float* Rw = Ow + 8 * 4 * 512;
    __syncthreads();
#pragma unroll
    for (int i = 0; i < 4; ++i) { *(LAS f32x4*)(Ow + (wid * 4 + i) * 512 + lane * 8) = (f32x4){O[i][0], O[i][1], O[i][2], O[i][3]}; *(LAS f32x4*)(Ow + (wid * 4 + i) * 512 + lane * 8 + 4) = (f32x4){O[i][4], O[i][5], O[i][6], O[i][7]};
        if ((lane & 15) == 0) Rw[(wid * 4 + i) * 4 + hd] = R[i]; }
    __syncthreads();
    float* PART = WSP(float, WS_PART) + (size_t)unit * 2048; float* PR = WSP(float, WS_PR) + (size_t)unit * 16;
    for (int idx = tid; idx < 2048; idx += NTHR) { const int i = idx >> 9, c = idx & 511, hc = c >> 7; float acc = 0.f, racc = 0.f;
#pragma unroll
        for (int w = 7; w >= 0; --w) { acc += ex2(-racc) * Ow[(w * 4 + i) * 512 + c]; racc += Rw[(w * 4 + i) * 4 + hc]; }
        PART[idx] = acc; if ((c & 127) == 0) PR[i * 4 + hc] = racc; }
}
__device__ __forceinline__ void attn_sample_combine(CA A, int layer, const int wv) {
    const int tid = tid_opaque(wv), lane = tid & 63, gw = blk_opaque() * NWAVES + (tid >> 6), NGW = gridDim.x * NWAVES;
    const bf16* QKV = WSP(bf16, WS_QKV); const float* PART = WSP(float, WS_PART); const float* PR = WSP(float, WS_PR);
    const float* kn = A->out + O_KS + (size_t)layer * TS * 512; const float* vn = A->out + O_VS + (size_t)layer * TS * 512;
    bf16* O2 = WSP(bf16, WS_OBR) + (size_t)2 * MP * 512;
    for (int it = gw; it < TS * 4; it += NGW) { const int sb = it >> 4, i = (it >> 2) & 3, hd = it & 3, row = TP + sb * 4 + i, c = hd * 128 + 2 * lane;
        const unsigned qw = *(const unsigned*)(QKV + (size_t)row * 1536 + c); const float q0 = bflo(qw), q1 = bfhi(qw);
        const float bias2 = IN_F(I_SBBIAS)[layer * 4 + hd] * LOG2E; float o0 = 0.f, o1 = 0.f, racc = 0.f;
        for (int j = i - 1; j >= 0; --j) { const float* kr = kn + (size_t)(sb * 4 + j) * 512 + c; const float* vr = vn + (size_t)(sb * 4 + j) * 512 + c;
            const float z = fminf(wave_sum(q0 * kr[0] + q1 * kr[1]) + bias2, 60.f), s1 = lg2(1.0f + ex2(z)), pv = ex2(z - s1 - racc); racc += s1; o0 += pv * vr[0]; o1 += pv * vr[1]; }
        for (int u = 31; u >= 0; --u) { const float* pr = PART + ((size_t)(sb * 32 + u) * 4 + i) * 512 + c; const float sc = ex2(-racc); o0 += sc * pr[0]; o1 += sc * pr[1]; racc += PR[(size_t)(sb * 32 + u) * 16 + i * 4 + hd]; }
        *(unsigned*)(O2 + (size_t)row * 512 + c) = pk2(o0, o1); }
}

#ifndef MK_ONE_LAUNCH
#define MK_ONE_LAUNCH 1
#endif
#ifndef REP_P0
#define REP_P0 1
#endif
#ifndef REP_IN
#define REP_IN 1
#endif
#ifndef REP_PREP
#define REP_PREP 1
#endif
#ifndef REP_MIXA
#define REP_MIXA 1
#endif
#ifndef REP_MIXB
#define REP_MIXB 1
#endif
#ifndef REP_MERGE
#define REP_MERGE 1
#endif
#ifndef REP_OUT
#define REP_OUT 1
#endif
#ifndef REP_UP
#define REP_UP 1
#endif
#ifndef REP_DOWN
#define REP_DOWN 1
#endif
constexpr int N_PHASES = 24;
__device__ __forceinline__ int queue_pop(unsigned* head, volatile LAS unsigned* slot, const int wv) {
    __syncthreads();
    if (tid_opaque(wv) == 0) *slot = __hip_atomic_fetch_add(head, 1u, __ATOMIC_RELAXED, __HIP_MEMORY_SCOPE_AGENT);
    __syncthreads();
    return (int)*slot;
}
__global__ void __launch_bounds__(NTHR, 2) mega(Args Araw) {
    extern __shared__ __attribute__((aligned(16))) unsigned char lds_raw[];
    LAS unsigned char* lds = (LAS unsigned char*)lds_raw;
    volatile LAS unsigned* MISC = (volatile LAS unsigned*)(lds + MISC_OFF);
    const int wv = __builtin_amdgcn_readfirstlane(threadIdx.x >> 6); const int tid = tid_opaque(wv), G = gridDim.x, blk = blk_opaque();
    if (tid < 16) MISC[tid] = 0u;
    __syncthreads();
    unsigned* ctl = (unsigned*)(Araw.ws + WS_CTL);
    XcdBarrier bar = xcd_barrier_post(ctl + CW_BAR + Araw.li * XCD_BAR_WORDS, MISC, tid);
    const int lo = Araw.ph_lo, hi = Araw.ph_hi;
#define IN(gp) (lo <= (gp) && (gp) < hi)
#define SEAM(gp) do { if (lo <= (gp) && (gp) + 1 < hi) xcd_barrier(bar, tid_opaque(wv)); } while (0)

    if (IN(0)) for (int rep = 0; rep < REP_P0; ++rep) { CA A = args_opaque(); p0_prologue(A, lds, wv); }
    SEAM(0);
    if (IN(1)) { CA A = args_opaque(); norm1_phase(A, wv); }
    SEAM(1);
    for (int layer = 0; layer < DEPTH; ++layer) {
        const int gb = 1 + 11 * layer;
        if (IN(gb + 1)) for (int rep = 0; rep < REP_IN; ++rep) { CA A = args_opaque();
            pg8::Gemm g{WSP(bf16, WS_H), WSP(bf16, WS_WIN) + (size_t)layer * NIN * DM, MP, NIN, DM}; pg8::StaticOrder S; S.init(MP, NIN, G, blk_opaque());
            EpiIn E{WSP(float, WS_UF), WSP(bf16, WS_QKV), WSP(bf16, WS_GATE), A->out + O_KP + (size_t)layer * TP * 512, A->out + O_VP + (size_t)layer * TP * 512,
                    A->out + O_KS + (size_t)layer * TS * 512, A->out + O_VS + (size_t)layer * TS * 512, 0.08838834764831845f * LOG2E};
            pg8::gemm_phase<EpiIn, pg8::StaticOrder, true, true>(lds, g, S, E, wv);
        }
        SEAM(gb + 1);
        if (IN(gb + 2)) for (int rep = 0; rep < REP_PREP; ++rep) { CA A = args_opaque(); prep_phase(A, layer, wv); }
        SEAM(gb + 2);
        if (IN(gb + 3)) for (int rep = 0; rep < REP_MIXA; ++rep) { CA A = args_opaque();
            { unsigned* qh = ctl + CW_QUEUE + 64 * (layer * 4 + 3) + 1024 * rep;
              for (;;) { const int u = queue_pop(qh, MISC + 4, wv); if (u >= 2048) break; ssd_prep_unit(A, lds, layer, u, wv); } }
            { unsigned* qh = ctl + CW_QUEUE + 64 * (layer * 4 + 2) + 1024 * rep;
              for (;;) { const int u = queue_pop(qh, MISC + 4, wv); if (u >= 512) break; dn_chunk_unit(A, lds, layer, u, wv); } }
            { unsigned* qh = ctl + CW_QUEUE + 64 * (layer * 4 + 0) + 1024 * rep;
              for (;;) { const int u = queue_pop(qh, MISC + 4, wv); if (u >= 128) break; attn_prompt_unit(A, lds, layer, u, wv); } }
        }
        SEAM(gb + 3);
        if (IN(gb + 4)) for (int rep = 0; rep < REP_MIXB; ++rep) { CA A = args_opaque();
            for (int t = blk; t < 16; t += G) dn_seq2(A, lds, layer, t, wv);
            for (int t = blk; t < 80; t += G) if (t >= 16) ssd_seq2(A, lds, layer, t - 16, wv);
            for (int t = blk; t < 112; t += G) if (t >= 80) dn_seq(A, lds, layer, t - 80 + 16, wv);
            for (int t = blk; t < 240; t += G) if (t >= 112) ssd_seq(A, lds, layer, t - 112 + 64, wv);
            { unsigned* qh = ctl + CW_QUEUE + 64 * (layer * 4 + 1) + 1024 * rep;
              for (;;) { const int u = queue_pop(qh, MISC + 4, wv); if (u >= 256) break; attn_sample_unit(A, lds, layer, u, wv); } }
        }
        SEAM(gb + 4);
        if (IN(gb + 5)) { CA A = args_opaque(); attn_sample_combine(A, layer, wv); }
        SEAM(gb + 5);
        if (IN(gb + 6)) for (int rep = 0; rep < REP_MERGE; ++rep) { CA A = args_opaque();
            pg8::StaticOrder S; S.init(TP, DM, G, blk_opaque());
            const bf16* Wb = WSP(bf16, WS_WBR) + (size_t)layer * 5 * DM * 512; const bf16* Ob = WSP(bf16, WS_OBR);
            const bf16* GT = WSP(bf16, WS_GATE); const float* SQ = WSP(float, WS_SSQ); float* MG = WSP(float, WS_MG32); bf16* MB = WSP(bf16, WS_MGB);
            { pg8::Gemm g{Ob + (size_t)0 * MP * 512, Wb + (size_t)0 * DM * 512, TP, DM, 512}; EpiMerge<0> E{GT, SQ, MG, MB}; pg8::gemm_phase<EpiMerge<0>, pg8::StaticOrder, true, true>(lds, g, S, E, wv); }
            { pg8::Gemm g{Ob + (size_t)1 * MP * 512, Wb + (size_t)1 * DM * 512, TP, DM, 512}; EpiMerge<1> E{GT, SQ, MG, MB}; pg8::gemm_phase<EpiMerge<1>, pg8::StaticOrder, true, true>(lds, g, S, E, wv); }
            { pg8::Gemm g{Ob + (size_t)2 * MP * 512, Wb + (size_t)2 * DM * 512, TP, DM, 512}; EpiMerge<2> E{GT, SQ, MG, MB}; pg8::gemm_phase<EpiMerge<2>, pg8::StaticOrder, true, true>(lds, g, S, E, wv); }
            { pg8::Gemm g{Ob + (size_t)3 * MP * 512, Wb + (size_t)3 * DM * 512, TP, DM, 512}; EpiMerge<3> E{GT, SQ, MG, MB}; pg8::gemm_phase<EpiMerge<3>, pg8::StaticOrder, true, true>(lds, g, S, E, wv); }
            { pg8::Gemm g{Ob + (size_t)4 * MP * 512, Wb + (size_t)4 * DM * 512, TP, DM, 512}; EpiMerge<4> E{GT, SQ, MG, MB}; pg8::gemm_phase<EpiMerge<4>, pg8::StaticOrder, true, true>(lds, g, S, E, wv); }
            sample_merge(A, layer, wv);
        }
        SEAM(gb + 6);
        if (IN(gb + 7)) for (int rep = 0; rep < REP_OUT; ++rep) { CA A = args_opaque();
            pg8::Gemm g{WSP(bf16, WS_MGB), WSP(bf16, WS_WOUT) + (size_t)layer * DM * DM, TP, DM, DM}; pg8::StaticOrder S; S.init(TP, DM, G, blk_opaque());
            EpiF32 E{WSP(float, WS_MIX), DM}; pg8::gemm_phase<EpiF32, pg8::StaticOrder, true, true>(lds, g, S, E, wv);
            { ALBf16 al{WSP(bf16, WS_MGB) + (size_t)TP * DM, DM}; sample_splitk(al, WSP(bf16, WS_WOUT) + (size_t)layer * DM * DM, DM, 128, 16, 4, WSP(float, WS_OUTS), DM, wv); }
        }
        SEAM(gb + 7);
        if (IN(gb + 8)) { CA A = args_opaque(); resid_phase(A, WSP(float, WS_MIX), WSP(float, WS_OUTS), IN_F(I_NMPOST) + layer * DM, IN_F(I_NLPRE) + layer * DM, layer == 0, wv); }
        SEAM(gb + 8);
        if (IN(gb + 9)) for (int rep = 0; rep < REP_UP; ++rep) { CA A = args_opaque();
            pg8::Gemm g{WSP(bf16, WS_H), WSP(bf16, WS_WUP) + (size_t)layer * DFF * DM, TP, DFF, DM}; pg8::StaticOrder S; S.init(TP, DFF, G, blk_opaque());
            EpiRelu2 E{WSP(bf16, WS_F), DFF}; pg8::gemm_phase<EpiRelu2, pg8::StaticOrder, true, true>(lds, g, S, E, wv);
            sample_up(A, layer, wv);
        }
        SEAM(gb + 9);
        if (IN(gb + 10)) for (int rep = 0; rep < REP_DOWN; ++rep) { CA A = args_opaque();
            pg8::Gemm g{WSP(bf16, WS_F), WSP(bf16, WS_WDN) + (size_t)layer * DM * DFF, TP, DM, DFF}; pg8::StaticOrder S; S.init(TP, DM, G, blk_opaque());
            EpiF32 E{WSP(float, WS_FD), DM}; pg8::gemm_phase<EpiF32, pg8::StaticOrder, true, true>(lds, g, S, E, wv);
            { ALBf16 al{WSP(bf16, WS_F) + (size_t)TP * DFF, DFF}; sample_splitk(al, WSP(bf16, WS_WDN) + (size_t)layer * DM * DFF, DFF, 128, 16, 16, WSP(float, WS_DNS), DM, wv); }
        }
        SEAM(gb + 10);
        if (IN(gb + 11)) { CA A = args_opaque(); resid_phase(A, WSP(float, WS_FD), WSP(float, WS_DNS), IN_F(I_NLPOST) + layer * DM, layer + 1 < DEPTH ? IN_F(I_NMPRE) + (layer + 1) * DM : nullptr, false, wv); }
        SEAM(gb + 11);
    }
#undef IN
#undef SEAM
}

extern "C" void kernel_launch(void* const* d_in, const int* in_sizes, int n_in, void* d_out, int out_size, void* d_ws, size_t ws_size, hipStream_t stream) {
    static int grid = 0;
    if (grid == 0) {
        if (n_in != N_IN || (size_t)out_size != O_END || ws_size < WS_END) { fprintf(stderr, "kernel_launch: unexpected problem (n_in %d, out %d vs %zu, ws %zu vs %zu); nothing launched\n", n_in, out_size, (size_t)O_END, ws_size, (size_t)WS_END); grid = -1; return; }
        int dev = 0, cus = 0, per_cu = 0;
        if (hipGetDevice(&dev) != hipSuccess || hipDeviceGetAttribute(&cus, hipDeviceAttributeMultiprocessorCount, dev) != hipSuccess) { grid = -1; return; }
        if (hipFuncSetAttribute((const void*)mega, hipFuncAttributeMaxDynamicSharedMemorySize, LDS_BYTES) != hipSuccess) { fprintf(stderr, "kernel_launch: hipFuncSetAttribute failed\n"); grid = -1; return; }
        if (hipOccupancyMaxActiveBlocksPerMultiprocessor(&per_cu, (const void*)mega, NTHR, LDS_BYTES) != hipSuccess || per_cu < 1) fprintf(stderr, "kernel_launch: occupancy query says %d blocks per CU\n", per_cu);
        (void)hipGetLastError();
        grid = cus;
    }
    if (grid < 0) return;
    (void)in_sizes;
    hipMemsetAsync((char*)d_ws + WS_CTL, 0, CTL_BYTES, stream);
    Args a{};
    for (int i = 0; i < N_IN; ++i) a.in[i] = d_in[i];
    a.out = (float*)d_out; a.ws = (unsigned char*)d_ws; a.pad = 0;
#if MK_ONE_LAUNCH
    a.ph_lo = 0; a.ph_hi = N_PHASES; a.li = 0;
    hipLaunchKernelGGL(mega, dim3(grid), dim3(NTHR), LDS_BYTES, stream, a);
#else
    for (int gp = 0; gp < N_PHASES; ++gp) { a.ph_lo = gp; a.ph_hi = gp + 1; a.li = 0; hipLaunchKernelGGL(mega, dim3(grid), dim3(NTHR), LDS_BYTES, stream, a); }
#endif
}
```

```cpp
#include <hip/hip_runtime.h>
#include <cstdio>
#include <cstdint>
__device__ __forceinline__ int lane_opaque() { unsigned m = ~0u; asm volatile("" : "+s"(m)); return (int)__builtin_amdgcn_mbcnt_hi(m, __builtin_amdgcn_mbcnt_lo(m, 0u)); }
__device__ __forceinline__ int tid_opaque(int wv) { return wv * 64 + lane_opaque(); }
__device__ __forceinline__ int blk_opaque() { int t = blockIdx.x; asm volatile("" : "+s"(t)); return t; }
namespace pg8 {
#define PG8_LAS __attribute__((address_space(3)))
typedef unsigned short bf16_t;
typedef short bf16x8 __attribute__((ext_vector_type(8)));
typedef float f32x4 __attribute__((ext_vector_type(4)));
typedef unsigned u32x4 __attribute__((ext_vector_type(4)));
constexpr int BM = 256, BK = 64, HALF = 128, HTB = HALF * BK * 2  , STAGE_BYTES = 8 * HTB, NXCD = 8, WGM = 8;

__host__ __device__ __forceinline__ int lds_byte(int r, int c) { const int st = (r >> 4) * 2 + (c >> 5), rr = r & 15, cc = c & 31, ob = rr * 64 + cc * 2; return st * 1024 + (ob ^ (((ob >> 9) & 1) << 5)); }
__host__ __device__ __forceinline__ void stage_rc(int b, int& R, int& C) { const int st = b / 1024, sb = b % 1024, swz = sb ^ (((sb >> 9) & 1) << 5); R = (st >> 1) * 16 + swz / 64; C = (st & 1) * 32 + (swz % 64) / 2; }
__host__ __device__ __forceinline__ int perm32(int rho) { const int n = rho >> 4, i = rho & 15; return 8 * (i >> 2) + 4 * n + (i & 3); }

struct Unit { int pm, pn, seg; };
struct Gemm { const bf16_t* A; const bf16_t* Bt; int M, N, K, KT, SEGB; };

struct StaticOrder {
    int nM, nN, nwg, G, c;
    __host__ __device__ void init(int M, int N, int G_, int c_) { nM = M / BM; nN = N / BM; nwg = nM * nN; G = G_; c = c_; }
    __host__ __device__ bool next(int i, Unit& u) const {
        const long L = (long)i * G + c; if (L >= nwg) return false;
        int wgid = (int)L; { const int q = nwg / NXCD, r = nwg % NXCD, xcd = wgid % NXCD, off = wgid / NXCD; wgid = (xcd < r ? xcd * (q + 1) : r * (q + 1) + (xcd - r) * q) + off; }
        const int nig = WGM * nN, gid = wgid / nig, fm = gid * WGM, gsz = (nM - fm) < WGM ? (nM - fm) : WGM;
        u.pm = fm + ((wgid % nig) % gsz); u.pn = (wgid % nig) / gsz; u.seg = 0; return true;
    }
    __device__ __forceinline__ void a_ready(const Unit&) const {}
    __device__ __forceinline__ void done(const Unit&) const {}
};
template <int NSEG> struct SegOrder : StaticOrder {
    __host__ __device__ bool next(int i, Unit& u) const { if (!StaticOrder::next(i / NSEG, u)) return false; u.seg = i % NSEG; return true; }
};
__device__ __forceinline__ unsigned cvt_pk_bf16(float lo, float hi) { unsigned r; asm volatile("v_cvt_pk_bf16_f32 %0, %1, %2" : "=v"(r) : "v"(lo), "v"(hi)); return r; }
typedef float f32x2 __attribute__((ext_vector_type(2)));
template <class Epi, class Sched, bool ALIGN_EPI = false, bool SP2 = false>
__device__ __forceinline__ void gemm_phase(PG8_LAS unsigned char* lds, const Gemm g, const Sched& S, const Epi& E, const int wv) {
    int wvo = wv; asm volatile("" : "+s"(wvo));
    const int lane = lane_opaque(), tid = wvo * 64 + lane, wid = wvo, wr = wid >> 2, wc = wid & 3, fr = lane & 15, fq = lane >> 4;
    const int K = g.K, nt = g.KT;
    unsigned voffA[2], voffB[2];
#pragma unroll
    for (int i = 0; i < 2; ++i) { int R, C; stage_rc(tid * 16 + i * 8192, R, C); const int Rb = Epi::PERM ? ((R & ~31) + perm32(R & 31)) : R;
        voffA[i] = (unsigned)(R * K + C) * 2u; voffB[i] = (unsigned)(Rb * K + C) * 2u; }
    const size_t kstep = (size_t)(BK * 2);
    const size_t hstep = (size_t)HALF * K * 2;
    const size_t tstep = 2 * hstep;
    const unsigned ldsw = (unsigned)wid * 1024u;
    const int aoff = lds_byte(wr * 64 + fr, fq * 8), boff = lds_byte(wc * 32 + fr, fq * 8);
#define PG8_SA(b, h) (((b) * 2 + (h)) * HTB)
#define PG8_SB(b, h) ((4 + (b) * 2 + (h)) * HTB)
#define PG8_STAGE(bufoff, gbase, voff) do { _Pragma("unroll") for (int _i = 0; _i < 2; ++_i) \
        __builtin_amdgcn_global_load_lds((const unsigned*)((const char*)(gbase) + (voff)[_i]), (PG8_LAS unsigned*)(lds + (bufoff) + ldsw + _i * 8192), 16, 0, 0); } while (0)
#define PG8_LDA(dst, b, h) do { _Pragma("unroll") for (int m = 0; m < 4; ++m) _Pragma("unroll") for (int k = 0; k < 2; ++k) dst[m][k] = *(const PG8_LAS bf16x8*)(lds + PG8_SA(b, h) + aoff + m * 2048 + k * 1024); } while (0)
#define PG8_LDB(dst, b, h) do { _Pragma("unroll") for (int n = 0; n < 2; ++n) _Pragma("unroll") for (int k = 0; k < 2; ++k) dst[n][k] = *(const PG8_LAS bf16x8*)(lds + PG8_SB(b, h) + boff + n * 2048 + k * 1024); } while (0)
#define PG8_MMA(ai, bj, At, Bt) do { __builtin_amdgcn_s_setprio(1); _Pragma("unroll") for (int m = 0; m < 4; ++m) _Pragma("unroll") for (int n = 0; n < 2; ++n) _Pragma("unroll") for (int k = 0; k < 2; ++k) \
        acc[ai][bj][m][n] = __builtin_amdgcn_mfma_f32_16x16x32_bf16(Bt[n][k], At[m][k], acc[ai][bj][m][n], 0, 0, 0); __builtin_amdgcn_s_setprio(0); } while (0)
#define PG8_WAIT_V(n) asm volatile("s_waitcnt vmcnt(" #n ")" ::: "memory")
#define PG8_WAIT_L(n) asm volatile("s_waitcnt lgkmcnt(" #n ")" ::: "memory")
#define PG8_BAR __builtin_amdgcn_s_barrier()
#define PG8_SCHED __builtin_amdgcn_sched_barrier(0)
    Unit cur, nxt; int ui = 0;
    if (!S.next(0, cur)) return;
    f32x4 acc[2][2][4][2];
#pragma unroll
    for (int a = 0; a < 2; ++a)
#pragma unroll
        for (int b = 0; b < 2; ++b)
#pragma unroll
            for (int m = 0; m < 4; ++m)
#pragma unroll
                for (int n = 0; n < 2; ++n) acc[a][b][m][n] = (f32x4){0.f, 0.f, 0.f, 0.f};
    bf16x8 At[4][2], B0[2][2], B1[2][2];
    const char* cA = (const char*)g.A + (size_t)cur.pm * tstep + (size_t)cur.seg * g.SEGB; const char* cB = (const char*)g.Bt + (size_t)cur.pn * tstep + (size_t)cur.seg * g.SEGB;
    S.a_ready(cur);
    if constexpr (SP2) {
        PG8_STAGE(PG8_SB(0, 0), cB, voffB); PG8_STAGE(PG8_SB(0, 1), cB + hstep, voffB); PG8_STAGE(PG8_SA(0, 0), cA, voffA); PG8_STAGE(PG8_SA(0, 1), cA + hstep, voffA);
        if (wr == 1) PG8_BAR;
        PG8_WAIT_V(2); PG8_BAR;
        PG8_STAGE(PG8_SB(1, 0), cB + kstep, voffB); PG8_STAGE(PG8_SA(1, 0), cA + kstep, voffA); PG8_STAGE(PG8_SB(1, 1), cB + hstep + kstep, voffB);
        PG8_WAIT_V(6); PG8_BAR;
    } else {
        PG8_STAGE(PG8_SB(0, 0), cB, voffB); PG8_STAGE(PG8_SA(0, 0), cA, voffA); PG8_STAGE(PG8_SB(0, 1), cB + hstep, voffB); PG8_STAGE(PG8_SA(0, 1), cA + hstep, voffA);
        if (wr == 1) PG8_BAR;
        PG8_WAIT_V(4); PG8_BAR;
        PG8_STAGE(PG8_SB(1, 0), cB + kstep, voffB); PG8_STAGE(PG8_SA(1, 0), cA + kstep, voffA); PG8_STAGE(PG8_SB(1, 1), cB + hstep + kstep, voffB);
        PG8_WAIT_V(6); PG8_BAR;
    }
    for (;;) {
        const bool has_next = S.next(ui + 1, nxt);
        const char* nA = has_next ? (const char*)g.A + (size_t)nxt.pm * tstep + (size_t)nxt.seg * g.SEGB : cA; const char* nB = has_next ? (const char*)g.Bt + (size_t)nxt.pn * tstep + (size_t)nxt.seg * g.SEGB : cB;
        for (int t = 0; t < nt; t += 2) {
            const bool last = (t == nt - 2);
            const char* a1 = cA + (size_t)(t + 1) * kstep;
            const char* a2 = last ? nA : cA + (size_t)(t + 2) * kstep; const char* b2 = last ? nB : cB + (size_t)(t + 2) * kstep;
            const char* a3 = a2 + kstep; const char* b3 = b2 + kstep;
            if (last && has_next) S.a_ready(nxt);
            if constexpr (SP2) {
            PG8_LDB(B0, 0, 0); PG8_LDB(B1, 0, 1); PG8_SCHED; PG8_LDA(At, 0, 0); PG8_STAGE(PG8_SA(1, 1), a1 + hstep, voffA);
            PG8_WAIT_V(8); PG8_WAIT_L(0); PG8_BAR; PG8_MMA(0, 0, At, B0); PG8_MMA(0, 1, At, B1); PG8_BAR; PG8_SCHED;
            PG8_LDA(At, 0, 1); PG8_STAGE(PG8_SB(0, 0), b2, voffB); PG8_STAGE(PG8_SB(0, 1), b2 + hstep, voffB); PG8_STAGE(PG8_SA(0, 0), a2, voffA);
            PG8_WAIT_V(8); PG8_WAIT_L(0); PG8_BAR; PG8_MMA(1, 0, At, B0); PG8_MMA(1, 1, At, B1); PG8_BAR; PG8_SCHED;
            PG8_LDB(B0, 1, 0); PG8_LDB(B1, 1, 1); PG8_SCHED; PG8_LDA(At, 1, 0); PG8_STAGE(PG8_SA(0, 1), a2 + hstep, voffA);
            PG8_WAIT_V(8); PG8_WAIT_L(0); PG8_BAR; PG8_MMA(0, 0, At, B0); PG8_MMA(0, 1, At, B1); PG8_BAR; PG8_SCHED;
            PG8_LDA(At, 1, 1); PG8_STAGE(PG8_SB(1, 0), b3, voffB); PG8_STAGE(PG8_SB(1, 1), b3 + hstep, voffB); PG8_STAGE(PG8_SA(1, 0), a3, voffA);
            PG8_WAIT_V(8); PG8_WAIT_L(0); PG8_BAR; PG8_MMA(1, 0, At, B0); PG8_MMA(1, 1, At, B1); PG8_BAR; PG8_SCHED;
            } else {
            PG8_LDB(B0, 0, 0); PG8_SCHED; PG8_LDA(At, 0, 0); PG8_STAGE(PG8_SA(1, 1), a1 + hstep, voffA);
            PG8_WAIT_L(8); PG8_BAR; PG8_WAIT_L(0); PG8_MMA(0, 0, At, B0); PG8_BAR; PG8_SCHED;
            PG8_LDB(B1, 0, 1); PG8_STAGE(PG8_SB(0, 0), b2, voffB);
            PG8_BAR; PG8_WAIT_L(0); PG8_MMA(0, 1, At, B1); PG8_BAR;
            PG8_LDA(At, 0, 1); PG8_STAGE(PG8_SA(0, 0), a2, voffA);
            PG8_BAR; PG8_WAIT_L(0); PG8_MMA(1, 0, At, B0); PG8_BAR; PG8_SCHED;
            PG8_STAGE(PG8_SB(0, 1), b2 + hstep, voffB);
            PG8_WAIT_V(6); PG8_BAR; PG8_MMA(1, 1, At, B1); PG8_BAR;
            PG8_LDB(B0, 1, 0); PG8_SCHED; PG8_LDA(At, 1, 0); PG8_STAGE(PG8_SA(0, 1), a2 + hstep, voffA);
            PG8_WAIT_L(8); PG8_BAR; PG8_WAIT_L(0); PG8_MMA(0, 0, At, B0); PG8_BAR; PG8_SCHED;
            PG8_LDB(B1, 1, 1); PG8_STAGE(PG8_SB(1, 0), b3, voffB);
            PG8_BAR; PG8_WAIT_L(0); PG8_MMA(0, 1, At, B1); PG8_BAR;
            PG8_LDA(At, 1, 1); PG8_STAGE(PG8_SA(1, 0), a3, voffA);
            PG8_BAR; PG8_WAIT_L(0); PG8_MMA(1, 0, At, B0); PG8_BAR; PG8_SCHED;
            PG8_STAGE(PG8_SB(1, 1), b3 + hstep, voffB);
            PG8_WAIT_V(6); PG8_BAR; PG8_MMA(1, 1, At, B1); PG8_BAR;
            }
        }
        if constexpr (ALIGN_EPI) { if (wr == 0) PG8_BAR; }
        if constexpr (!Epi::AFTER_DRAIN) { E(acc, cur, wr, wc, fr, fq); S.done(cur); }
        if (!has_next) break;
        if (!(Epi::KEEP_ACC && nxt.seg != 0)) {
#pragma unroll
        for (int a = 0; a < 2; ++a)
#pragma unroll
            for (int b = 0; b < 2; ++b)
#pragma unroll
                for (int m = 0; m < 4; ++m)
#pragma unroll
                    for (int n = 0; n < 2; ++n) acc[a][b][m][n] = (f32x4){0.f, 0.f, 0.f, 0.f}; }
        cur = nxt; cA = nA; cB = nB; ++ui;
        if constexpr (ALIGN_EPI) { if (wr == 1) PG8_BAR; }
    }
    PG8_WAIT_V(0);
    if constexpr (!ALIGN_EPI) { if (wr == 0) PG8_BAR; }
    PG8_BAR;
    if constexpr (Epi::AFTER_DRAIN) { E.fused(acc, cur, wr, wc, fr, fq, lds, wid, lane); S.done(cur); }
#undef PG8_SA
#undef PG8_SB
#undef PG8_STAGE
#undef PG8_LDA
#undef PG8_LDB
#undef PG8_MMA
#undef PG8_WAIT_V
#undef PG8_WAIT_L
#undef PG8_BAR
#undef PG8_SCHED
}
}

constexpr int DM = 2048, NBATCH = 4, SEQ = 2048, DEPTH = 2, DBATCH = 8, DSEQ = 4, PAST = 16384, PAGE = 128;
constexpr int TP = NBATCH * SEQ;
constexpr int TS = DBATCH * DSEQ;
constexpr int TT = TP + TS;
constexpr int MP = 8448;
constexpr int NPAGES = PAST / PAGE;
constexpr int NPOOL = 1280;
constexpr int POOLW = 512, DNC = 1536, SBW = 512, SSI = 1024, SSC = 1536, DFF = 8192;
constexpr int INCOLS = 14872, NIN = 15104;
constexpr int OBW = 2560;
constexpr int UFW = 5376;
constexpr int UF_POOL = 0, UF_DNQKV = 512, UF_DNZ = 2048, UF_SSZ = 2560, UF_XBC = 3584, UF_SMALL = 5120;
constexpr float RMS_EPS = 1e-6f;
constexpr float LOG2E = 1.4426950408889634f;
constexpr int NWAVES = 8, NTHR = 512;

constexpr size_t O_Y = 0;
constexpr size_t O_KP = O_Y + (size_t)TT * DM;
constexpr size_t O_VP = O_KP + (size_t)DEPTH * TP * 512;
constexpr size_t O_POOLP = O_VP + (size_t)DEPTH * TP * 512;
constexpr size_t O_DNCP = O_POOLP + (size_t)DEPTH * NBATCH * 15 * 512;
constexpr size_t O_DNSP = O_DNCP + (size_t)DEPTH * NBATCH * 3 * 1536;
constexpr size_t O_SSCP = O_DNSP + (size_t)DEPTH * NBATCH * 4 * 128 * 128;
constexpr size_t O_SSHP = O_SSCP + (size_t)DEPTH * NBATCH * 3 * 1536;
constexpr size_t O_KS = O_SSHP + (size_t)DEPTH * NBATCH * 16 * 64 * 128;
constexpr size_t O_VS = O_KS + (size_t)DEPTH * TS * 512;
constexpr size_t O_POOLS = O_VS + (size_t)DEPTH * TS * 512;
constexpr size_t O_DNCS = O_POOLS + (size_t)DEPTH * DBATCH * 15 * 512;
constexpr size_t O_DNSS = O_DNCS + (size_t)DEPTH * DBATCH * 3 * 1536;
constexpr size_t O_SSCS = O_DNSS + (size_t)DEPTH * DBATCH * 4 * 128 * 128;
constexpr size_t O_SSHS = O_SSCS + (size_t)DEPTH * DBATCH * 3 * 1536;
constexpr size_t O_END = O_SSHS + (size_t)DEPTH * DBATCH * 16 * 64 * 128;

constexpr size_t al256(size_t x) { return (x + 255) & ~(size_t)255; }
constexpr size_t WS_CTL = 0, CTL_BYTES = 1u << 20;
constexpr size_t SZ_WIN = (size_t)NIN * DM * 2, SZ_WBR = (size_t)5 * DM * 512 * 2, SZ_WOUT = (size_t)DM * DM * 2, SZ_WUP = (size_t)DFF * DM * 2, SZ_WDN = (size_t)DM * DFF * 2;
constexpr size_t WS_WIN = WS_CTL + CTL_BYTES;
constexpr size_t WS_WBR = WS_WIN + 2 * SZ_WIN;
constexpr size_t WS_WOUT = WS_WBR + 2 * SZ_WBR;
constexpr size_t WS_WUP = WS_WOUT + 2 * SZ_WOUT;
constexpr size_t WS_WDN = WS_WUP + 2 * SZ_WUP;
constexpr size_t WS_H = WS_WDN + 2 * SZ_WDN;
constexpr size_t WS_UF = WS_H + (size_t)MP * DM * 2;
constexpr size_t WS_QKV = WS_UF + (size_t)MP * UFW * 4;
constexpr size_t WS_GATE = WS_QKV + (size_t)MP * 1536 * 2;
constexpr size_t WS_DNQ = WS_GATE + (size_t)MP * 8192 * 2;
constexpr size_t WS_XBC = WS_DNQ + (size_t)MP * 1536 * 4;
constexpr size_t WS_SCAL = WS_XBC + (size_t)MP * 1536 * 4;
constexpr size_t WS_OBR = WS_SCAL + (size_t)MP * 32 * 4;
constexpr size_t SZ_OBR = (size_t)MP * 512 * 2;
constexpr size_t WS_SSQ = WS_OBR + 5 * SZ_OBR;
constexpr size_t WS_MG32 = WS_SSQ + (size_t)MP * 32 * 4;
constexpr size_t WS_MGB = WS_MG32 + (size_t)MP * DM * 4;
constexpr size_t WS_MIX = WS_MGB + (size_t)MP * DM * 2;
constexpr size_t WS_F = WS_MIX + (size_t)MP * DM * 4;
constexpr size_t WS_FD = WS_F + (size_t)MP * DFF * 2;
constexpr size_t WS_PART = WS_FD + (size_t)MP * DM * 4;
constexpr size_t WS_PR = WS_PART + (size_t)256 * 2048 * 4;
constexpr size_t WS_DNU = WS_PR + (size_t)256 * 16 * 4;
constexpr size_t WS_SSU = WS_DNU + (size_t)512 * 90368;
constexpr size_t WS_SSG = WS_SSU + (size_t)2048 * 16896;
constexpr size_t WS_MGS = WS_SSG + (size_t)256 * 49152;
constexpr size_t WS_OUTS = WS_MGS + (size_t)5 * TS * DM * 4;
constexpr size_t WS_UPS = WS_OUTS + (size_t)16 * TS * DM * 4;
constexpr size_t WS_DNS = WS_UPS + (size_t)4 * TS * DFF * 4;
constexpr size_t WS_RS = WS_DNS + (size_t)16 * TS * DM * 4;
constexpr size_t WS_END = WS_RS + (size_t)MP * 2 * 4;
static_assert(WS_WIN % 256 == 0 && WS_H % 256 == 0 && WS_UF % 256 == 0 && WS_OBR % 256 == 0 && WS_MG32 % 256 == 0 && WS_PART % 256 == 0, "ws alignment");

constexpr int CW_QUEUE = 64;
constexpr int CW_BAR = 4096;

constexpr int LDS_BYTES = 147456;
constexpr int RING_BYTES = 131072;
constexpr int MISC_OFF = RING_BYTES;

#define GAS __attribute__((address_space(1)))
#define LAS __attribute__((address_space(3)))
typedef unsigned short bf16;
typedef unsigned v4u __attribute__((ext_vector_type(4)));
typedef unsigned v2u __attribute__((ext_vector_type(2)));
typedef float f32x4 __attribute__((ext_vector_type(4)));
typedef float f32x2 __attribute__((ext_vector_type(2)));
typedef float f32x16 __attribute__((ext_vector_type(16)));
typedef short bf16x8 __attribute__((ext_vector_type(8)));
__device__ __forceinline__ unsigned f2bf(float f) { unsigned u = __builtin_bit_cast(unsigned, f); return (u + 0x7fffu + ((u >> 16) & 1u)) >> 16; }
__device__ __forceinline__ unsigned pk2(float lo, float hi) { return f2bf(lo) | (f2bf(hi) << 16); }
__device__ __forceinline__ float bflo(unsigned w) { return __builtin_bit_cast(float, w << 16); }
__device__ __forceinline__ float bfhi(unsigned w) { return __builtin_bit_cast(float, w & 0xffff0000u); }
__device__ __forceinline__ float row16_sum(float x) {
    x += __builtin_bit_cast(float, __builtin_amdgcn_update_dpp(0, __builtin_bit_cast(int, x), 0x128, 0xf, 0xf, false));
    x += __builtin_bit_cast(float, __builtin_amdgcn_update_dpp(0, __builtin_bit_cast(int, x), 0x124, 0xf, 0xf, false));
    x += __builtin_bit_cast(float, __builtin_amdgcn_update_dpp(0, __builtin_bit_cast(int, x), 0x122, 0xf, 0xf, false));
    x += __builtin_bit_cast(float, __builtin_amdgcn_update_dpp(0, __builtin_bit_cast(int, x), 0x121, 0xf, 0xf, false));
    return x;
}
__device__ __forceinline__ float rdlane(float x, int l) { return __builtin_bit_cast(float, __builtin_amdgcn_readlane(__builtin_bit_cast(int, x), l)); }
__device__ __forceinline__ float wave_sum(float v) { const float r = row16_sum(v); return (rdlane(r, 0) + rdlane(r, 16)) + (rdlane(r, 32) + rdlane(r, 48)); }
__device__ __forceinline__ float wave_scan(float x, int lane) {
    x += __builtin_bit_cast(float, __builtin_amdgcn_update_dpp(0, __builtin_bit_cast(int, x), 0x111, 0xf, 0xf, true));
    x += __builtin_bit_cast(float, __builtin_amdgcn_update_dpp(0, __builtin_bit_cast(int, x), 0x112, 0xf, 0xf, true));
    x += __builtin_bit_cast(float, __builtin_amdgcn_update_dpp(0, __builtin_bit_cast(int, x), 0x114, 0xf, 0xf, true));
    x += __builtin_bit_cast(float, __builtin_amdgcn_update_dpp(0, __builtin_bit_cast(int, x), 0x118, 0xf, 0xf, true));
    const float t0 = rdlane(x, 15), t1 = rdlane(x, 31), t2 = rdlane(x, 47);
    return x + (lane >= 48 ? (t0 + t1) + t2 : (lane >= 32 ? t0 + t1 : (lane >= 16 ? t0 : 0.f)));
}
__device__ __forceinline__ float fexp(float x) { return __builtin_amdgcn_exp2f(x * 1.4426950408889634f); }
__device__ __forceinline__ float sigmoidf_(float x) { return 1.0f / (1.0f + __expf(-x)); }
__device__ __forceinline__ float siluf_(float x) { return x / (1.0f + __expf(-x)); }
__device__ __forceinline__ float softplusf_(float x) { const float e = fexp(fminf(x, 20.f)); const float l = e < 0.01f ? e * (1.0f - e * (0.5f - e * 0.33333333f)) : __builtin_amdgcn_logf(1.0f + e) * 0.6931471805599453f; return x > 20.f ? x : l; }
__device__ __forceinline__ float ex2(float x) { return __builtin_amdgcn_exp2f(x); }
__device__ __forceinline__ float lg2(float x) { return __builtin_amdgcn_logf(x); }
#define XB_TMO      128
#define XB_XCNT(j)  (256  + 64 * (j))
#define XB_XSUB(j)  (1280 + 64 * (j))
#define XB_XGEN(j)  (2304 + 64 * (j))
#define XB_TOP      3328
#define XB_TOPGEN   3392
#define XCD_BAR_WORDS 3456
#define XB_SPIN_CAP (1u << 18)

__device__ __forceinline__ unsigned xb_ld(unsigned* p)              { return __hip_atomic_load(p, __ATOMIC_RELAXED, __HIP_MEMORY_SCOPE_AGENT); }
__device__ __forceinline__ unsigned xb_add(unsigned* p, unsigned v) { return __hip_atomic_fetch_add(p, v, __ATOMIC_RELAXED, __HIP_MEMORY_SCOPE_AGENT); }
__device__ __forceinline__ unsigned xb_xcc_id() { return (unsigned)__builtin_amdgcn_s_getreg((3 << 11) | 20) & 0xFu; }
#define XB_SPIN(cond, bar) do { unsigned _sp = 0; while (cond) { __builtin_amdgcn_s_sleep(1); \
    if ((++_sp & 255u) == 0u) { if (xb_ld(&(bar)[XB_TMO])) break; if (_sp > XB_SPIN_CAP) { atomicAdd(&(bar)[XB_TMO], 1u); break; } } } } while (0)

struct XcdBarrier {
    unsigned* bar; unsigned x;
    volatile LAS unsigned* st;
};

__device__ __forceinline__ XcdBarrier xcd_barrier_post(unsigned* bar, volatile LAS unsigned* st, const int tid) {
    XcdBarrier b; b.bar = bar; b.x = xb_xcc_id(); b.st = st;
    if (tid == 0) (void)xb_add(&bar[XB_XCNT(b.x)], 1u);
    return b;
}
__device__ __forceinline__ void xcd_barrier_complete(unsigned* bar, unsigned x, unsigned& nloc, unsigned& nx) {
    const unsigned G = gridDim.x * gridDim.y * gridDim.z;
    unsigned sum, cnt, mine, sp = 0u;
    for (;;) {
        sum = 0u; cnt = 0u; mine = 0u;
#pragma unroll
        for (unsigned j = 0; j < 16; ++j) { const unsigned c = xb_ld(&bar[XB_XCNT(j)]); sum += c; cnt += (c > 0u) ? 1u : 0u; mine = (j == x) ? c : mine; }
        if (sum == G) break;
        __builtin_amdgcn_s_sleep(1);
        if ((++sp & 255u) == 0u) { if (xb_ld(&bar[XB_TMO])) break; if (sp > XB_SPIN_CAP) { atomicAdd(&bar[XB_TMO], 1u); break; } }
    }
    nloc = mine > 0u ? mine : 1u; nx = cnt > 0u ? cnt : 1u;
}

__device__ __forceinline__ void xcd_barrier(const XcdBarrier& b, const int tid) {
    asm volatile("s_waitcnt vmcnt(0)" ::: "memory");
    __syncthreads();
    if (tid == 0) {
        unsigned* bar = b.bar;
        __builtin_amdgcn_s_waitcnt(0);
        unsigned nloc = b.st[0], nx = b.st[1];
        if (nloc == 0u) { xcd_barrier_complete(bar, b.x, nloc, nx); b.st[0] = nloc; b.st[1] = nx; }
        const unsigned old = xb_add(&bar[XB_XSUB(b.x)], 1u);
        const unsigned gen = old / nloc;
        if (old + 1u == (gen + 1u) * nloc) {
            __builtin_amdgcn_fence(__ATOMIC_RELEASE, "agent");
            asm volatile("s_waitcnt vmcnt(0)" ::: "memory");
            const unsigned og = xb_add(&bar[XB_TOP], 1u);
            const unsigned tg = og / nx;
            if (og + 1u == (tg + 1u) * nx) xb_add(&bar[XB_TOPGEN], 1u);
            else XB_SPIN(xb_ld(&bar[XB_TOPGEN]) == tg, bar);
            __builtin_amdgcn_fence(__ATOMIC_ACQUIRE, "agent");
            xb_add(&bar[XB_XGEN(b.x)], 1u);
            asm volatile("s_waitcnt vmcnt(0)" ::: "memory");
        } else {
            XB_SPIN(xb_ld(&bar[XB_XGEN(b.x)]) == gen, bar);
            __builtin_amdgcn_fence(__ATOMIC_ACQUIRE, "agent");
            asm volatile("s_waitcnt vmcnt(0)" ::: "memory");
        }
    }
    __syncthreads();
}

enum { I_XP = 0, I_XS, I_CK, I_CV, I_SPOOL, I_SDNC, I_SDNS, I_SSSC, I_SSSH, I_PT, I_NMPRE, I_NMPOST, I_NLPRE, I_NLPOST, I_WIN, I_POOLW, I_POOLSC, I_DNCW, I_DNALOG, I_DNDTB, I_DNNW, I_SBBIAS,
       I_SSCW, I_SSCB, I_SSALOG, I_SSDTB, I_SSD, I_SSNW, I_WBR, I_WOUT, I_WUP, I_WDN, N_IN };
struct Args { const void* in[N_IN]; float* out; unsigned char* ws; int ph_lo, ph_hi, li, pad; };
#define IN_F(i) ((const float*)A->in[i])
#define WSP(T, off) ((T*)(A->ws + (off)))
typedef const __attribute__((opencl_constant)) Args* CA;
__device__ __forceinline__ CA args_opaque() { auto p = __builtin_amdgcn_kernarg_segment_ptr(); asm volatile("" : "+s"(p)); return (CA)p; }

struct EpiIn {
    static constexpr bool PERM = true, AFTER_DRAIN = false, KEEP_ACC = false;
    float* UF; bf16* QKV; bf16* GATE; float *kp, *vp, *ks, *vs; float qscale;
    __device__ __forceinline__ void operator()(f32x4 (&acc)[2][2][4][2], const pg8::Unit& u, int wr, int wc, int fr, int fq) const {
        const int pn = u.pn, row0 = u.pm * 256 + wr * 64 + fr, cl = wc * 32 + 8 * fq;
        if (pn < 10 || (pn >= 16 && pn < 26) || pn == 58) {
            const int col0 = pn * 256 + (pn < 10 ? 0 : (pn < 26 ? -1536 : -9728)) + cl;
#pragma unroll
            for (int ai = 0; ai < 2; ++ai)
#pragma unroll
                for (int m = 0; m < 4; ++m) { float* rowp = UF + (size_t)(row0 + ai * 128 + m * 16) * UFW + col0;
#pragma unroll
                    for (int bj = 0; bj < 2; ++bj) { *(f32x4*)(rowp + bj * 128) = acc[ai][bj][m][0]; *(f32x4*)(rowp + bj * 128 + 4) = acc[ai][bj][m][1]; } }
        } else if (pn < 16) {
            const int which = (pn - 10) >> 1, c512 = ((pn - 10) & 1) * 256 + cl; const float sc = which == 0 ? qscale : 1.f;
#pragma unroll
            for (int ai = 0; ai < 2; ++ai)
#pragma unroll
                for (int m = 0; m < 4; ++m) { const int r = row0 + ai * 128 + m * 16; bf16* rowp = QKV + (size_t)r * 1536 + which * 512 + c512;
                    float* fo = nullptr;
                    if (which) { if (r < TP) fo = (which == 1 ? kp : vp) + (size_t)r * 512 + c512; else if (r < TT) fo = (which == 1 ? ks : vs) + (size_t)(r - TP) * 512 + c512; }
#pragma unroll
                    for (int bj = 0; bj < 2; ++bj) { const f32x4 v0 = acc[ai][bj][m][0], v1 = acc[ai][bj][m][1];
                        v4u w; w.x = pk2(v0[0] * sc, v0[1] * sc); w.y = pk2(v0[2] * sc, v0[3] * sc); w.z = pk2(v1[0] * sc, v1[1] * sc); w.w = pk2(v1[2] * sc, v1[3] * sc);
                        *(v4u*)(rowp + bj * 128) = w;
                        if (fo) { *(f32x4*)(fo + bj * 128) = v0; *(f32x4*)(fo + bj * 128 + 4) = v1; } } }
        } else {
            const int oc = (pn - 26) * 64 + wc * 16 + 4 * fq;
#pragma unroll
            for (int ai = 0; ai < 2; ++ai)
#pragma unroll
                for (int m = 0; m < 4; ++m) { const int r = row0 + ai * 128 + m * 16; bf16* rowp = GATE + (size_t)r * 8192 + oc;
                    f32x4 t[4];
#pragma unroll
                    for (int i = 0; i < 4; ++i)
#pragma unroll
                        for (int e = 0; e < 4; ++e) t[i][e] = 1.0f + fexp(-fminf(fmaxf(acc[ai][i >> 1][m][i & 1][e], -30.f), 30.f));
                    f32x4 o[4];
                    if (r < TP) {
#pragma unroll
                        for (int e = 0; e < 4; ++e) { const float i0 = __builtin_amdgcn_rcpf(t[0][e]), i1 = __builtin_amdgcn_rcpf(t[1][e]), i2 = __builtin_amdgcn_rcpf(t[2][e]), i3 = __builtin_amdgcn_rcpf(t[3][e]);
                            o[0][e] = t[1][e] * i0; o[1][e] = t[2][e] * i1; o[2][e] = t[3][e] * i2; o[3][e] = i3; }
                    } else {
#pragma unroll
                        for (int i = 0; i < 4; ++i)
#pragma unroll
                            for (int e = 0; e < 4; ++e) o[i][e] = __builtin_amdgcn_rcpf(t[i][e]);
                    }
#pragma unroll
                    for (int i = 0; i < 4; ++i) { v2u w; w.x = pk2(o[i][0], o[i][1]); w.y = pk2(o[i][2], o[i][3]); *(v2u*)(rowp + i * 2048) = w; } }
        }
    }
};
struct EpiMergeR {
    static constexpr bool PERM = true, AFTER_DRAIN = false, KEEP_ACC = true;
    const bf16* GATE; const float* RS; bf16* MGB;
    __device__ __forceinline__ void operator()(f32x4 (&acc)[2][2][4][2], const pg8::Unit& u, int wr, int wc, int fr, int fq) const {
        const unsigned row0 = (unsigned)(u.pm * 256 + wr * 64 + fr), col0 = (unsigned)(u.pn * 256 + wc * 32 + 8 * fq); const int seg = u.seg;
        const unsigned gofs = row0 * 8192u + (seg < 3 ? seg : 3) * 2048u + col0, oofs = row0 * 2048u + col0; const bool last = seg == 4;
        const float w2 = seg == 2 ? 1.f : 0.f, w3 = seg == 3 ? 1.f : 0.f, w4 = last ? 1.f : 0.f, w0 = 1.f - w2 - w3 - w4, ug = 1.f - w3;
#pragma unroll
        for (int ai = 0; ai < 2; ++ai)
#pragma unroll
            for (int m = 0; m < 4; ++m) { const unsigned rr = ai * 128 + m * 16; const f32x2 qq = *(const f32x2*)(RS + (row0 + rr) * 2u);
                const float r1 = __builtin_amdgcn_rsqf(qq[1]), rf = w0 + w2 * __builtin_amdgcn_sqrtf(qq[0]) + w3 * (__builtin_amdgcn_sqrtf(qq[1]) * __builtin_amdgcn_rsqf(qq[0])) + w4 * r1, rg = rf * ug, rc = rf * w3;
#pragma unroll
                for (int bj = 0; bj < 2; ++bj) { const v4u gg = *(const v4u*)(GATE + (gofs + rr * 8192u + bj * 128u));
                    f32x4& v0 = acc[ai][bj][m][0]; f32x4& v1 = acc[ai][bj][m][1];
                    v0[0] *= bflo(gg.x) * rg + rc; v0[1] *= bfhi(gg.x) * rg + rc; v0[2] *= bflo(gg.y) * rg + rc; v0[3] *= bfhi(gg.y) * rg + rc;
                    v1[0] *= bflo(gg.z) * rg + rc; v1[1] *= bfhi(gg.z) * rg + rc; v1[2] *= bflo(gg.w) * rg + rc; v1[3] *= bfhi(gg.w) * rg + rc;
                    if (last) { v4u w; w.x = pk2(v0[0], v0[1]); w.y = pk2(v0[2], v0[3]); w.z = pk2(v1[0], v1[1]); w.w = pk2(v1[2], v1[3]); *(v4u*)(MGB + (oofs + rr * 2048u + bj * 128u)) = w; } }
                asm volatile("" ::: "memory"); }
    }
};
struct EpiF32 {
    static constexpr bool PERM = true, AFTER_DRAIN = false, KEEP_ACC = false;
    float* C; int ldc;
    __device__ __forceinline__ void operator()(f32x4 (&acc)[2][2][4][2], const pg8::Unit& u, int wr, int wc, int fr, int fq) const {
        const int row0 = u.pm * 256 + wr * 64 + fr, col0 = u.pn * 256 + wc * 32 + 8 * fq;
#pragma unroll
        for (int ai = 0; ai < 2; ++ai)
#pragma unroll
            for (int m = 0; m < 4; ++m) { float* rowp = C + (size_t)(row0 + ai * 128 + m * 16) * ldc + col0;
#pragma unroll
                for (int bj = 0; bj < 2; ++bj) { *(f32x4*)(rowp + bj * 128) = acc[ai][bj][m][0]; *(f32x4*)(rowp + bj * 128 + 4) = acc[ai][bj][m][1]; } }
    }
};
struct EpiRelu2 {
    static constexpr bool PERM = true, AFTER_DRAIN = false, KEEP_ACC = false;
    bf16* O; int ldc;
    __device__ __forceinline__ void operator()(f32x4 (&acc)[2][2][4][2], const pg8::Unit& u, int wr, int wc, int fr, int fq) const {
        const int row0 = u.pm * 256 + wr * 64 + fr, col0 = u.pn * 256 + wc * 32 + 8 * fq;
#pragma unroll
        for (int ai = 0; ai < 2; ++ai)
#pragma unroll
            for (int m = 0; m < 4; ++m) { bf16* rowp = O + (size_t)(row0 + ai * 128 + m * 16) * ldc + col0;
#pragma unroll
                for (int bj = 0; bj < 2; ++bj) { f32x4 v0 = acc[ai][bj][m][0], v1 = acc[ai][bj][m][1];
#pragma unroll
                    for (int e = 0; e < 4; ++e) { const float a = fmaxf(v0[e], 0.f), b = fmaxf(v1[e], 0.f); v0[e] = a * a; v1[e] = b * b; }
                    v4u w; w.x = pk2(v0[0], v0[1]); w.y = pk2(v0[2], v0[3]); w.z = pk2(v1[0], v1[1]); w.w = pk2(v1[2], v1[3]); *(v4u*)(rowp + bj * 128) = w; } }
    }
};

__device__ __forceinline__ int win_src_col(int n) {
    if (n < 2560) return n;
    if (n < 6656) return n + 8;
    if (n < 14848) { const int t = n - 6656, pg = t >> 8, c = t & 255;
        return 6680 + (2 * (c >> 7) + ((c >> 2) & 1)) * 2048 + 64 * pg + 16 * ((c >> 5) & 3) + 4 * ((c >> 3) & 3) + (c & 3); }
    if (n < 14856) return n - 14848 + 2560;
    if (n < 14872) return n - 14856 + 6664;
    return -1;
}
template <int MODE>
__device__ __forceinline__ void transpose_item(const float* W, int ldw, int K, bf16* WT, int n0, int k0, const float* kscale, LAS float* scr, int lane) {
    const int n = n0 + (lane & 31); const int sc = MODE ? win_src_col(n) : n;
#pragma unroll 8
    for (int i = 0; i < 32; ++i) { const int kk = 2 * i + (lane >> 5); float v = sc >= 0 ? W[(size_t)(k0 + kk) * ldw + sc] : 0.f; if (kscale) v *= kscale[k0 + kk]; scr[kk * 33 + (lane & 31)] = v; }
    asm volatile("s_waitcnt lgkmcnt(0)" ::: "memory");
    const int c = lane & 7;
#pragma unroll
    for (int j = 0; j < 4; ++j) { const int nn = (lane >> 3) + 8 * j; const LAS float* s = scr + (8 * c) * 33 + nn;
        v4u o; o.x = pk2(s[0 * 33], s[1 * 33]); o.y = pk2(s[2 * 33], s[3 * 33]); o.z = pk2(s[4 * 33], s[5 * 33]); o.w = pk2(s[6 * 33], s[7 * 33]);
        *(v4u*)(WT + (size_t)(n0 + nn) * K + k0 + 8 * c) = o; }
    asm volatile("s_waitcnt lgkmcnt(0)" ::: "memory");
}
__device__ __forceinline__ void p0_prologue(CA A, LAS unsigned char* lds, const int wv) {
    const int tid = tid_opaque(wv), lane = tid & 63, wave = tid >> 6, G = gridDim.x;
    LAS float* scr = (LAS float*)(lds + wave * 8704);
    const int gw = blk_opaque() * NWAVES + wave, NGW = G * NWAVES;
    constexpr int I_IN = (NIN / 32) * (DM / 64), I_BR = (DM / 32) * (512 / 64), I_OUT = (DM / 32) * (DM / 64), I_UP = (DFF / 32) * (DM / 64), I_DN = (DM / 32) * (DFF / 64);
    constexpr int PER_LAYER = I_IN + 4 * I_BR + I_OUT + I_UP + I_DN;
    for (int it = gw; it < 2 * PER_LAYER; it += NGW) {
        const int L = it / PER_LAYER; int r = it % PER_LAYER;
        if (r < I_IN) { const int nb = r % (NIN / 32), kb = r / (NIN / 32);
            transpose_item<1>(IN_F(I_WIN) + (size_t)L * DM * INCOLS, INCOLS, DM, WSP(bf16, WS_WIN) + (size_t)L * NIN * DM, nb * 32, kb * 64, nullptr, scr, lane); continue; }
        r -= I_IN;
        if (r < 4 * I_BR) { const int s = 1 + r / I_BR, q = r % I_BR, nb = q % (DM / 32), kb = q / (DM / 32);
            transpose_item<0>(IN_F(I_WBR) + ((size_t)L * 2560 + 512 * s) * DM, DM, OBW, WSP(bf16, WS_WBR) + (size_t)L * DM * OBW + 512 * s, nb * 32, kb * 64,
                              s >= 3 ? IN_F(I_SSNW) + L * 1024 + (s - 3) * 512 : nullptr, scr, lane); continue; }
        r -= 4 * I_BR;
        if (r < I_OUT) { const int nb = r % (DM / 32), kb = r / (DM / 32);
            transpose_item<0>(IN_F(I_WOUT) + (size_t)L * DM * DM, DM, DM, WSP(bf16, WS_WOUT) + (size_t)L * DM * DM, nb * 32, kb * 64, nullptr, scr, lane); continue; }
        r -= I_OUT;
        if (r < I_UP) { const int nb = r % (DFF / 32), kb = r / (DFF / 32);
            transpose_item<0>(IN_F(I_WUP) + (size_t)L * DM * DFF, DFF, DM, WSP(bf16, WS_WUP) + (size_t)L * DFF * DM, nb * 32, kb * 64, nullptr, scr, lane); continue; }
        r -= I_UP;
        { const int nb = r % (DM / 32), kb = r / (DM / 32);
            transpose_item<0>(IN_F(I_WDN) + (size_t)L * DFF * DM, DM, DFF, WSP(bf16, WS_WDN) + (size_t)L * DM * DFF, nb * 32, kb * 64, nullptr, scr, lane); }
    }
    for (int idx = blk_opaque() * NTHR + tid; idx < 2 * DM * 64; idx += G * NTHR) {
        const int L = idx / (DM * 64), q = idx % (DM * 64), n = q & (DM - 1), kc = q >> 11, k0 = kc * 8, g = k0 >> 7, c0 = k0 & 127;
        const float* pw = IN_F(I_POOLW) + ((size_t)(L * 4 + g) * 128 + c0) * 128; const float* psc = IN_F(I_POOLSC) + L * 512 + g * 128;
        const float* wb = IN_F(I_WBR) + ((size_t)L * 2560 + g * 128) * DM + n;
        float acc[8] = {0.f, 0.f, 0.f, 0.f, 0.f, 0.f, 0.f, 0.f};
        for (int d = 0; d < 128; ++d) { const float wv = wb[(size_t)d * DM] * psc[d];
#pragma unroll
            for (int i = 0; i < 8; ++i) acc[i] += pw[i * 128 + d] * wv; }
        v4u o; o.x = pk2(acc[0], acc[1]); o.y = pk2(acc[2], acc[3]); o.z = pk2(acc[4], acc[5]); o.w = pk2(acc[6], acc[7]);
        *(v4u*)(WSP(bf16, WS_WBR) + (size_t)L * DM * OBW + (size_t)n * OBW + k0) = o;
    }
}

__device__ __forceinline__ const float* xin_row(CA A, int m) { return m < TP ? IN_F(I_XP) + (size_t)m * DM : IN_F(I_XS) + (size_t)(m - TP) * DM; }
__device__ __forceinline__ void store_bf16_row(bf16* orow, const f32x4 (&v)[8], float rstd, const float* g, int lane) {
#pragma unroll
    for (int j = 0; j < 8; ++j) { const f32x4 gj = ((const f32x4*)g)[lane + 64 * j]; const f32x4 o = v[j] * rstd * gj;
        v2u w; w.x = pk2(o[0], o[1]); w.y = pk2(o[2], o[3]); ((v2u*)orow)[lane + 64 * j] = w; }
}
__device__ __forceinline__ void norm1_phase(CA A, const int wv) {
    const int tid = tid_opaque(wv), lane = tid & 63, gw = blk_opaque() * NWAVES + (tid >> 6), NGW = gridDim.x * NWAVES;
    bf16* H = WSP(bf16, WS_H);
    for (int m = gw; m < MP; m += NGW) {
        if (m >= TT) { for (int j = 0; j < 8; ++j) ((v2u*)(H + (size_t)m * DM))[lane + 64 * j] = (v2u){0u, 0u}; continue; }
        const f32x4* xr = (const f32x4*)xin_row(A, m); f32x4 v[8]; float s = 0.f;
#pragma unroll
        for (int j = 0; j < 8; ++j) { v[j] = xr[lane + 64 * j]; s += (v[j][0] * v[j][0] + v[j][1] * v[j][1]) + (v[j][2] * v[j][2] + v[j][3] * v[j][3]); }
        const float rstd = 1.0f / sqrtf(wave_sum(s) * (1.0f / DM) + RMS_EPS);
        store_bf16_row(H + (size_t)m * DM, v, rstd, IN_F(I_NMPRE), lane);
    }
}
__device__ __forceinline__ void resid_phase(CA A, const float* Y, const float* PS, const float* gpost, const float* gnext, bool from_input, const int wv) {
    const int tid = tid_opaque(wv), lane = tid & 63, gw = blk_opaque() * NWAVES + (tid >> 6), NGW = gridDim.x * NWAVES;
    bf16* H = WSP(bf16, WS_H);
    for (int m = gw; m < TT; m += NGW) {
        const f32x4* yr = (const f32x4*)(Y + (size_t)m * DM); const f32x4* xr = from_input ? (const f32x4*)xin_row(A, m) : (const f32x4*)(A->out + O_Y + (size_t)m * DM);
        f32x4 v[8]; float s = 0.f;
        if (m < TP) {
#pragma unroll
            for (int j = 0; j < 8; ++j) v[j] = yr[lane + 64 * j];
        } else {
#pragma unroll
            for (int j = 0; j < 8; ++j) v[j] = (f32x4){0.f, 0.f, 0.f, 0.f};
            for (int sp = 0; sp < 16; ++sp) { const f32x4* pr = (const f32x4*)(PS + ((size_t)sp * TS + (m - TP)) * DM);
#pragma unroll
                for (int j = 0; j < 8; ++j) v[j] += pr[lane + 64 * j]; }
        }
#pragma unroll
        for (int j = 0; j < 8; ++j) s += (v[j][0] * v[j][0] + v[j][1] * v[j][1]) + (v[j][2] * v[j][2] + v[j][3] * v[j][3]);
        const float rstd = 1.0f / sqrtf(wave_sum(s) * (1.0f / DM) + RMS_EPS); float s2 = 0.f;
        f32x4* orow = (f32x4*)(A->out + O_Y + (size_t)m * DM);
#pragma unroll
        for (int j = 0; j < 8; ++j) { const f32x4 gj = ((const f32x4*)gpost)[lane + 64 * j]; v[j] = xr[lane + 64 * j] + v[j] * rstd * gj; orow[lane + 64 * j] = v[j];
            s2 += (v[j][0] * v[j][0] + v[j][1] * v[j][1]) + (v[j][2] * v[j][2] + v[j][3] * v[j][3]); }
        if (gnext) { const float rstd2 = 1.0f / sqrtf(wave_sum(s2) * (1.0f / DM) + RMS_EPS); store_bf16_row(H + (size_t)m * DM, v, rstd2, gnext, lane); }
    }
}

__device__ __forceinline__ float conv_tap(const float* UF, const float* state, int row, int j, int ucol, int c) {
    if (row < TP) { const int t = row & (SEQ - 1); return (t - 3 + j) >= 0 ? UF[(size_t)(row - 3 + j) * UFW + ucol + c] : 0.f; }
    const int s = row - TP, sb = s >> 2, e = (s & 3) + j;
    return e < 3 ? state[(size_t)(sb * 3 + e) * 1536 + c] : UF[(size_t)(TP + sb * 4 + e - 3) * UFW + ucol + c];
}
__device__ __forceinline__ void prep_phase(CA A, int layer, const int wv) {
    const int tid = tid_opaque(wv), lane = tid & 63, G = gridDim.x, gt = blk_opaque() * NTHR + tid, NGT = G * NTHR, gw = blk_opaque() * NWAVES + (tid >> 6), NGW = G * NWAVES;
    const float* UF = WSP(float, WS_UF); float* SC = WSP(float, WS_SCAL);
    for (int idx = gt; idx < TT * 24; idx += NGT) { const int row = idx / 24, j = idx % 24; const float u = UF[(size_t)row * UFW + UF_SMALL + j]; float r;
        if (j < 4) r = sigmoidf_(u);
        else if (j < 8) r = -fexp(IN_F(I_DNALOG)[layer * 4 + j - 4]) * softplusf_(u + IN_F(I_DNDTB)[layer * 4 + j - 4]);
        else r = softplusf_(u + IN_F(I_SSDTB)[layer * 16 + j - 8]);
        SC[(size_t)row * 32 + j] = r; }
    { bf16* O0 = WSP(bf16, WS_OBR); const float* spool = IN_F(I_SPOOL) + (size_t)layer * DBATCH * 15 * 512;
      for (int it = gw; it < (TP / 64 + DBATCH) * 4; it += NGW) { const int gi = it & 3, sc = it >> 2, w = 2 << gi, ch = gi * 128 + lane;
          if (sc < TP / 64) { const int row0 = sc * 64, t0 = row0 & (SEQ - 1); float s0 = 0.f, s1 = 0.f;
              for (int j = 1; j < w; ++j) if (t0 - j >= 0) { s0 += UF[(size_t)(row0 - j) * UFW + ch]; s1 += UF[(size_t)(row0 - j) * UFW + ch + 64]; }
#pragma unroll 8
              for (int i = 0; i < 64; ++i) { const int row = row0 + i, t = t0 + i; const float u0 = UF[(size_t)row * UFW + ch], u1 = UF[(size_t)row * UFW + ch + 64];
                  s0 += u0; s1 += u1; const float inv = 1.0f / (float)((t + 1) < w ? (t + 1) : w);
                  O0[(size_t)row * OBW + ch] = (bf16)f2bf(s0 * inv - u0); O0[(size_t)row * OBW + ch + 64] = (bf16)f2bf(s1 * inv - u1);
                  if (t - w + 1 >= 0) { s0 -= UF[(size_t)(row - w + 1) * UFW + ch]; s1 -= UF[(size_t)(row - w + 1) * UFW + ch + 64]; } } }
          else { const int sb = sc - TP / 64; const float inv = 1.0f / (float)w;
              for (int i = 0; i < DSEQ; ++i) { const int row = TP + sb * 4 + i, e = 15 + i; float s0 = 0.f, s1 = 0.f;
                  for (int j = 0; j < w; ++j) { const int ee = e - j; const float* src = ee < 15 ? spool + (size_t)(sb * 15 + ee) * 512 + ch : UF + (size_t)(TP + sb * 4 + ee - 15) * UFW + ch; s0 += src[0]; s1 += src[64]; }
                  O0[(size_t)row * OBW + ch] = (bf16)f2bf(s0 * inv - UF[(size_t)row * UFW + ch]); O0[(size_t)row * OBW + ch + 64] = (bf16)f2bf(s1 * inv - UF[(size_t)row * UFW + ch + 64]); } } } }
    for (int it = gw; it < (TP / 64 + DBATCH) * 24; it += NGW) { const int grp = it % 12, strm = (it / 12) & 1, sc = it / 24, c0 = grp * 128 + lane;
        const int ucol = strm ? UF_XBC : UF_DNQKV; float* OUTB = strm ? WSP(float, WS_XBC) : WSP(float, WS_DNQ);
        const float* cw = (strm ? IN_F(I_SSCW) : IN_F(I_DNCW)) + (size_t)layer * 4 * 1536; const float* st = (strm ? IN_F(I_SSSC) : IN_F(I_SDNC)) + (size_t)layer * DBATCH * 3 * 1536;
        const float wa0 = cw[c0], wa1 = cw[1536 + c0], wa2 = cw[3072 + c0], wa3 = cw[4608 + c0], wb0 = cw[c0 + 64], wb1 = cw[1536 + c0 + 64], wb2 = cw[3072 + c0 + 64], wb3 = cw[4608 + c0 + 64];
        const float ba = strm ? IN_F(I_SSCB)[layer * 1536 + c0] : 0.f, bb = strm ? IN_F(I_SSCB)[layer * 1536 + c0 + 64] : 0.f;
        const bool nrm = (strm == 0) && grp < 8; const float qs = grp < 4 ? 0.08838834764831845f : 1.0f;
        float ha0, ha1, ha2, hb0, hb1, hb2; int row0, n;
        if (sc < TP / 64) { row0 = sc * 64; n = 64; const int t0 = row0 & (SEQ - 1);
            if (t0 == 0) { ha0 = ha1 = ha2 = hb0 = hb1 = hb2 = 0.f; }
            else { const float* p = UF + (size_t)(row0 - 3) * UFW + ucol + c0; ha0 = p[0]; hb0 = p[64]; ha1 = p[UFW]; hb1 = p[UFW + 64]; ha2 = p[2 * UFW]; hb2 = p[2 * UFW + 64]; } }
        else { const int sb = sc - TP / 64; row0 = TP + sb * 4; n = DSEQ; const float* p = st + (size_t)(sb * 3) * 1536 + c0; ha0 = p[0]; hb0 = p[64]; ha1 = p[1536]; hb1 = p[1536 + 64]; ha2 = p[3072]; hb2 = p[3072 + 64]; }
#pragma unroll 8
        for (int i = 0; i < n; ++i) { const float* p = UF + (size_t)(row0 + i) * UFW + ucol + c0; const float ua = p[0], ub = p[64];
            float a = siluf_(ba + wa0 * ha0 + wa1 * ha1 + wa2 * ha2 + wa3 * ua), b = siluf_(bb + wb0 * hb0 + wb1 * hb1 + wb2 * hb2 + wb3 * ub);
            ha0 = ha1; ha1 = ha2; ha2 = ua; hb0 = hb1; hb1 = hb2; hb2 = ub;
            if (nrm) { const float rs = row16_sum(a * a + b * b);
                const float tot = (__builtin_bit_cast(float, __builtin_amdgcn_readlane(__builtin_bit_cast(int, rs), 0)) + __builtin_bit_cast(float, __builtin_amdgcn_readlane(__builtin_bit_cast(int, rs), 16)))
                                + (__builtin_bit_cast(float, __builtin_amdgcn_readlane(__builtin_bit_cast(int, rs), 32)) + __builtin_bit_cast(float, __builtin_amdgcn_readlane(__builtin_bit_cast(int, rs), 48)));
                const float sc2 = qs / sqrtf(tot + 1e-6f); a *= sc2; b *= sc2; }
            float* o = OUTB + (size_t)(row0 + i) * 1536 + c0; o[0] = a; o[64] = b; } }
    for (int idx = gt; idx < NBATCH * 3 * 1536; idx += NGT) { const int b = idx / (3 * 1536), q = idx % (3 * 1536), j = q / 1536, c = q % 1536; const size_t src = (size_t)(b * SEQ + SEQ - 3 + j) * UFW;
        A->out[O_DNCP + (size_t)layer * NBATCH * 3 * 1536 + idx] = UF[src + UF_DNQKV + c]; A->out[O_SSCP + (size_t)layer * NBATCH * 3 * 1536 + idx] = UF[src + UF_XBC + c]; }
    for (int idx = gt; idx < DBATCH * 3 * 1536; idx += NGT) { const int sb = idx / (3 * 1536), q = idx % (3 * 1536), j = q / 1536, c = q % 1536; const size_t src = (size_t)(TP + sb * 4 + 1 + j) * UFW;
        A->out[O_DNCS + (size_t)layer * DBATCH * 3 * 1536 + idx] = UF[src + UF_DNQKV + c]; A->out[O_SSCS + (size_t)layer * DBATCH * 3 * 1536 + idx] = UF[src + UF_XBC + c]; }
    for (int idx = gt; idx < NBATCH * 15 * 512; idx += NGT) { const int b = idx / (15 * 512), q = idx % (15 * 512), j = q >> 9, ch = q & 511;
        A->out[O_POOLP + (size_t)layer * NBATCH * 15 * 512 + idx] = UF[(size_t)(b * SEQ + SEQ - 15 + j) * UFW + ch]; }
    { const float* spool = IN_F(I_SPOOL) + (size_t)layer * DBATCH * 15 * 512;
      for (int idx = gt; idx < DBATCH * 15 * 512; idx += NGT) { const int sb = idx / (15 * 512), q = idx % (15 * 512), j = q >> 9, ch = q & 511, e = 4 + j;
          A->out[O_POOLS + (size_t)layer * DBATCH * 15 * 512 + idx] = e < 15 ? spool[(size_t)(sb * 15 + e) * 512 + ch] : UF[(size_t)(TP + sb * 4 + e - 15) * UFW + ch]; } }
}

__device__ __forceinline__ void dn_seq(CA A, LAS unsigned char* lds, int layer, int unit, const int wv) {
    const int tid = tid_opaque(wv), lane = tid & 63, wid = tid >> 6, v = tid & 127, kq = tid >> 7;
    int row0, L, h; const float* s0 = nullptr; float* sout;
    if (unit < 16) { const int b = unit >> 2; h = unit & 3; row0 = b * SEQ; L = SEQ; sout = A->out + O_DNSP + ((size_t)(layer * NBATCH + b) * 4 + h) * 16384; }
    else { const int u = unit - 16, sb = u >> 2; h = u & 3; row0 = TP + sb * 4; L = DSEQ; s0 = IN_F(I_SDNS) + ((size_t)(layer * DBATCH + sb) * 4 + h) * 16384; sout = A->out + O_DNSS + ((size_t)(layer * DBATCH + sb) * 4 + h) * 16384; }
    constexpr int CH = 32;
    LAS float* qs = (LAS float*)lds; LAS float* ks = qs + CH * 128; LAS float* vs = ks + CH * 128; LAS float* ob = vs + CH * 128;
    LAS float* red = ob + CH * 128;
    LAS float* egs = red + 2 * 2 * 4 * 128; LAS float* bts = egs + CH; LAS float* kqd = bts + CH;
    const float* DNQ = WSP(float, WS_DNQ); const float* SC = WSP(float, WS_SCAL); const float* UF = WSP(float, WS_UF); bf16* O1 = WSP(bf16, WS_OBR) + 512;
    const float* nw = IN_F(I_DNNW) + layer * 128;
    float S[32];
#pragma unroll
    for (int i = 0; i < 32; ++i) S[i] = s0 ? s0[(size_t)(32 * kq + i) * 128 + v] : 0.f;
    for (int c0 = 0; c0 < L; c0 += CH) {
        const int n = (L - c0) < CH ? (L - c0) : CH;
        __syncthreads();
        for (int idx = tid; idx < n * 128; idx += NTHR) { const int t = idx >> 7, c = idx & 127; const float* src = DNQ + (size_t)(row0 + c0 + t) * 1536 + h * 128 + c;
            qs[idx] = src[0]; ks[idx] = src[512]; vs[idx] = src[1024]; }
        if (tid < n) { const float* sc = SC + (size_t)(row0 + c0 + tid) * 32; bts[tid] = sc[h]; egs[tid] = fexp(sc[4 + h]); }
        __syncthreads();
        for (int t = wid; t < n; t += NWAVES) { const float s = wave_sum(ks[t * 128 + lane] * qs[t * 128 + lane] + ks[t * 128 + 64 + lane] * qs[t * 128 + 64 + lane]); if (lane == 0) kqd[t] = s; }
        __syncthreads();
        for (int t = 0; t < n; ++t) {
            const float eg = egs[t], bt = bts[t]; float kk[32]; float r = 0.f, pp = 0.f;
#pragma unroll
            for (int i4 = 0; i4 < 8; ++i4) { const f32x4 k4 = *(const LAS f32x4*)(ks + t * 128 + 32 * kq + 4 * i4), q4 = *(const LAS f32x4*)(qs + t * 128 + 32 * kq + 4 * i4);
#pragma unroll
                for (int e = 0; e < 4; ++e) { const int i = 4 * i4 + e; S[i] *= eg; kk[i] = k4[e]; r += S[i] * k4[e]; pp += S[i] * q4[e]; } }
            LAS float* rd = red + (t & 1) * 1024;
            rd[kq * 128 + v] = r; rd[512 + kq * 128 + v] = pp;
            __syncthreads();
            const float rt = (rd[v] + rd[128 + v]) + (rd[256 + v] + rd[384 + v]), pt = (rd[512 + v] + rd[640 + v]) + (rd[768 + v] + rd[896 + v]);
            const float dd = bt * (vs[t * 128 + v] - rt);
#pragma unroll
            for (int i = 0; i < 32; ++i) S[i] += kk[i] * dd;
            if (kq == 0) ob[t * 128 + v] = pt + kqd[t] * dd;
        }
        __syncthreads();
        for (int t = wid; t < n; t += NWAVES) { const int row = row0 + c0 + t; const float o0 = ob[t * 128 + lane], o1 = ob[t * 128 + 64 + lane];
            const float rstd = 1.0f / sqrtf(wave_sum(o0 * o0 + o1 * o1) * (1.0f / 128.0f) + RMS_EPS);
            const float z0 = UF[(size_t)row * UFW + UF_DNZ + h * 128 + lane], z1 = UF[(size_t)row * UFW + UF_DNZ + h * 128 + 64 + lane];
            O1[(size_t)row * OBW + h * 128 + lane] = (bf16)f2bf(o0 * rstd * nw[lane] * siluf_(z0)); O1[(size_t)row * OBW + h * 128 + 64 + lane] = (bf16)f2bf(o1 * rstd * nw[64 + lane] * siluf_(z1)); }
    }
#pragma unroll
    for (int i = 0; i < 32; ++i) sout[(size_t)(32 * kq + i) * 128 + v] = S[i];
    __syncthreads();
}

__device__ __forceinline__ void ssd_seq(CA A, LAS unsigned char* lds, int layer, int unit, const int wv) {
    const int tid = tid_opaque(wv), lane = tid & 63, wid = tid >> 6, p = tid >> 3, nq = tid & 7;
    int row0, L, hd; const float* h0 = nullptr; float* hout;
    if (unit < 64) { const int b = unit >> 4; hd = unit & 15; row0 = b * SEQ; L = SEQ; hout = A->out + O_SSHP + ((size_t)(layer * NBATCH + b) * 16 + hd) * 8192; }
    else { const int u = unit - 64, sb = u >> 4; hd = u & 15; row0 = TP + sb * 4; L = DSEQ; h0 = IN_F(I_SSSH) + ((size_t)(layer * DBATCH + sb) * 16 + hd) * 8192; hout = A->out + O_SSHS + ((size_t)(layer * DBATCH + sb) * 16 + hd) * 8192; }
    const int g = hd >> 3; constexpr int CH = 64;
    LAS float* Bs = (LAS float*)lds; LAS float* Cs = Bs + CH * 128; LAS float* xs = Cs + CH * 128; LAS float* yb = xs + CH * 64; LAS float* dts = yb + CH * 64;
    const float* XBC = WSP(float, WS_XBC); const float* SC = WSP(float, WS_SCAL); const float* UF = WSP(float, WS_UF); float* SSQ = WSP(float, WS_SSQ);
    bf16* Og = WSP(bf16, WS_OBR) + (3 + g) * 512;
    const float a = -fexp(IN_F(I_SSALOG)[layer * 16 + hd]), Dk = IN_F(I_SSD)[layer * 16 + hd];
    float hs[16];
#pragma unroll
    for (int j = 0; j < 16; ++j) hs[j] = h0 ? h0[(size_t)p * 128 + 16 * nq + j] : 0.f;
    for (int c0 = 0; c0 < L; c0 += CH) {
        const int n = (L - c0) < CH ? (L - c0) : CH;
        __syncthreads();
        for (int idx = tid; idx < n * 128; idx += NTHR) { const int t = idx >> 7, c = idx & 127; const float* src = XBC + (size_t)(row0 + c0 + t) * 1536; Bs[idx] = src[1024 + g * 128 + c]; Cs[idx] = src[1280 + g * 128 + c]; }
        for (int idx = tid; idx < n * 64; idx += NTHR) { const int t = idx >> 6, c = idx & 63; xs[idx] = XBC[(size_t)(row0 + c0 + t) * 1536 + hd * 64 + c]; }
        if (tid < n) dts[tid] = SC[(size_t)(row0 + c0 + tid) * 32 + 8 + hd];
        __syncthreads();
        for (int t = 0; t < n; ++t) {
            const float dt = dts[t], dA = fexp(dt * a), xv = xs[t * 64 + p], cx = dt * xv; float y = 0.f;
#pragma unroll
            for (int j4 = 0; j4 < 4; ++j4) { const f32x4 b4 = *(const LAS f32x4*)(Bs + t * 128 + 16 * nq + 4 * j4), c4 = *(const LAS f32x4*)(Cs + t * 128 + 16 * nq + 4 * j4);
#pragma unroll
                for (int e = 0; e < 4; ++e) { const int j = 4 * j4 + e; hs[j] = hs[j] * dA + cx * b4[e]; y += hs[j] * c4[e]; } }
            y += __shfl_xor(y, 1); y += __shfl_xor(y, 2); y += __shfl_xor(y, 4);
            if (nq == 0) yb[t * 64 + p] = y + Dk * xv;
        }
        __syncthreads();
        for (int t = wid; t < n; t += NWAVES) { const int row = row0 + c0 + t; const float z = UF[(size_t)row * UFW + UF_SSZ + hd * 64 + lane]; const float yg = yb[t * 64 + lane] * siluf_(z);
            const float ss = wave_sum(yg * yg); if (lane == 0) { SSQ[(size_t)row * 32 + hd * 2] = ss; SSQ[(size_t)row * 32 + hd * 2 + 1] = 0.f; }
            Og[(size_t)row * OBW + (hd & 7) * 64 + lane] = (bf16)f2bf(yg); }
    }
#pragma unroll
    for (int j = 0; j < 16; ++j) hout[(size_t)p * 128 + 16 * nq + j] = hs[j];
    __syncthreads();
}

constexpr size_t DNU_NW = 0, DNU_QG = 16384, DNU_AT = 32768, DNU_KGT = 40960, DNU_UP = 57344, DNU_EG = 90112, DNU_BYTES = 90368;
__device__ __forceinline__ float dpp_swap1(float x) { return __builtin_bit_cast(float, __builtin_amdgcn_mov_dpp(__builtin_bit_cast(int, x), 0xB1, 0xf, 0xf, true)); }
__device__ __forceinline__ void dn_chunk_unit(CA A, LAS unsigned char* lds, int layer, int unit, const int wv) {
    const int tid = tid_opaque(wv), lane = tid & 63, wid = tid >> 6, q4 = lane >> 4, l15 = lane & 15;
    const int bh = unit >> 5, ck = unit & 31, b = bh >> 2, h = bh & 3, row0 = b * SEQ + ck * 64;
    constexpr int FP = 132;
    LAS float* kf = (LAS float*)lds; LAS float* vf = kf + 64 * FP;
    LAS unsigned char* qb = lds + 2 * 64 * FP * 4; LAS unsigned char* kb = qb + 64 * 272;
    LAS float* Lp = (LAS float*)(kb + 64 * 272);
    LAS float* gcs = Lp + 2 * 64 * 32; LAS float* bts = gcs + 64;
    const float* DNQ = WSP(float, WS_DNQ); const float* SC = WSP(float, WS_SCAL);
    unsigned char* rec = A->ws + WS_DNU + (size_t)unit * DNU_BYTES;
    __syncthreads();
    if (tid < 64) { const float* sc = SC + (size_t)(row0 + tid) * 32; bts[tid] = sc[h]; gcs[tid] = wave_scan(sc[4 + h], lane); }
    __syncthreads();
    const float glast = gcs[63];
    if (tid == 0) *(float*)(rec + DNU_EG) = fexp(glast);
#pragma unroll
    for (int it = 0; it < 4; ++it) { const int idx = tid + 512 * it, t = idx >> 5, d4 = (idx & 31) * 4; const float* src = DNQ + (size_t)(row0 + t) * 1536 + h * 128 + d4;
        const f32x4 qv = *(const f32x4*)src, kv = *(const f32x4*)(src + 512), vv = *(const f32x4*)(src + 1024);
        *(LAS f32x4*)(kf + t * FP + d4) = kv; *(LAS f32x4*)(vf + t * FP + d4) = vv;
        v2u w; w.x = pk2(qv[0], qv[1]); w.y = pk2(qv[2], qv[3]); *(LAS v2u*)(qb + t * 272 + d4 * 2) = w;
        w.x = pk2(kv[0], kv[1]); w.y = pk2(kv[2], kv[3]); *(LAS v2u*)(kb + t * 272 + d4 * 2) = w;
        const float eg = fexp(gcs[t]); w.x = pk2(qv[0] * eg, qv[1] * eg); w.y = pk2(qv[2] * eg, qv[3] * eg); *(v2u*)(rec + DNU_QG + (size_t)(t * 128 + d4) * 2) = w; }
    __syncthreads();
    { const int c = lane, dg = wid; const float f = fexp(glast - gcs[c]); bf16* KGT = (bf16*)(rec + DNU_KGT);
#pragma unroll
      for (int i = 0; i < 16; ++i) { const int d = dg * 16 + i; KGT[d * 64 + c] = (bf16)f2bf(kf[c * FP + d] * f); } }
    { const int ct = wid >> 1; bf16* AT = (bf16*)(rec + DNU_AT);
#pragma unroll
      for (int e2 = 0; e2 < 2; ++e2) { const int et = 2 * (wid & 1) + e2; f32x4 aKK = {0.f, 0.f, 0.f, 0.f}, aQK = {0.f, 0.f, 0.f, 0.f};
#pragma unroll
          for (int ks = 0; ks < 4; ++ks) { const bf16x8 bfr = *(const LAS bf16x8*)(kb + (16 * et + l15) * 272 + (32 * ks + 8 * q4) * 2);
              const bf16x8 ak = *(const LAS bf16x8*)(kb + (16 * ct + l15) * 272 + (32 * ks + 8 * q4) * 2), aq = *(const LAS bf16x8*)(qb + (16 * ct + l15) * 272 + (32 * ks + 8 * q4) * 2);
              aKK = __builtin_amdgcn_mfma_f32_16x16x32_bf16(ak, bfr, aKK, 0, 0, 0); aQK = __builtin_amdgcn_mfma_f32_16x16x32_bf16(aq, bfr, aQK, 0, 0, 0); }
          const int e = 16 * et + l15; const float ge = gcs[e];
#pragma unroll
          for (int r = 0; r < 4; ++r) { const int c = 16 * ct + 4 * q4 + r; const float dec = e <= c ? fexp(gcs[c] - ge) : 0.f;
              Lp[((e & 1) * 64 + c) * 32 + (e >> 1)] = e < c ? bts[c] * aKK[r] * dec : 0.f;
              AT[c * 64 + e] = (bf16)f2bf(aQK[r] * dec); } } }
    __syncthreads();
    { const int j = tid >> 1, par = tid & 1; float x[32];
#pragma unroll
      for (int i = 0; i < 32; ++i) x[i] = 0.f;
      const LAS float* src = j < 128 ? vf + j : kf + (j - 128);
      float* UP = (float*)(rec + DNU_UP); bf16* NW = (bf16*)(rec + DNU_NW);
#pragma unroll
      for (int c = 0; c < 64; ++c) {
          constexpr int dummy = 0; (void)dummy;
          const int ni = (c + 1) >> 1; float a0 = 0.f, a1 = 0.f, a2 = 0.f, a3 = 0.f;
#pragma unroll
          for (int i4 = 0; i4 < (ni + 3) / 4; ++i4) { const f32x4 l4 = *(const LAS f32x4*)(Lp + (par * 64 + c) * 32 + 4 * i4);
              a0 += l4[0] * x[4 * i4]; if (4 * i4 + 1 < ni) a1 += l4[1] * x[4 * i4 + 1]; if (4 * i4 + 2 < ni) a2 += l4[2] * x[4 * i4 + 2]; if (4 * i4 + 3 < ni) a3 += l4[3] * x[4 * i4 + 3]; }
          float acc = (a0 + a1) + (a2 + a3); acc += dpp_swap1(acc);
          float rhs = src[c * FP] * bts[c]; if (j >= 128) rhs *= fexp(gcs[c]);
          const float xc = rhs - acc;
          x[c >> 1] = ((c & 1) == par) ? xc : x[c >> 1];
          if (par == 0) { if (j < 128) UP[(((j >> 4) * 4 + (c >> 4)) * 4 + (c & 3)) * 64 + ((c >> 2) & 3) * 16 + (j & 15)] = xc; else NW[c * 128 + (j - 128)] = (bf16)f2bf(-xc); }
      } }
}

constexpr int D2_NW = 0, D2_QG = 17408, D2_AT = 34816, D2_KGT = 44032, D2_BUF = 62464, D2_RED = 2 * D2_BUF;
__device__ __forceinline__ bf16x8 ld_frag_perm(const LAS unsigned char* p) {
    const v2u lo = *(const LAS v2u*)p, hi = *(const LAS v2u*)(p + 32); v4u w; w.x = lo.x; w.y = lo.y; w.z = hi.x; w.w = hi.y; return __builtin_bit_cast(bf16x8, w);
}
__device__ __forceinline__ bf16x8 pack_b(const f32x4& t0, const f32x4& t1) { v4u w; w.x = pk2(t0[0], t0[1]); w.y = pk2(t0[2], t0[3]); w.z = pk2(t1[0], t1[1]); w.w = pk2(t1[2], t1[3]); return __builtin_bit_cast(bf16x8, w); }
__device__ __forceinline__ void dn_seq2(CA A, LAS unsigned char* lds, int layer, int bh, const int wv) {
    const int tid = tid_opaque(wv), lane = tid & 63, w = tid >> 6, q4 = lane >> 4, l15 = lane & 15;
    const int b = bh >> 2, h = bh & 3;
    const unsigned char* recs = A->ws + WS_DNU + (size_t)(bh * 32) * DNU_BYTES;
    const float* UF = WSP(float, WS_UF); bf16* O1 = WSP(bf16, WS_OBR) + 512; const float* nw = IN_F(I_DNNW) + layer * 128;
    LAS float* red = (LAS float*)(lds + D2_RED);
    f32x4 S[8];
#pragma unroll
    for (int i = 0; i < 8; ++i) S[i] = (f32x4){0.f, 0.f, 0.f, 0.f};
    v4u st[7];
#define D2_LOAD(rec_) do { const v4u* g_ = (const v4u*)(rec_); _Pragma("unroll") for (int i_ = 0; i_ < 7; ++i_) st[i_] = g_[tid + 512 * i_]; } while (0)
#define D2_STORE(buf_) do { LAS unsigned char* b_ = lds + (buf_) * D2_BUF; \
        *(LAS v4u*)(b_ + D2_NW + (tid >> 4) * 272 + (tid & 15) * 16) = st[0]; *(LAS v4u*)(b_ + D2_NW + (32 + (tid >> 4)) * 272 + (tid & 15) * 16) = st[1]; \
        *(LAS v4u*)(b_ + D2_QG + (tid >> 4) * 272 + (tid & 15) * 16) = st[2]; *(LAS v4u*)(b_ + D2_QG + (32 + (tid >> 4)) * 272 + (tid & 15) * 16) = st[3]; \
        *(LAS v4u*)(b_ + D2_AT + (tid >> 3) * 144 + (tid & 7) * 16) = st[4]; \
        *(LAS v4u*)(b_ + D2_KGT + (tid >> 3) * 144 + (tid & 7) * 16) = st[5]; *(LAS v4u*)(b_ + D2_KGT + (64 + (tid >> 3)) * 144 + (tid & 7) * 16) = st[6]; } while (0)
    __syncthreads();
    D2_LOAD(recs); D2_STORE(0);
    f32x4 vnx[4]; float eglx = *(const float*)(recs + DNU_EG);
    { const float* UP0 = (const float*)(recs + DNU_UP) + (size_t)w * 1024 + lane;
#pragma unroll
      for (int mt = 0; mt < 4; ++mt)
#pragma unroll
          for (int r = 0; r < 4; ++r) vnx[mt][r] = UP0[(mt * 4 + r) * 64]; }
    __syncthreads();
    for (int ck = 0; ck < 32; ++ck) {
        const unsigned char* rec = recs + (size_t)ck * DNU_BYTES; const int row0 = b * SEQ + ck * 64;
        const LAS unsigned char* bf = lds + (ck & 1) * D2_BUF;
        if (ck + 1 < 32) D2_LOAD(rec + DNU_BYTES);
        const float egl = eglx;
        f32x4 vn[4];
#pragma unroll
        for (int mt = 0; mt < 4; ++mt) vn[mt] = vnx[mt];
        if (ck + 1 < 32) { eglx = *(const float*)(rec + DNU_BYTES + DNU_EG); const float* UP = (const float*)(rec + DNU_BYTES + DNU_UP) + (size_t)w * 1024 + lane;
#pragma unroll
            for (int mt = 0; mt < 4; ++mt)
#pragma unroll
                for (int r = 0; r < 4; ++r) vnx[mt][r] = UP[(mt * 4 + r) * 64]; }
        f32x4 zz[4];
#pragma unroll
        for (int mt = 0; mt < 4; ++mt)
#pragma unroll
            for (int r = 0; r < 4; ++r) zz[mt][r] = UF[(size_t)(row0 + 16 * mt + 4 * q4 + r) * UFW + UF_DNZ + h * 128 + 16 * w + l15];
        bf16x8 Sb[4];
#pragma unroll
        for (int ks = 0; ks < 4; ++ks) Sb[ks] = pack_b(S[2 * ks], S[2 * ks + 1]);
        const int aoff = l15 * 272 + 8 * q4, aoff2 = l15 * 144 + 8 * q4;
#pragma unroll
        for (int mt = 0; mt < 4; ++mt)
#pragma unroll
            for (int ks = 0; ks < 4; ++ks) vn[mt] = __builtin_amdgcn_mfma_f32_16x16x32_bf16(ld_frag_perm(bf + D2_NW + mt * 16 * 272 + aoff + ks * 64), Sb[ks], vn[mt], 0, 0, 0);
        bf16x8 vb[2];
        vb[0] = pack_b(vn[0], vn[1]); vb[1] = pack_b(vn[2], vn[3]);
        f32x4 o[4];
#pragma unroll
        for (int mt = 0; mt < 4; ++mt) { o[mt] = (f32x4){0.f, 0.f, 0.f, 0.f};
#pragma unroll
            for (int ks = 0; ks < 4; ++ks) o[mt] = __builtin_amdgcn_mfma_f32_16x16x32_bf16(ld_frag_perm(bf + D2_QG + mt * 16 * 272 + aoff + ks * 64), Sb[ks], o[mt], 0, 0, 0);
#pragma unroll
            for (int ke = 0; ke < 2; ++ke) o[mt] = __builtin_amdgcn_mfma_f32_16x16x32_bf16(ld_frag_perm(bf + D2_AT + mt * 16 * 144 + aoff2 + ke * 64), vb[ke], o[mt], 0, 0, 0); }
#pragma unroll
        for (int m8 = 0; m8 < 8; ++m8) { S[m8] = S[m8] * egl;
#pragma unroll
            for (int ke = 0; ke < 2; ++ke) S[m8] = __builtin_amdgcn_mfma_f32_16x16x32_bf16(ld_frag_perm(bf + D2_KGT + m8 * 16 * 144 + aoff2 + ke * 64), vb[ke], S[m8], 0, 0, 0); }
        LAS float* rd = red + (ck & 1) * 512;
#pragma unroll
        for (int mt = 0; mt < 4; ++mt)
#pragma unroll
            for (int r = 0; r < 4; ++r) { const float s = row16_sum(o[mt][r] * o[mt][r]);
                if (l15 == 0) rd[(16 * mt + 4 * q4 + r) * 8 + w] = s; }
        if (ck + 1 < 32) D2_STORE((ck + 1) & 1);
        __syncthreads();
#pragma unroll
        for (int mt = 0; mt < 4; ++mt)
#pragma unroll
            for (int r = 0; r < 4; ++r) { const int c = 16 * mt + 4 * q4 + r; const f32x4 s0 = *(const LAS f32x4*)(rd + c * 8), s1 = *(const LAS f32x4*)(rd + c * 8 + 4);
                const float rstd = 1.0f / sqrtf(((s0[0] + s0[1]) + (s0[2] + s0[3]) + (s1[0] + s1[1]) + (s1[2] + s1[3])) * (1.0f / 128.0f) + RMS_EPS);
                const int dv = 16 * w + l15;
                O1[(size_t)(row0 + c) * OBW + h * 128 + dv] = (bf16)f2bf(o[mt][r] * rstd * nw[dv] * siluf_(zz[mt][r])); }
    }
    float* sout = A->out + O_DNSP + ((size_t)(layer * NBATCH + b) * 4 + h) * 16384;
#pragma unroll
    for (int m8 = 0; m8 < 8; ++m8)
#pragma unroll
        for (int r = 0; r < 4; ++r) sout[(size_t)(16 * m8 + 4 * q4 + r) * 128 + 16 * w + l15] = S[m8][r];
    __syncthreads();
#undef D2_LOAD
#undef D2_STORE
}

constexpr size_t SSU_XT = 0, SSU_XTW = 8192, SSU_CUM = 16384, SSU_DT = 16640, SSU_BYTES = 16896;
constexpr size_t SSG_C = 0, SSG_B = 16384, SSG_BT = 32768, SSG_BYTES = 49152;
__device__ __forceinline__ void ssd_prep_unit(CA A, LAS unsigned char* lds, int layer, int unit, const int wv) {
    const int tid = tid_opaque(wv), lane = tid & 63;
    const int hd = unit & 15, bc = unit >> 4, b = bc >> 5, ck = bc & 31, g = hd >> 3, row0 = b * SEQ + ck * 64;
    const float* XBC = WSP(float, WS_XBC); const float* SC = WSP(float, WS_SCAL);
    unsigned char* rec = A->ws + WS_SSU + (size_t)unit * SSU_BYTES;
    LAS float* xl = (LAS float*)lds;
    LAS float* bl = xl + 64 * 65;
    LAS float* cums = bl + 64 * 129; LAS float* ws_ = cums + 64;
    const float a = -fexp(IN_F(I_SSALOG)[layer * 16 + hd]);
    __syncthreads();
    if (tid < 64) { const float dt = SC[(size_t)(row0 + tid) * 32 + 8 + hd]; const float c = wave_scan(dt * a, lane);
        cums[tid] = c; const float c63 = rdlane(c, 63); ws_[tid] = fexp(c63 - c) * dt;
        ((float*)(rec + SSU_CUM))[tid] = c; ((float*)(rec + SSU_DT))[tid] = dt; }
    { const int s = tid >> 3, p8 = (tid & 7) * 8; const float* src = XBC + (size_t)(row0 + s) * 1536 + hd * 64 + p8; const f32x4 x0 = *(const f32x4*)src, x1 = *(const f32x4*)(src + 4);
#pragma unroll
      for (int e = 0; e < 4; ++e) { xl[s * 65 + p8 + e] = x0[e]; xl[s * 65 + p8 + 4 + e] = x1[e]; } }
    __syncthreads();
    { const int p = tid >> 3, s8 = (tid & 7) * 8; float xv[8], xw[8];
#pragma unroll
      for (int i = 0; i < 8; ++i) { xv[i] = xl[(s8 + i) * 65 + p]; xw[i] = xv[i] * ws_[s8 + i]; }
      v4u o; o.x = pk2(xv[0], xv[1]); o.y = pk2(xv[2], xv[3]); o.z = pk2(xv[4], xv[5]); o.w = pk2(xv[6], xv[7]); *(v4u*)(rec + SSU_XT + (size_t)(p * 64 + s8) * 2) = o;
      o.x = pk2(xw[0], xw[1]); o.y = pk2(xw[2], xw[3]); o.z = pk2(xw[4], xw[5]); o.w = pk2(xw[6], xw[7]); *(v4u*)(rec + SSU_XTW + (size_t)(p * 64 + s8) * 2) = o; }
    if ((hd & 7) == 0) {
        unsigned char* grec = A->ws + WS_SSG + (size_t)(bc * 2 + g) * SSG_BYTES;
        const int s = tid >> 3, n16 = (tid & 7) * 16; const float* src = XBC + (size_t)(row0 + s) * 1536 + 1024 + g * 128 + n16;
        f32x4 bv[4], cv[4];
#pragma unroll
        for (int i = 0; i < 4; ++i) { bv[i] = *(const f32x4*)(src + 4 * i); cv[i] = *(const f32x4*)(src + 256 + 4 * i); }
#pragma unroll
        for (int i = 0; i < 2; ++i) { v4u o; o.x = pk2(bv[2 * i][0], bv[2 * i][1]); o.y = pk2(bv[2 * i][2], bv[2 * i][3]); o.z = pk2(bv[2 * i + 1][0], bv[2 * i + 1][1]); o.w = pk2(bv[2 * i + 1][2], bv[2 * i + 1][3]);
            *(v4u*)(grec + SSG_B + (size_t)(s * 128 + n16 + 8 * i) * 2) = o;
            o.x = pk2(cv[2 * i][0], cv[2 * i][1]); o.y = pk2(cv[2 * i][2], cv[2 * i][3]); o.z = pk2(cv[2 * i + 1][0], cv[2 * i + 1][1]); o.w = pk2(cv[2 * i + 1][2], cv[2 * i + 1][3]);
            *(v4u*)(grec + SSG_C + (size_t)(s * 128 + n16 + 8 * i) * 2) = o; }
#pragma unroll
        for (int i = 0; i < 4; ++i)
#pragma unroll
            for (int e = 0; e < 4; ++e) bl[s * 129 + n16 + 4 * i + e] = bv[i][e];
        __syncthreads();
        const int n = tid >> 2, s16 = (tid & 3) * 16; float t[16];
#pragma unroll
        for (int i = 0; i < 16; ++i) t[i] = bl[(s16 + i) * 129 + n];
#pragma unroll
        for (int i = 0; i < 2; ++i) { v4u o; o.x = pk2(t[8 * i], t[8 * i + 1]); o.y = pk2(t[8 * i + 2], t[8 * i + 3]); o.z = pk2(t[8 * i + 4], t[8 * i + 5]); o.w = pk2(t[8 * i + 6], t[8 * i + 7]);
            *(v4u*)(grec + SSG_BT + (size_t)(n * 64 + s16 + 8 * i) * 2) = o; }
    }
}

constexpr int S2_C = 0, S2_B = 17408, S2_BT = 34816, S2_XT = 53248, S2_XTW = 62464, S2_WM = 71680, S2_HB = 80896, S2_YB = 98304, S2_CUM = 114688, S2_DT = 114944;
__device__ __forceinline__ void ssd_seq2(CA A, LAS unsigned char* lds, int layer, int unit, const int wv) {
    const int tid = tid_opaque(wv), lane = tid & 63, w = tid >> 6, q4 = lane >> 4, l15 = lane & 15;
    const int b = unit >> 4, hd = unit & 15, g = hd >> 3;
    const unsigned char* hrec = A->ws + WS_SSU + (size_t)((b * 32) * 16 + hd) * SSU_BYTES;
    const unsigned char* grec = A->ws + WS_SSG + (size_t)((b * 32) * 2 + g) * SSG_BYTES;
    const float* UF = WSP(float, WS_UF); float* SSQ = WSP(float, WS_SSQ); bf16* Og = WSP(bf16, WS_OBR) + (3 + g) * 512;
    const float Dk = IN_F(I_SSD)[layer * 16 + hd];
    LAS float* yb = (LAS float*)(lds + S2_YB); LAS float* cums = (LAS float*)(lds + S2_CUM); LAS float* dts = (LAS float*)(lds + S2_DT);
    f32x4 hacc[4];
#pragma unroll
    for (int i = 0; i < 4; ++i) hacc[i] = (f32x4){0.f, 0.f, 0.f, 0.f};
    v4u st[8]; float sc1 = 0.f;
#define S2_LOAD(ck_) do { const v4u* gg_ = (const v4u*)(grec + (size_t)(ck_) * 2 * SSG_BYTES); const v4u* hh_ = (const v4u*)(hrec + (size_t)(ck_) * 16 * SSU_BYTES); \
        st[0] = gg_[tid]; st[1] = gg_[tid + 512]; st[2] = gg_[tid + 1024]; st[3] = gg_[tid + 1536]; st[4] = gg_[tid + 2048]; st[5] = gg_[tid + 2560]; st[6] = hh_[tid]; st[7] = hh_[tid + 512]; \
        if (tid < 128) sc1 = ((const float*)(hrec + (size_t)(ck_) * 16 * SSU_BYTES + SSU_CUM))[tid]; } while (0)
#define S2_STORE() do { \
        *(LAS v4u*)(lds + S2_C + (tid >> 4) * 272 + (tid & 15) * 16) = st[0]; *(LAS v4u*)(lds + S2_C + (32 + (tid >> 4)) * 272 + (tid & 15) * 16) = st[1]; \
        *(LAS v4u*)(lds + S2_B + (tid >> 4) * 272 + (tid & 15) * 16) = st[2]; *(LAS v4u*)(lds + S2_B + (32 + (tid >> 4)) * 272 + (tid & 15) * 16) = st[3]; \
        *(LAS v4u*)(lds + S2_BT + (tid >> 3) * 144 + (tid & 7) * 16) = st[4]; *(LAS v4u*)(lds + S2_BT + (64 + (tid >> 3)) * 144 + (tid & 7) * 16) = st[5]; \
        *(LAS v4u*)(lds + S2_XT + (tid >> 3) * 144 + (tid & 7) * 16) = st[6]; *(LAS v4u*)(lds + S2_XTW + (tid >> 3) * 144 + (tid & 7) * 16) = st[7]; \
        if (tid < 128) cums[tid] = sc1; } while (0)
    S2_LOAD(0);
    const int tt = w >> 1, aoffC = l15 * 272 + 16 * q4, aoffS = l15 * 144 + 16 * q4;
    for (int ck = 0; ck < 32; ++ck) {
        const int row0 = b * SEQ + ck * 64;
        __syncthreads();
        S2_STORE();
        __syncthreads();
        if (ck + 1 < 32) S2_LOAD(ck + 1);
        float zv[2][4];
#pragma unroll
        for (int e2 = 0; e2 < 2; ++e2)
#pragma unroll
            for (int r = 0; r < 4; ++r) zv[e2][r] = UF[(size_t)(row0 + 16 * tt + 4 * q4 + r) * UFW + UF_SSZ + hd * 64 + 16 * (2 * (w & 1) + e2) + l15];
#pragma unroll
        for (int e2 = 0; e2 < 2; ++e2) { const int stl = 2 * (w & 1) + e2; f32x4 acc = {0.f, 0.f, 0.f, 0.f};
            if (stl <= tt) {
#pragma unroll
                for (int ks = 0; ks < 4; ++ks) acc = __builtin_amdgcn_mfma_f32_16x16x32_bf16(*(const LAS bf16x8*)(lds + S2_C + tt * 16 * 272 + aoffC + ks * 64), *(const LAS bf16x8*)(lds + S2_B + stl * 16 * 272 + aoffC + ks * 64), acc, 0, 0, 0); }
            const int s = 16 * stl + l15; const float cs = cums[s], ds = dts[s];
#pragma unroll
            for (int r = 0; r < 4; ++r) { const int t = 16 * tt + 4 * q4 + r; const float v = s <= t ? acc[r] * fexp(cums[t] - cs) * ds : 0.f;
                *(LAS unsigned short*)(lds + S2_WM + t * 144 + s * 2) = (unsigned short)f2bf(v); } }
#pragma unroll
        for (int mt = 0; mt < 4; ++mt)
#pragma unroll
            for (int r = 0; r < 4; ++r) *(LAS unsigned short*)(lds + S2_HB + (16 * mt + 4 * q4 + r) * 272 + (16 * w + l15) * 2) = (unsigned short)f2bf(hacc[mt][r]);
        __syncthreads();
        float ssq[4] = {0.f, 0.f, 0.f, 0.f};
#pragma unroll
        for (int e2 = 0; e2 < 2; ++e2) { const int pt = 2 * (w & 1) + e2; f32x4 y = {0.f, 0.f, 0.f, 0.f};
#pragma unroll
            for (int ks = 0; ks < 4; ++ks) y = __builtin_amdgcn_mfma_f32_16x16x32_bf16(*(const LAS bf16x8*)(lds + S2_C + tt * 16 * 272 + aoffC + ks * 64), *(const LAS bf16x8*)(lds + S2_HB + pt * 16 * 272 + aoffC + ks * 64), y, 0, 0, 0);
#pragma unroll
            for (int r = 0; r < 4; ++r) y[r] *= fexp(cums[16 * tt + 4 * q4 + r]);
#pragma unroll
            for (int ke = 0; ke < 2; ++ke) y = __builtin_amdgcn_mfma_f32_16x16x32_bf16(*(const LAS bf16x8*)(lds + S2_WM + tt * 16 * 144 + aoffS + ke * 64), *(const LAS bf16x8*)(lds + S2_XT + pt * 16 * 144 + aoffS + ke * 64), y, 0, 0, 0);
            const int p = 16 * pt + l15;
#pragma unroll
            for (int r = 0; r < 4; ++r) { const int t = 16 * tt + 4 * q4 + r; const float xv = bflo((unsigned)*(const LAS unsigned short*)(lds + S2_XT + p * 144 + t * 2));
                const float yg = (y[r] + Dk * xv) * siluf_(zv[e2][r]); ssq[r] += yg * yg;
                Og[(size_t)(row0 + t) * OBW + (hd & 7) * 64 + p] = (bf16)f2bf(yg); } }
#pragma unroll
        for (int r = 0; r < 4; ++r) { const float s = row16_sum(ssq[r]); if (l15 == 0) SSQ[(size_t)(row0 + 16 * tt + 4 * q4 + r) * 32 + hd * 2 + (w & 1)] = s; }
        { const float e63 = fexp(cums[63]);
#pragma unroll
          for (int mt = 0; mt < 4; ++mt) { hacc[mt] = hacc[mt] * e63;
#pragma unroll
              for (int ke = 0; ke < 2; ++ke) hacc[mt] = __builtin_amdgcn_mfma_f32_16x16x32_bf16(*(const LAS bf16x8*)(lds + S2_XTW + mt * 16 * 144 + aoffS + ke * 64), *(const LAS bf16x8*)(lds + S2_BT + w * 16 * 144 + aoffS + ke * 64), hacc[mt], 0, 0, 0); } }
    }
    float* hout = A->out + O_SSHP + ((size_t)(layer * NBATCH + b) * 16 + hd) * 8192;
#pragma unroll
    for (int mt = 0; mt < 4; ++mt)
#pragma unroll
        for (int r = 0; r < 4; ++r) hout[(size_t)(16 * mt + 4 * q4 + r) * 128 + 16 * w + l15] = hacc[mt][r];
    __syncthreads();
#undef S2_LOAD
#undef S2_STORE
}

struct ALBf16 { const bf16* A; int lda; __device__ __forceinline__ bf16x8 operator()(int row, int k) const { return *(const bf16x8*)(A + (size_t)row * lda + k); } };
template <class AL> __device__ __forceinline__ void sgemm_task(const AL& al, const bf16* Wt, int ldw, int n0, int k0, int nks, f32x4 (&acc)[2], int l15, int q4) {
    const bf16* bp = Wt + (size_t)(n0 + l15) * ldw + k0 + 8 * q4;
    int nks_ = nks; asm volatile("" : "+s"(nks_));
#pragma unroll 4
    for (int ks = 0; ks < nks_; ++ks) { const bf16x8 b = *(const bf16x8*)(bp + 32 * ks); const bf16x8 a0 = al(l15, k0 + 32 * ks + 8 * q4), a1 = al(16 + l15, k0 + 32 * ks + 8 * q4);
        acc[0] = __builtin_amdgcn_mfma_f32_16x16x32_bf16(a0, b, acc[0], 0, 0, 0); acc[1] = __builtin_amdgcn_mfma_f32_16x16x32_bf16(a1, b, acc[1], 0, 0, 0); }
}
#define SAMPLE_IDS() const int tid = tid_opaque(wv), lane = tid & 63, l15 = lane & 15, q4 = lane >> 4, NGW = gridDim.x * NWAVES, gw = (tid >> 6) * gridDim.x + blk_opaque()
__device__ __forceinline__ void sample_merge(CA A, LAS unsigned char* lds, int layer, const int wv) {
    const int tid = tid_opaque(wv), lane = tid & 63, l15 = lane & 15, q4 = lane >> 4, w = tid >> 6, G = gridDim.x;
    const bf16* GT = WSP(bf16, WS_GATE); const float* RS = WSP(float, WS_RS); bf16* MB = WSP(bf16, WS_MGB); LAS float* part = (LAS float*)lds;
    for (int strip = blk_opaque(); strip < 128; strip += G) { const int n0 = strip * 16, col = n0 + l15;
        __syncthreads();
        if (w < 5) { const int s = w, gs = s < 3 ? s : 3;
            f32x4 acc[2] = {{0.f, 0.f, 0.f, 0.f}, {0.f, 0.f, 0.f, 0.f}};
            ALBf16 al{WSP(bf16, WS_OBR) + (size_t)TP * OBW + s * 512, OBW};
            sgemm_task(al, WSP(bf16, WS_WBR) + (size_t)layer * DM * OBW + s * 512, OBW, n0, 0, 16, acc, l15, q4);
#pragma unroll
            for (int mt = 0; mt < 2; ++mt)
#pragma unroll
                for (int r = 0; r < 4; ++r) { const int row = 16 * mt + 4 * q4 + r, grow = TP + row; float rs = 1.f;
                    if (s >= 3) rs = 1.0f / sqrtf(RS[(size_t)grow * 2 + (s - 3)]);
                    part[(s * 32 + row) * 16 + l15] = acc[mt][r] * bflo((unsigned)GT[(size_t)grow * 8192 + gs * 2048 + col]) * rs; } }
        __syncthreads();
        { const int row = tid >> 4, c = tid & 15; const float v = (part[row * 16 + c] + part[(32 + row) * 16 + c]) + (part[(64 + row) * 16 + c] + part[(96 + row) * 16 + c]) + part[(128 + row) * 16 + c];
          MB[(size_t)(TP + row) * DM + n0 + c] = (bf16)f2bf(v); } }
}
__device__ __forceinline__ void sample_up(CA A, LAS unsigned char* lds, int layer, const int wv) {
    const int tid = tid_opaque(wv), lane = tid & 63, l15 = lane & 15, q4 = lane >> 4, w = tid >> 6, G = gridDim.x;
    bf16* F = WSP(bf16, WS_F); LAS float* part = (LAS float*)lds;
    for (int sp = blk_opaque(); sp < 256; sp += G) { const int n0 = (2 * sp + (w >> 2)) * 16, kq = w & 3;
        __syncthreads();
        f32x4 acc[2] = {{0.f, 0.f, 0.f, 0.f}, {0.f, 0.f, 0.f, 0.f}};
        ALBf16 al{WSP(bf16, WS_H) + (size_t)TP * DM, DM};
        sgemm_task(al, WSP(bf16, WS_WUP) + (size_t)layer * DFF * DM, DM, n0, kq * 512, 16, acc, l15, q4);
#pragma unroll
        for (int mt = 0; mt < 2; ++mt)
#pragma unroll
            for (int r = 0; r < 4; ++r) part[(w * 32 + 16 * mt + 4 * q4 + r) * 16 + l15] = acc[mt][r];
        __syncthreads();
#pragma unroll
        for (int h2 = 0; h2 < 2; ++h2) { const int idx = tid + 512 * h2, half = idx >> 9, row = (idx >> 4) & 31, c = idx & 15; const LAS float* p = part + (half * 4 * 32 + row) * 16 + c;
            const float v = fmaxf((p[0] + p[32 * 16]) + (p[2 * 32 * 16] + p[3 * 32 * 16]), 0.f);
            F[(size_t)(TP + row) * DFF + (2 * sp + half) * 16 + c] = (bf16)f2bf(v * v); } }
}
template <class AL> __device__ __forceinline__ void sample_splitk(const AL& al, const bf16* Wt, int ldw, int nstrips, int nsplit, int nks, float* PART, int ldp, const int wv) {
    SAMPLE_IDS();
    for (int it = gw; it < nstrips * nsplit; it += NGW) { const int ns = it % nstrips, sp = it / nstrips, n0 = ns * 16;
        f32x4 acc[2] = {{0.f, 0.f, 0.f, 0.f}, {0.f, 0.f, 0.f, 0.f}};
        sgemm_task(al, Wt, ldw, n0, sp * nks * 32, nks, acc, l15, q4);
#pragma unroll
        for (int mt = 0; mt < 2; ++mt)
#pragma unroll
            for (int r = 0; r < 4; ++r) PART[((size_t)sp * TS + 16 * mt + 4 * q4 + r) * ldp + n0 + l15] = acc[mt][r]; }
}

constexpr int KS_PITCH = 272, VT_PITCH = 136;
constexpr int ATT_KS = 0, ATT_VT = 64 * KS_PITCH;
__device__ __forceinline__ void attn_prompt_unit(CA A, LAS unsigned char* lds, int layer, int unit, const int wv) {
    const int tid = tid_opaque(wv), lane = tid & 63, wid = tid >> 6, r = lane & 31, hh = lane >> 5;
    const int qb = 7 - (unit >> 4), bh = unit & 15, b = bh >> 2, h = bh & 3;
    const int q0 = qb * 256 + wid * 32, qpos = q0 + r;
    const bf16* QKV = WSP(bf16, WS_QKV) + (size_t)(b * SEQ) * 1536;
    bf16x8 Qf[8];
    { const bf16* qrow = QKV + (size_t)qpos * 1536 + h * 128 + 8 * hh;
#pragma unroll
      for (int s = 0; s < 8; ++s) Qf[s] = *(const bf16x8*)(qrow + 16 * s); }
    f32x16 O[4];
#pragma unroll
    for (int d = 0; d < 4; ++d)
#pragma unroll
        for (int i = 0; i < 16; ++i) O[d][i] = 0.f;
    float R = 0.f;
    const float bias2 = IN_F(I_SBBIAS)[layer * 4 + h] * LOG2E;
    const int ntile = qb * 4 + 4, srow = tid >> 3, sch = tid & 7;
    LAS unsigned char* Ks = lds + ATT_KS; LAS unsigned char* Vt = lds + ATT_VT;
    v4u kreg[2], vreg[2];
    { const bf16* src = QKV + (size_t)((ntile - 1) * 64 + srow) * 1536 + h * 128 + sch * 8;
      kreg[0] = *(const v4u*)(src + 512); kreg[1] = *(const v4u*)(src + 512 + 64); vreg[0] = *(const v4u*)(src + 1024); vreg[1] = *(const v4u*)(src + 1024 + 64); }
    for (int kt = ntile - 1; kt >= 0; --kt) {
        __syncthreads();
#pragma unroll
        for (int i = 0; i < 2; ++i) { *(LAS v4u*)(Ks + srow * KS_PITCH + (sch + 8 * i) * 16) = kreg[i];
            LAS unsigned short* vt = (LAS unsigned short*)Vt + ((sch + 8 * i) * 8) * (VT_PITCH / 2) + srow;
            const unsigned w[4] = {vreg[i].x, vreg[i].y, vreg[i].z, vreg[i].w};
#pragma unroll
            for (int e = 0; e < 4; ++e) { vt[(2 * e) * (VT_PITCH / 2)] = (unsigned short)(w[e] & 0xffffu); vt[(2 * e + 1) * (VT_PITCH / 2)] = (unsigned short)(w[e] >> 16); } }
        __syncthreads();
        if (kt > 0) { const bf16* src = QKV + (size_t)((kt - 1) * 64 + srow) * 1536 + h * 128 + sch * 8;
            kreg[0] = *(const v4u*)(src + 512); kreg[1] = *(const v4u*)(src + 512 + 64); vreg[0] = *(const v4u*)(src + 1024); vreg[1] = *(const v4u*)(src + 1024 + 64); }
        if (kt * 64 > q0 + 30) continue;
        const bool diag = (kt * 64 + 63 >= q0);
        const int kbase = kt * 64 + 4 * hh;
        bf16x8 Pf[4];
#pragma unroll
        for (int sub = 1; sub >= 0; --sub) {
            f32x16 sa;
#pragma unroll
            for (int i = 0; i < 16; ++i) sa[i] = bias2;
#pragma unroll
            for (int s = 0; s < 8; ++s) { const bf16x8 a = *(const LAS bf16x8*)(Ks + (32 * sub + r) * KS_PITCH + (16 * s + 8 * hh) * 2);
                sa = __builtin_amdgcn_mfma_f32_32x32x16_bf16(a, Qf[s], sa, 0, 0, 0); }
            float sp[16], Gs[4], Gp[4];
#pragma unroll
            for (int i = 0; i < 16; ++i) { const float z = fminf(sa[i], 60.f); sa[i] = z; float s1 = lg2(1.0f + ex2(z));
                if (diag && (kbase + 32 * sub + 8 * (i >> 2) + (i & 3) >= qpos)) s1 = 0.f;
                sp[i] = s1; }
#pragma unroll
            for (int g = 0; g < 4; ++g) { Gs[g] = (sp[4 * g] + sp[4 * g + 1]) + (sp[4 * g + 2] + sp[4 * g + 3]); Gp[g] = __shfl_xor(Gs[g], 32); }
            float run = R;
#pragma unroll
            for (int g = 3; g >= 0; --g) { float a = run + (hh == 0 ? Gp[g] : 0.f);
#pragma unroll
                for (int e = 3; e >= 0; --e) { const int i = 4 * g + e; float pv = ex2(sa[i] - sp[i] - a);
                    if (diag && (kbase + 32 * sub + 8 * g + e >= qpos)) pv = 0.f;
                    a += sp[i]; sp[i] = pv; }
                run += Gs[g] + Gp[g]; }
            R = run;
#pragma unroll
            for (int q2 = 0; q2 < 2; ++q2) { const int bs = 8 * q2; v4u w;
                w.x = pk2(sp[bs + 0], sp[bs + 1]); w.y = pk2(sp[bs + 2], sp[bs + 3]); w.z = pk2(sp[bs + 4], sp[bs + 5]); w.w = pk2(sp[bs + 6], sp[bs + 7]);
                Pf[2 * sub + q2] = __builtin_bit_cast(bf16x8, w); }
        }
#pragma unroll
        for (int d = 0; d < 4; ++d)
#pragma unroll
            for (int s4 = 0; s4 < 4; ++s4) { const LAS unsigned char* vp = Vt + (32 * d + r) * VT_PITCH + (16 * s4 + 4 * hh) * 2;
                const v2u lo = *(const LAS v2u*)vp, hi = *(const LAS v2u*)(vp + 16); v4u w; w.x = lo.x; w.y = lo.y; w.z = hi.x; w.w = hi.y;
                O[d] = __builtin_amdgcn_mfma_f32_32x32x16_bf16(__builtin_bit_cast(bf16x8, w), Pf[s4], O[d], 0, 0, 0); }
    }
    bf16* orow = WSP(bf16, WS_OBR) + 1024 + (size_t)(b * SEQ + qpos) * OBW + h * 128 + 4 * hh;
#pragma unroll
    for (int d = 0; d < 4; ++d)
#pragma unroll
        for (int g = 0; g < 4; ++g) { v2u w; w.x = pk2(O[d][4 * g], O[d][4 * g + 1]); w.y = pk2(O[d][4 * g + 2], O[d][4 * g + 3]); *(v2u*)(orow + 32 * d + 8 * g) = w; }
}

__device__ __forceinline__ void attn_sample_unit(CA A, LAS unsigned char* lds, int layer, int unit, const int wv) {
    const int tid = tid_opaque(wv), lane = tid & 63, wid = tid >> 6, sb = unit >> 5, pg4 = unit & 31, hd = lane >> 4;
    const int lp = 4 * pg4 + (wid >> 1), phys = ((const int*)A->in[I_PT])[sb * NPAGES + lp];
    const size_t pbase = ((size_t)(layer * NPOOL + phys) * PAGE + (wid & 1) * 64) * 512 + lane * 8;
    const float* Kc = IN_F(I_CK) + pbase; const float* Vc = IN_F(I_CV) + pbase;
    const bf16* QKV = WSP(bf16, WS_QKV);
    float qf[4][8], O[4][8], R[4];
#pragma unroll
    for (int i = 0; i < 4; ++i) { const v4u w = *(const v4u*)(QKV + (size_t)(TP + sb * 4 + i) * 1536 + lane * 8);
        qf[i][0] = bflo(w.x); qf[i][1] = bfhi(w.x); qf[i][2] = bflo(w.y); qf[i][3] = bfhi(w.y); qf[i][4] = bflo(w.z); qf[i][5] = bfhi(w.z); qf[i][6] = bflo(w.w); qf[i][7] = bfhi(w.w);
        R[i] = 0.f;
#pragma unroll
        for (int j = 0; j < 8; ++j) O[i][j] = 0.f; }
    const float bias2 = IN_F(I_SBBIAS)[layer * 4 + hd] * LOG2E;
#pragma unroll 4
    for (int t = 63; t >= 0; --t) {
        const f32x4 k0 = *(const f32x4*)(Kc + (size_t)t * 512), k1 = *(const f32x4*)(Kc + (size_t)t * 512 + 4), v0 = *(const f32x4*)(Vc + (size_t)t * 512), v1 = *(const f32x4*)(Vc + (size_t)t * 512 + 4);
#pragma unroll
        for (int i = 0; i < 4; ++i) {
            float s = (qf[i][0] * k0[0] + qf[i][1] * k0[1]) + (qf[i][2] * k0[2] + qf[i][3] * k0[3]) + (qf[i][4] * k1[0] + qf[i][5] * k1[1]) + (qf[i][6] * k1[2] + qf[i][7] * k1[3]);
            s = row16_sum(s);
            const float z = fminf(s + bias2, 60.f), s1 = lg2(1.0f + ex2(z)), pv = ex2(z - s1 - R[i]); R[i] += s1;
#pragma unroll
            for (int e = 0; e < 4; ++e) { O[i][e] += pv * v0[e]; O[i][4 + e] += pv * v1[e]; } }
    }
    LAS float* Ow = (LAS float*)lds;
    LAS float* Rw = Ow + 8 * 4 * 512;
    __syncthreads();
#pragma unroll
    for (int i = 0; i < 4; ++i) { *(LAS f32x4*)(Ow + (wid * 4 + i) * 512 + lane * 8) = (f32x4){O[i][0], O[i][1], O[i][2], O[i][3]}; *(LAS f32x4*)(Ow + (wid * 4 + i) * 512 + lane * 8 + 4) = (f32x4){O[i][4], O[i][5], O[i][6], O[i][7]};
        if ((lane & 15) == 0) Rw[(wid * 4 + i) * 4 + hd] = R[i]; }
    __syncthreads();
    float* PART = WSP(float, WS_PART) + (size_t)unit * 2048; float* PR = WSP(float, WS_PR) + (size_t)unit * 16;
    for (int idx = tid; idx < 2048; idx += NTHR) { const int i = idx >> 9, c = idx & 511, hc = c >> 7; float acc = 0.f, racc = 0.f;
#pragma unroll
        for (int w = 7; w >= 0; --w) { acc += ex2(-racc) * Ow[(w * 4 + i) * 512 + c]; racc += Rw[(w * 4 + i) * 4 + hc]; }
        PART[idx] = acc; if ((c & 127) == 0) PR[i * 4 + hc] = racc; }
}
__device__ __forceinline__ void attn_sample_combine(CA A, int layer, const int wv) {
    {
      const int t0 = tid_opaque(wv), gt = blk_opaque() * NTHR + t0; const float* SQ = WSP(float, WS_SSQ); float* RS = WSP(float, WS_RS);
      for (int idx = gt; idx < TT * 2; idx += gridDim.x * NTHR) { const f32x4* sq = (const f32x4*)(SQ + (size_t)idx * 16); const f32x4 a = sq[0], b = sq[1], c = sq[2], d = sq[3];
          RS[idx] = (((a[0] + a[1]) + (a[2] + a[3]) + (b[0] + b[1]) + (b[2] + b[3])) + ((c[0] + c[1]) + (c[2] + c[3]) + (d[0] + d[1]) + (d[2] + d[3]))) * (1.0f / 512.0f) + RMS_EPS; } }
    const int tid = tid_opaque(wv), lane = tid & 63, gw = blk_opaque() * NWAVES + (tid >> 6), NGW = gridDim.x * NWAVES;
    const bf16* QKV = WSP(bf16, WS_QKV); const float* PART = WSP(float, WS_PART); const float* PR = WSP(float, WS_PR);
    const float* kn = A->out + O_KS + (size_t)layer * TS * 512; const float* vn = A->out + O_VS + (size_t)layer * TS * 512;
    bf16* O2 = WSP(bf16, WS_OBR) + 1024;
    for (int it = gw; it < TS * 4; it += NGW) { const int sb = it >> 4, i = (it >> 2) & 3, hd = it & 3, row = TP + sb * 4 + i, c = hd * 128 + 2 * lane;
        const unsigned qw = *(const unsigned*)(QKV + (size_t)row * 1536 + c); const float q0 = bflo(qw), q1 = bfhi(qw);
        const float bias2 = IN_F(I_SBBIAS)[layer * 4 + hd] * LOG2E; float o0 = 0.f, o1 = 0.f, racc = 0.f;
        for (int j = i - 1; j >= 0; --j) { const float* kr = kn + (size_t)(sb * 4 + j) * 512 + c; const float* vr = vn + (size_t)(sb * 4 + j) * 512 + c;
            const float z = fminf(wave_sum(q0 * kr[0] + q1 * kr[1]) + bias2, 60.f), s1 = lg2(1.0f + ex2(z)), pv = ex2(z - s1 - racc); racc += s1; o0 += pv * vr[0]; o1 += pv * vr[1]; }
        for (int u = 31; u >= 0; --u) { const float* pr = PART + ((size_t)(sb * 32 + u) * 4 + i) * 512 + c; const float sc = ex2(-racc); o0 += sc * pr[0]; o1 += sc * pr[1]; racc += PR[(size_t)(sb * 32 + u) * 16 + i * 4 + hd]; }
        *(unsigned*)(O2 + (size_t)row * OBW + c) = pk2(o0, o1); }
}

#ifndef MK_ONE_LAUNCH
#define MK_ONE_LAUNCH 1
#endif
#ifndef REP_P0
#define REP_P0 1
#endif
#ifndef REP_IN
#define REP_IN 1
#endif
#ifndef REP_PREP
#define REP_PREP 1
#endif
#ifndef REP_MIXA
#define REP_MIXA 1
#endif
#ifndef REP_MIXB
#define REP_MIXB 1
#endif
#ifndef REP_MERGE
#define REP_MERGE 1
#endif
#ifndef REP_OUT
#define REP_OUT 1
#endif
#ifndef REP_UP
#define REP_UP 1
#endif
#ifndef REP_DOWN
#define REP_DOWN 1
#endif
#ifndef REP_BAR
#define REP_BAR 1
#endif
#ifndef REP_RES1L0
#define REP_RES1L0 1
#endif
constexpr int N_PHASES = 24;
__device__ __forceinline__ int queue_pop(unsigned* head, volatile LAS unsigned* slot, const int wv) {
    __syncthreads();
    if (tid_opaque(wv) == 0) *slot = __hip_atomic_fetch_add(head, 1u, __ATOMIC_RELAXED, __HIP_MEMORY_SCOPE_AGENT);
    __syncthreads();
    return (int)*slot;
}
__global__ void __launch_bounds__(NTHR, 2) mega(Args Araw) {
    extern __shared__ __attribute__((aligned(16))) unsigned char lds_raw[];
    LAS unsigned char* lds = (LAS unsigned char*)lds_raw;
    volatile LAS unsigned* MISC = (volatile LAS unsigned*)(lds + MISC_OFF);
    const int wv = __builtin_amdgcn_readfirstlane(threadIdx.x >> 6); const int tid = tid_opaque(wv), G = gridDim.x, blk = blk_opaque();
    if (tid < 16) MISC[tid] = 0u;
    __syncthreads();
    unsigned* ctl = (unsigned*)(Araw.ws + WS_CTL);
    XcdBarrier bar = xcd_barrier_post(ctl + CW_BAR + Araw.li * XCD_BAR_WORDS, MISC, tid);
    const int lo = Araw.ph_lo, hi = Araw.ph_hi;
#define IN(gp) (lo <= (gp) && (gp) < hi)
#define SEAM(gp) do { if (lo <= (gp) && (gp) + 1 < hi) for (int rb_ = 0; rb_ < REP_BAR; ++rb_) xcd_barrier(bar, tid_opaque(wv)); } while (0)

    if (IN(0)) for (int rep = 0; rep < REP_P0; ++rep) { CA A = args_opaque(); p0_prologue(A, lds, wv); }
    SEAM(0);
    if (IN(1)) { CA A = args_opaque(); norm1_phase(A, wv); }
    SEAM(1);
    for (int layer = 0; layer < DEPTH; ++layer) {
        const int gb = 1 + 11 * layer;
        if (IN(gb + 1)) for (int rep = 0; rep < REP_IN; ++rep) { CA A = args_opaque();
            pg8::Gemm g{WSP(bf16, WS_H), WSP(bf16, WS_WIN) + (size_t)layer * NIN * DM, MP, NIN, DM, DM / 64, 0}; pg8::StaticOrder S; S.init(MP, NIN, G, blk_opaque());
            EpiIn E{WSP(float, WS_UF), WSP(bf16, WS_QKV), WSP(bf16, WS_GATE), A->out + O_KP + (size_t)layer * TP * 512, A->out + O_VP + (size_t)layer * TP * 512,
                    A->out + O_KS + (size_t)layer * TS * 512, A->out + O_VS + (size_t)layer * TS * 512, 0.08838834764831845f * LOG2E};
            pg8::gemm_phase<EpiIn, pg8::StaticOrder, true, true>(lds, g, S, E, wv);
        }
        SEAM(gb + 1);
        if (IN(gb + 2)) for (int rep = 0; rep < REP_PREP; ++rep) { CA A = args_opaque(); prep_phase(A, layer, wv); }
        SEAM(gb + 2);
        if (IN(gb + 3)) for (int rep = 0; rep < REP_MIXA; ++rep) { CA A = args_opaque();
            { unsigned* qh = (unsigned*)(A->ws + WS_CTL) + CW_QUEUE + 64 * (layer * 4 + 3) + 1024 * rep;
              for (;;) { const int u = queue_pop(qh, MISC + 4, wv); if (u >= 2048) break; ssd_prep_unit(A, lds, layer, u, wv); } }
            { unsigned* qh = (unsigned*)(A->ws + WS_CTL) + CW_QUEUE + 64 * (layer * 4 + 2) + 1024 * rep;
              for (;;) { const int u = queue_pop(qh, MISC + 4, wv); if (u >= 512) break; dn_chunk_unit(A, lds, layer, u, wv); } }
            { unsigned* qh = (unsigned*)(A->ws + WS_CTL) + CW_QUEUE + 64 * (layer * 4 + 0) + 1024 * rep;
              for (;;) { const int u = queue_pop(qh, MISC + 4, wv); if (u >= 128) break; attn_prompt_unit(A, lds, layer, u, wv); } }
        }
        SEAM(gb + 3);
        if (IN(gb + 4)) for (int rep = 0; rep < REP_MIXB; ++rep) { CA A = args_opaque();
            for (int t = blk; t < 16; t += G) dn_seq2(A, lds, layer, t, wv);
            for (int t = blk; t < 80; t += G) if (t >= 16) ssd_seq2(A, lds, layer, t - 16, wv);
            for (int t = blk; t < 112; t += G) if (t >= 80) dn_seq(A, lds, layer, t - 80 + 16, wv);
            for (int t = blk; t < 240; t += G) if (t >= 112) ssd_seq(A, lds, layer, t - 112 + 64, wv);
            { unsigned* qh = (unsigned*)(A->ws + WS_CTL) + CW_QUEUE + 64 * (layer * 4 + 1) + 1024 * rep;
              for (;;) { const int u = queue_pop(qh, MISC + 4, wv); if (u >= 256) break; attn_sample_unit(A, lds, layer, u, wv); } }
        }
        SEAM(gb + 4);
        if (IN(gb + 5)) { CA A = args_opaque(); attn_sample_combine(A, layer, wv); }
        SEAM(gb + 5);
        if (IN(gb + 6)) for (int rep = 0; rep < REP_MERGE; ++rep) { CA A = args_opaque();
            pg8::SegOrder<5> S; S.init(TP, DM, G, blk_opaque());
            pg8::Gemm g{WSP(bf16, WS_OBR), WSP(bf16, WS_WBR) + (size_t)layer * DM * OBW, TP, DM, OBW, 8, 1024};
            EpiMergeR E{WSP(bf16, WS_GATE), WSP(float, WS_RS), WSP(bf16, WS_MGB)};
            pg8::gemm_phase<EpiMergeR, pg8::SegOrder<5>, true, true>(lds, g, S, E, wv);
            sample_merge(A, lds, layer, wv);
        }
        SEAM(gb + 6);
        if (IN(gb + 7)) for (int rep = 0; rep < REP_OUT; ++rep) { CA A = args_opaque();
            pg8::Gemm g{WSP(bf16, WS_MGB), WSP(bf16, WS_WOUT) + (size_t)layer * DM * DM, TP, DM, DM, DM / 64, 0}; pg8::StaticOrder S; S.init(TP, DM, G, blk_opaque());
            EpiF32 E{WSP(float, WS_MIX), DM}; pg8::gemm_phase<EpiF32, pg8::StaticOrder, true, true>(lds, g, S, E, wv);
            { ALBf16 al{WSP(bf16, WS_MGB) + (size_t)TP * DM, DM}; sample_splitk(al, WSP(bf16, WS_WOUT) + (size_t)layer * DM * DM, DM, 128, 16, 4, WSP(float, WS_OUTS), DM, wv); }
        }
        SEAM(gb + 7);
        if (IN(gb + 8)) for (int rep = 0; rep < (layer == 0 ? REP_RES1L0 : 1); ++rep) { CA A = args_opaque(); resid_phase(A, WSP(float, WS_MIX), WSP(float, WS_OUTS), IN_F(I_NMPOST) + layer * DM, IN_F(I_NLPRE) + layer * DM, layer == 0, wv); }
        SEAM(gb + 8);
        if (IN(gb + 9)) for (int rep = 0; rep < REP_UP; ++rep) { CA A = args_opaque();
            pg8::Gemm g{WSP(bf16, WS_H), WSP(bf16, WS_WUP) + (size_t)layer * DFF * DM, TP, DFF, DM, DM / 64, 0}; pg8::StaticOrder S; S.init(TP, DFF, G, blk_opaque());
            EpiRelu2 E{WSP(bf16, WS_F), DFF}; pg8::gemm_phase<EpiRelu2, pg8::StaticOrder, true, true>(lds, g, S, E, wv);
            sample_up(A, lds, layer, wv);
        }
        SEAM(gb + 9);
        if (IN(gb + 10)) for (int rep = 0; rep < REP_DOWN; ++rep) { CA A = args_opaque();
            pg8::Gemm g{WSP(bf16, WS_F), WSP(bf16, WS_WDN) + (size_t)layer * DM * DFF, TP, DM, DFF, DFF / 64, 0}; pg8::StaticOrder S; S.init(TP, DM, G, blk_opaque());
            EpiF32 E{WSP(float, WS_FD), DM}; pg8::gemm_phase<EpiF32, pg8::StaticOrder, true, true>(lds, g, S, E, wv);
            { ALBf16 al{WSP(bf16, WS_F) + (size_t)TP * DFF, DFF}; sample_splitk(al, WSP(bf16, WS_WDN) + (size_t)layer * DM * DFF, DFF, 128, 16, 16, WSP(float, WS_DNS), DM, wv); }
        }
        SEAM(gb + 10);
        if (IN(gb + 11)) { CA A = args_opaque(); resid_phase(A, WSP(float, WS_FD), WSP(float, WS_DNS), IN_F(I_NLPOST) + layer * DM, layer + 1 < DEPTH ? IN_F(I_NMPRE) + (layer + 1) * DM : nullptr, false, wv); }
        SEAM(gb + 11);
    }
#undef IN
#undef SEAM
}

extern "C" void kernel_launch(void* const* d_in, const int* in_sizes, int n_in, void* d_out, int out_size, void* d_ws, size_t ws_size, hipStream_t stream) {
    static int grid = 0;
    if (grid == 0) {
        if (n_in != N_IN || (size_t)out_size != O_END || ws_size < WS_END) { fprintf(stderr, "kernel_launch: unexpected problem (n_in %d, out %d vs %zu, ws %zu vs %zu); nothing launched\n", n_in, out_size, (size_t)O_END, ws_size, (size_t)WS_END); grid = -1; return; }
        int dev = 0, cus = 0, per_cu = 0;
        if (hipGetDevice(&dev) != hipSuccess || hipDeviceGetAttribute(&cus, hipDeviceAttributeMultiprocessorCount, dev) != hipSuccess) { grid = -1; return; }
        if (hipFuncSetAttribute((const void*)mega, hipFuncAttributeMaxDynamicSharedMemorySize, LDS_BYTES) != hipSuccess) { fprintf(stderr, "kernel_launch: hipFuncSetAttribute failed\n"); grid = -1; return; }
        if (hipOccupancyMaxActiveBlocksPerMultiprocessor(&per_cu, (const void*)mega, NTHR, LDS_BYTES) != hipSuccess || per_cu < 1) fprintf(stderr, "kernel_launch: occupancy query says %d blocks per CU\n", per_cu);
        (void)hipGetLastError();
        grid = cus;
    }
    if (grid < 0) return;
    (void)in_sizes;
    hipMemsetAsync((char*)d_ws + WS_CTL, 0, CTL_BYTES, stream);
    Args a{};
    for (int i = 0; i < N_IN; ++i) a.in[i] = d_in[i];
    a.out = (float*)d_out; a.ws = (unsigned char*)d_ws; a.pad = 0;
#if MK_ONE_LAUNCH
    a.ph_lo = 0; a.ph_hi = N_PHASES; a.li = 0;
    hipLaunchKernelGGL(mega, dim3(grid), dim3(NTHR), LDS_BYTES, stream, a);
#else
    for (int gp = 0; gp < N_PHASES; ++gp) { a.ph_lo = gp; a.ph_hi = gp + 1; a.li = 0; hipLaunchKernelGGL(mega, dim3(grid), dim3(NTHR), LDS_BYTES, stream, a); }
#endif
}
```

```cpp
#include <hip/hip_runtime.h>
#include <cstdio>
#include <cstdint>
__device__ __forceinline__ int lane_opaque() { unsigned m = ~0u; asm volatile("" : "+s"(m)); return (int)__builtin_amdgcn_mbcnt_hi(m, __builtin_amdgcn_mbcnt_lo(m, 0u)); }
__device__ __forceinline__ int tid_opaque(int wv) { return wv * 64 + lane_opaque(); }
__device__ __forceinline__ int blk_opaque() { int t = blockIdx.x; asm volatile("" : "+s"(t)); return t; }
namespace pg8 {
#define PG8_LAS __attribute__((address_space(3)))
typedef unsigned short bf16_t;
typedef short bf16x8 __attribute__((ext_vector_type(8)));
typedef float f32x4 __attribute__((ext_vector_type(4)));
typedef unsigned u32x4 __attribute__((ext_vector_type(4)));
constexpr int BM = 256, BK = 64, HALF = 128, HTB = HALF * BK * 2  , STAGE_BYTES = 8 * HTB, NXCD = 8, WGM = 8;

__host__ __device__ __forceinline__ int lds_byte(int r, int c) { const int st = (r >> 4) * 2 + (c >> 5), rr = r & 15, cc = c & 31, ob = rr * 64 + cc * 2; return st * 1024 + (ob ^ (((ob >> 9) & 1) << 5)); }
__host__ __device__ __forceinline__ void stage_rc(int b, int& R, int& C) { const int st = b / 1024, sb = b % 1024, swz = sb ^ (((sb >> 9) & 1) << 5); R = (st >> 1) * 16 + swz / 64; C = (st & 1) * 32 + (swz % 64) / 2; }
__host__ __device__ __forceinline__ int perm32(int rho) { const int n = rho >> 4, i = rho & 15; return 8 * (i >> 2) + 4 * n + (i & 3); }

struct Unit { int pm, pn, seg; };
struct Gemm { const bf16_t* A; const bf16_t* Bt; int M, N, K, KT, SEGB; };

struct StaticOrder {
    int nM, nN, nwg, G, c;
    __host__ __device__ void init(int M, int N, int G_, int c_) { nM = M / BM; nN = N / BM; nwg = nM * nN; G = G_; c = c_; }
    __host__ __device__ bool next(int i, Unit& u) const {
        const long L = (long)i * G + c; if (L >= nwg) return false;
        int wgid = (int)L; { const int q = nwg / NXCD, r = nwg % NXCD, xcd = wgid % NXCD, off = wgid / NXCD; wgid = (xcd < r ? xcd * (q + 1) : r * (q + 1) + (xcd - r) * q) + off; }
        const int nig = WGM * nN, gid = wgid / nig, fm = gid * WGM, gsz = (nM - fm) < WGM ? (nM - fm) : WGM;
        u.pm = fm + ((wgid % nig) % gsz); u.pn = (wgid % nig) / gsz; u.seg = 0; return true;
    }
    __device__ __forceinline__ void a_ready(const Unit&) const {}
    __device__ __forceinline__ void done(const Unit&) const {}
};
template <int NSEG> struct SegOrder : StaticOrder {
    __host__ __device__ bool next(int i, Unit& u) const { if (!StaticOrder::next(i / NSEG, u)) return false; u.seg = i % NSEG; return true; }
};
__device__ __forceinline__ unsigned cvt_pk_bf16(float lo, float hi) { unsigned r; asm volatile("v_cvt_pk_bf16_f32 %0, %1, %2" : "=v"(r) : "v"(lo), "v"(hi)); return r; }
typedef float f32x2 __attribute__((ext_vector_type(2)));
template <class Epi, class Sched, bool ALIGN_EPI = false, bool SP2 = false>
__device__ __forceinline__ void gemm_phase(PG8_LAS unsigned char* lds, const Gemm g, const Sched& S, const Epi& E, const int wv) {
    int wvo = wv; asm volatile("" : "+s"(wvo));
    const int lane = lane_opaque(), tid = wvo * 64 + lane, wid = wvo, wr = wid >> 2, wc = wid & 3, fr = lane & 15, fq = lane >> 4;
    const int K = g.K, nt = g.KT;
    unsigned voffA[2], voffB[2];
#pragma unroll
    for (int i = 0; i < 2; ++i) { int R, C; stage_rc(tid * 16 + i * 8192, R, C); const int Rb = Epi::PERM ? ((R & ~31) + perm32(R & 31)) : R;
        voffA[i] = (unsigned)(R * K + C) * 2u; voffB[i] = (unsigned)(Rb * K + C) * 2u; }
    const size_t kstep = (size_t)(BK * 2);
    const size_t hstep = (size_t)HALF * K * 2;
    const size_t tstep = 2 * hstep;
    const unsigned ldsw = (unsigned)wid * 1024u;
    const int aoff = lds_byte(wr * 64 + fr, fq * 8), boff = lds_byte(wc * 32 + fr, fq * 8);
#define PG8_SA(b, h) (((b) * 2 + (h)) * HTB)
#define PG8_SB(b, h) ((4 + (b) * 2 + (h)) * HTB)
#define PG8_STAGE(bufoff, gbase, voff) do { _Pragma("unroll") for (int _i = 0; _i < 2; ++_i) \
        __builtin_amdgcn_global_load_lds((const unsigned*)((const char*)(gbase) + (voff)[_i]), (PG8_LAS unsigned*)(lds + (bufoff) + ldsw + _i * 8192), 16, 0, 0); } while (0)
#define PG8_LDA(dst, b, h) do { _Pragma("unroll") for (int m = 0; m < 4; ++m) _Pragma("unroll") for (int k = 0; k < 2; ++k) dst[m][k] = *(const PG8_LAS bf16x8*)(lds + PG8_SA(b, h) + aoff + m * 2048 + k * 1024); } while (0)
#define PG8_LDB(dst, b, h) do { _Pragma("unroll") for (int n = 0; n < 2; ++n) _Pragma("unroll") for (int k = 0; k < 2; ++k) dst[n][k] = *(const PG8_LAS bf16x8*)(lds + PG8_SB(b, h) + boff + n * 2048 + k * 1024); } while (0)
#define PG8_MMA(ai, bj, At, Bt) do { __builtin_amdgcn_s_setprio(1); _Pragma("unroll") for (int m = 0; m < 4; ++m) _Pragma("unroll") for (int n = 0; n < 2; ++n) _Pragma("unroll") for (int k = 0; k < 2; ++k) \
        acc[ai][bj][m][n] = __builtin_amdgcn_mfma_f32_16x16x32_bf16(Bt[n][k], At[m][k], acc[ai][bj][m][n], 0, 0, 0); __builtin_amdgcn_s_setprio(0); } while (0)
#define PG8_WAIT_V(n) asm volatile("s_waitcnt vmcnt(" #n ")" ::: "memory")
#define PG8_WAIT_L(n) asm volatile("s_waitcnt lgkmcnt(" #n ")" ::: "memory")
#define PG8_BAR __builtin_amdgcn_s_barrier()
#define PG8_SCHED __builtin_amdgcn_sched_barrier(0)
    Unit cur, nxt; int ui = 0;
    if (!S.next(0, cur)) return;
    f32x4 acc[2][2][4][2];
#pragma unroll
    for (int a = 0; a < 2; ++a)
#pragma unroll
        for (int b = 0; b < 2; ++b)
#pragma unroll
            for (int m = 0; m < 4; ++m)
#pragma unroll
                for (int n = 0; n < 2; ++n) acc[a][b][m][n] = (f32x4){0.f, 0.f, 0.f, 0.f};
    bf16x8 At[4][2], B0[2][2], B1[2][2];
    const char* cA = (const char*)g.A + (size_t)cur.pm * tstep + (size_t)cur.seg * g.SEGB; const char* cB = (const char*)g.Bt + (size_t)cur.pn * tstep + (size_t)cur.seg * g.SEGB;
    S.a_ready(cur);
    if constexpr (SP2) {
        PG8_STAGE(PG8_SB(0, 0), cB, voffB); PG8_STAGE(PG8_SB(0, 1), cB + hstep, voffB); PG8_STAGE(PG8_SA(0, 0), cA, voffA); PG8_STAGE(PG8_SA(0, 1), cA + hstep, voffA);
        if (wr == 1) PG8_BAR;
        PG8_WAIT_V(2); PG8_BAR;
        PG8_STAGE(PG8_SB(1, 0), cB + kstep, voffB); PG8_STAGE(PG8_SA(1, 0), cA + kstep, voffA); PG8_STAGE(PG8_SB(1, 1), cB + hstep + kstep, voffB);
        PG8_WAIT_V(6); PG8_BAR;
    } else {
        PG8_STAGE(PG8_SB(0, 0), cB, voffB); PG8_STAGE(PG8_SA(0, 0), cA, voffA); PG8_STAGE(PG8_SB(0, 1), cB + hstep, voffB); PG8_STAGE(PG8_SA(0, 1), cA + hstep, voffA);
        if (wr == 1) PG8_BAR;
        PG8_WAIT_V(4); PG8_BAR;
        PG8_STAGE(PG8_SB(1, 0), cB + kstep, voffB); PG8_STAGE(PG8_SA(1, 0), cA + kstep, voffA); PG8_STAGE(PG8_SB(1, 1), cB + hstep + kstep, voffB);
        PG8_WAIT_V(6); PG8_BAR;
    }
    for (;;) {
        const bool has_next = S.next(ui + 1, nxt);
        const char* nA = has_next ? (const char*)g.A + (size_t)nxt.pm * tstep + (size_t)nxt.seg * g.SEGB : cA; const char* nB = has_next ? (const char*)g.Bt + (size_t)nxt.pn * tstep + (size_t)nxt.seg * g.SEGB : cB;
        for (int t = 0; t < nt; t += 2) {
            const bool last = (t == nt - 2);
            const char* a1 = cA + (size_t)(t + 1) * kstep;
            const char* a2 = last ? nA : cA + (size_t)(t + 2) * kstep; const char* b2 = last ? nB : cB + (size_t)(t + 2) * kstep;
            const char* a3 = a2 + kstep; const char* b3 = b2 + kstep;
            if (last && has_next) S.a_ready(nxt);
            if constexpr (SP2) {
            PG8_LDB(B0, 0, 0); PG8_LDB(B1, 0, 1); PG8_SCHED; PG8_LDA(At, 0, 0); PG8_STAGE(PG8_SA(1, 1), a1 + hstep, voffA);
            PG8_WAIT_V(8); PG8_WAIT_L(0); PG8_BAR; PG8_MMA(0, 0, At, B0); PG8_MMA(0, 1, At, B1); PG8_BAR; PG8_SCHED;
            PG8_LDA(At, 0, 1); PG8_STAGE(PG8_SB(0, 0), b2, voffB); PG8_STAGE(PG8_SB(0, 1), b2 + hstep, voffB); PG8_STAGE(PG8_SA(0, 0), a2, voffA);
            PG8_WAIT_V(8); PG8_WAIT_L(0); PG8_BAR; PG8_MMA(1, 0, At, B0); PG8_MMA(1, 1, At, B1); PG8_BAR; PG8_SCHED;
            PG8_LDB(B0, 1, 0); PG8_LDB(B1, 1, 1); PG8_SCHED; PG8_LDA(At, 1, 0); PG8_STAGE(PG8_SA(0, 1), a2 + hstep, voffA);
            PG8_WAIT_V(8); PG8_WAIT_L(0); PG8_BAR; PG8_MMA(0, 0, At, B0); PG8_MMA(0, 1, At, B1); PG8_BAR; PG8_SCHED;
            PG8_LDA(At, 1, 1); PG8_STAGE(PG8_SB(1, 0), b3, voffB); PG8_STAGE(PG8_SB(1, 1), b3 + hstep, voffB); PG8_STAGE(PG8_SA(1, 0), a3, voffA);
            PG8_WAIT_V(8); PG8_WAIT_L(0); PG8_BAR; PG8_MMA(1, 0, At, B0); PG8_MMA(1, 1, At, B1); PG8_BAR; PG8_SCHED;
            } else {
            PG8_LDB(B0, 0, 0); PG8_SCHED; PG8_LDA(At, 0, 0); PG8_STAGE(PG8_SA(1, 1), a1 + hstep, voffA);
            PG8_WAIT_L(8); PG8_BAR; PG8_WAIT_L(0); PG8_MMA(0, 0, At, B0); PG8_BAR; PG8_SCHED;
            PG8_LDB(B1, 0, 1); PG8_STAGE(PG8_SB(0, 0), b2, voffB);
            PG8_BAR; PG8_WAIT_L(0); PG8_MMA(0, 1, At, B1); PG8_BAR;
            PG8_LDA(At, 0, 1); PG8_STAGE(PG8_SA(0, 0), a2, voffA);
            PG8_BAR; PG8_WAIT_L(0); PG8_MMA(1, 0, At, B0); PG8_BAR; PG8_SCHED;
            PG8_STAGE(PG8_SB(0, 1), b2 + hstep, voffB);
            PG8_WAIT_V(6); PG8_BAR; PG8_MMA(1, 1, At, B1); PG8_BAR;
            PG8_LDB(B0, 1, 0); PG8_SCHED; PG8_LDA(At, 1, 0); PG8_STAGE(PG8_SA(0, 1), a2 + hstep, voffA);
            PG8_WAIT_L(8); PG8_BAR; PG8_WAIT_L(0); PG8_MMA(0, 0, At, B0); PG8_BAR; PG8_SCHED;
            PG8_LDB(B1, 1, 1); PG8_STAGE(PG8_SB(1, 0), b3, voffB);
            PG8_BAR; PG8_WAIT_L(0); PG8_MMA(0, 1, At, B1); PG8_BAR;
            PG8_LDA(At, 1, 1); PG8_STAGE(PG8_SA(1, 0), a3, voffA);
            PG8_BAR; PG8_WAIT_L(0); PG8_MMA(1, 0, At, B0); PG8_BAR; PG8_SCHED;
            PG8_STAGE(PG8_SB(1, 1), b3 + hstep, voffB);
            PG8_WAIT_V(6); PG8_BAR; PG8_MMA(1, 1, At, B1); PG8_BAR;
            }
        }
        if constexpr (ALIGN_EPI) { if (wr == 0) PG8_BAR; }
        if constexpr (!Epi::AFTER_DRAIN) { E(acc, cur, wr, wc, fr, fq); S.done(cur); }
        if (!has_next) break;
        if (!(Epi::KEEP_ACC && nxt.seg != 0)) {
#pragma unroll
        for (int a = 0; a < 2; ++a)
#pragma unroll
            for (int b = 0; b < 2; ++b)
#pragma unroll
                for (int m = 0; m < 4; ++m)
#pragma unroll
                    for (int n = 0; n < 2; ++n) acc[a][b][m][n] = (f32x4){0.f, 0.f, 0.f, 0.f}; }
        cur = nxt; cA = nA; cB = nB; ++ui;
        if constexpr (ALIGN_EPI) { if (wr == 1) PG8_BAR; }
    }
    PG8_WAIT_V(0);
    if constexpr (!ALIGN_EPI) { if (wr == 0) PG8_BAR; }
    PG8_BAR;
    if constexpr (Epi::AFTER_DRAIN) { E.fused(acc, cur, wr, wc, fr, fq, lds, wid, lane); S.done(cur); }
#undef PG8_SA
#undef PG8_SB
#undef PG8_STAGE
#undef PG8_LDA
#undef PG8_LDB
#undef PG8_MMA
#undef PG8_WAIT_V
#undef PG8_WAIT_L
#undef PG8_BAR
#undef PG8_SCHED
}
}

constexpr int DM = 2048, NBATCH = 4, SEQ = 2048, DEPTH = 2, DBATCH = 8, DSEQ = 4, PAST = 16384, PAGE = 128;
constexpr int TP = NBATCH * SEQ;
constexpr int TS = DBATCH * DSEQ;
constexpr int TT = TP + TS;
constexpr int MP = 8448;
constexpr int NPAGES = PAST / PAGE;
constexpr int NPOOL = 1280;
constexpr int POOLW = 512, DNC = 1536, SBW = 512, SSI = 1024, SSC = 1536, DFF = 8192;
constexpr int INCOLS = 14872, NIN = 15104;
constexpr int OBW = 2560;
constexpr int UFW = 5376;
constexpr int UF_POOL = 0, UF_DNQKV = 512, UF_DNZ = 2048, UF_SSZ = 2560, UF_XBC = 3584, UF_SMALL = 5120;
constexpr float RMS_EPS = 1e-6f;
constexpr float LOG2E = 1.4426950408889634f;
constexpr int NWAVES = 8, NTHR = 512;

constexpr size_t O_Y = 0;
constexpr size_t O_KP = O_Y + (size_t)TT * DM;
constexpr size_t O_VP = O_KP + (size_t)DEPTH * TP * 512;
constexpr size_t O_POOLP = O_VP + (size_t)DEPTH * TP * 512;
constexpr size_t O_DNCP = O_POOLP + (size_t)DEPTH * NBATCH * 15 * 512;
constexpr size_t O_DNSP = O_DNCP + (size_t)DEPTH * NBATCH * 3 * 1536;
constexpr size_t O_SSCP = O_DNSP + (size_t)DEPTH * NBATCH * 4 * 128 * 128;
constexpr size_t O_SSHP = O_SSCP + (size_t)DEPTH * NBATCH * 3 * 1536;
constexpr size_t O_KS = O_SSHP + (size_t)DEPTH * NBATCH * 16 * 64 * 128;
constexpr size_t O_VS = O_KS + (size_t)DEPTH * TS * 512;
constexpr size_t O_POOLS = O_VS + (size_t)DEPTH * TS * 512;
constexpr size_t O_DNCS = O_POOLS + (size_t)DEPTH * DBATCH * 15 * 512;
constexpr size_t O_DNSS = O_DNCS + (size_t)DEPTH * DBATCH * 3 * 1536;
constexpr size_t O_SSCS = O_DNSS + (size_t)DEPTH * DBATCH * 4 * 128 * 128;
constexpr size_t O_SSHS = O_SSCS + (size_t)DEPTH * DBATCH * 3 * 1536;
constexpr size_t O_END = O_SSHS + (size_t)DEPTH * DBATCH * 16 * 64 * 128;

constexpr size_t al256(size_t x) { return (x + 255) & ~(size_t)255; }
constexpr size_t WS_CTL = 0, CTL_BYTES = 1u << 20;
constexpr size_t SZ_WIN = (size_t)NIN * DM * 2, SZ_WBR = (size_t)5 * DM * 512 * 2, SZ_WOUT = (size_t)DM * DM * 2, SZ_WUP = (size_t)DFF * DM * 2, SZ_WDN = (size_t)DM * DFF * 2;
constexpr size_t WS_WIN = WS_CTL + CTL_BYTES;
constexpr size_t WS_WBR = WS_WIN + 2 * SZ_WIN;
constexpr size_t WS_WOUT = WS_WBR + 2 * SZ_WBR;
constexpr size_t WS_WUP = WS_WOUT + 2 * SZ_WOUT;
constexpr size_t WS_WDN = WS_WUP + 2 * SZ_WUP;
constexpr size_t WS_H = WS_WDN + 2 * SZ_WDN;
constexpr size_t WS_UF = WS_H + (size_t)MP * DM * 2;
constexpr size_t WS_QKV = WS_UF + (size_t)MP * UFW * 4;
constexpr size_t WS_GATE = WS_QKV + (size_t)MP * 1536 * 2;
constexpr size_t WS_DNQ = WS_GATE + (size_t)MP * 8192 * 2;
constexpr size_t WS_XBC = WS_DNQ + (size_t)MP * 1536 * 4;
constexpr size_t WS_SCAL = WS_XBC + (size_t)MP * 1536 * 4;
constexpr size_t WS_OBR = WS_SCAL + (size_t)MP * 32 * 4;
constexpr size_t SZ_OBR = (size_t)MP * 512 * 2;
constexpr size_t WS_SSQ = WS_OBR + 5 * SZ_OBR;
constexpr size_t WS_MG32 = WS_SSQ + (size_t)MP * 32 * 4;
constexpr size_t WS_MGB = WS_MG32 + (size_t)MP * DM * 4;
constexpr size_t WS_MIX = WS_MGB + (size_t)MP * DM * 2;
constexpr size_t WS_F = WS_MIX + (size_t)MP * DM * 4;
constexpr size_t WS_FD = WS_F + (size_t)MP * DFF * 2;
constexpr size_t WS_PART = WS_FD + (size_t)MP * DM * 4;
constexpr size_t WS_PR = WS_PART + (size_t)256 * 2048 * 4;
constexpr size_t WS_DNU = WS_PR + (size_t)256 * 16 * 4;
constexpr size_t WS_SSU = WS_DNU + (size_t)512 * 90368;
constexpr size_t WS_SSG = WS_SSU + (size_t)2048 * 16896;
constexpr size_t WS_MGS = WS_SSG + (size_t)256 * 49152;
constexpr size_t WS_OUTS = WS_MGS + (size_t)5 * TS * DM * 4;
constexpr size_t WS_UPS = WS_OUTS + (size_t)16 * TS * DM * 4;
constexpr size_t WS_DNS = WS_UPS + (size_t)4 * TS * DFF * 4;
constexpr size_t WS_RS = WS_DNS + (size_t)16 * TS * DM * 4;
constexpr size_t WS_DNO = WS_RS + (size_t)MP * 2 * 4;
constexpr size_t WS_DNSQ = WS_DNO + (size_t)TP * 512 * 4;
constexpr size_t WS_END = WS_DNSQ + (size_t)TP * 32 * 4;
static_assert(WS_WIN % 256 == 0 && WS_H % 256 == 0 && WS_UF % 256 == 0 && WS_OBR % 256 == 0 && WS_MG32 % 256 == 0 && WS_PART % 256 == 0, "ws alignment");

constexpr int CW_QUEUE = 64;
constexpr int CW_BAR = 4096;

constexpr int LDS_BYTES = 147456;
constexpr int RING_BYTES = 131072;
constexpr int MISC_OFF = RING_BYTES;

#define GAS __attribute__((address_space(1)))
#define LAS __attribute__((address_space(3)))
typedef unsigned short bf16;
typedef unsigned v4u __attribute__((ext_vector_type(4)));
typedef unsigned v2u __attribute__((ext_vector_type(2)));
typedef float f32x4 __attribute__((ext_vector_type(4)));
typedef float f32x2 __attribute__((ext_vector_type(2)));
typedef float f32x16 __attribute__((ext_vector_type(16)));
typedef short bf16x8 __attribute__((ext_vector_type(8)));
__device__ __forceinline__ unsigned pk2(float lo, float hi) { unsigned r; asm("v_cvt_pk_bf16_f32 %0, %1, %2" : "=v"(r) : "v"(lo), "v"(hi)); return r; }
__device__ __forceinline__ unsigned f2bf(float f) { return pk2(f, f) & 0xffffu; }
__device__ __forceinline__ float bflo(unsigned w) { return __builtin_bit_cast(float, w << 16); }
__device__ __forceinline__ float bfhi(unsigned w) { return __builtin_bit_cast(float, w & 0xffff0000u); }
__device__ __forceinline__ float row16_sum(float x) {
    x += __builtin_bit_cast(float, __builtin_amdgcn_update_dpp(0, __builtin_bit_cast(int, x), 0x128, 0xf, 0xf, false));
    x += __builtin_bit_cast(float, __builtin_amdgcn_update_dpp(0, __builtin_bit_cast(int, x), 0x124, 0xf, 0xf, false));
    x += __builtin_bit_cast(float, __builtin_amdgcn_update_dpp(0, __builtin_bit_cast(int, x), 0x122, 0xf, 0xf, false));
    x += __builtin_bit_cast(float, __builtin_amdgcn_update_dpp(0, __builtin_bit_cast(int, x), 0x121, 0xf, 0xf, false));
    return x;
}
__device__ __forceinline__ float rdlane(float x, int l) { return __builtin_bit_cast(float, __builtin_amdgcn_readlane(__builtin_bit_cast(int, x), l)); }
__device__ __forceinline__ float wave_sum(float v) { const float r = row16_sum(v); return (rdlane(r, 0) + rdlane(r, 16)) + (rdlane(r, 32) + rdlane(r, 48)); }
__device__ __forceinline__ float wave_scan(float x, int lane) {
    x += __builtin_bit_cast(float, __builtin_amdgcn_update_dpp(0, __builtin_bit_cast(int, x), 0x111, 0xf, 0xf, true));
    x += __builtin_bit_cast(float, __builtin_amdgcn_update_dpp(0, __builtin_bit_cast(int, x), 0x112, 0xf, 0xf, true));
    x += __builtin_bit_cast(float, __builtin_amdgcn_update_dpp(0, __builtin_bit_cast(int, x), 0x114, 0xf, 0xf, true));
    x += __builtin_bit_cast(float, __builtin_amdgcn_update_dpp(0, __builtin_bit_cast(int, x), 0x118, 0xf, 0xf, true));
    const float t0 = rdlane(x, 15), t1 = rdlane(x, 31), t2 = rdlane(x, 47);
    return x + (lane >= 48 ? (t0 + t1) + t2 : (lane >= 32 ? t0 + t1 : (lane >= 16 ? t0 : 0.f)));
}
__device__ __forceinline__ float fexp(float x) { return __builtin_amdgcn_exp2f(x * 1.4426950408889634f); }
__device__ __forceinline__ float sigmoidf_(float x) { return 1.0f / (1.0f + __expf(-x)); }
__device__ __forceinline__ float siluf_(float x) { return x / (1.0f + __expf(-x)); }
__device__ __forceinline__ float softplusf_(float x) { const float e = fexp(fminf(x, 20.f)); const float l = e < 0.01f ? e * (1.0f - e * (0.5f - e * 0.33333333f)) : __builtin_amdgcn_logf(1.0f + e) * 0.6931471805599453f; return x > 20.f ? x : l; }
__device__ __forceinline__ float ex2(float x) { return __builtin_amdgcn_exp2f(x); }
__device__ __forceinline__ float lg2(float x) { return __builtin_amdgcn_logf(x); }
#define XB_TMO      128
#define XB_XCNT(j)  (256  + 64 * (j))
#define XB_XSUB(j)  (1280 + 64 * (j))
#define XB_XGEN(j)  (2304 + 64 * (j))
#define XB_TOP      3328
#define XB_TOPGEN   3392
#define XCD_BAR_WORDS 3456
#define XB_SPIN_CAP (1u << 18)

__device__ __forceinline__ unsigned xb_ld(unsigned* p)              { return __hip_atomic_load(p, __ATOMIC_RELAXED, __HIP_MEMORY_SCOPE_AGENT); }
__device__ __forceinline__ unsigned xb_add(unsigned* p, unsigned v) { return __hip_atomic_fetch_add(p, v, __ATOMIC_RELAXED, __HIP_MEMORY_SCOPE_AGENT); }
__device__ __forceinline__ unsigned xb_xcc_id() { return (unsigned)__builtin_amdgcn_s_getreg((3 << 11) | 20) & 0xFu; }
#define XB_SPIN(cond, bar) do { unsigned _sp = 0; while (cond) { __builtin_amdgcn_s_sleep(1); \
    if ((++_sp & 255u) == 0u) { if (xb_ld(&(bar)[XB_TMO])) break; if (_sp > XB_SPIN_CAP) { atomicAdd(&(bar)[XB_TMO], 1u); break; } } } } while (0)

struct XcdBarrier {
    unsigned* bar; unsigned x;
    volatile LAS unsigned* st;
};

__device__ __forceinline__ XcdBarrier xcd_barrier_post(unsigned* bar, volatile LAS unsigned* st, const int tid) {
    XcdBarrier b; b.bar = bar; b.x = xb_xcc_id(); b.st = st;
    if (tid == 0) (void)xb_add(&bar[XB_XCNT(b.x)], 1u);
    return b;
}
__device__ __forceinline__ void xcd_barrier_complete(unsigned* bar, unsigned x, unsigned& nloc, unsigned& nx) {
    const unsigned G = gridDim.x * gridDim.y * gridDim.z;
    unsigned sum, cnt, mine, sp = 0u;
    for (;;) {
        sum = 0u; cnt = 0u; mine = 0u;
#pragma unroll
        for (unsigned j = 0; j < 16; ++j) { const unsigned c = xb_ld(&bar[XB_XCNT(j)]); sum += c; cnt += (c > 0u) ? 1u : 0u; mine = (j == x) ? c : mine; }
        if (sum == G) break;
        __builtin_amdgcn_s_sleep(1);
        if ((++sp & 255u) == 0u) { if (xb_ld(&bar[XB_TMO])) break; if (sp > XB_SPIN_CAP) { atomicAdd(&bar[XB_TMO], 1u); break; } }
    }
    nloc = mine > 0u ? mine : 1u; nx = cnt > 0u ? cnt : 1u;
}

__device__ __forceinline__ void xcd_barrier(const XcdBarrier& b, const int tid) {
    asm volatile("s_waitcnt vmcnt(0)" ::: "memory");
    __syncthreads();
    if (tid == 0) {
        unsigned* bar = b.bar;
        __builtin_amdgcn_s_waitcnt(0);
        unsigned nloc = b.st[0], nx = b.st[1];
        if (nloc == 0u) { xcd_barrier_complete(bar, b.x, nloc, nx); b.st[0] = nloc; b.st[1] = nx; }
        const unsigned old = xb_add(&bar[XB_XSUB(b.x)], 1u);
        const unsigned gen = old / nloc;
        if (old + 1u == (gen + 1u) * nloc) {
            __builtin_amdgcn_fence(__ATOMIC_RELEASE, "agent");
            asm volatile("s_waitcnt vmcnt(0)" ::: "memory");
            const unsigned og = xb_add(&bar[XB_TOP], 1u);
            const unsigned tg = og / nx;
            if (og + 1u == (tg + 1u) * nx) xb_add(&bar[XB_TOPGEN], 1u);
            else XB_SPIN(xb_ld(&bar[XB_TOPGEN]) == tg, bar);
            __builtin_amdgcn_fence(__ATOMIC_ACQUIRE, "agent");
            xb_add(&bar[XB_XGEN(b.x)], 1u);
            asm volatile("s_waitcnt vmcnt(0)" ::: "memory");
        } else {
            XB_SPIN(xb_ld(&bar[XB_XGEN(b.x)]) == gen, bar);
            __builtin_amdgcn_fence(__ATOMIC_ACQUIRE, "agent");
            asm volatile("s_waitcnt vmcnt(0)" ::: "memory");
        }
    }
    __syncthreads();
}

enum { I_XP = 0, I_XS, I_CK, I_CV, I_SPOOL, I_SDNC, I_SDNS, I_SSSC, I_SSSH, I_PT, I_NMPRE, I_NMPOST, I_NLPRE, I_NLPOST, I_WIN, I_POOLW, I_POOLSC, I_DNCW, I_DNALOG, I_DNDTB, I_DNNW, I_SBBIAS,
       I_SSCW, I_SSCB, I_SSALOG, I_SSDTB, I_SSD, I_SSNW, I_WBR, I_WOUT, I_WUP, I_WDN, N_IN };
struct Args { const void* in[N_IN]; float* out; unsigned char* ws; int ph_lo, ph_hi, li, pad; };
#define IN_F(i) ((const float*)A->in[i])
#define WSP(T, off) ((T*)(A->ws + (off)))
typedef const __attribute__((opencl_constant)) Args* CA;
__device__ __forceinline__ CA args_opaque() { auto p = __builtin_amdgcn_kernarg_segment_ptr(); asm volatile("" : "+s"(p)); return (CA)p; }

struct EpiIn {
    static constexpr bool PERM = true, AFTER_DRAIN = false, KEEP_ACC = false;
    float* UF; bf16* QKV; bf16* GATE; float *kp, *vp, *ks, *vs; float qscale;
    __device__ __forceinline__ void operator()(f32x4 (&acc)[2][2][4][2], const pg8::Unit& u, int wr, int wc, int fr, int fq) const {
        const int pn = u.pn, row0 = u.pm * 256 + wr * 64 + fr, cl = wc * 32 + 8 * fq;
        if (pn < 10 || (pn >= 16 && pn < 26) || pn == 58) {
            const int col0 = pn * 256 + (pn < 10 ? 0 : (pn < 26 ? -1536 : -9728)) + cl;
#pragma unroll
            for (int ai = 0; ai < 2; ++ai)
#pragma unroll
                for (int m = 0; m < 4; ++m) { float* rowp = UF + (size_t)(row0 + ai * 128 + m * 16) * UFW + col0;
#pragma unroll
                    for (int bj = 0; bj < 2; ++bj) { *(f32x4*)(rowp + bj * 128) = acc[ai][bj][m][0]; *(f32x4*)(rowp + bj * 128 + 4) = acc[ai][bj][m][1]; } }
        } else if (pn < 16) {
            const int which = (pn - 10) >> 1, c512 = ((pn - 10) & 1) * 256 + cl; const float sc = which == 0 ? qscale : 1.f;
#pragma unroll
            for (int ai = 0; ai < 2; ++ai)
#pragma unroll
                for (int m = 0; m < 4; ++m) { const int r = row0 + ai * 128 + m * 16; bf16* rowp = QKV + (size_t)r * 1536 + which * 512 + c512;
                    float* fo = nullptr;
                    if (which) { if (r < TP) fo = (which == 1 ? kp : vp) + (size_t)r * 512 + c512; else if (r < TT) fo = (which == 1 ? ks : vs) + (size_t)(r - TP) * 512 + c512; }
#pragma unroll
                    for (int bj = 0; bj < 2; ++bj) { const f32x4 v0 = acc[ai][bj][m][0], v1 = acc[ai][bj][m][1];
                        v4u w; w.x = pk2(v0[0] * sc, v0[1] * sc); w.y = pk2(v0[2] * sc, v0[3] * sc); w.z = pk2(v1[0] * sc, v1[1] * sc); w.w = pk2(v1[2] * sc, v1[3] * sc);
                        *(v4u*)(rowp + bj * 128) = w;
                        if (fo) { *(f32x4*)(fo + bj * 128) = v0; *(f32x4*)(fo + bj * 128 + 4) = v1; } } }
        } else {
            const int oc = (pn - 26) * 64 + wc * 16 + 4 * fq;
#pragma unroll
            for (int ai = 0; ai < 2; ++ai)
#pragma unroll
                for (int m = 0; m < 4; ++m) { const int r = row0 + ai * 128 + m * 16; bf16* rowp = GATE + (size_t)r * 8192 + oc;
                    f32x4 t[4];
#pragma unroll
                    for (int i = 0; i < 4; ++i)
#pragma unroll
                        for (int e = 0; e < 4; ++e) t[i][e] = 1.0f + fexp(-fminf(fmaxf(acc[ai][i >> 1][m][i & 1][e], -30.f), 30.f));
                    f32x4 o[4];
                    if (r < TP) {
#pragma unroll
                        for (int e = 0; e < 4; ++e) { const float i0 = __builtin_amdgcn_rcpf(t[0][e]), i1 = __builtin_amdgcn_rcpf(t[1][e]), i2 = __builtin_amdgcn_rcpf(t[2][e]), i3 = __builtin_amdgcn_rcpf(t[3][e]);
                            o[0][e] = t[1][e] * i0; o[1][e] = t[2][e] * i1; o[2][e] = t[3][e] * i2; o[3][e] = i3; }
                    } else {
#pragma unroll
                        for (int i = 0; i < 4; ++i)
#pragma unroll
                            for (int e = 0; e < 4; ++e) o[i][e] = __builtin_amdgcn_rcpf(t[i][e]);
                    }
#pragma unroll
                    for (int i = 0; i < 4; ++i) { v2u w; w.x = pk2(o[i][0], o[i][1]); w.y = pk2(o[i][2], o[i][3]); *(v2u*)(rowp + i * 2048) = w; } }
        }
    }
};
struct EpiMergeR {
    static constexpr bool PERM = true, AFTER_DRAIN = false, KEEP_ACC = true;
    const bf16* GATE; const float* RS; bf16* MGB;
    __device__ __forceinline__ void operator()(f32x4 (&acc)[2][2][4][2], const pg8::Unit& u, int wr, int wc, int fr, int fq) const {
        const unsigned row0 = (unsigned)(u.pm * 256 + wr * 64 + fr), col0 = (unsigned)(u.pn * 256 + wc * 32 + 8 * fq); const int seg = u.seg;
        const unsigned gofs = row0 * 8192u + (seg < 3 ? seg : 3) * 2048u + col0, oofs = row0 * 2048u + col0; const bool last = seg == 4;
        const float w2 = seg == 2 ? 1.f : 0.f, w3 = seg == 3 ? 1.f : 0.f, w4 = last ? 1.f : 0.f, w0 = 1.f - w2 - w3 - w4, ug = 1.f - w3;
#pragma unroll
        for (int ai = 0; ai < 2; ++ai)
#pragma unroll
            for (int m = 0; m < 4; ++m) { const unsigned rr = ai * 128 + m * 16; const f32x2 qq = *(const f32x2*)(RS + (row0 + rr) * 2u);
                const float r1 = __builtin_amdgcn_rsqf(qq[1]), rf = w0 + w2 * __builtin_amdgcn_sqrtf(qq[0]) + w3 * (__builtin_amdgcn_sqrtf(qq[1]) * __builtin_amdgcn_rsqf(qq[0])) + w4 * r1, rg = rf * ug, rc = rf * w3;
#pragma unroll
                for (int bj = 0; bj < 2; ++bj) { const v4u gg = *(const v4u*)(GATE + (gofs + rr * 8192u + bj * 128u));
                    f32x4& v0 = acc[ai][bj][m][0]; f32x4& v1 = acc[ai][bj][m][1];
                    v0[0] *= bflo(gg.x) * rg + rc; v0[1] *= bfhi(gg.x) * rg + rc; v0[2] *= bflo(gg.y) * rg + rc; v0[3] *= bfhi(gg.y) * rg + rc;
                    v1[0] *= bflo(gg.z) * rg + rc; v1[1] *= bfhi(gg.z) * rg + rc; v1[2] *= bflo(gg.w) * rg + rc; v1[3] *= bfhi(gg.w) * rg + rc;
                    if (last) { v4u w; w.x = pk2(v0[0], v0[1]); w.y = pk2(v0[2], v0[3]); w.z = pk2(v1[0], v1[1]); w.w = pk2(v1[2], v1[3]); *(v4u*)(MGB + (oofs + rr * 2048u + bj * 128u)) = w; } }
                asm volatile("" ::: "memory"); }
    }
};
struct EpiF32 {
    static constexpr bool PERM = true, AFTER_DRAIN = false, KEEP_ACC = false;
    float* C; int ldc;
    __device__ __forceinline__ void operator()(f32x4 (&acc)[2][2][4][2], const pg8::Unit& u, int wr, int wc, int fr, int fq) const {
        const int row0 = u.pm * 256 + wr * 64 + fr, col0 = u.pn * 256 + wc * 32 + 8 * fq;
#pragma unroll
        for (int ai = 0; ai < 2; ++ai)
#pragma unroll
            for (int m = 0; m < 4; ++m) { float* rowp = C + (size_t)(row0 + ai * 128 + m * 16) * ldc + col0;
#pragma unroll
                for (int bj = 0; bj < 2; ++bj) { *(f32x4*)(rowp + bj * 128) = acc[ai][bj][m][0]; *(f32x4*)(rowp + bj * 128 + 4) = acc[ai][bj][m][1]; } }
    }
};
struct EpiRelu2 {
    static constexpr bool PERM = true, AFTER_DRAIN = false, KEEP_ACC = false;
    bf16* O; int ldc;
    __device__ __forceinline__ void operator()(f32x4 (&acc)[2][2][4][2], const pg8::Unit& u, int wr, int wc, int fr, int fq) const {
        const int row0 = u.pm * 256 + wr * 64 + fr, col0 = u.pn * 256 + wc * 32 + 8 * fq;
#pragma unroll
        for (int ai = 0; ai < 2; ++ai)
#pragma unroll
            for (int m = 0; m < 4; ++m) { bf16* rowp = O + (size_t)(row0 + ai * 128 + m * 16) * ldc + col0;
#pragma unroll
                for (int bj = 0; bj < 2; ++bj) { f32x4 v0 = acc[ai][bj][m][0], v1 = acc[ai][bj][m][1];
#pragma unroll
                    for (int e = 0; e < 4; ++e) { const float a = fmaxf(v0[e], 0.f), b = fmaxf(v1[e], 0.f); v0[e] = a * a; v1[e] = b * b; }
                    v4u w; w.x = pk2(v0[0], v0[1]); w.y = pk2(v0[2], v0[3]); w.z = pk2(v1[0], v1[1]); w.w = pk2(v1[2], v1[3]); *(v4u*)(rowp + bj * 128) = w; } }
    }
};

__device__ __forceinline__ int win_src_col(int n) {
    if (n < 2560) return n;
    if (n < 6656) return n + 8;
    if (n < 14848) { const int t = n - 6656, pg = t >> 8, c = t & 255;
        return 6680 + (2 * (c >> 7) + ((c >> 2) & 1)) * 2048 + 64 * pg + 16 * ((c >> 5) & 3) + 4 * ((c >> 3) & 3) + (c & 3); }
    if (n < 14856) return n - 14848 + 2560;
    if (n < 14872) return n - 14856 + 6664;
    return -1;
}
template <int MODE>
__device__ __forceinline__ void transpose_item(const float* W, int ldw, int K, bf16* WT, int n0, int k0, const float* kscale, LAS float* scr, int lane) {
    const int n = n0 + (lane & 31); const int sc = MODE ? win_src_col(n) : n;
#pragma unroll 8
    for (int i = 0; i < 32; ++i) { const int kk = 2 * i + (lane >> 5); float v = sc >= 0 ? W[(size_t)(k0 + kk) * ldw + sc] : 0.f; if (kscale) v *= kscale[k0 + kk]; scr[kk * 33 + (lane & 31)] = v; }
    asm volatile("s_waitcnt lgkmcnt(0)" ::: "memory");
    const int c = lane & 7;
#pragma unroll
    for (int j = 0; j < 4; ++j) { const int nn = (lane >> 3) + 8 * j; const LAS float* s = scr + (8 * c) * 33 + nn;
        v4u o; o.x = pk2(s[0 * 33], s[1 * 33]); o.y = pk2(s[2 * 33], s[3 * 33]); o.z = pk2(s[4 * 33], s[5 * 33]); o.w = pk2(s[6 * 33], s[7 * 33]);
        *(v4u*)(WT + (size_t)(n0 + nn) * K + k0 + 8 * c) = o; }
    asm volatile("s_waitcnt lgkmcnt(0)" ::: "memory");
}
__device__ __forceinline__ void p0_prologue(CA A, LAS unsigned char* lds, const int wv) {
    const int tid = tid_opaque(wv), lane = tid & 63, wave = tid >> 6, G = gridDim.x;
    LAS float* scr = (LAS float*)(lds + wave * 8704);
    const int gw = blk_opaque() * NWAVES + wave, NGW = G * NWAVES;
    constexpr int I_IN = (NIN / 32) * (DM / 64), I_BR = (DM / 32) * (512 / 64), I_OUT = (DM / 32) * (DM / 64), I_UP = (DFF / 32) * (DM / 64), I_DN = (DM / 32) * (DFF / 64);
    constexpr int PER_LAYER = I_IN + 4 * I_BR + I_OUT + I_UP + I_DN;
    for (int it = gw; it < 2 * PER_LAYER; it += NGW) {
        const int L = it / PER_LAYER; int r = it % PER_LAYER;
        if (r < I_IN) { const int nb = r % (NIN / 32), kb = r / (NIN / 32);
            transpose_item<1>(IN_F(I_WIN) + (size_t)L * DM * INCOLS, INCOLS, DM, WSP(bf16, WS_WIN) + (size_t)L * NIN * DM, nb * 32, kb * 64, nullptr, scr, lane); continue; }
        r -= I_IN;
        if (r < 4 * I_BR) { const int s = 1 + r / I_BR, q = r % I_BR, nb = q % (DM / 32), kb = q / (DM / 32);
            transpose_item<0>(IN_F(I_WBR) + ((size_t)L * 2560 + 512 * s) * DM, DM, OBW, WSP(bf16, WS_WBR) + (size_t)L * DM * OBW + 512 * s, nb * 32, kb * 64,
                              s >= 3 ? IN_F(I_SSNW) + L * 1024 + (s - 3) * 512 : nullptr, scr, lane); continue; }
        r -= 4 * I_BR;
        if (r < I_OUT) { const int nb = r % (DM / 32), kb = r / (DM / 32);
            transpose_item<0>(IN_F(I_WOUT) + (size_t)L * DM * DM, DM, DM, WSP(bf16, WS_WOUT) + (size_t)L * DM * DM, nb * 32, kb * 64, nullptr, scr, lane); continue; }
        r -= I_OUT;
        if (r < I_UP) { const int nb = r % (DFF / 32), kb = r / (DFF / 32);
            transpose_item<0>(IN_F(I_WUP) + (size_t)L * DM * DFF, DFF, DM, WSP(bf16, WS_WUP) + (size_t)L * DFF * DM, nb * 32, kb * 64, nullptr, scr, lane); continue; }
        r -= I_UP;
        { const int nb = r % (DM / 32), kb = r / (DM / 32);
            transpose_item<0>(IN_F(I_WDN) + (size_t)L * DFF * DM, DM, DFF, WSP(bf16, WS_WDN) + (size_t)L * DM * DFF, nb * 32, kb * 64, nullptr, scr, lane); }
    }
    for (int idx = blk_opaque() * NTHR + tid; idx < 2 * DM * 64; idx += G * NTHR) {
        const int L = idx / (DM * 64), q = idx % (DM * 64), n = q & (DM - 1), kc = q >> 11, k0 = kc * 8, g = k0 >> 7, c0 = k0 & 127;
        const float* pw = IN_F(I_POOLW) + ((size_t)(L * 4 + g) * 128 + c0) * 128; const float* psc = IN_F(I_POOLSC) + L * 512 + g * 128;
        const float* wb = IN_F(I_WBR) + ((size_t)L * 2560 + g * 128) * DM + n;
        float acc[8] = {0.f, 0.f, 0.f, 0.f, 0.f, 0.f, 0.f, 0.f};
        for (int d = 0; d < 128; ++d) { const float wv = wb[(size_t)d * DM] * psc[d];
#pragma unroll
            for (int i = 0; i < 8; ++i) acc[i] += pw[i * 128 + d] * wv; }
        v4u o; o.x = pk2(acc[0], acc[1]); o.y = pk2(acc[2], acc[3]); o.z = pk2(acc[4], acc[5]); o.w = pk2(acc[6], acc[7]);
        *(v4u*)(WSP(bf16, WS_WBR) + (size_t)L * DM * OBW + (size_t)n * OBW + k0) = o;
    }
}

__device__ __forceinline__ const float* xin_row(CA A, int m) { return m < TP ? IN_F(I_XP) + (size_t)m * DM : IN_F(I_XS) + (size_t)(m - TP) * DM; }
__device__ __forceinline__ void store_bf16_row(bf16* orow, const f32x4 (&v)[8], float rstd, const float* g, int lane) {
#pragma unroll
    for (int j = 0; j < 8; ++j) { const f32x4 gj = ((const f32x4*)g)[lane + 64 * j]; const f32x4 o = v[j] * rstd * gj;
        v2u w; w.x = pk2(o[0], o[1]); w.y = pk2(o[2], o[3]); ((v2u*)orow)[lane + 64 * j] = w; }
}
__device__ __forceinline__ void norm1_phase(CA A, const int wv) {
    const int tid = tid_opaque(wv), lane = tid & 63, gw = blk_opaque() * NWAVES + (tid >> 6), NGW = gridDim.x * NWAVES;
    bf16* H = WSP(bf16, WS_H);
    for (int m = gw; m < MP; m += NGW) {
        if (m >= TT) { for (int j = 0; j < 8; ++j) ((v2u*)(H + (size_t)m * DM))[lane + 64 * j] = (v2u){0u, 0u}; continue; }
        const f32x4* xr = (const f32x4*)xin_row(A, m); f32x4 v[8]; float s = 0.f;
#pragma unroll
        for (int j = 0; j < 8; ++j) { v[j] = xr[lane + 64 * j]; s += (v[j][0] * v[j][0] + v[j][1] * v[j][1]) + (v[j][2] * v[j][2] + v[j][3] * v[j][3]); }
        const float rstd = 1.0f / sqrtf(wave_sum(s) * (1.0f / DM) + RMS_EPS);
        store_bf16_row(H + (size_t)m * DM, v, rstd, IN_F(I_NMPRE), lane);
    }
}
__device__ __forceinline__ void resid_phase(CA A, const float* Y, const float* PS, const float* gpost, const float* gnext, bool from_input, const int wv) {
    const int tid = tid_opaque(wv), lane = tid & 63, gw = blk_opaque() * NWAVES + (tid >> 6), NGW = gridDim.x * NWAVES;
    bf16* H = WSP(bf16, WS_H);
    for (int m = gw; m < TT; m += NGW) {
        const f32x4* yr = (const f32x4*)(Y + (size_t)m * DM); const f32x4* xr = from_input ? (const f32x4*)xin_row(A, m) : (const f32x4*)(A->out + O_Y + (size_t)m * DM);
        f32x4 v[8]; float s = 0.f;
        if (m < TP) {
#pragma unroll
            for (int j = 0; j < 8; ++j) v[j] = yr[lane + 64 * j];
        } else {
#pragma unroll
            for (int j = 0; j < 8; ++j) v[j] = (f32x4){0.f, 0.f, 0.f, 0.f};
            for (int sp = 0; sp < 16; ++sp) { const f32x4* pr = (const f32x4*)(PS + ((size_t)sp * TS + (m - TP)) * DM);
#pragma unroll
                for (int j = 0; j < 8; ++j) v[j] += pr[lane + 64 * j]; }
        }
#pragma unroll
        for (int j = 0; j < 8; ++j) s += (v[j][0] * v[j][0] + v[j][1] * v[j][1]) + (v[j][2] * v[j][2] + v[j][3] * v[j][3]);
        const float rstd = 1.0f / sqrtf(wave_sum(s) * (1.0f / DM) + RMS_EPS); float s2 = 0.f;
        f32x4* orow = (f32x4*)(A->out + O_Y + (size_t)m * DM);
#pragma unroll
        for (int j = 0; j < 8; ++j) { const f32x4 gj = ((const f32x4*)gpost)[lane + 64 * j]; v[j] = xr[lane + 64 * j] + v[j] * rstd * gj; orow[lane + 64 * j] = v[j];
            s2 += (v[j][0] * v[j][0] + v[j][1] * v[j][1]) + (v[j][2] * v[j][2] + v[j][3] * v[j][3]); }
        if (gnext) { const float rstd2 = 1.0f / sqrtf(wave_sum(s2) * (1.0f / DM) + RMS_EPS); store_bf16_row(H + (size_t)m * DM, v, rstd2, gnext, lane); }
    }
}

__device__ __forceinline__ float conv_tap(const float* UF, const float* state, int row, int j, int ucol, int c) {
    if (row < TP) { const int t = row & (SEQ - 1); return (t - 3 + j) >= 0 ? UF[(size_t)(row - 3 + j) * UFW + ucol + c] : 0.f; }
    const int s = row - TP, sb = s >> 2, e = (s & 3) + j;
    return e < 3 ? state[(size_t)(sb * 3 + e) * 1536 + c] : UF[(size_t)(TP + sb * 4 + e - 3) * UFW + ucol + c];
}
__device__ __forceinline__ void prep_phase(CA A, int layer, const int wv) {
    const int tid = tid_opaque(wv), lane = tid & 63, G = gridDim.x, gt = blk_opaque() * NTHR + tid, NGT = G * NTHR, gw = blk_opaque() * NWAVES + (tid >> 6), NGW = G * NWAVES;
    const float* UF = WSP(float, WS_UF); float* SC = WSP(float, WS_SCAL);
    for (int idx = gt; idx < TT * 24; idx += NGT) { const int row = idx / 24, j = idx % 24; const float u = UF[(size_t)row * UFW + UF_SMALL + j]; float r;
        if (j < 4) r = sigmoidf_(u);
        else if (j < 8) r = -fexp(IN_F(I_DNALOG)[layer * 4 + j - 4]) * softplusf_(u + IN_F(I_DNDTB)[layer * 4 + j - 4]);
        else r = softplusf_(u + IN_F(I_SSDTB)[layer * 16 + j - 8]);
        SC[(size_t)row * 32 + j] = r; }
    { bf16* O0 = WSP(bf16, WS_OBR); const float* spool = IN_F(I_SPOOL) + (size_t)layer * DBATCH * 15 * 512;
      for (int it = gw; it < (TP / 64 + DBATCH) * 4; it += NGW) { const int gi = it & 3, sc = it >> 2, w = 2 << gi, ch = gi * 128 + lane;
          if (sc < TP / 64) { const int row0 = sc * 64, t0 = row0 & (SEQ - 1); float s0 = 0.f, s1 = 0.f;
              for (int j = 1; j < w; ++j) if (t0 - j >= 0) { s0 += UF[(size_t)(row0 - j) * UFW + ch]; s1 += UF[(size_t)(row0 - j) * UFW + ch + 64]; }
#pragma unroll 8
              for (int i = 0; i < 64; ++i) { const int row = row0 + i, t = t0 + i; const float u0 = UF[(size_t)row * UFW + ch], u1 = UF[(size_t)row * UFW + ch + 64];
                  s0 += u0; s1 += u1; const float inv = 1.0f / (float)((t + 1) < w ? (t + 1) : w);
                  O0[(size_t)row * OBW + ch] = (bf16)f2bf(s0 * inv - u0); O0[(size_t)row * OBW + ch + 64] = (bf16)f2bf(s1 * inv - u1);
                  if (t - w + 1 >= 0) { s0 -= UF[(size_t)(row - w + 1) * UFW + ch]; s1 -= UF[(size_t)(row - w + 1) * UFW + ch + 64]; } } }
          else { const int sb = sc - TP / 64; const float inv = 1.0f / (float)w;
              for (int i = 0; i < DSEQ; ++i) { const int row = TP + sb * 4 + i, e = 15 + i; float s0 = 0.f, s1 = 0.f;
                  for (int j = 0; j < w; ++j) { const int ee = e - j; const float* src = ee < 15 ? spool + (size_t)(sb * 15 + ee) * 512 + ch : UF + (size_t)(TP + sb * 4 + ee - 15) * UFW + ch; s0 += src[0]; s1 += src[64]; }
                  O0[(size_t)row * OBW + ch] = (bf16)f2bf(s0 * inv - UF[(size_t)row * UFW + ch]); O0[(size_t)row * OBW + ch + 64] = (bf16)f2bf(s1 * inv - UF[(size_t)row * UFW + ch + 64]); } } } }
    for (int it = gw; it < (TP / 64 + DBATCH) * 24; it += NGW) { const int grp = it % 12, strm = (it / 12) & 1, sc = it / 24, c0 = grp * 128 + lane;
        const int ucol = strm ? UF_XBC : UF_DNQKV; float* OUTB = strm ? WSP(float, WS_XBC) : WSP(float, WS_DNQ);
        const float* cw = (strm ? IN_F(I_SSCW) : IN_F(I_DNCW)) + (size_t)layer * 4 * 1536; const float* st = (strm ? IN_F(I_SSSC) : IN_F(I_SDNC)) + (size_t)layer * DBATCH * 3 * 1536;
        const float wa0 = cw[c0], wa1 = cw[1536 + c0], wa2 = cw[3072 + c0], wa3 = cw[4608 + c0], wb0 = cw[c0 + 64], wb1 = cw[1536 + c0 + 64], wb2 = cw[3072 + c0 + 64], wb3 = cw[4608 + c0 + 64];
        const float ba = strm ? IN_F(I_SSCB)[layer * 1536 + c0] : 0.f, bb = strm ? IN_F(I_SSCB)[layer * 1536 + c0 + 64] : 0.f;
        const bool nrm = (strm == 0) && grp < 8; const float qs = grp < 4 ? 0.08838834764831845f : 1.0f;
        float ha0, ha1, ha2, hb0, hb1, hb2; int row0, n;
        if (sc < TP / 64) { row0 = sc * 64; n = 64; const int t0 = row0 & (SEQ - 1);
            if (t0 == 0) { ha0 = ha1 = ha2 = hb0 = hb1 = hb2 = 0.f; }
            else { const float* p = UF + (size_t)(row0 - 3) * UFW + ucol + c0; ha0 = p[0]; hb0 = p[64]; ha1 = p[UFW]; hb1 = p[UFW + 64]; ha2 = p[2 * UFW]; hb2 = p[2 * UFW + 64]; } }
        else { const int sb = sc - TP / 64; row0 = TP + sb * 4; n = DSEQ; const float* p = st + (size_t)(sb * 3) * 1536 + c0; ha0 = p[0]; hb0 = p[64]; ha1 = p[1536]; hb1 = p[1536 + 64]; ha2 = p[3072]; hb2 = p[3072 + 64]; }
#pragma unroll 8
        for (int i = 0; i < n; ++i) { const float* p = UF + (size_t)(row0 + i) * UFW + ucol + c0; const float ua = p[0], ub = p[64];
            float a = siluf_(ba + wa0 * ha0 + wa1 * ha1 + wa2 * ha2 + wa3 * ua), b = siluf_(bb + wb0 * hb0 + wb1 * hb1 + wb2 * hb2 + wb3 * ub);
            ha0 = ha1; ha1 = ha2; ha2 = ua; hb0 = hb1; hb1 = hb2; hb2 = ub;
            if (nrm) { const float rs = row16_sum(a * a + b * b);
                const float tot = (__builtin_bit_cast(float, __builtin_amdgcn_readlane(__builtin_bit_cast(int, rs), 0)) + __builtin_bit_cast(float, __builtin_amdgcn_readlane(__builtin_bit_cast(int, rs), 16)))
                                + (__builtin_bit_cast(float, __builtin_amdgcn_readlane(__builtin_bit_cast(int, rs), 32)) + __builtin_bit_cast(float, __builtin_amdgcn_readlane(__builtin_bit_cast(int, rs), 48)));
                const float sc2 = qs / sqrtf(tot + 1e-6f); a *= sc2; b *= sc2; }
            float* o = OUTB + (size_t)(row0 + i) * 1536 + c0; o[0] = a; o[64] = b; } }
    for (int idx = gt; idx < NBATCH * 3 * 1536; idx += NGT) { const int b = idx / (3 * 1536), q = idx % (3 * 1536), j = q / 1536, c = q % 1536; const size_t src = (size_t)(b * SEQ + SEQ - 3 + j) * UFW;
        A->out[O_DNCP + (size_t)layer * NBATCH * 3 * 1536 + idx] = UF[src + UF_DNQKV + c]; A->out[O_SSCP + (size_t)layer * NBATCH * 3 * 1536 + idx] = UF[src + UF_XBC + c]; }
    for (int idx = gt; idx < DBATCH * 3 * 1536; idx += NGT) { const int sb = idx / (3 * 1536), q = idx % (3 * 1536), j = q / 1536, c = q % 1536; const size_t src = (size_t)(TP + sb * 4 + 1 + j) * UFW;
        A->out[O_DNCS + (size_t)layer * DBATCH * 3 * 1536 + idx] = UF[src + UF_DNQKV + c]; A->out[O_SSCS + (size_t)layer * DBATCH * 3 * 1536 + idx] = UF[src + UF_XBC + c]; }
    for (int idx = gt; idx < NBATCH * 15 * 512; idx += NGT) { const int b = idx / (15 * 512), q = idx % (15 * 512), j = q >> 9, ch = q & 511;
        A->out[O_POOLP + (size_t)layer * NBATCH * 15 * 512 + idx] = UF[(size_t)(b * SEQ + SEQ - 15 + j) * UFW + ch]; }
    { const float* spool = IN_F(I_SPOOL) + (size_t)layer * DBATCH * 15 * 512;
      for (int idx = gt; idx < DBATCH * 15 * 512; idx += NGT) { const int sb = idx / (15 * 512), q = idx % (15 * 512), j = q >> 9, ch = q & 511, e = 4 + j;
          A->out[O_POOLS + (size_t)layer * DBATCH * 15 * 512 + idx] = e < 15 ? spool[(size_t)(sb * 15 + e) * 512 + ch] : UF[(size_t)(TP + sb * 4 + e - 15) * UFW + ch]; } }
}

__device__ __forceinline__ void dn_seq(CA A, LAS unsigned char* lds, int layer, int unit, const int wv) {
    const int tid = tid_opaque(wv), lane = tid & 63, wid = tid >> 6, v = tid & 127, kq = tid >> 7;
    int row0, L, h; const float* s0 = nullptr; float* sout;
    if (unit < 16) { const int b = unit >> 2; h = unit & 3; row0 = b * SEQ; L = SEQ; sout = A->out + O_DNSP + ((size_t)(layer * NBATCH + b) * 4 + h) * 16384; }
    else { const int u = unit - 16, sb = u >> 2; h = u & 3; row0 = TP + sb * 4; L = DSEQ; s0 = IN_F(I_SDNS) + ((size_t)(layer * DBATCH + sb) * 4 + h) * 16384; sout = A->out + O_DNSS + ((size_t)(layer * DBATCH + sb) * 4 + h) * 16384; }
    constexpr int CH = 32;
    LAS float* qs = (LAS float*)lds; LAS float* ks = qs + CH * 128; LAS float* vs = ks + CH * 128; LAS float* ob = vs + CH * 128;
    LAS float* red = ob + CH * 128;
    LAS float* egs = red + 2 * 2 * 4 * 128; LAS float* bts = egs + CH; LAS float* kqd = bts + CH;
    const float* DNQ = WSP(float, WS_DNQ); const float* SC = WSP(float, WS_SCAL); const float* UF = WSP(float, WS_UF); bf16* O1 = WSP(bf16, WS_OBR) + 512;
    const float* nw = IN_F(I_DNNW) + layer * 128;
    float S[32];
#pragma unroll
    for (int i = 0; i < 32; ++i) S[i] = s0 ? s0[(size_t)(32 * kq + i) * 128 + v] : 0.f;
    for (int c0 = 0; c0 < L; c0 += CH) {
        const int n = (L - c0) < CH ? (L - c0) : CH;
        __syncthreads();
        for (int idx = tid; idx < n * 128; idx += NTHR) { const int t = idx >> 7, c = idx & 127; const float* src = DNQ + (size_t)(row0 + c0 + t) * 1536 + h * 128 + c;
            qs[idx] = src[0]; ks[idx] = src[512]; vs[idx] = src[1024]; }
        if (tid < n) { const float* sc = SC + (size_t)(row0 + c0 + tid) * 32; bts[tid] = sc[h]; egs[tid] = fexp(sc[4 + h]); }
        __syncthreads();
        for (int t = wid; t < n; t += NWAVES) { const float s = wave_sum(ks[t * 128 + lane] * qs[t * 128 + lane] + ks[t * 128 + 64 + lane] * qs[t * 128 + 64 + lane]); if (lane == 0) kqd[t] = s; }
        __syncthreads();
        for (int t = 0; t < n; ++t) {
            const float eg = egs[t], bt = bts[t]; float kk[32]; float r = 0.f, pp = 0.f;
#pragma unroll
            for (int i4 = 0; i4 < 8; ++i4) { const f32x4 k4 = *(const LAS f32x4*)(ks + t * 128 + 32 * kq + 4 * i4), q4 = *(const LAS f32x4*)(qs + t * 128 + 32 * kq + 4 * i4);
#pragma unroll
                for (int e = 0; e < 4; ++e) { const int i = 4 * i4 + e; S[i] *= eg; kk[i] = k4[e]; r += S[i] * k4[e]; pp += S[i] * q4[e]; } }
            LAS float* rd = red + (t & 1) * 1024;
            rd[kq * 128 + v] = r; rd[512 + kq * 128 + v] = pp;
            __syncthreads();
            const float rt = (rd[v] + rd[128 + v]) + (rd[256 + v] + rd[384 + v]), pt = (rd[512 + v] + rd[640 + v]) + (rd[768 + v] + rd[896 + v]);
            const float dd = bt * (vs[t * 128 + v] - rt);
#pragma unroll
            for (int i = 0; i < 32; ++i) S[i] += kk[i] * dd;
            if (kq == 0) ob[t * 128 + v] = pt + kqd[t] * dd;
        }
        __syncthreads();
        for (int t = wid; t < n; t += NWAVES) { const int row = row0 + c0 + t; const float o0 = ob[t * 128 + lane], o1 = ob[t * 128 + 64 + lane];
            const float rstd = 1.0f / sqrtf(wave_sum(o0 * o0 + o1 * o1) * (1.0f / 128.0f) + RMS_EPS);
            const float z0 = UF[(size_t)row * UFW + UF_DNZ + h * 128 + lane], z1 = UF[(size_t)row * UFW + UF_DNZ + h * 128 + 64 + lane];
            O1[(size_t)row * OBW + h * 128 + lane] = (bf16)f2bf(o0 * rstd * nw[lane] * siluf_(z0)); O1[(size_t)row * OBW + h * 128 + 64 + lane] = (bf16)f2bf(o1 * rstd * nw[64 + lane] * siluf_(z1)); }
    }
#pragma unroll
    for (int i = 0; i < 32; ++i) sout[(size_t)(32 * kq + i) * 128 + v] = S[i];
    __syncthreads();
}

__device__ __forceinline__ void ssd_seq(CA A, LAS unsigned char* lds, int layer, int unit, const int wv) {
    const int tid = tid_opaque(wv), lane = tid & 63, wid = tid >> 6, p = tid >> 3, nq = tid & 7;
    int row0, L, hd; const float* h0 = nullptr; float* hout;
    if (unit < 64) { const int b = unit >> 4; hd = unit & 15; row0 = b * SEQ; L = SEQ; hout = A->out + O_SSHP + ((size_t)(layer * NBATCH + b) * 16 + hd) * 8192; }
    else { const int u = unit - 64, sb = u >> 4; hd = u & 15; row0 = TP + sb * 4; L = DSEQ; h0 = IN_F(I_SSSH) + ((size_t)(layer * DBATCH + sb) * 16 + hd) * 8192; hout = A->out + O_SSHS + ((size_t)(layer * DBATCH + sb) * 16 + hd) * 8192; }
    const int g = hd >> 3; constexpr int CH = 64;
    LAS float* Bs = (LAS float*)lds; LAS float* Cs = Bs + CH * 128; LAS float* xs = Cs + CH * 128; LAS float* yb = xs + CH * 64; LAS float* dts = yb + CH * 64;
    const float* XBC = WSP(float, WS_XBC); const float* SC = WSP(float, WS_SCAL); const float* UF = WSP(float, WS_UF); float* SSQ = WSP(float, WS_SSQ);
    bf16* Og = WSP(bf16, WS_OBR) + (3 + g) * 512;
    const float a = -fexp(IN_F(I_SSALOG)[layer * 16 + hd]), Dk = IN_F(I_SSD)[layer * 16 + hd];
    float hs[16];
#pragma unroll
    for (int j = 0; j < 16; ++j) hs[j] = h0 ? h0[(size_t)p * 128 + 16 * nq + j] : 0.f;
    for (int c0 = 0; c0 < L; c0 += CH) {
        const int n = (L - c0) < CH ? (L - c0) : CH;
        __syncthreads();
        for (int idx = tid; idx < n * 128; idx += NTHR) { const int t = idx >> 7, c = idx & 127; const float* src = XBC + (size_t)(row0 + c0 + t) * 1536; Bs[idx] = src[1024 + g * 128 + c]; Cs[idx] = src[1280 + g * 128 + c]; }
        for (int idx = tid; idx < n * 64; idx += NTHR) { const int t = idx >> 6, c = idx & 63; xs[idx] = XBC[(size_t)(row0 + c0 + t) * 1536 + hd * 64 + c]; }
        if (tid < n) dts[tid] = SC[(size_t)(row0 + c0 + tid) * 32 + 8 + hd];
        __syncthreads();
        for (int t = 0; t < n; ++t) {
            const float dt = dts[t], dA = fexp(dt * a), xv = xs[t * 64 + p], cx = dt * xv; float y = 0.f;
#pragma unroll
            for (int j4 = 0; j4 < 4; ++j4) { const f32x4 b4 = *(const LAS f32x4*)(Bs + t * 128 + 16 * nq + 4 * j4), c4 = *(const LAS f32x4*)(Cs + t * 128 + 16 * nq + 4 * j4);
#pragma unroll
                for (int e = 0; e < 4; ++e) { const int j = 4 * j4 + e; hs[j] = hs[j] * dA + cx * b4[e]; y += hs[j] * c4[e]; } }
            y += __shfl_xor(y, 1); y += __shfl_xor(y, 2); y += __shfl_xor(y, 4);
            if (nq == 0) yb[t * 64 + p] = y + Dk * xv;
        }
        __syncthreads();
        for (int t = wid; t < n; t += NWAVES) { const int row = row0 + c0 + t; const float z = UF[(size_t)row * UFW + UF_SSZ + hd * 64 + lane]; const float yg = yb[t * 64 + lane] * siluf_(z);
            const float ss = wave_sum(yg * yg); if (lane == 0) { SSQ[(size_t)row * 32 + hd * 2] = ss; SSQ[(size_t)row * 32 + hd * 2 + 1] = 0.f; }
            Og[(size_t)row * OBW + (hd & 7) * 64 + lane] = (bf16)f2bf(yg); }
    }
#pragma unroll
    for (int j = 0; j < 16; ++j) hout[(size_t)p * 128 + 16 * nq + j] = hs[j];
    __syncthreads();
}

constexpr size_t DNU_NW = 0, DNU_QG = 16384, DNU_AT = 32768, DNU_KGT = 40960, DNU_UP = 57344, DNU_EG = 90112, DNU_BYTES = 90368;
__device__ __forceinline__ float dpp_swap1(float x) { return __builtin_bit_cast(float, __builtin_amdgcn_mov_dpp(__builtin_bit_cast(int, x), 0xB1, 0xf, 0xf, true)); }
__device__ __forceinline__ void dn_chunk_unit(CA A, LAS unsigned char* lds, int layer, int unit, const int wv) {
    const int tid = tid_opaque(wv), lane = tid & 63, wid = tid >> 6, q4 = lane >> 4, l15 = lane & 15;
    const int bh = unit >> 5, ck = unit & 31, b = bh >> 2, h = bh & 3, row0 = b * SEQ + ck * 64;
    constexpr int FP = 132;
    LAS float* kf = (LAS float*)lds; LAS float* vf = kf + 64 * FP;
    LAS unsigned char* qb = lds + 2 * 64 * FP * 4; LAS unsigned char* kb = qb + 64 * 272;
    LAS float* Lp = (LAS float*)(kb + 64 * 272);
    LAS float* gcs = Lp + 2 * 64 * 32; LAS float* bts = gcs + 64;
    const float* DNQ = WSP(float, WS_DNQ); const float* SC = WSP(float, WS_SCAL);
    unsigned char* rec = A->ws + WS_DNU + (size_t)unit * DNU_BYTES;
    __syncthreads();
    if (tid < 64) { const float* sc = SC + (size_t)(row0 + tid) * 32; bts[tid] = sc[h]; gcs[tid] = wave_scan(sc[4 + h], lane); }
    __syncthreads();
    const float glast = gcs[63];
    if (tid == 0) *(float*)(rec + DNU_EG) = fexp(glast);
#pragma unroll
    for (int it = 0; it < 4; ++it) { const int idx = tid + 512 * it, t = idx >> 5, d4 = (idx & 31) * 4; const float* src = DNQ + (size_t)(row0 + t) * 1536 + h * 128 + d4;
        const f32x4 qv = *(const f32x4*)src, kv = *(const f32x4*)(src + 512), vv = *(const f32x4*)(src + 1024);
        *(LAS f32x4*)(kf + t * FP + d4) = kv; *(LAS f32x4*)(vf + t * FP + d4) = vv;
        v2u w; w.x = pk2(qv[0], qv[1]); w.y = pk2(qv[2], qv[3]); *(LAS v2u*)(qb + t * 272 + d4 * 2) = w;
        w.x = pk2(kv[0], kv[1]); w.y = pk2(kv[2], kv[3]); *(LAS v2u*)(kb + t * 272 + d4 * 2) = w;
        const float eg = fexp(gcs[t]); w.x = pk2(qv[0] * eg, qv[1] * eg); w.y = pk2(qv[2] * eg, qv[3] * eg); *(v2u*)(rec + DNU_QG + (size_t)(t * 128 + d4) * 2) = w; }
    __syncthreads();
    { const int c = lane, dg = wid; const float f = fexp(glast - gcs[c]); bf16* KGT = (bf16*)(rec + DNU_KGT);
#pragma unroll
      for (int i = 0; i < 16; ++i) { const int d = dg * 16 + i; KGT[d * 64 + c] = (bf16)f2bf(kf[c * FP + d] * f); } }
    { const int ct = wid >> 1; bf16* AT = (bf16*)(rec + DNU_AT);
#pragma unroll
      for (int e2 = 0; e2 < 2; ++e2) { const int et = 2 * (wid & 1) + e2; f32x4 aKK = {0.f, 0.f, 0.f, 0.f}, aQK = {0.f, 0.f, 0.f, 0.f};
#pragma unroll
          for (int ks = 0; ks < 4; ++ks) { const bf16x8 bfr = *(const LAS bf16x8*)(kb + (16 * et + l15) * 272 + (32 * ks + 8 * q4) * 2);
              const bf16x8 ak = *(const LAS bf16x8*)(kb + (16 * ct + l15) * 272 + (32 * ks + 8 * q4) * 2), aq = *(const LAS bf16x8*)(qb + (16 * ct + l15) * 272 + (32 * ks + 8 * q4) * 2);
              aKK = __builtin_amdgcn_mfma_f32_16x16x32_bf16(ak, bfr, aKK, 0, 0, 0); aQK = __builtin_amdgcn_mfma_f32_16x16x32_bf16(aq, bfr, aQK, 0, 0, 0); }
          const int e = 16 * et + l15; const float ge = gcs[e];
#pragma unroll
          for (int r = 0; r < 4; ++r) { const int c = 16 * ct + 4 * q4 + r; const float dec = e <= c ? fexp(gcs[c] - ge) : 0.f;
              Lp[((e & 1) * 64 + c) * 32 + (e >> 1)] = e < c ? bts[c] * aKK[r] * dec : 0.f;
              AT[c * 64 + e] = (bf16)f2bf(aQK[r] * dec); } } }
    __syncthreads();
    { const int j = tid >> 1, par = tid & 1; float x[32];
#pragma unroll
      for (int i = 0; i < 32; ++i) x[i] = 0.f;
      const LAS float* src = j < 128 ? vf + j : kf + (j - 128);
      float* UP = (float*)(rec + DNU_UP); bf16* NW = (bf16*)(rec + DNU_NW);
#pragma unroll
      for (int c = 0; c < 64; ++c) {
          constexpr int dummy = 0; (void)dummy;
          const int ni = (c + 1) >> 1; float a0 = 0.f, a1 = 0.f, a2 = 0.f, a3 = 0.f;
#pragma unroll
          for (int i4 = 0; i4 < (ni + 3) / 4; ++i4) { const f32x4 l4 = *(const LAS f32x4*)(Lp + (par * 64 + c) * 32 + 4 * i4);
              a0 += l4[0] * x[4 * i4]; if (4 * i4 + 1 < ni) a1 += l4[1] * x[4 * i4 + 1]; if (4 * i4 + 2 < ni) a2 += l4[2] * x[4 * i4 + 2]; if (4 * i4 + 3 < ni) a3 += l4[3] * x[4 * i4 + 3]; }
          float acc = (a0 + a1) + (a2 + a3); acc += dpp_swap1(acc);
          float rhs = src[c * FP] * bts[c]; if (j >= 128) rhs *= fexp(gcs[c]);
          const float xc = rhs - acc;
          x[c >> 1] = ((c & 1) == par) ? xc : x[c >> 1];
          if (par == 0) { if (j < 128) UP[(((j >> 4) * 4 + (c >> 4)) * 4 + (c & 3)) * 64 + ((c >> 2) & 3) * 16 + (j & 15)] = xc; else NW[c * 128 + (j - 128)] = (bf16)f2bf(-xc); }
      } }
}

constexpr int D2_NW = 0, D2_QG = 17408, D2_AT = 34816, D2_KGT = 44032, D2_BUF = 62464, D2_RED = 2 * D2_BUF;
__device__ __forceinline__ bf16x8 ld_frag_perm(const LAS unsigned char* p) {
    const v2u lo = *(const LAS v2u*)p, hi = *(const LAS v2u*)(p + 32); v4u w; w.x = lo.x; w.y = lo.y; w.z = hi.x; w.w = hi.y; return __builtin_bit_cast(bf16x8, w);
}
__device__ __forceinline__ bf16x8 pack_b(const f32x4& t0, const f32x4& t1) { v4u w; w.x = pk2(t0[0], t0[1]); w.y = pk2(t0[2], t0[3]); w.z = pk2(t1[0], t1[1]); w.w = pk2(t1[2], t1[3]); return __builtin_bit_cast(bf16x8, w); }
__device__ __forceinline__ void dn_seq2(CA A, LAS unsigned char* lds, int layer, int bh, const int wv) {
    const int tid = tid_opaque(wv), lane = tid & 63, w = tid >> 6, q4 = lane >> 4, l15 = lane & 15;
    const int b = bh >> 2, h = bh & 3;
    const unsigned char* recs = A->ws + WS_DNU + (size_t)(bh * 32) * DNU_BYTES;
    const float* UF = WSP(float, WS_UF); bf16* O1 = WSP(bf16, WS_OBR) + 512; const float* nw = IN_F(I_DNNW) + layer * 128;
    LAS float* red = (LAS float*)(lds + D2_RED);
    const float nwv = nw[16 * w + l15];
    f32x4 S[8];
#pragma unroll
    for (int i = 0; i < 8; ++i) S[i] = (f32x4){0.f, 0.f, 0.f, 0.f};
    v4u st[7];
#define D2_LOAD(rec_) do { const v4u* g_ = (const v4u*)(rec_); _Pragma("unroll") for (int i_ = 0; i_ < 7; ++i_) st[i_] = g_[tid + 512 * i_]; } while (0)
#define D2_STORE(buf_) do { LAS unsigned char* b_ = lds + (buf_) * D2_BUF; \
        *(LAS v4u*)(b_ + D2_NW + (tid >> 4) * 272 + (tid & 15) * 16) = st[0]; *(LAS v4u*)(b_ + D2_NW + (32 + (tid >> 4)) * 272 + (tid & 15) * 16) = st[1]; \
        *(LAS v4u*)(b_ + D2_QG + (tid >> 4) * 272 + (tid & 15) * 16) = st[2]; *(LAS v4u*)(b_ + D2_QG + (32 + (tid >> 4)) * 272 + (tid & 15) * 16) = st[3]; \
        *(LAS v4u*)(b_ + D2_AT + (tid >> 3) * 144 + (tid & 7) * 16) = st[4]; \
        *(LAS v4u*)(b_ + D2_KGT + (tid >> 3) * 144 + (tid & 7) * 16) = st[5]; *(LAS v4u*)(b_ + D2_KGT + (64 + (tid >> 3)) * 144 + (tid & 7) * 16) = st[6]; } while (0)
    __syncthreads();
    D2_LOAD(recs); D2_STORE(0);
    f32x4 vnx[4]; float eglx = *(const float*)(recs + DNU_EG);
    { const float* UP0 = (const float*)(recs + DNU_UP) + (size_t)w * 1024 + lane;
#pragma unroll
      for (int mt = 0; mt < 4; ++mt)
#pragma unroll
          for (int r = 0; r < 4; ++r) vnx[mt][r] = UP0[(mt * 4 + r) * 64]; }
    __syncthreads();
    for (int ck = 0; ck < 32; ++ck) {
        const unsigned char* rec = recs + (size_t)ck * DNU_BYTES; const int row0 = b * SEQ + ck * 64;
        const LAS unsigned char* bf = lds + (ck & 1) * D2_BUF;
        if (ck + 1 < 32) D2_LOAD(rec + DNU_BYTES);
        const float egl = eglx;
        f32x4 vn[4];
#pragma unroll
        for (int mt = 0; mt < 4; ++mt) vn[mt] = vnx[mt];
        if (ck + 1 < 32) { eglx = *(const float*)(rec + DNU_BYTES + DNU_EG); const float* UP = (const float*)(rec + DNU_BYTES + DNU_UP) + (size_t)w * 1024 + lane;
#pragma unroll
            for (int mt = 0; mt < 4; ++mt)
#pragma unroll
                for (int r = 0; r < 4; ++r) vnx[mt][r] = UP[(mt * 4 + r) * 64]; }
        f32x4 zz[4];
#pragma unroll
        for (int mt = 0; mt < 4; ++mt)
#pragma unroll
            for (int r = 0; r < 4; ++r) zz[mt][r] = UF[(size_t)(row0 + 16 * mt + 4 * q4 + r) * UFW + UF_DNZ + h * 128 + 16 * w + l15];
        bf16x8 Sb[4];
#pragma unroll
        for (int ks = 0; ks < 4; ++ks) Sb[ks] = pack_b(S[2 * ks], S[2 * ks + 1]);
        const int aoff = l15 * 272 + 8 * q4, aoff2 = l15 * 144 + 8 * q4;
#pragma unroll
        for (int mt = 0; mt < 4; ++mt)
#pragma unroll
            for (int ks = 0; ks < 4; ++ks) vn[mt] = __builtin_amdgcn_mfma_f32_16x16x32_bf16(ld_frag_perm(bf + D2_NW + mt * 16 * 272 + aoff + ks * 64), Sb[ks], vn[mt], 0, 0, 0);
        bf16x8 vb[2];
        vb[0] = pack_b(vn[0], vn[1]); vb[1] = pack_b(vn[2], vn[3]);
        f32x4 o[4];
#pragma unroll
        for (int mt = 0; mt < 4; ++mt) { o[mt] = (f32x4){0.f, 0.f, 0.f, 0.f};
#pragma unroll
            for (int ks = 0; ks < 4; ++ks) o[mt] = __builtin_amdgcn_mfma_f32_16x16x32_bf16(ld_frag_perm(bf + D2_QG + mt * 16 * 272 + aoff + ks * 64), Sb[ks], o[mt], 0, 0, 0);
#pragma unroll
            for (int ke = 0; ke < 2; ++ke) o[mt] = __builtin_amdgcn_mfma_f32_16x16x32_bf16(ld_frag_perm(bf + D2_AT + mt * 16 * 144 + aoff2 + ke * 64), vb[ke], o[mt], 0, 0, 0); }
#pragma unroll
        for (int m8 = 0; m8 < 8; ++m8) { S[m8] = S[m8] * egl;
#pragma unroll
            for (int ke = 0; ke < 2; ++ke) S[m8] = __builtin_amdgcn_mfma_f32_16x16x32_bf16(ld_frag_perm(bf + D2_KGT + m8 * 16 * 144 + aoff2 + ke * 64), vb[ke], S[m8], 0, 0, 0); }
        LAS float* rd = red + (ck & 1) * 512;
#pragma unroll
        for (int mt = 0; mt < 4; ++mt)
#pragma unroll
            for (int r = 0; r < 4; ++r) { const float s = row16_sum(o[mt][r] * o[mt][r]);
                if (l15 == 0) rd[(16 * mt + 4 * q4 + r) * 8 + w] = s; }
        if (ck + 1 < 32) D2_STORE((ck + 1) & 1);
        __syncthreads();
#pragma unroll
        for (int mt = 0; mt < 4; ++mt)
#pragma unroll
            for (int r = 0; r < 4; ++r) { const int c = 16 * mt + 4 * q4 + r; const f32x4 s0 = *(const LAS f32x4*)(rd + c * 8), s1 = *(const LAS f32x4*)(rd + c * 8 + 4);
                const float rstd = __builtin_amdgcn_rsqf(((s0[0] + s0[1]) + (s0[2] + s0[3]) + (s1[0] + s1[1]) + (s1[2] + s1[3])) * (1.0f / 128.0f) + RMS_EPS);
                const int dv = 16 * w + l15;
                const float zq = zz[mt][r]; O1[(size_t)(row0 + c) * OBW + h * 128 + dv] = (bf16)f2bf(o[mt][r] * rstd * nwv * zq * __builtin_amdgcn_rcpf(1.0f + fexp(-zq))); }
    }
    float* sout = A->out + O_DNSP + ((size_t)(layer * NBATCH + b) * 4 + h) * 16384;
#pragma unroll
    for (int m8 = 0; m8 < 8; ++m8)
#pragma unroll
        for (int r = 0; r < 4; ++r) sout[(size_t)(16 * m8 + 4 * q4 + r) * 128 + 16 * w + l15] = S[m8][r];
    __syncthreads();
#undef D2_LOAD
#undef D2_STORE
}

constexpr size_t SSU_XT = 0, SSU_XTW = 8192, SSU_CUM = 16384, SSU_DT = 16640, SSU_BYTES = 16896;
constexpr size_t SSG_C = 0, SSG_B = 16384, SSG_BT = 32768, SSG_BYTES = 49152;
__device__ __forceinline__ void ssd_prep_unit(CA A, LAS unsigned char* lds, int layer, int unit, const int wv) {
    const int tid = tid_opaque(wv), lane = tid & 63;
    const int hd = unit & 15, bc = unit >> 4, b = bc >> 5, ck = bc & 31, g = hd >> 3, row0 = b * SEQ + ck * 64;
    const float* XBC = WSP(float, WS_XBC); const float* SC = WSP(float, WS_SCAL);
    unsigned char* rec = A->ws + WS_SSU + (size_t)unit * SSU_BYTES;
    LAS float* xl = (LAS float*)lds;
    LAS float* bl = xl + 64 * 65;
    LAS float* cums = bl + 64 * 129; LAS float* ws_ = cums + 64;
    const float a = -fexp(IN_F(I_SSALOG)[layer * 16 + hd]);
    __syncthreads();
    if (tid < 64) { const float dt = SC[(size_t)(row0 + tid) * 32 + 8 + hd]; const float c = wave_scan(dt * a, lane);
        cums[tid] = c; const float c63 = rdlane(c, 63); ws_[tid] = fexp(c63 - c) * dt;
        ((float*)(rec + SSU_CUM))[tid] = c; ((float*)(rec + SSU_DT))[tid] = dt; }
    { const int s = tid >> 3, p8 = (tid & 7) * 8; const float* src = XBC + (size_t)(row0 + s) * 1536 + hd * 64 + p8; const f32x4 x0 = *(const f32x4*)src, x1 = *(const f32x4*)(src + 4);
#pragma unroll
      for (int e = 0; e < 4; ++e) { xl[s * 65 + p8 + e] = x0[e]; xl[s * 65 + p8 + 4 + e] = x1[e]; } }
    __syncthreads();
    { const int p = tid >> 3, s8 = (tid & 7) * 8; float xv[8], xw[8];
#pragma unroll
      for (int i = 0; i < 8; ++i) { xv[i] = xl[(s8 + i) * 65 + p]; xw[i] = xv[i] * ws_[s8 + i]; }
      v4u o; o.x = pk2(xv[0], xv[1]); o.y = pk2(xv[2], xv[3]); o.z = pk2(xv[4], xv[5]); o.w = pk2(xv[6], xv[7]); *(v4u*)(rec + SSU_XT + (size_t)(p * 64 + s8) * 2) = o;
      o.x = pk2(xw[0], xw[1]); o.y = pk2(xw[2], xw[3]); o.z = pk2(xw[4], xw[5]); o.w = pk2(xw[6], xw[7]); *(v4u*)(rec + SSU_XTW + (size_t)(p * 64 + s8) * 2) = o; }
    if ((hd & 7) == 0) {
        unsigned char* grec = A->ws + WS_SSG + (size_t)(bc * 2 + g) * SSG_BYTES;
        const int s = tid >> 3, n16 = (tid & 7) * 16; const float* src = XBC + (size_t)(row0 + s) * 1536 + 1024 + g * 128 + n16;
        f32x4 bv[4], cv[4];
#pragma unroll
        for (int i = 0; i < 4; ++i) { bv[i] = *(const f32x4*)(src + 4 * i); cv[i] = *(const f32x4*)(src + 256 + 4 * i); }
#pragma unroll
        for (int i = 0; i < 2; ++i) { v4u o; o.x = pk2(bv[2 * i][0], bv[2 * i][1]); o.y = pk2(bv[2 * i][2], bv[2 * i][3]); o.z = pk2(bv[2 * i + 1][0], bv[2 * i + 1][1]); o.w = pk2(bv[2 * i + 1][2], bv[2 * i + 1][3]);
            *(v4u*)(grec + SSG_B + (size_t)(s * 128 + n16 + 8 * i) * 2) = o;
            o.x = pk2(cv[2 * i][0], cv[2 * i][1]); o.y = pk2(cv[2 * i][2], cv[2 * i][3]); o.z = pk2(cv[2 * i + 1][0], cv[2 * i + 1][1]); o.w = pk2(cv[2 * i + 1][2], cv[2 * i + 1][3]);
            *(v4u*)(grec + SSG_C + (size_t)(s * 128 + n16 + 8 * i) * 2) = o; }
#pragma unroll
        for (int i = 0; i < 4; ++i)
#pragma unroll
            for (int e = 0; e < 4; ++e) bl[s * 129 + n16 + 4 * i + e] = bv[i][e];
        __syncthreads();
        const int n = tid >> 2, s16 = (tid & 3) * 16; float t[16];
#pragma unroll
        for (int i = 0; i < 16; ++i) t[i] = bl[(s16 + i) * 129 + n];
#pragma unroll
        for (int i = 0; i < 2; ++i) { v4u o; o.x = pk2(t[8 * i], t[8 * i + 1]); o.y = pk2(t[8 * i + 2], t[8 * i + 3]); o.z = pk2(t[8 * i + 4], t[8 * i + 5]); o.w = pk2(t[8 * i + 6], t[8 * i + 7]);
            *(v4u*)(grec + SSG_BT + (size_t)(n * 64 + s16 + 8 * i) * 2) = o; }
    }
}

constexpr int S2_C = 0, S2_B = 17408, S2_BT = 34816, S2_XT = 53248, S2_XTW = 62464, S2_WM = 71680, S2_HB = 80896, S2_YB = 98304, S2_CUM = 114688, S2_DT = 114944;
__device__ __forceinline__ void ssd_seq2(CA A, LAS unsigned char* lds, int layer, int unit, const int wv) {
    const int tid = tid_opaque(wv), lane = tid & 63, w = tid >> 6, q4 = lane >> 4, l15 = lane & 15;
    const int b = unit >> 4, hd = unit & 15, g = hd >> 3;
    const unsigned char* hrec = A->ws + WS_SSU + (size_t)((b * 32) * 16 + hd) * SSU_BYTES;
    const unsigned char* grec = A->ws + WS_SSG + (size_t)((b * 32) * 2 + g) * SSG_BYTES;
    const float* UF = WSP(float, WS_UF); float* SSQ = WSP(float, WS_SSQ); bf16* Og = WSP(bf16, WS_OBR) + (3 + g) * 512;
    const float Dk = IN_F(I_SSD)[layer * 16 + hd];
    LAS float* yb = (LAS float*)(lds + S2_YB); LAS float* cums = (LAS float*)(lds + S2_CUM); LAS float* dts = (LAS float*)(lds + S2_DT);
    f32x4 hacc[4];
#pragma unroll
    for (int i = 0; i < 4; ++i) hacc[i] = (f32x4){0.f, 0.f, 0.f, 0.f};
    v4u st[8]; float sc1 = 0.f;
#define S2_LOAD(ck_) do { const v4u* gg_ = (const v4u*)(grec + (size_t)(ck_) * 2 * SSG_BYTES); const v4u* hh_ = (const v4u*)(hrec + (size_t)(ck_) * 16 * SSU_BYTES); \
        st[0] = gg_[tid]; st[1] = gg_[tid + 512]; st[2] = gg_[tid + 1024]; st[3] = gg_[tid + 1536]; st[4] = gg_[tid + 2048]; st[5] = gg_[tid + 2560]; st[6] = hh_[tid]; st[7] = hh_[tid + 512]; \
        if (tid < 128) sc1 = ((const float*)(hrec + (size_t)(ck_) * 16 * SSU_BYTES + SSU_CUM))[tid]; } while (0)
#define S2_STORE() do { \
        *(LAS v4u*)(lds + S2_C + (tid >> 4) * 272 + (tid & 15) * 16) = st[0]; *(LAS v4u*)(lds + S2_C + (32 + (tid >> 4)) * 272 + (tid & 15) * 16) = st[1]; \
        *(LAS v4u*)(lds + S2_B + (tid >> 4) * 272 + (tid & 15) * 16) = st[2]; *(LAS v4u*)(lds + S2_B + (32 + (tid >> 4)) * 272 + (tid & 15) * 16) = st[3]; \
        *(LAS v4u*)(lds + S2_BT + (tid >> 3) * 144 + (tid & 7) * 16) = st[4]; *(LAS v4u*)(lds + S2_BT + (64 + (tid >> 3)) * 144 + (tid & 7) * 16) = st[5]; \
        *(LAS v4u*)(lds + S2_XT + (tid >> 3) * 144 + (tid & 7) * 16) = st[6]; *(LAS v4u*)(lds + S2_XTW + (tid >> 3) * 144 + (tid & 7) * 16) = st[7]; \
        if (tid < 128) cums[tid] = sc1; } while (0)
    S2_LOAD(0);
    const int tt = w >> 1, aoffC = l15 * 272 + 16 * q4, aoffS = l15 * 144 + 16 * q4;
    for (int ck = 0; ck < 32; ++ck) {
        const int row0 = b * SEQ + ck * 64;
        __syncthreads();
        S2_STORE();
        __syncthreads();
        if (ck + 1 < 32) S2_LOAD(ck + 1);
        float zv[2][4];
#pragma unroll
        for (int e2 = 0; e2 < 2; ++e2)
#pragma unroll
            for (int r = 0; r < 4; ++r) zv[e2][r] = UF[(size_t)(row0 + 16 * tt + 4 * q4 + r) * UFW + UF_SSZ + hd * 64 + 16 * (2 * (w & 1) + e2) + l15];
#pragma unroll
        for (int e2 = 0; e2 < 2; ++e2) { const int stl = 2 * (w & 1) + e2; f32x4 acc = {0.f, 0.f, 0.f, 0.f};
            if (stl <= tt) {
#pragma unroll
                for (int ks = 0; ks < 4; ++ks) acc = __builtin_amdgcn_mfma_f32_16x16x32_bf16(*(const LAS bf16x8*)(lds + S2_C + tt * 16 * 272 + aoffC + ks * 64), *(const LAS bf16x8*)(lds + S2_B + stl * 16 * 272 + aoffC + ks * 64), acc, 0, 0, 0); }
            const int s = 16 * stl + l15; const float cs = cums[s], ds = dts[s];
#pragma unroll
            for (int r = 0; r < 4; ++r) { const int t = 16 * tt + 4 * q4 + r; const float v = s <= t ? acc[r] * fexp(cums[t] - cs) * ds : 0.f;
                *(LAS unsigned short*)(lds + S2_WM + t * 144 + s * 2) = (unsigned short)f2bf(v); } }
#pragma unroll
        for (int mt = 0; mt < 4; ++mt)
#pragma unroll
            for (int r = 0; r < 4; ++r) *(LAS unsigned short*)(lds + S2_HB + (16 * mt + 4 * q4 + r) * 272 + (16 * w + l15) * 2) = (unsigned short)f2bf(hacc[mt][r]);
        __syncthreads();
        float ssq[4] = {0.f, 0.f, 0.f, 0.f};
#pragma unroll
        for (int e2 = 0; e2 < 2; ++e2) { const int pt = 2 * (w & 1) + e2; f32x4 y = {0.f, 0.f, 0.f, 0.f};
#pragma unroll
            for (int ks = 0; ks < 4; ++ks) y = __builtin_amdgcn_mfma_f32_16x16x32_bf16(*(const LAS bf16x8*)(lds + S2_C + tt * 16 * 272 + aoffC + ks * 64), *(const LAS bf16x8*)(lds + S2_HB + pt * 16 * 272 + aoffC + ks * 64), y, 0, 0, 0);
#pragma unroll
            for (int r = 0; r < 4; ++r) y[r] *= fexp(cums[16 * tt + 4 * q4 + r]);
#pragma unroll
            for (int ke = 0; ke < 2; ++ke) y = __builtin_amdgcn_mfma_f32_16x16x32_bf16(*(const LAS bf16x8*)(lds + S2_WM + tt * 16 * 144 + aoffS + ke * 64), *(const LAS bf16x8*)(lds + S2_XT + pt * 16 * 144 + aoffS + ke * 64), y, 0, 0, 0);
            const int p = 16 * pt + l15;
#pragma unroll
            for (int r = 0; r < 4; ++r) { const int t = 16 * tt + 4 * q4 + r; const float xv = bflo((unsigned)*(const LAS unsigned short*)(lds + S2_XT + p * 144 + t * 2));
                const float yg = (y[r] + Dk * xv) * siluf_(zv[e2][r]); ssq[r] += yg * yg;
                Og[(size_t)(row0 + t) * OBW + (hd & 7) * 64 + p] = (bf16)f2bf(yg); } }
#pragma unroll
        for (int r = 0; r < 4; ++r) { const float s = row16_sum(ssq[r]); if (l15 == 0) SSQ[(size_t)(row0 + 16 * tt + 4 * q4 + r) * 32 + hd * 2 + (w & 1)] = s; }
        { const float e63 = fexp(cums[63]);
#pragma unroll
          for (int mt = 0; mt < 4; ++mt) { hacc[mt] = hacc[mt] * e63;
#pragma unroll
              for (int ke = 0; ke < 2; ++ke) hacc[mt] = __builtin_amdgcn_mfma_f32_16x16x32_bf16(*(const LAS bf16x8*)(lds + S2_XTW + mt * 16 * 144 + aoffS + ke * 64), *(const LAS bf16x8*)(lds + S2_BT + w * 16 * 144 + aoffS + ke * 64), hacc[mt], 0, 0, 0); } }
    }
    float* hout = A->out + O_SSHP + ((size_t)(layer * NBATCH + b) * 16 + hd) * 8192;
#pragma unroll
    for (int mt = 0; mt < 4; ++mt)
#pragma unroll
        for (int r = 0; r < 4; ++r) hout[(size_t)(16 * mt + 4 * q4 + r) * 128 + 16 * w + l15] = hacc[mt][r];
    __syncthreads();
#undef S2_LOAD
#undef S2_STORE
}

struct ALBf16 { const bf16* A; int lda; __device__ __forceinline__ bf16x8 operator()(int row, int k) const { return *(const bf16x8*)(A + (size_t)row * lda + k); } };
template <class AL> __device__ __forceinline__ void sgemm_task(const AL& al, const bf16* Wt, int ldw, int n0, int k0, int nks, f32x4 (&acc)[2], int l15, int q4) {
    const bf16* bp = Wt + (size_t)(n0 + l15) * ldw + k0 + 8 * q4;
    int nks_ = nks; asm volatile("" : "+s"(nks_));
#pragma unroll 4
    for (int ks = 0; ks < nks_; ++ks) { const bf16x8 b = *(const bf16x8*)(bp + 32 * ks); const bf16x8 a0 = al(l15, k0 + 32 * ks + 8 * q4), a1 = al(16 + l15, k0 + 32 * ks + 8 * q4);
        acc[0] = __builtin_amdgcn_mfma_f32_16x16x32_bf16(a0, b, acc[0], 0, 0, 0); acc[1] = __builtin_amdgcn_mfma_f32_16x16x32_bf16(a1, b, acc[1], 0, 0, 0); }
}
#define SAMPLE_IDS() const int tid = tid_opaque(wv), lane = tid & 63, l15 = lane & 15, q4 = lane >> 4, NGW = gridDim.x * NWAVES, gw = (tid >> 6) * gridDim.x + blk_opaque()
__device__ __forceinline__ void sample_merge(CA A, LAS unsigned char* lds, int layer, const int wv) {
    const int tid = tid_opaque(wv), lane = tid & 63, l15 = lane & 15, q4 = lane >> 4, w = tid >> 6, G = gridDim.x;
    const bf16* GT = WSP(bf16, WS_GATE); const float* RS = WSP(float, WS_RS); bf16* MB = WSP(bf16, WS_MGB); LAS float* part = (LAS float*)lds;
    for (int strip = blk_opaque(); strip < 128; strip += G) { const int n0 = strip * 16, col = n0 + l15;
        __syncthreads();
        if (w < 5) { const int s = w, gs = s < 3 ? s : 3;
            f32x4 acc[2] = {{0.f, 0.f, 0.f, 0.f}, {0.f, 0.f, 0.f, 0.f}};
            ALBf16 al{WSP(bf16, WS_OBR) + (size_t)TP * OBW + s * 512, OBW};
            sgemm_task(al, WSP(bf16, WS_WBR) + (size_t)layer * DM * OBW + s * 512, OBW, n0, 0, 16, acc, l15, q4);
#pragma unroll
            for (int mt = 0; mt < 2; ++mt)
#pragma unroll
                for (int r = 0; r < 4; ++r) { const int row = 16 * mt + 4 * q4 + r, grow = TP + row; float rs = 1.f;
                    if (s >= 3) rs = 1.0f / sqrtf(RS[(size_t)grow * 2 + (s - 3)]);
                    part[(s * 32 + row) * 16 + l15] = acc[mt][r] * bflo((unsigned)GT[(size_t)grow * 8192 + gs * 2048 + col]) * rs; } }
        __syncthreads();
        { const int row = tid >> 4, c = tid & 15; const float v = (part[row * 16 + c] + part[(32 + row) * 16 + c]) + (part[(64 + row) * 16 + c] + part[(96 + row) * 16 + c]) + part[(128 + row) * 16 + c];
          MB[(size_t)(TP + row) * DM + n0 + c] = (bf16)f2bf(v); } }
}
__device__ __forceinline__ void sample_up(CA A, LAS unsigned char* lds, int layer, const int wv) {
    const int tid = tid_opaque(wv), lane = tid & 63, l15 = lane & 15, q4 = lane >> 4, w = tid >> 6, G = gridDim.x;
    bf16* F = WSP(bf16, WS_F); LAS float* part = (LAS float*)lds;
    for (int sp = blk_opaque(); sp < 256; sp += G) { const int n0 = (2 * sp + (w >> 2)) * 16, kq = w & 3;
        __syncthreads();
        f32x4 acc[2] = {{0.f, 0.f, 0.f, 0.f}, {0.f, 0.f, 0.f, 0.f}};
        ALBf16 al{WSP(bf16, WS_H) + (size_t)TP * DM, DM};
        sgemm_task(al, WSP(bf16, WS_WUP) + (size_t)layer * DFF * DM, DM, n0, kq * 512, 16, acc, l15, q4);
#pragma unroll
        for (int mt = 0; mt < 2; ++mt)
#pragma unroll
            for (int r = 0; r < 4; ++r) part[(w * 32 + 16 * mt + 4 * q4 + r) * 16 + l15] = acc[mt][r];
        __syncthreads();
#pragma unroll
        for (int h2 = 0; h2 < 2; ++h2) { const int idx = tid + 512 * h2, half = idx >> 9, row = (idx >> 4) & 31, c = idx & 15; const LAS float* p = part + (half * 4 * 32 + row) * 16 + c;
            const float v = fmaxf((p[0] + p[32 * 16]) + (p[2 * 32 * 16] + p[3 * 32 * 16]), 0.f);
            F[(size_t)(TP + row) * DFF + (2 * sp + half) * 16 + c] = (bf16)f2bf(v * v); } }
}
template <class AL> __device__ __forceinline__ void sample_splitk(const AL& al, const bf16* Wt, int ldw, int nstrips, int nsplit, int nks, float* PART, int ldp, const int wv) {
    SAMPLE_IDS();
    for (int it = gw; it < nstrips * nsplit; it += NGW) { const int ns = it % nstrips, sp = it / nstrips, n0 = ns * 16;
        f32x4 acc[2] = {{0.f, 0.f, 0.f, 0.f}, {0.f, 0.f, 0.f, 0.f}};
        sgemm_task(al, Wt, ldw, n0, sp * nks * 32, nks, acc, l15, q4);
#pragma unroll
        for (int mt = 0; mt < 2; ++mt)
#pragma unroll
            for (int r = 0; r < 4; ++r) PART[((size_t)sp * TS + 16 * mt + 4 * q4 + r) * ldp + n0 + l15] = acc[mt][r]; }
}

constexpr int KS_PITCH = 272, VT_PITCH = 136;
constexpr int ATT_KS = 0, ATT_VT = 64 * KS_PITCH;
__device__ __forceinline__ void attn_prompt_unit(CA A, LAS unsigned char* lds, int layer, int unit, const int wv) {
    const int tid = tid_opaque(wv), lane = tid & 63, wid = tid >> 6, r = lane & 31, hh = lane >> 5;
    const int qb = 7 - (unit >> 4), bh = unit & 15, b = bh >> 2, h = bh & 3;
    const int q0 = qb * 256 + wid * 32, qpos = q0 + r;
    const bf16* QKV = WSP(bf16, WS_QKV) + (size_t)(b * SEQ) * 1536;
    bf16x8 Qf[8];
    { const bf16* qrow = QKV + (size_t)qpos * 1536 + h * 128 + 8 * hh;
#pragma unroll
      for (int s = 0; s < 8; ++s) Qf[s] = *(const bf16x8*)(qrow + 16 * s); }
    f32x16 O[4];
#pragma unroll
    for (int d = 0; d < 4; ++d)
#pragma unroll
        for (int i = 0; i < 16; ++i) O[d][i] = 0.f;
    float R = 0.f;
    const float bias2 = IN_F(I_SBBIAS)[layer * 4 + h] * LOG2E;
    const int ntile = qb * 4 + 4, srow = tid >> 3, sch = tid & 7;
    LAS unsigned char* Ks = lds + ATT_KS; LAS unsigned char* Vt = lds + ATT_VT;
    v4u kreg[2], vreg[2];
    { const bf16* src = QKV + (size_t)((ntile - 1) * 64 + srow) * 1536 + h * 128 + sch * 8;
      kreg[0] = *(const v4u*)(src + 512); kreg[1] = *(const v4u*)(src + 512 + 64); vreg[0] = *(const v4u*)(src + 1024); vreg[1] = *(const v4u*)(src + 1024 + 64); }
    for (int kt = ntile - 1; kt >= 0; --kt) {
        __syncthreads();
#pragma unroll
        for (int i = 0; i < 2; ++i) { *(LAS v4u*)(Ks + srow * KS_PITCH + (sch + 8 * i) * 16) = kreg[i];
            LAS unsigned short* vt = (LAS unsigned short*)Vt + ((sch + 8 * i) * 8) * (VT_PITCH / 2) + srow;
            const unsigned w[4] = {vreg[i].x, vreg[i].y, vreg[i].z, vreg[i].w};
#pragma unroll
            for (int e = 0; e < 4; ++e) { vt[(2 * e) * (VT_PITCH / 2)] = (unsigned short)(w[e] & 0xffffu); vt[(2 * e + 1) * (VT_PITCH / 2)] = (unsigned short)(w[e] >> 16); } }
        __syncthreads();
        if (kt > 0) { const bf16* src = QKV + (size_t)((kt - 1) * 64 + srow) * 1536 + h * 128 + sch * 8;
            kreg[0] = *(const v4u*)(src + 512); kreg[1] = *(const v4u*)(src + 512 + 64); vreg[0] = *(const v4u*)(src + 1024); vreg[1] = *(const v4u*)(src + 1024 + 64); }
        if (kt * 64 > q0 + 30) continue;
        const bool diag = (kt * 64 + 63 >= q0);
        const int kbase = kt * 64 + 4 * hh;
        bf16x8 Pf[4];
#pragma unroll
        for (int sub = 1; sub >= 0; --sub) {
            f32x16 sa;
#pragma unroll
            for (int i = 0; i < 16; ++i) sa[i] = bias2;
#pragma unroll
            for (int s = 0; s < 8; ++s) { const bf16x8 a = *(const LAS bf16x8*)(Ks + (32 * sub + r) * KS_PITCH + (16 * s + 8 * hh) * 2);
                sa = __builtin_amdgcn_mfma_f32_32x32x16_bf16(a, Qf[s], sa, 0, 0, 0); }
            float sp[16], Gs[4], Gp[4];
#pragma unroll
            for (int i = 0; i < 16; ++i) { const float z = fminf(sa[i], 60.f); sa[i] = z; float s1 = lg2(1.0f + ex2(z));
                if (diag && (kbase + 32 * sub + 8 * (i >> 2) + (i & 3) >= qpos)) s1 = 0.f;
                sp[i] = s1; }
#pragma unroll
            for (int g = 0; g < 4; ++g) { Gs[g] = (sp[4 * g] + sp[4 * g + 1]) + (sp[4 * g + 2] + sp[4 * g + 3]); Gp[g] = __shfl_xor(Gs[g], 32); }
            float run = R;
#pragma unroll
            for (int g = 3; g >= 0; --g) { float a = run + (hh == 0 ? Gp[g] : 0.f);
#pragma unroll
                for (int e = 3; e >= 0; --e) { const int i = 4 * g + e; float pv = ex2(sa[i] - sp[i] - a);
                    if (diag && (kbase + 32 * sub + 8 * g + e >= qpos)) pv = 0.f;
                    a += sp[i]; sp[i] = pv; }
                run += Gs[g] + Gp[g]; }
            R = run;
#pragma unroll
            for (int q2 = 0; q2 < 2; ++q2) { const int bs = 8 * q2; v4u w;
                w.x = pk2(sp[bs + 0], sp[bs + 1]); w.y = pk2(sp[bs + 2], sp[bs + 3]); w.z = pk2(sp[bs + 4], sp[bs + 5]); w.w = pk2(sp[bs + 6], sp[bs + 7]);
                Pf[2 * sub + q2] = __builtin_bit_cast(bf16x8, w); }
        }
#pragma unroll
        for (int d = 0; d < 4; ++d)
#pragma unroll
            for (int s4 = 0; s4 < 4; ++s4) { const LAS unsigned char* vp = Vt + (32 * d + r) * VT_PITCH + (16 * s4 + 4 * hh) * 2;
                const v2u lo = *(const LAS v2u*)vp, hi = *(const LAS v2u*)(vp + 16); v4u w; w.x = lo.x; w.y = lo.y; w.z = hi.x; w.w = hi.y;
                O[d] = __builtin_amdgcn_mfma_f32_32x32x16_bf16(__builtin_bit_cast(bf16x8, w), Pf[s4], O[d], 0, 0, 0); }
    }
    bf16* orow = WSP(bf16, WS_OBR) + 1024 + (size_t)(b * SEQ + qpos) * OBW + h * 128 + 4 * hh;
#pragma unroll
    for (int d = 0; d < 4; ++d)
#pragma unroll
        for (int g = 0; g < 4; ++g) { v2u w; w.x = pk2(O[d][4 * g], O[d][4 * g + 1]); w.y = pk2(O[d][4 * g + 2], O[d][4 * g + 3]); *(v2u*)(orow + 32 * d + 8 * g) = w; }
}

__device__ __forceinline__ void attn_sample_unit(CA A, LAS unsigned char* lds, int layer, int unit, const int wv) {
    const int tid = tid_opaque(wv), lane = tid & 63, wid = tid >> 6, sb = unit >> 5, pg4 = unit & 31, hd = lane >> 4;
    const int lp = 4 * pg4 + (wid >> 1), phys = ((const int*)A->in[I_PT])[sb * NPAGES + lp];
    const size_t pbase = ((size_t)(layer * NPOOL + phys) * PAGE + (wid & 1) * 64) * 512 + lane * 8;
    const float* Kc = IN_F(I_CK) + pbase; const float* Vc = IN_F(I_CV) + pbase;
    const bf16* QKV = WSP(bf16, WS_QKV);
    float qf[4][8], O[4][8], R[4];
#pragma unroll
    for (int i = 0; i < 4; ++i) { const v4u w = *(const v4u*)(QKV + (size_t)(TP + sb * 4 + i) * 1536 + lane * 8);
        qf[i][0] = bflo(w.x); qf[i][1] = bfhi(w.x); qf[i][2] = bflo(w.y); qf[i][3] = bfhi(w.y); qf[i][4] = bflo(w.z); qf[i][5] = bfhi(w.z); qf[i][6] = bflo(w.w); qf[i][7] = bfhi(w.w);
        R[i] = 0.f;
#pragma unroll
        for (int j = 0; j < 8; ++j) O[i][j] = 0.f; }
    const float bias2 = IN_F(I_SBBIAS)[layer * 4 + hd] * LOG2E;
#pragma unroll 4
    for (int t = 63; t >= 0; --t) {
        const f32x4 k0 = *(const f32x4*)(Kc + (size_t)t * 512), k1 = *(const f32x4*)(Kc + (size_t)t * 512 + 4), v0 = *(const f32x4*)(Vc + (size_t)t * 512), v1 = *(const f32x4*)(Vc + (size_t)t * 512 + 4);
#pragma unroll
        for (int i = 0; i < 4; ++i) {
            float s = (qf[i][0] * k0[0] + qf[i][1] * k0[1]) + (qf[i][2] * k0[2] + qf[i][3] * k0[3]) + (qf[i][4] * k1[0] + qf[i][5] * k1[1]) + (qf[i][6] * k1[2] + qf[i][7] * k1[3]);
            s = row16_sum(s);
            const float z = fminf(s + bias2, 60.f), s1 = lg2(1.0f + ex2(z)), pv = ex2(z - s1 - R[i]); R[i] += s1;
#pragma unroll
            for (int e = 0; e < 4; ++e) { O[i][e] += pv * v0[e]; O[i][4 + e] += pv * v1[e]; } }
    }
    LAS float* Ow = (LAS float*)lds;
    LAS float* Rw = Ow + 8 * 4 * 512;
    __syncthreads();
#pragma unroll
    for (int i = 0; i < 4; ++i) { *(LAS f32x4*)(Ow + (wid * 4 + i) * 512 + lane * 8) = (f32x4){O[i][0], O[i][1], O[i][2], O[i][3]}; *(LAS f32x4*)(Ow + (wid * 4 + i) * 512 + lane * 8 + 4) = (f32x4){O[i][4], O[i][5], O[i][6], O[i][7]};
        if ((lane & 15) == 0) Rw[(wid * 4 + i) * 4 + hd] = R[i]; }
    __syncthreads();
    float* PART = WSP(float, WS_PART) + (size_t)unit * 2048; float* PR = WSP(float, WS_PR) + (size_t)unit * 16;
    for (int idx = tid; idx < 2048; idx += NTHR) { const int i = idx >> 9, c = idx & 511, hc = c >> 7; float acc = 0.f, racc = 0.f;
#pragma unroll
        for (int w = 7; w >= 0; --w) { acc += ex2(-racc) * Ow[(w * 4 + i) * 512 + c]; racc += Rw[(w * 4 + i) * 4 + hc]; }
        PART[idx] = acc; if ((c & 127) == 0) PR[i * 4 + hc] = racc; }
}
__device__ __forceinline__ void attn_sample_combine(CA A, int layer, const int wv) {
    {
      const int t0 = tid_opaque(wv), gt = blk_opaque() * NTHR + t0; const float* SQ = WSP(float, WS_SSQ); float* RS = WSP(float, WS_RS);
      for (int idx = gt; idx < TT * 2; idx += gridDim.x * NTHR) { const f32x4* sq = (const f32x4*)(SQ + (size_t)idx * 16); const f32x4 a = sq[0], b = sq[1], c = sq[2], d = sq[3];
          RS[idx] = (((a[0] + a[1]) + (a[2] + a[3]) + (b[0] + b[1]) + (b[2] + b[3])) + ((c[0] + c[1]) + (c[2] + c[3]) + (d[0] + d[1]) + (d[2] + d[3]))) * (1.0f / 512.0f) + RMS_EPS; } }
    const int tid = tid_opaque(wv), lane = tid & 63, gw = blk_opaque() * NWAVES + (tid >> 6), NGW = gridDim.x * NWAVES;
    const bf16* QKV = WSP(bf16, WS_QKV); const float* PART = WSP(float, WS_PART); const float* PR = WSP(float, WS_PR);
    const float* kn = A->out + O_KS + (size_t)layer * TS * 512; const float* vn = A->out + O_VS + (size_t)layer * TS * 512;
    bf16* O2 = WSP(bf16, WS_OBR) + 1024;
    for (int it = gw; it < TS * 4; it += NGW) { const int sb = it >> 4, i = (it >> 2) & 3, hd = it & 3, row = TP + sb * 4 + i, c = hd * 128 + 2 * lane;
        const unsigned qw = *(const unsigned*)(QKV + (size_t)row * 1536 + c); const float q0 = bflo(qw), q1 = bfhi(qw);
        const float bias2 = IN_F(I_SBBIAS)[layer * 4 + hd] * LOG2E; float o0 = 0.f, o1 = 0.f, racc = 0.f;
        for (int j = i - 1; j >= 0; --j) { const float* kr = kn + (size_t)(sb * 4 + j) * 512 + c; const float* vr = vn + (size_t)(sb * 4 + j) * 512 + c;
            const float z = fminf(wave_sum(q0 * kr[0] + q1 * kr[1]) + bias2, 60.f), s1 = lg2(1.0f + ex2(z)), pv = ex2(z - s1 - racc); racc += s1; o0 += pv * vr[0]; o1 += pv * vr[1]; }
        for (int u = 31; u >= 0; --u) { const float* pr = PART + ((size_t)(sb * 32 + u) * 4 + i) * 512 + c; const float sc = ex2(-racc); o0 += sc * pr[0]; o1 += sc * pr[1]; racc += PR[(size_t)(sb * 32 + u) * 16 + i * 4 + hd]; }
        *(unsigned*)(O2 + (size_t)row * OBW + c) = pk2(o0, o1); }
}

#ifndef MK_ONE_LAUNCH
#define MK_ONE_LAUNCH 1
#endif
#ifndef REP_P0
#define REP_P0 1
#endif
#ifndef REP_IN
#define REP_IN 1
#endif
#ifndef REP_PREP
#define REP_PREP 1
#endif
#ifndef REP_MIXA
#define REP_MIXA 1
#endif
#ifndef REP_MIXB
#define REP_MIXB 1
#endif
#ifndef REP_MERGE
#define REP_MERGE 1
#endif
#ifndef REP_OUT
#define REP_OUT 1
#endif
#ifndef REP_UP
#define REP_UP 1
#endif
#ifndef REP_DOWN
#define REP_DOWN 1
#endif
#ifndef REP_BAR
#define REP_BAR 1
#endif
#ifndef REP_RES1L0
#define REP_RES1L0 1
#endif
#ifndef REP_BDN
#define REP_BDN 1
#endif
#ifndef REP_BSSD
#define REP_BSSD 1
#endif
#ifndef REP_BSATT
#define REP_BSATT 1
#endif
constexpr int N_PHASES = 24;
__device__ __forceinline__ int queue_pop(unsigned* head, volatile LAS unsigned* slot, const int wv) {
    __syncthreads();
    if (tid_opaque(wv) == 0) *slot = __hip_atomic_fetch_add(head, 1u, __ATOMIC_RELAXED, __HIP_MEMORY_SCOPE_AGENT);
    __syncthreads();
    return (int)*slot;
}
__global__ void __launch_bounds__(NTHR, 2) mega(Args Araw) {
    extern __shared__ __attribute__((aligned(16))) unsigned char lds_raw[];
    LAS unsigned char* lds = (LAS unsigned char*)lds_raw;
    volatile LAS unsigned* MISC = (volatile LAS unsigned*)(lds + MISC_OFF);
    const int wv = __builtin_amdgcn_readfirstlane(threadIdx.x >> 6); const int tid = tid_opaque(wv), G = gridDim.x, blk = blk_opaque();
    if (tid < 16) MISC[tid] = 0u;
    __syncthreads();
    unsigned* ctl = (unsigned*)(Araw.ws + WS_CTL);
    XcdBarrier bar = xcd_barrier_post(ctl + CW_BAR + Araw.li * XCD_BAR_WORDS, MISC, tid);
    const int lo = Araw.ph_lo, hi = Araw.ph_hi;
#define IN(gp) (lo <= (gp) && (gp) < hi)
#define SEAM(gp) do { if (lo <= (gp) && (gp) + 1 < hi) for (int rb_ = 0; rb_ < REP_BAR; ++rb_) xcd_barrier(bar, tid_opaque(wv)); } while (0)

    if (IN(0)) for (int rep = 0; rep < REP_P0; ++rep) { CA A = args_opaque(); p0_prologue(A, lds, wv); }
    SEAM(0);
    if (IN(1)) { CA A = args_opaque(); norm1_phase(A, wv); }
    SEAM(1);
    for (int layer = 0; layer < DEPTH; ++layer) {
        const int gb = 1 + 11 * layer;
        if (IN(gb + 1)) for (int rep = 0; rep < REP_IN; ++rep) { CA A = args_opaque();
            pg8::Gemm g{WSP(bf16, WS_H), WSP(bf16, WS_WIN) + (size_t)layer * NIN * DM, MP, NIN, DM, DM / 64, 0}; pg8::StaticOrder S; S.init(MP, NIN, G, blk_opaque());
            EpiIn E{WSP(float, WS_UF), WSP(bf16, WS_QKV), WSP(bf16, WS_GATE), A->out + O_KP + (size_t)layer * TP * 512, A->out + O_VP + (size_t)layer * TP * 512,
                    A->out + O_KS + (size_t)layer * TS * 512, A->out + O_VS + (size_t)layer * TS * 512, 0.08838834764831845f * LOG2E};
            pg8::gemm_phase<EpiIn, pg8::StaticOrder, true, true>(lds, g, S, E, wv);
        }
        SEAM(gb + 1);
        if (IN(gb + 2)) for (int rep = 0; rep < REP_PREP; ++rep) { CA A = args_opaque(); prep_phase(A, layer, wv); }
        SEAM(gb + 2);
        if (IN(gb + 3)) for (int rep = 0; rep < REP_MIXA; ++rep) { CA A = args_opaque();
            { unsigned* qh = (unsigned*)(A->ws + WS_CTL) + CW_QUEUE + 64 * (layer * 4 + 3) + 1024 * rep;
              for (;;) { const int u = queue_pop(qh, MISC + 4, wv); if (u >= 2048) break; ssd_prep_unit(A, lds, layer, u, wv); } }
            { unsigned* qh = (unsigned*)(A->ws + WS_CTL) + CW_QUEUE + 64 * (layer * 4 + 2) + 1024 * rep;
              for (;;) { const int u = queue_pop(qh, MISC + 4, wv); if (u >= 512) break; dn_chunk_unit(A, lds, layer, u, wv); } }
        }
        SEAM(gb + 3);
        if (IN(gb + 4)) for (int rep = 0; rep < REP_MIXB; ++rep) { CA A = args_opaque();
            for (int r2 = 0; r2 < REP_BDN; ++r2) for (int t = blk; t < 16; t += G) dn_seq2(A, lds, layer, t, wv);
            for (int r2 = 0; r2 < REP_BSSD; ++r2) for (int t = blk; t < 80; t += G) if (t >= 16) ssd_seq2(A, lds, layer, t - 16, wv);
            for (int t = blk; t < 112; t += G) if (t >= 80) dn_seq(A, lds, layer, t - 80 + 16, wv);
            for (int t = blk; t < 240; t += G) if (t >= 112) ssd_seq(A, lds, layer, t - 112 + 64, wv);
            { unsigned* qh = (unsigned*)(A->ws + WS_CTL) + CW_QUEUE + 64 * (layer * 4 + 0) + 1024 * rep;
              for (;;) { const int u = queue_pop(qh, MISC + 4, wv); if (u >= 128) break; attn_prompt_unit(A, lds, layer, u, wv); } }
            for (int r2 = 0; r2 < REP_BSATT; ++r2) { unsigned* qh = (unsigned*)(A->ws + WS_CTL) + CW_QUEUE + 64 * (layer * 4 + 1) + 1024 * rep + 2048 * r2;
              for (;;) { const int u = queue_pop(qh, MISC + 4, wv); if (u >= 256) break; attn_sample_unit(A, lds, layer, u, wv); } }
        }
        SEAM(gb + 4);
        if (IN(gb + 5)) { CA A = args_opaque(); attn_sample_combine(A, layer, wv); }
        SEAM(gb + 5);
        if (IN(gb + 6)) for (int rep = 0; rep < REP_MERGE; ++rep) { CA A = args_opaque();
            pg8::SegOrder<5> S; S.init(TP, DM, G, blk_opaque());
            pg8::Gemm g{WSP(bf16, WS_OBR), WSP(bf16, WS_WBR) + (size_t)layer * DM * OBW, TP, DM, OBW, 8, 1024};
            EpiMergeR E{WSP(bf16, WS_GATE), WSP(float, WS_RS), WSP(bf16, WS_MGB)};
            pg8::gemm_phase<EpiMergeR, pg8::SegOrder<5>, true, true>(lds, g, S, E, wv);
            sample_merge(A, lds, layer, wv);
        }
        SEAM(gb + 6);
        if (IN(gb + 7)) for (int rep = 0; rep < REP_OUT; ++rep) { CA A = args_opaque();
            pg8::Gemm g{WSP(bf16, WS_MGB), WSP(bf16, WS_WOUT) + (size_t)layer * DM * DM, TP, DM, DM, DM / 64, 0}; pg8::StaticOrder S; S.init(TP, DM, G, blk_opaque());
            EpiF32 E{WSP(float, WS_MIX), DM}; pg8::gemm_phase<EpiF32, pg8::StaticOrder, true, true>(lds, g, S, E, wv);
            { ALBf16 al{WSP(bf16, WS_MGB) + (size_t)TP * DM, DM}; sample_splitk(al, WSP(bf16, WS_WOUT) + (size_t)layer * DM * DM, DM, 128, 16, 4, WSP(float, WS_OUTS), DM, wv); }
        }
        SEAM(gb + 7);
        if (IN(gb + 8)) for (int rep = 0; rep < (layer == 0 ? REP_RES1L0 : 1); ++rep) { CA A = args_opaque(); resid_phase(A, WSP(float, WS_MIX), WSP(float, WS_OUTS), IN_F(I_NMPOST) + layer * DM, IN_F(I_NLPRE) + layer * DM, layer == 0, wv); }
        SEAM(gb + 8);
        if (IN(gb + 9)) for (int rep = 0; rep < REP_UP; ++rep) { CA A = args_opaque();
            pg8::Gemm g{WSP(bf16, WS_H), WSP(bf16, WS_WUP) + (size_t)layer * DFF * DM, TP, DFF, DM, DM / 64, 0}; pg8::StaticOrder S; S.init(TP, DFF, G, blk_opaque());
            EpiRelu2 E{WSP(bf16, WS_F), DFF}; pg8::gemm_phase<EpiRelu2, pg8::StaticOrder, true, true>(lds, g, S, E, wv);
            sample_up(A, lds, layer, wv);
        }
        SEAM(gb + 9);
        if (IN(gb + 10)) for (int rep = 0; rep < REP_DOWN; ++rep) { CA A = args_opaque();
            pg8::Gemm g{WSP(bf16, WS_F), WSP(bf16, WS_WDN) + (size_t)layer * DM * DFF, TP, DM, DFF, DFF / 64, 0}; pg8::StaticOrder S; S.init(TP, DM, G, blk_opaque());
            EpiF32 E{WSP(float, WS_FD), DM}; pg8::gemm_phase<EpiF32, pg8::StaticOrder, true, true>(lds, g, S, E, wv);
            { ALBf16 al{WSP(bf16, WS_F) + (size_t)TP * DFF, DFF}; sample_splitk(al, WSP(bf16, WS_WDN) + (size_t)layer * DM * DFF, DFF, 128, 16, 16, WSP(float, WS_DNS), DM, wv); }
        }
        SEAM(gb + 10);
        if (IN(gb + 11)) { CA A = args_opaque(); resid_phase(A, WSP(float, WS_FD), WSP(float, WS_DNS), IN_F(I_NLPOST) + layer * DM, layer + 1 < DEPTH ? IN_F(I_NMPRE) + (layer + 1) * DM : nullptr, false, wv); }
        SEAM(gb + 11);
    }
#undef IN
#undef SEAM
}

extern "C" void kernel_launch(void* const* d_in, const int* in_sizes, int n_in, void* d_out, int out_size, void* d_ws, size_t ws_size, hipStream_t stream) {
    static int grid = 0;
    if (grid == 0) {
        if (n_in != N_IN || (size_t)out_size != O_END || ws_size < WS_END) { fprintf(stderr, "kernel_launch: unexpected problem (n_in %d, out %d vs %zu, ws %zu vs %zu); nothing launched\n", n_in, out_size, (size_t)O_END, ws_size, (size_t)WS_END); grid = -1; return; }
        int dev = 0, cus = 0, per_cu = 0;
        if (hipGetDevice(&dev) != hipSuccess || hipDeviceGetAttribute(&cus, hipDeviceAttributeMultiprocessorCount, dev) != hipSuccess) { grid = -1; return; }
        if (hipFuncSetAttribute((const void*)mega, hipFuncAttributeMaxDynamicSharedMemorySize, LDS_BYTES) != hipSuccess) { fprintf(stderr, "kernel_launch: hipFuncSetAttribute failed\n"); grid = -1; return; }
        if (hipOccupancyMaxActiveBlocksPerMultiprocessor(&per_cu, (const void*)mega, NTHR, LDS_BYTES) != hipSuccess || per_cu < 1) fprintf(stderr, "kernel_launch: occupancy query says %d blocks per CU\n", per_cu);
        (void)hipGetLastError();
        grid = cus;
    }
    if (grid < 0) return;
    (void)in_sizes;
    hipMemsetAsync((char*)d_ws + WS_CTL, 0, CTL_BYTES, stream);
    Args a{};
    for (int i = 0; i < N_IN; ++i) a.in[i] = d_in[i];
    a.out = (float*)d_out; a.ws = (unsigned char*)d_ws; a.pad = 0;
#if MK_ONE_LAUNCH
    a.ph_lo = 0; a.ph_hi = N_PHASES; a.li = 0;
    hipLaunchKernelGGL(mega, dim3(grid), dim3(NTHR), LDS_BYTES, stream, a);
#else
    for (int gp = 0; gp < N_PHASES; ++gp) { a.ph_lo = gp; a.ph_hi = gp + 1; a.li = 0; hipLaunchKernelGGL(mega, dim3(grid), dim3(NTHR), LDS_BYTES, stream, a); }
#endif
}
```

```cpp
#include <hip/hip_runtime.h>
#include <cstdio>
#include <cstdint>
__device__ __forceinline__ int lane_opaque() { unsigned m = ~0u; asm volatile("" : "+s"(m)); return (int)__builtin_amdgcn_mbcnt_hi(m, __builtin_amdgcn_mbcnt_lo(m, 0u)); }
__device__ __forceinline__ int tid_opaque(int wv) { return wv * 64 + lane_opaque(); }
__device__ __forceinline__ int blk_opaque() { int t = blockIdx.x; asm volatile("" : "+s"(t)); return t; }
namespace pg8 {
#define PG8_LAS __attribute__((address_space(3)))
typedef unsigned short bf16_t;
typedef short bf16x8 __attribute__((ext_vector_type(8)));
typedef float f32x4 __attribute__((ext_vector_type(4)));
typedef unsigned u32x4 __attribute__((ext_vector_type(4)));
constexpr int BM = 256, BK = 64, HALF = 128, HTB = HALF * BK * 2  , STAGE_BYTES = 8 * HTB, NXCD = 8, WGM = 8;

__host__ __device__ __forceinline__ int lds_byte(int r, int c) { const int st = (r >> 4) * 2 + (c >> 5), rr = r & 15, cc = c & 31, ob = rr * 64 + cc * 2; return st * 1024 + (ob ^ (((ob >> 9) & 1) << 5)); }
__host__ __device__ __forceinline__ void stage_rc(int b, int& R, int& C) { const int st = b / 1024, sb = b % 1024, swz = sb ^ (((sb >> 9) & 1) << 5); R = (st >> 1) * 16 + swz / 64; C = (st & 1) * 32 + (swz % 64) / 2; }
__host__ __device__ __forceinline__ int perm32(int rho) { const int n = rho >> 4, i = rho & 15; return 8 * (i >> 2) + 4 * n + (i & 3); }

struct Unit { int pm, pn, seg; };
struct Gemm { const bf16_t* A; const bf16_t* Bt; int M, N, K, KT, SEGB; };

struct StaticOrder {
    int nM, nN, nwg, G, c;
    __host__ __device__ void init(int M, int N, int G_, int c_) { nM = M / BM; nN = N / BM; nwg = nM * nN; G = G_; c = c_; }
    __host__ __device__ bool next(int i, Unit& u) const {
        const long L = (long)i * G + c; if (L >= nwg) return false;
        int wgid = (int)L; { const int q = nwg / NXCD, r = nwg % NXCD, xcd = wgid % NXCD, off = wgid / NXCD; wgid = (xcd < r ? xcd * (q + 1) : r * (q + 1) + (xcd - r) * q) + off; }
        const int nig = WGM * nN, gid = wgid / nig, fm = gid * WGM, gsz = (nM - fm) < WGM ? (nM - fm) : WGM;
        u.pm = fm + ((wgid % nig) % gsz); u.pn = (wgid % nig) / gsz; u.seg = 0; return true;
    }
    __device__ __forceinline__ void a_ready(const Unit&) const {}
    __device__ __forceinline__ void done(const Unit&) const {}
};
template <int NSEG> struct SegOrder : StaticOrder {
    __host__ __device__ bool next(int i, Unit& u) const { if (!StaticOrder::next(i / NSEG, u)) return false; u.seg = i % NSEG; return true; }
};
__device__ __forceinline__ unsigned cvt_pk_bf16(float lo, float hi) { unsigned r; asm volatile("v_cvt_pk_bf16_f32 %0, %1, %2" : "=v"(r) : "v"(lo), "v"(hi)); return r; }
typedef float f32x2 __attribute__((ext_vector_type(2)));
template <class Epi, class Sched, bool ALIGN_EPI = false, bool SP2 = false>
__device__ __forceinline__ void gemm_phase(PG8_LAS unsigned char* lds, const Gemm g, const Sched& S, const Epi& E, const int wv) {
    int wvo = wv; asm volatile("" : "+s"(wvo));
    const int lane = lane_opaque(), tid = wvo * 64 + lane, wid = wvo, wr = wid >> 2, wc = wid & 3, fr = lane & 15, fq = lane >> 4;
    const int K = g.K, nt = g.KT;
    unsigned voffA[2], voffB[2];
#pragma unroll
    for (int i = 0; i < 2; ++i) { int R, C; stage_rc(tid * 16 + i * 8192, R, C); const int Rb = Epi::PERM ? ((R & ~31) + perm32(R & 31)) : R;
        voffA[i] = (unsigned)(R * K + C) * 2u; voffB[i] = (unsigned)(Rb * K + C) * 2u; }
    const size_t kstep = (size_t)(BK * 2);
    const size_t hstep = (size_t)HALF * K * 2;
    const size_t tstep = 2 * hstep;
    const unsigned ldsw = (unsigned)wid * 1024u;
    const int aoff = lds_byte(wr * 64 + fr, fq * 8), boff = lds_byte(wc * 32 + fr, fq * 8);
#define PG8_SA(b, h) (((b) * 2 + (h)) * HTB)
#define PG8_SB(b, h) ((4 + (b) * 2 + (h)) * HTB)
#define PG8_STAGE(bufoff, gbase, voff) do { _Pragma("unroll") for (int _i = 0; _i < 2; ++_i) \
        __builtin_amdgcn_global_load_lds((const unsigned*)((const char*)(gbase) + (voff)[_i]), (PG8_LAS unsigned*)(lds + (bufoff) + ldsw + _i * 8192), 16, 0, 0); } while (0)
#define PG8_LDA(dst, b, h) do { _Pragma("unroll") for (int m = 0; m < 4; ++m) _Pragma("unroll") for (int k = 0; k < 2; ++k) dst[m][k] = *(const PG8_LAS bf16x8*)(lds + PG8_SA(b, h) + aoff + m * 2048 + k * 1024); } while (0)
#define PG8_LDB(dst, b, h) do { _Pragma("unroll") for (int n = 0; n < 2; ++n) _Pragma("unroll") for (int k = 0; k < 2; ++k) dst[n][k] = *(const PG8_LAS bf16x8*)(lds + PG8_SB(b, h) + boff + n * 2048 + k * 1024); } while (0)
#define PG8_MMA(ai, bj, At, Bt) do { __builtin_amdgcn_s_setprio(1); _Pragma("unroll") for (int m = 0; m < 4; ++m) _Pragma("unroll") for (int n = 0; n < 2; ++n) _Pragma("unroll") for (int k = 0; k < 2; ++k) \
        acc[ai][bj][m][n] = __builtin_amdgcn_mfma_f32_16x16x32_bf16(Bt[n][k], At[m][k], acc[ai][bj][m][n], 0, 0, 0); __builtin_amdgcn_s_setprio(0); } while (0)
#define PG8_WAIT_V(n) asm volatile("s_waitcnt vmcnt(" #n ")" ::: "memory")
#define PG8_WAIT_L(n) asm volatile("s_waitcnt lgkmcnt(" #n ")" ::: "memory")
#define PG8_BAR __builtin_amdgcn_s_barrier()
#define PG8_SCHED __builtin_amdgcn_sched_barrier(0)
    Unit cur, nxt; int ui = 0;
    if (!S.next(0, cur)) return;
    f32x4 acc[2][2][4][2];
#pragma unroll
    for (int a = 0; a < 2; ++a)
#pragma unroll
        for (int b = 0; b < 2; ++b)
#pragma unroll
            for (int m = 0; m < 4; ++m)
#pragma unroll
                for (int n = 0; n < 2; ++n) acc[a][b][m][n] = (f32x4){0.f, 0.f, 0.f, 0.f};
    bf16x8 At[4][2], B0[2][2], B1[2][2];
    const char* cA = (const char*)g.A + (size_t)cur.pm * tstep + (size_t)cur.seg * g.SEGB; const char* cB = (const char*)g.Bt + (size_t)cur.pn * tstep + (size_t)cur.seg * g.SEGB;
    S.a_ready(cur);
    if constexpr (SP2) {
        PG8_STAGE(PG8_SB(0, 0), cB, voffB); PG8_STAGE(PG8_SB(0, 1), cB + hstep, voffB); PG8_STAGE(PG8_SA(0, 0), cA, voffA); PG8_STAGE(PG8_SA(0, 1), cA + hstep, voffA);
        if (wr == 1) PG8_BAR;
        PG8_WAIT_V(2); PG8_BAR;
        PG8_STAGE(PG8_SB(1, 0), cB + kstep, voffB); PG8_STAGE(PG8_SA(1, 0), cA + kstep, voffA); PG8_STAGE(PG8_SB(1, 1), cB + hstep + kstep, voffB);
        PG8_WAIT_V(6); PG8_BAR;
    } else {
        PG8_STAGE(PG8_SB(0, 0), cB, voffB); PG8_STAGE(PG8_SA(0, 0), cA, voffA); PG8_STAGE(PG8_SB(0, 1), cB + hstep, voffB); PG8_STAGE(PG8_SA(0, 1), cA + hstep, voffA);
        if (wr == 1) PG8_BAR;
        PG8_WAIT_V(4); PG8_BAR;
        PG8_STAGE(PG8_SB(1, 0), cB + kstep, voffB); PG8_STAGE(PG8_SA(1, 0), cA + kstep, voffA); PG8_STAGE(PG8_SB(1, 1), cB + hstep + kstep, voffB);
        PG8_WAIT_V(6); PG8_BAR;
    }
    for (;;) {
        const bool has_next = S.next(ui + 1, nxt);
        const char* nA = has_next ? (const char*)g.A + (size_t)nxt.pm * tstep + (size_t)nxt.seg * g.SEGB : cA; const char* nB = has_next ? (const char*)g.Bt + (size_t)nxt.pn * tstep + (size_t)nxt.seg * g.SEGB : cB;
        for (int t = 0; t < nt; t += 2) {
            const bool last = (t == nt - 2);
            const char* a1 = cA + (size_t)(t + 1) * kstep;
            const char* a2 = last ? nA : cA + (size_t)(t + 2) * kstep; const char* b2 = last ? nB : cB + (size_t)(t + 2) * kstep;
            const char* a3 = a2 + kstep; const char* b3 = b2 + kstep;
            if (last && has_next) S.a_ready(nxt);
            if constexpr (SP2) {
            PG8_LDB(B0, 0, 0); PG8_LDB(B1, 0, 1); PG8_SCHED; PG8_LDA(At, 0, 0); PG8_STAGE(PG8_SA(1, 1), a1 + hstep, voffA);
            PG8_WAIT_V(8); PG8_WAIT_L(0); PG8_BAR; PG8_MMA(0, 0, At, B0); PG8_MMA(0, 1, At, B1); PG8_BAR; PG8_SCHED;
            PG8_LDA(At, 0, 1); PG8_STAGE(PG8_SB(0, 0), b2, voffB); PG8_STAGE(PG8_SB(0, 1), b2 + hstep, voffB); PG8_STAGE(PG8_SA(0, 0), a2, voffA);
            PG8_WAIT_V(8); PG8_WAIT_L(0); PG8_BAR; PG8_MMA(1, 0, At, B0); PG8_MMA(1, 1, At, B1); PG8_BAR; PG8_SCHED;
            PG8_LDB(B0, 1, 0); PG8_LDB(B1, 1, 1); PG8_SCHED; PG8_LDA(At, 1, 0); PG8_STAGE(PG8_SA(0, 1), a2 + hstep, voffA);
            PG8_WAIT_V(8); PG8_WAIT_L(0); PG8_BAR; PG8_MMA(0, 0, At, B0); PG8_MMA(0, 1, At, B1); PG8_BAR; PG8_SCHED;
            PG8_LDA(At, 1, 1); PG8_STAGE(PG8_SB(1, 0), b3, voffB); PG8_STAGE(PG8_SB(1, 1), b3 + hstep, voffB); PG8_STAGE(PG8_SA(1, 0), a3, voffA);
            PG8_WAIT_V(8); PG8_WAIT_L(0); PG8_BAR; PG8_MMA(1, 0, At, B0); PG8_MMA(1, 1, At, B1); PG8_BAR; PG8_SCHED;
            } else {
            PG8_LDB(B0, 0, 0); PG8_SCHED; PG8_LDA(At, 0, 0); PG8_STAGE(PG8_SA(1, 1), a1 + hstep, voffA);
            PG8_WAIT_L(8); PG8_BAR; PG8_WAIT_L(0); PG8_MMA(0, 0, At, B0); PG8_BAR; PG8_SCHED;
            PG8_LDB(B1, 0, 1); PG8_STAGE(PG8_SB(0, 0), b2, voffB);
            PG8_BAR; PG8_WAIT_L(0); PG8_MMA(0, 1, At, B1); PG8_BAR;
            PG8_LDA(At, 0, 1); PG8_STAGE(PG8_SA(0, 0), a2, voffA);
            PG8_BAR; PG8_WAIT_L(0); PG8_MMA(1, 0, At, B0); PG8_BAR; PG8_SCHED;
            PG8_STAGE(PG8_SB(0, 1), b2 + hstep, voffB);
            PG8_WAIT_V(6); PG8_BAR; PG8_MMA(1, 1, At, B1); PG8_BAR;
            PG8_LDB(B0, 1, 0); PG8_SCHED; PG8_LDA(At, 1, 0); PG8_STAGE(PG8_SA(0, 1), a2 + hstep, voffA);
            PG8_WAIT_L(8); PG8_BAR; PG8_WAIT_L(0); PG8_MMA(0, 0, At, B0); PG8_BAR; PG8_SCHED;
            PG8_LDB(B1, 1, 1); PG8_STAGE(PG8_SB(1, 0), b3, voffB);
            PG8_BAR; PG8_WAIT_L(0); PG8_MMA(0, 1, At, B1); PG8_BAR;
            PG8_LDA(At, 1, 1); PG8_STAGE(PG8_SA(1, 0), a3, voffA);
            PG8_BAR; PG8_WAIT_L(0); PG8_MMA(1, 0, At, B0); PG8_BAR; PG8_SCHED;
            PG8_STAGE(PG8_SB(1, 1), b3 + hstep, voffB);
            PG8_WAIT_V(6); PG8_BAR; PG8_MMA(1, 1, At, B1); PG8_BAR;
            }
        }
        if constexpr (ALIGN_EPI) { if (wr == 0) PG8_BAR; }
        if constexpr (!Epi::AFTER_DRAIN) { E(acc, cur, wr, wc, fr, fq); S.done(cur); }
        if (!has_next) break;
        if (!(Epi::KEEP_ACC && nxt.seg != 0)) {
#pragma unroll
        for (int a = 0; a < 2; ++a)
#pragma unroll
            for (int b = 0; b < 2; ++b)
#pragma unroll
                for (int m = 0; m < 4; ++m)
#pragma unroll
                    for (int n = 0; n < 2; ++n) acc[a][b][m][n] = (f32x4){0.f, 0.f, 0.f, 0.f}; }
        cur = nxt; cA = nA; cB = nB; ++ui;
        if constexpr (ALIGN_EPI) { if (wr == 1) PG8_BAR; }
    }
    PG8_WAIT_V(0);
    if constexpr (!ALIGN_EPI) { if (wr == 0) PG8_BAR; }
    PG8_BAR;
    if constexpr (Epi::AFTER_DRAIN) { E.fused(acc, cur, wr, wc, fr, fq, lds, wid, lane); S.done(cur); }
#undef PG8_SA
#undef PG8_SB
#undef PG8_STAGE
#undef PG8_LDA
#undef PG8_LDB
#undef PG8_MMA
#undef PG8_WAIT_V
#undef PG8_WAIT_L
#undef PG8_BAR
#undef PG8_SCHED
}
}

constexpr int DM = 2048, NBATCH = 4, SEQ = 2048, DEPTH = 2, DBATCH = 8, DSEQ = 4, PAST = 16384, PAGE = 128;
constexpr int TP = NBATCH * SEQ;
constexpr int TS = DBATCH * DSEQ;
constexpr int TT = TP + TS;
constexpr int MP = 8448;
constexpr int NPAGES = PAST / PAGE;
constexpr int NPOOL = 1280;
constexpr int POOLW = 512, DNC = 1536, SBW = 512, SSI = 1024, SSC = 1536, DFF = 8192;
constexpr int INCOLS = 14872, NIN = 15104;
constexpr int OBW = 2560;
constexpr int UFW = 5376;
constexpr int UF_POOL = 0, UF_DNQKV = 512, UF_DNZ = 2048, UF_SSZ = 2560, UF_XBC = 3584, UF_SMALL = 5120;
constexpr float RMS_EPS = 1e-6f;
constexpr float LOG2E = 1.4426950408889634f;
constexpr int NWAVES = 8, NTHR = 512;

constexpr size_t O_Y = 0;
constexpr size_t O_KP = O_Y + (size_t)TT * DM;
constexpr size_t O_VP = O_KP + (size_t)DEPTH * TP * 512;
constexpr size_t O_POOLP = O_VP + (size_t)DEPTH * TP * 512;
constexpr size_t O_DNCP = O_POOLP + (size_t)DEPTH * NBATCH * 15 * 512;
constexpr size_t O_DNSP = O_DNCP + (size_t)DEPTH * NBATCH * 3 * 1536;
constexpr size_t O_SSCP = O_DNSP + (size_t)DEPTH * NBATCH * 4 * 128 * 128;
constexpr size_t O_SSHP = O_SSCP + (size_t)DEPTH * NBATCH * 3 * 1536;
constexpr size_t O_KS = O_SSHP + (size_t)DEPTH * NBATCH * 16 * 64 * 128;
constexpr size_t O_VS = O_KS + (size_t)DEPTH * TS * 512;
constexpr size_t O_POOLS = O_VS + (size_t)DEPTH * TS * 512;
constexpr size_t O_DNCS = O_POOLS + (size_t)DEPTH * DBATCH * 15 * 512;
constexpr size_t O_DNSS = O_DNCS + (size_t)DEPTH * DBATCH * 3 * 1536;
constexpr size_t O_SSCS = O_DNSS + (size_t)DEPTH * DBATCH * 4 * 128 * 128;
constexpr size_t O_SSHS = O_SSCS + (size_t)DEPTH * DBATCH * 3 * 1536;
constexpr size_t O_END = O_SSHS + (size_t)DEPTH * DBATCH * 16 * 64 * 128;

constexpr size_t al256(size_t x) { return (x + 255) & ~(size_t)255; }
constexpr size_t WS_CTL = 0, CTL_BYTES = 1u << 20;
constexpr size_t SZ_WIN = (size_t)NIN * DM * 2, SZ_WBR = (size_t)5 * DM * 512 * 2, SZ_WOUT = (size_t)DM * DM * 2, SZ_WUP = (size_t)DFF * DM * 2, SZ_WDN = (size_t)DM * DFF * 2;
constexpr size_t WS_WIN = WS_CTL + CTL_BYTES;
constexpr size_t WS_WBR = WS_WIN + 2 * SZ_WIN;
constexpr size_t WS_WOUT = WS_WBR + 2 * SZ_WBR;
constexpr size_t WS_WUP = WS_WOUT + 2 * SZ_WOUT;
constexpr size_t WS_WDN = WS_WUP + 2 * SZ_WUP;
constexpr size_t WS_H = WS_WDN + 2 * SZ_WDN;
constexpr size_t WS_UF = WS_H + (size_t)MP * DM * 2;
constexpr size_t WS_QKV = WS_UF + (size_t)MP * UFW * 4;
constexpr size_t WS_GATE = WS_QKV + (size_t)MP * 1536 * 2;
constexpr size_t WS_DNQ = WS_GATE + (size_t)MP * 8192 * 2;
constexpr size_t WS_XBC = WS_DNQ + (size_t)MP * 1536 * 4;
constexpr size_t WS_SCAL = WS_XBC + (size_t)MP * 1536 * 4;
constexpr size_t WS_OBR = WS_SCAL + (size_t)MP * 32 * 4;
constexpr size_t SZ_OBR = (size_t)MP * 512 * 2;
constexpr size_t WS_SSQ = WS_OBR + 5 * SZ_OBR;
constexpr size_t WS_MG32 = WS_SSQ + (size_t)MP * 32 * 4;
constexpr size_t WS_MGB = WS_MG32 + (size_t)MP * DM * 4;
constexpr size_t WS_MIX = WS_MGB + (size_t)MP * DM * 2;
constexpr size_t WS_F = WS_MIX + (size_t)MP * DM * 4;
constexpr size_t WS_FD = WS_F + (size_t)MP * DFF * 2;
constexpr size_t WS_PART = WS_FD + (size_t)MP * DM * 4;
constexpr size_t WS_PR = WS_PART + (size_t)256 * 2048 * 4;
constexpr size_t WS_DNU = WS_PR + (size_t)256 * 16 * 4;
constexpr size_t WS_SSU = WS_DNU + (size_t)512 * 90368;
constexpr size_t WS_SSG = WS_SSU + (size_t)2048 * 16896;
constexpr size_t WS_MGS = WS_SSG + (size_t)256 * 49152;
constexpr size_t WS_OUTS = WS_MGS + (size_t)5 * TS * DM * 4;
constexpr size_t WS_UPS = WS_OUTS + (size_t)16 * TS * DM * 4;
constexpr size_t WS_DNS = WS_UPS + (size_t)4 * TS * DFF * 4;
constexpr size_t WS_RS = WS_DNS + (size_t)16 * TS * DM * 4;
constexpr size_t WS_DNO = WS_RS + (size_t)MP * 2 * 4;
constexpr size_t WS_DNSQ = WS_DNO + (size_t)TP * 512 * 4;
constexpr size_t WS_END = WS_DNSQ + (size_t)TP * 32 * 4;
static_assert(WS_WIN % 256 == 0 && WS_H % 256 == 0 && WS_UF % 256 == 0 && WS_OBR % 256 == 0 && WS_MG32 % 256 == 0 && WS_PART % 256 == 0, "ws alignment");

constexpr int CW_QUEUE = 64;
constexpr int CW_BAR = 4096;

constexpr int LDS_BYTES = 147456;
constexpr int RING_BYTES = 131072;
constexpr int MISC_OFF = RING_BYTES;

#define GAS __attribute__((address_space(1)))
#define LAS __attribute__((address_space(3)))
typedef unsigned short bf16;
typedef unsigned v4u __attribute__((ext_vector_type(4)));
typedef unsigned v2u __attribute__((ext_vector_type(2)));
typedef float f32x4 __attribute__((ext_vector_type(4)));
typedef float f32x2 __attribute__((ext_vector_type(2)));
typedef float f32x16 __attribute__((ext_vector_type(16)));
typedef short bf16x8 __attribute__((ext_vector_type(8)));
__device__ __forceinline__ unsigned pk2(float lo, float hi) { unsigned r; asm("v_cvt_pk_bf16_f32 %0, %1, %2" : "=v"(r) : "v"(lo), "v"(hi)); return r; }
__device__ __forceinline__ unsigned f2bf(float f) { return pk2(f, f) & 0xffffu; }
__device__ __forceinline__ float bflo(unsigned w) { return __builtin_bit_cast(float, w << 16); }
__device__ __forceinline__ float bfhi(unsigned w) { return __builtin_bit_cast(float, w & 0xffff0000u); }
__device__ __forceinline__ float row16_sum(float x) {
    x += __builtin_bit_cast(float, __builtin_amdgcn_update_dpp(0, __builtin_bit_cast(int, x), 0x128, 0xf, 0xf, false));
    x += __builtin_bit_cast(float, __builtin_amdgcn_update_dpp(0, __builtin_bit_cast(int, x), 0x124, 0xf, 0xf, false));
    x += __builtin_bit_cast(float, __builtin_amdgcn_update_dpp(0, __builtin_bit_cast(int, x), 0x122, 0xf, 0xf, false));
    x += __builtin_bit_cast(float, __builtin_amdgcn_update_dpp(0, __builtin_bit_cast(int, x), 0x121, 0xf, 0xf, false));
    return x;
}
__device__ __forceinline__ float rdlane(float x, int l) { return __builtin_bit_cast(float, __builtin_amdgcn_readlane(__builtin_bit_cast(int, x), l)); }
__device__ __forceinline__ float wave_sum(float v) { const float r = row16_sum(v); return (rdlane(r, 0) + rdlane(r, 16)) + (rdlane(r, 32) + rdlane(r, 48)); }
__device__ __forceinline__ float wave_scan(float x, int lane) {
    x += __builtin_bit_cast(float, __builtin_amdgcn_update_dpp(0, __builtin_bit_cast(int, x), 0x111, 0xf, 0xf, true));
    x += __builtin_bit_cast(float, __builtin_amdgcn_update_dpp(0, __builtin_bit_cast(int, x), 0x112, 0xf, 0xf, true));
    x += __builtin_bit_cast(float, __builtin_amdgcn_update_dpp(0, __builtin_bit_cast(int, x), 0x114, 0xf, 0xf, true));
    x += __builtin_bit_cast(float, __builtin_amdgcn_update_dpp(0, __builtin_bit_cast(int, x), 0x118, 0xf, 0xf, true));
    const float t0 = rdlane(x, 15), t1 = rdlane(x, 31), t2 = rdlane(x, 47);
    return x + (lane >= 48 ? (t0 + t1) + t2 : (lane >= 32 ? t0 + t1 : (lane >= 16 ? t0 : 0.f)));
}
__device__ __forceinline__ float fexp(float x) { return __builtin_amdgcn_exp2f(x * 1.4426950408889634f); }
__device__ __forceinline__ float sigmoidf_(float x) { return 1.0f / (1.0f + __expf(-x)); }
__device__ __forceinline__ float siluf_(float x) { return x / (1.0f + __expf(-x)); }
__device__ __forceinline__ float softplusf_(float x) { const float e = fexp(fminf(x, 20.f)); const float l = e < 0.01f ? e * (1.0f - e * (0.5f - e * 0.33333333f)) : __builtin_amdgcn_logf(1.0f + e) * 0.6931471805599453f; return x > 20.f ? x : l; }
__device__ __forceinline__ float ex2(float x) { return __builtin_amdgcn_exp2f(x); }
__device__ __forceinline__ float lg2(float x) { return __builtin_amdgcn_logf(x); }
#define XB_TMO      128
#define XB_XCNT(j)  (256  + 64 * (j))
#define XB_XSUB(j)  (1280 + 64 * (j))
#define XB_XGEN(j)  (2304 + 64 * (j))
#define XB_TOP      3328
#define XB_TOPGEN   3392
#define XCD_BAR_WORDS 3456
#define XB_SPIN_CAP (1u << 18)

__device__ __forceinline__ unsigned xb_ld(unsigned* p)              { return __hip_atomic_load(p, __ATOMIC_RELAXED, __HIP_MEMORY_SCOPE_AGENT); }
__device__ __forceinline__ unsigned xb_add(unsigned* p, unsigned v) { return __hip_atomic_fetch_add(p, v, __ATOMIC_RELAXED, __HIP_MEMORY_SCOPE_AGENT); }
__device__ __forceinline__ unsigned xb_xcc_id() { return (unsigned)__builtin_amdgcn_s_getreg((3 << 11) | 20) & 0xFu; }
#define XB_SPIN(cond, bar) do { unsigned _sp = 0; while (cond) { __builtin_amdgcn_s_sleep(1); \
    if ((++_sp & 255u) == 0u) { if (xb_ld(&(bar)[XB_TMO])) break; if (_sp > XB_SPIN_CAP) { atomicAdd(&(bar)[XB_TMO], 1u); break; } } } } while (0)

struct XcdBarrier {
    unsigned* bar; unsigned x;
    volatile LAS unsigned* st;
};

__device__ __forceinline__ XcdBarrier xcd_barrier_post(unsigned* bar, volatile LAS unsigned* st, const int tid) {
    XcdBarrier b; b.bar = bar; b.x = xb_xcc_id(); b.st = st;
    if (tid == 0) (void)xb_add(&bar[XB_XCNT(b.x)], 1u);
    return b;
}
__device__ __forceinline__ void xcd_barrier_complete(unsigned* bar, unsigned x, unsigned& nloc, unsigned& nx) {
    const unsigned G = gridDim.x * gridDim.y * gridDim.z;
    unsigned sum, cnt, mine, sp = 0u;
    for (;;) {
        sum = 0u; cnt = 0u; mine = 0u;
#pragma unroll
        for (unsigned j = 0; j < 16; ++j) { const unsigned c = xb_ld(&bar[XB_XCNT(j)]); sum += c; cnt += (c > 0u) ? 1u : 0u; mine = (j == x) ? c : mine; }
        if (sum == G) break;
        __builtin_amdgcn_s_sleep(1);
        if ((++sp & 255u) == 0u) { if (xb_ld(&bar[XB_TMO])) break; if (sp > XB_SPIN_CAP) { atomicAdd(&bar[XB_TMO], 1u); break; } }
    }
    nloc = mine > 0u ? mine : 1u; nx = cnt > 0u ? cnt : 1u;
}

__device__ __forceinline__ void xcd_barrier(const XcdBarrier& b, const int tid) {
    asm volatile("s_waitcnt vmcnt(0)" ::: "memory");
    __syncthreads();
    if (tid == 0) {
        unsigned* bar = b.bar;
        __builtin_amdgcn_s_waitcnt(0);
        unsigned nloc = b.st[0], nx = b.st[1];
        if (nloc == 0u) { xcd_barrier_complete(bar, b.x, nloc, nx); b.st[0] = nloc; b.st[1] = nx; }
        const unsigned old = xb_add(&bar[XB_XSUB(b.x)], 1u);
        const unsigned gen = old / nloc;
        if (old + 1u == (gen + 1u) * nloc) {
            __builtin_amdgcn_fence(__ATOMIC_RELEASE, "agent");
            asm volatile("s_waitcnt vmcnt(0)" ::: "memory");
            const unsigned og = xb_add(&bar[XB_TOP], 1u);
            const unsigned tg = og / nx;
            if (og + 1u == (tg + 1u) * nx) xb_add(&bar[XB_TOPGEN], 1u);
            else XB_SPIN(xb_ld(&bar[XB_TOPGEN]) == tg, bar);
            __builtin_amdgcn_fence(__ATOMIC_ACQUIRE, "agent");
            xb_add(&bar[XB_XGEN(b.x)], 1u);
            asm volatile("s_waitcnt vmcnt(0)" ::: "memory");
        } else {
            XB_SPIN(xb_ld(&bar[XB_XGEN(b.x)]) == gen, bar);
            __builtin_amdgcn_fence(__ATOMIC_ACQUIRE, "agent");
            asm volatile("s_waitcnt vmcnt(0)" ::: "memory");
        }
    }
    __syncthreads();
}

enum { I_XP = 0, I_XS, I_CK, I_CV, I_SPOOL, I_SDNC, I_SDNS, I_SSSC, I_SSSH, I_PT, I_NMPRE, I_NMPOST, I_NLPRE, I_NLPOST, I_WIN, I_POOLW, I_POOLSC, I_DNCW, I_DNALOG, I_DNDTB, I_DNNW, I_SBBIAS,
       I_SSCW, I_SSCB, I_SSALOG, I_SSDTB, I_SSD, I_SSNW, I_WBR, I_WOUT, I_WUP, I_WDN, N_IN };
struct Args { const void* in[N_IN]; float* out; unsigned char* ws; int ph_lo, ph_hi, li, pad; };
#define IN_F(i) ((const float*)A->in[i])
#define WSP(T, off) ((T*)(A->ws + (off)))
typedef const __attribute__((opencl_constant)) Args* CA;
__device__ __forceinline__ CA args_opaque() { auto p = __builtin_amdgcn_kernarg_segment_ptr(); asm volatile("" : "+s"(p)); return (CA)p; }

struct EpiIn {
    static constexpr bool PERM = true, AFTER_DRAIN = false, KEEP_ACC = false;
    float* UF; bf16* QKV; bf16* GATE; float *kp, *vp, *ks, *vs; float qscale;
    __device__ __forceinline__ void operator()(f32x4 (&acc)[2][2][4][2], const pg8::Unit& u, int wr, int wc, int fr, int fq) const {
        const int pn = u.pn, row0 = u.pm * 256 + wr * 64 + fr, cl = wc * 32 + 8 * fq;
        if (pn < 10 || (pn >= 16 && pn < 26) || pn == 58) {
            const int col0 = pn * 256 + (pn < 10 ? 0 : (pn < 26 ? -1536 : -9728)) + cl;
#pragma unroll
            for (int ai = 0; ai < 2; ++ai)
#pragma unroll
                for (int m = 0; m < 4; ++m) { float* rowp = UF + (size_t)(row0 + ai * 128 + m * 16) * UFW + col0;
#pragma unroll
                    for (int bj = 0; bj < 2; ++bj) { *(f32x4*)(rowp + bj * 128) = acc[ai][bj][m][0]; *(f32x4*)(rowp + bj * 128 + 4) = acc[ai][bj][m][1]; } }
        } else if (pn < 16) {
            const int which = (pn - 10) >> 1, c512 = ((pn - 10) & 1) * 256 + cl; const float sc = which == 0 ? qscale : 1.f;
#pragma unroll
            for (int ai = 0; ai < 2; ++ai)
#pragma unroll
                for (int m = 0; m < 4; ++m) { const int r = row0 + ai * 128 + m * 16; bf16* rowp = QKV + (size_t)r * 1536 + which * 512 + c512;
                    float* fo = nullptr;
                    if (which) { if (r < TP) fo = (which == 1 ? kp : vp) + (size_t)r * 512 + c512; else if (r < TT) fo = (which == 1 ? ks : vs) + (size_t)(r - TP) * 512 + c512; }
#pragma unroll
                    for (int bj = 0; bj < 2; ++bj) { const f32x4 v0 = acc[ai][bj][m][0], v1 = acc[ai][bj][m][1];
                        v4u w; w.x = pk2(v0[0] * sc, v0[1] * sc); w.y = pk2(v0[2] * sc, v0[3] * sc); w.z = pk2(v1[0] * sc, v1[1] * sc); w.w = pk2(v1[2] * sc, v1[3] * sc);
                        *(v4u*)(rowp + bj * 128) = w;
                        if (fo) { *(f32x4*)(fo + bj * 128) = v0; *(f32x4*)(fo + bj * 128 + 4) = v1; } } }
        } else {
            const int oc = (pn - 26) * 64 + wc * 16 + 4 * fq;
#pragma unroll
            for (int ai = 0; ai < 2; ++ai)
#pragma unroll
                for (int m = 0; m < 4; ++m) { const int r = row0 + ai * 128 + m * 16; bf16* rowp = GATE + (size_t)r * 8192 + oc;
                    f32x4 t[4];
#pragma unroll
                    for (int i = 0; i < 4; ++i)
#pragma unroll
                        for (int e = 0; e < 4; ++e) t[i][e] = 1.0f + fexp(-fminf(fmaxf(acc[ai][i >> 1][m][i & 1][e], -30.f), 30.f));
                    f32x4 o[4];
                    if (r < TP) {
#pragma unroll
                        for (int e = 0; e < 4; ++e) { const float i0 = __builtin_amdgcn_rcpf(t[0][e]), i1 = __builtin_amdgcn_rcpf(t[1][e]), i2 = __builtin_amdgcn_rcpf(t[2][e]), i3 = __builtin_amdgcn_rcpf(t[3][e]);
                            o[0][e] = t[1][e] * i0; o[1][e] = t[2][e] * i1; o[2][e] = t[3][e] * i2; o[3][e] = i3; }
                    } else {
#pragma unroll
                        for (int i = 0; i < 4; ++i)
#pragma unroll
                            for (int e = 0; e < 4; ++e) o[i][e] = __builtin_amdgcn_rcpf(t[i][e]);
                    }
#pragma unroll
                    for (int i = 0; i < 4; ++i) { v2u w; w.x = pk2(o[i][0], o[i][1]); w.y = pk2(o[i][2], o[i][3]); *(v2u*)(rowp + i * 2048) = w; } }
        }
    }
};
struct EpiMergeR {
    static constexpr bool PERM = true, AFTER_DRAIN = false, KEEP_ACC = true;
    const bf16* GATE; const float* RS; bf16* MGB;
    __device__ __forceinline__ void operator()(f32x4 (&acc)[2][2][4][2], const pg8::Unit& u, int wr, int wc, int fr, int fq) const {
        const unsigned row0 = (unsigned)(u.pm * 256 + wr * 64 + fr), col0 = (unsigned)(u.pn * 256 + wc * 32 + 8 * fq); const int seg = u.seg;
        const unsigned gofs = row0 * 8192u + (seg < 3 ? seg : 3) * 2048u + col0, oofs = row0 * 2048u + col0; const bool last = seg == 4;
        const float w2 = seg == 2 ? 1.f : 0.f, w3 = seg == 3 ? 1.f : 0.f, w4 = last ? 1.f : 0.f, w0 = 1.f - w2 - w3 - w4, ug = 1.f - w3;
#pragma unroll
        for (int ai = 0; ai < 2; ++ai)
#pragma unroll
            for (int m = 0; m < 4; ++m) { const unsigned rr = ai * 128 + m * 16; const f32x2 qq = *(const f32x2*)(RS + (row0 + rr) * 2u);
                const float r1 = __builtin_amdgcn_rsqf(qq[1]), rf = w0 + w2 * __builtin_amdgcn_sqrtf(qq[0]) + w3 * (__builtin_amdgcn_sqrtf(qq[1]) * __builtin_amdgcn_rsqf(qq[0])) + w4 * r1, rg = rf * ug, rc = rf * w3;
#pragma unroll
                for (int bj = 0; bj < 2; ++bj) { const v4u gg = *(const v4u*)(GATE + (gofs + rr * 8192u + bj * 128u));
                    f32x4& v0 = acc[ai][bj][m][0]; f32x4& v1 = acc[ai][bj][m][1];
                    v0[0] *= bflo(gg.x) * rg + rc; v0[1] *= bfhi(gg.x) * rg + rc; v0[2] *= bflo(gg.y) * rg + rc; v0[3] *= bfhi(gg.y) * rg + rc;
                    v1[0] *= bflo(gg.z) * rg + rc; v1[1] *= bfhi(gg.z) * rg + rc; v1[2] *= bflo(gg.w) * rg + rc; v1[3] *= bfhi(gg.w) * rg + rc;
                    if (last) { v4u w; w.x = pk2(v0[0], v0[1]); w.y = pk2(v0[2], v0[3]); w.z = pk2(v1[0], v1[1]); w.w = pk2(v1[2], v1[3]); *(v4u*)(MGB + (oofs + rr * 2048u + bj * 128u)) = w; } }
                asm volatile("" ::: "memory"); }
    }
};
struct EpiF32 {
    static constexpr bool PERM = true, AFTER_DRAIN = false, KEEP_ACC = false;
    float* C; int ldc;
    __device__ __forceinline__ void operator()(f32x4 (&acc)[2][2][4][2], const pg8::Unit& u, int wr, int wc, int fr, int fq) const {
        const int row0 = u.pm * 256 + wr * 64 + fr, col0 = u.pn * 256 + wc * 32 + 8 * fq;
#pragma unroll
        for (int ai = 0; ai < 2; ++ai)
#pragma unroll
            for (int m = 0; m < 4; ++m) { float* rowp = C + (size_t)(row0 + ai * 128 + m * 16) * ldc + col0;
#pragma unroll
                for (int bj = 0; bj < 2; ++bj) { *(f32x4*)(rowp + bj * 128) = acc[ai][bj][m][0]; *(f32x4*)(rowp + bj * 128 + 4) = acc[ai][bj][m][1]; } }
    }
};
struct EpiRelu2 {
    static constexpr bool PERM = true, AFTER_DRAIN = false, KEEP_ACC = false;
    bf16* O; int ldc;
    __device__ __forceinline__ void operator()(f32x4 (&acc)[2][2][4][2], const pg8::Unit& u, int wr, int wc, int fr, int fq) const {
        const int row0 = u.pm * 256 + wr * 64 + fr, col0 = u.pn * 256 + wc * 32 + 8 * fq;
#pragma unroll
        for (int ai = 0; ai < 2; ++ai)
#pragma unroll
            for (int m = 0; m < 4; ++m) { bf16* rowp = O + (size_t)(row0 + ai * 128 + m * 16) * ldc + col0;
#pragma unroll
                for (int bj = 0; bj < 2; ++bj) { f32x4 v0 = acc[ai][bj][m][0], v1 = acc[ai][bj][m][1];
#pragma unroll
                    for (int e = 0; e < 4; ++e) { const float a = fmaxf(v0[e], 0.f), b = fmaxf(v1[e], 0.f); v0[e] = a * a; v1[e] = b * b; }
                    v4u w; w.x = pk2(v0[0], v0[1]); w.y = pk2(v0[2], v0[3]); w.z = pk2(v1[0], v1[1]); w.w = pk2(v1[2], v1[3]); *(v4u*)(rowp + bj * 128) = w; } }
    }
};

__device__ __forceinline__ int win_src_col(int n) {
    if (n < 2560) return n;
    if (n < 6656) return n + 8;
    if (n < 14848) { const int t = n - 6656, pg = t >> 8, c = t & 255;
        return 6680 + (2 * (c >> 7) + ((c >> 2) & 1)) * 2048 + 64 * pg + 16 * ((c >> 5) & 3) + 4 * ((c >> 3) & 3) + (c & 3); }
    if (n < 14856) return n - 14848 + 2560;
    if (n < 14872) return n - 14856 + 6664;
    return -1;
}
template <int MODE>
__device__ __forceinline__ void transpose_item(const float* W, int ldw, int K, bf16* WT, int n0, int k0, const float* kscale, LAS unsigned* scr, int lane) {
    const int n = n0 + lane; const int sc = MODE ? win_src_col(n) : n;
#pragma unroll 8
    for (int i = 0; i < 32; ++i) { float a = 0.f, b = 0.f;
        if (sc >= 0) { a = W[(size_t)(k0 + 2 * i) * ldw + sc]; b = W[(size_t)(k0 + 2 * i + 1) * ldw + sc]; }
        if (kscale) { a *= kscale[k0 + 2 * i]; b *= kscale[k0 + 2 * i + 1]; }
        scr[i * 65 + lane] = pk2(a, b); }
    asm volatile("s_waitcnt lgkmcnt(0)" ::: "memory");
    const int part = lane & 3;
#pragma unroll
    for (int j = 0; j < 4; ++j) { const int nn = (lane >> 2) + 16 * j; const LAS unsigned* s = scr + (8 * part) * 65 + nn;
        v4u o0, o1; o0.x = s[0]; o0.y = s[65]; o0.z = s[130]; o0.w = s[195]; o1.x = s[260]; o1.y = s[325]; o1.z = s[390]; o1.w = s[455];
        v4u* dst = (v4u*)(WT + (size_t)(n0 + nn) * K + k0 + 16 * part); dst[0] = o0; dst[1] = o1; }
    asm volatile("s_waitcnt lgkmcnt(0)" ::: "memory");
}
__device__ __forceinline__ void p0_prologue(CA A, LAS unsigned char* lds, const int wv) {
    const int tid = tid_opaque(wv), lane = tid & 63, wave = tid >> 6, G = gridDim.x;
    LAS unsigned* scr = (LAS unsigned*)(lds + wave * 8320);
    const int gw = blk_opaque() * NWAVES + wave, NGW = G * NWAVES;
    constexpr int I_IN = (NIN / 64) * (DM / 64), I_BR = (DM / 64) * (512 / 64), I_OUT = (DM / 64) * (DM / 64), I_UP = (DFF / 64) * (DM / 64), I_DN = (DM / 64) * (DFF / 64);
    constexpr int PER_LAYER = I_IN + 4 * I_BR + I_OUT + I_UP + I_DN;
    for (int it = gw; it < 2 * PER_LAYER; it += NGW) {
        const int L = it / PER_LAYER; int r = it % PER_LAYER;
        if (r < I_IN) { const int nb = r % (NIN / 64), kb = r / (NIN / 64);
            transpose_item<1>(IN_F(I_WIN) + (size_t)L * DM * INCOLS, INCOLS, DM, WSP(bf16, WS_WIN) + (size_t)L * NIN * DM, nb * 64, kb * 64, nullptr, scr, lane); continue; }
        r -= I_IN;
        if (r < 4 * I_BR) { const int s = 1 + r / I_BR, q = r % I_BR, nb = q % (DM / 64), kb = q / (DM / 64);
            transpose_item<0>(IN_F(I_WBR) + ((size_t)L * 2560 + 512 * s) * DM, DM, OBW, WSP(bf16, WS_WBR) + (size_t)L * DM * OBW + 512 * s, nb * 64, kb * 64,
                              s >= 3 ? IN_F(I_SSNW) + L * 1024 + (s - 3) * 512 : nullptr, scr, lane); continue; }
        r -= 4 * I_BR;
        if (r < I_OUT) { const int nb = r % (DM / 64), kb = r / (DM / 64);
            transpose_item<0>(IN_F(I_WOUT) + (size_t)L * DM * DM, DM, DM, WSP(bf16, WS_WOUT) + (size_t)L * DM * DM, nb * 64, kb * 64, nullptr, scr, lane); continue; }
        r -= I_OUT;
        if (r < I_UP) { const int nb = r % (DFF / 64), kb = r / (DFF / 64);
            transpose_item<0>(IN_F(I_WUP) + (size_t)L * DM * DFF, DFF, DM, WSP(bf16, WS_WUP) + (size_t)L * DFF * DM, nb * 64, kb * 64, nullptr, scr, lane); continue; }
        r -= I_UP;
        { const int nb = r % (DM / 64), kb = r / (DM / 64);
            transpose_item<0>(IN_F(I_WDN) + (size_t)L * DFF * DM, DM, DFF, WSP(bf16, WS_WDN) + (size_t)L * DM * DFF, nb * 64, kb * 64, nullptr, scr, lane); }
    }
    for (int idx = blk_opaque() * NTHR + tid; idx < 2 * DM * 64; idx += G * NTHR) {
        const int L = idx / (DM * 64), q = idx % (DM * 64), n = q & (DM - 1), kc = q >> 11, k0 = kc * 8, g = k0 >> 7, c0 = k0 & 127;
        const float* pw = IN_F(I_POOLW) + ((size_t)(L * 4 + g) * 128 + c0) * 128; const float* psc = IN_F(I_POOLSC) + L * 512 + g * 128;
        const float* wb = IN_F(I_WBR) + ((size_t)L * 2560 + g * 128) * DM + n;
        float acc[8] = {0.f, 0.f, 0.f, 0.f, 0.f, 0.f, 0.f, 0.f};
        for (int d = 0; d < 128; ++d) { const float wv = wb[(size_t)d * DM] * psc[d];
#pragma unroll
            for (int i = 0; i < 8; ++i) acc[i] += pw[i * 128 + d] * wv; }
        v4u o; o.x = pk2(acc[0], acc[1]); o.y = pk2(acc[2], acc[3]); o.z = pk2(acc[4], acc[5]); o.w = pk2(acc[6], acc[7]);
        *(v4u*)(WSP(bf16, WS_WBR) + (size_t)L * DM * OBW + (size_t)n * OBW + k0) = o;
    }
}

__device__ __forceinline__ const float* xin_row(CA A, int m) { return m < TP ? IN_F(I_XP) + (size_t)m * DM : IN_F(I_XS) + (size_t)(m - TP) * DM; }
__device__ __forceinline__ void store_bf16_row(bf16* orow, const f32x4 (&v)[8], float rstd, const float* g, int lane) {
#pragma unroll
    for (int j = 0; j < 8; ++j) { const f32x4 gj = ((const f32x4*)g)[lane + 64 * j]; const f32x4 o = v[j] * rstd * gj;
        v2u w; w.x = pk2(o[0], o[1]); w.y = pk2(o[2], o[3]); ((v2u*)orow)[lane + 64 * j] = w; }
}
__device__ __forceinline__ void norm1_phase(CA A, const int wv) {
    const int tid = tid_opaque(wv), lane = tid & 63, gw = blk_opaque() * NWAVES + (tid >> 6), NGW = gridDim.x * NWAVES;
    bf16* H = WSP(bf16, WS_H);
    for (int m = gw; m < MP; m += NGW) {
        if (m >= TT) { for (int j = 0; j < 8; ++j) ((v2u*)(H + (size_t)m * DM))[lane + 64 * j] = (v2u){0u, 0u}; continue; }
        const f32x4* xr = (const f32x4*)xin_row(A, m); f32x4 v[8]; float s = 0.f;
#pragma unroll
        for (int j = 0; j < 8; ++j) { v[j] = xr[lane + 64 * j]; s += (v[j][0] * v[j][0] + v[j][1] * v[j][1]) + (v[j][2] * v[j][2] + v[j][3] * v[j][3]); }
        const float rstd = 1.0f / sqrtf(wave_sum(s) * (1.0f / DM) + RMS_EPS);
        store_bf16_row(H + (size_t)m * DM, v, rstd, IN_F(I_NMPRE), lane);
    }
}
__device__ __forceinline__ void resid_phase(CA A, const float* Y, const float* PS, const float* gpost, const float* gnext, bool from_input, const int wv) {
    const int tid = tid_opaque(wv), lane = tid & 63, gw = blk_opaque() * NWAVES + (tid >> 6), NGW = gridDim.x * NWAVES;
    bf16* H = WSP(bf16, WS_H);
    for (int m = gw; m < TT; m += NGW) {
        const f32x4* yr = (const f32x4*)(Y + (size_t)m * DM); const f32x4* xr = from_input ? (const f32x4*)xin_row(A, m) : (const f32x4*)(A->out + O_Y + (size_t)m * DM);
        f32x4 v[8]; float s = 0.f;
        if (m < TP) {
#pragma unroll
            for (int j = 0; j < 8; ++j) v[j] = yr[lane + 64 * j];
        } else {
#pragma unroll
            for (int j = 0; j < 8; ++j) v[j] = (f32x4){0.f, 0.f, 0.f, 0.f};
            for (int sp = 0; sp < 16; ++sp) { const f32x4* pr = (const f32x4*)(PS + ((size_t)sp * TS + (m - TP)) * DM);
#pragma unroll
                for (int j = 0; j < 8; ++j) v[j] += pr[lane + 64 * j]; }
        }
#pragma unroll
        for (int j = 0; j < 8; ++j) s += (v[j][0] * v[j][0] + v[j][1] * v[j][1]) + (v[j][2] * v[j][2] + v[j][3] * v[j][3]);
        const float rstd = 1.0f / sqrtf(wave_sum(s) * (1.0f / DM) + RMS_EPS); float s2 = 0.f;
        f32x4* orow = (f32x4*)(A->out + O_Y + (size_t)m * DM);
#pragma unroll
        for (int j = 0; j < 8; ++j) { const f32x4 gj = ((const f32x4*)gpost)[lane + 64 * j]; v[j] = xr[lane + 64 * j] + v[j] * rstd * gj; orow[lane + 64 * j] = v[j];
            s2 += (v[j][0] * v[j][0] + v[j][1] * v[j][1]) + (v[j][2] * v[j][2] + v[j][3] * v[j][3]); }
        if (gnext) { const float rstd2 = 1.0f / sqrtf(wave_sum(s2) * (1.0f / DM) + RMS_EPS); store_bf16_row(H + (size_t)m * DM, v, rstd2, gnext, lane); }
    }
}

__device__ __forceinline__ float conv_tap(const float* UF, const float* state, int row, int j, int ucol, int c) {
    if (row < TP) { const int t = row & (SEQ - 1); return (t - 3 + j) >= 0 ? UF[(size_t)(row - 3 + j) * UFW + ucol + c] : 0.f; }
    const int s = row - TP, sb = s >> 2, e = (s & 3) + j;
    return e < 3 ? state[(size_t)(sb * 3 + e) * 1536 + c] : UF[(size_t)(TP + sb * 4 + e - 3) * UFW + ucol + c];
}
__device__ __forceinline__ void prep_phase(CA A, int layer, const int wv) {
    const int tid = tid_opaque(wv), lane = tid & 63, G = gridDim.x, gt = blk_opaque() * NTHR + tid, NGT = G * NTHR, gw = blk_opaque() * NWAVES + (tid >> 6), NGW = G * NWAVES;
    const float* UF = WSP(float, WS_UF); float* SC = WSP(float, WS_SCAL);
    for (int idx = gt; idx < TT * 24; idx += NGT) { const int row = idx / 24, j = idx % 24; const float u = UF[(size_t)row * UFW + UF_SMALL + j]; float r;
        if (j < 4) r = sigmoidf_(u);
        else if (j < 8) r = -fexp(IN_F(I_DNALOG)[layer * 4 + j - 4]) * softplusf_(u + IN_F(I_DNDTB)[layer * 4 + j - 4]);
        else r = softplusf_(u + IN_F(I_SSDTB)[layer * 16 + j - 8]);
        SC[(size_t)row * 32 + j] = r; }
    { bf16* O0 = WSP(bf16, WS_OBR); const float* spool = IN_F(I_SPOOL) + (size_t)layer * DBATCH * 15 * 512;
      for (int it = gw; it < (TP / 64 + DBATCH) * 4; it += NGW) { const int gi = it & 3, sc = it >> 2, w = 2 << gi, ch = gi * 128 + lane;
          if (sc < TP / 64) { const int row0 = sc * 64, t0 = row0 & (SEQ - 1); float s0 = 0.f, s1 = 0.f;
              for (int j = 1; j < w; ++j) if (t0 - j >= 0) { s0 += UF[(size_t)(row0 - j) * UFW + ch]; s1 += UF[(size_t)(row0 - j) * UFW + ch + 64]; }
#pragma unroll 8
              for (int i = 0; i < 64; ++i) { const int row = row0 + i, t = t0 + i; const float u0 = UF[(size_t)row * UFW + ch], u1 = UF[(size_t)row * UFW + ch + 64];
                  s0 += u0; s1 += u1; const float inv = 1.0f / (float)((t + 1) < w ? (t + 1) : w);
                  O0[(size_t)row * OBW + ch] = (bf16)f2bf(s0 * inv - u0); O0[(size_t)row * OBW + ch + 64] = (bf16)f2bf(s1 * inv - u1);
                  if (t - w + 1 >= 0) { s0 -= UF[(size_t)(row - w + 1) * UFW + ch]; s1 -= UF[(size_t)(row - w + 1) * UFW + ch + 64]; } } }
          else { const int sb = sc - TP / 64; const float inv = 1.0f / (float)w;
              for (int i = 0; i < DSEQ; ++i) { const int row = TP + sb * 4 + i, e = 15 + i; float s0 = 0.f, s1 = 0.f;
                  for (int j = 0; j < w; ++j) { const int ee = e - j; const float* src = ee < 15 ? spool + (size_t)(sb * 15 + ee) * 512 + ch : UF + (size_t)(TP + sb * 4 + ee - 15) * UFW + ch; s0 += src[0]; s1 += src[64]; }
                  O0[(size_t)row * OBW + ch] = (bf16)f2bf(s0 * inv - UF[(size_t)row * UFW + ch]); O0[(size_t)row * OBW + ch + 64] = (bf16)f2bf(s1 * inv - UF[(size_t)row * UFW + ch + 64]); } } } }
    for (int it0 = gw; it0 < DBATCH * 24; it0 += NGW) { const int it = it0 + (TP / 64) * 24; const int grp = it % 12, strm = (it / 12) & 1, sc = it / 24, c0 = grp * 128 + lane;
        const int ucol = strm ? UF_XBC : UF_DNQKV; float* OUTB = strm ? WSP(float, WS_XBC) : WSP(float, WS_DNQ);
        const float* cw = (strm ? IN_F(I_SSCW) : IN_F(I_DNCW)) + (size_t)layer * 4 * 1536; const float* st = (strm ? IN_F(I_SSSC) : IN_F(I_SDNC)) + (size_t)layer * DBATCH * 3 * 1536;
        const float wa0 = cw[c0], wa1 = cw[1536 + c0], wa2 = cw[3072 + c0], wa3 = cw[4608 + c0], wb0 = cw[c0 + 64], wb1 = cw[1536 + c0 + 64], wb2 = cw[3072 + c0 + 64], wb3 = cw[4608 + c0 + 64];
        const float ba = strm ? IN_F(I_SSCB)[layer * 1536 + c0] : 0.f, bb = strm ? IN_F(I_SSCB)[layer * 1536 + c0 + 64] : 0.f;
        const bool nrm = (strm == 0) && grp < 8; const float qs = grp < 4 ? 0.08838834764831845f : 1.0f;
        float ha0, ha1, ha2, hb0, hb1, hb2; int row0, n;
        if (sc < TP / 64) { row0 = sc * 64; n = 64; const int t0 = row0 & (SEQ - 1);
            if (t0 == 0) { ha0 = ha1 = ha2 = hb0 = hb1 = hb2 = 0.f; }
            else { const float* p = UF + (size_t)(row0 - 3) * UFW + ucol + c0; ha0 = p[0]; hb0 = p[64]; ha1 = p[UFW]; hb1 = p[UFW + 64]; ha2 = p[2 * UFW]; hb2 = p[2 * UFW + 64]; } }
        else { const int sb = sc - TP / 64; row0 = TP + sb * 4; n = DSEQ; const float* p = st + (size_t)(sb * 3) * 1536 + c0; ha0 = p[0]; hb0 = p[64]; ha1 = p[1536]; hb1 = p[1536 + 64]; ha2 = p[3072]; hb2 = p[3072 + 64]; }
#pragma unroll 8
        for (int i = 0; i < n; ++i) { const float* p = UF + (size_t)(row0 + i) * UFW + ucol + c0; const float ua = p[0], ub = p[64];
            float a = siluf_(ba + wa0 * ha0 + wa1 * ha1 + wa2 * ha2 + wa3 * ua), b = siluf_(bb + wb0 * hb0 + wb1 * hb1 + wb2 * hb2 + wb3 * ub);
            ha0 = ha1; ha1 = ha2; ha2 = ua; hb0 = hb1; hb1 = hb2; hb2 = ub;
            if (nrm) { const float rs = row16_sum(a * a + b * b);
                const float tot = (__builtin_bit_cast(float, __builtin_amdgcn_readlane(__builtin_bit_cast(int, rs), 0)) + __builtin_bit_cast(float, __builtin_amdgcn_readlane(__builtin_bit_cast(int, rs), 16)))
                                + (__builtin_bit_cast(float, __builtin_amdgcn_readlane(__builtin_bit_cast(int, rs), 32)) + __builtin_bit_cast(float, __builtin_amdgcn_readlane(__builtin_bit_cast(int, rs), 48)));
                const float sc2 = qs / sqrtf(tot + 1e-6f); a *= sc2; b *= sc2; }
            float* o = OUTB + (size_t)(row0 + i) * 1536 + c0; o[0] = a; o[64] = b; } }
    for (int idx = gt; idx < NBATCH * 3 * 1536; idx += NGT) { const int b = idx / (3 * 1536), q = idx % (3 * 1536), j = q / 1536, c = q % 1536; const size_t src = (size_t)(b * SEQ + SEQ - 3 + j) * UFW;
        A->out[O_DNCP + (size_t)layer * NBATCH * 3 * 1536 + idx] = UF[src + UF_DNQKV + c]; A->out[O_SSCP + (size_t)layer * NBATCH * 3 * 1536 + idx] = UF[src + UF_XBC + c]; }
    for (int idx = gt; idx < DBATCH * 3 * 1536; idx += NGT) { const int sb = idx / (3 * 1536), q = idx % (3 * 1536), j = q / 1536, c = q % 1536; const size_t src = (size_t)(TP + sb * 4 + 1 + j) * UFW;
        A->out[O_DNCS + (size_t)layer * DBATCH * 3 * 1536 + idx] = UF[src + UF_DNQKV + c]; A->out[O_SSCS + (size_t)layer * DBATCH * 3 * 1536 + idx] = UF[src + UF_XBC + c]; }
    for (int idx = gt; idx < NBATCH * 15 * 512; idx += NGT) { const int b = idx / (15 * 512), q = idx % (15 * 512), j = q >> 9, ch = q & 511;
        A->out[O_POOLP + (size_t)layer * NBATCH * 15 * 512 + idx] = UF[(size_t)(b * SEQ + SEQ - 15 + j) * UFW + ch]; }
    { const float* spool = IN_F(I_SPOOL) + (size_t)layer * DBATCH * 15 * 512;
      for (int idx = gt; idx < DBATCH * 15 * 512; idx += NGT) { const int sb = idx / (15 * 512), q = idx % (15 * 512), j = q >> 9, ch = q & 511, e = 4 + j;
          A->out[O_POOLS + (size_t)layer * DBATCH * 15 * 512 + idx] = e < 15 ? spool[(size_t)(sb * 15 + e) * 512 + ch] : UF[(size_t)(TP + sb * 4 + e - 15) * UFW + ch]; } }
}

__device__ __forceinline__ void dn_seq(CA A, LAS unsigned char* lds, int layer, int unit, const int wv) {
    const int tid = tid_opaque(wv), lane = tid & 63, wid = tid >> 6, v = tid & 127, kq = tid >> 7;
    int row0, L, h; const float* s0 = nullptr; float* sout;
    if (unit < 16) { const int b = unit >> 2; h = unit & 3; row0 = b * SEQ; L = SEQ; sout = A->out + O_DNSP + ((size_t)(layer * NBATCH + b) * 4 + h) * 16384; }
    else { const int u = unit - 16, sb = u >> 2; h = u & 3; row0 = TP + sb * 4; L = DSEQ; s0 = IN_F(I_SDNS) + ((size_t)(layer * DBATCH + sb) * 4 + h) * 16384; sout = A->out + O_DNSS + ((size_t)(layer * DBATCH + sb) * 4 + h) * 16384; }
    constexpr int CH = 32;
    LAS float* qs = (LAS float*)lds; LAS float* ks = qs + CH * 128; LAS float* vs = ks + CH * 128; LAS float* ob = vs + CH * 128;
    LAS float* red = ob + CH * 128;
    LAS float* egs = red + 2 * 2 * 4 * 128; LAS float* bts = egs + CH; LAS float* kqd = bts + CH;
    const float* DNQ = WSP(float, WS_DNQ); const float* SC = WSP(float, WS_SCAL); const float* UF = WSP(float, WS_UF); bf16* O1 = WSP(bf16, WS_OBR) + 512;
    const float* nw = IN_F(I_DNNW) + layer * 128;
    float S[32];
#pragma unroll
    for (int i = 0; i < 32; ++i) S[i] = s0 ? s0[(size_t)(32 * kq + i) * 128 + v] : 0.f;
    for (int c0 = 0; c0 < L; c0 += CH) {
        const int n = (L - c0) < CH ? (L - c0) : CH;
        __syncthreads();
        for (int idx = tid; idx < n * 128; idx += NTHR) { const int t = idx >> 7, c = idx & 127; const float* src = DNQ + (size_t)(row0 + c0 + t) * 1536 + h * 128 + c;
            qs[idx] = src[0]; ks[idx] = src[512]; vs[idx] = src[1024]; }
        if (tid < n) { const float* sc = SC + (size_t)(row0 + c0 + tid) * 32; bts[tid] = sc[h]; egs[tid] = fexp(sc[4 + h]); }
        __syncthreads();
        for (int t = wid; t < n; t += NWAVES) { const float s = wave_sum(ks[t * 128 + lane] * qs[t * 128 + lane] + ks[t * 128 + 64 + lane] * qs[t * 128 + 64 + lane]); if (lane == 0) kqd[t] = s; }
        __syncthreads();
        for (int t = 0; t < n; ++t) {
            const float eg = egs[t], bt = bts[t]; float kk[32]; float r = 0.f, pp = 0.f;
#pragma unroll
            for (int i4 = 0; i4 < 8; ++i4) { const f32x4 k4 = *(const LAS f32x4*)(ks + t * 128 + 32 * kq + 4 * i4), q4 = *(const LAS f32x4*)(qs + t * 128 + 32 * kq + 4 * i4);
#pragma unroll
                for (int e = 0; e < 4; ++e) { const int i = 4 * i4 + e; S[i] *= eg; kk[i] = k4[e]; r += S[i] * k4[e]; pp += S[i] * q4[e]; } }
            LAS float* rd = red + (t & 1) * 1024;
            rd[kq * 128 + v] = r; rd[512 + kq * 128 + v] = pp;
            __syncthreads();
            const float rt = (rd[v] + rd[128 + v]) + (rd[256 + v] + rd[384 + v]), pt = (rd[512 + v] + rd[640 + v]) + (rd[768 + v] + rd[896 + v]);
            const float dd = bt * (vs[t * 128 + v] - rt);
#pragma unroll
            for (int i = 0; i < 32; ++i) S[i] += kk[i] * dd;
            if (kq == 0) ob[t * 128 + v] = pt + kqd[t] * dd;
        }
        __syncthreads();
        for (int t = wid; t < n; t += NWAVES) { const int row = row0 + c0 + t; const float o0 = ob[t * 128 + lane], o1 = ob[t * 128 + 64 + lane];
            const float rstd = 1.0f / sqrtf(wave_sum(o0 * o0 + o1 * o1) * (1.0f / 128.0f) + RMS_EPS);
            const float z0 = UF[(size_t)row * UFW + UF_DNZ + h * 128 + lane], z1 = UF[(size_t)row * UFW + UF_DNZ + h * 128 + 64 + lane];
            O1[(size_t)row * OBW + h * 128 + lane] = (bf16)f2bf(o0 * rstd * nw[lane] * siluf_(z0)); O1[(size_t)row * OBW + h * 128 + 64 + lane] = (bf16)f2bf(o1 * rstd * nw[64 + lane] * siluf_(z1)); }
    }
#pragma unroll
    for (int i = 0; i < 32; ++i) sout[(size_t)(32 * kq + i) * 128 + v] = S[i];
    __syncthreads();
}

__device__ __forceinline__ void ssd_seq(CA A, LAS unsigned char* lds, int layer, int unit, const int wv) {
    const int tid = tid_opaque(wv), lane = tid & 63, wid = tid >> 6, p = tid >> 3, nq = tid & 7;
    int row0, L, hd; const float* h0 = nullptr; float* hout;
    if (unit < 64) { const int b = unit >> 4; hd = unit & 15; row0 = b * SEQ; L = SEQ; hout = A->out + O_SSHP + ((size_t)(layer * NBATCH + b) * 16 + hd) * 8192; }
    else { const int u = unit - 64, sb = u >> 4; hd = u & 15; row0 = TP + sb * 4; L = DSEQ; h0 = IN_F(I_SSSH) + ((size_t)(layer * DBATCH + sb) * 16 + hd) * 8192; hout = A->out + O_SSHS + ((size_t)(layer * DBATCH + sb) * 16 + hd) * 8192; }
    const int g = hd >> 3; constexpr int CH = 64;
    LAS float* Bs = (LAS float*)lds; LAS float* Cs = Bs + CH * 128; LAS float* xs = Cs + CH * 128; LAS float* yb = xs + CH * 64; LAS float* dts = yb + CH * 64;
    const float* XBC = WSP(float, WS_XBC); const float* SC = WSP(float, WS_SCAL); const float* UF = WSP(float, WS_UF); float* SSQ = WSP(float, WS_SSQ);
    bf16* Og = WSP(bf16, WS_OBR) + (3 + g) * 512;
    const float a = -fexp(IN_F(I_SSALOG)[layer * 16 + hd]), Dk = IN_F(I_SSD)[layer * 16 + hd];
    float hs[16];
#pragma unroll
    for (int j = 0; j < 16; ++j) hs[j] = h0 ? h0[(size_t)p * 128 + 16 * nq + j] : 0.f;
    for (int c0 = 0; c0 < L; c0 += CH) {
        const int n = (L - c0) < CH ? (L - c0) : CH;
        __syncthreads();
        for (int idx = tid; idx < n * 128; idx += NTHR) { const int t = idx >> 7, c = idx & 127; const float* src = XBC + (size_t)(row0 + c0 + t) * 1536; Bs[idx] = src[1024 + g * 128 + c]; Cs[idx] = src[1280 + g * 128 + c]; }
        for (int idx = tid; idx < n * 64; idx += NTHR) { const int t = idx >> 6, c = idx & 63; xs[idx] = XBC[(size_t)(row0 + c0 + t) * 1536 + hd * 64 + c]; }
        if (tid < n) dts[tid] = SC[(size_t)(row0 + c0 + tid) * 32 + 8 + hd];
        __syncthreads();
        for (int t = 0; t < n; ++t) {
            const float dt = dts[t], dA = fexp(dt * a), xv = xs[t * 64 + p], cx = dt * xv; float y = 0.f;
#pragma unroll
            for (int j4 = 0; j4 < 4; ++j4) { const f32x4 b4 = *(const LAS f32x4*)(Bs + t * 128 + 16 * nq + 4 * j4), c4 = *(const LAS f32x4*)(Cs + t * 128 + 16 * nq + 4 * j4);
#pragma unroll
                for (int e = 0; e < 4; ++e) { const int j = 4 * j4 + e; hs[j] = hs[j] * dA + cx * b4[e]; y += hs[j] * c4[e]; } }
            y += __shfl_xor(y, 1); y += __shfl_xor(y, 2); y += __shfl_xor(y, 4);
            if (nq == 0) yb[t * 64 + p] = y + Dk * xv;
        }
        __syncthreads();
        for (int t = wid; t < n; t += NWAVES) { const int row = row0 + c0 + t; const float z = UF[(size_t)row * UFW + UF_SSZ + hd * 64 + lane]; const float yg = yb[t * 64 + lane] * siluf_(z);
            const float ss = wave_sum(yg * yg); if (lane == 0) { SSQ[(size_t)row * 32 + hd * 2] = ss; SSQ[(size_t)row * 32 + hd * 2 + 1] = 0.f; }
            Og[(size_t)row * OBW + (hd & 7) * 64 + lane] = (bf16)f2bf(yg); }
    }
#pragma unroll
    for (int j = 0; j < 16; ++j) hout[(size_t)p * 128 + 16 * nq + j] = hs[j];
    __syncthreads();
}

constexpr size_t DNU_NW = 0, DNU_QG = 16384, DNU_AT = 32768, DNU_KGT = 40960, DNU_UP = 57344, DNU_EG = 90112, DNU_BYTES = 90368;
__device__ __forceinline__ float dpp_swap1(float x) { return __builtin_bit_cast(float, __builtin_amdgcn_mov_dpp(__builtin_bit_cast(int, x), 0xB1, 0xf, 0xf, true)); }
__device__ __forceinline__ void dn_chunk_unit(CA A, LAS unsigned char* lds, int layer, int unit, const int wv) {
    const int tid = tid_opaque(wv), lane = tid & 63, wid = tid >> 6, q4 = lane >> 4, l15 = lane & 15;
    const int bh = unit >> 5, ck = unit & 31, b = bh >> 2, h = bh & 3, row0 = b * SEQ + ck * 64;
    constexpr int FP = 132;
    LAS float* kf = (LAS float*)lds; LAS float* vf = kf + 64 * FP;
    LAS unsigned char* qb = lds + 2 * 64 * FP * 4; LAS unsigned char* kb = qb + 64 * 272;
    LAS float* Lp = (LAS float*)(kb + 64 * 272);
    LAS float* gcs = Lp + 2 * 64 * 32; LAS float* bts = gcs + 64;
    const float* SC = WSP(float, WS_SCAL);
    unsigned char* rec = A->ws + WS_DNU + (size_t)unit * DNU_BYTES;
    __syncthreads();
    if (tid < 64) { const float* sc = SC + (size_t)(row0 + tid) * 32; bts[tid] = sc[h]; gcs[tid] = wave_scan(sc[4 + h], lane); }
    __syncthreads();
    const float glast = gcs[63];
    if (tid == 0) *(float*)(rec + DNU_EG) = fexp(glast);
    { const float* UF = WSP(float, WS_UF); const float* cw = IN_F(I_DNCW) + (size_t)layer * 4 * 1536;
#pragma unroll
      for (int it = 0; it < 4; ++it) { const int idx = tid + 512 * it, t = idx >> 5, d4 = (idx & 31) * 4, tq = ck * 64 + t; f32x4 val[3];
#pragma unroll
          for (int sIdx = 0; sIdx < 3; ++sIdx) { const int col = sIdx * 512 + h * 128 + d4; f32x4 a = {0.f, 0.f, 0.f, 0.f};
#pragma unroll
              for (int j = 0; j < 4; ++j) if (tq - 3 + j >= 0) a += *(const f32x4*)(UF + (size_t)(row0 + t - 3 + j) * UFW + UF_DNQKV + col) * *(const f32x4*)(cw + j * 1536 + col);
#pragma unroll
              for (int e = 0; e < 4; ++e) a[e] = siluf_(a[e]);
              if (sIdx < 2) { float ss = row16_sum((a[0] * a[0] + a[1] * a[1]) + (a[2] * a[2] + a[3] * a[3])); ss += __shfl_xor(ss, 16);
                  const float sc = (sIdx == 0 ? 0.08838834764831845f : 1.0f) * __builtin_amdgcn_rsqf(ss + 1e-6f); a = a * sc; }
              val[sIdx] = a; }
          const f32x4 qv = val[0], kv = val[1], vv = val[2];
          *(LAS f32x4*)(kf + t * FP + d4) = kv; *(LAS f32x4*)(vf + t * FP + d4) = vv;
          v2u w; w.x = pk2(qv[0], qv[1]); w.y = pk2(qv[2], qv[3]); *(LAS v2u*)(qb + t * 272 + d4 * 2) = w;
          w.x = pk2(kv[0], kv[1]); w.y = pk2(kv[2], kv[3]); *(LAS v2u*)(kb + t * 272 + d4 * 2) = w;
          const float eg = fexp(gcs[t]); w.x = pk2(qv[0] * eg, qv[1] * eg); w.y = pk2(qv[2] * eg, qv[3] * eg); *(v2u*)(rec + DNU_QG + (size_t)(t * 128 + d4) * 2) = w; } }
    __syncthreads();
    { const int c = lane, dg = wid; const float f = fexp(glast - gcs[c]); bf16* KGT = (bf16*)(rec + DNU_KGT);
#pragma unroll
      for (int i = 0; i < 16; ++i) { const int d = dg * 16 + i; KGT[d * 64 + c] = (bf16)f2bf(kf[c * FP + d] * f); } }
    { const int ct = wid >> 1; bf16* AT = (bf16*)(rec + DNU_AT);
#pragma unroll
      for (int e2 = 0; e2 < 2; ++e2) { const int et = 2 * (wid & 1) + e2; f32x4 aKK = {0.f, 0.f, 0.f, 0.f}, aQK = {0.f, 0.f, 0.f, 0.f};
#pragma unroll
          for (int ks = 0; ks < 4; ++ks) { const bf16x8 bfr = *(const LAS bf16x8*)(kb + (16 * et + l15) * 272 + (32 * ks + 8 * q4) * 2);
              const bf16x8 ak = *(const LAS bf16x8*)(kb + (16 * ct + l15) * 272 + (32 * ks + 8 * q4) * 2), aq = *(const LAS bf16x8*)(qb + (16 * ct + l15) * 272 + (32 * ks + 8 * q4) * 2);
              aKK = __builtin_amdgcn_mfma_f32_16x16x32_bf16(ak, bfr, aKK, 0, 0, 0); aQK = __builtin_amdgcn_mfma_f32_16x16x32_bf16(aq, bfr, aQK, 0, 0, 0); }
          const int e = 16 * et + l15; const float ge = gcs[e];
#pragma unroll
          for (int r = 0; r < 4; ++r) { const int c = 16 * ct + 4 * q4 + r; const float dec = e <= c ? fexp(gcs[c] - ge) : 0.f;
              Lp[((e & 1) * 64 + c) * 32 + (e >> 1)] = e < c ? bts[c] * aKK[r] * dec : 0.f;
              AT[c * 64 + e] = (bf16)f2bf(aQK[r] * dec); } } }
    __syncthreads();
    { const int j = tid >> 1, par = tid & 1; float x[32];
#pragma unroll
      for (int i = 0; i < 32; ++i) x[i] = 0.f;
      const LAS float* src = j < 128 ? vf + j : kf + (j - 128);
      float* UP = (float*)(rec + DNU_UP); bf16* NW = (bf16*)(rec + DNU_NW);
#pragma unroll
      for (int c = 0; c < 64; ++c) {
          constexpr int dummy = 0; (void)dummy;
          const int ni = (c + 1) >> 1; float a0 = 0.f, a1 = 0.f, a2 = 0.f, a3 = 0.f;
#pragma unroll
          for (int i4 = 0; i4 < (ni + 3) / 4; ++i4) { const f32x4 l4 = *(const LAS f32x4*)(Lp + (par * 64 + c) * 32 + 4 * i4);
              a0 += l4[0] * x[4 * i4]; if (4 * i4 + 1 < ni) a1 += l4[1] * x[4 * i4 + 1]; if (4 * i4 + 2 < ni) a2 += l4[2] * x[4 * i4 + 2]; if (4 * i4 + 3 < ni) a3 += l4[3] * x[4 * i4 + 3]; }
          float acc = (a0 + a1) + (a2 + a3); acc += dpp_swap1(acc);
          float rhs = src[c * FP] * bts[c]; if (j >= 128) rhs *= fexp(gcs[c]);
          const float xc = rhs - acc;
          x[c >> 1] = ((c & 1) == par) ? xc : x[c >> 1];
          if (par == 0) { if (j < 128) UP[(((j >> 4) * 4 + (c >> 4)) * 4 + (c & 3)) * 64 + ((c >> 2) & 3) * 16 + (j & 15)] = xc; else NW[c * 128 + (j - 128)] = (bf16)f2bf(-xc); }
      } }
}

constexpr int D2_NW = 0, D2_QG = 17408, D2_AT = 34816, D2_KGT = 44032, D2_BUF = 62464, D2_RED = 2 * D2_BUF;
__device__ __forceinline__ bf16x8 ld_frag_perm(const LAS unsigned char* p) {
    const v2u lo = *(const LAS v2u*)p, hi = *(const LAS v2u*)(p + 32); v4u w; w.x = lo.x; w.y = lo.y; w.z = hi.x; w.w = hi.y; return __builtin_bit_cast(bf16x8, w);
}
__device__ __forceinline__ bf16x8 pack_b(const f32x4& t0, const f32x4& t1) { v4u w; w.x = pk2(t0[0], t0[1]); w.y = pk2(t0[2], t0[3]); w.z = pk2(t1[0], t1[1]); w.w = pk2(t1[2], t1[3]); return __builtin_bit_cast(bf16x8, w); }
__device__ __forceinline__ void dn_seq2(CA A, LAS unsigned char* lds, int layer, int bh, const int wv) {
    const int tid = tid_opaque(wv), lane = tid & 63, w = tid >> 6, q4 = lane >> 4, l15 = lane & 15;
    const int b = bh >> 2, h = bh & 3;
    const unsigned char* recs = A->ws + WS_DNU + (size_t)(bh * 32) * DNU_BYTES;
    const float* UF = WSP(float, WS_UF); bf16* O1 = WSP(bf16, WS_OBR) + 512; const float* nw = IN_F(I_DNNW) + layer * 128;
    LAS float* red = (LAS float*)(lds + D2_RED);
    const float nwv = nw[16 * w + l15];
    f32x4 S[8];
#pragma unroll
    for (int i = 0; i < 8; ++i) S[i] = (f32x4){0.f, 0.f, 0.f, 0.f};
    v4u st[7];
#define D2_LOAD(rec_) do { const v4u* g_ = (const v4u*)(rec_); _Pragma("unroll") for (int i_ = 0; i_ < 7; ++i_) st[i_] = g_[tid + 512 * i_]; } while (0)
#define D2_STORE(buf_) do { LAS unsigned char* b_ = lds + (buf_) * D2_BUF; \
        *(LAS v4u*)(b_ + D2_NW + (tid >> 4) * 272 + (tid & 15) * 16) = st[0]; *(LAS v4u*)(b_ + D2_NW + (32 + (tid >> 4)) * 272 + (tid & 15) * 16) = st[1]; \
        *(LAS v4u*)(b_ + D2_QG + (tid >> 4) * 272 + (tid & 15) * 16) = st[2]; *(LAS v4u*)(b_ + D2_QG + (32 + (tid >> 4)) * 272 + (tid & 15) * 16) = st[3]; \
        *(LAS v4u*)(b_ + D2_AT + (tid >> 3) * 144 + (tid & 7) * 16) = st[4]; \
        *(LAS v4u*)(b_ + D2_KGT + (tid >> 3) * 144 + (tid & 7) * 16) = st[5]; *(LAS v4u*)(b_ + D2_KGT + (64 + (tid >> 3)) * 144 + (tid & 7) * 16) = st[6]; } while (0)
    __syncthreads();
    D2_LOAD(recs); D2_STORE(0);
    f32x4 vnx[4]; float eglx = *(const float*)(recs + DNU_EG);
    { const float* UP0 = (const float*)(recs + DNU_UP) + (size_t)w * 1024 + lane;
#pragma unroll
      for (int mt = 0; mt < 4; ++mt)
#pragma unroll
          for (int r = 0; r < 4; ++r) vnx[mt][r] = UP0[(mt * 4 + r) * 64]; }
    __syncthreads();
    for (int ck = 0; ck < 32; ++ck) {
        const unsigned char* rec = recs + (size_t)ck * DNU_BYTES; const int row0 = b * SEQ + ck * 64;
        const LAS unsigned char* bf = lds + (ck & 1) * D2_BUF;
        if (ck + 1 < 32) D2_LOAD(rec + DNU_BYTES);
        const float egl = eglx;
        f32x4 vn[4];
#pragma unroll
        for (int mt = 0; mt < 4; ++mt) vn[mt] = vnx[mt];
        if (ck + 1 < 32) { eglx = *(const float*)(rec + DNU_BYTES + DNU_EG); const float* UP = (const float*)(rec + DNU_BYTES + DNU_UP) + (size_t)w * 1024 + lane;
#pragma unroll
            for (int mt = 0; mt < 4; ++mt)
#pragma unroll
                for (int r = 0; r < 4; ++r) vnx[mt][r] = UP[(mt * 4 + r) * 64]; }
        f32x4 zz[4];
#pragma unroll
        for (int mt = 0; mt < 4; ++mt)
#pragma unroll
            for (int r = 0; r < 4; ++r) zz[mt][r] = UF[(size_t)(row0 + 16 * mt + 4 * q4 + r) * UFW + UF_DNZ + h * 128 + 16 * w + l15];
        bf16x8 Sb[4];
#pragma unroll
        for (int ks = 0; ks < 4; ++ks) Sb[ks] = pack_b(S[2 * ks], S[2 * ks + 1]);
        const int aoff = l15 * 272 + 8 * q4, aoff2 = l15 * 144 + 8 * q4;
#pragma unroll
        for (int mt = 0; mt < 4; ++mt)
#pragma unroll
            for (int ks = 0; ks < 4; ++ks) vn[mt] = __builtin_amdgcn_mfma_f32_16x16x32_bf16(ld_frag_perm(bf + D2_NW + mt * 16 * 272 + aoff + ks * 64), Sb[ks], vn[mt], 0, 0, 0);
        bf16x8 vb[2];
        vb[0] = pack_b(vn[0], vn[1]); vb[1] = pack_b(vn[2], vn[3]);
        f32x4 o[4];
#pragma unroll
        for (int mt = 0; mt < 4; ++mt) { o[mt] = (f32x4){0.f, 0.f, 0.f, 0.f};
#pragma unroll
            for (int ks = 0; ks < 4; ++ks) o[mt] = __builtin_amdgcn_mfma_f32_16x16x32_bf16(ld_frag_perm(bf + D2_QG + mt * 16 * 272 + aoff + ks * 64), Sb[ks], o[mt], 0, 0, 0);
#pragma unroll
            for (int ke = 0; ke < 2; ++ke) o[mt] = __builtin_amdgcn_mfma_f32_16x16x32_bf16(ld_frag_perm(bf + D2_AT + mt * 16 * 144 + aoff2 + ke * 64), vb[ke], o[mt], 0, 0, 0); }
#pragma unroll
        for (int m8 = 0; m8 < 8; ++m8) { S[m8] = S[m8] * egl;
#pragma unroll
            for (int ke = 0; ke < 2; ++ke) S[m8] = __builtin_amdgcn_mfma_f32_16x16x32_bf16(ld_frag_perm(bf + D2_KGT + m8 * 16 * 144 + aoff2 + ke * 64), vb[ke], S[m8], 0, 0, 0); }
        LAS float* rd = red + (ck & 1) * 512;
#pragma unroll
        for (int mt = 0; mt < 4; ++mt)
#pragma unroll
            for (int r = 0; r < 4; ++r) { const float s = row16_sum(o[mt][r] * o[mt][r]);
                if (l15 == 0) rd[(16 * mt + 4 * q4 + r) * 8 + w] = s; }
        if (ck + 1 < 32) D2_STORE((ck + 1) & 1);
        __syncthreads();
#pragma unroll
        for (int mt = 0; mt < 4; ++mt)
#pragma unroll
            for (int r = 0; r < 4; ++r) { const int c = 16 * mt + 4 * q4 + r; const f32x4 s0 = *(const LAS f32x4*)(rd + c * 8), s1 = *(const LAS f32x4*)(rd + c * 8 + 4);
                const float rstd = __builtin_amdgcn_rsqf(((s0[0] + s0[1]) + (s0[2] + s0[3]) + (s1[0] + s1[1]) + (s1[2] + s1[3])) * (1.0f / 128.0f) + RMS_EPS);
                const int dv = 16 * w + l15;
                const float zq = zz[mt][r]; O1[(size_t)(row0 + c) * OBW + h * 128 + dv] = (bf16)f2bf(o[mt][r] * rstd * nwv * zq * __builtin_amdgcn_rcpf(1.0f + fexp(-zq))); }
    }
    float* sout = A->out + O_DNSP + ((size_t)(layer * NBATCH + b) * 4 + h) * 16384;
#pragma unroll
    for (int m8 = 0; m8 < 8; ++m8)
#pragma unroll
        for (int r = 0; r < 4; ++r) sout[(size_t)(16 * m8 + 4 * q4 + r) * 128 + 16 * w + l15] = S[m8][r];
    __syncthreads();
#undef D2_LOAD
#undef D2_STORE
}

constexpr size_t SSU_XT = 0, SSU_XTW = 8192, SSU_CUM = 16384, SSU_DT = 16640, SSU_BYTES = 16896;
constexpr size_t SSG_C = 0, SSG_B = 16384, SSG_BT = 32768, SSG_BYTES = 49152;
__device__ __forceinline__ void ssd_prep_unit(CA A, LAS unsigned char* lds, int layer, int unit, const int wv) {
    const int tid = tid_opaque(wv), lane = tid & 63;
    const int hd = unit & 15, bc = unit >> 4, b = bc >> 5, ck = bc & 31, g = hd >> 3, row0 = b * SEQ + ck * 64;
    const float* SC = WSP(float, WS_SCAL);
    unsigned char* rec = A->ws + WS_SSU + (size_t)unit * SSU_BYTES;
    LAS float* xl = (LAS float*)lds;
    LAS float* bl = xl + 64 * 65;
    LAS float* cums = bl + 64 * 129; LAS float* ws_ = cums + 64;
    const float a = -fexp(IN_F(I_SSALOG)[layer * 16 + hd]);
    __syncthreads();
    if (tid < 64) { const float dt = SC[(size_t)(row0 + tid) * 32 + 8 + hd]; const float c = wave_scan(dt * a, lane);
        cums[tid] = c; const float c63 = rdlane(c, 63); ws_[tid] = fexp(c63 - c) * dt;
        ((float*)(rec + SSU_CUM))[tid] = c; ((float*)(rec + SSU_DT))[tid] = dt; }
    const float* UF = WSP(float, WS_UF); const float* cw = IN_F(I_SSCW) + (size_t)layer * 4 * 1536; const float* cb = IN_F(I_SSCB) + layer * 1536; const int tq0 = ck * 64;
    { const int s = tid >> 3, p8 = (tid & 7) * 8, col = hd * 64 + p8; f32x4 x0 = *(const f32x4*)(cb + col), x1 = *(const f32x4*)(cb + col + 4);
#pragma unroll
      for (int j = 0; j < 4; ++j) if (tq0 + s - 3 + j >= 0) { const float* up = UF + (size_t)(row0 + s - 3 + j) * UFW + UF_XBC + col; x0 += *(const f32x4*)up * *(const f32x4*)(cw + j * 1536 + col); x1 += *(const f32x4*)(up + 4) * *(const f32x4*)(cw + j * 1536 + col + 4); }
#pragma unroll
      for (int e = 0; e < 4; ++e) { xl[s * 65 + p8 + e] = siluf_(x0[e]); xl[s * 65 + p8 + 4 + e] = siluf_(x1[e]); } }
    __syncthreads();
    { const int p = tid >> 3, s8 = (tid & 7) * 8; float xv[8], xw[8];
#pragma unroll
      for (int i = 0; i < 8; ++i) { xv[i] = xl[(s8 + i) * 65 + p]; xw[i] = xv[i] * ws_[s8 + i]; }
      v4u o; o.x = pk2(xv[0], xv[1]); o.y = pk2(xv[2], xv[3]); o.z = pk2(xv[4], xv[5]); o.w = pk2(xv[6], xv[7]); *(v4u*)(rec + SSU_XT + (size_t)(p * 64 + s8) * 2) = o;
      o.x = pk2(xw[0], xw[1]); o.y = pk2(xw[2], xw[3]); o.z = pk2(xw[4], xw[5]); o.w = pk2(xw[6], xw[7]); *(v4u*)(rec + SSU_XTW + (size_t)(p * 64 + s8) * 2) = o; }
    if ((hd & 7) == 0) {
        unsigned char* grec = A->ws + WS_SSG + (size_t)(bc * 2 + g) * SSG_BYTES;
        const int s = tid >> 3, n16 = (tid & 7) * 16, colb = 1024 + g * 128 + n16;
        f32x4 bv[4], cv[4];
#pragma unroll
        for (int i = 0; i < 4; ++i) { bv[i] = *(const f32x4*)(cb + colb + 4 * i); cv[i] = *(const f32x4*)(cb + colb + 256 + 4 * i); }
#pragma unroll
        for (int j = 0; j < 4; ++j) if (tq0 + s - 3 + j >= 0) { const float* up = UF + (size_t)(row0 + s - 3 + j) * UFW + UF_XBC + colb; const float* wp = cw + j * 1536 + colb;
#pragma unroll
            for (int i = 0; i < 4; ++i) { bv[i] += *(const f32x4*)(up + 4 * i) * *(const f32x4*)(wp + 4 * i); cv[i] += *(const f32x4*)(up + 256 + 4 * i) * *(const f32x4*)(wp + 256 + 4 * i); } }
#pragma unroll
        for (int i = 0; i < 4; ++i)
#pragma unroll
            for (int e = 0; e < 4; ++e) { bv[i][e] = siluf_(bv[i][e]); cv[i][e] = siluf_(cv[i][e]); }
#pragma unroll
        for (int i = 0; i < 2; ++i) { v4u o; o.x = pk2(bv[2 * i][0], bv[2 * i][1]); o.y = pk2(bv[2 * i][2], bv[2 * i][3]); o.z = pk2(bv[2 * i + 1][0], bv[2 * i + 1][1]); o.w = pk2(bv[2 * i + 1][2], bv[2 * i + 1][3]);
            *(v4u*)(grec + SSG_B + (size_t)(s * 128 + n16 + 8 * i) * 2) = o;
            o.x = pk2(cv[2 * i][0], cv[2 * i][1]); o.y = pk2(cv[2 * i][2], cv[2 * i][3]); o.z = pk2(cv[2 * i + 1][0], cv[2 * i + 1][1]); o.w = pk2(cv[2 * i + 1][2], cv[2 * i + 1][3]);
            *(v4u*)(grec + SSG_C + (size_t)(s * 128 + n16 + 8 * i) * 2) = o; }
#pragma unroll
        for (int i = 0; i < 4; ++i)
#pragma unroll
            for (int e = 0; e < 4; ++e) bl[s * 129 + n16 + 4 * i + e] = bv[i][e];
        __syncthreads();
        const int n = tid >> 2, s16 = (tid & 3) * 16; float t[16];
#pragma unroll
        for (int i = 0; i < 16; ++i) t[i] = bl[(s16 + i) * 129 + n];
#pragma unroll
        for (int i = 0; i < 2; ++i) { v4u o; o.x = pk2(t[8 * i], t[8 * i + 1]); o.y = pk2(t[8 * i + 2], t[8 * i + 3]); o.z = pk2(t[8 * i + 4], t[8 * i + 5]); o.w = pk2(t[8 * i + 6], t[8 * i + 7]);
            *(v4u*)(grec + SSG_BT + (size_t)(n * 64 + s16 + 8 * i) * 2) = o; }
    }
}

constexpr int S2_C = 0, S2_B = 17408, S2_BT = 34816, S2_XT = 53248, S2_XTW = 62464, S2_WM = 71680, S2_HB = 80896, S2_YB = 98304, S2_CUM = 114688, S2_DT = 114944;
__device__ __forceinline__ void ssd_seq2(CA A, LAS unsigned char* lds, int layer, int unit, const int wv) {
    const int tid = tid_opaque(wv), lane = tid & 63, w = tid >> 6, q4 = lane >> 4, l15 = lane & 15;
    const int b = unit >> 4, hd = unit & 15, g = hd >> 3;
    const unsigned char* hrec = A->ws + WS_SSU + (size_t)((b * 32) * 16 + hd) * SSU_BYTES;
    const unsigned char* grec = A->ws + WS_SSG + (size_t)((b * 32) * 2 + g) * SSG_BYTES;
    const float* UF = WSP(float, WS_UF); float* SSQ = WSP(float, WS_SSQ); bf16* Og = WSP(bf16, WS_OBR) + (3 + g) * 512;
    const float Dk = IN_F(I_SSD)[layer * 16 + hd];
    LAS float* yb = (LAS float*)(lds + S2_YB); LAS float* cums = (LAS float*)(lds + S2_CUM); LAS float* dts = (LAS float*)(lds + S2_DT);
    f32x4 hacc[4];
#pragma unroll
    for (int i = 0; i < 4; ++i) hacc[i] = (f32x4){0.f, 0.f, 0.f, 0.f};
    v4u st[8]; float sc1 = 0.f;
#define S2_LOAD(ck_) do { const v4u* gg_ = (const v4u*)(grec + (size_t)(ck_) * 2 * SSG_BYTES); const v4u* hh_ = (const v4u*)(hrec + (size_t)(ck_) * 16 * SSU_BYTES); \
        st[0] = gg_[tid]; st[1] = gg_[tid + 512]; st[2] = gg_[tid + 1024]; st[3] = gg_[tid + 1536]; st[4] = gg_[tid + 2048]; st[5] = gg_[tid + 2560]; st[6] = hh_[tid]; st[7] = hh_[tid + 512]; \
        if (tid < 128) sc1 = ((const float*)(hrec + (size_t)(ck_) * 16 * SSU_BYTES + SSU_CUM))[tid]; } while (0)
#define S2_STORE() do { \
        *(LAS v4u*)(lds + S2_C + (tid >> 4) * 272 + (tid & 15) * 16) = st[0]; *(LAS v4u*)(lds + S2_C + (32 + (tid >> 4)) * 272 + (tid & 15) * 16) = st[1]; \
        *(LAS v4u*)(lds + S2_B + (tid >> 4) * 272 + (tid & 15) * 16) = st[2]; *(LAS v4u*)(lds + S2_B + (32 + (tid >> 4)) * 272 + (tid & 15) * 16) = st[3]; \
        *(LAS v4u*)(lds + S2_BT + (tid >> 3) * 144 + (tid & 7) * 16) = st[4]; *(LAS v4u*)(lds + S2_BT + (64 + (tid >> 3)) * 144 + (tid & 7) * 16) = st[5]; \
        *(LAS v4u*)(lds + S2_XT + (tid >> 3) * 144 + (tid & 7) * 16) = st[6]; *(LAS v4u*)(lds + S2_XTW + (tid >> 3) * 144 + (tid & 7) * 16) = st[7]; \
        if (tid < 128) cums[tid] = sc1; } while (0)
    S2_LOAD(0);
    const int tt = w >> 1, aoffC = l15 * 272 + 16 * q4, aoffS = l15 * 144 + 16 * q4;
    for (int ck = 0; ck < 32; ++ck) {
        const int row0 = b * SEQ + ck * 64;
        __syncthreads();
        S2_STORE();
        __syncthreads();
        if (ck + 1 < 32) S2_LOAD(ck + 1);
        float zv[2][4];
#pragma unroll
        for (int e2 = 0; e2 < 2; ++e2)
#pragma unroll
            for (int r = 0; r < 4; ++r) zv[e2][r] = UF[(size_t)(row0 + 16 * tt + 4 * q4 + r) * UFW + UF_SSZ + hd * 64 + 16 * (2 * (w & 1) + e2) + l15];
#pragma unroll
        for (int e2 = 0; e2 < 2; ++e2) { const int stl = 2 * (w & 1) + e2; f32x4 acc = {0.f, 0.f, 0.f, 0.f};
            if (stl <= tt) {
#pragma unroll
                for (int ks = 0; ks < 4; ++ks) acc = __builtin_amdgcn_mfma_f32_16x16x32_bf16(*(const LAS bf16x8*)(lds + S2_C + tt * 16 * 272 + aoffC + ks * 64), *(const LAS bf16x8*)(lds + S2_B + stl * 16 * 272 + aoffC + ks * 64), acc, 0, 0, 0); }
            const int s = 16 * stl + l15; const float cs = cums[s], ds = dts[s];
#pragma unroll
            for (int r = 0; r < 4; ++r) { const int t = 16 * tt + 4 * q4 + r; const float v = s <= t ? acc[r] * fexp(cums[t] - cs) * ds : 0.f;
                *(LAS unsigned short*)(lds + S2_WM + t * 144 + s * 2) = (unsigned short)f2bf(v); } }
#pragma unroll
        for (int mt = 0; mt < 4; ++mt)
#pragma unroll
            for (int r = 0; r < 4; ++r) *(LAS unsigned short*)(lds + S2_HB + (16 * mt + 4 * q4 + r) * 272 + (16 * w + l15) * 2) = (unsigned short)f2bf(hacc[mt][r]);
        __syncthreads();
        float ssq[4] = {0.f, 0.f, 0.f, 0.f};
#pragma unroll
        for (int e2 = 0; e2 < 2; ++e2) { const int pt = 2 * (w & 1) + e2; f32x4 y = {0.f, 0.f, 0.f, 0.f};
#pragma unroll
            for (int ks = 0; ks < 4; ++ks) y = __builtin_amdgcn_mfma_f32_16x16x32_bf16(*(const LAS bf16x8*)(lds + S2_C + tt * 16 * 272 + aoffC + ks * 64), *(const LAS bf16x8*)(lds + S2_HB + pt * 16 * 272 + aoffC + ks * 64), y, 0, 0, 0);
#pragma unroll
            for (int r = 0; r < 4; ++r) y[r] *= fexp(cums[16 * tt + 4 * q4 + r]);
#pragma unroll
            for (int ke = 0; ke < 2; ++ke) y = __builtin_amdgcn_mfma_f32_16x16x32_bf16(*(const LAS bf16x8*)(lds + S2_WM + tt * 16 * 144 + aoffS + ke * 64), *(const LAS bf16x8*)(lds + S2_XT + pt * 16 * 144 + aoffS + ke * 64), y, 0, 0, 0);
            const int p = 16 * pt + l15;
#pragma unroll
            for (int r = 0; r < 4; ++r) { const int t = 16 * tt + 4 * q4 + r; const float xv = bflo((unsigned)*(const LAS unsigned short*)(lds + S2_XT + p * 144 + t * 2));
                const float yg = (y[r] + Dk * xv) * siluf_(zv[e2][r]); ssq[r] += yg * yg;
                Og[(size_t)(row0 + t) * OBW + (hd & 7) * 64 + p] = (bf16)f2bf(yg); } }
#pragma unroll
        for (int r = 0; r < 4; ++r) { const float s = row16_sum(ssq[r]); if (l15 == 0) SSQ[(size_t)(row0 + 16 * tt + 4 * q4 + r) * 32 + hd * 2 + (w & 1)] = s; }
        { const float e63 = fexp(cums[63]);
#pragma unroll
          for (int mt = 0; mt < 4; ++mt) { hacc[mt] = hacc[mt] * e63;
#pragma unroll
              for (int ke = 0; ke < 2; ++ke) hacc[mt] = __builtin_amdgcn_mfma_f32_16x16x32_bf16(*(const LAS bf16x8*)(lds + S2_XTW + mt * 16 * 144 + aoffS + ke * 64), *(const LAS bf16x8*)(lds + S2_BT + w * 16 * 144 + aoffS + ke * 64), hacc[mt], 0, 0, 0); } }
    }
    float* hout = A->out + O_SSHP + ((size_t)(layer * NBATCH + b) * 16 + hd) * 8192;
#pragma unroll
    for (int mt = 0; mt < 4; ++mt)
#pragma unroll
        for (int r = 0; r < 4; ++r) hout[(size_t)(16 * mt + 4 * q4 + r) * 128 + 16 * w + l15] = hacc[mt][r];
    __syncthreads();
#undef S2_LOAD
#undef S2_STORE
}

struct ALBf16 { const bf16* A; int lda; __device__ __forceinline__ bf16x8 operator()(int row, int k) const { return *(const bf16x8*)(A + (size_t)row * lda + k); } };
template <class AL> __device__ __forceinline__ void sgemm_task(const AL& al, const bf16* Wt, int ldw, int n0, int k0, int nks, f32x4 (&acc)[2], int l15, int q4) {
    const bf16* bp = Wt + (size_t)(n0 + l15) * ldw + k0 + 8 * q4;
    int nks_ = nks; asm volatile("" : "+s"(nks_));
#pragma unroll 4
    for (int ks = 0; ks < nks_; ++ks) { const bf16x8 b = *(const bf16x8*)(bp + 32 * ks); const bf16x8 a0 = al(l15, k0 + 32 * ks + 8 * q4), a1 = al(16 + l15, k0 + 32 * ks + 8 * q4);
        acc[0] = __builtin_amdgcn_mfma_f32_16x16x32_bf16(a0, b, acc[0], 0, 0, 0); acc[1] = __builtin_amdgcn_mfma_f32_16x16x32_bf16(a1, b, acc[1], 0, 0, 0); }
}
#define SAMPLE_IDS() const int tid = tid_opaque(wv), lane = tid & 63, l15 = lane & 15, q4 = lane >> 4, NGW = gridDim.x * NWAVES, gw = (tid >> 6) * gridDim.x + blk_opaque()
__device__ __forceinline__ void sample_merge(CA A, LAS unsigned char* lds, int layer, const int wv) {
    const int tid = tid_opaque(wv), lane = tid & 63, l15 = lane & 15, q4 = lane >> 4, w = tid >> 6, G = gridDim.x;
    const bf16* GT = WSP(bf16, WS_GATE); const float* RS = WSP(float, WS_RS); bf16* MB = WSP(bf16, WS_MGB); LAS float* part = (LAS float*)lds;
    for (int strip = blk_opaque(); strip < 128; strip += G) { const int n0 = strip * 16, col = n0 + l15;
        __syncthreads();
        if (w < 5) { const int s = w, gs = s < 3 ? s : 3;
            f32x4 acc[2] = {{0.f, 0.f, 0.f, 0.f}, {0.f, 0.f, 0.f, 0.f}};
            ALBf16 al{WSP(bf16, WS_OBR) + (size_t)TP * OBW + s * 512, OBW};
            sgemm_task(al, WSP(bf16, WS_WBR) + (size_t)layer * DM * OBW + s * 512, OBW, n0, 0, 16, acc, l15, q4);
#pragma unroll
            for (int mt = 0; mt < 2; ++mt)
#pragma unroll
                for (int r = 0; r < 4; ++r) { const int row = 16 * mt + 4 * q4 + r, grow = TP + row; float rs = 1.f;
                    if (s >= 3) rs = 1.0f / sqrtf(RS[(size_t)grow * 2 + (s - 3)]);
                    part[(s * 32 + row) * 16 + l15] = acc[mt][r] * bflo((unsigned)GT[(size_t)grow * 8192 + gs * 2048 + col]) * rs; } }
        __syncthreads();
        { const int row = tid >> 4, c = tid & 15; const float v = (part[row * 16 + c] + part[(32 + row) * 16 + c]) + (part[(64 + row) * 16 + c] + part[(96 + row) * 16 + c]) + part[(128 + row) * 16 + c];
          MB[(size_t)(TP + row) * DM + n0 + c] = (bf16)f2bf(v); } }
}
__device__ __forceinline__ void sample_up(CA A, LAS unsigned char* lds, int layer, const int wv) {
    const int tid = tid_opaque(wv), lane = tid & 63, l15 = lane & 15, q4 = lane >> 4, w = tid >> 6, G = gridDim.x;
    bf16* F = WSP(bf16, WS_F); LAS float* part = (LAS float*)lds;
    for (int sp = blk_opaque(); sp < 256; sp += G) { const int n0 = (2 * sp + (w >> 2)) * 16, kq = w & 3;
        __syncthreads();
        f32x4 acc[2] = {{0.f, 0.f, 0.f, 0.f}, {0.f, 0.f, 0.f, 0.f}};
        ALBf16 al{WSP(bf16, WS_H) + (size_t)TP * DM, DM};
        sgemm_task(al, WSP(bf16, WS_WUP) + (size_t)layer * DFF * DM, DM, n0, kq * 512, 16, acc, l15, q4);
#pragma unroll
        for (int mt = 0; mt < 2; ++mt)
#pragma unroll
            for (int r = 0; r < 4; ++r) part[(w * 32 + 16 * mt + 4 * q4 + r) * 16 + l15] = acc[mt][r];
        __syncthreads();
#pragma unroll
        for (int h2 = 0; h2 < 2; ++h2) { const int idx = tid + 512 * h2, half = idx >> 9, row = (idx >> 4) & 31, c = idx & 15; const LAS float* p = part + (half * 4 * 32 + row) * 16 + c;
            const float v = fmaxf((p[0] + p[32 * 16]) + (p[2 * 32 * 16] + p[3 * 32 * 16]), 0.f);
            F[(size_t)(TP + row) * DFF + (2 * sp + half) * 16 + c] = (bf16)f2bf(v * v); } }
}
template <class AL> __device__ __forceinline__ void sample_splitk(const AL& al, const bf16* Wt, int ldw, int nstrips, int nsplit, int nks, float* PART, int ldp, const int wv) {
    SAMPLE_IDS();
    for (int it = gw; it < nstrips * nsplit; it += NGW) { const int ns = it % nstrips, sp = it / nstrips, n0 = ns * 16;
        f32x4 acc[2] = {{0.f, 0.f, 0.f, 0.f}, {0.f, 0.f, 0.f, 0.f}};
        sgemm_task(al, Wt, ldw, n0, sp * nks * 32, nks, acc, l15, q4);
#pragma unroll
        for (int mt = 0; mt < 2; ++mt)
#pragma unroll
            for (int r = 0; r < 4; ++r) PART[((size_t)sp * TS + 16 * mt + 4 * q4 + r) * ldp + n0 + l15] = acc[mt][r]; }
}

constexpr int KS_PITCH = 272, VT_PITCH = 136;
constexpr int ATT_KS = 0, ATT_VT = 64 * KS_PITCH;
__device__ __forceinline__ void attn_prompt_unit(CA A, LAS unsigned char* lds, int layer, int unit, const int wv) {
    const int tid = tid_opaque(wv), lane = tid & 63, wid = tid >> 6, r = lane & 31, hh = lane >> 5;
    const int qb = 7 - (unit >> 4), bh = unit & 15, b = bh >> 2, h = bh & 3;
    const int q0 = qb * 256 + wid * 32, qpos = q0 + r;
    const bf16* QKV = WSP(bf16, WS_QKV) + (size_t)(b * SEQ) * 1536;
    bf16x8 Qf[8];
    { const bf16* qrow = QKV + (size_t)qpos * 1536 + h * 128 + 8 * hh;
#pragma unroll
      for (int s = 0; s < 8; ++s) Qf[s] = *(const bf16x8*)(qrow + 16 * s); }
    f32x16 O[4];
#pragma unroll
    for (int d = 0; d < 4; ++d)
#pragma unroll
        for (int i = 0; i < 16; ++i) O[d][i] = 0.f;
    float R = 0.f;
    const float bias2 = IN_F(I_SBBIAS)[layer * 4 + h] * LOG2E;
    const int ntile = qb * 4 + 4, srow = tid >> 3, sch = tid & 7;
    LAS unsigned char* Ks = lds + ATT_KS; LAS unsigned char* Vt = lds + ATT_VT;
    v4u kreg[2], vreg[2];
    { const bf16* src = QKV + (size_t)((ntile - 1) * 64 + srow) * 1536 + h * 128 + sch * 8;
      kreg[0] = *(const v4u*)(src + 512); kreg[1] = *(const v4u*)(src + 512 + 64); vreg[0] = *(const v4u*)(src + 1024); vreg[1] = *(const v4u*)(src + 1024 + 64); }
    for (int kt = ntile - 1; kt >= 0; --kt) {
        __syncthreads();
#pragma unroll
        for (int i = 0; i < 2; ++i) { *(LAS v4u*)(Ks + srow * KS_PITCH + (sch + 8 * i) * 16) = kreg[i];
            LAS unsigned short* vt = (LAS unsigned short*)Vt + ((sch + 8 * i) * 8) * (VT_PITCH / 2) + srow;
            const unsigned w[4] = {vreg[i].x, vreg[i].y, vreg[i].z, vreg[i].w};
#pragma unroll
            for (int e = 0; e < 4; ++e) { vt[(2 * e) * (VT_PITCH / 2)] = (unsigned short)(w[e] & 0xffffu); vt[(2 * e + 1) * (VT_PITCH / 2)] = (unsigned short)(w[e] >> 16); } }
        __syncthreads();
        if (kt > 0) { const bf16* src = QKV + (size_t)((kt - 1) * 64 + srow) * 1536 + h * 128 + sch * 8;
            kreg[0] = *(const v4u*)(src + 512); kreg[1] = *(const v4u*)(src + 512 + 64); vreg[0] = *(const v4u*)(src + 1024); vreg[1] = *(const v4u*)(src + 1024 + 64); }
        if (kt * 64 > q0 + 30) continue;
        const bool diag = (kt * 64 + 63 >= q0);
        const int kbase = kt * 64 + 4 * hh;
        bf16x8 Pf[4];
#pragma unroll
        for (int sub = 1; sub >= 0; --sub) {
            f32x16 sa;
#pragma unroll
            for (int i = 0; i < 16; ++i) sa[i] = bias2;
#pragma unroll
            for (int s = 0; s < 8; ++s) { const bf16x8 a = *(const LAS bf16x8*)(Ks + (32 * sub + r) * KS_PITCH + (16 * s + 8 * hh) * 2);
                sa = __builtin_amdgcn_mfma_f32_32x32x16_bf16(a, Qf[s], sa, 0, 0, 0); }
            float sp[16], Gs[4], Gp[4];
#pragma unroll
            for (int i = 0; i < 16; ++i) { const float z = fminf(sa[i], 60.f); sa[i] = z; float s1 = lg2(1.0f + ex2(z));
                if (diag && (kbase + 32 * sub + 8 * (i >> 2) + (i & 3) >= qpos)) s1 = 0.f;
                sp[i] = s1; }
#pragma unroll
            for (int g = 0; g < 4; ++g) { Gs[g] = (sp[4 * g] + sp[4 * g + 1]) + (sp[4 * g + 2] + sp[4 * g + 3]); Gp[g] = __shfl_xor(Gs[g], 32); }
            float run = R;
#pragma unroll
            for (int g = 3; g >= 0; --g) { float a = run + (hh == 0 ? Gp[g] : 0.f);
#pragma unroll
                for (int e = 3; e >= 0; --e) { const int i = 4 * g + e; float pv = ex2(sa[i] - sp[i] - a);
                    if (diag && (kbase + 32 * sub + 8 * g + e >= qpos)) pv = 0.f;
                    a += sp[i]; sp[i] = pv; }
                run += Gs[g] + Gp[g]; }
            R = run;
#pragma unroll
            for (int q2 = 0; q2 < 2; ++q2) { const int bs = 8 * q2; v4u w;
                w.x = pk2(sp[bs + 0], sp[bs + 1]); w.y = pk2(sp[bs + 2], sp[bs + 3]); w.z = pk2(sp[bs + 4], sp[bs + 5]); w.w = pk2(sp[bs + 6], sp[bs + 7]);
                Pf[2 * sub + q2] = __builtin_bit_cast(bf16x8, w); }
        }
#pragma unroll
        for (int d = 0; d < 4; ++d)
#pragma unroll
            for (int s4 = 0; s4 < 4; ++s4) { const LAS unsigned char* vp = Vt + (32 * d + r) * VT_PITCH + (16 * s4 + 4 * hh) * 2;
                const v2u lo = *(const LAS v2u*)vp, hi = *(const LAS v2u*)(vp + 16); v4u w; w.x = lo.x; w.y = lo.y; w.z = hi.x; w.w = hi.y;
                O[d] = __builtin_amdgcn_mfma_f32_32x32x16_bf16(__builtin_bit_cast(bf16x8, w), Pf[s4], O[d], 0, 0, 0); }
    }
    bf16* orow = WSP(bf16, WS_OBR) + 1024 + (size_t)(b * SEQ + qpos) * OBW + h * 128 + 4 * hh;
#pragma unroll
    for (int d = 0; d < 4; ++d)
#pragma unroll
        for (int g = 0; g < 4; ++g) { v2u w; w.x = pk2(O[d][4 * g], O[d][4 * g + 1]); w.y = pk2(O[d][4 * g + 2], O[d][4 * g + 3]); *(v2u*)(orow + 32 * d + 8 * g) = w; }
}

__device__ __forceinline__ void attn_sample_unit(CA A, LAS unsigned char* lds, int layer, int unit, const int wv) {
    const int tid = tid_opaque(wv), lane = tid & 63, wid = tid >> 6, sb = unit >> 5, pg4 = unit & 31, hd = lane >> 4;
    const int lp = 4 * pg4 + (wid >> 1), phys = ((const int*)A->in[I_PT])[sb * NPAGES + lp];
    const size_t pbase = ((size_t)(layer * NPOOL + phys) * PAGE + (wid & 1) * 64) * 512 + lane * 8;
    const float* Kc = IN_F(I_CK) + pbase; const float* Vc = IN_F(I_CV) + pbase;
    const bf16* QKV = WSP(bf16, WS_QKV);
    float qf[4][8], O[4][8], R[4];
#pragma unroll
    for (int i = 0; i < 4; ++i) { const v4u w = *(const v4u*)(QKV + (size_t)(TP + sb * 4 + i) * 1536 + lane * 8);
        qf[i][0] = bflo(w.x); qf[i][1] = bfhi(w.x); qf[i][2] = bflo(w.y); qf[i][3] = bfhi(w.y); qf[i][4] = bflo(w.z); qf[i][5] = bfhi(w.z); qf[i][6] = bflo(w.w); qf[i][7] = bfhi(w.w);
        R[i] = 0.f;
#pragma unroll
        for (int j = 0; j < 8; ++j) O[i][j] = 0.f; }
    const float bias2 = IN_F(I_SBBIAS)[layer * 4 + hd] * LOG2E;
#pragma unroll 4
    for (int t = 63; t >= 0; --t) {
        const f32x4 k0 = *(const f32x4*)(Kc + (size_t)t * 512), k1 = *(const f32x4*)(Kc + (size_t)t * 512 + 4), v0 = *(const f32x4*)(Vc + (size_t)t * 512), v1 = *(const f32x4*)(Vc + (size_t)t * 512 + 4);
#pragma unroll
        for (int i = 0; i < 4; ++i) {
            float s = (qf[i][0] * k0[0] + qf[i][1] * k0[1]) + (qf[i][2] * k0[2] + qf[i][3] * k0[3]) + (qf[i][4] * k1[0] + qf[i][5] * k1[1]) + (qf[i][6] * k1[2] + qf[i][7] * k1[3]);
            s = row16_sum(s);
            const float z = fminf(s + bias2, 60.f), s1 = lg2(1.0f + ex2(z)), pv = ex2(z - s1 - R[i]); R[i] += s1;
#pragma unroll
            for (int e = 0; e < 4; ++e) { O[i][e] += pv * v0[e]; O[i][4 + e] += pv * v1[e]; } }
    }
    LAS float* Ow = (LAS float*)lds;
    LAS float* Rw = Ow + 8 * 4 * 512;
    __syncthreads();
#pragma unroll
    for (int i = 0; i < 4; ++i) { *(LAS f32x4*)(Ow + (wid * 4 + i) * 512 + lane * 8) = (f32x4){O[i][0], O[i][1], O[i][2], O[i][3]}; *(LAS f32x4*)(Ow + (wid * 4 + i) * 512 + lane * 8 + 4) = (f32x4){O[i][4], O[i][5], O[i][6], O[i][7]};
        if ((lane & 15) == 0) Rw[(wid * 4 + i) * 4 + hd] = R[i]; }
    __syncthreads();
    float* PART = WSP(float, WS_PART) + (size_t)unit * 2048; float* PR = WSP(float, WS_PR) + (size_t)unit * 16;
    for (int idx = tid; idx < 2048; idx += NTHR) { const int i = idx >> 9, c = idx & 511, hc = c >> 7; float acc = 0.f, racc = 0.f;
#pragma unroll
        for (int w = 7; w >= 0; --w) { acc += ex2(-racc) * Ow[(w * 4 + i) * 512 + c]; racc += Rw[(w * 4 + i) * 4 + hc]; }
        PART[idx] = acc; if ((c & 127) == 0) PR[i * 4 + hc] = racc; }
}
__device__ __forceinline__ void attn_sample_combine(CA A, int layer, const int wv) {
    {
      const int t0 = tid_opaque(wv), gt = blk_opaque() * NTHR + t0; const float* SQ = WSP(float, WS_SSQ); float* RS = WSP(float, WS_RS);
      for (int idx = gt; idx < TT * 2; idx += gridDim.x * NTHR) { const f32x4* sq = (const f32x4*)(SQ + (size_t)idx * 16); const f32x4 a = sq[0], b = sq[1], c = sq[2], d = sq[3];
          RS[idx] = (((a[0] + a[1]) + (a[2] + a[3]) + (b[0] + b[1]) + (b[2] + b[3])) + ((c[0] + c[1]) + (c[2] + c[3]) + (d[0] + d[1]) + (d[2] + d[3]))) * (1.0f / 512.0f) + RMS_EPS; } }
    const int tid = tid_opaque(wv), lane = tid & 63, gw = blk_opaque() * NWAVES + (tid >> 6), NGW = gridDim.x * NWAVES;
    const bf16* QKV = WSP(bf16, WS_QKV); const float* PART = WSP(float, WS_PART); const float* PR = WSP(float, WS_PR);
    const float* kn = A->out + O_KS + (size_t)layer * TS * 512; const float* vn = A->out + O_VS + (size_t)layer * TS * 512;
    bf16* O2 = WSP(bf16, WS_OBR) + 1024;
    for (int it = gw; it < TS * 4; it += NGW) { const int sb = it >> 4, i = (it >> 2) & 3, hd = it & 3, row = TP + sb * 4 + i, c = hd * 128 + 2 * lane;
        const unsigned qw = *(const unsigned*)(QKV + (size_t)row * 1536 + c); const float q0 = bflo(qw), q1 = bfhi(qw);
        const float bias2 = IN_F(I_SBBIAS)[layer * 4 + hd] * LOG2E; float o0 = 0.f, o1 = 0.f, racc = 0.f;
        for (int j = i - 1; j >= 0; --j) { const float* kr = kn + (size_t)(sb * 4 + j) * 512 + c; const float* vr = vn + (size_t)(sb * 4 + j) * 512 + c;
            const float z = fminf(wave_sum(q0 * kr[0] + q1 * kr[1]) + bias2, 60.f), s1 = lg2(1.0f + ex2(z)), pv = ex2(z - s1 - racc); racc += s1; o0 += pv * vr[0]; o1 += pv * vr[1]; }
        for (int u = 31; u >= 0; --u) { const float* pr = PART + ((size_t)(sb * 32 + u) * 4 + i) * 512 + c; const float sc = ex2(-racc); o0 += sc * pr[0]; o1 += sc * pr[1]; racc += PR[(size_t)(sb * 32 + u) * 16 + i * 4 + hd]; }
        *(unsigned*)(O2 + (size_t)row * OBW + c) = pk2(o0, o1); }
}

#ifndef MK_ONE_LAUNCH
#define MK_ONE_LAUNCH 1
#endif
#ifndef REP_P0
#define REP_P0 1
#endif
#ifndef REP_IN
#define REP_IN 1
#endif
#ifndef REP_PREP
#define REP_PREP 1
#endif
#ifndef REP_MIXA
#define REP_MIXA 1
#endif
#ifndef REP_MIXB
#define REP_MIXB 1
#endif
#ifndef REP_MERGE
#define REP_MERGE 1
#endif
#ifndef REP_OUT
#define REP_OUT 1
#endif
#ifndef REP_UP
#define REP_UP 1
#endif
#ifndef REP_DOWN
#define REP_DOWN 1
#endif
#ifndef REP_BAR
#define REP_BAR 1
#endif
#ifndef REP_RES1L0
#define REP_RES1L0 1
#endif
#ifndef REP_BDN
#define REP_BDN 1
#endif
#ifndef REP_BSSD
#define REP_BSSD 1
#endif
#ifndef REP_BSATT
#define REP_BSATT 1
#endif
constexpr int N_PHASES = 24;
__device__ __forceinline__ int queue_pop(unsigned* head, volatile LAS unsigned* slot, const int wv) {
    __syncthreads();
    if (tid_opaque(wv) == 0) *slot = __hip_atomic_fetch_add(head, 1u, __ATOMIC_RELAXED, __HIP_MEMORY_SCOPE_AGENT);
    __syncthreads();
    return (int)*slot;
}
__global__ void __launch_bounds__(NTHR, 2) mega(Args Araw) {
    extern __shared__ __attribute__((aligned(16))) unsigned char lds_raw[];
    LAS unsigned char* lds = (LAS unsigned char*)lds_raw;
    volatile LAS unsigned* MISC = (volatile LAS unsigned*)(lds + MISC_OFF);
    const int wv = __builtin_amdgcn_readfirstlane(threadIdx.x >> 6); const int tid = tid_opaque(wv), G = gridDim.x, blk = blk_opaque();
    if (tid < 16) MISC[tid] = 0u;
    __syncthreads();
    unsigned* ctl = (unsigned*)(Araw.ws + WS_CTL);
    XcdBarrier bar = xcd_barrier_post(ctl + CW_BAR + Araw.li * XCD_BAR_WORDS, MISC, tid);
    const int lo = Araw.ph_lo, hi = Araw.ph_hi;
#define IN(gp) (lo <= (gp) && (gp) < hi)
#define SEAM(gp) do { if (lo <= (gp) && (gp) + 1 < hi) for (int rb_ = 0; rb_ < REP_BAR; ++rb_) xcd_barrier(bar, tid_opaque(wv)); } while (0)

    if (IN(0)) for (int rep = 0; rep < REP_P0; ++rep) { CA A = args_opaque(); p0_prologue(A, lds, wv); }
    SEAM(0);
    if (IN(1)) { CA A = args_opaque(); norm1_phase(A, wv); }
    SEAM(1);
    for (int layer = 0; layer < DEPTH; ++layer) {
        const int gb = 1 + 11 * layer;
        if (IN(gb + 1)) for (int rep = 0; rep < REP_IN; ++rep) { CA A = args_opaque();
            pg8::Gemm g{WSP(bf16, WS_H), WSP(bf16, WS_WIN) + (size_t)layer * NIN * DM, MP, NIN, DM, DM / 64, 0}; pg8::StaticOrder S; S.init(MP, NIN, G, blk_opaque());
            EpiIn E{WSP(float, WS_UF), WSP(bf16, WS_QKV), WSP(bf16, WS_GATE), A->out + O_KP + (size_t)layer * TP * 512, A->out + O_VP + (size_t)layer * TP * 512,
                    A->out + O_KS + (size_t)layer * TS * 512, A->out + O_VS + (size_t)layer * TS * 512, 0.08838834764831845f * LOG2E};
            pg8::gemm_phase<EpiIn, pg8::StaticOrder, true, true>(lds, g, S, E, wv);
        }
        SEAM(gb + 1);
        if (IN(gb + 2)) for (int rep = 0; rep < REP_PREP; ++rep) { CA A = args_opaque(); prep_phase(A, layer, wv); }
        SEAM(gb + 2);
        if (IN(gb + 3)) for (int rep = 0; rep < REP_MIXA; ++rep) { CA A = args_opaque();
            { unsigned* qh = (unsigned*)(A->ws + WS_CTL) + CW_QUEUE + 64 * (layer * 4 + 3) + 1024 * rep;
              for (;;) { const int u = queue_pop(qh, MISC + 4, wv); if (u >= 2048) break; ssd_prep_unit(A, lds, layer, u, wv); } }
            { unsigned* qh = (unsigned*)(A->ws + WS_CTL) + CW_QUEUE + 64 * (layer * 4 + 2) + 1024 * rep;
              for (;;) { const int u = queue_pop(qh, MISC + 4, wv); if (u >= 512) break; dn_chunk_unit(A, lds, layer, u, wv); } }
        }
        SEAM(gb + 3);
        if (IN(gb + 4)) for (int rep = 0; rep < REP_MIXB; ++rep) { CA A = args_opaque();
            for (int r2 = 0; r2 < REP_BDN; ++r2) for (int t = blk; t < 16; t += G) dn_seq2(A, lds, layer, t, wv);
            for (int r2 = 0; r2 < REP_BSSD; ++r2) for (int t = blk; t < 80; t += G) if (t >= 16) ssd_seq2(A, lds, layer, t - 16, wv);
            for (int t = blk; t < 112; t += G) if (t >= 80) dn_seq(A, lds, layer, t - 80 + 16, wv);
            for (int t = blk; t < 240; t += G) if (t >= 112) ssd_seq(A, lds, layer, t - 112 + 64, wv);
            { unsigned* qh = (unsigned*)(A->ws + WS_CTL) + CW_QUEUE + 64 * (layer * 4 + 0) + 1024 * rep;
              for (;;) { const int u = queue_pop(qh, MISC + 4, wv); if (u >= 128) break; attn_prompt_unit(A, lds, layer, u, wv); } }
            for (int r2 = 0; r2 < REP_BSATT; ++r2) { unsigned* qh = (unsigned*)(A->ws + WS_CTL) + CW_QUEUE + 64 * (layer * 4 + 1) + 1024 * rep + 2048 * r2;
              for (;;) { const int u = queue_pop(qh, MISC + 4, wv); if (u >= 256) break; attn_sample_unit(A, lds, layer, u, wv); } }
        }
        SEAM(gb + 4);
        if (IN(gb + 5)) { CA A = args_opaque(); attn_sample_combine(A, layer, wv); }
        SEAM(gb + 5);
        if (IN(gb + 6)) for (int rep = 0; rep < REP_MERGE; ++rep) { CA A = args_opaque();
            pg8::SegOrder<5> S; S.init(TP, DM, G, blk_opaque());
            pg8::Gemm g{WSP(bf16, WS_OBR), WSP(bf16, WS_WBR) + (size_t)layer * DM * OBW, TP, DM, OBW, 8, 1024};
            EpiMergeR E{WSP(bf16, WS_GATE), WSP(float, WS_RS), WSP(bf16, WS_MGB)};
            pg8::gemm_phase<EpiMergeR, pg8::SegOrder<5>, true, true>(lds, g, S, E, wv);
            sample_merge(A, lds, layer, wv);
        }
        SEAM(gb + 6);
        if (IN(gb + 7)) for (int rep = 0; rep < REP_OUT; ++rep) { CA A = args_opaque();
            pg8::Gemm g{WSP(bf16, WS_MGB), WSP(bf16, WS_WOUT) + (size_t)layer * DM * DM, TP, DM, DM, DM / 64, 0}; pg8::StaticOrder S; S.init(TP, DM, G, blk_opaque());
            EpiF32 E{WSP(float, WS_MIX), DM}; pg8::gemm_phase<EpiF32, pg8::StaticOrder, true, true>(lds, g, S, E, wv);
            { ALBf16 al{WSP(bf16, WS_MGB) + (size_t)TP * DM, DM}; sample_splitk(al, WSP(bf16, WS_WOUT) + (size_t)layer * DM * DM, DM, 128, 16, 4, WSP(float, WS_OUTS), DM, wv); }
        }
        SEAM(gb + 7);
        if (IN(gb + 8)) for (int rep = 0; rep < (layer == 0 ? REP_RES1L0 : 1); ++rep) { CA A = args_opaque(); resid_phase(A, WSP(float, WS_MIX), WSP(float, WS_OUTS), IN_F(I_NMPOST) + layer * DM, IN_F(I_NLPRE) + layer * DM, layer == 0, wv); }
        SEAM(gb + 8);
        if (IN(gb + 9)) for (int rep = 0; rep < REP_UP; ++rep) { CA A = args_opaque();
            pg8::Gemm g{WSP(bf16, WS_H), WSP(bf16, WS_WUP) + (size_t)layer * DFF * DM, TP, DFF, DM, DM / 64, 0}; pg8::StaticOrder S; S.init(TP, DFF, G, blk_opaque());
            EpiRelu2 E{WSP(bf16, WS_F), DFF}; pg8::gemm_phase<EpiRelu2, pg8::StaticOrder, true, true>(lds, g, S, E, wv);
            sample_up(A, lds, layer, wv);
        }
        SEAM(gb + 9);
        if (IN(gb + 10)) for (int rep = 0; rep < REP_DOWN; ++rep) { CA A = args_opaque();
            pg8::Gemm g{WSP(bf16, WS_F), WSP(bf16, WS_WDN) + (size_t)layer * DM * DFF, TP, DM, DFF, DFF / 64, 0}; pg8::StaticOrder S; S.init(TP, DM, G, blk_opaque());
            EpiF32 E{WSP(float, WS_FD), DM}; pg8::gemm_phase<EpiF32, pg8::StaticOrder, true, true>(lds, g, S, E, wv);
            { ALBf16 al{WSP(bf16, WS_F) + (size_t)TP * DFF, DFF}; sample_splitk(al, WSP(bf16, WS_WDN) + (size_t)layer * DM * DFF, DFF, 128, 16, 16, WSP(float, WS_DNS), DM, wv); }
        }
        SEAM(gb + 10);
        if (IN(gb + 11)) { CA A = args_opaque(); resid_phase(A, WSP(float, WS_FD), WSP(float, WS_DNS), IN_F(I_NLPOST) + layer * DM, layer + 1 < DEPTH ? IN_F(I_NMPRE) + (layer + 1) * DM : nullptr, false, wv); }
        SEAM(gb + 11);
    }
#undef IN
#undef SEAM
}

extern "C" void kernel_launch(void* const* d_in, const int* in_sizes, int n_in, void* d_out, int out_size, void* d_ws, size_t ws_size, hipStream_t stream) {
    static int grid = 0;
    if (grid == 0) {
        if (n_in != N_IN || (size_t)out_size != O_END || ws_size < WS_END) { fprintf(stderr, "kernel_launch: unexpected problem (n_in %d, out %d vs %zu, ws %zu vs %zu); nothing launched\n", n_in, out_size, (size_t)O_END, ws_size, (size_t)WS_END); grid = -1; return; }
        int dev = 0, cus = 0, per_cu = 0;
        if (hipGetDevice(&dev) != hipSuccess || hipDeviceGetAttribute(&cus, hipDeviceAttributeMultiprocessorCount, dev) != hipSuccess) { grid = -1; return; }
        if (hipFuncSetAttribute((const void*)mega, hipFuncAttributeMaxDynamicSharedMemorySize, LDS_BYTES) != hipSuccess) { fprintf(stderr, "kernel_launch: hipFuncSetAttribute failed\n"); grid = -1; return; }
        if (hipOccupancyMaxActiveBlocksPerMultiprocessor(&per_cu, (const void*)mega, NTHR, LDS_BYTES) != hipSuccess || per_cu < 1) fprintf(stderr, "kernel_launch: occupancy query says %d blocks per CU\n", per_cu);
        (void)hipGetLastError();
        grid = cus;
    }
    if (grid < 0) return;
    (void)in_sizes;
    hipMemsetAsync((char*)d_ws + WS_CTL, 0, CTL_BYTES, stream);
    Args a{};
    for (int i = 0; i < N_IN; ++i) a.in[i] = d_in[i];
    a.out = (float*)d_out; a.ws = (unsigned char*)d_ws; a.pad = 0;
#if MK_ONE_LAUNCH
    a.ph_lo = 0; a.ph_hi = N_PHASES; a.li = 0;
    hipLaunchKernelGGL(mega, dim3(grid), dim3(NTHR), LDS_BYTES, stream, a);
#else
    for (int gp = 0; gp < N_PHASES; ++gp) { a.ph_lo = gp; a.ph_hi = gp + 1; a.li = 0; hipLaunchKernelGGL(mega, dim3(grid), dim3(NTHR), LDS_BYTES, stream, a); }
#endif
}
```

```cpp
#include <hip/hip_runtime.h>
#include <cstdio>
#include <cstdint>
__device__ __forceinline__ int lane_opaque() { unsigned m = ~0u; asm volatile("" : "+s"(m)); return (int)__builtin_amdgcn_mbcnt_hi(m, __builtin_amdgcn_mbcnt_lo(m, 0u)); }
__device__ __forceinline__ int tid_opaque(int wv) { return wv * 64 + lane_opaque(); }
__device__ __forceinline__ int blk_opaque() { int t = blockIdx.x; asm volatile("" : "+s"(t)); return t; }
namespace pg8 {
#define PG8_LAS __attribute__((address_space(3)))
typedef unsigned short bf16_t;
typedef short bf16x8 __attribute__((ext_vector_type(8)));
typedef float f32x4 __attribute__((ext_vector_type(4)));
typedef unsigned u32x4 __attribute__((ext_vector_type(4)));
constexpr int BM = 256, BK = 64, HALF = 128, HTB = HALF * BK * 2  , STAGE_BYTES = 8 * HTB, NXCD = 8, WGM = 8;

__host__ __device__ __forceinline__ int lds_byte(int r, int c) { const int st = (r >> 4) * 2 + (c >> 5), rr = r & 15, cc = c & 31, ob = rr * 64 + cc * 2; return st * 1024 + (ob ^ (((ob >> 9) & 1) << 5)); }
__host__ __device__ __forceinline__ void stage_rc(int b, int& R, int& C) { const int st = b / 1024, sb = b % 1024, swz = sb ^ (((sb >> 9) & 1) << 5); R = (st >> 1) * 16 + swz / 64; C = (st & 1) * 32 + (swz % 64) / 2; }
__host__ __device__ __forceinline__ int perm32(int rho) { const int n = rho >> 4, i = rho & 15; return 8 * (i >> 2) + 4 * n + (i & 3); }

struct Unit { int pm, pn, seg; };
struct Gemm { const bf16_t* A; const bf16_t* Bt; int M, N, K, KT, SEGB; };

struct StaticOrder {
    int nM, nN, nwg, G, c;
    __host__ __device__ void init(int M, int N, int G_, int c_) { nM = M / BM; nN = N / BM; nwg = nM * nN; G = G_; c = c_; }
    __host__ __device__ bool next(int i, Unit& u) const {
        const long L = (long)i * G + c; if (L >= nwg) return false;
        int wgid = (int)L; { const int q = nwg / NXCD, r = nwg % NXCD, xcd = wgid % NXCD, off = wgid / NXCD; wgid = (xcd < r ? xcd * (q + 1) : r * (q + 1) + (xcd - r) * q) + off; }
        const int nig = WGM * nN, gid = wgid / nig, fm = gid * WGM, gsz = (nM - fm) < WGM ? (nM - fm) : WGM;
        u.pm = fm + ((wgid % nig) % gsz); u.pn = (wgid % nig) / gsz; u.seg = 0; return true;
    }
    __device__ __forceinline__ void a_ready(const Unit&) const {}
    __device__ __forceinline__ void done(const Unit&) const {}
};
template <int NSEG> struct SegOrder : StaticOrder {
    __host__ __device__ bool next(int i, Unit& u) const { if (!StaticOrder::next(i / NSEG, u)) return false; u.seg = i % NSEG; return true; }
};
__device__ __forceinline__ unsigned cvt_pk_bf16(float lo, float hi) { unsigned r; asm volatile("v_cvt_pk_bf16_f32 %0, %1, %2" : "=v"(r) : "v"(lo), "v"(hi)); return r; }
typedef float f32x2 __attribute__((ext_vector_type(2)));
template <class Epi, class Sched, bool ALIGN_EPI = false, bool SP2 = false>
__device__ __forceinline__ void gemm_phase(PG8_LAS unsigned char* lds, const Gemm g, const Sched& S, const Epi& E, const int wv) {
    int wvo = wv; asm volatile("" : "+s"(wvo));
    const int lane = lane_opaque(), tid = wvo * 64 + lane, wid = wvo, wr = wid >> 2, wc = wid & 3, fr = lane & 15, fq = lane >> 4;
    const int K = g.K, nt = g.KT;
    unsigned voffA[2], voffB[2];
#pragma unroll
    for (int i = 0; i < 2; ++i) { int R, C; stage_rc(tid * 16 + i * 8192, R, C); const int Rb = Epi::PERM ? ((R & ~31) + perm32(R & 31)) : R;
        voffA[i] = (unsigned)(R * K + C) * 2u; voffB[i] = (unsigned)(Rb * K + C) * 2u; }
    const size_t kstep = (size_t)(BK * 2);
    const size_t hstep = (size_t)HALF * K * 2;
    const size_t tstep = 2 * hstep;
    const unsigned ldsw = (unsigned)wid * 1024u;
    const int aoff = lds_byte(wr * 64 + fr, fq * 8), boff = lds_byte(wc * 32 + fr, fq * 8);
#define PG8_SA(b, h) (((b) * 2 + (h)) * HTB)
#define PG8_SB(b, h) ((4 + (b) * 2 + (h)) * HTB)
#define PG8_STAGE(bufoff, gbase, voff) do { _Pragma("unroll") for (int _i = 0; _i < 2; ++_i) \
        __builtin_amdgcn_global_load_lds((const unsigned*)((const char*)(gbase) + (voff)[_i]), (PG8_LAS unsigned*)(lds + (bufoff) + ldsw + _i * 8192), 16, 0, 0); } while (0)
#define PG8_LDA(dst, b, h) do { _Pragma("unroll") for (int m = 0; m < 4; ++m) _Pragma("unroll") for (int k = 0; k < 2; ++k) dst[m][k] = *(const PG8_LAS bf16x8*)(lds + PG8_SA(b, h) + aoff + m * 2048 + k * 1024); } while (0)
#define PG8_LDB(dst, b, h) do { _Pragma("unroll") for (int n = 0; n < 2; ++n) _Pragma("unroll") for (int k = 0; k < 2; ++k) dst[n][k] = *(const PG8_LAS bf16x8*)(lds + PG8_SB(b, h) + boff + n * 2048 + k * 1024); } while (0)
#define PG8_MMA(ai, bj, At, Bt) do { __builtin_amdgcn_s_setprio(1); _Pragma("unroll") for (int m = 0; m < 4; ++m) _Pragma("unroll") for (int n = 0; n < 2; ++n) _Pragma("unroll") for (int k = 0; k < 2; ++k) \
        acc[ai][bj][m][n] = __builtin_amdgcn_mfma_f32_16x16x32_bf16(Bt[n][k], At[m][k], acc[ai][bj][m][n], 0, 0, 0); __builtin_amdgcn_s_setprio(0); } while (0)
#define PG8_WAIT_V(n) asm volatile("s_waitcnt vmcnt(" #n ")" ::: "memory")
#define PG8_WAIT_L(n) asm volatile("s_waitcnt lgkmcnt(" #n ")" ::: "memory")
#define PG8_BAR __builtin_amdgcn_s_barrier()
#define PG8_SCHED __builtin_amdgcn_sched_barrier(0)
    Unit cur, nxt; int ui = 0;
    if (!S.next(0, cur)) return;
    f32x4 acc[2][2][4][2];
#pragma unroll
    for (int a = 0; a < 2; ++a)
#pragma unroll
        for (int b = 0; b < 2; ++b)
#pragma unroll
            for (int m = 0; m < 4; ++m)
#pragma unroll
                for (int n = 0; n < 2; ++n) acc[a][b][m][n] = (f32x4){0.f, 0.f, 0.f, 0.f};
    bf16x8 At[4][2], B0[2][2], B1[2][2];
    const char* cA = (const char*)g.A + (size_t)cur.pm * tstep + (size_t)cur.seg * g.SEGB; const char* cB = (const char*)g.Bt + (size_t)cur.pn * tstep + (size_t)cur.seg * g.SEGB;
    S.a_ready(cur);
    if constexpr (SP2) {
        PG8_STAGE(PG8_SB(0, 0), cB, voffB); PG8_STAGE(PG8_SB(0, 1), cB + hstep, voffB); PG8_STAGE(PG8_SA(0, 0), cA, voffA); PG8_STAGE(PG8_SA(0, 1), cA + hstep, voffA);
        if (wr == 1) PG8_BAR;
        PG8_WAIT_V(2); PG8_BAR;
        PG8_STAGE(PG8_SB(1, 0), cB + kstep, voffB); PG8_STAGE(PG8_SA(1, 0), cA + kstep, voffA); PG8_STAGE(PG8_SB(1, 1), cB + hstep + kstep, voffB);
        PG8_WAIT_V(6); PG8_BAR;
    } else {
        PG8_STAGE(PG8_SB(0, 0), cB, voffB); PG8_STAGE(PG8_SA(0, 0), cA, voffA); PG8_STAGE(PG8_SB(0, 1), cB + hstep, voffB); PG8_STAGE(PG8_SA(0, 1), cA + hstep, voffA);
        if (wr == 1) PG8_BAR;
        PG8_WAIT_V(4); PG8_BAR;
        PG8_STAGE(PG8_SB(1, 0), cB + kstep, voffB); PG8_STAGE(PG8_SA(1, 0), cA + kstep, voffA); PG8_STAGE(PG8_SB(1, 1), cB + hstep + kstep, voffB);
        PG8_WAIT_V(6); PG8_BAR;
    }
    for (;;) {
        const bool has_next = S.next(ui + 1, nxt);
        const char* nA = has_next ? (const char*)g.A + (size_t)nxt.pm * tstep + (size_t)nxt.seg * g.SEGB : cA; const char* nB = has_next ? (const char*)g.Bt + (size_t)nxt.pn * tstep + (size_t)nxt.seg * g.SEGB : cB;
        for (int t = 0; t < nt; t += 2) {
            const bool last = (t == nt - 2);
            const char* a1 = cA + (size_t)(t + 1) * kstep;
            const char* a2 = last ? nA : cA + (size_t)(t + 2) * kstep; const char* b2 = last ? nB : cB + (size_t)(t + 2) * kstep;
            const char* a3 = a2 + kstep; const char* b3 = b2 + kstep;
            if (last && has_next) S.a_ready(nxt);
            if constexpr (SP2) {
            PG8_LDB(B0, 0, 0); PG8_LDB(B1, 0, 1); PG8_SCHED; PG8_LDA(At, 0, 0); PG8_STAGE(PG8_SA(1, 1), a1 + hstep, voffA);
            PG8_WAIT_V(8); PG8_WAIT_L(0); PG8_BAR; PG8_MMA(0, 0, At, B0); PG8_MMA(0, 1, At, B1); PG8_BAR; PG8_SCHED;
            PG8_LDA(At, 0, 1); PG8_STAGE(PG8_SB(0, 0), b2, voffB); PG8_STAGE(PG8_SB(0, 1), b2 + hstep, voffB); PG8_STAGE(PG8_SA(0, 0), a2, voffA);
            PG8_WAIT_V(8); PG8_WAIT_L(0); PG8_BAR; PG8_MMA(1, 0, At, B0); PG8_MMA(1, 1, At, B1); PG8_BAR; PG8_SCHED;
            PG8_LDB(B0, 1, 0); PG8_LDB(B1, 1, 1); PG8_SCHED; PG8_LDA(At, 1, 0); PG8_STAGE(PG8_SA(0, 1), a2 + hstep, voffA);
            PG8_WAIT_V(8); PG8_WAIT_L(0); PG8_BAR; PG8_MMA(0, 0, At, B0); PG8_MMA(0, 1, At, B1); PG8_BAR; PG8_SCHED;
            PG8_LDA(At, 1, 1); PG8_STAGE(PG8_SB(1, 0), b3, voffB); PG8_STAGE(PG8_SB(1, 1), b3 + hstep, voffB); PG8_STAGE(PG8_SA(1, 0), a3, voffA);
            PG8_WAIT_V(8); PG8_WAIT_L(0); PG8_BAR; PG8_MMA(1, 0, At, B0); PG8_MMA(1, 1, At, B1); PG8_BAR; PG8_SCHED;
            } else {
            PG8_LDB(B0, 0, 0); PG8_SCHED; PG8_LDA(At, 0, 0); PG8_STAGE(PG8_SA(1, 1), a1 + hstep, voffA);
            PG8_WAIT_L(8); PG8_BAR; PG8_WAIT_L(0); PG8_MMA(0, 0, At, B0); PG8_BAR; PG8_SCHED;
            PG8_LDB(B1, 0, 1); PG8_STAGE(PG8_SB(0, 0), b2, voffB);
            PG8_BAR; PG8_WAIT_L(0); PG8_MMA(0, 1, At, B1); PG8_BAR;
            PG8_LDA(At, 0, 1); PG8_STAGE(PG8_SA(0, 0), a2, voffA);
            PG8_BAR; PG8_WAIT_L(0); PG8_MMA(1, 0, At, B0); PG8_BAR; PG8_SCHED;
            PG8_STAGE(PG8_SB(0, 1), b2 + hstep, voffB);
            PG8_WAIT_V(6); PG8_BAR; PG8_MMA(1, 1, At, B1); PG8_BAR;
            PG8_LDB(B0, 1, 0); PG8_SCHED; PG8_LDA(At, 1, 0); PG8_STAGE(PG8_SA(0, 1), a2 + hstep, voffA);
            PG8_WAIT_L(8); PG8_BAR; PG8_WAIT_L(0); PG8_MMA(0, 0, At, B0); PG8_BAR; PG8_SCHED;
            PG8_LDB(B1, 1, 1); PG8_STAGE(PG8_SB(1, 0), b3, voffB);
            PG8_BAR; PG8_WAIT_L(0); PG8_MMA(0, 1, At, B1); PG8_BAR;
            PG8_LDA(At, 1, 1); PG8_STAGE(PG8_SA(1, 0), a3, voffA);
            PG8_BAR; PG8_WAIT_L(0); PG8_MMA(1, 0, At, B0); PG8_BAR; PG8_SCHED;
            PG8_STAGE(PG8_SB(1, 1), b3 + hstep, voffB);
            PG8_WAIT_V(6); PG8_BAR; PG8_MMA(1, 1, At, B1); PG8_BAR;
            }
        }
        if constexpr (ALIGN_EPI) { if (wr == 0) PG8_BAR; }
        if constexpr (!Epi::AFTER_DRAIN) { E(acc, cur, wr, wc, fr, fq); S.done(cur); }
        if (!has_next) break;
        if (!(Epi::KEEP_ACC && nxt.seg != 0)) {
#pragma unroll
        for (int a = 0; a < 2; ++a)
#pragma unroll
            for (int b = 0; b < 2; ++b)
#pragma unroll
                for (int m = 0; m < 4; ++m)
#pragma unroll
                    for (int n = 0; n < 2; ++n) acc[a][b][m][n] = (f32x4){0.f, 0.f, 0.f, 0.f}; }
        cur = nxt; cA = nA; cB = nB; ++ui;
        if constexpr (ALIGN_EPI) { if (wr == 1) PG8_BAR; }
    }
    PG8_WAIT_V(0);
    if constexpr (!ALIGN_EPI) { if (wr == 0) PG8_BAR; }
    PG8_BAR;
    if constexpr (Epi::AFTER_DRAIN) { E.fused(acc, cur, wr, wc, fr, fq, lds, wid, lane); S.done(cur); }
#undef PG8_SA
#undef PG8_SB
#undef PG8_STAGE
#undef PG8_LDA
#undef PG8_LDB
#undef PG8_MMA
#undef PG8_WAIT_V
#undef PG8_WAIT_L
#undef PG8_BAR
#undef PG8_SCHED
}
}

constexpr int DM = 2048, NBATCH = 4, SEQ = 2048, DEPTH = 2, DBATCH = 8, DSEQ = 4, PAST = 16384, PAGE = 128;
constexpr int TP = NBATCH * SEQ;
constexpr int TS = DBATCH * DSEQ;
constexpr int TT = TP + TS;
constexpr int MP = 8448;
constexpr int NPAGES = PAST / PAGE;
constexpr int NPOOL = 1280;
constexpr int POOLW = 512, DNC = 1536, SBW = 512, SSI = 1024, SSC = 1536, DFF = 8192;
constexpr int INCOLS = 14872, NIN = 15104;
constexpr int OBW = 2560;
constexpr int UFW = 5376;
constexpr int UF_POOL = 0, UF_DNQKV = 512, UF_DNZ = 2048, UF_SSZ = 2560, UF_XBC = 3584, UF_SMALL = 5120;
constexpr float RMS_EPS = 1e-6f;
constexpr float LOG2E = 1.4426950408889634f;
constexpr int NWAVES = 8, NTHR = 512;

constexpr size_t O_Y = 0;
constexpr size_t O_KP = O_Y + (size_t)TT * DM;
constexpr size_t O_VP = O_KP + (size_t)DEPTH * TP * 512;
constexpr size_t O_POOLP = O_VP + (size_t)DEPTH * TP * 512;
constexpr size_t O_DNCP = O_POOLP + (size_t)DEPTH * NBATCH * 15 * 512;
constexpr size_t O_DNSP = O_DNCP + (size_t)DEPTH * NBATCH * 3 * 1536;
constexpr size_t O_SSCP = O_DNSP + (size_t)DEPTH * NBATCH * 4 * 128 * 128;
constexpr size_t O_SSHP = O_SSCP + (size_t)DEPTH * NBATCH * 3 * 1536;
constexpr size_t O_KS = O_SSHP + (size_t)DEPTH * NBATCH * 16 * 64 * 128;
constexpr size_t O_VS = O_KS + (size_t)DEPTH * TS * 512;
constexpr size_t O_POOLS = O_VS + (size_t)DEPTH * TS * 512;
constexpr size_t O_DNCS = O_POOLS + (size_t)DEPTH * DBATCH * 15 * 512;
constexpr size_t O_DNSS = O_DNCS + (size_t)DEPTH * DBATCH * 3 * 1536;
constexpr size_t O_SSCS = O_DNSS + (size_t)DEPTH * DBATCH * 4 * 128 * 128;
constexpr size_t O_SSHS = O_SSCS + (size_t)DEPTH * DBATCH * 3 * 1536;
constexpr size_t O_END = O_SSHS + (size_t)DEPTH * DBATCH * 16 * 64 * 128;

constexpr size_t al256(size_t x) { return (x + 255) & ~(size_t)255; }
constexpr size_t WS_CTL = 0, CTL_BYTES = 1u << 20;
constexpr size_t SZ_WIN = (size_t)NIN * DM * 2, SZ_WBR = (size_t)5 * DM * 512 * 2, SZ_WOUT = (size_t)DM * DM * 2, SZ_WUP = (size_t)DFF * DM * 2, SZ_WDN = (size_t)DM * DFF * 2;
constexpr size_t WS_WIN = WS_CTL + CTL_BYTES;
constexpr size_t WS_WBR = WS_WIN + 2 * SZ_WIN;
constexpr size_t WS_WOUT = WS_WBR + 2 * SZ_WBR;
constexpr size_t WS_WUP = WS_WOUT + 2 * SZ_WOUT;
constexpr size_t WS_WDN = WS_WUP + 2 * SZ_WUP;
constexpr size_t WS_H = WS_WDN + 2 * SZ_WDN;
constexpr size_t WS_UF = WS_H + (size_t)MP * DM * 2;
constexpr size_t WS_QKV = WS_UF + (size_t)MP * UFW * 4;
constexpr size_t WS_GATE = WS_QKV + (size_t)MP * 1536 * 2;
constexpr size_t WS_DNQ = WS_GATE + (size_t)MP * 8192 * 2;
constexpr size_t WS_XBC = WS_DNQ + (size_t)MP * 1536 * 4;
constexpr size_t WS_SCAL = WS_XBC + (size_t)MP * 1536 * 4;
constexpr size_t WS_OBR = WS_SCAL + (size_t)MP * 32 * 4;
constexpr size_t SZ_OBR = (size_t)MP * 512 * 2;
constexpr size_t WS_SSQ = WS_OBR + 5 * SZ_OBR;
constexpr size_t WS_MG32 = WS_SSQ + (size_t)MP * 32 * 4;
constexpr size_t WS_MGB = WS_MG32 + (size_t)MP * DM * 4;
constexpr size_t WS_MIX = WS_MGB + (size_t)MP * DM * 2;
constexpr size_t WS_F = WS_MIX + (size_t)MP * DM * 4;
constexpr size_t WS_FD = WS_F + (size_t)MP * DFF * 2;
constexpr size_t WS_PART = WS_FD + (size_t)MP * DM * 4;
constexpr size_t WS_PR = WS_PART + (size_t)256 * 2048 * 4;
constexpr size_t WS_DNU = WS_PR + (size_t)256 * 16 * 4;
constexpr size_t WS_SSU = WS_DNU + (size_t)512 * 90368;
constexpr size_t WS_SSG = WS_SSU + (size_t)2048 * 16896;
constexpr size_t WS_MGS = WS_SSG + (size_t)256 * 49152;
constexpr size_t WS_OUTS = WS_MGS + (size_t)5 * TS * DM * 4;
constexpr size_t WS_UPS = WS_OUTS + (size_t)16 * TS * DM * 4;
constexpr size_t WS_DNS = WS_UPS + (size_t)4 * TS * DFF * 4;
constexpr size_t WS_RS = WS_DNS + (size_t)16 * TS * DM * 4;
constexpr size_t WS_DNSV = WS_RS + (size_t)MP * 2 * 4;
constexpr size_t WS_END = WS_DNSV + (size_t)512 * 49152;
static_assert(WS_WIN % 256 == 0 && WS_H % 256 == 0 && WS_UF % 256 == 0 && WS_OBR % 256 == 0 && WS_MG32 % 256 == 0 && WS_PART % 256 == 0, "ws alignment");

constexpr int CW_QUEUE = 64;
constexpr int CW_BAR = 4096;

constexpr int LDS_BYTES = 147456;
constexpr int RING_BYTES = 131072;
constexpr int MISC_OFF = RING_BYTES;

#define GAS __attribute__((address_space(1)))
#define LAS __attribute__((address_space(3)))
typedef unsigned short bf16;
typedef unsigned v4u __attribute__((ext_vector_type(4)));
typedef unsigned v2u __attribute__((ext_vector_type(2)));
typedef float f32x4 __attribute__((ext_vector_type(4)));
typedef float f32x2 __attribute__((ext_vector_type(2)));
typedef float f32x16 __attribute__((ext_vector_type(16)));
typedef short bf16x8 __attribute__((ext_vector_type(8)));
typedef __bf16 bf16x2_t __attribute__((ext_vector_type(2)));
__device__ __forceinline__ unsigned pk2(float lo, float hi) { const f32x2 v = {lo, hi}; return __builtin_bit_cast(unsigned, __builtin_convertvector(v, bf16x2_t)); }
__device__ __forceinline__ unsigned f2bf(float f) { return pk2(f, f) & 0xffffu; }
__device__ __forceinline__ float bflo(unsigned w) { return __builtin_bit_cast(float, w << 16); }
__device__ __forceinline__ float bfhi(unsigned w) { return __builtin_bit_cast(float, w & 0xffff0000u); }
__device__ __forceinline__ float row16_sum(float x) {
    x += __builtin_bit_cast(float, __builtin_amdgcn_update_dpp(0, __builtin_bit_cast(int, x), 0x128, 0xf, 0xf, false));
    x += __builtin_bit_cast(float, __builtin_amdgcn_update_dpp(0, __builtin_bit_cast(int, x), 0x124, 0xf, 0xf, false));
    x += __builtin_bit_cast(float, __builtin_amdgcn_update_dpp(0, __builtin_bit_cast(int, x), 0x122, 0xf, 0xf, false));
    x += __builtin_bit_cast(float, __builtin_amdgcn_update_dpp(0, __builtin_bit_cast(int, x), 0x121, 0xf, 0xf, false));
    return x;
}
__device__ __forceinline__ float rdlane(float x, int l) { return __builtin_bit_cast(float, __builtin_amdgcn_readlane(__builtin_bit_cast(int, x), l)); }
__device__ __forceinline__ float wave_sum(float v) { const float r = row16_sum(v); return (rdlane(r, 0) + rdlane(r, 16)) + (rdlane(r, 32) + rdlane(r, 48)); }
__device__ __forceinline__ float wave_scan(float x, int lane) {
    x += __builtin_bit_cast(float, __builtin_amdgcn_update_dpp(0, __builtin_bit_cast(int, x), 0x111, 0xf, 0xf, true));
    x += __builtin_bit_cast(float, __builtin_amdgcn_update_dpp(0, __builtin_bit_cast(int, x), 0x112, 0xf, 0xf, true));
    x += __builtin_bit_cast(float, __builtin_amdgcn_update_dpp(0, __builtin_bit_cast(int, x), 0x114, 0xf, 0xf, true));
    x += __builtin_bit_cast(float, __builtin_amdgcn_update_dpp(0, __builtin_bit_cast(int, x), 0x118, 0xf, 0xf, true));
    const float t0 = rdlane(x, 15), t1 = rdlane(x, 31), t2 = rdlane(x, 47);
    return x + (lane >= 48 ? (t0 + t1) + t2 : (lane >= 32 ? t0 + t1 : (lane >= 16 ? t0 : 0.f)));
}
__device__ __forceinline__ float fexp(float x) { return __builtin_amdgcn_exp2f(x * 1.4426950408889634f); }
__device__ __forceinline__ float sigmoidf_(float x) { return 1.0f / (1.0f + __expf(-x)); }
__device__ __forceinline__ float siluf_(float x) { return x / (1.0f + __expf(-x)); }
__device__ __forceinline__ float softplusf_(float x) { const float e = fexp(fminf(x, 20.f)); const float l = e < 0.01f ? e * (1.0f - e * (0.5f - e * 0.33333333f)) : __builtin_amdgcn_logf(1.0f + e) * 0.6931471805599453f; return x > 20.f ? x : l; }
__device__ __forceinline__ float ex2(float x) { return __builtin_amdgcn_exp2f(x); }
__device__ __forceinline__ float lg2(float x) { return __builtin_amdgcn_logf(x); }
#define XB_TMO      128
#define XB_XCNT(j)  (256  + 64 * (j))
#define XB_XSUB(j)  (1280 + 64 * (j))
#define XB_XGEN(j)  (2304 + 64 * (j))
#define XB_TOP      3328
#define XB_TOPGEN   3392
#define XCD_BAR_WORDS 3456
#define XB_SPIN_CAP (1u << 18)

__device__ __forceinline__ unsigned xb_ld(unsigned* p)              { return __hip_atomic_load(p, __ATOMIC_RELAXED, __HIP_MEMORY_SCOPE_AGENT); }
__device__ __forceinline__ unsigned xb_add(unsigned* p, unsigned v) { return __hip_atomic_fetch_add(p, v, __ATOMIC_RELAXED, __HIP_MEMORY_SCOPE_AGENT); }
__device__ __forceinline__ unsigned xb_xcc_id() { return (unsigned)__builtin_amdgcn_s_getreg((3 << 11) | 20) & 0xFu; }
#define XB_SPIN(cond, bar) do { unsigned _sp = 0; while (cond) { __builtin_amdgcn_s_sleep(1); \
    if ((++_sp & 255u) == 0u) { if (xb_ld(&(bar)[XB_TMO])) break; if (_sp > XB_SPIN_CAP) { atomicAdd(&(bar)[XB_TMO], 1u); break; } } } } while (0)

struct XcdBarrier {
    unsigned* bar; unsigned x;
    volatile LAS unsigned* st;
};

__device__ __forceinline__ XcdBarrier xcd_barrier_post(unsigned* bar, volatile LAS unsigned* st, const int tid) {
    XcdBarrier b; b.bar = bar; b.x = xb_xcc_id(); b.st = st;
    if (tid == 0) (void)xb_add(&bar[XB_XCNT(b.x)], 1u);
    return b;
}
__device__ __forceinline__ void xcd_barrier_complete(unsigned* bar, unsigned x, unsigned& nloc, unsigned& nx) {
    const unsigned G = gridDim.x * gridDim.y * gridDim.z;
    unsigned sum, cnt, mine, sp = 0u;
    for (;;) {
        sum = 0u; cnt = 0u; mine = 0u;
#pragma unroll
        for (unsigned j = 0; j < 16; ++j) { const unsigned c = xb_ld(&bar[XB_XCNT(j)]); sum += c; cnt += (c > 0u) ? 1u : 0u; mine = (j == x) ? c : mine; }
        if (sum == G) break;
        __builtin_amdgcn_s_sleep(1);
        if ((++sp & 255u) == 0u) { if (xb_ld(&bar[XB_TMO])) break; if (sp > XB_SPIN_CAP) { atomicAdd(&bar[XB_TMO], 1u); break; } }
    }
    nloc = mine > 0u ? mine : 1u; nx = cnt > 0u ? cnt : 1u;
}

__device__ __forceinline__ void xcd_barrier(const XcdBarrier& b, const int tid) {
    asm volatile("s_waitcnt vmcnt(0)" ::: "memory");
    __syncthreads();
    if (tid == 0) {
        unsigned* bar = b.bar;
        __builtin_amdgcn_s_waitcnt(0);
        unsigned nloc = b.st[0], nx = b.st[1];
        if (nloc == 0u) { xcd_barrier_complete(bar, b.x, nloc, nx); b.st[0] = nloc; b.st[1] = nx; }
        const unsigned old = xb_add(&bar[XB_XSUB(b.x)], 1u);
        const unsigned gen = old / nloc;
        if (old + 1u == (gen + 1u) * nloc) {
            __builtin_amdgcn_fence(__ATOMIC_RELEASE, "agent");
            asm volatile("s_waitcnt vmcnt(0)" ::: "memory");
            const unsigned og = xb_add(&bar[XB_TOP], 1u);
            const unsigned tg = og / nx;
            if (og + 1u == (tg + 1u) * nx) xb_add(&bar[XB_TOPGEN], 1u);
            else XB_SPIN(xb_ld(&bar[XB_TOPGEN]) == tg, bar);
            __builtin_amdgcn_fence(__ATOMIC_ACQUIRE, "agent");
            xb_add(&bar[XB_XGEN(b.x)], 1u);
            asm volatile("s_waitcnt vmcnt(0)" ::: "memory");
        } else {
            XB_SPIN(xb_ld(&bar[XB_XGEN(b.x)]) == gen, bar);
            __builtin_amdgcn_fence(__ATOMIC_ACQUIRE, "agent");
            asm volatile("s_waitcnt vmcnt(0)" ::: "memory");
        }
    }
    __syncthreads();
}

enum { I_XP = 0, I_XS, I_CK, I_CV, I_SPOOL, I_SDNC, I_SDNS, I_SSSC, I_SSSH, I_PT, I_NMPRE, I_NMPOST, I_NLPRE, I_NLPOST, I_WIN, I_POOLW, I_POOLSC, I_DNCW, I_DNALOG, I_DNDTB, I_DNNW, I_SBBIAS,
       I_SSCW, I_SSCB, I_SSALOG, I_SSDTB, I_SSD, I_SSNW, I_WBR, I_WOUT, I_WUP, I_WDN, N_IN };
struct Args { const void* in[N_IN]; float* out; unsigned char* ws; int ph_lo, ph_hi, li, pad; };
#define IN_F(i) ((const float*)A->in[i])
#define WSP(T, off) ((T*)(A->ws + (off)))
typedef const __attribute__((opencl_constant)) Args* CA;
__device__ __forceinline__ CA args_opaque() { auto p = __builtin_amdgcn_kernarg_segment_ptr(); asm volatile("" : "+s"(p)); return (CA)p; }

struct EpiIn {
    static constexpr bool PERM = true, AFTER_DRAIN = false, KEEP_ACC = false;
    float* UF; bf16* QKV; bf16* GATE; float *kp, *vp, *ks, *vs; float qscale;
    __device__ __forceinline__ void operator()(f32x4 (&acc)[2][2][4][2], const pg8::Unit& u, int wr, int wc, int fr, int fq) const {
        const int pn = u.pn, row0 = u.pm * 256 + wr * 64 + fr, cl = wc * 32 + 8 * fq;
        if (pn < 10 || (pn >= 16 && pn < 26) || pn == 58) {
            const int col0 = pn * 256 + (pn < 10 ? 0 : (pn < 26 ? -1536 : -9728)) + cl;
#pragma unroll
            for (int ai = 0; ai < 2; ++ai)
#pragma unroll
                for (int m = 0; m < 4; ++m) { float* rowp = UF + (size_t)(row0 + ai * 128 + m * 16) * UFW + col0;
#pragma unroll
                    for (int bj = 0; bj < 2; ++bj) { *(f32x4*)(rowp + bj * 128) = acc[ai][bj][m][0]; *(f32x4*)(rowp + bj * 128 + 4) = acc[ai][bj][m][1]; } }
        } else if (pn < 16) {
            const int which = (pn - 10) >> 1, c512 = ((pn - 10) & 1) * 256 + cl; const float sc = which == 0 ? qscale : 1.f;
#pragma unroll
            for (int ai = 0; ai < 2; ++ai)
#pragma unroll
                for (int m = 0; m < 4; ++m) { const int r = row0 + ai * 128 + m * 16; bf16* rowp = QKV + (size_t)r * 1536 + which * 512 + c512;
                    float* fo = nullptr;
                    if (which) { if (r < TP) fo = (which == 1 ? kp : vp) + (size_t)r * 512 + c512; else if (r < TT) fo = (which == 1 ? ks : vs) + (size_t)(r - TP) * 512 + c512; }
#pragma unroll
                    for (int bj = 0; bj < 2; ++bj) { const f32x4 v0 = acc[ai][bj][m][0], v1 = acc[ai][bj][m][1];
                        v4u w; w.x = pk2(v0[0] * sc, v0[1] * sc); w.y = pk2(v0[2] * sc, v0[3] * sc); w.z = pk2(v1[0] * sc, v1[1] * sc); w.w = pk2(v1[2] * sc, v1[3] * sc);
                        *(v4u*)(rowp + bj * 128) = w;
                        if (fo) { *(f32x4*)(fo + bj * 128) = v0; *(f32x4*)(fo + bj * 128 + 4) = v1; } } }
        } else {
            const int oc = (pn - 26) * 64 + wc * 16 + 4 * fq;
#pragma unroll
            for (int ai = 0; ai < 2; ++ai)
#pragma unroll
                for (int m = 0; m < 4; ++m) { const int r = row0 + ai * 128 + m * 16; bf16* rowp = GATE + (size_t)r * 8192 + oc;
                    f32x4 t[4];
#pragma unroll
                    for (int i = 0; i < 4; ++i)
#pragma unroll
                        for (int e = 0; e < 4; ++e) t[i][e] = 1.0f + fexp(-fminf(fmaxf(acc[ai][i >> 1][m][i & 1][e], -30.f), 30.f));
                    f32x4 o[4];
                    if (r < TP) {
#pragma unroll
                        for (int e = 0; e < 4; ++e) { const float i0 = __builtin_amdgcn_rcpf(t[0][e]), i1 = __builtin_amdgcn_rcpf(t[1][e]), i2 = __builtin_amdgcn_rcpf(t[2][e]), i3 = __builtin_amdgcn_rcpf(t[3][e]);
                            o[0][e] = t[1][e] * i0; o[1][e] = t[2][e] * i1; o[2][e] = t[3][e] * i2; o[3][e] = i3; }
                    } else {
#pragma unroll
                        for (int i = 0; i < 4; ++i)
#pragma unroll
                            for (int e = 0; e < 4; ++e) o[i][e] = __builtin_amdgcn_rcpf(t[i][e]);
                    }
#pragma unroll
                    for (int i = 0; i < 4; ++i) { v2u w; w.x = pk2(o[i][0], o[i][1]); w.y = pk2(o[i][2], o[i][3]); *(v2u*)(rowp + i * 2048) = w; } }
        }
    }
};
struct EpiMergeR {
    static constexpr bool PERM = true, AFTER_DRAIN = false, KEEP_ACC = true;
    const bf16* GATE; const float* RS; bf16* MGB;
    __device__ __forceinline__ void operator()(f32x4 (&acc)[2][2][4][2], const pg8::Unit& u, int wr, int wc, int fr, int fq) const {
        const unsigned row0 = (unsigned)(u.pm * 256 + wr * 64 + fr), col0 = (unsigned)(u.pn * 256 + wc * 32 + 8 * fq); const int seg = u.seg;
        const unsigned gofs = row0 * 8192u + (seg < 3 ? seg : 3) * 2048u + col0, oofs = row0 * 2048u + col0; const bool last = seg == 4;
        const float w2 = seg == 2 ? 1.f : 0.f, w3 = seg == 3 ? 1.f : 0.f, w4 = last ? 1.f : 0.f, w0 = 1.f - w2 - w3 - w4, ug = 1.f - w3;
#pragma unroll
        for (int ai = 0; ai < 2; ++ai)
#pragma unroll
            for (int m = 0; m < 4; ++m) { const unsigned rr = ai * 128 + m * 16; const f32x2 qq = *(const f32x2*)(RS + (row0 + rr) * 2u);
                const float r1 = __builtin_amdgcn_rsqf(qq[1]), rf = w0 + w2 * __builtin_amdgcn_sqrtf(qq[0]) + w3 * (__builtin_amdgcn_sqrtf(qq[1]) * __builtin_amdgcn_rsqf(qq[0])) + w4 * r1, rg = rf * ug, rc = rf * w3;
#pragma unroll
                for (int bj = 0; bj < 2; ++bj) { const v4u gg = *(const v4u*)(GATE + (gofs + rr * 8192u + bj * 128u));
                    f32x4& v0 = acc[ai][bj][m][0]; f32x4& v1 = acc[ai][bj][m][1];
                    v0[0] *= bflo(gg.x) * rg + rc; v0[1] *= bfhi(gg.x) * rg + rc; v0[2] *= bflo(gg.y) * rg + rc; v0[3] *= bfhi(gg.y) * rg + rc;
                    v1[0] *= bflo(gg.z) * rg + rc; v1[1] *= bfhi(gg.z) * rg + rc; v1[2] *= bflo(gg.w) * rg + rc; v1[3] *= bfhi(gg.w) * rg + rc;
                    if (last) { v4u w; w.x = pk2(v0[0], v0[1]); w.y = pk2(v0[2], v0[3]); w.z = pk2(v1[0], v1[1]); w.w = pk2(v1[2], v1[3]); *(v4u*)(MGB + (oofs + rr * 2048u + bj * 128u)) = w; } }
                asm volatile("" ::: "memory"); }
    }
};
struct EpiF32 {
    static constexpr bool PERM = true, AFTER_DRAIN = false, KEEP_ACC = false;
    float* C; int ldc;
    __device__ __forceinline__ void operator()(f32x4 (&acc)[2][2][4][2], const pg8::Unit& u, int wr, int wc, int fr, int fq) const {
        const int row0 = u.pm * 256 + wr * 64 + fr, col0 = u.pn * 256 + wc * 32 + 8 * fq;
#pragma unroll
        for (int ai = 0; ai < 2; ++ai)
#pragma unroll
            for (int m = 0; m < 4; ++m) { float* rowp = C + (size_t)(row0 + ai * 128 + m * 16) * ldc + col0;
#pragma unroll
                for (int bj = 0; bj < 2; ++bj) { *(f32x4*)(rowp + bj * 128) = acc[ai][bj][m][0]; *(f32x4*)(rowp + bj * 128 + 4) = acc[ai][bj][m][1]; } }
    }
};
struct EpiRelu2 {
    static constexpr bool PERM = true, AFTER_DRAIN = false, KEEP_ACC = false;
    bf16* O; int ldc;
    __device__ __forceinline__ void operator()(f32x4 (&acc)[2][2][4][2], const pg8::Unit& u, int wr, int wc, int fr, int fq) const {
        const int row0 = u.pm * 256 + wr * 64 + fr, col0 = u.pn * 256 + wc * 32 + 8 * fq;
#pragma unroll
        for (int ai = 0; ai < 2; ++ai)
#pragma unroll
            for (int m = 0; m < 4; ++m) { bf16* rowp = O + (size_t)(row0 + ai * 128 + m * 16) * ldc + col0;
#pragma unroll
                for (int bj = 0; bj < 2; ++bj) { f32x4 v0 = acc[ai][bj][m][0], v1 = acc[ai][bj][m][1];
#pragma unroll
                    for (int e = 0; e < 4; ++e) { const float a = fmaxf(v0[e], 0.f), b = fmaxf(v1[e], 0.f); v0[e] = a * a; v1[e] = b * b; }
                    v4u w; w.x = pk2(v0[0], v0[1]); w.y = pk2(v0[2], v0[3]); w.z = pk2(v1[0], v1[1]); w.w = pk2(v1[2], v1[3]); *(v4u*)(rowp + bj * 128) = w; } }
    }
};

__device__ __forceinline__ int win_src_col(int n) {
    if (n < 2560) return n;
    if (n < 6656) return n + 8;
    if (n < 14848) { const int t = n - 6656, pg = t >> 8, c = t & 255;
        return 6680 + (2 * (c >> 7) + ((c >> 2) & 1)) * 2048 + 64 * pg + 16 * ((c >> 5) & 3) + 4 * ((c >> 3) & 3) + (c & 3); }
    if (n < 14856) return n - 14848 + 2560;
    if (n < 14872) return n - 14856 + 6664;
    return -1;
}
template <int MODE>
__device__ __forceinline__ void transpose_item(const float* W, int ldw, int K, bf16* WT, int n0, int k0, const float* kscale, LAS unsigned* scr, int lane) {
    const int n = n0 + lane; const int sc = MODE ? win_src_col(n) : n;
#pragma unroll 8
    for (int i = 0; i < 32; ++i) { float a = 0.f, b = 0.f;
        if (sc >= 0) { a = W[(size_t)(k0 + 2 * i) * ldw + sc]; b = W[(size_t)(k0 + 2 * i + 1) * ldw + sc]; }
        if (kscale) { a *= kscale[k0 + 2 * i]; b *= kscale[k0 + 2 * i + 1]; }
        scr[i * 65 + lane] = pk2(a, b); }
    asm volatile("s_waitcnt lgkmcnt(0)" ::: "memory");
    const int part = lane & 3;
#pragma unroll
    for (int j = 0; j < 4; ++j) { const int nn = (lane >> 2) + 16 * j; const LAS unsigned* s = scr + (8 * part) * 65 + nn;
        v4u o0, o1; o0.x = s[0]; o0.y = s[65]; o0.z = s[130]; o0.w = s[195]; o1.x = s[260]; o1.y = s[325]; o1.z = s[390]; o1.w = s[455];
        v4u* dst = (v4u*)(WT + (size_t)(n0 + nn) * K + k0 + 16 * part); dst[0] = o0; dst[1] = o1; }
    asm volatile("s_waitcnt lgkmcnt(0)" ::: "memory");
}
__device__ __forceinline__ void p0_prologue(CA A, LAS unsigned char* lds, const int wv) {
    const int tid = tid_opaque(wv), lane = tid & 63, wave = tid >> 6, G = gridDim.x;
    LAS unsigned* scr = (LAS unsigned*)(lds + wave * 8320);
    const int gw = blk_opaque() * NWAVES + wave, NGW = G * NWAVES;
    constexpr int I_IN = (NIN / 64) * (DM / 64), I_BR = (DM / 64) * (512 / 64), I_OUT = (DM / 64) * (DM / 64), I_UP = (DFF / 64) * (DM / 64), I_DN = (DM / 64) * (DFF / 64);
    constexpr int PER_LAYER = I_IN + 4 * I_BR + I_OUT + I_UP + I_DN;
    for (int it = gw; it < 2 * PER_LAYER; it += NGW) {
        const int L = it / PER_LAYER; int r = it % PER_LAYER;
        if (r < I_IN) { const int nb = r % (NIN / 64), kb = r / (NIN / 64);
            transpose_item<1>(IN_F(I_WIN) + (size_t)L * DM * INCOLS, INCOLS, DM, WSP(bf16, WS_WIN) + (size_t)L * NIN * DM, nb * 64, kb * 64, nullptr, scr, lane); continue; }
        r -= I_IN;
        if (r < 4 * I_BR) { const int s = 1 + r / I_BR, q = r % I_BR, nb = q % (DM / 64), kb = q / (DM / 64);
            transpose_item<0>(IN_F(I_WBR) + ((size_t)L * 2560 + 512 * s) * DM, DM, OBW, WSP(bf16, WS_WBR) + (size_t)L * DM * OBW + 512 * s, nb * 64, kb * 64,
                              s >= 3 ? IN_F(I_SSNW) + L * 1024 + (s - 3) * 512 : nullptr, scr, lane); continue; }
        r -= 4 * I_BR;
        if (r < I_OUT) { const int nb = r % (DM / 64), kb = r / (DM / 64);
            transpose_item<0>(IN_F(I_WOUT) + (size_t)L * DM * DM, DM, DM, WSP(bf16, WS_WOUT) + (size_t)L * DM * DM, nb * 64, kb * 64, nullptr, scr, lane); continue; }
        r -= I_OUT;
        if (r < I_UP) { const int nb = r % (DFF / 64), kb = r / (DFF / 64);
            transpose_item<0>(IN_F(I_WUP) + (size_t)L * DM * DFF, DFF, DM, WSP(bf16, WS_WUP) + (size_t)L * DFF * DM, nb * 64, kb * 64, nullptr, scr, lane); continue; }
        r -= I_UP;
        { const int nb = r % (DM / 64), kb = r / (DM / 64);
            transpose_item<0>(IN_F(I_WDN) + (size_t)L * DFF * DM, DM, DFF, WSP(bf16, WS_WDN) + (size_t)L * DM * DFF, nb * 64, kb * 64, nullptr, scr, lane); }
    }
    for (int idx = blk_opaque() * NTHR + tid; idx < 2 * DM * 64; idx += G * NTHR) {
        const int L = idx / (DM * 64), q = idx % (DM * 64), n = q & (DM - 1), kc = q >> 11, k0 = kc * 8, g = k0 >> 7, c0 = k0 & 127;
        const float* pw = IN_F(I_POOLW) + ((size_t)(L * 4 + g) * 128 + c0) * 128; const float* psc = IN_F(I_POOLSC) + L * 512 + g * 128;
        const float* wb = IN_F(I_WBR) + ((size_t)L * 2560 + g * 128) * DM + n;
        float acc[8] = {0.f, 0.f, 0.f, 0.f, 0.f, 0.f, 0.f, 0.f};
        for (int d = 0; d < 128; ++d) { const float wv = wb[(size_t)d * DM] * psc[d];
#pragma unroll
            for (int i = 0; i < 8; ++i) acc[i] += pw[i * 128 + d] * wv; }
        v4u o; o.x = pk2(acc[0], acc[1]); o.y = pk2(acc[2], acc[3]); o.z = pk2(acc[4], acc[5]); o.w = pk2(acc[6], acc[7]);
        *(v4u*)(WSP(bf16, WS_WBR) + (size_t)L * DM * OBW + (size_t)n * OBW + k0) = o;
    }
}

__device__ __forceinline__ const float* xin_row(CA A, int m) { return m < TP ? IN_F(I_XP) + (size_t)m * DM : IN_F(I_XS) + (size_t)(m - TP) * DM; }
__device__ __forceinline__ void store_bf16_row(bf16* orow, const f32x4 (&v)[8], float rstd, const float* g, int lane) {
#pragma unroll
    for (int j = 0; j < 8; ++j) { const f32x4 gj = ((const f32x4*)g)[lane + 64 * j]; const f32x4 o = v[j] * rstd * gj;
        v2u w; w.x = pk2(o[0], o[1]); w.y = pk2(o[2], o[3]); ((v2u*)orow)[lane + 64 * j] = w; }
}
__device__ __forceinline__ void norm1_phase(CA A, const int wv) {
    const int tid = tid_opaque(wv), lane = tid & 63, gw = blk_opaque() * NWAVES + (tid >> 6), NGW = gridDim.x * NWAVES;
    bf16* H = WSP(bf16, WS_H);
    for (int m = gw; m < MP; m += NGW) {
        if (m >= TT) { for (int j = 0; j < 8; ++j) ((v2u*)(H + (size_t)m * DM))[lane + 64 * j] = (v2u){0u, 0u}; continue; }
        const f32x4* xr = (const f32x4*)xin_row(A, m); f32x4 v[8]; float s = 0.f;
#pragma unroll
        for (int j = 0; j < 8; ++j) { v[j] = xr[lane + 64 * j]; s += (v[j][0] * v[j][0] + v[j][1] * v[j][1]) + (v[j][2] * v[j][2] + v[j][3] * v[j][3]); }
        const float rstd = 1.0f / sqrtf(wave_sum(s) * (1.0f / DM) + RMS_EPS);
        store_bf16_row(H + (size_t)m * DM, v, rstd, IN_F(I_NMPRE), lane);
    }
}
__device__ __forceinline__ void resid_phase(CA A, const float* Y, const float* PS, const float* gpost, const float* gnext, bool from_input, const int wv) {
    const int tid = tid_opaque(wv), lane = tid & 63, gw = blk_opaque() * NWAVES + (tid >> 6), NGW = gridDim.x * NWAVES;
    bf16* H = WSP(bf16, WS_H);
    for (int m = gw; m < TT; m += NGW) {
        const f32x4* yr = (const f32x4*)(Y + (size_t)m * DM); const f32x4* xr = from_input ? (const f32x4*)xin_row(A, m) : (const f32x4*)(A->out + O_Y + (size_t)m * DM);
        f32x4 v[8]; float s = 0.f;
        if (m < TP) {
#pragma unroll
            for (int j = 0; j < 8; ++j) v[j] = yr[lane + 64 * j];
        } else {
#pragma unroll
            for (int j = 0; j < 8; ++j) v[j] = (f32x4){0.f, 0.f, 0.f, 0.f};
            for (int sp = 0; sp < 16; ++sp) { const f32x4* pr = (const f32x4*)(PS + ((size_t)sp * TS + (m - TP)) * DM);
#pragma unroll
                for (int j = 0; j < 8; ++j) v[j] += pr[lane + 64 * j]; }
        }
#pragma unroll
        for (int j = 0; j < 8; ++j) s += (v[j][0] * v[j][0] + v[j][1] * v[j][1]) + (v[j][2] * v[j][2] + v[j][3] * v[j][3]);
        const float rstd = 1.0f / sqrtf(wave_sum(s) * (1.0f / DM) + RMS_EPS); float s2 = 0.f;
        f32x4* orow = (f32x4*)(A->out + O_Y + (size_t)m * DM);
#pragma unroll
        for (int j = 0; j < 8; ++j) { const f32x4 gj = ((const f32x4*)gpost)[lane + 64 * j]; v[j] = xr[lane + 64 * j] + v[j] * rstd * gj; orow[lane + 64 * j] = v[j];
            s2 += (v[j][0] * v[j][0] + v[j][1] * v[j][1]) + (v[j][2] * v[j][2] + v[j][3] * v[j][3]); }
        if (gnext) { const float rstd2 = 1.0f / sqrtf(wave_sum(s2) * (1.0f / DM) + RMS_EPS); store_bf16_row(H + (size_t)m * DM, v, rstd2, gnext, lane); }
    }
}

__device__ __forceinline__ float conv_tap(const float* UF, const float* state, int row, int j, int ucol, int c) {
    if (row < TP) { const int t = row & (SEQ - 1); return (t - 3 + j) >= 0 ? UF[(size_t)(row - 3 + j) * UFW + ucol + c] : 0.f; }
    const int s = row - TP, sb = s >> 2, e = (s & 3) + j;
    return e < 3 ? state[(size_t)(sb * 3 + e) * 1536 + c] : UF[(size_t)(TP + sb * 4 + e - 3) * UFW + ucol + c];
}
__device__ __forceinline__ void prep_phase(CA A, int layer, const int wv) {
    const int tid = tid_opaque(wv), lane = tid & 63, G = gridDim.x, gt = blk_opaque() * NTHR + tid, NGT = G * NTHR, gw = blk_opaque() * NWAVES + (tid >> 6), NGW = G * NWAVES;
    const float* UF = WSP(float, WS_UF); float* SC = WSP(float, WS_SCAL);
    for (int idx = gt; idx < TT * 24; idx += NGT) { const int row = idx / 24, j = idx % 24; const float u = UF[(size_t)row * UFW + UF_SMALL + j]; float r;
        if (j < 4) r = sigmoidf_(u);
        else if (j < 8) r = -fexp(IN_F(I_DNALOG)[layer * 4 + j - 4]) * softplusf_(u + IN_F(I_DNDTB)[layer * 4 + j - 4]);
        else r = softplusf_(u + IN_F(I_SSDTB)[layer * 16 + j - 8]);
        SC[(size_t)row * 32 + j] = r; }
    { bf16* O0 = WSP(bf16, WS_OBR); const float* spool = IN_F(I_SPOOL) + (size_t)layer * DBATCH * 15 * 512;
      for (int it = gw; it < (TP / 64 + DBATCH) * 4; it += NGW) { const int gi = it & 3, sc = it >> 2, w = 2 << gi, ch = gi * 128 + lane;
          if (sc < TP / 64) { const int row0 = sc * 64, t0 = row0 & (SEQ - 1); float s0 = 0.f, s1 = 0.f;
              for (int j = 1; j < w; ++j) if (t0 - j >= 0) { s0 += UF[(size_t)(row0 - j) * UFW + ch]; s1 += UF[(size_t)(row0 - j) * UFW + ch + 64]; }
#pragma unroll 8
              for (int i = 0; i < 64; ++i) { const int row = row0 + i, t = t0 + i; const float u0 = UF[(size_t)row * UFW + ch], u1 = UF[(size_t)row * UFW + ch + 64];
                  s0 += u0; s1 += u1; const float inv = 1.0f / (float)((t + 1) < w ? (t + 1) : w);
                  O0[(size_t)row * OBW + ch] = (bf16)f2bf(s0 * inv - u0); O0[(size_t)row * OBW + ch + 64] = (bf16)f2bf(s1 * inv - u1);
                  if (t - w + 1 >= 0) { s0 -= UF[(size_t)(row - w + 1) * UFW + ch]; s1 -= UF[(size_t)(row - w + 1) * UFW + ch + 64]; } } }
          else { const int sb = sc - TP / 64; const float inv = 1.0f / (float)w;
              for (int i = 0; i < DSEQ; ++i) { const int row = TP + sb * 4 + i, e = 15 + i; float s0 = 0.f, s1 = 0.f;
                  for (int j = 0; j < w; ++j) { const int ee = e - j; const float* src = ee < 15 ? spool + (size_t)(sb * 15 + ee) * 512 + ch : UF + (size_t)(TP + sb * 4 + ee - 15) * UFW + ch; s0 += src[0]; s1 += src[64]; }
                  O0[(size_t)row * OBW + ch] = (bf16)f2bf(s0 * inv - UF[(size_t)row * UFW + ch]); O0[(size_t)row * OBW + ch + 64] = (bf16)f2bf(s1 * inv - UF[(size_t)row * UFW + ch + 64]); } } } }
    for (int it0 = gw; it0 < DBATCH * 24; it0 += NGW) { const int it = it0 + (TP / 64) * 24; const int grp = it % 12, strm = (it / 12) & 1, sc = it / 24, c0 = grp * 128 + lane;
        const int ucol = strm ? UF_XBC : UF_DNQKV; float* OUTB = strm ? WSP(float, WS_XBC) : WSP(float, WS_DNQ);
        const float* cw = (strm ? IN_F(I_SSCW) : IN_F(I_DNCW)) + (size_t)layer * 4 * 1536; const float* st = (strm ? IN_F(I_SSSC) : IN_F(I_SDNC)) + (size_t)layer * DBATCH * 3 * 1536;
        const float wa0 = cw[c0], wa1 = cw[1536 + c0], wa2 = cw[3072 + c0], wa3 = cw[4608 + c0], wb0 = cw[c0 + 64], wb1 = cw[1536 + c0 + 64], wb2 = cw[3072 + c0 + 64], wb3 = cw[4608 + c0 + 64];
        const float ba = strm ? IN_F(I_SSCB)[layer * 1536 + c0] : 0.f, bb = strm ? IN_F(I_SSCB)[layer * 1536 + c0 + 64] : 0.f;
        const bool nrm = (strm == 0) && grp < 8; const float qs = grp < 4 ? 0.08838834764831845f : 1.0f;
        float ha0, ha1, ha2, hb0, hb1, hb2; int row0, n;
        if (sc < TP / 64) { row0 = sc * 64; n = 64; const int t0 = row0 & (SEQ - 1);
            if (t0 == 0) { ha0 = ha1 = ha2 = hb0 = hb1 = hb2 = 0.f; }
            else { const float* p = UF + (size_t)(row0 - 3) * UFW + ucol + c0; ha0 = p[0]; hb0 = p[64]; ha1 = p[UFW]; hb1 = p[UFW + 64]; ha2 = p[2 * UFW]; hb2 = p[2 * UFW + 64]; } }
        else { const int sb = sc - TP / 64; row0 = TP + sb * 4; n = DSEQ; const float* p = st + (size_t)(sb * 3) * 1536 + c0; ha0 = p[0]; hb0 = p[64]; ha1 = p[1536]; hb1 = p[1536 + 64]; ha2 = p[3072]; hb2 = p[3072 + 64]; }
#pragma unroll 8
        for (int i = 0; i < n; ++i) { const float* p = UF + (size_t)(row0 + i) * UFW + ucol + c0; const float ua = p[0], ub = p[64];
            float a = siluf_(ba + wa0 * ha0 + wa1 * ha1 + wa2 * ha2 + wa3 * ua), b = siluf_(bb + wb0 * hb0 + wb1 * hb1 + wb2 * hb2 + wb3 * ub);
            ha0 = ha1; ha1 = ha2; ha2 = ua; hb0 = hb1; hb1 = hb2; hb2 = ub;
            if (nrm) { const float rs = row16_sum(a * a + b * b);
                const float tot = (__builtin_bit_cast(float, __builtin_amdgcn_readlane(__builtin_bit_cast(int, rs), 0)) + __builtin_bit_cast(float, __builtin_amdgcn_readlane(__builtin_bit_cast(int, rs), 16)))
                                + (__builtin_bit_cast(float, __builtin_amdgcn_readlane(__builtin_bit_cast(int, rs), 32)) + __builtin_bit_cast(float, __builtin_amdgcn_readlane(__builtin_bit_cast(int, rs), 48)));
                const float sc2 = qs / sqrtf(tot + 1e-6f); a *= sc2; b *= sc2; }
            float* o = OUTB + (size_t)(row0 + i) * 1536 + c0; o[0] = a; o[64] = b; } }
    for (int idx = gt; idx < NBATCH * 3 * 1536; idx += NGT) { const int b = idx / (3 * 1536), q = idx % (3 * 1536), j = q / 1536, c = q % 1536; const size_t src = (size_t)(b * SEQ + SEQ - 3 + j) * UFW;
        A->out[O_DNCP + (size_t)layer * NBATCH * 3 * 1536 + idx] = UF[src + UF_DNQKV + c]; A->out[O_SSCP + (size_t)layer * NBATCH * 3 * 1536 + idx] = UF[src + UF_XBC + c]; }
    for (int idx = gt; idx < DBATCH * 3 * 1536; idx += NGT) { const int sb = idx / (3 * 1536), q = idx % (3 * 1536), j = q / 1536, c = q % 1536; const size_t src = (size_t)(TP + sb * 4 + 1 + j) * UFW;
        A->out[O_DNCS + (size_t)layer * DBATCH * 3 * 1536 + idx] = UF[src + UF_DNQKV + c]; A->out[O_SSCS + (size_t)layer * DBATCH * 3 * 1536 + idx] = UF[src + UF_XBC + c]; }
    for (int idx = gt; idx < NBATCH * 15 * 512; idx += NGT) { const int b = idx / (15 * 512), q = idx % (15 * 512), j = q >> 9, ch = q & 511;
        A->out[O_POOLP + (size_t)layer * NBATCH * 15 * 512 + idx] = UF[(size_t)(b * SEQ + SEQ - 15 + j) * UFW + ch]; }
    { const float* spool = IN_F(I_SPOOL) + (size_t)layer * DBATCH * 15 * 512;
      for (int idx = gt; idx < DBATCH * 15 * 512; idx += NGT) { const int sb = idx / (15 * 512), q = idx % (15 * 512), j = q >> 9, ch = q & 511, e = 4 + j;
          A->out[O_POOLS + (size_t)layer * DBATCH * 15 * 512 + idx] = e < 15 ? spool[(size_t)(sb * 15 + e) * 512 + ch] : UF[(size_t)(TP + sb * 4 + e - 15) * UFW + ch]; } }
}

__device__ __forceinline__ void dn_seq(CA A, LAS unsigned char* lds, int layer, int unit, const int wv) {
    const int tid = tid_opaque(wv), lane = tid & 63, wid = tid >> 6, v = tid & 127, kq = tid >> 7;
    int row0, L, h; const float* s0 = nullptr; float* sout;
    if (unit < 16) { const int b = unit >> 2; h = unit & 3; row0 = b * SEQ; L = SEQ; sout = A->out + O_DNSP + ((size_t)(layer * NBATCH + b) * 4 + h) * 16384; }
    else { const int u = unit - 16, sb = u >> 2; h = u & 3; row0 = TP + sb * 4; L = DSEQ; s0 = IN_F(I_SDNS) + ((size_t)(layer * DBATCH + sb) * 4 + h) * 16384; sout = A->out + O_DNSS + ((size_t)(layer * DBATCH + sb) * 4 + h) * 16384; }
    constexpr int CH = 32;
    LAS float* qs = (LAS float*)lds; LAS float* ks = qs + CH * 128; LAS float* vs = ks + CH * 128; LAS float* ob = vs + CH * 128;
    LAS float* red = ob + CH * 128;
    LAS float* egs = red + 2 * 2 * 4 * 128; LAS float* bts = egs + CH; LAS float* kqd = bts + CH;
    const float* DNQ = WSP(float, WS_DNQ); const float* SC = WSP(float, WS_SCAL); const float* UF = WSP(float, WS_UF); bf16* O1 = WSP(bf16, WS_OBR) + 512;
    const float* nw = IN_F(I_DNNW) + layer * 128;
    float S[32];
#pragma unroll
    for (int i = 0; i < 32; ++i) S[i] = s0 ? s0[(size_t)(32 * kq + i) * 128 + v] : 0.f;
    for (int c0 = 0; c0 < L; c0 += CH) {
        const int n = (L - c0) < CH ? (L - c0) : CH;
        __syncthreads();
        for (int idx = tid; idx < n * 128; idx += NTHR) { const int t = idx >> 7, c = idx & 127; const float* src = DNQ + (size_t)(row0 + c0 + t) * 1536 + h * 128 + c;
            qs[idx] = src[0]; ks[idx] = src[512]; vs[idx] = src[1024]; }
        if (tid < n) { const float* sc = SC + (size_t)(row0 + c0 + tid) * 32; bts[tid] = sc[h]; egs[tid] = fexp(sc[4 + h]); }
        __syncthreads();
        for (int t = wid; t < n; t += NWAVES) { const float s = wave_sum(ks[t * 128 + lane] * qs[t * 128 + lane] + ks[t * 128 + 64 + lane] * qs[t * 128 + 64 + lane]); if (lane == 0) kqd[t] = s; }
        __syncthreads();
        for (int t = 0; t < n; ++t) {
            const float eg = egs[t], bt = bts[t]; float kk[32]; float r = 0.f, pp = 0.f;
#pragma unroll
            for (int i4 = 0; i4 < 8; ++i4) { const f32x4 k4 = *(const LAS f32x4*)(ks + t * 128 + 32 * kq + 4 * i4), q4 = *(const LAS f32x4*)(qs + t * 128 + 32 * kq + 4 * i4);
#pragma unroll
                for (int e = 0; e < 4; ++e) { const int i = 4 * i4 + e; S[i] *= eg; kk[i] = k4[e]; r += S[i] * k4[e]; pp += S[i] * q4[e]; } }
            LAS float* rd = red + (t & 1) * 1024;
            rd[kq * 128 + v] = r; rd[512 + kq * 128 + v] = pp;
            __syncthreads();
            const float rt = (rd[v] + rd[128 + v]) + (rd[256 + v] + rd[384 + v]), pt = (rd[512 + v] + rd[640 + v]) + (rd[768 + v] + rd[896 + v]);
            const float dd = bt * (vs[t * 128 + v] - rt);
#pragma unroll
            for (int i = 0; i < 32; ++i) S[i] += kk[i] * dd;
            if (kq == 0) ob[t * 128 + v] = pt + kqd[t] * dd;
        }
        __syncthreads();
        for (int t = wid; t < n; t += NWAVES) { const int row = row0 + c0 + t; const float o0 = ob[t * 128 + lane], o1 = ob[t * 128 + 64 + lane];
            const float rstd = 1.0f / sqrtf(wave_sum(o0 * o0 + o1 * o1) * (1.0f / 128.0f) + RMS_EPS);
            const float z0 = UF[(size_t)row * UFW + UF_DNZ + h * 128 + lane], z1 = UF[(size_t)row * UFW + UF_DNZ + h * 128 + 64 + lane];
            O1[(size_t)row * OBW + h * 128 + lane] = (bf16)f2bf(o0 * rstd * nw[lane] * siluf_(z0)); O1[(size_t)row * OBW + h * 128 + 64 + lane] = (bf16)f2bf(o1 * rstd * nw[64 + lane] * siluf_(z1)); }
    }
#pragma unroll
    for (int i = 0; i < 32; ++i) sout[(size_t)(32 * kq + i) * 128 + v] = S[i];
    __syncthreads();
}

__device__ __forceinline__ void ssd_seq(CA A, LAS unsigned char* lds, int layer, int unit, const int wv) {
    const int tid = tid_opaque(wv), lane = tid & 63, wid = tid >> 6, p = tid >> 3, nq = tid & 7;
    int row0, L, hd; const float* h0 = nullptr; float* hout;
    if (unit < 64) { const int b = unit >> 4; hd = unit & 15; row0 = b * SEQ; L = SEQ; hout = A->out + O_SSHP + ((size_t)(layer * NBATCH + b) * 16 + hd) * 8192; }
    else { const int u = unit - 64, sb = u >> 4; hd = u & 15; row0 = TP + sb * 4; L = DSEQ; h0 = IN_F(I_SSSH) + ((size_t)(layer * DBATCH + sb) * 16 + hd) * 8192; hout = A->out + O_SSHS + ((size_t)(layer * DBATCH + sb) * 16 + hd) * 8192; }
    const int g = hd >> 3; constexpr int CH = 64;
    LAS float* Bs = (LAS float*)lds; LAS float* Cs = Bs + CH * 128; LAS float* xs = Cs + CH * 128; LAS float* yb = xs + CH * 64; LAS float* dts = yb + CH * 64;
    const float* XBC = WSP(float, WS_XBC); const float* SC = WSP(float, WS_SCAL); const float* UF = WSP(float, WS_UF); float* SSQ = WSP(float, WS_SSQ);
    bf16* Og = WSP(bf16, WS_OBR) + (3 + g) * 512;
    const float a = -fexp(IN_F(I_SSALOG)[layer * 16 + hd]), Dk = IN_F(I_SSD)[layer * 16 + hd];
    float hs[16];
#pragma unroll
    for (int j = 0; j < 16; ++j) hs[j] = h0 ? h0[(size_t)p * 128 + 16 * nq + j] : 0.f;
    for (int c0 = 0; c0 < L; c0 += CH) {
        const int n = (L - c0) < CH ? (L - c0) : CH;
        __syncthreads();
        for (int idx = tid; idx < n * 128; idx += NTHR) { const int t = idx >> 7, c = idx & 127; const float* src = XBC + (size_t)(row0 + c0 + t) * 1536; Bs[idx] = src[1024 + g * 128 + c]; Cs[idx] = src[1280 + g * 128 + c]; }
        for (int idx = tid; idx < n * 64; idx += NTHR) { const int t = idx >> 6, c = idx & 63; xs[idx] = XBC[(size_t)(row0 + c0 + t) * 1536 + hd * 64 + c]; }
        if (tid < n) dts[tid] = SC[(size_t)(row0 + c0 + tid) * 32 + 8 + hd];
        __syncthreads();
        for (int t = 0; t < n; ++t) {
            const float dt = dts[t], dA = fexp(dt * a), xv = xs[t * 64 + p], cx = dt * xv; float y = 0.f;
#pragma unroll
            for (int j4 = 0; j4 < 4; ++j4) { const f32x4 b4 = *(const LAS f32x4*)(Bs + t * 128 + 16 * nq + 4 * j4), c4 = *(const LAS f32x4*)(Cs + t * 128 + 16 * nq + 4 * j4);
#pragma unroll
                for (int e = 0; e < 4; ++e) { const int j = 4 * j4 + e; hs[j] = hs[j] * dA + cx * b4[e]; y += hs[j] * c4[e]; } }
            y += __shfl_xor(y, 1); y += __shfl_xor(y, 2); y += __shfl_xor(y, 4);
            if (nq == 0) yb[t * 64 + p] = y + Dk * xv;
        }
        __syncthreads();
        for (int t = wid; t < n; t += NWAVES) { const int row = row0 + c0 + t; const float z = UF[(size_t)row * UFW + UF_SSZ + hd * 64 + lane]; const float yg = yb[t * 64 + lane] * siluf_(z);
            const float ss = wave_sum(yg * yg); if (lane == 0) { SSQ[(size_t)row * 32 + hd * 2] = ss; SSQ[(size_t)row * 32 + hd * 2 + 1] = 0.f; }
            Og[(size_t)row * OBW + (hd & 7) * 64 + lane] = (bf16)f2bf(yg); }
    }
#pragma unroll
    for (int j = 0; j < 16; ++j) hout[(size_t)p * 128 + 16 * nq + j] = hs[j];
    __syncthreads();
}

constexpr size_t DNU_NW = 0, DNU_QG = 16384, DNU_AT = 32768, DNU_KGT = 40960, DNU_UP = 57344, DNU_EG = 90112, DNU_BYTES = 90368;
__device__ __forceinline__ float dpp_swap1(float x) { return __builtin_bit_cast(float, __builtin_amdgcn_mov_dpp(__builtin_bit_cast(int, x), 0xB1, 0xf, 0xf, true)); }
__device__ __forceinline__ void dn_chunk_unit(CA A, LAS unsigned char* lds, int layer, int unit, const int wv) {
    const int tid = tid_opaque(wv), lane = tid & 63, wid = tid >> 6, q4 = lane >> 4, l15 = lane & 15;
    const int bh = unit >> 5, ck = unit & 31, b = bh >> 2, h = bh & 3, row0 = b * SEQ + ck * 64;
    constexpr int FP = 132;
    LAS float* kf = (LAS float*)lds; LAS float* vf = kf + 64 * FP;
    LAS unsigned char* qb = lds + 2 * 64 * FP * 4; LAS unsigned char* kb = qb + 64 * 272;
    LAS float* Lp = (LAS float*)(kb + 64 * 272);
    LAS float* gcs = Lp + 2 * 64 * 32; LAS float* bts = gcs + 64;
    const float* SC = WSP(float, WS_SCAL);
    unsigned char* rec = A->ws + WS_DNU + (size_t)unit * DNU_BYTES;
    __syncthreads();
    if (tid < 64) { const float* sc = SC + (size_t)(row0 + tid) * 32; bts[tid] = sc[h]; gcs[tid] = wave_scan(sc[4 + h], lane); }
    __syncthreads();
    const float glast = gcs[63];
    if (tid == 0) *(float*)(rec + DNU_EG) = fexp(glast);
    { const float* UF = WSP(float, WS_UF); const float* cw = IN_F(I_DNCW) + (size_t)layer * 4 * 1536;
#pragma unroll
      for (int it = 0; it < 4; ++it) { const int idx = tid + 512 * it, t = idx >> 5, d4 = (idx & 31) * 4, tq = ck * 64 + t; f32x4 val[3];
#pragma unroll
          for (int sIdx = 0; sIdx < 3; ++sIdx) { const int col = sIdx * 512 + h * 128 + d4; f32x4 a = {0.f, 0.f, 0.f, 0.f};
#pragma unroll
              for (int j = 0; j < 4; ++j) if (tq - 3 + j >= 0) a += *(const f32x4*)(UF + (size_t)(row0 + t - 3 + j) * UFW + UF_DNQKV + col) * *(const f32x4*)(cw + j * 1536 + col);
#pragma unroll
              for (int e = 0; e < 4; ++e) a[e] = siluf_(a[e]);
              if (sIdx < 2) { float ss = row16_sum((a[0] * a[0] + a[1] * a[1]) + (a[2] * a[2] + a[3] * a[3])); ss += __shfl_xor(ss, 16);
                  const float sc = (sIdx == 0 ? 0.08838834764831845f : 1.0f) * __builtin_amdgcn_rsqf(ss + 1e-6f); a = a * sc; }
              val[sIdx] = a; }
          const f32x4 qv = val[0], kv = val[1], vv = val[2];
          *(LAS f32x4*)(kf + t * FP + d4) = kv; *(LAS f32x4*)(vf + t * FP + d4) = vv;
          v2u w; w.x = pk2(qv[0], qv[1]); w.y = pk2(qv[2], qv[3]); *(LAS v2u*)(qb + t * 272 + d4 * 2) = w;
          w.x = pk2(kv[0], kv[1]); w.y = pk2(kv[2], kv[3]); *(LAS v2u*)(kb + t * 272 + d4 * 2) = w;
          const float eg = fexp(gcs[t]); w.x = pk2(qv[0] * eg, qv[1] * eg); w.y = pk2(qv[2] * eg, qv[3] * eg); *(v2u*)(rec + DNU_QG + (size_t)(t * 128 + d4) * 2) = w; } }
    __syncthreads();
    { const int c = lane, dg = wid; const float f = fexp(glast - gcs[c]); bf16* KGT = (bf16*)(rec + DNU_KGT);
#pragma unroll
      for (int i = 0; i < 16; ++i) { const int d = dg * 16 + i; KGT[d * 64 + c] = (bf16)f2bf(kf[c * FP + d] * f); } }
    { const int ct = wid >> 1; bf16* AT = (bf16*)(rec + DNU_AT);
#pragma unroll
      for (int e2 = 0; e2 < 2; ++e2) { const int et = 2 * (wid & 1) + e2; f32x4 aKK = {0.f, 0.f, 0.f, 0.f}, aQK = {0.f, 0.f, 0.f, 0.f};
#pragma unroll
          for (int ks = 0; ks < 4; ++ks) { const bf16x8 bfr = *(const LAS bf16x8*)(kb + (16 * et + l15) * 272 + (32 * ks + 8 * q4) * 2);
              const bf16x8 ak = *(const LAS bf16x8*)(kb + (16 * ct + l15) * 272 + (32 * ks + 8 * q4) * 2), aq = *(const LAS bf16x8*)(qb + (16 * ct + l15) * 272 + (32 * ks + 8 * q4) * 2);
              aKK = __builtin_amdgcn_mfma_f32_16x16x32_bf16(ak, bfr, aKK, 0, 0, 0); aQK = __builtin_amdgcn_mfma_f32_16x16x32_bf16(aq, bfr, aQK, 0, 0, 0); }
          const int e = 16 * et + l15; const float ge = gcs[e];
#pragma unroll
          for (int r = 0; r < 4; ++r) { const int c = 16 * ct + 4 * q4 + r; const float dec = e <= c ? fexp(gcs[c] - ge) : 0.f;
              Lp[((e & 1) * 64 + c) * 32 + (e >> 1)] = e < c ? bts[c] * aKK[r] * dec : 0.f;
              AT[c * 64 + e] = (bf16)f2bf(aQK[r] * dec); } } }
    __syncthreads();
    { const int j = tid >> 1, par = tid & 1; float x[32];
#pragma unroll
      for (int i = 0; i < 32; ++i) x[i] = 0.f;
      const LAS float* src = j < 128 ? vf + j : kf + (j - 128);
      float* UP = (float*)(rec + DNU_UP); bf16* NW = (bf16*)(rec + DNU_NW);
#pragma unroll
      for (int c = 0; c < 64; ++c) {
          constexpr int dummy = 0; (void)dummy;
          const int ni = (c + 1) >> 1; float a0 = 0.f, a1 = 0.f, a2 = 0.f, a3 = 0.f;
#pragma unroll
          for (int i4 = 0; i4 < (ni + 3) / 4; ++i4) { const f32x4 l4 = *(const LAS f32x4*)(Lp + (par * 64 + c) * 32 + 4 * i4);
              a0 += l4[0] * x[4 * i4]; if (4 * i4 + 1 < ni) a1 += l4[1] * x[4 * i4 + 1]; if (4 * i4 + 2 < ni) a2 += l4[2] * x[4 * i4 + 2]; if (4 * i4 + 3 < ni) a3 += l4[3] * x[4 * i4 + 3]; }
          float acc = (a0 + a1) + (a2 + a3); acc += dpp_swap1(acc);
          float rhs = src[c * FP] * bts[c]; if (j >= 128) rhs *= fexp(gcs[c]);
          const float xc = rhs - acc;
          x[c >> 1] = ((c & 1) == par) ? xc : x[c >> 1];
          if (par == 0) { if (j < 128) UP[(((j >> 4) * 4 + (c >> 4)) * 4 + (c & 3)) * 64 + ((c >> 2) & 3) * 16 + (j & 15)] = xc; else NW[c * 128 + (j - 128)] = (bf16)f2bf(-xc); }
      } }
}

constexpr int D2_NW = 0, D2_KGT = 17408, D2_BUF = 35840;
__device__ __forceinline__ bf16x8 ld_frag_perm(const LAS unsigned char* p) {
    const v2u lo = *(const LAS v2u*)p, hi = *(const LAS v2u*)(p + 32); v4u w; w.x = lo.x; w.y = lo.y; w.z = hi.x; w.w = hi.y; return __builtin_bit_cast(bf16x8, w);
}
__device__ __forceinline__ bf16x8 pack_b(const f32x4& t0, const f32x4& t1) { v4u w; w.x = pk2(t0[0], t0[1]); w.y = pk2(t0[2], t0[3]); w.z = pk2(t1[0], t1[1]); w.w = pk2(t1[2], t1[3]); return __builtin_bit_cast(bf16x8, w); }
__device__ __forceinline__ void dn_seq2(CA A, LAS unsigned char* lds, int layer, int bh, const int wv) {
    const int tid = tid_opaque(wv), lane = tid & 63, w = tid >> 6, q4 = lane >> 4, l15 = lane & 15;
    const int b = bh >> 2, h = bh & 3;
    const unsigned char* recs = A->ws + WS_DNU + (size_t)(bh * 32) * DNU_BYTES;
    v4u* sav = (v4u*)(A->ws + WS_DNSV + (size_t)(bh * 32) * 49152) + (size_t)w * 6 * 64 + lane;
    f32x4 S[8];
#pragma unroll
    for (int i = 0; i < 8; ++i) S[i] = (f32x4){0.f, 0.f, 0.f, 0.f};
    v4u st[4];
#define D2_LOAD(rec_) do { const v4u* g_ = (const v4u*)(rec_); st[0] = g_[tid]; st[1] = g_[tid + 512]; st[2] = g_[tid + 2560]; st[3] = g_[tid + 3072]; } while (0)
#define D2_STORE(buf_) do { LAS unsigned char* b_ = lds + (buf_) * D2_BUF; \
        *(LAS v4u*)(b_ + D2_NW + (tid >> 4) * 272 + (tid & 15) * 16) = st[0]; *(LAS v4u*)(b_ + D2_NW + (32 + (tid >> 4)) * 272 + (tid & 15) * 16) = st[1]; \
        *(LAS v4u*)(b_ + D2_KGT + (tid >> 3) * 144 + (tid & 7) * 16) = st[2]; *(LAS v4u*)(b_ + D2_KGT + (64 + (tid >> 3)) * 144 + (tid & 7) * 16) = st[3]; } while (0)
    __syncthreads();
    D2_LOAD(recs); D2_STORE(0);
    f32x4 vnx[4]; float eglx = *(const float*)(recs + DNU_EG);
    { const float* UP0 = (const float*)(recs + DNU_UP) + (size_t)w * 1024 + lane;
#pragma unroll
      for (int mt = 0; mt < 4; ++mt)
#pragma unroll
          for (int r = 0; r < 4; ++r) vnx[mt][r] = UP0[(mt * 4 + r) * 64]; }
    __syncthreads();
    for (int ck = 0; ck < 32; ++ck) {
        const unsigned char* rec = recs + (size_t)ck * DNU_BYTES;
        const LAS unsigned char* bf = lds + (ck & 1) * D2_BUF;
        if (ck + 1 < 32) D2_LOAD(rec + DNU_BYTES);
        const float egl = eglx;
        f32x4 vn[4];
#pragma unroll
        for (int mt = 0; mt < 4; ++mt) vn[mt] = vnx[mt];
        if (ck + 1 < 32) { eglx = *(const float*)(rec + DNU_BYTES + DNU_EG); const float* UP = (const float*)(rec + DNU_BYTES + DNU_UP) + (size_t)w * 1024 + lane;
#pragma unroll
            for (int mt = 0; mt < 4; ++mt)
#pragma unroll
                for (int r = 0; r < 4; ++r) vnx[mt][r] = UP[(mt * 4 + r) * 64]; }
        bf16x8 Sb[4];
#pragma unroll
        for (int ks = 0; ks < 4; ++ks) { Sb[ks] = pack_b(S[2 * ks], S[2 * ks + 1]); sav[(size_t)ck * 3072 + ks * 64] = __builtin_bit_cast(v4u, Sb[ks]); }
        const int aoff = l15 * 272 + 8 * q4, aoff2 = l15 * 144 + 8 * q4;
#pragma unroll
        for (int mt = 0; mt < 4; ++mt)
#pragma unroll
            for (int ks = 0; ks < 4; ++ks) vn[mt] = __builtin_amdgcn_mfma_f32_16x16x32_bf16(ld_frag_perm(bf + D2_NW + mt * 16 * 272 + aoff + ks * 64), Sb[ks], vn[mt], 0, 0, 0);
        bf16x8 vb[2];
        vb[0] = pack_b(vn[0], vn[1]); vb[1] = pack_b(vn[2], vn[3]);
        sav[(size_t)ck * 3072 + 4 * 64] = __builtin_bit_cast(v4u, vb[0]); sav[(size_t)ck * 3072 + 5 * 64] = __builtin_bit_cast(v4u, vb[1]);
#pragma unroll
        for (int m8 = 0; m8 < 8; ++m8) { S[m8] = S[m8] * egl;
#pragma unroll
            for (int ke = 0; ke < 2; ++ke) S[m8] = __builtin_amdgcn_mfma_f32_16x16x32_bf16(ld_frag_perm(bf + D2_KGT + m8 * 16 * 144 + aoff2 + ke * 64), vb[ke], S[m8], 0, 0, 0); }
        if (ck + 1 < 32) D2_STORE((ck + 1) & 1);
        __syncthreads();
    }
    float* sout = A->out + O_DNSP + ((size_t)(layer * NBATCH + b) * 4 + h) * 16384;
#pragma unroll
    for (int m8 = 0; m8 < 8; ++m8)
#pragma unroll
        for (int r = 0; r < 4; ++r) sout[(size_t)(16 * m8 + 4 * q4 + r) * 128 + 16 * w + l15] = S[m8][r];
    __syncthreads();
#undef D2_LOAD
#undef D2_STORE
}
constexpr int D3_QG = 0, D3_AT = 17408, D3_RED = 26624;
__device__ __forceinline__ void dn_out_unit(CA A, LAS unsigned char* lds, int layer, int unit, const int wv) {
    const int tid = tid_opaque(wv), lane = tid & 63, w = tid >> 6, q4 = lane >> 4, l15 = lane & 15;
    const int bh = unit >> 5, ck = unit & 31, b = bh >> 2, h = bh & 3, row0 = b * SEQ + ck * 64;
    const unsigned char* rec = A->ws + WS_DNU + (size_t)unit * DNU_BYTES;
    const v4u* sav = (const v4u*)(A->ws + WS_DNSV + (size_t)unit * 49152) + (size_t)w * 6 * 64 + lane;
    const float* UF = WSP(float, WS_UF); bf16* O1 = WSP(bf16, WS_OBR) + 512; const float nwv = IN_F(I_DNNW)[layer * 128 + 16 * w + l15];
    LAS float* red = (LAS float*)(lds + D3_RED);
    __syncthreads();
    { const v4u* g_ = (const v4u*)rec; const v4u a0 = g_[tid + 1024], a1 = g_[tid + 1536], a2 = g_[tid + 2048];
      *(LAS v4u*)(lds + D3_QG + (tid >> 4) * 272 + (tid & 15) * 16) = a0; *(LAS v4u*)(lds + D3_QG + (32 + (tid >> 4)) * 272 + (tid & 15) * 16) = a1;
      *(LAS v4u*)(lds + D3_AT + (tid >> 3) * 144 + (tid & 7) * 16) = a2; }
    bf16x8 Sb[4], vb[2];
#pragma unroll
    for (int ks = 0; ks < 4; ++ks) Sb[ks] = __builtin_bit_cast(bf16x8, sav[ks * 64]);
    vb[0] = __builtin_bit_cast(bf16x8, sav[4 * 64]); vb[1] = __builtin_bit_cast(bf16x8, sav[5 * 64]);
    f32x4 zz[4];
#pragma unroll
    for (int mt = 0; mt < 4; ++mt)
#pragma unroll
        for (int r = 0; r < 4; ++r) zz[mt][r] = UF[(size_t)(row0 + 16 * mt + 4 * q4 + r) * UFW + UF_DNZ + h * 128 + 16 * w + l15];
    __syncthreads();
    const int aoff = l15 * 272 + 8 * q4, aoff2 = l15 * 144 + 8 * q4;
    f32x4 o[4];
#pragma unroll
    for (int mt = 0; mt < 4; ++mt) { o[mt] = (f32x4){0.f, 0.f, 0.f, 0.f};
#pragma unroll
        for (int ks = 0; ks < 4; ++ks) o[mt] = __builtin_amdgcn_mfma_f32_16x16x32_bf16(ld_frag_perm(lds + D3_QG + mt * 16 * 272 + aoff + ks * 64), Sb[ks], o[mt], 0, 0, 0);
#pragma unroll
        for (int ke = 0; ke < 2; ++ke) o[mt] = __builtin_amdgcn_mfma_f32_16x16x32_bf16(ld_frag_perm(lds + D3_AT + mt * 16 * 144 + aoff2 + ke * 64), vb[ke], o[mt], 0, 0, 0); }
#pragma unroll
    for (int mt = 0; mt < 4; ++mt)
#pragma unroll
        for (int r = 0; r < 4; ++r) red[(16 * mt + 4 * q4 + r) * 8 + w] = row16_sum(o[mt][r] * o[mt][r]);
    __syncthreads();
#pragma unroll
    for (int mt = 0; mt < 4; ++mt)
#pragma unroll
        for (int r = 0; r < 4; ++r) { const int c = 16 * mt + 4 * q4 + r; const f32x4 s0 = *(const LAS f32x4*)(red + c * 8), s1 = *(const LAS f32x4*)(red + c * 8 + 4);
            const float rstd = __builtin_amdgcn_rsqf(((s0[0] + s0[1]) + (s0[2] + s0[3]) + (s1[0] + s1[1]) + (s1[2] + s1[3])) * (1.0f / 128.0f) + RMS_EPS);
            const float zq = zz[mt][r]; O1[(size_t)(row0 + c) * OBW + h * 128 + 16 * w + l15] = (bf16)f2bf(o[mt][r] * rstd * nwv * zq * __builtin_amdgcn_rcpf(1.0f + fexp(-zq))); }
}

constexpr size_t SSU_XT = 0, SSU_XTW = 8192, SSU_CUM = 16384, SSU_DT = 16640, SSU_BYTES = 16896;
constexpr size_t SSG_C = 0, SSG_B = 16384, SSG_BT = 32768, SSG_BYTES = 49152;
__device__ __forceinline__ void ssd_prep_unit(CA A, LAS unsigned char* lds, int layer, int unit, const int wv) {
    const int tid = tid_opaque(wv), lane = tid & 63;
    const int hd = unit & 15, bc = unit >> 4, b = bc >> 5, ck = bc & 31, g = hd >> 3, row0 = b * SEQ + ck * 64;
    const float* SC = WSP(float, WS_SCAL);
    unsigned char* rec = A->ws + WS_SSU + (size_t)unit * SSU_BYTES;
    LAS float* xl = (LAS float*)lds;
    LAS float* bl = xl + 64 * 65;
    LAS float* cums = bl + 64 * 129; LAS float* ws_ = cums + 64;
    const float a = -fexp(IN_F(I_SSALOG)[layer * 16 + hd]);
    __syncthreads();
    if (tid < 64) { const float dt = SC[(size_t)(row0 + tid) * 32 + 8 + hd]; const float c = wave_scan(dt * a, lane);
        cums[tid] = c; const float c63 = rdlane(c, 63); ws_[tid] = fexp(c63 - c) * dt;
        ((float*)(rec + SSU_CUM))[tid] = c; ((float*)(rec + SSU_DT))[tid] = dt; }
    const float* UF = WSP(float, WS_UF); const float* cw = IN_F(I_SSCW) + (size_t)layer * 4 * 1536; const float* cb = IN_F(I_SSCB) + layer * 1536; const int tq0 = ck * 64;
    { const int s = tid >> 3, p8 = (tid & 7) * 8, col = hd * 64 + p8; f32x4 x0 = *(const f32x4*)(cb + col), x1 = *(const f32x4*)(cb + col + 4);
#pragma unroll
      for (int j = 0; j < 4; ++j) if (tq0 + s - 3 + j >= 0) { const float* up = UF + (size_t)(row0 + s - 3 + j) * UFW + UF_XBC + col; x0 += *(const f32x4*)up * *(const f32x4*)(cw + j * 1536 + col); x1 += *(const f32x4*)(up + 4) * *(const f32x4*)(cw + j * 1536 + col + 4); }
#pragma unroll
      for (int e = 0; e < 4; ++e) { xl[s * 65 + p8 + e] = siluf_(x0[e]); xl[s * 65 + p8 + 4 + e] = siluf_(x1[e]); } }
    __syncthreads();
    { const int p = tid >> 3, s8 = (tid & 7) * 8; float xv[8], xw[8];
#pragma unroll
      for (int i = 0; i < 8; ++i) { xv[i] = xl[(s8 + i) * 65 + p]; xw[i] = xv[i] * ws_[s8 + i]; }
      v4u o; o.x = pk2(xv[0], xv[1]); o.y = pk2(xv[2], xv[3]); o.z = pk2(xv[4], xv[5]); o.w = pk2(xv[6], xv[7]); *(v4u*)(rec + SSU_XT + (size_t)(p * 64 + s8) * 2) = o;
      o.x = pk2(xw[0], xw[1]); o.y = pk2(xw[2], xw[3]); o.z = pk2(xw[4], xw[5]); o.w = pk2(xw[6], xw[7]); *(v4u*)(rec + SSU_XTW + (size_t)(p * 64 + s8) * 2) = o; }
    if ((hd & 7) == 0) {
        unsigned char* grec = A->ws + WS_SSG + (size_t)(bc * 2 + g) * SSG_BYTES;
        const int s = tid >> 3, n16 = (tid & 7) * 16, colb = 1024 + g * 128 + n16;
        f32x4 bv[4], cv[4];
#pragma unroll
        for (int i = 0; i < 4; ++i) { bv[i] = *(const f32x4*)(cb + colb + 4 * i); cv[i] = *(const f32x4*)(cb + colb + 256 + 4 * i); }
#pragma unroll
        for (int j = 0; j < 4; ++j) if (tq0 + s - 3 + j >= 0) { const float* up = UF + (size_t)(row0 + s - 3 + j) * UFW + UF_XBC + colb; const float* wp = cw + j * 1536 + colb;
#pragma unroll
            for (int i = 0; i < 4; ++i) { bv[i] += *(const f32x4*)(up + 4 * i) * *(const f32x4*)(wp + 4 * i); cv[i] += *(const f32x4*)(up + 256 + 4 * i) * *(const f32x4*)(wp + 256 + 4 * i); } }
#pragma unroll
        for (int i = 0; i < 4; ++i)
#pragma unroll
            for (int e = 0; e < 4; ++e) { bv[i][e] = siluf_(bv[i][e]); cv[i][e] = siluf_(cv[i][e]); }
#pragma unroll
        for (int i = 0; i < 2; ++i) { v4u o; o.x = pk2(bv[2 * i][0], bv[2 * i][1]); o.y = pk2(bv[2 * i][2], bv[2 * i][3]); o.z = pk2(bv[2 * i + 1][0], bv[2 * i + 1][1]); o.w = pk2(bv[2 * i + 1][2], bv[2 * i + 1][3]);
            *(v4u*)(grec + SSG_B + (size_t)(s * 128 + n16 + 8 * i) * 2) = o;
            o.x = pk2(cv[2 * i][0], cv[2 * i][1]); o.y = pk2(cv[2 * i][2], cv[2 * i][3]); o.z = pk2(cv[2 * i + 1][0], cv[2 * i + 1][1]); o.w = pk2(cv[2 * i + 1][2], cv[2 * i + 1][3]);
            *(v4u*)(grec + SSG_C + (size_t)(s * 128 + n16 + 8 * i) * 2) = o; }
#pragma unroll
        for (int i = 0; i < 4; ++i)
#pragma unroll
            for (int e = 0; e < 4; ++e) bl[s * 129 + n16 + 4 * i + e] = bv[i][e];
        __syncthreads();
        const int n = tid >> 2, s16 = (tid & 3) * 16; float t[16];
#pragma unroll
        for (int i = 0; i < 16; ++i) t[i] = bl[(s16 + i) * 129 + n];
#pragma unroll
        for (int i = 0; i < 2; ++i) { v4u o; o.x = pk2(t[8 * i], t[8 * i + 1]); o.y = pk2(t[8 * i + 2], t[8 * i + 3]); o.z = pk2(t[8 * i + 4], t[8 * i + 5]); o.w = pk2(t[8 * i + 6], t[8 * i + 7]);
            *(v4u*)(grec + SSG_BT + (size_t)(n * 64 + s16 + 8 * i) * 2) = o; }
    }
}

constexpr int S2_C = 0, S2_B = 17408, S2_BT = 34816, S2_XT = 53248, S2_XTW = 62464, S2_WM = 71680, S2_HB = 80896, S2_YB = 98304, S2_CUM = 114688, S2_DT = 114944;
__device__ __forceinline__ void ssd_seq2(CA A, LAS unsigned char* lds, int layer, int unit, const int wv) {
    const int tid = tid_opaque(wv), lane = tid & 63, w = tid >> 6, q4 = lane >> 4, l15 = lane & 15;
    const int b = unit >> 4, hd = unit & 15, g = hd >> 3;
    const unsigned char* hrec = A->ws + WS_SSU + (size_t)((b * 32) * 16 + hd) * SSU_BYTES;
    const unsigned char* grec = A->ws + WS_SSG + (size_t)((b * 32) * 2 + g) * SSG_BYTES;
    const float* UF = WSP(float, WS_UF); float* SSQ = WSP(float, WS_SSQ); bf16* Og = WSP(bf16, WS_OBR) + (3 + g) * 512;
    const float Dk = IN_F(I_SSD)[layer * 16 + hd];
    LAS float* yb = (LAS float*)(lds + S2_YB); LAS float* cums = (LAS float*)(lds + S2_CUM); LAS float* dts = (LAS float*)(lds + S2_DT);
    f32x4 hacc[4];
#pragma unroll
    for (int i = 0; i < 4; ++i) hacc[i] = (f32x4){0.f, 0.f, 0.f, 0.f};
    v4u st[8]; float sc1 = 0.f;
#define S2_LOAD(ck_) do { const v4u* gg_ = (const v4u*)(grec + (size_t)(ck_) * 2 * SSG_BYTES); const v4u* hh_ = (const v4u*)(hrec + (size_t)(ck_) * 16 * SSU_BYTES); \
        st[0] = gg_[tid]; st[1] = gg_[tid + 512]; st[2] = gg_[tid + 1024]; st[3] = gg_[tid + 1536]; st[4] = gg_[tid + 2048]; st[5] = gg_[tid + 2560]; st[6] = hh_[tid]; st[7] = hh_[tid + 512]; \
        if (tid < 128) sc1 = ((const float*)(hrec + (size_t)(ck_) * 16 * SSU_BYTES + SSU_CUM))[tid]; } while (0)
#define S2_STORE() do { \
        *(LAS v4u*)(lds + S2_C + (tid >> 4) * 272 + (tid & 15) * 16) = st[0]; *(LAS v4u*)(lds + S2_C + (32 + (tid >> 4)) * 272 + (tid & 15) * 16) = st[1]; \
        *(LAS v4u*)(lds + S2_B + (tid >> 4) * 272 + (tid & 15) * 16) = st[2]; *(LAS v4u*)(lds + S2_B + (32 + (tid >> 4)) * 272 + (tid & 15) * 16) = st[3]; \
        *(LAS v4u*)(lds + S2_BT + (tid >> 3) * 144 + (tid & 7) * 16) = st[4]; *(LAS v4u*)(lds + S2_BT + (64 + (tid >> 3)) * 144 + (tid & 7) * 16) = st[5]; \
        *(LAS v4u*)(lds + S2_XT + (tid >> 3) * 144 + (tid & 7) * 16) = st[6]; *(LAS v4u*)(lds + S2_XTW + (tid >> 3) * 144 + (tid & 7) * 16) = st[7]; \
        if (tid < 128) cums[tid] = sc1; } while (0)
    S2_LOAD(0);
    const int tt = w >> 1, aoffC = l15 * 272 + 16 * q4, aoffS = l15 * 144 + 16 * q4;
    for (int ck = 0; ck < 32; ++ck) {
        const int row0 = b * SEQ + ck * 64;
        __syncthreads();
        S2_STORE();
        __syncthreads();
        if (ck + 1 < 32) S2_LOAD(ck + 1);
        float zv[2][4];
#pragma unroll
        for (int e2 = 0; e2 < 2; ++e2)
#pragma unroll
            for (int r = 0; r < 4; ++r) zv[e2][r] = UF[(size_t)(row0 + 16 * tt + 4 * q4 + r) * UFW + UF_SSZ + hd * 64 + 16 * (2 * (w & 1) + e2) + l15];
#pragma unroll
        for (int e2 = 0; e2 < 2; ++e2) { const int stl = 2 * (w & 1) + e2; f32x4 acc = {0.f, 0.f, 0.f, 0.f};
            if (stl <= tt) {
#pragma unroll
                for (int ks = 0; ks < 4; ++ks) acc = __builtin_amdgcn_mfma_f32_16x16x32_bf16(*(const LAS bf16x8*)(lds + S2_C + tt * 16 * 272 + aoffC + ks * 64), *(const LAS bf16x8*)(lds + S2_B + stl * 16 * 272 + aoffC + ks * 64), acc, 0, 0, 0); }
            const int s = 16 * stl + l15; const float cs = cums[s], ds = dts[s];
#pragma unroll
            for (int r = 0; r < 4; ++r) { const int t = 16 * tt + 4 * q4 + r; const float v = s <= t ? acc[r] * fexp(cums[t] - cs) * ds : 0.f;
                *(LAS unsigned short*)(lds + S2_WM + t * 144 + s * 2) = (unsigned short)f2bf(v); } }
#pragma unroll
        for (int mt = 0; mt < 4; ++mt)
#pragma unroll
            for (int r = 0; r < 4; ++r) *(LAS unsigned short*)(lds + S2_HB + (16 * mt + 4 * q4 + r) * 272 + (16 * w + l15) * 2) = (unsigned short)f2bf(hacc[mt][r]);
        __syncthreads();
        float ssq[4] = {0.f, 0.f, 0.f, 0.f};
#pragma unroll
        for (int e2 = 0; e2 < 2; ++e2) { const int pt = 2 * (w & 1) + e2; f32x4 y = {0.f, 0.f, 0.f, 0.f};
#pragma unroll
            for (int ks = 0; ks < 4; ++ks) y = __builtin_amdgcn_mfma_f32_16x16x32_bf16(*(const LAS bf16x8*)(lds + S2_C + tt * 16 * 272 + aoffC + ks * 64), *(const LAS bf16x8*)(lds + S2_HB + pt * 16 * 272 + aoffC + ks * 64), y, 0, 0, 0);
#pragma unroll
            for (int r = 0; r < 4; ++r) y[r] *= fexp(cums[16 * tt + 4 * q4 + r]);
#pragma unroll
            for (int ke = 0; ke < 2; ++ke) y = __builtin_amdgcn_mfma_f32_16x16x32_bf16(*(const LAS bf16x8*)(lds + S2_WM + tt * 16 * 144 + aoffS + ke * 64), *(const LAS bf16x8*)(lds + S2_XT + pt * 16 * 144 + aoffS + ke * 64), y, 0, 0, 0);
            const int p = 16 * pt + l15;
#pragma unroll
            for (int r = 0; r < 4; ++r) { const int t = 16 * tt + 4 * q4 + r; const float xv = bflo((unsigned)*(const LAS unsigned short*)(lds + S2_XT + p * 144 + t * 2));
                const float yg = (y[r] + Dk * xv) * siluf_(zv[e2][r]); ssq[r] += yg * yg;
                Og[(size_t)(row0 + t) * OBW + (hd & 7) * 64 + p] = (bf16)f2bf(yg); } }
#pragma unroll
        for (int r = 0; r < 4; ++r) { const float s = row16_sum(ssq[r]); if (l15 == 0) SSQ[(size_t)(row0 + 16 * tt + 4 * q4 + r) * 32 + hd * 2 + (w & 1)] = s; }
        { const float e63 = fexp(cums[63]);
#pragma unroll
          for (int mt = 0; mt < 4; ++mt) { hacc[mt] = hacc[mt] * e63;
#pragma unroll
              for (int ke = 0; ke < 2; ++ke) hacc[mt] = __builtin_amdgcn_mfma_f32_16x16x32_bf16(*(const LAS bf16x8*)(lds + S2_XTW + mt * 16 * 144 + aoffS + ke * 64), *(const LAS bf16x8*)(lds + S2_BT + w * 16 * 144 + aoffS + ke * 64), hacc[mt], 0, 0, 0); } }
    }
    float* hout = A->out + O_SSHP + ((size_t)(layer * NBATCH + b) * 16 + hd) * 8192;
#pragma unroll
    for (int mt = 0; mt < 4; ++mt)
#pragma unroll
        for (int r = 0; r < 4; ++r) hout[(size_t)(16 * mt + 4 * q4 + r) * 128 + 16 * w + l15] = hacc[mt][r];
    __syncthreads();
#undef S2_LOAD
#undef S2_STORE
}

struct ALBf16 { const bf16* A; int lda; __device__ __forceinline__ bf16x8 operator()(int row, int k) const { return *(const bf16x8*)(A + (size_t)row * lda + k); } };
template <class AL> __device__ __forceinline__ void sgemm_task(const AL& al, const bf16* Wt, int ldw, int n0, int k0, int nks, f32x4 (&acc)[2], int l15, int q4) {
    const bf16* bp = Wt + (size_t)(n0 + l15) * ldw + k0 + 8 * q4;
    int nks_ = nks; asm volatile("" : "+s"(nks_));
#pragma unroll 4
    for (int ks = 0; ks < nks_; ++ks) { const bf16x8 b = *(const bf16x8*)(bp + 32 * ks); const bf16x8 a0 = al(l15, k0 + 32 * ks + 8 * q4), a1 = al(16 + l15, k0 + 32 * ks + 8 * q4);
        acc[0] = __builtin_amdgcn_mfma_f32_16x16x32_bf16(a0, b, acc[0], 0, 0, 0); acc[1] = __builtin_amdgcn_mfma_f32_16x16x32_bf16(a1, b, acc[1], 0, 0, 0); }
}
#define SAMPLE_IDS() const int tid = tid_opaque(wv), lane = tid & 63, l15 = lane & 15, q4 = lane >> 4, NGW = gridDim.x * NWAVES, gw = (tid >> 6) * gridDim.x + blk_opaque()
__device__ __forceinline__ void sample_merge(CA A, LAS unsigned char* lds, int layer, const int wv) {
    const int tid = tid_opaque(wv), lane = tid & 63, l15 = lane & 15, q4 = lane >> 4, w = tid >> 6, G = gridDim.x;
    const bf16* GT = WSP(bf16, WS_GATE); const float* RS = WSP(float, WS_RS); bf16* MB = WSP(bf16, WS_MGB); LAS float* part = (LAS float*)lds;
    for (int strip = blk_opaque(); strip < 128; strip += G) { const int n0 = strip * 16, col = n0 + l15;
        __syncthreads();
        if (w < 5) { const int s = w, gs = s < 3 ? s : 3;
            f32x4 acc[2] = {{0.f, 0.f, 0.f, 0.f}, {0.f, 0.f, 0.f, 0.f}};
            ALBf16 al{WSP(bf16, WS_OBR) + (size_t)TP * OBW + s * 512, OBW};
            sgemm_task(al, WSP(bf16, WS_WBR) + (size_t)layer * DM * OBW + s * 512, OBW, n0, 0, 16, acc, l15, q4);
#pragma unroll
            for (int mt = 0; mt < 2; ++mt)
#pragma unroll
                for (int r = 0; r < 4; ++r) { const int row = 16 * mt + 4 * q4 + r, grow = TP + row; float rs = 1.f;
                    if (s >= 3) rs = 1.0f / sqrtf(RS[(size_t)grow * 2 + (s - 3)]);
                    part[(s * 32 + row) * 16 + l15] = acc[mt][r] * bflo((unsigned)GT[(size_t)grow * 8192 + gs * 2048 + col]) * rs; } }
        __syncthreads();
        { const int row = tid >> 4, c = tid & 15; const float v = (part[row * 16 + c] + part[(32 + row) * 16 + c]) + (part[(64 + row) * 16 + c] + part[(96 + row) * 16 + c]) + part[(128 + row) * 16 + c];
          MB[(size_t)(TP + row) * DM + n0 + c] = (bf16)f2bf(v); } }
}
__device__ __forceinline__ void sample_up(CA A, LAS unsigned char* lds, int layer, const int wv) {
    const int tid = tid_opaque(wv), lane = tid & 63, l15 = lane & 15, q4 = lane >> 4, w = tid >> 6, G = gridDim.x;
    bf16* F = WSP(bf16, WS_F); LAS float* part = (LAS float*)lds;
    for (int sp = blk_opaque(); sp < 256; sp += G) { const int n0 = (2 * sp + (w >> 2)) * 16, kq = w & 3;
        __syncthreads();
        f32x4 acc[2] = {{0.f, 0.f, 0.f, 0.f}, {0.f, 0.f, 0.f, 0.f}};
        ALBf16 al{WSP(bf16, WS_H) + (size_t)TP * DM, DM};
        sgemm_task(al, WSP(bf16, WS_WUP) + (size_t)layer * DFF * DM, DM, n0, kq * 512, 16, acc, l15, q4);
#pragma unroll
        for (int mt = 0; mt < 2; ++mt)
#pragma unroll
            for (int r = 0; r < 4; ++r) part[(w * 32 + 16 * mt + 4 * q4 + r) * 16 + l15] = acc[mt][r];
        __syncthreads();
#pragma unroll
        for (int h2 = 0; h2 < 2; ++h2) { const int idx = tid + 512 * h2, half = idx >> 9, row = (idx >> 4) & 31, c = idx & 15; const LAS float* p = part + (half * 4 * 32 + row) * 16 + c;
            const float v = fmaxf((p[0] + p[32 * 16]) + (p[2 * 32 * 16] + p[3 * 32 * 16]), 0.f);
            F[(size_t)(TP + row) * DFF + (2 * sp + half) * 16 + c] = (bf16)f2bf(v * v); } }
}
template <class AL> __device__ __forceinline__ void sample_splitk(const AL& al, const bf16* Wt, int ldw, int nstrips, int nsplit, int nks, float* PART, int ldp, const int wv) {
    SAMPLE_IDS();
    for (int it = gw; it < nstrips * nsplit; it += NGW) { const int ns = it % nstrips, sp = it / nstrips, n0 = ns * 16;
        f32x4 acc[2] = {{0.f, 0.f, 0.f, 0.f}, {0.f, 0.f, 0.f, 0.f}};
        sgemm_task(al, Wt, ldw, n0, sp * nks * 32, nks, acc, l15, q4);
#pragma unroll
        for (int mt = 0; mt < 2; ++mt)
#pragma unroll
            for (int r = 0; r < 4; ++r) PART[((size_t)sp * TS + 16 * mt + 4 * q4 + r) * ldp + n0 + l15] = acc[mt][r]; }
}

constexpr int KS_PITCH = 272, VT_PITCH = 136;
constexpr int ATT_KS = 0, ATT_VT = 64 * KS_PITCH;
__device__ __forceinline__ void attn_prompt_unit(CA A, LAS unsigned char* lds, int layer, int unit, const int wv) {
    const int tid = tid_opaque(wv), lane = tid & 63, wid = tid >> 6, r = lane & 31, hh = lane >> 5;
    const int qb = 7 - (unit >> 4), bh = unit & 15, b = bh >> 2, h = bh & 3;
    const int q0 = qb * 256 + wid * 32, qpos = q0 + r;
    const bf16* QKV = WSP(bf16, WS_QKV) + (size_t)(b * SEQ) * 1536;
    bf16x8 Qf[8];
    { const bf16* qrow = QKV + (size_t)qpos * 1536 + h * 128 + 8 * hh;
#pragma unroll
      for (int s = 0; s < 8; ++s) Qf[s] = *(const bf16x8*)(qrow + 16 * s); }
    f32x16 O[4];
#pragma unroll
    for (int d = 0; d < 4; ++d)
#pragma unroll
        for (int i = 0; i < 16; ++i) O[d][i] = 0.f;
    float R = 0.f;
    const float bias2 = IN_F(I_SBBIAS)[layer * 4 + h] * LOG2E;
    const int ntile = qb * 4 + 4, srow = tid >> 3, sch = tid & 7;
    LAS unsigned char* Ks = lds + ATT_KS; LAS unsigned char* Vt = lds + ATT_VT;
    v4u kreg[2], vreg[2];
    { const bf16* src = QKV + (size_t)((ntile - 1) * 64 + srow) * 1536 + h * 128 + sch * 8;
      kreg[0] = *(const v4u*)(src + 512); kreg[1] = *(const v4u*)(src + 512 + 64); vreg[0] = *(const v4u*)(src + 1024); vreg[1] = *(const v4u*)(src + 1024 + 64); }
    for (int kt = ntile - 1; kt >= 0; --kt) {
        __syncthreads();
#pragma unroll
        for (int i = 0; i < 2; ++i) { *(LAS v4u*)(Ks + srow * KS_PITCH + (sch + 8 * i) * 16) = kreg[i];
            LAS unsigned short* vt = (LAS unsigned short*)Vt + ((sch + 8 * i) * 8) * (VT_PITCH / 2) + srow;
            const unsigned w[4] = {vreg[i].x, vreg[i].y, vreg[i].z, vreg[i].w};
#pragma unroll
            for (int e = 0; e < 4; ++e) { vt[(2 * e) * (VT_PITCH / 2)] = (unsigned short)(w[e] & 0xffffu); vt[(2 * e + 1) * (VT_PITCH / 2)] = (unsigned short)(w[e] >> 16); } }
        __syncthreads();
        if (kt > 0) { const bf16* src = QKV + (size_t)((kt - 1) * 64 + srow) * 1536 + h * 128 + sch * 8;
            kreg[0] = *(const v4u*)(src + 512); kreg[1] = *(const v4u*)(src + 512 + 64); vreg[0] = *(const v4u*)(src + 1024); vreg[1] = *(const v4u*)(src + 1024 + 64); }
        if (kt * 64 > q0 + 30) continue;
        const bool diag = (kt * 64 + 63 >= q0);
        const int kbase = kt * 64 + 4 * hh;
        bf16x8 Pf[4];
#pragma unroll
        for (int sub = 1; sub >= 0; --sub) {
            f32x16 sa;
#pragma unroll
            for (int i = 0; i < 16; ++i) sa[i] = bias2;
#pragma unroll
            for (int s = 0; s < 8; ++s) { const bf16x8 a = *(const LAS bf16x8*)(Ks + (32 * sub + r) * KS_PITCH + (16 * s + 8 * hh) * 2);
                sa = __builtin_amdgcn_mfma_f32_32x32x16_bf16(a, Qf[s], sa, 0, 0, 0); }
            float sp[16], Gs[4], Gp[4];
#pragma unroll
            for (int i = 0; i < 16; ++i) { const float z = fminf(sa[i], 60.f); sa[i] = z; float s1 = lg2(1.0f + ex2(z));
                if (diag && (kbase + 32 * sub + 8 * (i >> 2) + (i & 3) >= qpos)) s1 = 0.f;
                sp[i] = s1; }
#pragma unroll
            for (int g = 0; g < 4; ++g) { Gs[g] = (sp[4 * g] + sp[4 * g + 1]) + (sp[4 * g + 2] + sp[4 * g + 3]); Gp[g] = __shfl_xor(Gs[g], 32); }
            float run = R;
#pragma unroll
            for (int g = 3; g >= 0; --g) { float a = run + (hh == 0 ? Gp[g] : 0.f);
#pragma unroll
                for (int e = 3; e >= 0; --e) { const int i = 4 * g + e; float pv = ex2(sa[i] - sp[i] - a);
                    if (diag && (kbase + 32 * sub + 8 * g + e >= qpos)) pv = 0.f;
                    a += sp[i]; sp[i] = pv; }
                run += Gs[g] + Gp[g]; }
            R = run;
#pragma unroll
            for (int q2 = 0; q2 < 2; ++q2) { const int bs = 8 * q2; v4u w;
                w.x = pk2(sp[bs + 0], sp[bs + 1]); w.y = pk2(sp[bs + 2], sp[bs + 3]); w.z = pk2(sp[bs + 4], sp[bs + 5]); w.w = pk2(sp[bs + 6], sp[bs + 7]);
                Pf[2 * sub + q2] = __builtin_bit_cast(bf16x8, w); }
        }
#pragma unroll
        for (int d = 0; d < 4; ++d)
#pragma unroll
            for (int s4 = 0; s4 < 4; ++s4) { const LAS unsigned char* vp = Vt + (32 * d + r) * VT_PITCH + (16 * s4 + 4 * hh) * 2;
                const v2u lo = *(const LAS v2u*)vp, hi = *(const LAS v2u*)(vp + 16); v4u w; w.x = lo.x; w.y = lo.y; w.z = hi.x; w.w = hi.y;
                O[d] = __builtin_amdgcn_mfma_f32_32x32x16_bf16(__builtin_bit_cast(bf16x8, w), Pf[s4], O[d], 0, 0, 0); }
    }
    bf16* orow = WSP(bf16, WS_OBR) + 1024 + (size_t)(b * SEQ + qpos) * OBW + h * 128 + 4 * hh;
#pragma unroll
    for (int d = 0; d < 4; ++d)
#pragma unroll
        for (int g = 0; g < 4; ++g) { v2u w; w.x = pk2(O[d][4 * g], O[d][4 * g + 1]); w.y = pk2(O[d][4 * g + 2], O[d][4 * g + 3]); *(v2u*)(orow + 32 * d + 8 * g) = w; }
}

__device__ __forceinline__ void attn_sample_unit(CA A, LAS unsigned char* lds, int layer, int unit, const int wv) {
    const int tid = tid_opaque(wv), lane = tid & 63, wid = tid >> 6, sb = unit >> 5, pg4 = unit & 31, hd = lane >> 4;
    const int lp = 4 * pg4 + (wid >> 1), phys = ((const int*)A->in[I_PT])[sb * NPAGES + lp];
    const size_t pbase = ((size_t)(layer * NPOOL + phys) * PAGE + (wid & 1) * 64) * 512 + lane * 8;
    const float* Kc = IN_F(I_CK) + pbase; const float* Vc = IN_F(I_CV) + pbase;
    const bf16* QKV = WSP(bf16, WS_QKV);
    float qf[4][8], O[4][8], R[4];
#pragma unroll
    for (int i = 0; i < 4; ++i) { const v4u w = *(const v4u*)(QKV + (size_t)(TP + sb * 4 + i) * 1536 + lane * 8);
        qf[i][0] = bflo(w.x); qf[i][1] = bfhi(w.x); qf[i][2] = bflo(w.y); qf[i][3] = bfhi(w.y); qf[i][4] = bflo(w.z); qf[i][5] = bfhi(w.z); qf[i][6] = bflo(w.w); qf[i][7] = bfhi(w.w);
        R[i] = 0.f;
#pragma unroll
        for (int j = 0; j < 8; ++j) O[i][j] = 0.f; }
    const float bias2 = IN_F(I_SBBIAS)[layer * 4 + hd] * LOG2E;
#pragma unroll 4
    for (int t = 63; t >= 0; --t) {
        const f32x4 k0 = *(const f32x4*)(Kc + (size_t)t * 512), k1 = *(const f32x4*)(Kc + (size_t)t * 512 + 4), v0 = *(const f32x4*)(Vc + (size_t)t * 512), v1 = *(const f32x4*)(Vc + (size_t)t * 512 + 4);
#pragma unroll
        for (int i = 0; i < 4; ++i) {
            float s = (qf[i][0] * k0[0] + qf[i][1] * k0[1]) + (qf[i][2] * k0[2] + qf[i][3] * k0[3]) + (qf[i][4] * k1[0] + qf[i][5] * k1[1]) + (qf[i][6] * k1[2] + qf[i][7] * k1[3]);
            s = row16_sum(s);
            const float z = fminf(s + bias2, 60.f), s1 = lg2(1.0f + ex2(z)), pv = ex2(z - s1 - R[i]); R[i] += s1;
#pragma unroll
            for (int e = 0; e < 4; ++e) { O[i][e] += pv * v0[e]; O[i][4 + e] += pv * v1[e]; } }
    }
    LAS float* Ow = (LAS float*)lds;
    LAS float* Rw = Ow + 8 * 4 * 512;
    __syncthreads();
#pragma unroll
    for (int i = 0; i < 4; ++i) { *(LAS f32x4*)(Ow + (wid * 4 + i) * 512 + lane * 8) = (f32x4){O[i][0], O[i][1], O[i][2], O[i][3]}; *(LAS f32x4*)(Ow + (wid * 4 + i) * 512 + lane * 8 + 4) = (f32x4){O[i][4], O[i][5], O[i][6], O[i][7]};
        if ((lane & 15) == 0) Rw[(wid * 4 + i) * 4 + hd] = R[i]; }
    __syncthreads();
    float* PART = WSP(float, WS_PART) + (size_t)unit * 2048; float* PR = WSP(float, WS_PR) + (size_t)unit * 16;
    for (int idx = tid; idx < 2048; idx += NTHR) { const int i = idx >> 9, c = idx & 511, hc = c >> 7; float acc = 0.f, racc = 0.f;
#pragma unroll
        for (int w = 7; w >= 0; --w) { acc += ex2(-racc) * Ow[(w * 4 + i) * 512 + c]; racc += Rw[(w * 4 + i) * 4 + hc]; }
        PART[idx] = acc; if ((c & 127) == 0) PR[i * 4 + hc] = racc; }
}
__device__ __forceinline__ void attn_sample_combine(CA A, int layer, const int wv) {
    {
      const int t0 = tid_opaque(wv), gt = blk_opaque() * NTHR + t0; const float* SQ = WSP(float, WS_SSQ); float* RS = WSP(float, WS_RS);
      for (int idx = gt; idx < TT * 2; idx += gridDim.x * NTHR) { const f32x4* sq = (const f32x4*)(SQ + (size_t)idx * 16); const f32x4 a = sq[0], b = sq[1], c = sq[2], d = sq[3];
          RS[idx] = (((a[0] + a[1]) + (a[2] + a[3]) + (b[0] + b[1]) + (b[2] + b[3])) + ((c[0] + c[1]) + (c[2] + c[3]) + (d[0] + d[1]) + (d[2] + d[3]))) * (1.0f / 512.0f) + RMS_EPS; } }
    const int tid = tid_opaque(wv), lane = tid & 63, gw = blk_opaque() * NWAVES + (tid >> 6), NGW = gridDim.x * NWAVES;
    const bf16* QKV = WSP(bf16, WS_QKV); const float* PART = WSP(float, WS_PART); const float* PR = WSP(float, WS_PR);
    const float* kn = A->out + O_KS + (size_t)layer * TS * 512; const float* vn = A->out + O_VS + (size_t)layer * TS * 512;
    bf16* O2 = WSP(bf16, WS_OBR) + 1024;
    for (int it = gw; it < TS * 4; it += NGW) { const int sb = it >> 4, i = (it >> 2) & 3, hd = it & 3, row = TP + sb * 4 + i, c = hd * 128 + 2 * lane;
        const unsigned qw = *(const unsigned*)(QKV + (size_t)row * 1536 + c); const float q0 = bflo(qw), q1 = bfhi(qw);
        const float bias2 = IN_F(I_SBBIAS)[layer * 4 + hd] * LOG2E; float o0 = 0.f, o1 = 0.f, racc = 0.f;
        for (int j = i - 1; j >= 0; --j) { const float* kr = kn + (size_t)(sb * 4 + j) * 512 + c; const float* vr = vn + (size_t)(sb * 4 + j) * 512 + c;
            const float z = fminf(wave_sum(q0 * kr[0] + q1 * kr[1]) + bias2, 60.f), s1 = lg2(1.0f + ex2(z)), pv = ex2(z - s1 - racc); racc += s1; o0 += pv * vr[0]; o1 += pv * vr[1]; }
        for (int u = 31; u >= 0; --u) { const float* pr = PART + ((size_t)(sb * 32 + u) * 4 + i) * 512 + c; const float sc = ex2(-racc); o0 += sc * pr[0]; o1 += sc * pr[1]; racc += PR[(size_t)(sb * 32 + u) * 16 + i * 4 + hd]; }
        *(unsigned*)(O2 + (size_t)row * OBW + c) = pk2(o0, o1); }
}

#ifndef MK_ONE_LAUNCH
#define MK_ONE_LAUNCH 1
#endif
#ifndef REP_P0
#define REP_P0 1
#endif
#ifndef REP_IN
#define REP_IN 1
#endif
#ifndef REP_PREP
#define REP_PREP 1
#endif
#ifndef REP_MIXA
#define REP_MIXA 1
#endif
#ifndef REP_MIXB
#define REP_MIXB 1
#endif
#ifndef REP_MERGE
#define REP_MERGE 1
#endif
#ifndef REP_OUT
#define REP_OUT 1
#endif
#ifndef REP_UP
#define REP_UP 1
#endif
#ifndef REP_DOWN
#define REP_DOWN 1
#endif
#ifndef REP_BAR
#define REP_BAR 1
#endif
#ifndef REP_RES1L0
#define REP_RES1L0 1
#endif
#ifndef REP_BDN
#define REP_BDN 1
#endif
#ifndef REP_BSSD
#define REP_BSSD 1
#endif
#ifndef REP_BSATT
#define REP_BSATT 1
#endif
constexpr int N_PHASES = 24;
__device__ __forceinline__ int queue_pop(unsigned* head, volatile LAS unsigned* slot, const int wv) {
    __syncthreads();
    if (tid_opaque(wv) == 0) *slot = __hip_atomic_fetch_add(head, 1u, __ATOMIC_RELAXED, __HIP_MEMORY_SCOPE_AGENT);
    __syncthreads();
    return (int)*slot;
}
__global__ void __launch_bounds__(NTHR, 2) mega(Args Araw) {
    extern __shared__ __attribute__((aligned(16))) unsigned char lds_raw[];
    LAS unsigned char* lds = (LAS unsigned char*)lds_raw;
    volatile LAS unsigned* MISC = (volatile LAS unsigned*)(lds + MISC_OFF);
    const int wv = __builtin_amdgcn_readfirstlane(threadIdx.x >> 6); const int tid = tid_opaque(wv), G = gridDim.x, blk = blk_opaque();
    if (tid < 16) MISC[tid] = 0u;
    __syncthreads();
    unsigned* ctl = (unsigned*)(Araw.ws + WS_CTL);
    XcdBarrier bar = xcd_barrier_post(ctl + CW_BAR + Araw.li * XCD_BAR_WORDS, MISC, tid);
    const int lo = Araw.ph_lo, hi = Araw.ph_hi;
#define IN(gp) (lo <= (gp) && (gp) < hi)
#define SEAM(gp) do { if (lo <= (gp) && (gp) + 1 < hi) for (int rb_ = 0; rb_ < REP_BAR; ++rb_) xcd_barrier(bar, tid_opaque(wv)); } while (0)

    if (IN(0)) for (int rep = 0; rep < REP_P0; ++rep) { CA A = args_opaque(); p0_prologue(A, lds, wv); }
    SEAM(0);
    if (IN(1)) { CA A = args_opaque(); norm1_phase(A, wv); }
    SEAM(1);
    for (int layer = 0; layer < DEPTH; ++layer) {
        const int gb = 1 + 11 * layer;
        if (IN(gb + 1)) for (int rep = 0; rep < REP_IN; ++rep) { CA A = args_opaque();
            pg8::Gemm g{WSP(bf16, WS_H), WSP(bf16, WS_WIN) + (size_t)layer * NIN * DM, MP, NIN, DM, DM / 64, 0}; pg8::StaticOrder S; S.init(MP, NIN, G, blk_opaque());
            EpiIn E{WSP(float, WS_UF), WSP(bf16, WS_QKV), WSP(bf16, WS_GATE), A->out + O_KP + (size_t)layer * TP * 512, A->out + O_VP + (size_t)layer * TP * 512,
                    A->out + O_KS + (size_t)layer * TS * 512, A->out + O_VS + (size_t)layer * TS * 512, 0.08838834764831845f * LOG2E};
            pg8::gemm_phase<EpiIn, pg8::StaticOrder, true, true>(lds, g, S, E, wv);
        }
        SEAM(gb + 1);
        if (IN(gb + 2)) for (int rep = 0; rep < REP_PREP; ++rep) { CA A = args_opaque(); prep_phase(A, layer, wv); }
        SEAM(gb + 2);
        if (IN(gb + 3)) for (int rep = 0; rep < REP_MIXA; ++rep) { CA A = args_opaque();
            { unsigned* qh = (unsigned*)(A->ws + WS_CTL) + CW_QUEUE + 64 * (layer * 4 + 3) + 1024 * rep;
              for (;;) { const int u = queue_pop(qh, MISC + 4, wv); if (u >= 2048) break; ssd_prep_unit(A, lds, layer, u, wv); } }
            { unsigned* qh = (unsigned*)(A->ws + WS_CTL) + CW_QUEUE + 64 * (layer * 4 + 2) + 1024 * rep;
              for (;;) { const int u = queue_pop(qh, MISC + 4, wv); if (u >= 512) break; dn_chunk_unit(A, lds, layer, u, wv); } }
        }
        SEAM(gb + 3);
        if (IN(gb + 4)) for (int rep = 0; rep < REP_MIXB; ++rep) { CA A = args_opaque();
            for (int r2 = 0; r2 < REP_BDN; ++r2) for (int t = blk; t < 16; t += G) dn_seq2(A, lds, layer, t, wv);
            for (int r2 = 0; r2 < REP_BSSD; ++r2) for (int t = blk; t < 80; t += G) if (t >= 16) ssd_seq2(A, lds, layer, t - 16, wv);
            for (int t = blk; t < 112; t += G) if (t >= 80) dn_seq(A, lds, layer, t - 80 + 16, wv);
            for (int t = blk; t < 240; t += G) if (t >= 112) ssd_seq(A, lds, layer, t - 112 + 64, wv);
            { unsigned* qh = (unsigned*)(A->ws + WS_CTL) + CW_QUEUE + 64 * (layer * 4 + 0) + 1024 * rep;
              for (;;) { const int u = queue_pop(qh, MISC + 4, wv); if (u >= 128) break; attn_prompt_unit(A, lds, layer, u, wv); } }
            for (int r2 = 0; r2 < REP_BSATT; ++r2) { unsigned* qh = (unsigned*)(A->ws + WS_CTL) + CW_QUEUE + 64 * (layer * 4 + 1) + 1024 * rep + 2048 * r2;
              for (;;) { const int u = queue_pop(qh, MISC + 4, wv); if (u >= 256) break; attn_sample_unit(A, lds, layer, u, wv); } }
        }
        SEAM(gb + 4);
        if (IN(gb + 5)) { CA A = args_opaque(); attn_sample_combine(A, layer, wv);
            { unsigned* qh = (unsigned*)(A->ws + WS_CTL) + 16384 + 64 * layer;
              for (;;) { const int u = queue_pop(qh, MISC + 4, wv); if (u >= 512) break; dn_out_unit(A, lds, layer, u, wv); } } }
        SEAM(gb + 5);
        if (IN(gb + 6)) for (int rep = 0; rep < REP_MERGE; ++rep) { CA A = args_opaque();
            pg8::SegOrder<5> S; S.init(TP, DM, G, blk_opaque());
            pg8::Gemm g{WSP(bf16, WS_OBR), WSP(bf16, WS_WBR) + (size_t)layer * DM * OBW, TP, DM, OBW, 8, 1024};
            EpiMergeR E{WSP(bf16, WS_GATE), WSP(float, WS_RS), WSP(bf16, WS_MGB)};
            pg8::gemm_phase<EpiMergeR, pg8::SegOrder<5>, true, true>(lds, g, S, E, wv);
            sample_merge(A, lds, layer, wv);
        }
        SEAM(gb + 6);
        if (IN(gb + 7)) for (int rep = 0; rep < REP_OUT; ++rep) { CA A = args_opaque();
            pg8::Gemm g{WSP(bf16, WS_MGB), WSP(bf16, WS_WOUT) + (size_t)layer * DM * DM, TP, DM, DM, DM / 64, 0}; pg8::StaticOrder S; S.init(TP, DM, G, blk_opaque());
            EpiF32 E{WSP(float, WS_MIX), DM}; pg8::gemm_phase<EpiF32, pg8::StaticOrder, true, true>(lds, g, S, E, wv);
            { ALBf16 al{WSP(bf16, WS_MGB) + (size_t)TP * DM, DM}; sample_splitk(al, WSP(bf16, WS_WOUT) + (size_t)layer * DM * DM, DM, 128, 16, 4, WSP(float, WS_OUTS), DM, wv); }
        }
        SEAM(gb + 7);
        if (IN(gb + 8)) for (int rep = 0; rep < (layer == 0 ? REP_RES1L0 : 1); ++rep) { CA A = args_opaque(); resid_phase(A, WSP(float, WS_MIX), WSP(float, WS_OUTS), IN_F(I_NMPOST) + layer * DM, IN_F(I_NLPRE) + layer * DM, layer == 0, wv); }
        SEAM(gb + 8);
        if (IN(gb + 9)) for (int rep = 0; rep < REP_UP; ++rep) { CA A = args_opaque();
            pg8::Gemm g{WSP(bf16, WS_H), WSP(bf16, WS_WUP) + (size_t)layer * DFF * DM, TP, DFF, DM, DM / 64, 0}; pg8::StaticOrder S; S.init(TP, DFF, G, blk_opaque());
            EpiRelu2 E{WSP(bf16, WS_F), DFF}; pg8::gemm_phase<EpiRelu2, pg8::StaticOrder, true, true>(lds, g, S, E, wv);
            sample_up(A, lds, layer, wv);
        }
        SEAM(gb + 9);
        if (IN(gb + 10)) for (int rep = 0; rep < REP_DOWN; ++rep) { CA A = args_opaque();
            pg8::Gemm g{WSP(bf16, WS_F), WSP(bf16, WS_WDN) + (size_t)layer * DM * DFF, TP, DM, DFF, DFF / 64, 0}; pg8::StaticOrder S; S.init(TP, DM, G, blk_opaque());
            EpiF32 E{WSP(float, WS_FD), DM}; pg8::gemm_phase<EpiF32, pg8::StaticOrder, true, true>(lds, g, S, E, wv);
            { ALBf16 al{WSP(bf16, WS_F) + (size_t)TP * DFF, DFF}; sample_splitk(al, WSP(bf16, WS_WDN) + (size_t)layer * DM * DFF, DFF, 128, 16, 16, WSP(float, WS_DNS), DM, wv); }
        }
        SEAM(gb + 10);
        if (IN(gb + 11)) { CA A = args_opaque(); resid_phase(A, WSP(float, WS_FD), WSP(float, WS_DNS), IN_F(I_NLPOST) + layer * DM, layer + 1 < DEPTH ? IN_F(I_NMPRE) + (layer + 1) * DM : nullptr, false, wv); }
        SEAM(gb + 11);
    }
#undef IN
#undef SEAM
}

extern "C" void kernel_launch(void* const* d_in, const int* in_sizes, int n_in, void* d_out, int out_size, void* d_ws, size_t ws_size, hipStream_t stream) {
    static int grid = 0;
    if (grid == 0) {
        if (n_in != N_IN || (size_t)out_size != O_END || ws_size < WS_END) { fprintf(stderr, "kernel_launch: unexpected problem (n_in %d, out %d vs %zu, ws %zu vs %zu); nothing launched\n", n_in, out_size, (size_t)O_END, ws_size, (size_t)WS_END); grid = -1; return; }
        int dev = 0, cus = 0, per_cu = 0;
        if (hipGetDevice(&dev) != hipSuccess || hipDeviceGetAttribute(&cus, hipDeviceAttributeMultiprocessorCount, dev) != hipSuccess) { grid = -1; return; }
        if (hipFuncSetAttribute((const void*)mega, hipFuncAttributeMaxDynamicSharedMemorySize, LDS_BYTES) != hipSuccess) { fprintf(stderr, "kernel_launch: hipFuncSetAttribute failed\n"); grid = -1; return; }
        if (hipOccupancyMaxActiveBlocksPerMultiprocessor(&per_cu, (const void*)mega, NTHR, LDS_BYTES) != hipSuccess || per_cu < 1) fprintf(stderr, "kernel_launch: occupancy query says %d blocks per CU\n", per_cu);
        (void)hipGetLastError();
        grid = cus;
    }
    if (grid < 0) return;
    (void)in_sizes;
    hipMemsetAsync((char*)d_ws + WS_CTL, 0, CTL_BYTES, stream);
    Args a{};
    for (int i = 0; i < N_IN; ++i) a.in[i] = d_in[i];
    a.out = (float*)d_out; a.ws = (unsigned char*)d_ws; a.pad = 0;
#if MK_ONE_LAUNCH
    a.ph_lo = 0; a.ph_hi = N_PHASES; a.li = 0;
    hipLaunchKernelGGL(mega, dim3(grid), dim3(NTHR), LDS_BYTES, stream, a);
#else
    for (int gp = 0; gp < N_PHASES; ++gp) { a.ph_lo = gp; a.ph_hi = gp + 1; a.li = 0; hipLaunchKernelGGL(mega, dim3(grid), dim3(NTHR), LDS_BYTES, stream, a); }
#endif
}
```

```cpp
#include <hip/hip_runtime.h>
#include <cstdio>
#include <cstdint>
__device__ __forceinline__ int lane_opaque() { unsigned m = ~0u; asm volatile("" : "+s"(m)); return (int)__builtin_amdgcn_mbcnt_hi(m, __builtin_amdgcn_mbcnt_lo(m, 0u)); }
__device__ __forceinline__ int tid_opaque(int wv) { return wv * 64 + lane_opaque(); }
__device__ __forceinline__ int blk_opaque() { int t = blockIdx.x; asm volatile("" : "+s"(t)); return t; }
namespace pg8 {
#define PG8_LAS __attribute__((address_space(3)))
typedef unsigned short bf16_t;
typedef short bf16x8 __attribute__((ext_vector_type(8)));
typedef float f32x4 __attribute__((ext_vector_type(4)));
typedef unsigned u32x4 __attribute__((ext_vector_type(4)));
constexpr int BM = 256, BK = 64, HALF = 128, HTB = HALF * BK * 2  , STAGE_BYTES = 8 * HTB, NXCD = 8, WGM = 8;

__host__ __device__ __forceinline__ int lds_byte(int r, int c) { const int st = (r >> 4) * 2 + (c >> 5), rr = r & 15, cc = c & 31, ob = rr * 64 + cc * 2; return st * 1024 + (ob ^ (((ob >> 9) & 1) << 5)); }
__host__ __device__ __forceinline__ void stage_rc(int b, int& R, int& C) { const int st = b / 1024, sb = b % 1024, swz = sb ^ (((sb >> 9) & 1) << 5); R = (st >> 1) * 16 + swz / 64; C = (st & 1) * 32 + (swz % 64) / 2; }
__host__ __device__ __forceinline__ int perm32(int rho) { const int n = rho >> 4, i = rho & 15; return 8 * (i >> 2) + 4 * n + (i & 3); }

struct Unit { int pm, pn, seg; };
struct Gemm { const bf16_t* A; const bf16_t* Bt; int M, N, K, KT, SEGB; };

struct StaticOrder {
    int nM, nN, nwg, G, c;
    __host__ __device__ void init(int M, int N, int G_, int c_) { nM = M / BM; nN = N / BM; nwg = nM * nN; G = G_; c = c_; }
    __host__ __device__ bool next(int i, Unit& u) const {
        const long L = (long)i * G + c; if (L >= nwg) return false;
        int wgid = (int)L; { const int q = nwg / NXCD, r = nwg % NXCD, xcd = wgid % NXCD, off = wgid / NXCD; wgid = (xcd < r ? xcd * (q + 1) : r * (q + 1) + (xcd - r) * q) + off; }
        const int nig = WGM * nN, gid = wgid / nig, fm = gid * WGM, gsz = (nM - fm) < WGM ? (nM - fm) : WGM;
        u.pm = fm + ((wgid % nig) % gsz); u.pn = (wgid % nig) / gsz; u.seg = 0; return true;
    }
    __device__ __forceinline__ void a_ready(const Unit&) const {}
    __device__ __forceinline__ void done(const Unit&) const {}
};
template <int NSEG> struct SegOrder : StaticOrder {
    __host__ __device__ bool next(int i, Unit& u) const { if (!StaticOrder::next(i / NSEG, u)) return false; u.seg = i % NSEG; return true; }
};
__device__ __forceinline__ unsigned cvt_pk_bf16(float lo, float hi) { unsigned r; asm volatile("v_cvt_pk_bf16_f32 %0, %1, %2" : "=v"(r) : "v"(lo), "v"(hi)); return r; }
typedef float f32x2 __attribute__((ext_vector_type(2)));
template <class Epi, class Sched, bool ALIGN_EPI = false, bool SP2 = false>
__device__ __forceinline__ void gemm_phase(PG8_LAS unsigned char* lds, const Gemm g, const Sched& S, const Epi& E, const int wv) {
    int wvo = wv; asm volatile("" : "+s"(wvo));
    const int lane = lane_opaque(), tid = wvo * 64 + lane, wid = wvo, wr = wid >> 2, wc = wid & 3, fr = lane & 15, fq = lane >> 4;
    const int K = g.K, nt = g.KT;
    unsigned voffA[2], voffB[2];
#pragma unroll
    for (int i = 0; i < 2; ++i) { int R, C; stage_rc(tid * 16 + i * 8192, R, C); const int Rb = Epi::PERM ? ((R & ~31) + perm32(R & 31)) : R;
        voffA[i] = (unsigned)(R * K + C) * 2u; voffB[i] = (unsigned)(Rb * K + C) * 2u; }
    const size_t kstep = (size_t)(BK * 2);
    const size_t hstep = (size_t)HALF * K * 2;
    const size_t tstep = 2 * hstep;
    const unsigned ldsw = (unsigned)wid * 1024u;
    const int aoff = lds_byte(wr * 64 + fr, fq * 8), boff = lds_byte(wc * 32 + fr, fq * 8);
#define PG8_SA(b, h) (((b) * 2 + (h)) * HTB)
#define PG8_SB(b, h) ((4 + (b) * 2 + (h)) * HTB)
#define PG8_STAGE(bufoff, gbase, voff) do { _Pragma("unroll") for (int _i = 0; _i < 2; ++_i) \
        __builtin_amdgcn_global_load_lds((const unsigned*)((const char*)(gbase) + (voff)[_i]), (PG8_LAS unsigned*)(lds + (bufoff) + ldsw + _i * 8192), 16, 0, 0); } while (0)
#define PG8_LDA(dst, b, h) do { _Pragma("unroll") for (int m = 0; m < 4; ++m) _Pragma("unroll") for (int k = 0; k < 2; ++k) dst[m][k] = *(const PG8_LAS bf16x8*)(lds + PG8_SA(b, h) + aoff + m * 2048 + k * 1024); } while (0)
#define PG8_LDB(dst, b, h) do { _Pragma("unroll") for (int n = 0; n < 2; ++n) _Pragma("unroll") for (int k = 0; k < 2; ++k) dst[n][k] = *(const PG8_LAS bf16x8*)(lds + PG8_SB(b, h) + boff + n * 2048 + k * 1024); } while (0)
#define PG8_MMA(ai, bj, At, Bt) do { __builtin_amdgcn_s_setprio(1); _Pragma("unroll") for (int m = 0; m < 4; ++m) _Pragma("unroll") for (int n = 0; n < 2; ++n) _Pragma("unroll") for (int k = 0; k < 2; ++k) \
        acc[ai][bj][m][n] = __builtin_amdgcn_mfma_f32_16x16x32_bf16(Bt[n][k], At[m][k], acc[ai][bj][m][n], 0, 0, 0); __builtin_amdgcn_s_setprio(0); } while (0)
#define PG8_WAIT_V(n) asm volatile("s_waitcnt vmcnt(" #n ")" ::: "memory")
#define PG8_WAIT_L(n) asm volatile("s_waitcnt lgkmcnt(" #n ")" ::: "memory")
#define PG8_BAR __builtin_amdgcn_s_barrier()
#define PG8_SCHED __builtin_amdgcn_sched_barrier(0)
    Unit cur, nxt; int ui = 0;
    if (!S.next(0, cur)) return;
    f32x4 acc[2][2][4][2];
#pragma unroll
    for (int a = 0; a < 2; ++a)
#pragma unroll
        for (int b = 0; b < 2; ++b)
#pragma unroll
            for (int m = 0; m < 4; ++m)
#pragma unroll
                for (int n = 0; n < 2; ++n) acc[a][b][m][n] = (f32x4){0.f, 0.f, 0.f, 0.f};
    bf16x8 At[4][2], B0[2][2], B1[2][2];
    const char* cA = (const char*)g.A + (size_t)cur.pm * tstep + (size_t)cur.seg * g.SEGB; const char* cB = (const char*)g.Bt + (size_t)cur.pn * tstep + (size_t)cur.seg * g.SEGB;
    S.a_ready(cur);
    if constexpr (SP2) {
        PG8_STAGE(PG8_SB(0, 0), cB, voffB); PG8_STAGE(PG8_SB(0, 1), cB + hstep, voffB); PG8_STAGE(PG8_SA(0, 0), cA, voffA); PG8_STAGE(PG8_SA(0, 1), cA + hstep, voffA);
        if (wr == 1) PG8_BAR;
        PG8_WAIT_V(2); PG8_BAR;
        PG8_STAGE(PG8_SB(1, 0), cB + kstep, voffB); PG8_STAGE(PG8_SA(1, 0), cA + kstep, voffA); PG8_STAGE(PG8_SB(1, 1), cB + hstep + kstep, voffB);
        PG8_WAIT_V(6); PG8_BAR;
    } else {
        PG8_STAGE(PG8_SB(0, 0), cB, voffB); PG8_STAGE(PG8_SA(0, 0), cA, voffA); PG8_STAGE(PG8_SB(0, 1), cB + hstep, voffB); PG8_STAGE(PG8_SA(0, 1), cA + hstep, voffA);
        if (wr == 1) PG8_BAR;
        PG8_WAIT_V(4); PG8_BAR;
        PG8_STAGE(PG8_SB(1, 0), cB + kstep, voffB); PG8_STAGE(PG8_SA(1, 0), cA + kstep, voffA); PG8_STAGE(PG8_SB(1, 1), cB + hstep + kstep, voffB);
        PG8_WAIT_V(6); PG8_BAR;
    }
    for (;;) {
        const bool has_next = S.next(ui + 1, nxt);
        const char* nA = has_next ? (const char*)g.A + (size_t)nxt.pm * tstep + (size_t)nxt.seg * g.SEGB : cA; const char* nB = has_next ? (const char*)g.Bt + (size_t)nxt.pn * tstep + (size_t)nxt.seg * g.SEGB : cB;
        for (int t = 0; t < nt; t += 2) {
            const bool last = (t == nt - 2);
            const char* a1 = cA + (size_t)(t + 1) * kstep;
            const char* a2 = last ? nA : cA + (size_t)(t + 2) * kstep; const char* b2 = last ? nB : cB + (size_t)(t + 2) * kstep;
            const char* a3 = a2 + kstep; const char* b3 = b2 + kstep;
            if (last && has_next) S.a_ready(nxt);
            if constexpr (SP2) {
            PG8_LDB(B0, 0, 0); PG8_LDB(B1, 0, 1); PG8_SCHED; PG8_LDA(At, 0, 0); PG8_STAGE(PG8_SA(1, 1), a1 + hstep, voffA);
            PG8_WAIT_V(8); PG8_WAIT_L(0); PG8_BAR; PG8_MMA(0, 0, At, B0); PG8_MMA(0, 1, At, B1); PG8_BAR; PG8_SCHED;
            PG8_LDA(At, 0, 1); PG8_STAGE(PG8_SB(0, 0), b2, voffB); PG8_STAGE(PG8_SB(0, 1), b2 + hstep, voffB); PG8_STAGE(PG8_SA(0, 0), a2, voffA);
            PG8_WAIT_V(8); PG8_WAIT_L(0); PG8_BAR; PG8_MMA(1, 0, At, B0); PG8_MMA(1, 1, At, B1); PG8_BAR; PG8_SCHED;
            PG8_LDB(B0, 1, 0); PG8_LDB(B1, 1, 1); PG8_SCHED; PG8_LDA(At, 1, 0); PG8_STAGE(PG8_SA(0, 1), a2 + hstep, voffA);
            PG8_WAIT_V(8); PG8_WAIT_L(0); PG8_BAR; PG8_MMA(0, 0, At, B0); PG8_MMA(0, 1, At, B1); PG8_BAR; PG8_SCHED;
            PG8_LDA(At, 1, 1); PG8_STAGE(PG8_SB(1, 0), b3, voffB); PG8_STAGE(PG8_SB(1, 1), b3 + hstep, voffB); PG8_STAGE(PG8_SA(1, 0), a3, voffA);
            PG8_WAIT_V(8); PG8_WAIT_L(0); PG8_BAR; PG8_MMA(1, 0, At, B0); PG8_MMA(1, 1, At, B1); PG8_BAR; PG8_SCHED;
            } else {
            PG8_LDB(B0, 0, 0); PG8_SCHED; PG8_LDA(At, 0, 0); PG8_STAGE(PG8_SA(1, 1), a1 + hstep, voffA);
            PG8_WAIT_L(8); PG8_BAR; PG8_WAIT_L(0); PG8_MMA(0, 0, At, B0); PG8_BAR; PG8_SCHED;
            PG8_LDB(B1, 0, 1); PG8_STAGE(PG8_SB(0, 0), b2, voffB);
            PG8_BAR; PG8_WAIT_L(0); PG8_MMA(0, 1, At, B1); PG8_BAR;
            PG8_LDA(At, 0, 1); PG8_STAGE(PG8_SA(0, 0), a2, voffA);
            PG8_BAR; PG8_WAIT_L(0); PG8_MMA(1, 0, At, B0); PG8_BAR; PG8_SCHED;
            PG8_STAGE(PG8_SB(0, 1), b2 + hstep, voffB);
            PG8_WAIT_V(6); PG8_BAR; PG8_MMA(1, 1, At, B1); PG8_BAR;
            PG8_LDB(B0, 1, 0); PG8_SCHED; PG8_LDA(At, 1, 0); PG8_STAGE(PG8_SA(0, 1), a2 + hstep, voffA);
            PG8_WAIT_L(8); PG8_BAR; PG8_WAIT_L(0); PG8_MMA(0, 0, At, B0); PG8_BAR; PG8_SCHED;
            PG8_LDB(B1, 1, 1); PG8_STAGE(PG8_SB(1, 0), b3, voffB);
            PG8_BAR; PG8_WAIT_L(0); PG8_MMA(0, 1, At, B1); PG8_BAR;
            PG8_LDA(At, 1, 1); PG8_STAGE(PG8_SA(1, 0), a3, voffA);
            PG8_BAR; PG8_WAIT_L(0); PG8_MMA(1, 0, At, B0); PG8_BAR; PG8_SCHED;
            PG8_STAGE(PG8_SB(1, 1), b3 + hstep, voffB);
            PG8_WAIT_V(6); PG8_BAR; PG8_MMA(1, 1, At, B1); PG8_BAR;
            }
        }
        if constexpr (ALIGN_EPI) { if (wr == 0) PG8_BAR; }
        if constexpr (!Epi::AFTER_DRAIN) { E(acc, cur, wr, wc, fr, fq); S.done(cur); }
        if (!has_next) break;
        if (!(Epi::KEEP_ACC && nxt.seg != 0)) {
#pragma unroll
        for (int a = 0; a < 2; ++a)
#pragma unroll
            for (int b = 0; b < 2; ++b)
#pragma unroll
                for (int m = 0; m < 4; ++m)
#pragma unroll
                    for (int n = 0; n < 2; ++n) acc[a][b][m][n] = (f32x4){0.f, 0.f, 0.f, 0.f}; }
        cur = nxt; cA = nA; cB = nB; ++ui;
        if constexpr (ALIGN_EPI) { if (wr == 1) PG8_BAR; }
    }
    PG8_WAIT_V(0);
    if constexpr (!ALIGN_EPI) { if (wr == 0) PG8_BAR; }
    PG8_BAR;
    if constexpr (Epi::AFTER_DRAIN) { E.fused(acc, cur, wr, wc, fr, fq, lds, wid, lane); S.done(cur); }
#undef PG8_SA
#undef PG8_SB
#undef PG8_STAGE
#undef PG8_LDA
#undef PG8_LDB
#undef PG8_MMA
#undef PG8_WAIT_V
#undef PG8_WAIT_L
#undef PG8_BAR
#undef PG8_SCHED
}
}

constexpr int DM = 2048, NBATCH = 4, SEQ = 2048, DEPTH = 2, DBATCH = 8, DSEQ = 4, PAST = 16384, PAGE = 128;
constexpr int TP = NBATCH * SEQ;
constexpr int TS = DBATCH * DSEQ;
constexpr int TT = TP + TS;
constexpr int MP = 8448;
constexpr int NPAGES = PAST / PAGE;
constexpr int NPOOL = 1280;
constexpr int POOLW = 512, DNC = 1536, SBW = 512, SSI = 1024, SSC = 1536, DFF = 8192;
constexpr int INCOLS = 14872, NIN = 15104;
constexpr int OBW = 2560;
constexpr int UFW = 5376;
constexpr int UF_POOL = 0, UF_DNQKV = 512, UF_DNZ = 2048, UF_SSZ = 2560, UF_XBC = 3584, UF_SMALL = 5120;
constexpr float RMS_EPS = 1e-6f;
constexpr float LOG2E = 1.4426950408889634f;
constexpr int NWAVES = 8, NTHR = 512;

constexpr size_t O_Y = 0;
constexpr size_t O_KP = O_Y + (size_t)TT * DM;
constexpr size_t O_VP = O_KP + (size_t)DEPTH * TP * 512;
constexpr size_t O_POOLP = O_VP + (size_t)DEPTH * TP * 512;
constexpr size_t O_DNCP = O_POOLP + (size_t)DEPTH * NBATCH * 15 * 512;
constexpr size_t O_DNSP = O_DNCP + (size_t)DEPTH * NBATCH * 3 * 1536;
constexpr size_t O_SSCP = O_DNSP + (size_t)DEPTH * NBATCH * 4 * 128 * 128;
constexpr size_t O_SSHP = O_SSCP + (size_t)DEPTH * NBATCH * 3 * 1536;
constexpr size_t O_KS = O_SSHP + (size_t)DEPTH * NBATCH * 16 * 64 * 128;
constexpr size_t O_VS = O_KS + (size_t)DEPTH * TS * 512;
constexpr size_t O_POOLS = O_VS + (size_t)DEPTH * TS * 512;
constexpr size_t O_DNCS = O_POOLS + (size_t)DEPTH * DBATCH * 15 * 512;
constexpr size_t O_DNSS = O_DNCS + (size_t)DEPTH * DBATCH * 3 * 1536;
constexpr size_t O_SSCS = O_DNSS + (size_t)DEPTH * DBATCH * 4 * 128 * 128;
constexpr size_t O_SSHS = O_SSCS + (size_t)DEPTH * DBATCH * 3 * 1536;
constexpr size_t O_END = O_SSHS + (size_t)DEPTH * DBATCH * 16 * 64 * 128;

constexpr size_t al256(size_t x) { return (x + 255) & ~(size_t)255; }
constexpr size_t WS_CTL = 0, CTL_BYTES = 1u << 20;
constexpr size_t SZ_WIN = (size_t)NIN * DM * 2, SZ_WBR = (size_t)5 * DM * 512 * 2, SZ_WOUT = (size_t)DM * DM * 2, SZ_WUP = (size_t)DFF * DM * 2, SZ_WDN = (size_t)DM * DFF * 2;
constexpr size_t WS_WIN = WS_CTL + CTL_BYTES;
constexpr size_t WS_WBR = WS_WIN + 2 * SZ_WIN;
constexpr size_t WS_WOUT = WS_WBR + 2 * SZ_WBR;
constexpr size_t WS_WUP = WS_WOUT + 2 * SZ_WOUT;
constexpr size_t WS_WDN = WS_WUP + 2 * SZ_WUP;
constexpr size_t WS_H = WS_WDN + 2 * SZ_WDN;
constexpr size_t WS_UF = WS_H + (size_t)MP * DM * 2;
constexpr size_t WS_QKV = WS_UF + (size_t)MP * UFW * 4;
constexpr size_t WS_GATE = WS_QKV + (size_t)MP * 1536 * 2;
constexpr size_t WS_DNQ = WS_GATE + (size_t)MP * 8192 * 2;
constexpr size_t WS_XBC = WS_DNQ + (size_t)MP * 1536 * 4;
constexpr size_t WS_SCAL = WS_XBC + (size_t)MP * 1536 * 4;
constexpr size_t WS_OBR = WS_SCAL + (size_t)MP * 32 * 4;
constexpr size_t SZ_OBR = (size_t)MP * 512 * 2;
constexpr size_t WS_SSQ = WS_OBR + 5 * SZ_OBR;
constexpr size_t WS_MG32 = WS_SSQ + (size_t)MP * 32 * 4;
constexpr size_t WS_MGB = WS_MG32 + (size_t)MP * DM * 4;
constexpr size_t WS_MIX = WS_MGB + (size_t)MP * DM * 2;
constexpr size_t WS_F = WS_MIX + (size_t)MP * DM * 4;
constexpr size_t WS_FD = WS_F + (size_t)MP * DFF * 2;
constexpr size_t WS_PART = WS_FD + (size_t)MP * DM * 4;
constexpr size_t WS_PR = WS_PART + (size_t)256 * 2048 * 4;
constexpr size_t WS_DNU = WS_PR + (size_t)256 * 16 * 4;
constexpr size_t WS_SSU = WS_DNU + (size_t)512 * 90368;
constexpr size_t WS_SSG = WS_SSU + (size_t)2048 * 16896;
constexpr size_t WS_MGS = WS_SSG + (size_t)256 * 49152;
constexpr size_t WS_OUTS = WS_MGS + (size_t)5 * TS * DM * 4;
constexpr size_t WS_UPS = WS_OUTS + (size_t)16 * TS * DM * 4;
constexpr size_t WS_DNS = WS_UPS + (size_t)4 * TS * DFF * 4;
constexpr size_t WS_RS = WS_DNS + (size_t)16 * TS * DM * 4;
constexpr size_t WS_DNSV = WS_RS + (size_t)MP * 2 * 4;
constexpr size_t WS_END = WS_DNSV + (size_t)512 * 49152;
static_assert(WS_WIN % 256 == 0 && WS_H % 256 == 0 && WS_UF % 256 == 0 && WS_OBR % 256 == 0 && WS_MG32 % 256 == 0 && WS_PART % 256 == 0, "ws alignment");

constexpr int CW_QUEUE = 64;
constexpr int CW_BAR = 4096;

constexpr int LDS_BYTES = 147456;
constexpr int RING_BYTES = 131072;
constexpr int MISC_OFF = RING_BYTES;

#define GAS __attribute__((address_space(1)))
#define LAS __attribute__((address_space(3)))
typedef unsigned short bf16;
typedef unsigned v4u __attribute__((ext_vector_type(4)));
typedef unsigned v2u __attribute__((ext_vector_type(2)));
typedef float f32x4 __attribute__((ext_vector_type(4)));
typedef float f32x2 __attribute__((ext_vector_type(2)));
typedef float f32x16 __attribute__((ext_vector_type(16)));
typedef short bf16x8 __attribute__((ext_vector_type(8)));
typedef __bf16 bf16x2_t __attribute__((ext_vector_type(2)));
__device__ __forceinline__ unsigned pk2(float lo, float hi) { const f32x2 v = {lo, hi}; return __builtin_bit_cast(unsigned, __builtin_convertvector(v, bf16x2_t)); }
__device__ __forceinline__ unsigned f2bf(float f) { return pk2(f, f) & 0xffffu; }
__device__ __forceinline__ float bflo(unsigned w) { return __builtin_bit_cast(float, w << 16); }
__device__ __forceinline__ float bfhi(unsigned w) { return __builtin_bit_cast(float, w & 0xffff0000u); }
__device__ __forceinline__ float row16_sum(float x) {
    x += __builtin_bit_cast(float, __builtin_amdgcn_update_dpp(0, __builtin_bit_cast(int, x), 0x128, 0xf, 0xf, false));
    x += __builtin_bit_cast(float, __builtin_amdgcn_update_dpp(0, __builtin_bit_cast(int, x), 0x124, 0xf, 0xf, false));
    x += __builtin_bit_cast(float, __builtin_amdgcn_update_dpp(0, __builtin_bit_cast(int, x), 0x122, 0xf, 0xf, false));
    x += __builtin_bit_cast(float, __builtin_amdgcn_update_dpp(0, __builtin_bit_cast(int, x), 0x121, 0xf, 0xf, false));
    return x;
}
__device__ __forceinline__ float rdlane(float x, int l) { return __builtin_bit_cast(float, __builtin_amdgcn_readlane(__builtin_bit_cast(int, x), l)); }
__device__ __forceinline__ float wave_sum(float v) { const float r = row16_sum(v); return (rdlane(r, 0) + rdlane(r, 16)) + (rdlane(r, 32) + rdlane(r, 48)); }
__device__ __forceinline__ float wave_scan(float x, int lane) {
    x += __builtin_bit_cast(float, __builtin_amdgcn_update_dpp(0, __builtin_bit_cast(int, x), 0x111, 0xf, 0xf, true));
    x += __builtin_bit_cast(float, __builtin_amdgcn_update_dpp(0, __builtin_bit_cast(int, x), 0x112, 0xf, 0xf, true));
    x += __builtin_bit_cast(float, __builtin_amdgcn_update_dpp(0, __builtin_bit_cast(int, x), 0x114, 0xf, 0xf, true));
    x += __builtin_bit_cast(float, __builtin_amdgcn_update_dpp(0, __builtin_bit_cast(int, x), 0x118, 0xf, 0xf, true));
    const float t0 = rdlane(x, 15), t1 = rdlane(x, 31), t2 = rdlane(x, 47);
    return x + (lane >= 48 ? (t0 + t1) + t2 : (lane >= 32 ? t0 + t1 : (lane >= 16 ? t0 : 0.f)));
}
__device__ __forceinline__ float fexp(float x) { return __builtin_amdgcn_exp2f(x * 1.4426950408889634f); }
__device__ __forceinline__ float sigmoidf_(float x) { return 1.0f / (1.0f + __expf(-x)); }
__device__ __forceinline__ float siluf_(float x) { return x / (1.0f + __expf(-x)); }
__device__ __forceinline__ float softplusf_(float x) { const float e = fexp(fminf(x, 20.f)); const float l = e < 0.01f ? e * (1.0f - e * (0.5f - e * 0.33333333f)) : __builtin_amdgcn_logf(1.0f + e) * 0.6931471805599453f; return x > 20.f ? x : l; }
__device__ __forceinline__ float ex2(float x) { return __builtin_amdgcn_exp2f(x); }
__device__ __forceinline__ float lg2(float x) { return __builtin_amdgcn_logf(x); }
#define XB_TMO      128
#define XB_XCNT(j)  (256  + 64 * (j))
#define XB_XSUB(j)  (1280 + 64 * (j))
#define XB_XGEN(j)  (2304 + 64 * (j))
#define XB_TOP      3328
#define XB_TOPGEN   3392
#define XCD_BAR_WORDS 3456
#define XB_SPIN_CAP (1u << 18)

__device__ __forceinline__ unsigned xb_ld(unsigned* p)              { return __hip_atomic_load(p, __ATOMIC_RELAXED, __HIP_MEMORY_SCOPE_AGENT); }
__device__ __forceinline__ unsigned xb_add(unsigned* p, unsigned v) { return __hip_atomic_fetch_add(p, v, __ATOMIC_RELAXED, __HIP_MEMORY_SCOPE_AGENT); }
__device__ __forceinline__ unsigned xb_xcc_id() { return (unsigned)__builtin_amdgcn_s_getreg((3 << 11) | 20) & 0xFu; }
#define XB_SPIN(cond, bar) do { unsigned _sp = 0; while (cond) { __builtin_amdgcn_s_sleep(1); \
    if ((++_sp & 255u) == 0u) { if (xb_ld(&(bar)[XB_TMO])) break; if (_sp > XB_SPIN_CAP) { atomicAdd(&(bar)[XB_TMO], 1u); break; } } } } while (0)

struct XcdBarrier {
    unsigned* bar; unsigned x;
    volatile LAS unsigned* st;
};

__device__ __forceinline__ XcdBarrier xcd_barrier_post(unsigned* bar, volatile LAS unsigned* st, const int tid) {
    XcdBarrier b; b.bar = bar; b.x = xb_xcc_id(); b.st = st;
    if (tid == 0) (void)xb_add(&bar[XB_XCNT(b.x)], 1u);
    return b;
}
__device__ __forceinline__ void xcd_barrier_complete(unsigned* bar, unsigned x, unsigned& nloc, unsigned& nx) {
    const unsigned G = gridDim.x * gridDim.y * gridDim.z;
    unsigned sum, cnt, mine, sp = 0u;
    for (;;) {
        sum = 0u; cnt = 0u; mine = 0u;
#pragma unroll
        for (unsigned j = 0; j < 16; ++j) { const unsigned c = xb_ld(&bar[XB_XCNT(j)]); sum += c; cnt += (c > 0u) ? 1u : 0u; mine = (j == x) ? c : mine; }
        if (sum == G) break;
        __builtin_amdgcn_s_sleep(1);
        if ((++sp & 255u) == 0u) { if (xb_ld(&bar[XB_TMO])) break; if (sp > XB_SPIN_CAP) { atomicAdd(&bar[XB_TMO], 1u); break; } }
    }
    nloc = mine > 0u ? mine : 1u; nx = cnt > 0u ? cnt : 1u;
}

__device__ __forceinline__ void xcd_barrier(const XcdBarrier& b, const int tid) {
    asm volatile("s_waitcnt vmcnt(0)" ::: "memory");
    __syncthreads();
    if (tid == 0) {
        unsigned* bar = b.bar;
        __builtin_amdgcn_s_waitcnt(0);
        unsigned nloc = b.st[0], nx = b.st[1];
        if (nloc == 0u) { xcd_barrier_complete(bar, b.x, nloc, nx); b.st[0] = nloc; b.st[1] = nx; }
        const unsigned old = xb_add(&bar[XB_XSUB(b.x)], 1u);
        const unsigned gen = old / nloc;
        if (old + 1u == (gen + 1u) * nloc) {
            __builtin_amdgcn_fence(__ATOMIC_RELEASE, "agent");
            asm volatile("s_waitcnt vmcnt(0)" ::: "memory");
            const unsigned og = xb_add(&bar[XB_TOP], 1u);
            const unsigned tg = og / nx;
            if (og + 1u == (tg + 1u) * nx) xb_add(&bar[XB_TOPGEN], 1u);
            else XB_SPIN(xb_ld(&bar[XB_TOPGEN]) == tg, bar);
            __builtin_amdgcn_fence(__ATOMIC_ACQUIRE, "agent");
            xb_add(&bar[XB_XGEN(b.x)], 1u);
            asm volatile("s_waitcnt vmcnt(0)" ::: "memory");
        } else {
            XB_SPIN(xb_ld(&bar[XB_XGEN(b.x)]) == gen, bar);
            __builtin_amdgcn_fence(__ATOMIC_ACQUIRE, "agent");
            asm volatile("s_waitcnt vmcnt(0)" ::: "memory");
        }
    }
    __syncthreads();
}

enum { I_XP = 0, I_XS, I_CK, I_CV, I_SPOOL, I_SDNC, I_SDNS, I_SSSC, I_SSSH, I_PT, I_NMPRE, I_NMPOST, I_NLPRE, I_NLPOST, I_WIN, I_POOLW, I_POOLSC, I_DNCW, I_DNALOG, I_DNDTB, I_DNNW, I_SBBIAS,
       I_SSCW, I_SSCB, I_SSALOG, I_SSDTB, I_SSD, I_SSNW, I_WBR, I_WOUT, I_WUP, I_WDN, N_IN };
struct Args { const void* in[N_IN]; float* out; unsigned char* ws; int ph_lo, ph_hi, li, pad; };
#define IN_F(i) ((const float*)A->in[i])
#define WSP(T, off) ((T*)(A->ws + (off)))
typedef const __attribute__((opencl_constant)) Args* CA;
__device__ __forceinline__ CA args_opaque() { auto p = __builtin_amdgcn_kernarg_segment_ptr(); asm volatile("" : "+s"(p)); return (CA)p; }

struct EpiIn {
    static constexpr bool PERM = true, AFTER_DRAIN = false, KEEP_ACC = false;
    float* UF; bf16* QKV; bf16* GATE; float *kp, *vp, *ks, *vs; float qscale;
    __device__ __forceinline__ void operator()(f32x4 (&acc)[2][2][4][2], const pg8::Unit& u, int wr, int wc, int fr, int fq) const {
        const int pn = u.pn, row0 = u.pm * 256 + wr * 64 + fr, cl = wc * 32 + 8 * fq;
        if (pn < 10 || (pn >= 16 && pn < 26) || pn == 58) {
            const int col0 = pn * 256 + (pn < 10 ? 0 : (pn < 26 ? -1536 : -9728)) + cl;
#pragma unroll
            for (int ai = 0; ai < 2; ++ai)
#pragma unroll
                for (int m = 0; m < 4; ++m) { float* rowp = UF + (size_t)(row0 + ai * 128 + m * 16) * UFW + col0;
#pragma unroll
                    for (int bj = 0; bj < 2; ++bj) { *(f32x4*)(rowp + bj * 128) = acc[ai][bj][m][0]; *(f32x4*)(rowp + bj * 128 + 4) = acc[ai][bj][m][1]; } }
        } else if (pn < 16) {
            const int which = (pn - 10) >> 1, c512 = ((pn - 10) & 1) * 256 + cl; const float sc = which == 0 ? qscale : 1.f;
#pragma unroll
            for (int ai = 0; ai < 2; ++ai)
#pragma unroll
                for (int m = 0; m < 4; ++m) { const int r = row0 + ai * 128 + m * 16; bf16* rowp = QKV + (size_t)r * 1536 + which * 512 + c512;
                    float* fo = nullptr;
                    if (which) { if (r < TP) fo = (which == 1 ? kp : vp) + (size_t)r * 512 + c512; else if (r < TT) fo = (which == 1 ? ks : vs) + (size_t)(r - TP) * 512 + c512; }
#pragma unroll
                    for (int bj = 0; bj < 2; ++bj) { const f32x4 v0 = acc[ai][bj][m][0], v1 = acc[ai][bj][m][1];
                        v4u w; w.x = pk2(v0[0] * sc, v0[1] * sc); w.y = pk2(v0[2] * sc, v0[3] * sc); w.z = pk2(v1[0] * sc, v1[1] * sc); w.w = pk2(v1[2] * sc, v1[3] * sc);
                        *(v4u*)(rowp + bj * 128) = w;
                        if (fo) { *(f32x4*)(fo + bj * 128) = v0; *(f32x4*)(fo + bj * 128 + 4) = v1; } } }
        } else {
            const int oc = (pn - 26) * 64 + wc * 16 + 4 * fq;
#pragma unroll
            for (int ai = 0; ai < 2; ++ai)
#pragma unroll
                for (int m = 0; m < 4; ++m) { const int r = row0 + ai * 128 + m * 16; bf16* rowp = GATE + (size_t)r * 8192 + oc;
                    f32x4 t[4];
#pragma unroll
                    for (int i = 0; i < 4; ++i)
#pragma unroll
                        for (int e = 0; e < 4; ++e) t[i][e] = 1.0f + fexp(-fminf(fmaxf(acc[ai][i >> 1][m][i & 1][e], -30.f), 30.f));
                    f32x4 o[4];
                    if (r < TP) {
#pragma unroll
                        for (int e = 0; e < 4; ++e) { const float i0 = __builtin_amdgcn_rcpf(t[0][e]), i1 = __builtin_amdgcn_rcpf(t[1][e]), i2 = __builtin_amdgcn_rcpf(t[2][e]), i3 = __builtin_amdgcn_rcpf(t[3][e]);
                            o[0][e] = t[1][e] * i0; o[1][e] = t[2][e] * i1; o[2][e] = t[3][e] * i2; o[3][e] = i3; }
                    } else {
#pragma unroll
                        for (int i = 0; i < 4; ++i)
#pragma unroll
                            for (int e = 0; e < 4; ++e) o[i][e] = __builtin_amdgcn_rcpf(t[i][e]);
                    }
#pragma unroll
                    for (int i = 0; i < 4; ++i) { v2u w; w.x = pk2(o[i][0], o[i][1]); w.y = pk2(o[i][2], o[i][3]); *(v2u*)(rowp + i * 2048) = w; } }
        }
    }
};
struct EpiMergeR {
    static constexpr bool PERM = true, AFTER_DRAIN = false, KEEP_ACC = true;
    const bf16* GATE; const float* RS; bf16* MGB;
    __device__ __forceinline__ void operator()(f32x4 (&acc)[2][2][4][2], const pg8::Unit& u, int wr, int wc, int fr, int fq) const {
        const unsigned row0 = (unsigned)(u.pm * 256 + wr * 64 + fr), col0 = (unsigned)(u.pn * 256 + wc * 32 + 8 * fq); const int seg = u.seg;
        const unsigned gofs = row0 * 8192u + (seg < 3 ? seg : 3) * 2048u + col0, oofs = row0 * 2048u + col0; const bool last = seg == 4;
        const float w2 = seg == 2 ? 1.f : 0.f, w3 = seg == 3 ? 1.f : 0.f, w4 = last ? 1.f : 0.f, w0 = 1.f - w2 - w3 - w4, ug = 1.f - w3;
#pragma unroll
        for (int ai = 0; ai < 2; ++ai)
#pragma unroll
            for (int m = 0; m < 4; ++m) { const unsigned rr = ai * 128 + m * 16; const f32x2 qq = *(const f32x2*)(RS + (row0 + rr) * 2u);
                const float r1 = __builtin_amdgcn_rsqf(qq[1]), rf = w0 + w2 * __builtin_amdgcn_sqrtf(qq[0]) + w3 * (__builtin_amdgcn_sqrtf(qq[1]) * __builtin_amdgcn_rsqf(qq[0])) + w4 * r1, rg = rf * ug, rc = rf * w3;
#pragma unroll
                for (int bj = 0; bj < 2; ++bj) { const v4u gg = *(const v4u*)(GATE + (gofs + rr * 8192u + bj * 128u));
                    f32x4& v0 = acc[ai][bj][m][0]; f32x4& v1 = acc[ai][bj][m][1];
                    v0[0] *= bflo(gg.x) * rg + rc; v0[1] *= bfhi(gg.x) * rg + rc; v0[2] *= bflo(gg.y) * rg + rc; v0[3] *= bfhi(gg.y) * rg + rc;
                    v1[0] *= bflo(gg.z) * rg + rc; v1[1] *= bfhi(gg.z) * rg + rc; v1[2] *= bflo(gg.w) * rg + rc; v1[3] *= bfhi(gg.w) * rg + rc;
                    if (last) { v4u w; w.x = pk2(v0[0], v0[1]); w.y = pk2(v0[2], v0[3]); w.z = pk2(v1[0], v1[1]); w.w = pk2(v1[2], v1[3]); *(v4u*)(MGB + (oofs + rr * 2048u + bj * 128u)) = w; } }
                asm volatile("" ::: "memory"); }
    }
};
struct EpiF32 {
    static constexpr bool PERM = true, AFTER_DRAIN = false, KEEP_ACC = false;
    float* C; int ldc;
    __device__ __forceinline__ void operator()(f32x4 (&acc)[2][2][4][2], const pg8::Unit& u, int wr, int wc, int fr, int fq) const {
        const int row0 = u.pm * 256 + wr * 64 + fr, col0 = u.pn * 256 + wc * 32 + 8 * fq;
#pragma unroll
        for (int ai = 0; ai < 2; ++ai)
#pragma unroll
            for (int m = 0; m < 4; ++m) { float* rowp = C + (size_t)(row0 + ai * 128 + m * 16) * ldc + col0;
#pragma unroll
                for (int bj = 0; bj < 2; ++bj) { *(f32x4*)(rowp + bj * 128) = acc[ai][bj][m][0]; *(f32x4*)(rowp + bj * 128 + 4) = acc[ai][bj][m][1]; } }
    }
};
struct EpiRelu2 {
    static constexpr bool PERM = true, AFTER_DRAIN = false, KEEP_ACC = false;
    bf16* O; int ldc;
    __device__ __forceinline__ void operator()(f32x4 (&acc)[2][2][4][2], const pg8::Unit& u, int wr, int wc, int fr, int fq) const {
        const int row0 = u.pm * 256 + wr * 64 + fr, col0 = u.pn * 256 + wc * 32 + 8 * fq;
#pragma unroll
        for (int ai = 0; ai < 2; ++ai)
#pragma unroll
            for (int m = 0; m < 4; ++m) { bf16* rowp = O + (size_t)(row0 + ai * 128 + m * 16) * ldc + col0;
#pragma unroll
                for (int bj = 0; bj < 2; ++bj) { f32x4 v0 = acc[ai][bj][m][0], v1 = acc[ai][bj][m][1];
#pragma unroll
                    for (int e = 0; e < 4; ++e) { const float a = fmaxf(v0[e], 0.f), b = fmaxf(v1[e], 0.f); v0[e] = a * a; v1[e] = b * b; }
                    v4u w; w.x = pk2(v0[0], v0[1]); w.y = pk2(v0[2], v0[3]); w.z = pk2(v1[0], v1[1]); w.w = pk2(v1[2], v1[3]); *(v4u*)(rowp + bj * 128) = w; } }
    }
};

__device__ __forceinline__ int win_src_col(int n) {
    if (n < 2560) return n;
    if (n < 6656) return n + 8;
    if (n < 14848) { const int t = n - 6656, pg = t >> 8, c = t & 255;
        return 6680 + (2 * (c >> 7) + ((c >> 2) & 1)) * 2048 + 64 * pg + 16 * ((c >> 5) & 3) + 4 * ((c >> 3) & 3) + (c & 3); }
    if (n < 14856) return n - 14848 + 2560;
    if (n < 14872) return n - 14856 + 6664;
    return -1;
}
template <int MODE>
__device__ __forceinline__ void transpose_item(const float* W, int ldw, int K, bf16* WT, int n0, int k0, const float* kscale, LAS unsigned* scr, int lane) {
    const int n = n0 + lane; const int sc = MODE ? win_src_col(n) : n;
#pragma unroll 8
    for (int i = 0; i < 32; ++i) { float a = 0.f, b = 0.f;
        if (sc >= 0) { a = W[(size_t)(k0 + 2 * i) * ldw + sc]; b = W[(size_t)(k0 + 2 * i + 1) * ldw + sc]; }
        if (kscale) { a *= kscale[k0 + 2 * i]; b *= kscale[k0 + 2 * i + 1]; }
        scr[i * 65 + lane] = pk2(a, b); }
    asm volatile("s_waitcnt lgkmcnt(0)" ::: "memory");
    const int part = lane & 3;
#pragma unroll
    for (int j = 0; j < 4; ++j) { const int nn = (lane >> 2) + 16 * j; const LAS unsigned* s = scr + (8 * part) * 65 + nn;
        v4u o0, o1; o0.x = s[0]; o0.y = s[65]; o0.z = s[130]; o0.w = s[195]; o1.x = s[260]; o1.y = s[325]; o1.z = s[390]; o1.w = s[455];
        v4u* dst = (v4u*)(WT + (size_t)(n0 + nn) * K + k0 + 16 * part); dst[0] = o0; dst[1] = o1; }
    asm volatile("s_waitcnt lgkmcnt(0)" ::: "memory");
}
__device__ __forceinline__ void p0_prologue(CA A, LAS unsigned char* lds, const int wv) {
    const int tid = tid_opaque(wv), lane = tid & 63, wave = tid >> 6, G = gridDim.x;
    LAS unsigned* scr = (LAS unsigned*)(lds + wave * 8320);
    const int gw = blk_opaque() * NWAVES + wave, NGW = G * NWAVES;
    constexpr int I_IN = (NIN / 64) * (DM / 64), I_BR = (DM / 64) * (512 / 64), I_OUT = (DM / 64) * (DM / 64), I_UP = (DFF / 64) * (DM / 64), I_DN = (DM / 64) * (DFF / 64);
    constexpr int PER_LAYER = I_IN + 4 * I_BR + I_OUT + I_UP + I_DN;
    for (int it = gw; it < 2 * PER_LAYER; it += NGW) {
        const int L = it / PER_LAYER; int r = it % PER_LAYER;
        if (r < I_IN) { const int nb = r % (NIN / 64), kb = r / (NIN / 64);
            transpose_item<1>(IN_F(I_WIN) + (size_t)L * DM * INCOLS, INCOLS, DM, WSP(bf16, WS_WIN) + (size_t)L * NIN * DM, nb * 64, kb * 64, nullptr, scr, lane); continue; }
        r -= I_IN;
        if (r < 4 * I_BR) { const int s = 1 + r / I_BR, q = r % I_BR, nb = q % (DM / 64), kb = q / (DM / 64);
            transpose_item<0>(IN_F(I_WBR) + ((size_t)L * 2560 + 512 * s) * DM, DM, OBW, WSP(bf16, WS_WBR) + (size_t)L * DM * OBW + 512 * s, nb * 64, kb * 64,
                              s >= 3 ? IN_F(I_SSNW) + L * 1024 + (s - 3) * 512 : nullptr, scr, lane); continue; }
        r -= 4 * I_BR;
        if (r < I_OUT) { const int nb = r % (DM / 64), kb = r / (DM / 64);
            transpose_item<0>(IN_F(I_WOUT) + (size_t)L * DM * DM, DM, DM, WSP(bf16, WS_WOUT) + (size_t)L * DM * DM, nb * 64, kb * 64, nullptr, scr, lane); continue; }
        r -= I_OUT;
        if (r < I_UP) { const int nb = r % (DFF / 64), kb = r / (DFF / 64);
            transpose_item<0>(IN_F(I_WUP) + (size_t)L * DM * DFF, DFF, DM, WSP(bf16, WS_WUP) + (size_t)L * DFF * DM, nb * 64, kb * 64, nullptr, scr, lane); continue; }
        r -= I_UP;
        { const int nb = r % (DM / 64), kb = r / (DM / 64);
            transpose_item<0>(IN_F(I_WDN) + (size_t)L * DFF * DM, DM, DFF, WSP(bf16, WS_WDN) + (size_t)L * DM * DFF, nb * 64, kb * 64, nullptr, scr, lane); }
    }
    for (int idx = blk_opaque() * NTHR + tid; idx < 2 * DM * 64; idx += G * NTHR) {
        const int L = idx / (DM * 64), q = idx % (DM * 64), n = q & (DM - 1), kc = q >> 11, k0 = kc * 8, g = k0 >> 7, c0 = k0 & 127;
        const float* pw = IN_F(I_POOLW) + ((size_t)(L * 4 + g) * 128 + c0) * 128; const float* psc = IN_F(I_POOLSC) + L * 512 + g * 128;
        const float* wb = IN_F(I_WBR) + ((size_t)L * 2560 + g * 128) * DM + n;
        float acc[8] = {0.f, 0.f, 0.f, 0.f, 0.f, 0.f, 0.f, 0.f};
        for (int d = 0; d < 128; ++d) { const float wv = wb[(size_t)d * DM] * psc[d];
#pragma unroll
            for (int i = 0; i < 8; ++i) acc[i] += pw[i * 128 + d] * wv; }
        v4u o; o.x = pk2(acc[0], acc[1]); o.y = pk2(acc[2], acc[3]); o.z = pk2(acc[4], acc[5]); o.w = pk2(acc[6], acc[7]);
        *(v4u*)(WSP(bf16, WS_WBR) + (size_t)L * DM * OBW + (size_t)n * OBW + k0) = o;
    }
}

__device__ __forceinline__ const float* xin_row(CA A, int m) { return m < TP ? IN_F(I_XP) + (size_t)m * DM : IN_F(I_XS) + (size_t)(m - TP) * DM; }
__device__ __forceinline__ void store_bf16_row(bf16* orow, const f32x4 (&v)[8], float rstd, const float* g, int lane) {
#pragma unroll
    for (int j = 0; j < 8; ++j) { const f32x4 gj = ((const f32x4*)g)[lane + 64 * j]; const f32x4 o = v[j] * rstd * gj;
        v2u w; w.x = pk2(o[0], o[1]); w.y = pk2(o[2], o[3]); ((v2u*)orow)[lane + 64 * j] = w; }
}
__device__ __forceinline__ void norm1_phase(CA A, const int wv) {
    const int tid = tid_opaque(wv), lane = tid & 63, gw = blk_opaque() * NWAVES + (tid >> 6), NGW = gridDim.x * NWAVES;
    bf16* H = WSP(bf16, WS_H);
    for (int m = gw; m < MP; m += NGW) {
        if (m >= TT) { for (int j = 0; j < 8; ++j) ((v2u*)(H + (size_t)m * DM))[lane + 64 * j] = (v2u){0u, 0u}; continue; }
        const f32x4* xr = (const f32x4*)xin_row(A, m); f32x4 v[8]; float s = 0.f;
#pragma unroll
        for (int j = 0; j < 8; ++j) { v[j] = xr[lane + 64 * j]; s += (v[j][0] * v[j][0] + v[j][1] * v[j][1]) + (v[j][2] * v[j][2] + v[j][3] * v[j][3]); }
        const float rstd = 1.0f / sqrtf(wave_sum(s) * (1.0f / DM) + RMS_EPS);
        store_bf16_row(H + (size_t)m * DM, v, rstd, IN_F(I_NMPRE), lane);
    }
}
__device__ __forceinline__ void resid_load(CA A, const float* Y, const float* PS, bool from_input, int m, int lane, f32x4 (&v)[8], f32x4 (&x)[8]) {
    const f32x4* xr = from_input ? (const f32x4*)xin_row(A, m) : (const f32x4*)(A->out + O_Y + (size_t)m * DM);
#pragma unroll
    for (int j = 0; j < 8; ++j) x[j] = xr[lane + 64 * j];
    if (m < TP) { const f32x4* yr = (const f32x4*)(Y + (size_t)m * DM);
#pragma unroll
        for (int j = 0; j < 8; ++j) v[j] = yr[lane + 64 * j];
    } else {
#pragma unroll
        for (int j = 0; j < 8; ++j) v[j] = (f32x4){0.f, 0.f, 0.f, 0.f};
        for (int sp = 0; sp < 16; ++sp) { const f32x4* pr = (const f32x4*)(PS + ((size_t)sp * TS + (m - TP)) * DM);
#pragma unroll
            for (int j = 0; j < 8; ++j) v[j] += pr[lane + 64 * j]; }
    }
}
__device__ __forceinline__ void resid_phase(CA A, const float* Y, const float* PS, const float* gpost, const float* gnext, bool from_input, const int wv) {
    const int tid = tid_opaque(wv), lane = tid & 63, gw = blk_opaque() * NWAVES + (tid >> 6), NGW = gridDim.x * NWAVES;
    bf16* H = WSP(bf16, WS_H);
    f32x4 v[8], x[8], vn[8], xn[8];
    int m = gw; if (m < TP) resid_load(A, Y, PS, from_input, m, lane, v, x);
    while (m < TT) {
        int mnext = m + NGW; if (m < TP && mnext >= TP) mnext = (gw < TS) ? TP + gw : TT;
        else if (m >= TP) mnext = TT;
        if (mnext < TT) resid_load(A, Y, PS, from_input, mnext, lane, vn, xn);
        float s = 0.f;
#pragma unroll
        for (int j = 0; j < 8; ++j) s += (v[j][0] * v[j][0] + v[j][1] * v[j][1]) + (v[j][2] * v[j][2] + v[j][3] * v[j][3]);
        const float rstd = __builtin_amdgcn_rsqf(wave_sum(s) * (1.0f / DM) + RMS_EPS); float s2 = 0.f;
        f32x4* orow = (f32x4*)(A->out + O_Y + (size_t)m * DM);
#pragma unroll
        for (int j = 0; j < 8; ++j) { const f32x4 gj = ((const f32x4*)gpost)[lane + 64 * j]; v[j] = x[j] + v[j] * rstd * gj; orow[lane + 64 * j] = v[j];
            s2 += (v[j][0] * v[j][0] + v[j][1] * v[j][1]) + (v[j][2] * v[j][2] + v[j][3] * v[j][3]); }
        if (gnext) { const float rstd2 = __builtin_amdgcn_rsqf(wave_sum(s2) * (1.0f / DM) + RMS_EPS); store_bf16_row(H + (size_t)m * DM, v, rstd2, gnext, lane); }
#pragma unroll
        for (int j = 0; j < 8; ++j) { v[j] = vn[j]; x[j] = xn[j]; }
        m = mnext;
    }
}

__device__ __forceinline__ float conv_tap(const float* UF, const float* state, int row, int j, int ucol, int c) {
    if (row < TP) { const int t = row & (SEQ - 1); return (t - 3 + j) >= 0 ? UF[(size_t)(row - 3 + j) * UFW + ucol + c] : 0.f; }
    const int s = row - TP, sb = s >> 2, e = (s & 3) + j;
    return e < 3 ? state[(size_t)(sb * 3 + e) * 1536 + c] : UF[(size_t)(TP + sb * 4 + e - 3) * UFW + ucol + c];
}
__device__ __forceinline__ void prep_phase(CA A, int layer, const int wv) {
    const int tid = tid_opaque(wv), lane = tid & 63, G = gridDim.x, gt = blk_opaque() * NTHR + tid, NGT = G * NTHR, gw = blk_opaque() * NWAVES + (tid >> 6), NGW = G * NWAVES;
    const float* UF = WSP(float, WS_UF); float* SC = WSP(float, WS_SCAL);
    for (int idx = gt; idx < TT * 24; idx += NGT) { const int row = idx / 24, j = idx % 24; const float u = UF[(size_t)row * UFW + UF_SMALL + j]; float r;
        if (j < 4) r = sigmoidf_(u);
        else if (j < 8) r = -fexp(IN_F(I_DNALOG)[layer * 4 + j - 4]) * softplusf_(u + IN_F(I_DNDTB)[layer * 4 + j - 4]);
        else r = softplusf_(u + IN_F(I_SSDTB)[layer * 16 + j - 8]);
        SC[(size_t)row * 32 + j] = r; }
    { bf16* O0 = WSP(bf16, WS_OBR); const float* spool = IN_F(I_SPOOL) + (size_t)layer * DBATCH * 15 * 512;
      for (int it = gw; it < (TP / 64 + DBATCH) * 4; it += NGW) { const int gi = it & 3, sc = it >> 2, w = 2 << gi, ch = gi * 128 + lane;
          if (sc < TP / 64) { const int row0 = sc * 64, t0 = row0 & (SEQ - 1); float s0 = 0.f, s1 = 0.f;
              for (int j = 1; j < w; ++j) if (t0 - j >= 0) { s0 += UF[(size_t)(row0 - j) * UFW + ch]; s1 += UF[(size_t)(row0 - j) * UFW + ch + 64]; }
#pragma unroll 8
              for (int i = 0; i < 64; ++i) { const int row = row0 + i, t = t0 + i; const float u0 = UF[(size_t)row * UFW + ch], u1 = UF[(size_t)row * UFW + ch + 64];
                  s0 += u0; s1 += u1; const float inv = 1.0f / (float)((t + 1) < w ? (t + 1) : w);
                  O0[(size_t)row * OBW + ch] = (bf16)f2bf(s0 * inv - u0); O0[(size_t)row * OBW + ch + 64] = (bf16)f2bf(s1 * inv - u1);
                  if (t - w + 1 >= 0) { s0 -= UF[(size_t)(row - w + 1) * UFW + ch]; s1 -= UF[(size_t)(row - w + 1) * UFW + ch + 64]; } } }
          else { const int sb = sc - TP / 64; const float inv = 1.0f / (float)w;
              for (int i = 0; i < DSEQ; ++i) { const int row = TP + sb * 4 + i, e = 15 + i; float s0 = 0.f, s1 = 0.f;
                  for (int j = 0; j < w; ++j) { const int ee = e - j; const float* src = ee < 15 ? spool + (size_t)(sb * 15 + ee) * 512 + ch : UF + (size_t)(TP + sb * 4 + ee - 15) * UFW + ch; s0 += src[0]; s1 += src[64]; }
                  O0[(size_t)row * OBW + ch] = (bf16)f2bf(s0 * inv - UF[(size_t)row * UFW + ch]); O0[(size_t)row * OBW + ch + 64] = (bf16)f2bf(s1 * inv - UF[(size_t)row * UFW + ch + 64]); } } } }
    for (int it0 = gw; it0 < DBATCH * 24; it0 += NGW) { const int it = it0 + (TP / 64) * 24; const int grp = it % 12, strm = (it / 12) & 1, sc = it / 24, c0 = grp * 128 + lane;
        const int ucol = strm ? UF_XBC : UF_DNQKV; float* OUTB = strm ? WSP(float, WS_XBC) : WSP(float, WS_DNQ);
        const float* cw = (strm ? IN_F(I_SSCW) : IN_F(I_DNCW)) + (size_t)layer * 4 * 1536; const float* st = (strm ? IN_F(I_SSSC) : IN_F(I_SDNC)) + (size_t)layer * DBATCH * 3 * 1536;
        const float wa0 = cw[c0], wa1 = cw[1536 + c0], wa2 = cw[3072 + c0], wa3 = cw[4608 + c0], wb0 = cw[c0 + 64], wb1 = cw[1536 + c0 + 64], wb2 = cw[3072 + c0 + 64], wb3 = cw[4608 + c0 + 64];
        const float ba = strm ? IN_F(I_SSCB)[layer * 1536 + c0] : 0.f, bb = strm ? IN_F(I_SSCB)[layer * 1536 + c0 + 64] : 0.f;
        const bool nrm = (strm == 0) && grp < 8; const float qs = grp < 4 ? 0.08838834764831845f : 1.0f;
        float ha0, ha1, ha2, hb0, hb1, hb2; int row0, n;
        if (sc < TP / 64) { row0 = sc * 64; n = 64; const int t0 = row0 & (SEQ - 1);
            if (t0 == 0) { ha0 = ha1 = ha2 = hb0 = hb1 = hb2 = 0.f; }
            else { const float* p = UF + (size_t)(row0 - 3) * UFW + ucol + c0; ha0 = p[0]; hb0 = p[64]; ha1 = p[UFW]; hb1 = p[UFW + 64]; ha2 = p[2 * UFW]; hb2 = p[2 * UFW + 64]; } }
        else { const int sb = sc - TP / 64; row0 = TP + sb * 4; n = DSEQ; const float* p = st + (size_t)(sb * 3) * 1536 + c0; ha0 = p[0]; hb0 = p[64]; ha1 = p[1536]; hb1 = p[1536 + 64]; ha2 = p[3072]; hb2 = p[3072 + 64]; }
#pragma unroll 8
        for (int i = 0; i < n; ++i) { const float* p = UF + (size_t)(row0 + i) * UFW + ucol + c0; const float ua = p[0], ub = p[64];
            float a = siluf_(ba + wa0 * ha0 + wa1 * ha1 + wa2 * ha2 + wa3 * ua), b = siluf_(bb + wb0 * hb0 + wb1 * hb1 + wb2 * hb2 + wb3 * ub);
            ha0 = ha1; ha1 = ha2; ha2 = ua; hb0 = hb1; hb1 = hb2; hb2 = ub;
            if (nrm) { const float rs = row16_sum(a * a + b * b);
                const float tot = (__builtin_bit_cast(float, __builtin_amdgcn_readlane(__builtin_bit_cast(int, rs), 0)) + __builtin_bit_cast(float, __builtin_amdgcn_readlane(__builtin_bit_cast(int, rs), 16)))
                                + (__builtin_bit_cast(float, __builtin_amdgcn_readlane(__builtin_bit_cast(int, rs), 32)) + __builtin_bit_cast(float, __builtin_amdgcn_readlane(__builtin_bit_cast(int, rs), 48)));
                const float sc2 = qs / sqrtf(tot + 1e-6f); a *= sc2; b *= sc2; }
            float* o = OUTB + (size_t)(row0 + i) * 1536 + c0; o[0] = a; o[64] = b; } }
    for (int idx = gt; idx < NBATCH * 3 * 1536; idx += NGT) { const int b = idx / (3 * 1536), q = idx % (3 * 1536), j = q / 1536, c = q % 1536; const size_t src = (size_t)(b * SEQ + SEQ - 3 + j) * UFW;
        A->out[O_DNCP + (size_t)layer * NBATCH * 3 * 1536 + idx] = UF[src + UF_DNQKV + c]; A->out[O_SSCP + (size_t)layer * NBATCH * 3 * 1536 + idx] = UF[src + UF_XBC + c]; }
    for (int idx = gt; idx < DBATCH * 3 * 1536; idx += NGT) { const int sb = idx / (3 * 1536), q = idx % (3 * 1536), j = q / 1536, c = q % 1536; const size_t src = (size_t)(TP + sb * 4 + 1 + j) * UFW;
        A->out[O_DNCS + (size_t)layer * DBATCH * 3 * 1536 + idx] = UF[src + UF_DNQKV + c]; A->out[O_SSCS + (size_t)layer * DBATCH * 3 * 1536 + idx] = UF[src + UF_XBC + c]; }
    for (int idx = gt; idx < NBATCH * 15 * 512; idx += NGT) { const int b = idx / (15 * 512), q = idx % (15 * 512), j = q >> 9, ch = q & 511;
        A->out[O_POOLP + (size_t)layer * NBATCH * 15 * 512 + idx] = UF[(size_t)(b * SEQ + SEQ - 15 + j) * UFW + ch]; }
    { const float* spool = IN_F(I_SPOOL) + (size_t)layer * DBATCH * 15 * 512;
      for (int idx = gt; idx < DBATCH * 15 * 512; idx += NGT) { const int sb = idx / (15 * 512), q = idx % (15 * 512), j = q >> 9, ch = q & 511, e = 4 + j;
          A->out[O_POOLS + (size_t)layer * DBATCH * 15 * 512 + idx] = e < 15 ? spool[(size_t)(sb * 15 + e) * 512 + ch] : UF[(size_t)(TP + sb * 4 + e - 15) * UFW + ch]; } }
}

__device__ __forceinline__ void dn_seq(CA A, LAS unsigned char* lds, int layer, int unit, const int wv) {
    const int tid = tid_opaque(wv), lane = tid & 63, wid = tid >> 6, v = tid & 127, kq = tid >> 7;
    int row0, L, h; const float* s0 = nullptr; float* sout;
    if (unit < 16) { const int b = unit >> 2; h = unit & 3; row0 = b * SEQ; L = SEQ; sout = A->out + O_DNSP + ((size_t)(layer * NBATCH + b) * 4 + h) * 16384; }
    else { const int u = unit - 16, sb = u >> 2; h = u & 3; row0 = TP + sb * 4; L = DSEQ; s0 = IN_F(I_SDNS) + ((size_t)(layer * DBATCH + sb) * 4 + h) * 16384; sout = A->out + O_DNSS + ((size_t)(layer * DBATCH + sb) * 4 + h) * 16384; }
    constexpr int CH = 32;
    LAS float* qs = (LAS float*)lds; LAS float* ks = qs + CH * 128; LAS float* vs = ks + CH * 128; LAS float* ob = vs + CH * 128;
    LAS float* red = ob + CH * 128;
    LAS float* egs = red + 2 * 2 * 4 * 128; LAS float* bts = egs + CH; LAS float* kqd = bts + CH;
    const float* DNQ = WSP(float, WS_DNQ); const float* SC = WSP(float, WS_SCAL); const float* UF = WSP(float, WS_UF); bf16* O1 = WSP(bf16, WS_OBR) + 512;
    const float* nw = IN_F(I_DNNW) + layer * 128;
    float S[32];
#pragma unroll
    for (int i = 0; i < 32; ++i) S[i] = s0 ? s0[(size_t)(32 * kq + i) * 128 + v] : 0.f;
    for (int c0 = 0; c0 < L; c0 += CH) {
        const int n = (L - c0) < CH ? (L - c0) : CH;
        __syncthreads();
        for (int idx = tid; idx < n * 128; idx += NTHR) { const int t = idx >> 7, c = idx & 127; const float* src = DNQ + (size_t)(row0 + c0 + t) * 1536 + h * 128 + c;
            qs[idx] = src[0]; ks[idx] = src[512]; vs[idx] = src[1024]; }
        if (tid < n) { const float* sc = SC + (size_t)(row0 + c0 + tid) * 32; bts[tid] = sc[h]; egs[tid] = fexp(sc[4 + h]); }
        __syncthreads();
        for (int t = wid; t < n; t += NWAVES) { const float s = wave_sum(ks[t * 128 + lane] * qs[t * 128 + lane] + ks[t * 128 + 64 + lane] * qs[t * 128 + 64 + lane]); if (lane == 0) kqd[t] = s; }
        __syncthreads();
        for (int t = 0; t < n; ++t) {
            const float eg = egs[t], bt = bts[t]; float kk[32]; float r = 0.f, pp = 0.f;
#pragma unroll
            for (int i4 = 0; i4 < 8; ++i4) { const f32x4 k4 = *(const LAS f32x4*)(ks + t * 128 + 32 * kq + 4 * i4), q4 = *(const LAS f32x4*)(qs + t * 128 + 32 * kq + 4 * i4);
#pragma unroll
                for (int e = 0; e < 4; ++e) { const int i = 4 * i4 + e; S[i] *= eg; kk[i] = k4[e]; r += S[i] * k4[e]; pp += S[i] * q4[e]; } }
            LAS float* rd = red + (t & 1) * 1024;
            rd[kq * 128 + v] = r; rd[512 + kq * 128 + v] = pp;
            __syncthreads();
            const float rt = (rd[v] + rd[128 + v]) + (rd[256 + v] + rd[384 + v]), pt = (rd[512 + v] + rd[640 + v]) + (rd[768 + v] + rd[896 + v]);
            const float dd = bt * (vs[t * 128 + v] - rt);
#pragma unroll
            for (int i = 0; i < 32; ++i) S[i] += kk[i] * dd;
            if (kq == 0) ob[t * 128 + v] = pt + kqd[t] * dd;
        }
        __syncthreads();
        for (int t = wid; t < n; t += NWAVES) { const int row = row0 + c0 + t; const float o0 = ob[t * 128 + lane], o1 = ob[t * 128 + 64 + lane];
            const float rstd = 1.0f / sqrtf(wave_sum(o0 * o0 + o1 * o1) * (1.0f / 128.0f) + RMS_EPS);
            const float z0 = UF[(size_t)row * UFW + UF_DNZ + h * 128 + lane], z1 = UF[(size_t)row * UFW + UF_DNZ + h * 128 + 64 + lane];
            O1[(size_t)row * OBW + h * 128 + lane] = (bf16)f2bf(o0 * rstd * nw[lane] * siluf_(z0)); O1[(size_t)row * OBW + h * 128 + 64 + lane] = (bf16)f2bf(o1 * rstd * nw[64 + lane] * siluf_(z1)); }
    }
#pragma unroll
    for (int i = 0; i < 32; ++i) sout[(size_t)(32 * kq + i) * 128 + v] = S[i];
    __syncthreads();
}

__device__ __forceinline__ void ssd_seq(CA A, LAS unsigned char* lds, int layer, int unit, const int wv) {
    const int tid = tid_opaque(wv), lane = tid & 63, wid = tid >> 6, p = tid >> 3, nq = tid & 7;
    int row0, L, hd; const float* h0 = nullptr; float* hout;
    if (unit < 64) { const int b = unit >> 4; hd = unit & 15; row0 = b * SEQ; L = SEQ; hout = A->out + O_SSHP + ((size_t)(layer * NBATCH + b) * 16 + hd) * 8192; }
    else { const int u = unit - 64, sb = u >> 4; hd = u & 15; row0 = TP + sb * 4; L = DSEQ; h0 = IN_F(I_SSSH) + ((size_t)(layer * DBATCH + sb) * 16 + hd) * 8192; hout = A->out + O_SSHS + ((size_t)(layer * DBATCH + sb) * 16 + hd) * 8192; }
    const int g = hd >> 3; constexpr int CH = 64;
    LAS float* Bs = (LAS float*)lds; LAS float* Cs = Bs + CH * 128; LAS float* xs = Cs + CH * 128; LAS float* yb = xs + CH * 64; LAS float* dts = yb + CH * 64;
    const float* XBC = WSP(float, WS_XBC); const float* SC = WSP(float, WS_SCAL); const float* UF = WSP(float, WS_UF); float* SSQ = WSP(float, WS_SSQ);
    bf16* Og = WSP(bf16, WS_OBR) + (3 + g) * 512;
    const float a = -fexp(IN_F(I_SSALOG)[layer * 16 + hd]), Dk = IN_F(I_SSD)[layer * 16 + hd];
    float hs[16];
#pragma unroll
    for (int j = 0; j < 16; ++j) hs[j] = h0 ? h0[(size_t)p * 128 + 16 * nq + j] : 0.f;
    for (int c0 = 0; c0 < L; c0 += CH) {
        const int n = (L - c0) < CH ? (L - c0) : CH;
        __syncthreads();
        for (int idx = tid; idx < n * 128; idx += NTHR) { const int t = idx >> 7, c = idx & 127; const float* src = XBC + (size_t)(row0 + c0 + t) * 1536; Bs[idx] = src[1024 + g * 128 + c]; Cs[idx] = src[1280 + g * 128 + c]; }
        for (int idx = tid; idx < n * 64; idx += NTHR) { const int t = idx >> 6, c = idx & 63; xs[idx] = XBC[(size_t)(row0 + c0 + t) * 1536 + hd * 64 + c]; }
        if (tid < n) dts[tid] = SC[(size_t)(row0 + c0 + tid) * 32 + 8 + hd];
        __syncthreads();
        for (int t = 0; t < n; ++t) {
            const float dt = dts[t], dA = fexp(dt * a), xv = xs[t * 64 + p], cx = dt * xv; float y = 0.f;
#pragma unroll
            for (int j4 = 0; j4 < 4; ++j4) { const f32x4 b4 = *(const LAS f32x4*)(Bs + t * 128 + 16 * nq + 4 * j4), c4 = *(const LAS f32x4*)(Cs + t * 128 + 16 * nq + 4 * j4);
#pragma unroll
                for (int e = 0; e < 4; ++e) { const int j = 4 * j4 + e; hs[j] = hs[j] * dA + cx * b4[e]; y += hs[j] * c4[e]; } }
            y += __shfl_xor(y, 1); y += __shfl_xor(y, 2); y += __shfl_xor(y, 4);
            if (nq == 0) yb[t * 64 + p] = y + Dk * xv;
        }
        __syncthreads();
        for (int t = wid; t < n; t += NWAVES) { const int row = row0 + c0 + t; const float z = UF[(size_t)row * UFW + UF_SSZ + hd * 64 + lane]; const float yg = yb[t * 64 + lane] * siluf_(z);
            const float ss = wave_sum(yg * yg); if (lane == 0) { SSQ[(size_t)row * 32 + hd * 2] = ss; SSQ[(size_t)row * 32 + hd * 2 + 1] = 0.f; }
            Og[(size_t)row * OBW + (hd & 7) * 64 + lane] = (bf16)f2bf(yg); }
    }
#pragma unroll
    for (int j = 0; j < 16; ++j) hout[(size_t)p * 128 + 16 * nq + j] = hs[j];
    __syncthreads();
}

constexpr size_t DNU_NW = 0, DNU_QG = 16384, DNU_AT = 32768, DNU_KGT = 40960, DNU_UP = 57344, DNU_EG = 90112, DNU_BYTES = 90368;
__device__ __forceinline__ float dpp_swap1(float x) { return __builtin_bit_cast(float, __builtin_amdgcn_mov_dpp(__builtin_bit_cast(int, x), 0xB1, 0xf, 0xf, true)); }
__device__ __forceinline__ void dn_chunk_unit(CA A, LAS unsigned char* lds, int layer, int unit, const int wv) {
    const int tid = tid_opaque(wv), lane = tid & 63, wid = tid >> 6, q4 = lane >> 4, l15 = lane & 15;
    const int bh = unit >> 5, ck = unit & 31, b = bh >> 2, h = bh & 3, row0 = b * SEQ + ck * 64;
    constexpr int FP = 132;
    LAS float* kf = (LAS float*)lds; LAS float* vf = kf + 64 * FP;
    LAS unsigned char* qb = lds + 2 * 64 * FP * 4; LAS unsigned char* kb = qb + 64 * 272;
    LAS float* Lp = (LAS float*)(kb + 64 * 272);
    LAS float* gcs = Lp + 2 * 64 * 32; LAS float* bts = gcs + 64;
    const float* SC = WSP(float, WS_SCAL);
    unsigned char* rec = A->ws + WS_DNU + (size_t)unit * DNU_BYTES;
    __syncthreads();
    if (tid < 64) { const float* sc = SC + (size_t)(row0 + tid) * 32; bts[tid] = sc[h]; gcs[tid] = wave_scan(sc[4 + h], lane); }
    __syncthreads();
    const float glast = gcs[63];
    if (tid == 0) *(float*)(rec + DNU_EG) = fexp(glast);
    { const float* UF = WSP(float, WS_UF); const float* cw = IN_F(I_DNCW) + (size_t)layer * 4 * 1536;
#pragma unroll
      for (int it = 0; it < 4; ++it) { const int idx = tid + 512 * it, t = idx >> 5, d4 = (idx & 31) * 4, tq = ck * 64 + t; f32x4 val[3];
#pragma unroll
          for (int sIdx = 0; sIdx < 3; ++sIdx) { const int col = sIdx * 512 + h * 128 + d4; f32x4 a = {0.f, 0.f, 0.f, 0.f};
#pragma unroll
              for (int j = 0; j < 4; ++j) if (tq - 3 + j >= 0) a += *(const f32x4*)(UF + (size_t)(row0 + t - 3 + j) * UFW + UF_DNQKV + col) * *(const f32x4*)(cw + j * 1536 + col);
#pragma unroll
              for (int e = 0; e < 4; ++e) a[e] = siluf_(a[e]);
              if (sIdx < 2) { float ss = row16_sum((a[0] * a[0] + a[1] * a[1]) + (a[2] * a[2] + a[3] * a[3])); ss += __shfl_xor(ss, 16);
                  const float sc = (sIdx == 0 ? 0.08838834764831845f : 1.0f) * __builtin_amdgcn_rsqf(ss + 1e-6f); a = a * sc; }
              val[sIdx] = a; }
          const f32x4 qv = val[0], kv = val[1], vv = val[2];
          *(LAS f32x4*)(kf + t * FP + d4) = kv; *(LAS f32x4*)(vf + t * FP + d4) = vv;
          v2u w; w.x = pk2(qv[0], qv[1]); w.y = pk2(qv[2], qv[3]); *(LAS v2u*)(qb + t * 272 + d4 * 2) = w;
          w.x = pk2(kv[0], kv[1]); w.y = pk2(kv[2], kv[3]); *(LAS v2u*)(kb + t * 272 + d4 * 2) = w;
          const float eg = fexp(gcs[t]); w.x = pk2(qv[0] * eg, qv[1] * eg); w.y = pk2(qv[2] * eg, qv[3] * eg); *(v2u*)(rec + DNU_QG + (size_t)(t * 128 + d4) * 2) = w; } }
    __syncthreads();
    { const int c = lane, dg = wid; const float f = fexp(glast - gcs[c]); bf16* KGT = (bf16*)(rec + DNU_KGT);
#pragma unroll
      for (int i = 0; i < 16; ++i) { const int d = dg * 16 + i; KGT[d * 64 + c] = (bf16)f2bf(kf[c * FP + d] * f); } }
    { const int ct = wid >> 1; bf16* AT = (bf16*)(rec + DNU_AT);
#pragma unroll
      for (int e2 = 0; e2 < 2; ++e2) { const int et = 2 * (wid & 1) + e2; f32x4 aKK = {0.f, 0.f, 0.f, 0.f}, aQK = {0.f, 0.f, 0.f, 0.f};
#pragma unroll
          for (int ks = 0; ks < 4; ++ks) { const bf16x8 bfr = *(const LAS bf16x8*)(kb + (16 * et + l15) * 272 + (32 * ks + 8 * q4) * 2);
              const bf16x8 ak = *(const LAS bf16x8*)(kb + (16 * ct + l15) * 272 + (32 * ks + 8 * q4) * 2), aq = *(const LAS bf16x8*)(qb + (16 * ct + l15) * 272 + (32 * ks + 8 * q4) * 2);
              aKK = __builtin_amdgcn_mfma_f32_16x16x32_bf16(ak, bfr, aKK, 0, 0, 0); aQK = __builtin_amdgcn_mfma_f32_16x16x32_bf16(aq, bfr, aQK, 0, 0, 0); }
          const int e = 16 * et + l15; const float ge = gcs[e];
#pragma unroll
          for (int r = 0; r < 4; ++r) { const int c = 16 * ct + 4 * q4 + r; const float dec = e <= c ? fexp(gcs[c] - ge) : 0.f;
              Lp[((e & 1) * 64 + c) * 32 + (e >> 1)] = e < c ? bts[c] * aKK[r] * dec : 0.f;
              AT[c * 64 + e] = (bf16)f2bf(aQK[r] * dec); } } }
    __syncthreads();
    { const int j = tid >> 1, par = tid & 1; float x[32];
#pragma unroll
      for (int i = 0; i < 32; ++i) x[i] = 0.f;
      const LAS float* src = j < 128 ? vf + j : kf + (j - 128);
      float* UP = (float*)(rec + DNU_UP); bf16* NW = (bf16*)(rec + DNU_NW);
#pragma unroll
      for (int c = 0; c < 64; ++c) {
          constexpr int dummy = 0; (void)dummy;
          const int ni = (c + 1) >> 1; float a0 = 0.f, a1 = 0.f, a2 = 0.f, a3 = 0.f;
#pragma unroll
          for (int i4 = 0; i4 < (ni + 3) / 4; ++i4) { const f32x4 l4 = *(const LAS f32x4*)(Lp + (par * 64 + c) * 32 + 4 * i4);
              a0 += l4[0] * x[4 * i4]; if (4 * i4 + 1 < ni) a1 += l4[1] * x[4 * i4 + 1]; if (4 * i4 + 2 < ni) a2 += l4[2] * x[4 * i4 + 2]; if (4 * i4 + 3 < ni) a3 += l4[3] * x[4 * i4 + 3]; }
          float acc = (a0 + a1) + (a2 + a3); acc += dpp_swap1(acc);
          float rhs = src[c * FP] * bts[c]; if (j >= 128) rhs *= fexp(gcs[c]);
          const float xc = rhs - acc;
          x[c >> 1] = ((c & 1) == par) ? xc : x[c >> 1];
          if (par == 0) { if (j < 128) UP[(((j >> 4) * 4 + (c >> 4)) * 4 + (c & 3)) * 64 + ((c >> 2) & 3) * 16 + (j & 15)] = xc; else NW[c * 128 + (j - 128)] = (bf16)f2bf(-xc); }
      } }
}

constexpr int D2_NW = 0, D2_KGT = 17408, D2_BUF = 35840;
__device__ __forceinline__ bf16x8 ld_frag_perm(const LAS unsigned char* p) {
    const v2u lo = *(const LAS v2u*)p, hi = *(const LAS v2u*)(p + 32); v4u w; w.x = lo.x; w.y = lo.y; w.z = hi.x; w.w = hi.y; return __builtin_bit_cast(bf16x8, w);
}
__device__ __forceinline__ bf16x8 pack_b(const f32x4& t0, const f32x4& t1) { v4u w; w.x = pk2(t0[0], t0[1]); w.y = pk2(t0[2], t0[3]); w.z = pk2(t1[0], t1[1]); w.w = pk2(t1[2], t1[3]); return __builtin_bit_cast(bf16x8, w); }
__device__ __forceinline__ void dn_seq2(CA A, LAS unsigned char* lds, int layer, int bh, const int wv) {
    const int tid = tid_opaque(wv), lane = tid & 63, w = tid >> 6, q4 = lane >> 4, l15 = lane & 15;
    const int b = bh >> 2, h = bh & 3;
    const unsigned char* recs = A->ws + WS_DNU + (size_t)(bh * 32) * DNU_BYTES;
    v4u* sav = (v4u*)(A->ws + WS_DNSV + (size_t)(bh * 32) * 49152) + (size_t)w * 6 * 64 + lane;
    f32x4 S[8];
#pragma unroll
    for (int i = 0; i < 8; ++i) S[i] = (f32x4){0.f, 0.f, 0.f, 0.f};
    v4u st[4];
#define D2_LOAD(rec_) do { const v4u* g_ = (const v4u*)(rec_); st[0] = g_[tid]; st[1] = g_[tid + 512]; st[2] = g_[tid + 2560]; st[3] = g_[tid + 3072]; } while (0)
#define D2_STORE(buf_) do { LAS unsigned char* b_ = lds + (buf_) * D2_BUF; \
        *(LAS v4u*)(b_ + D2_NW + (tid >> 4) * 272 + (tid & 15) * 16) = st[0]; *(LAS v4u*)(b_ + D2_NW + (32 + (tid >> 4)) * 272 + (tid & 15) * 16) = st[1]; \
        *(LAS v4u*)(b_ + D2_KGT + (tid >> 3) * 144 + (tid & 7) * 16) = st[2]; *(LAS v4u*)(b_ + D2_KGT + (64 + (tid >> 3)) * 144 + (tid & 7) * 16) = st[3]; } while (0)
    __syncthreads();
    D2_LOAD(recs); D2_STORE(0);
    f32x4 vnx[4]; float eglx = *(const float*)(recs + DNU_EG);
    { const float* UP0 = (const float*)(recs + DNU_UP) + (size_t)w * 1024 + lane;
#pragma unroll
      for (int mt = 0; mt < 4; ++mt)
#pragma unroll
          for (int r = 0; r < 4; ++r) vnx[mt][r] = UP0[(mt * 4 + r) * 64]; }
    __syncthreads();
    for (int ck = 0; ck < 32; ++ck) {
        const unsigned char* rec = recs + (size_t)ck * DNU_BYTES;
        const LAS unsigned char* bf = lds + (ck & 1) * D2_BUF;
        if (ck + 1 < 32) D2_LOAD(rec + DNU_BYTES);
        const float egl = eglx;
        f32x4 vn[4];
#pragma unroll
        for (int mt = 0; mt < 4; ++mt) vn[mt] = vnx[mt];
        if (ck + 1 < 32) { eglx = *(const float*)(rec + DNU_BYTES + DNU_EG); const float* UP = (const float*)(rec + DNU_BYTES + DNU_UP) + (size_t)w * 1024 + lane;
#pragma unroll
            for (int mt = 0; mt < 4; ++mt)
#pragma unroll
                for (int r = 0; r < 4; ++r) vnx[mt][r] = UP[(mt * 4 + r) * 64]; }
        bf16x8 Sb[4];
#pragma unroll
        for (int ks = 0; ks < 4; ++ks) { Sb[ks] = pack_b(S[2 * ks], S[2 * ks + 1]); sav[(size_t)ck * 3072 + ks * 64] = __builtin_bit_cast(v4u, Sb[ks]); }
        const int aoff = l15 * 272 + 8 * q4, aoff2 = l15 * 144 + 8 * q4;
#pragma unroll
        for (int mt = 0; mt < 4; ++mt)
#pragma unroll
            for (int ks = 0; ks < 4; ++ks) vn[mt] = __builtin_amdgcn_mfma_f32_16x16x32_bf16(ld_frag_perm(bf + D2_NW + mt * 16 * 272 + aoff + ks * 64), Sb[ks], vn[mt], 0, 0, 0);
        bf16x8 vb[2];
        vb[0] = pack_b(vn[0], vn[1]); vb[1] = pack_b(vn[2], vn[3]);
        sav[(size_t)ck * 3072 + 4 * 64] = __builtin_bit_cast(v4u, vb[0]); sav[(size_t)ck * 3072 + 5 * 64] = __builtin_bit_cast(v4u, vb[1]);
#pragma unroll
        for (int m8 = 0; m8 < 8; ++m8) { S[m8] = S[m8] * egl;
#pragma unroll
            for (int ke = 0; ke < 2; ++ke) S[m8] = __builtin_amdgcn_mfma_f32_16x16x32_bf16(ld_frag_perm(bf + D2_KGT + m8 * 16 * 144 + aoff2 + ke * 64), vb[ke], S[m8], 0, 0, 0); }
        if (ck + 1 < 32) D2_STORE((ck + 1) & 1);
        __syncthreads();
    }
    float* sout = A->out + O_DNSP + ((size_t)(layer * NBATCH + b) * 4 + h) * 16384;
#pragma unroll
    for (int m8 = 0; m8 < 8; ++m8)
#pragma unroll
        for (int r = 0; r < 4; ++r) sout[(size_t)(16 * m8 + 4 * q4 + r) * 128 + 16 * w + l15] = S[m8][r];
    __syncthreads();
#undef D2_LOAD
#undef D2_STORE
}
constexpr int D3_QG = 0, D3_AT = 17408, D3_RED = 26624;
__device__ __forceinline__ void dn_out_unit(CA A, LAS unsigned char* lds, int layer, int unit, const int wv) {
    const int tid = tid_opaque(wv), lane = tid & 63, w = tid >> 6, q4 = lane >> 4, l15 = lane & 15;
    const int bh = unit >> 5, ck = unit & 31, b = bh >> 2, h = bh & 3, row0 = b * SEQ + ck * 64;
    const unsigned char* rec = A->ws + WS_DNU + (size_t)unit * DNU_BYTES;
    const v4u* sav = (const v4u*)(A->ws + WS_DNSV + (size_t)unit * 49152) + (size_t)w * 6 * 64 + lane;
    const float* UF = WSP(float, WS_UF); bf16* O1 = WSP(bf16, WS_OBR) + 512; const float nwv = IN_F(I_DNNW)[layer * 128 + 16 * w + l15];
    LAS float* red = (LAS float*)(lds + D3_RED);
    __syncthreads();
    { const v4u* g_ = (const v4u*)rec; const v4u a0 = g_[tid + 1024], a1 = g_[tid + 1536], a2 = g_[tid + 2048];
      *(LAS v4u*)(lds + D3_QG + (tid >> 4) * 272 + (tid & 15) * 16) = a0; *(LAS v4u*)(lds + D3_QG + (32 + (tid >> 4)) * 272 + (tid & 15) * 16) = a1;
      *(LAS v4u*)(lds + D3_AT + (tid >> 3) * 144 + (tid & 7) * 16) = a2; }
    bf16x8 Sb[4], vb[2];
#pragma unroll
    for (int ks = 0; ks < 4; ++ks) Sb[ks] = __builtin_bit_cast(bf16x8, sav[ks * 64]);
    vb[0] = __builtin_bit_cast(bf16x8, sav[4 * 64]); vb[1] = __builtin_bit_cast(bf16x8, sav[5 * 64]);
    f32x4 zz[4];
#pragma unroll
    for (int mt = 0; mt < 4; ++mt)
#pragma unroll
        for (int r = 0; r < 4; ++r) zz[mt][r] = UF[(size_t)(row0 + 16 * mt + 4 * q4 + r) * UFW + UF_DNZ + h * 128 + 16 * w + l15];
    __syncthreads();
    const int aoff = l15 * 272 + 8 * q4, aoff2 = l15 * 144 + 8 * q4;
    f32x4 o[4];
#pragma unroll
    for (int mt = 0; mt < 4; ++mt) { o[mt] = (f32x4){0.f, 0.f, 0.f, 0.f};
#pragma unroll
        for (int ks = 0; ks < 4; ++ks) o[mt] = __builtin_amdgcn_mfma_f32_16x16x32_bf16(ld_frag_perm(lds + D3_QG + mt * 16 * 272 + aoff + ks * 64), Sb[ks], o[mt], 0, 0, 0);
#pragma unroll
        for (int ke = 0; ke < 2; ++ke) o[mt] = __builtin_amdgcn_mfma_f32_16x16x32_bf16(ld_frag_perm(lds + D3_AT + mt * 16 * 144 + aoff2 + ke * 64), vb[ke], o[mt], 0, 0, 0); }
#pragma unroll
    for (int mt = 0; mt < 4; ++mt)
#pragma unroll
        for (int r = 0; r < 4; ++r) red[(16 * mt + 4 * q4 + r) * 8 + w] = row16_sum(o[mt][r] * o[mt][r]);
    __syncthreads();
#pragma unroll
    for (int mt = 0; mt < 4; ++mt)
#pragma unroll
        for (int r = 0; r < 4; ++r) { const int c = 16 * mt + 4 * q4 + r; const f32x4 s0 = *(const LAS f32x4*)(red + c * 8), s1 = *(const LAS f32x4*)(red + c * 8 + 4);
            const float rstd = __builtin_amdgcn_rsqf(((s0[0] + s0[1]) + (s0[2] + s0[3]) + (s1[0] + s1[1]) + (s1[2] + s1[3])) * (1.0f / 128.0f) + RMS_EPS);
            const float zq = zz[mt][r]; O1[(size_t)(row0 + c) * OBW + h * 128 + 16 * w + l15] = (bf16)f2bf(o[mt][r] * rstd * nwv * zq * __builtin_amdgcn_rcpf(1.0f + fexp(-zq))); }
}

constexpr size_t SSU_XT = 0, SSU_XTW = 8192, SSU_CUM = 16384, SSU_DT = 16640, SSU_BYTES = 16896;
constexpr size_t SSG_C = 0, SSG_B = 16384, SSG_BT = 32768, SSG_BYTES = 49152;
__device__ __forceinline__ void ssd_prep_unit(CA A, LAS unsigned char* lds, int layer, int unit, const int wv) {
    const int tid = tid_opaque(wv), lane = tid & 63;
    const int hd = unit & 15, bc = unit >> 4, b = bc >> 5, ck = bc & 31, g = hd >> 3, row0 = b * SEQ + ck * 64;
    const float* SC = WSP(float, WS_SCAL);
    unsigned char* rec = A->ws + WS_SSU + (size_t)unit * SSU_BYTES;
    LAS float* xl = (LAS float*)lds;
    LAS float* bl = xl + 64 * 65;
    LAS float* cums = bl + 64 * 129; LAS float* ws_ = cums + 64;
    const float a = -fexp(IN_F(I_SSALOG)[layer * 16 + hd]);
    __syncthreads();
    if (tid < 64) { const float dt = SC[(size_t)(row0 + tid) * 32 + 8 + hd]; const float c = wave_scan(dt * a, lane);
        cums[tid] = c; const float c63 = rdlane(c, 63); ws_[tid] = fexp(c63 - c) * dt;
        ((float*)(rec + SSU_CUM))[tid] = c; ((float*)(rec + SSU_DT))[tid] = dt; }
    const float* UF = WSP(float, WS_UF); const float* cw = IN_F(I_SSCW) + (size_t)layer * 4 * 1536; const float* cb = IN_F(I_SSCB) + layer * 1536; const int tq0 = ck * 64;
    { const int s = tid >> 3, p8 = (tid & 7) * 8, col = hd * 64 + p8; f32x4 x0 = *(const f32x4*)(cb + col), x1 = *(const f32x4*)(cb + col + 4);
#pragma unroll
      for (int j = 0; j < 4; ++j) if (tq0 + s - 3 + j >= 0) { const float* up = UF + (size_t)(row0 + s - 3 + j) * UFW + UF_XBC + col; x0 += *(const f32x4*)up * *(const f32x4*)(cw + j * 1536 + col); x1 += *(const f32x4*)(up + 4) * *(const f32x4*)(cw + j * 1536 + col + 4); }
#pragma unroll
      for (int e = 0; e < 4; ++e) { xl[s * 65 + p8 + e] = siluf_(x0[e]); xl[s * 65 + p8 + 4 + e] = siluf_(x1[e]); } }
    __syncthreads();
    { const int p = tid >> 3, s8 = (tid & 7) * 8; float xv[8], xw[8];
#pragma unroll
      for (int i = 0; i < 8; ++i) { xv[i] = xl[(s8 + i) * 65 + p]; xw[i] = xv[i] * ws_[s8 + i]; }
      v4u o; o.x = pk2(xv[0], xv[1]); o.y = pk2(xv[2], xv[3]); o.z = pk2(xv[4], xv[5]); o.w = pk2(xv[6], xv[7]); *(v4u*)(rec + SSU_XT + (size_t)(p * 64 + s8) * 2) = o;
      o.x = pk2(xw[0], xw[1]); o.y = pk2(xw[2], xw[3]); o.z = pk2(xw[4], xw[5]); o.w = pk2(xw[6], xw[7]); *(v4u*)(rec + SSU_XTW + (size_t)(p * 64 + s8) * 2) = o; }
    if ((hd & 7) == 0) {
        unsigned char* grec = A->ws + WS_SSG + (size_t)(bc * 2 + g) * SSG_BYTES;
        const int s = tid >> 3, n16 = (tid & 7) * 16, colb = 1024 + g * 128 + n16;
        f32x4 bv[4], cv[4];
#pragma unroll
        for (int i = 0; i < 4; ++i) { bv[i] = *(const f32x4*)(cb + colb + 4 * i); cv[i] = *(const f32x4*)(cb + colb + 256 + 4 * i); }
#pragma unroll
        for (int j = 0; j < 4; ++j) if (tq0 + s - 3 + j >= 0) { const float* up = UF + (size_t)(row0 + s - 3 + j) * UFW + UF_XBC + colb; const float* wp = cw + j * 1536 + colb;
#pragma unroll
            for (int i = 0; i < 4; ++i) { bv[i] += *(const f32x4*)(up + 4 * i) * *(const f32x4*)(wp + 4 * i); cv[i] += *(const f32x4*)(up + 256 + 4 * i) * *(const f32x4*)(wp + 256 + 4 * i); } }
#pragma unroll
        for (int i = 0; i < 4; ++i)
#pragma unroll
            for (int e = 0; e < 4; ++e) { bv[i][e] = siluf_(bv[i][e]); cv[i][e] = siluf_(cv[i][e]); }
#pragma unroll
        for (int i = 0; i < 2; ++i) { v4u o; o.x = pk2(bv[2 * i][0], bv[2 * i][1]); o.y = pk2(bv[2 * i][2], bv[2 * i][3]); o.z = pk2(bv[2 * i + 1][0], bv[2 * i + 1][1]); o.w = pk2(bv[2 * i + 1][2], bv[2 * i + 1][3]);
            *(v4u*)(grec + SSG_B + (size_t)(s * 128 + n16 + 8 * i) * 2) = o;
            o.x = pk2(cv[2 * i][0], cv[2 * i][1]); o.y = pk2(cv[2 * i][2], cv[2 * i][3]); o.z = pk2(cv[2 * i + 1][0], cv[2 * i + 1][1]); o.w = pk2(cv[2 * i + 1][2], cv[2 * i + 1][3]);
            *(v4u*)(grec + SSG_C + (size_t)(s * 128 + n16 + 8 * i) * 2) = o; }
#pragma unroll
        for (int i = 0; i < 4; ++i)
#pragma unroll
            for (int e = 0; e < 4; ++e) bl[s * 129 + n16 + 4 * i + e] = bv[i][e];
        __syncthreads();
        const int n = tid >> 2, s16 = (tid & 3) * 16; float t[16];
#pragma unroll
        for (int i = 0; i < 16; ++i) t[i] = bl[(s16 + i) * 129 + n];
#pragma unroll
        for (int i = 0; i < 2; ++i) { v4u o; o.x = pk2(t[8 * i], t[8 * i + 1]); o.y = pk2(t[8 * i + 2], t[8 * i + 3]); o.z = pk2(t[8 * i + 4], t[8 * i + 5]); o.w = pk2(t[8 * i + 6], t[8 * i + 7]);
            *(v4u*)(grec + SSG_BT + (size_t)(n * 64 + s16 + 8 * i) * 2) = o; }
    }
}

constexpr int S2_C = 0, S2_B = 17408, S2_BT = 34816, S2_XT = 53248, S2_XTW = 62464, S2_WM = 71680, S2_HB = 80896, S2_YB = 98304, S2_CUM = 114688, S2_DT = 114944;
__device__ __forceinline__ void ssd_seq2(CA A, LAS unsigned char* lds, int layer, int unit, const int wv) {
    const int tid = tid_opaque(wv), lane = tid & 63, w = tid >> 6, q4 = lane >> 4, l15 = lane & 15;
    const int b = unit >> 4, hd = unit & 15, g = hd >> 3;
    const unsigned char* hrec = A->ws + WS_SSU + (size_t)((b * 32) * 16 + hd) * SSU_BYTES;
    const unsigned char* grec = A->ws + WS_SSG + (size_t)((b * 32) * 2 + g) * SSG_BYTES;
    const float* UF = WSP(float, WS_UF); float* SSQ = WSP(float, WS_SSQ); bf16* Og = WSP(bf16, WS_OBR) + (3 + g) * 512;
    const float Dk = IN_F(I_SSD)[layer * 16 + hd];
    LAS float* yb = (LAS float*)(lds + S2_YB); LAS float* cums = (LAS float*)(lds + S2_CUM); LAS float* dts = (LAS float*)(lds + S2_DT);
    f32x4 hacc[4];
#pragma unroll
    for (int i = 0; i < 4; ++i) hacc[i] = (f32x4){0.f, 0.f, 0.f, 0.f};
    v4u st[8]; float sc1 = 0.f;
#define S2_LOAD(ck_) do { const v4u* gg_ = (const v4u*)(grec + (size_t)(ck_) * 2 * SSG_BYTES); const v4u* hh_ = (const v4u*)(hrec + (size_t)(ck_) * 16 * SSU_BYTES); \
        st[0] = gg_[tid]; st[1] = gg_[tid + 512]; st[2] = gg_[tid + 1024]; st[3] = gg_[tid + 1536]; st[4] = gg_[tid + 2048]; st[5] = gg_[tid + 2560]; st[6] = hh_[tid]; st[7] = hh_[tid + 512]; \
        if (tid < 128) sc1 = ((const float*)(hrec + (size_t)(ck_) * 16 * SSU_BYTES + SSU_CUM))[tid]; } while (0)
#define S2_STORE() do { \
        *(LAS v4u*)(lds + S2_C + (tid >> 4) * 272 + (tid & 15) * 16) = st[0]; *(LAS v4u*)(lds + S2_C + (32 + (tid >> 4)) * 272 + (tid & 15) * 16) = st[1]; \
        *(LAS v4u*)(lds + S2_B + (tid >> 4) * 272 + (tid & 15) * 16) = st[2]; *(LAS v4u*)(lds + S2_B + (32 + (tid >> 4)) * 272 + (tid & 15) * 16) = st[3]; \
        *(LAS v4u*)(lds + S2_BT + (tid >> 3) * 144 + (tid & 7) * 16) = st[4]; *(LAS v4u*)(lds + S2_BT + (64 + (tid >> 3)) * 144 + (tid & 7) * 16) = st[5]; \
        *(LAS v4u*)(lds + S2_XT + (tid >> 3) * 144 + (tid & 7) * 16) = st[6]; *(LAS v4u*)(lds + S2_XTW + (tid >> 3) * 144 + (tid & 7) * 16) = st[7]; \
        if (tid < 128) cums[tid] = sc1; } while (0)
    S2_LOAD(0);
    const int tt = w >> 1, aoffC = l15 * 272 + 16 * q4, aoffS = l15 * 144 + 16 * q4;
    for (int ck = 0; ck < 32; ++ck) {
        const int row0 = b * SEQ + ck * 64;
        __syncthreads();
        S2_STORE();
        __syncthreads();
        if (ck + 1 < 32) S2_LOAD(ck + 1);
        float zv[2][4];
#pragma unroll
        for (int e2 = 0; e2 < 2; ++e2)
#pragma unroll
            for (int r = 0; r < 4; ++r) zv[e2][r] = UF[(size_t)(row0 + 16 * tt + 4 * q4 + r) * UFW + UF_SSZ + hd * 64 + 16 * (2 * (w & 1) + e2) + l15];
#pragma unroll
        for (int e2 = 0; e2 < 2; ++e2) { const int stl = 2 * (w & 1) + e2; f32x4 acc = {0.f, 0.f, 0.f, 0.f};
            if (stl <= tt) {
#pragma unroll
                for (int ks = 0; ks < 4; ++ks) acc = __builtin_amdgcn_mfma_f32_16x16x32_bf16(*(const LAS bf16x8*)(lds + S2_C + tt * 16 * 272 + aoffC + ks * 64), *(const LAS bf16x8*)(lds + S2_B + stl * 16 * 272 + aoffC + ks * 64), acc, 0, 0, 0); }
            const int s = 16 * stl + l15; const float cs = cums[s], ds = dts[s];
#pragma unroll
            for (int r = 0; r < 4; ++r) { const int t = 16 * tt + 4 * q4 + r; const float v = s <= t ? acc[r] * fexp(cums[t] - cs) * ds : 0.f;
                *(LAS unsigned short*)(lds + S2_WM + t * 144 + s * 2) = (unsigned short)f2bf(v); } }
#pragma unroll
        for (int mt = 0; mt < 4; ++mt)
#pragma unroll
            for (int r = 0; r < 4; ++r) *(LAS unsigned short*)(lds + S2_HB + (16 * mt + 4 * q4 + r) * 272 + (16 * w + l15) * 2) = (unsigned short)f2bf(hacc[mt][r]);
        __syncthreads();
        float ssq[4] = {0.f, 0.f, 0.f, 0.f};
#pragma unroll
        for (int e2 = 0; e2 < 2; ++e2) { const int pt = 2 * (w & 1) + e2; f32x4 y = {0.f, 0.f, 0.f, 0.f};
#pragma unroll
            for (int ks = 0; ks < 4; ++ks) y = __builtin_amdgcn_mfma_f32_16x16x32_bf16(*(const LAS bf16x8*)(lds + S2_C + tt * 16 * 272 + aoffC + ks * 64), *(const LAS bf16x8*)(lds + S2_HB + pt * 16 * 272 + aoffC + ks * 64), y, 0, 0, 0);
#pragma unroll
            for (int r = 0; r < 4; ++r) y[r] *= fexp(cums[16 * tt + 4 * q4 + r]);
#pragma unroll
            for (int ke = 0; ke < 2; ++ke) y = __builtin_amdgcn_mfma_f32_16x16x32_bf16(*(const LAS bf16x8*)(lds + S2_WM + tt * 16 * 144 + aoffS + ke * 64), *(const LAS bf16x8*)(lds + S2_XT + pt * 16 * 144 + aoffS + ke * 64), y, 0, 0, 0);
            const int p = 16 * pt + l15;
#pragma unroll
            for (int r = 0; r < 4; ++r) { const int t = 16 * tt + 4 * q4 + r; const float xv = bflo((unsigned)*(const LAS unsigned short*)(lds + S2_XT + p * 144 + t * 2));
                const float yg = (y[r] + Dk * xv) * siluf_(zv[e2][r]); ssq[r] += yg * yg;
                Og[(size_t)(row0 + t) * OBW + (hd & 7) * 64 + p] = (bf16)f2bf(yg); } }
#pragma unroll
        for (int r = 0; r < 4; ++r) { const float s = row16_sum(ssq[r]); if (l15 == 0) SSQ[(size_t)(row0 + 16 * tt + 4 * q4 + r) * 32 + hd * 2 + (w & 1)] = s; }
        { const float e63 = fexp(cums[63]);
#pragma unroll
          for (int mt = 0; mt < 4; ++mt) { hacc[mt] = hacc[mt] * e63;
#pragma unroll
              for (int ke = 0; ke < 2; ++ke) hacc[mt] = __builtin_amdgcn_mfma_f32_16x16x32_bf16(*(const LAS bf16x8*)(lds + S2_XTW + mt * 16 * 144 + aoffS + ke * 64), *(const LAS bf16x8*)(lds + S2_BT + w * 16 * 144 + aoffS + ke * 64), hacc[mt], 0, 0, 0); } }
    }
    float* hout = A->out + O_SSHP + ((size_t)(layer * NBATCH + b) * 16 + hd) * 8192;
#pragma unroll
    for (int mt = 0; mt < 4; ++mt)
#pragma unroll
        for (int r = 0; r < 4; ++r) hout[(size_t)(16 * mt + 4 * q4 + r) * 128 + 16 * w + l15] = hacc[mt][r];
    __syncthreads();
#undef S2_LOAD
#undef S2_STORE
}

struct ALBf16 { const bf16* A; int lda; __device__ __forceinline__ bf16x8 operator()(int row, int k) const { return *(const bf16x8*)(A + (size_t)row * lda + k); } };
template <class AL> __device__ __forceinline__ void sgemm_task(const AL& al, const bf16* Wt, int ldw, int n0, int k0, int nks, f32x4 (&acc)[2], int l15, int q4) {
    const bf16* bp = Wt + (size_t)(n0 + l15) * ldw + k0 + 8 * q4;
    int nks_ = nks; asm volatile("" : "+s"(nks_));
#pragma unroll 4
    for (int ks = 0; ks < nks_; ++ks) { const bf16x8 b = *(const bf16x8*)(bp + 32 * ks); const bf16x8 a0 = al(l15, k0 + 32 * ks + 8 * q4), a1 = al(16 + l15, k0 + 32 * ks + 8 * q4);
        acc[0] = __builtin_amdgcn_mfma_f32_16x16x32_bf16(a0, b, acc[0], 0, 0, 0); acc[1] = __builtin_amdgcn_mfma_f32_16x16x32_bf16(a1, b, acc[1], 0, 0, 0); }
}
#define SAMPLE_IDS() const int tid = tid_opaque(wv), lane = tid & 63, l15 = lane & 15, q4 = lane >> 4, NGW = gridDim.x * NWAVES, gw = (tid >> 6) * gridDim.x + blk_opaque()
__device__ __forceinline__ void sample_merge(CA A, LAS unsigned char* lds, int layer, const int wv) {
    const int tid = tid_opaque(wv), lane = tid & 63, l15 = lane & 15, q4 = lane >> 4, w = tid >> 6, G = gridDim.x;
    const bf16* GT = WSP(bf16, WS_GATE); const float* RS = WSP(float, WS_RS); bf16* MB = WSP(bf16, WS_MGB); LAS float* part = (LAS float*)lds;
    for (int strip = blk_opaque(); strip < 128; strip += G) { const int n0 = strip * 16, col = n0 + l15;
        __syncthreads();
        if (w < 5) { const int s = w, gs = s < 3 ? s : 3;
            f32x4 acc[2] = {{0.f, 0.f, 0.f, 0.f}, {0.f, 0.f, 0.f, 0.f}};
            ALBf16 al{WSP(bf16, WS_OBR) + (size_t)TP * OBW + s * 512, OBW};
            sgemm_task(al, WSP(bf16, WS_WBR) + (size_t)layer * DM * OBW + s * 512, OBW, n0, 0, 16, acc, l15, q4);
#pragma unroll
            for (int mt = 0; mt < 2; ++mt)
#pragma unroll
                for (int r = 0; r < 4; ++r) { const int row = 16 * mt + 4 * q4 + r, grow = TP + row; float rs = 1.f;
                    if (s >= 3) rs = 1.0f / sqrtf(RS[(size_t)grow * 2 + (s - 3)]);
                    part[(s * 32 + row) * 16 + l15] = acc[mt][r] * bflo((unsigned)GT[(size_t)grow * 8192 + gs * 2048 + col]) * rs; } }
        __syncthreads();
        { const int row = tid >> 4, c = tid & 15; const float v = (part[row * 16 + c] + part[(32 + row) * 16 + c]) + (part[(64 + row) * 16 + c] + part[(96 + row) * 16 + c]) + part[(128 + row) * 16 + c];
          MB[(size_t)(TP + row) * DM + n0 + c] = (bf16)f2bf(v); } }
}
__device__ __forceinline__ void sample_up(CA A, LAS unsigned char* lds, int layer, const int wv) {
    const int tid = tid_opaque(wv), lane = tid & 63, l15 = lane & 15, q4 = lane >> 4, w = tid >> 6, G = gridDim.x;
    bf16* F = WSP(bf16, WS_F); LAS float* part = (LAS float*)lds;
    for (int sp = blk_opaque(); sp < 256; sp += G) { const int n0 = (2 * sp + (w >> 2)) * 16, kq = w & 3;
        __syncthreads();
        f32x4 acc[2] = {{0.f, 0.f, 0.f, 0.f}, {0.f, 0.f, 0.f, 0.f}};
        ALBf16 al{WSP(bf16, WS_H) + (size_t)TP * DM, DM};
        sgemm_task(al, WSP(bf16, WS_WUP) + (size_t)layer * DFF * DM, DM, n0, kq * 512, 16, acc, l15, q4);
#pragma unroll
        for (int mt = 0; mt < 2; ++mt)
#pragma unroll
            for (int r = 0; r < 4; ++r) part[(w * 32 + 16 * mt + 4 * q4 + r) * 16 + l15] = acc[mt][r];
        __syncthreads();
#pragma unroll
        for (int h2 = 0; h2 < 2; ++h2) { const int idx = tid + 512 * h2, half = idx >> 9, row = (idx >> 4) & 31, c = idx & 15; const LAS float* p = part + (half * 4 * 32 + row) * 16 + c;
            const float v = fmaxf((p[0] + p[32 * 16]) + (p[2 * 32 * 16] + p[3 * 32 * 16]), 0.f);
            F[(size_t)(TP + row) * DFF + (2 * sp + half) * 16 + c] = (bf16)f2bf(v * v); } }
}
template <class AL> __device__ __forceinline__ void sample_splitk(const AL& al, const bf16* Wt, int ldw, int nstrips, int nsplit, int nks, float* PART, int ldp, const int wv) {
    SAMPLE_IDS();
    for (int it = gw; it < nstrips * nsplit; it += NGW) { const int ns = it % nstrips, sp = it / nstrips, n0 = ns * 16;
        f32x4 acc[2] = {{0.f, 0.f, 0.f, 0.f}, {0.f, 0.f, 0.f, 0.f}};
        sgemm_task(al, Wt, ldw, n0, sp * nks * 32, nks, acc, l15, q4);
#pragma unroll
        for (int mt = 0; mt < 2; ++mt)
#pragma unroll
            for (int r = 0; r < 4; ++r) PART[((size_t)sp * TS + 16 * mt + 4 * q4 + r) * ldp + n0 + l15] = acc[mt][r]; }
}

constexpr int KS_PITCH = 272, VT_PITCH = 136;
constexpr int ATT_KS = 0, ATT_VT = 64 * KS_PITCH;
__device__ __forceinline__ void attn_prompt_unit(CA A, LAS unsigned char* lds, int layer, int unit, const int wv) {
    const int tid = tid_opaque(wv), lane = tid & 63, wid = tid >> 6, r = lane & 31, hh = lane >> 5;
    const int qb = 7 - (unit >> 4), bh = unit & 15, b = bh >> 2, h = bh & 3;
    const int q0 = qb * 256 + wid * 32, qpos = q0 + r;
    const bf16* QKV = WSP(bf16, WS_QKV) + (size_t)(b * SEQ) * 1536;
    bf16x8 Qf[8];
    { const bf16* qrow = QKV + (size_t)qpos * 1536 + h * 128 + 8 * hh;
#pragma unroll
      for (int s = 0; s < 8; ++s) Qf[s] = *(const bf16x8*)(qrow + 16 * s); }
    f32x16 O[4];
#pragma unroll
    for (int d = 0; d < 4; ++d)
#pragma unroll
        for (int i = 0; i < 16; ++i) O[d][i] = 0.f;
    float R = 0.f;
    const float bias2 = IN_F(I_SBBIAS)[layer * 4 + h] * LOG2E;
    const int ntile = qb * 4 + 4, srow = tid >> 3, sch = tid & 7;
    LAS unsigned char* Ks = lds + ATT_KS; LAS unsigned char* Vt = lds + ATT_VT;
    v4u kreg[2], vreg[2];
    { const bf16* src = QKV + (size_t)((ntile - 1) * 64 + srow) * 1536 + h * 128 + sch * 8;
      kreg[0] = *(const v4u*)(src + 512); kreg[1] = *(const v4u*)(src + 512 + 64); vreg[0] = *(const v4u*)(src + 1024); vreg[1] = *(const v4u*)(src + 1024 + 64); }
    for (int kt = ntile - 1; kt >= 0; --kt) {
        __syncthreads();
#pragma unroll
        for (int i = 0; i < 2; ++i) { *(LAS v4u*)(Ks + srow * KS_PITCH + (sch + 8 * i) * 16) = kreg[i];
            LAS unsigned short* vt = (LAS unsigned short*)Vt + ((sch + 8 * i) * 8) * (VT_PITCH / 2) + srow;
            const unsigned w[4] = {vreg[i].x, vreg[i].y, vreg[i].z, vreg[i].w};
#pragma unroll
            for (int e = 0; e < 4; ++e) { vt[(2 * e) * (VT_PITCH / 2)] = (unsigned short)(w[e] & 0xffffu); vt[(2 * e + 1) * (VT_PITCH / 2)] = (unsigned short)(w[e] >> 16); } }
        __syncthreads();
        if (kt > 0) { const bf16* src = QKV + (size_t)((kt - 1) * 64 + srow) * 1536 + h * 128 + sch * 8;
            kreg[0] = *(const v4u*)(src + 512); kreg[1] = *(const v4u*)(src + 512 + 64); vreg[0] = *(const v4u*)(src + 1024); vreg[1] = *(const v4u*)(src + 1024 + 64); }
        if (kt * 64 > q0 + 30) continue;
        const bool diag = (kt * 64 + 63 >= q0);
        const int kbase = kt * 64 + 4 * hh;
        bf16x8 Pf[4];
#pragma unroll
        for (int sub = 1; sub >= 0; --sub) {
            f32x16 sa;
#pragma unroll
            for (int i = 0; i < 16; ++i) sa[i] = bias2;
#pragma unroll
            for (int s = 0; s < 8; ++s) { const bf16x8 a = *(const LAS bf16x8*)(Ks + (32 * sub + r) * KS_PITCH + (16 * s + 8 * hh) * 2);
                sa = __builtin_amdgcn_mfma_f32_32x32x16_bf16(a, Qf[s], sa, 0, 0, 0); }
            float sp[16], Gs[4], Gp[4];
#pragma unroll
            for (int i = 0; i < 16; ++i) { const float z = fminf(sa[i], 60.f); sa[i] = z; float s1 = lg2(1.0f + ex2(z));
                if (diag && (kbase + 32 * sub + 8 * (i >> 2) + (i & 3) >= qpos)) s1 = 0.f;
                sp[i] = s1; }
#pragma unroll
            for (int g = 0; g < 4; ++g) { Gs[g] = (sp[4 * g] + sp[4 * g + 1]) + (sp[4 * g + 2] + sp[4 * g + 3]); Gp[g] = __shfl_xor(Gs[g], 32); }
            float run = R;
#pragma unroll
            for (int g = 3; g >= 0; --g) { float a = run + (hh == 0 ? Gp[g] : 0.f);
#pragma unroll
                for (int e = 3; e >= 0; --e) { const int i = 4 * g + e; float pv = ex2(sa[i] - sp[i] - a);
                    if (diag && (kbase + 32 * sub + 8 * g + e >= qpos)) pv = 0.f;
                    a += sp[i]; sp[i] = pv; }
                run += Gs[g] + Gp[g]; }
            R = run;
#pragma unroll
            for (int q2 = 0; q2 < 2; ++q2) { const int bs = 8 * q2; v4u w;
                w.x = pk2(sp[bs + 0], sp[bs + 1]); w.y = pk2(sp[bs + 2], sp[bs + 3]); w.z = pk2(sp[bs + 4], sp[bs + 5]); w.w = pk2(sp[bs + 6], sp[bs + 7]);
                Pf[2 * sub + q2] = __builtin_bit_cast(bf16x8, w); }
        }
#pragma unroll
        for (int d = 0; d < 4; ++d)
#pragma unroll
            for (int s4 = 0; s4 < 4; ++s4) { const LAS unsigned char* vp = Vt + (32 * d + r) * VT_PITCH + (16 * s4 + 4 * hh) * 2;
                const v2u lo = *(const LAS v2u*)vp, hi = *(const LAS v2u*)(vp + 16); v4u w; w.x = lo.x; w.y = lo.y; w.z = hi.x; w.w = hi.y;
                O[d] = __builtin_amdgcn_mfma_f32_32x32x16_bf16(__builtin_bit_cast(bf16x8, w), Pf[s4], O[d], 0, 0, 0); }
    }
    bf16* orow = WSP(bf16, WS_OBR) + 1024 + (size_t)(b * SEQ + qpos) * OBW + h * 128 + 4 * hh;
#pragma unroll
    for (int d = 0; d < 4; ++d)
#pragma unroll
        for (int g = 0; g < 4; ++g) { v2u w; w.x = pk2(O[d][4 * g], O[d][4 * g + 1]); w.y = pk2(O[d][4 * g + 2], O[d][4 * g + 3]); *(v2u*)(orow + 32 * d + 8 * g) = w; }
}

__device__ __forceinline__ void attn_sample_unit(CA A, LAS unsigned char* lds, int layer, int unit, const int wv) {
    const int tid = tid_opaque(wv), lane = tid & 63, wid = tid >> 6, sb = unit >> 5, pg4 = unit & 31, hd = lane >> 4;
    const int lp = 4 * pg4 + (wid >> 1), phys = ((const int*)A->in[I_PT])[sb * NPAGES + lp];
    const size_t pbase = ((size_t)(layer * NPOOL + phys) * PAGE + (wid & 1) * 64) * 512 + lane * 8;
    const float* Kc = IN_F(I_CK) + pbase; const float* Vc = IN_F(I_CV) + pbase;
    const bf16* QKV = WSP(bf16, WS_QKV);
    float qf[4][8], O[4][8], R[4];
#pragma unroll
    for (int i = 0; i < 4; ++i) { const v4u w = *(const v4u*)(QKV + (size_t)(TP + sb * 4 + i) * 1536 + lane * 8);
        qf[i][0] = bflo(w.x); qf[i][1] = bfhi(w.x); qf[i][2] = bflo(w.y); qf[i][3] = bfhi(w.y); qf[i][4] = bflo(w.z); qf[i][5] = bfhi(w.z); qf[i][6] = bflo(w.w); qf[i][7] = bfhi(w.w);
        R[i] = 0.f;
#pragma unroll
        for (int j = 0; j < 8; ++j) O[i][j] = 0.f; }
    const float bias2 = IN_F(I_SBBIAS)[layer * 4 + hd] * LOG2E;
#pragma unroll 4
    for (int t = 63; t >= 0; --t) {
        const f32x4 k0 = *(const f32x4*)(Kc + (size_t)t * 512), k1 = *(const f32x4*)(Kc + (size_t)t * 512 + 4), v0 = *(const f32x4*)(Vc + (size_t)t * 512), v1 = *(const f32x4*)(Vc + (size_t)t * 512 + 4);
#pragma unroll
        for (int i = 0; i < 4; ++i) {
            float s = (qf[i][0] * k0[0] + qf[i][1] * k0[1]) + (qf[i][2] * k0[2] + qf[i][3] * k0[3]) + (qf[i][4] * k1[0] + qf[i][5] * k1[1]) + (qf[i][6] * k1[2] + qf[i][7] * k1[3]);
            s = row16_sum(s);
            const float z = fminf(s + bias2, 60.f), s1 = lg2(1.0f + ex2(z)), pv = ex2(z - s1 - R[i]); R[i] += s1;
#pragma unroll
            for (int e = 0; e < 4; ++e) { O[i][e] += pv * v0[e]; O[i][4 + e] += pv * v1[e]; } }
    }
    LAS float* Ow = (LAS float*)lds;
    LAS float* Rw = Ow + 8 * 4 * 512;
    __syncthreads();
#pragma unroll
    for (int i = 0; i < 4; ++i) { *(LAS f32x4*)(Ow + (wid * 4 + i) * 512 + lane * 8) = (f32x4){O[i][0], O[i][1], O[i][2], O[i][3]}; *(LAS f32x4*)(Ow + (wid * 4 + i) * 512 + lane * 8 + 4) = (f32x4){O[i][4], O[i][5], O[i][6], O[i][7]};
        if ((lane & 15) == 0) Rw[(wid * 4 + i) * 4 + hd] = R[i]; }
    __syncthreads();
    float* PART = WSP(float, WS_PART) + (size_t)unit * 2048; float* PR = WSP(float, WS_PR) + (size_t)unit * 16;
    for (int idx = tid; idx < 2048; idx += NTHR) { const int i = idx >> 9, c = idx & 511, hc = c >> 7; float acc = 0.f, racc = 0.f;
#pragma unroll
        for (int w = 7; w >= 0; --w) { acc += ex2(-racc) * Ow[(w * 4 + i) * 512 + c]; racc += Rw[(w * 4 + i) * 4 + hc]; }
        PART[idx] = acc; if ((c & 127) == 0) PR[i * 4 + hc] = racc; }
}
__device__ __forceinline__ void attn_sample_combine(CA A, int layer, const int wv) {
    {
      const int t0 = tid_opaque(wv), gt = blk_opaque() * NTHR + t0; const float* SQ = WSP(float, WS_SSQ); float* RS = WSP(float, WS_RS);
      for (int idx = gt; idx < TT * 2; idx += gridDim.x * NTHR) { const f32x4* sq = (const f32x4*)(SQ + (size_t)idx * 16); const f32x4 a = sq[0], b = sq[1], c = sq[2], d = sq[3];
          RS[idx] = (((a[0] + a[1]) + (a[2] + a[3]) + (b[0] + b[1]) + (b[2] + b[3])) + ((c[0] + c[1]) + (c[2] + c[3]) + (d[0] + d[1]) + (d[2] + d[3]))) * (1.0f / 512.0f) + RMS_EPS; } }
    const int tid = tid_opaque(wv), lane = tid & 63, gw = blk_opaque() * NWAVES + (tid >> 6), NGW = gridDim.x * NWAVES;
    const bf16* QKV = WSP(bf16, WS_QKV); const float* PART = WSP(float, WS_PART); const float* PR = WSP(float, WS_PR);
    const float* kn = A->out + O_KS + (size_t)layer * TS * 512; const float* vn = A->out + O_VS + (size_t)layer * TS * 512;
    bf16* O2 = WSP(bf16, WS_OBR) + 1024;
    for (int it = gw; it < TS * 4; it += NGW) { const int sb = it >> 4, i = (it >> 2) & 3, hd = it & 3, row = TP + sb * 4 + i, c = hd * 128 + 2 * lane;
        const unsigned qw = *(const unsigned*)(QKV + (size_t)row * 1536 + c); const float q0 = bflo(qw), q1 = bfhi(qw);
        const float bias2 = IN_F(I_SBBIAS)[layer * 4 + hd] * LOG2E; float o0 = 0.f, o1 = 0.f, racc = 0.f;
        for (int j = i - 1; j >= 0; --j) { const float* kr = kn + (size_t)(sb * 4 + j) * 512 + c; const float* vr = vn + (size_t)(sb * 4 + j) * 512 + c;
            const float z = fminf(wave_sum(q0 * kr[0] + q1 * kr[1]) + bias2, 60.f), s1 = lg2(1.0f + ex2(z)), pv = ex2(z - s1 - racc); racc += s1; o0 += pv * vr[0]; o1 += pv * vr[1]; }
        for (int u = 31; u >= 0; --u) { const float* pr = PART + ((size_t)(sb * 32 + u) * 4 + i) * 512 + c; const float sc = ex2(-racc); o0 += sc * pr[0]; o1 += sc * pr[1]; racc += PR[(size_t)(sb * 32 + u) * 16 + i * 4 + hd]; }
        *(unsigned*)(O2 + (size_t)row * OBW + c) = pk2(o0, o1); }
}

#ifndef MK_ONE_LAUNCH
#define MK_ONE_LAUNCH 1
#endif
#ifndef REP_P0
#define REP_P0 1
#endif
#ifndef REP_IN
#define REP_IN 1
#endif
#ifndef REP_PREP
#define REP_PREP 1
#endif
#ifndef REP_MIXA
#define REP_MIXA 1
#endif
#ifndef REP_MIXB
#define REP_MIXB 1
#endif
#ifndef REP_MERGE
#define REP_MERGE 1
#endif
#ifndef REP_OUT
#define REP_OUT 1
#endif
#ifndef REP_UP
#define REP_UP 1
#endif
#ifndef REP_DOWN
#define REP_DOWN 1
#endif
#ifndef REP_BAR
#define REP_BAR 1
#endif
#ifndef REP_RES1L0
#define REP_RES1L0 1
#endif
#ifndef REP_BDN
#define REP_BDN 1
#endif
#ifndef REP_BSSD
#define REP_BSSD 1
#endif
#ifndef REP_BSATT
#define REP_BSATT 1
#endif
constexpr int N_PHASES = 24;
__device__ __forceinline__ int queue_pop(unsigned* head, volatile LAS unsigned* slot, const int wv) {
    __syncthreads();
    if (tid_opaque(wv) == 0) *slot = __hip_atomic_fetch_add(head, 1u, __ATOMIC_RELAXED, __HIP_MEMORY_SCOPE_AGENT);
    __syncthreads();
    return (int)*slot;
}
__global__ void __launch_bounds__(NTHR, 2) mega(Args Araw) {
    extern __shared__ __attribute__((aligned(16))) unsigned char lds_raw[];
    LAS unsigned char* lds = (LAS unsigned char*)lds_raw;
    volatile LAS unsigned* MISC = (volatile LAS unsigned*)(lds + MISC_OFF);
    const int wv = __builtin_amdgcn_readfirstlane(threadIdx.x >> 6); const int tid = tid_opaque(wv), G = gridDim.x, blk = blk_opaque();
    if (tid < 16) MISC[tid] = 0u;
    __syncthreads();
    unsigned* ctl = (unsigned*)(Araw.ws + WS_CTL);
    XcdBarrier bar = xcd_barrier_post(ctl + CW_BAR + Araw.li * XCD_BAR_WORDS, MISC, tid);
    const int lo = Araw.ph_lo, hi = Araw.ph_hi;
#define IN(gp) (lo <= (gp) && (gp) < hi)
#define SEAM(gp) do { if (lo <= (gp) && (gp) + 1 < hi) for (int rb_ = 0; rb_ < REP_BAR; ++rb_) xcd_barrier(bar, tid_opaque(wv)); } while (0)

    if (IN(0)) for (int rep = 0; rep < REP_P0; ++rep) { CA A = args_opaque(); p0_prologue(A, lds, wv); }
    SEAM(0);
    if (IN(1)) { CA A = args_opaque(); norm1_phase(A, wv); }
    SEAM(1);
    for (int layer = 0; layer < DEPTH; ++layer) {
        const int gb = 1 + 11 * layer;
        if (IN(gb + 1)) for (int rep = 0; rep < REP_IN; ++rep) { CA A = args_opaque();
            pg8::Gemm g{WSP(bf16, WS_H), WSP(bf16, WS_WIN) + (size_t)layer * NIN * DM, MP, NIN, DM, DM / 64, 0}; pg8::StaticOrder S; S.init(MP, NIN, G, blk_opaque());
            EpiIn E{WSP(float, WS_UF), WSP(bf16, WS_QKV), WSP(bf16, WS_GATE), A->out + O_KP + (size_t)layer * TP * 512, A->out + O_VP + (size_t)layer * TP * 512,
                    A->out + O_KS + (size_t)layer * TS * 512, A->out + O_VS + (size_t)layer * TS * 512, 0.08838834764831845f * LOG2E};
            pg8::gemm_phase<EpiIn, pg8::StaticOrder, true, true>(lds, g, S, E, wv);
        }
        SEAM(gb + 1);
        if (IN(gb + 2)) for (int rep = 0; rep < REP_PREP; ++rep) { CA A = args_opaque(); prep_phase(A, layer, wv); }
        SEAM(gb + 2);
        if (IN(gb + 3)) for (int rep = 0; rep < REP_MIXA; ++rep) { CA A = args_opaque();
            { unsigned* qh = (unsigned*)(A->ws + WS_CTL) + CW_QUEUE + 64 * (layer * 4 + 3) + 1024 * rep;
              for (;;) { const int u = queue_pop(qh, MISC + 4, wv); if (u >= 2048) break; ssd_prep_unit(A, lds, layer, u, wv); } }
            { unsigned* qh = (unsigned*)(A->ws + WS_CTL) + CW_QUEUE + 64 * (layer * 4 + 2) + 1024 * rep;
              for (;;) { const int u = queue_pop(qh, MISC + 4, wv); if (u >= 512) break; dn_chunk_unit(A, lds, layer, u, wv); } }
        }
        SEAM(gb + 3);
        if (IN(gb + 4)) for (int rep = 0; rep < REP_MIXB; ++rep) { CA A = args_opaque();
            for (int r2 = 0; r2 < REP_BDN; ++r2) for (int t = blk; t < 16; t += G) dn_seq2(A, lds, layer, t, wv);
            for (int r2 = 0; r2 < REP_BSSD; ++r2) for (int t = blk; t < 80; t += G) if (t >= 16) ssd_seq2(A, lds, layer, t - 16, wv);
            for (int t = blk; t < 112; t += G) if (t >= 80) dn_seq(A, lds, layer, t - 80 + 16, wv);
            for (int t = blk; t < 240; t += G) if (t >= 112) ssd_seq(A, lds, layer, t - 112 + 64, wv);
            { unsigned* qh = (unsigned*)(A->ws + WS_CTL) + CW_QUEUE + 64 * (layer * 4 + 0) + 1024 * rep;
              for (;;) { const int u = queue_pop(qh, MISC + 4, wv); if (u >= 128) break; attn_prompt_unit(A, lds, layer, u, wv); } }
            for (int r2 = 0; r2 < REP_BSATT; ++r2) { unsigned* qh = (unsigned*)(A->ws + WS_CTL) + CW_QUEUE + 64 * (layer * 4 + 1) + 1024 * rep + 2048 * r2;
              for (;;) { const int u = queue_pop(qh, MISC + 4, wv); if (u >= 256) break; attn_sample_unit(A, lds, layer, u, wv); } }
        }
        SEAM(gb + 4);
        if (IN(gb + 5)) { CA A = args_opaque(); attn_sample_combine(A, layer, wv);
            { unsigned* qh = (unsigned*)(A->ws + WS_CTL) + 16384 + 64 * layer;
              for (;;) { const int u = queue_pop(qh, MISC + 4, wv); if (u >= 512) break; dn_out_unit(A, lds, layer, u, wv); } } }
        SEAM(gb + 5);
        if (IN(gb + 6)) for (int rep = 0; rep < REP_MERGE; ++rep) { CA A = args_opaque();
            pg8::SegOrder<5> S; S.init(TP, DM, G, blk_opaque());
            pg8::Gemm g{WSP(bf16, WS_OBR), WSP(bf16, WS_WBR) + (size_t)layer * DM * OBW, TP, DM, OBW, 8, 1024};
            EpiMergeR E{WSP(bf16, WS_GATE), WSP(float, WS_RS), WSP(bf16, WS_MGB)};
            pg8::gemm_phase<EpiMergeR, pg8::SegOrder<5>, true, true>(lds, g, S, E, wv);
            sample_merge(A, lds, layer, wv);
        }
        SEAM(gb + 6);
        if (IN(gb + 7)) for (int rep = 0; rep < REP_OUT; ++rep) { CA A = args_opaque();
            pg8::Gemm g{WSP(bf16, WS_MGB), WSP(bf16, WS_WOUT) + (size_t)layer * DM * DM, TP, DM, DM, DM / 64, 0}; pg8::StaticOrder S; S.init(TP, DM, G, blk_opaque());
            EpiF32 E{WSP(float, WS_MIX), DM}; pg8::gemm_phase<EpiF32, pg8::StaticOrder, true, true>(lds, g, S, E, wv);
            { ALBf16 al{WSP(bf16, WS_MGB) + (size_t)TP * DM, DM}; sample_splitk(al, WSP(bf16, WS_WOUT) + (size_t)layer * DM * DM, DM, 128, 16, 4, WSP(float, WS_OUTS), DM, wv); }
        }
        SEAM(gb + 7);
        if (IN(gb + 8)) for (int rep = 0; rep < (layer == 0 ? REP_RES1L0 : 1); ++rep) { CA A = args_opaque(); resid_phase(A, WSP(float, WS_MIX), WSP(float, WS_OUTS), IN_F(I_NMPOST) + layer * DM, IN_F(I_NLPRE) + layer * DM, layer == 0, wv); }
        SEAM(gb + 8);
        if (IN(gb + 9)) for (int rep = 0; rep < REP_UP; ++rep) { CA A = args_opaque();
            pg8::Gemm g{WSP(bf16, WS_H), WSP(bf16, WS_WUP) + (size_t)layer * DFF * DM, TP, DFF, DM, DM / 64, 0}; pg8::StaticOrder S; S.init(TP, DFF, G, blk_opaque());
            EpiRelu2 E{WSP(bf16, WS_F), DFF}; pg8::gemm_phase<EpiRelu2, pg8::StaticOrder, true, true>(lds, g, S, E, wv);
            sample_up(A, lds, layer, wv);
        }
        SEAM(gb + 9);
        if (IN(gb + 10)) for (int rep = 0; rep < REP_DOWN; ++rep) { CA A = args_opaque();
            pg8::Gemm g{WSP(bf16, WS_F), WSP(bf16, WS_WDN) + (size_t)layer * DM * DFF, TP, DM, DFF, DFF / 64, 0}; pg8::StaticOrder S; S.init(TP, DM, G, blk_opaque());
            EpiF32 E{WSP(float, WS_FD), DM}; pg8::gemm_phase<EpiF32, pg8::StaticOrder, true, true>(lds, g, S, E, wv);
            { ALBf16 al{WSP(bf16, WS_F) + (size_t)TP * DFF, DFF}; sample_splitk(al, WSP(bf16, WS_WDN) + (size_t)layer * DM * DFF, DFF, 128, 16, 16, WSP(float, WS_DNS), DM, wv); }
        }
        SEAM(gb + 10);
        if (IN(gb + 11)) { CA A = args_opaque(); resid_phase(A, WSP(float, WS_FD), WSP(float, WS_DNS), IN_F(I_NLPOST) + layer * DM, layer + 1 < DEPTH ? IN_F(I_NMPRE) + (layer + 1) * DM : nullptr, false, wv); }
        SEAM(gb + 11);
    }
#undef IN
#undef SEAM
}

extern "C" void kernel_launch(void* const* d_in, const int* in_sizes, int n_in, void* d_out, int out_size, void* d_ws, size_t ws_size, hipStream_t stream) {
    static int grid = 0;
    if (grid == 0) {
        if (n_in != N_IN || (size_t)out_size != O_END || ws_size < WS_END) { fprintf(stderr, "kernel_launch: unexpected problem (n_in %d, out %d vs %zu, ws %zu vs %zu); nothing launched\n", n_in, out_size, (size_t)O_END, ws_size, (size_t)WS_END); grid = -1; return; }
        int dev = 0, cus = 0, per_cu = 0;
        if (hipGetDevice(&dev) != hipSuccess || hipDeviceGetAttribute(&cus, hipDeviceAttributeMultiprocessorCount, dev) != hipSuccess) { grid = -1; return; }
        if (hipFuncSetAttribute((const void*)mega, hipFuncAttributeMaxDynamicSharedMemorySize, LDS_BYTES) != hipSuccess) { fprintf(stderr, "kernel_launch: hipFuncSetAttribute failed\n"); grid = -1; return; }
        if (hipOccupancyMaxActiveBlocksPerMultiprocessor(&per_cu, (const void*)mega, NTHR, LDS_BYTES) != hipSuccess || per_cu < 1) fprintf(stderr, "kernel_launch: occupancy query says %d blocks per CU\n", per_cu);
        (void)hipGetLastError();
        grid = cus;
    }
    if (grid < 0) return;
    (void)in_sizes;
    hipMemsetAsync((char*)d_ws + WS_CTL, 0, CTL_BYTES, stream);
    Args a{};
    for (int i = 0; i < N_IN; ++i) a.in[i] = d_in[i];
    a.out = (float*)d_out; a.ws = (unsigned char*)d_ws; a.pad = 0;
#if MK_ONE_LAUNCH
    a.ph_lo = 0; a.ph_hi = N_PHASES; a.li = 0;
    hipLaunchKernelGGL(mega, dim3(grid), dim3(NTHR), LDS_BYTES, stream, a);
#else
    for (int gp = 0; gp < N_PHASES; ++gp) { a.ph_lo = gp; a.ph_hi = gp + 1; a.li = 0; hipLaunchKernelGGL(mega, dim3(grid), dim3(NTHR), LDS_BYTES, stream, a); }
#endif
}
```

```cpp
#include <hip/hip_runtime.h>
#include <cstdio>
#include <cstdint>
__device__ __forceinline__ int lane_opaque() { unsigned m = ~0u; asm volatile("" : "+s"(m)); return (int)__builtin_amdgcn_mbcnt_hi(m, __builtin_amdgcn_mbcnt_lo(m, 0u)); }
__device__ __forceinline__ int tid_opaque(int wv) { return wv * 64 + lane_opaque(); }
__device__ __forceinline__ int blk_opaque() { int t = blockIdx.x; asm volatile("" : "+s"(t)); return t; }
namespace pg8 {
#define PG8_LAS __attribute__((address_space(3)))
typedef unsigned short bf16_t;
typedef short bf16x8 __attribute__((ext_vector_type(8)));
typedef float f32x4 __attribute__((ext_vector_type(4)));
typedef unsigned u32x4 __attribute__((ext_vector_type(4)));
constexpr int BM = 256, BK = 64, HALF = 128, HTB = HALF * BK * 2  , STAGE_BYTES = 8 * HTB, NXCD = 8, WGM = 8;

__host__ __device__ __forceinline__ int lds_byte(int r, int c) { const int st = (r >> 4) * 2 + (c >> 5), rr = r & 15, cc = c & 31, ob = rr * 64 + cc * 2; return st * 1024 + (ob ^ (((ob >> 9) & 1) << 5)); }
__host__ __device__ __forceinline__ void stage_rc(int b, int& R, int& C) { const int st = b / 1024, sb = b % 1024, swz = sb ^ (((sb >> 9) & 1) << 5); R = (st >> 1) * 16 + swz / 64; C = (st & 1) * 32 + (swz % 64) / 2; }
__host__ __device__ __forceinline__ int perm32(int rho) { const int n = rho >> 4, i = rho & 15; return 8 * (i >> 2) + 4 * n + (i & 3); }

struct Unit { int pm, pn, seg; };
struct Gemm { const bf16_t* A; const bf16_t* Bt; int M, N, K, KT, SEGB; };

struct StaticOrder {
    int nM, nN, nwg, G, c;
    __host__ __device__ void init(int M, int N, int G_, int c_) { nM = M / BM; nN = N / BM; nwg = nM * nN; G = G_; c = c_; }
    __host__ __device__ bool next(int i, Unit& u) const {
        const long L = (long)i * G + c; if (L >= nwg) return false;
        int wgid = (int)L; { const int q = nwg / NXCD, r = nwg % NXCD, xcd = wgid % NXCD, off = wgid / NXCD; wgid = (xcd < r ? xcd * (q + 1) : r * (q + 1) + (xcd - r) * q) + off; }
        const int nig = WGM * nN, gid = wgid / nig, fm = gid * WGM, gsz = (nM - fm) < WGM ? (nM - fm) : WGM;
        u.pm = fm + ((wgid % nig) % gsz); u.pn = (wgid % nig) / gsz; u.seg = 0; return true;
    }
    __device__ __forceinline__ void a_ready(const Unit&) const {}
    __device__ __forceinline__ void done(const Unit&) const {}
};
template <int NSEG> struct SegOrder : StaticOrder {
    __host__ __device__ bool next(int i, Unit& u) const { if (!StaticOrder::next(i / NSEG, u)) return false; u.seg = i % NSEG; return true; }
};
__device__ __forceinline__ unsigned cvt_pk_bf16(float lo, float hi) { unsigned r; asm volatile("v_cvt_pk_bf16_f32 %0, %1, %2" : "=v"(r) : "v"(lo), "v"(hi)); return r; }
typedef float f32x2 __attribute__((ext_vector_type(2)));
template <class Epi, class Sched, bool ALIGN_EPI = false, bool SP2 = false>
__device__ __forceinline__ void gemm_phase(PG8_LAS unsigned char* lds, const Gemm g, const Sched& S, const Epi& E, const int wv) {
    int wvo = wv; asm volatile("" : "+s"(wvo));
    const int lane = lane_opaque(), tid = wvo * 64 + lane, wid = wvo, wr = wid >> 2, wc = wid & 3, fr = lane & 15, fq = lane >> 4;
    const int K = g.K, nt = g.KT;
    unsigned voffA[2], voffB[2];
#pragma unroll
    for (int i = 0; i < 2; ++i) { int R, C; stage_rc(tid * 16 + i * 8192, R, C); const int Rb = Epi::PERM ? ((R & ~31) + perm32(R & 31)) : R;
        voffA[i] = (unsigned)(R * K + C) * 2u; voffB[i] = (unsigned)(Rb * K + C) * 2u; }
    const size_t kstep = (size_t)(BK * 2);
    const size_t hstep = (size_t)HALF * K * 2;
    const size_t tstep = 2 * hstep;
    const unsigned ldsw = (unsigned)wid * 1024u;
    const int aoff = lds_byte(wr * 64 + fr, fq * 8), boff = lds_byte(wc * 32 + fr, fq * 8);
#define PG8_SA(b, h) (((b) * 2 + (h)) * HTB)
#define PG8_SB(b, h) ((4 + (b) * 2 + (h)) * HTB)
#define PG8_STAGE(bufoff, gbase, voff) do { _Pragma("unroll") for (int _i = 0; _i < 2; ++_i) \
        __builtin_amdgcn_global_load_lds((const unsigned*)((const char*)(gbase) + (voff)[_i]), (PG8_LAS unsigned*)(lds + (bufoff) + ldsw + _i * 8192), 16, 0, 0); } while (0)
#define PG8_LDA(dst, b, h) do { _Pragma("unroll") for (int m = 0; m < 4; ++m) _Pragma("unroll") for (int k = 0; k < 2; ++k) dst[m][k] = *(const PG8_LAS bf16x8*)(lds + PG8_SA(b, h) + aoff + m * 2048 + k * 1024); } while (0)
#define PG8_LDB(dst, b, h) do { _Pragma("unroll") for (int n = 0; n < 2; ++n) _Pragma("unroll") for (int k = 0; k < 2; ++k) dst[n][k] = *(const PG8_LAS bf16x8*)(lds + PG8_SB(b, h) + boff + n * 2048 + k * 1024); } while (0)
#define PG8_MMA(ai, bj, At, Bt) do { __builtin_amdgcn_s_setprio(1); _Pragma("unroll") for (int m = 0; m < 4; ++m) _Pragma("unroll") for (int n = 0; n < 2; ++n) _Pragma("unroll") for (int k = 0; k < 2; ++k) \
        acc[ai][bj][m][n] = __builtin_amdgcn_mfma_f32_16x16x32_bf16(Bt[n][k], At[m][k], acc[ai][bj][m][n], 0, 0, 0); __builtin_amdgcn_s_setprio(0); } while (0)
#define PG8_WAIT_V(n) asm volatile("s_waitcnt vmcnt(" #n ")" ::: "memory")
#define PG8_WAIT_L(n) asm volatile("s_waitcnt lgkmcnt(" #n ")" ::: "memory")
#define PG8_BAR __builtin_amdgcn_s_barrier()
#define PG8_SCHED __builtin_amdgcn_sched_barrier(0)
    Unit cur, nxt; int ui = 0;
    if (!S.next(0, cur)) return;
    f32x4 acc[2][2][4][2];
#pragma unroll
    for (int a = 0; a < 2; ++a)
#pragma unroll
        for (int b = 0; b < 2; ++b)
#pragma unroll
            for (int m = 0; m < 4; ++m)
#pragma unroll
                for (int n = 0; n < 2; ++n) acc[a][b][m][n] = (f32x4){0.f, 0.f, 0.f, 0.f};
    bf16x8 At[4][2], B0[2][2], B1[2][2];
    const char* cA = (const char*)g.A + (size_t)cur.pm * tstep + (size_t)cur.seg * g.SEGB; const char* cB = (const char*)g.Bt + (size_t)cur.pn * tstep + (size_t)cur.seg * g.SEGB;
    S.a_ready(cur);
    if constexpr (SP2) {
        PG8_STAGE(PG8_SB(0, 0), cB, voffB); PG8_STAGE(PG8_SB(0, 1), cB + hstep, voffB); PG8_STAGE(PG8_SA(0, 0), cA, voffA); PG8_STAGE(PG8_SA(0, 1), cA + hstep, voffA);
        if (wr == 1) PG8_BAR;
        PG8_WAIT_V(2); PG8_BAR;
        PG8_STAGE(PG8_SB(1, 0), cB + kstep, voffB); PG8_STAGE(PG8_SA(1, 0), cA + kstep, voffA); PG8_STAGE(PG8_SB(1, 1), cB + hstep + kstep, voffB);
        PG8_WAIT_V(6); PG8_BAR;
    } else {
        PG8_STAGE(PG8_SB(0, 0), cB, voffB); PG8_STAGE(PG8_SA(0, 0), cA, voffA); PG8_STAGE(PG8_SB(0, 1), cB + hstep, voffB); PG8_STAGE(PG8_SA(0, 1), cA + hstep, voffA);
        if (wr == 1) PG8_BAR;
        PG8_WAIT_V(4); PG8_BAR;
        PG8_STAGE(PG8_SB(1, 0), cB + kstep, voffB); PG8_STAGE(PG8_SA(1, 0), cA + kstep, voffA); PG8_STAGE(PG8_SB(1, 1), cB + hstep + kstep, voffB);
        PG8_WAIT_V(6); PG8_BAR;
    }
    for (;;) {
        const bool has_next = S.next(ui + 1, nxt);
        const char* nA = has_next ? (const char*)g.A + (size_t)nxt.pm * tstep + (size_t)nxt.seg * g.SEGB : cA; const char* nB = has_next ? (const char*)g.Bt + (size_t)nxt.pn * tstep + (size_t)nxt.seg * g.SEGB : cB;
        for (int t = 0; t < nt; t += 2) {
            const bool last = (t == nt - 2);
            const char* a1 = cA + (size_t)(t + 1) * kstep;
            const char* a2 = last ? nA : cA + (size_t)(t + 2) * kstep; const char* b2 = last ? nB : cB + (size_t)(t + 2) * kstep;
            const char* a3 = a2 + kstep; const char* b3 = b2 + kstep;
            if (last && has_next) S.a_ready(nxt);
            if constexpr (SP2) {
            PG8_LDB(B0, 0, 0); PG8_LDB(B1, 0, 1); PG8_SCHED; PG8_LDA(At, 0, 0); PG8_STAGE(PG8_SA(1, 1), a1 + hstep, voffA);
            PG8_WAIT_V(8); PG8_WAIT_L(0); PG8_BAR; PG8_MMA(0, 0, At, B0); PG8_MMA(0, 1, At, B1); PG8_BAR; PG8_SCHED;
            PG8_LDA(At, 0, 1); PG8_STAGE(PG8_SB(0, 0), b2, voffB); PG8_STAGE(PG8_SB(0, 1), b2 + hstep, voffB); PG8_STAGE(PG8_SA(0, 0), a2, voffA);
            PG8_WAIT_V(8); PG8_WAIT_L(0); PG8_BAR; PG8_MMA(1, 0, At, B0); PG8_MMA(1, 1, At, B1); PG8_BAR; PG8_SCHED;
            PG8_LDB(B0, 1, 0); PG8_LDB(B1, 1, 1); PG8_SCHED; PG8_LDA(At, 1, 0); PG8_STAGE(PG8_SA(0, 1), a2 + hstep, voffA);
            PG8_WAIT_V(8); PG8_WAIT_L(0); PG8_BAR; PG8_MMA(0, 0, At, B0); PG8_MMA(0, 1, At, B1); PG8_BAR; PG8_SCHED;
            PG8_LDA(At, 1, 1); PG8_STAGE(PG8_SB(1, 0), b3, voffB); PG8_STAGE(PG8_SB(1, 1), b3 + hstep, voffB); PG8_STAGE(PG8_SA(1, 0), a3, voffA);
            PG8_WAIT_V(8); PG8_WAIT_L(0); PG8_BAR; PG8_MMA(1, 0, At, B0); PG8_MMA(1, 1, At, B1); PG8_BAR; PG8_SCHED;
            } else {
            PG8_LDB(B0, 0, 0); PG8_SCHED; PG8_LDA(At, 0, 0); PG8_STAGE(PG8_SA(1, 1), a1 + hstep, voffA);
            PG8_WAIT_L(8); PG8_BAR; PG8_WAIT_L(0); PG8_MMA(0, 0, At, B0); PG8_BAR; PG8_SCHED;
            PG8_LDB(B1, 0, 1); PG8_STAGE(PG8_SB(0, 0), b2, voffB);
            PG8_BAR; PG8_WAIT_L(0); PG8_MMA(0, 1, At, B1); PG8_BAR;
            PG8_LDA(At, 0, 1); PG8_STAGE(PG8_SA(0, 0), a2, voffA);
            PG8_BAR; PG8_WAIT_L(0); PG8_MMA(1, 0, At, B0); PG8_BAR; PG8_SCHED;
            PG8_STAGE(PG8_SB(0, 1), b2 + hstep, voffB);
            PG8_WAIT_V(6); PG8_BAR; PG8_MMA(1, 1, At, B1); PG8_BAR;
            PG8_LDB(B0, 1, 0); PG8_SCHED; PG8_LDA(At, 1, 0); PG8_STAGE(PG8_SA(0, 1), a2 + hstep, voffA);
            PG8_WAIT_L(8); PG8_BAR; PG8_WAIT_L(0); PG8_MMA(0, 0, At, B0); PG8_BAR; PG8_SCHED;
            PG8_LDB(B1, 1, 1); PG8_STAGE(PG8_SB(1, 0), b3, voffB);
            PG8_BAR; PG8_WAIT_L(0); PG8_MMA(0, 1, At, B1); PG8_BAR;
            PG8_LDA(At, 1, 1); PG8_STAGE(PG8_SA(1, 0), a3, voffA);
            PG8_BAR; PG8_WAIT_L(0); PG8_MMA(1, 0, At, B0); PG8_BAR; PG8_SCHED;
            PG8_STAGE(PG8_SB(1, 1), b3 + hstep, voffB);
            PG8_WAIT_V(6); PG8_BAR; PG8_MMA(1, 1, At, B1); PG8_BAR;
            }
        }
        if constexpr (ALIGN_EPI) { if (wr == 0) PG8_BAR; }
        if constexpr (!Epi::AFTER_DRAIN) { E(acc, cur, wr, wc, fr, fq); S.done(cur); }
        if (!has_next) break;
        if (!(Epi::KEEP_ACC && nxt.seg != 0)) {
#pragma unroll
        for (int a = 0; a < 2; ++a)
#pragma unroll
            for (int b = 0; b < 2; ++b)
#pragma unroll
                for (int m = 0; m < 4; ++m)
#pragma unroll
                    for (int n = 0; n < 2; ++n) acc[a][b][m][n] = (f32x4){0.f, 0.f, 0.f, 0.f}; }
        cur = nxt; cA = nA; cB = nB; ++ui;
        if constexpr (ALIGN_EPI) { if (wr == 1) PG8_BAR; }
    }
    PG8_WAIT_V(0);
    if constexpr (!ALIGN_EPI) { if (wr == 0) PG8_BAR; }
    PG8_BAR;
    if constexpr (Epi::AFTER_DRAIN) { E.fused(acc, cur, wr, wc, fr, fq, lds, wid, lane); S.done(cur); }
#undef PG8_SA
#undef PG8_SB
#undef PG8_STAGE
#undef PG8_LDA
#undef PG8_LDB
#undef PG8_MMA
#undef PG8_WAIT_V
#undef PG8_WAIT_L
#undef PG8_BAR
#undef PG8_SCHED
}
}

constexpr int DM = 2048, NBATCH = 4, SEQ = 2048, DEPTH = 2, DBATCH = 8, DSEQ = 4, PAST = 16384, PAGE = 128;
constexpr int TP = NBATCH * SEQ;
constexpr int TS = DBATCH * DSEQ;
constexpr int TT = TP + TS;
constexpr int MP = 8448;
constexpr int NPAGES = PAST / PAGE;
constexpr int NPOOL = 1280;
constexpr int POOLW = 512, DNC = 1536, SBW = 512, SSI = 1024, SSC = 1536, DFF = 8192;
constexpr int INCOLS = 14872, NIN = 15104;
constexpr int OBW = 2560;
constexpr int UFW = 5376;
constexpr int UF_POOL = 0, UF_DNQKV = 512, UF_DNZ = 2048, UF_SSZ = 2560, UF_XBC = 3584, UF_SMALL = 5120;
constexpr float RMS_EPS = 1e-6f;
constexpr float LOG2E = 1.4426950408889634f;
constexpr int NWAVES = 8, NTHR = 512;

constexpr size_t O_Y = 0;
constexpr size_t O_KP = O_Y + (size_t)TT * DM;
constexpr size_t O_VP = O_KP + (size_t)DEPTH * TP * 512;
constexpr size_t O_POOLP = O_VP + (size_t)DEPTH * TP * 512;
constexpr size_t O_DNCP = O_POOLP + (size_t)DEPTH * NBATCH * 15 * 512;
constexpr size_t O_DNSP = O_DNCP + (size_t)DEPTH * NBATCH * 3 * 1536;
constexpr size_t O_SSCP = O_DNSP + (size_t)DEPTH * NBATCH * 4 * 128 * 128;
constexpr size_t O_SSHP = O_SSCP + (size_t)DEPTH * NBATCH * 3 * 1536;
constexpr size_t O_KS = O_SSHP + (size_t)DEPTH * NBATCH * 16 * 64 * 128;
constexpr size_t O_VS = O_KS + (size_t)DEPTH * TS * 512;
constexpr size_t O_POOLS = O_VS + (size_t)DEPTH * TS * 512;
constexpr size_t O_DNCS = O_POOLS + (size_t)DEPTH * DBATCH * 15 * 512;
constexpr size_t O_DNSS = O_DNCS + (size_t)DEPTH * DBATCH * 3 * 1536;
constexpr size_t O_SSCS = O_DNSS + (size_t)DEPTH * DBATCH * 4 * 128 * 128;
constexpr size_t O_SSHS = O_SSCS + (size_t)DEPTH * DBATCH * 3 * 1536;
constexpr size_t O_END = O_SSHS + (size_t)DEPTH * DBATCH * 16 * 64 * 128;

constexpr size_t al256(size_t x) { return (x + 255) & ~(size_t)255; }
constexpr size_t WS_CTL = 0, CTL_BYTES = 1u << 20;
constexpr size_t SZ_WIN = (size_t)NIN * DM * 2, SZ_WBR = (size_t)5 * DM * 512 * 2, SZ_WOUT = (size_t)DM * DM * 2, SZ_WUP = (size_t)DFF * DM * 2, SZ_WDN = (size_t)DM * DFF * 2;
constexpr size_t WS_WIN = WS_CTL + CTL_BYTES;
constexpr size_t WS_WBR = WS_WIN + 2 * SZ_WIN;
constexpr size_t WS_WOUT = WS_WBR + 2 * SZ_WBR;
constexpr size_t WS_WUP = WS_WOUT + 2 * SZ_WOUT;
constexpr size_t WS_WDN = WS_WUP + 2 * SZ_WUP;
constexpr size_t WS_H = WS_WDN + 2 * SZ_WDN;
constexpr size_t WS_UF = WS_H + (size_t)MP * DM * 2;
constexpr size_t WS_QKV = WS_UF + (size_t)MP * UFW * 4;
constexpr size_t WS_GATE = WS_QKV + (size_t)MP * 1536 * 2;
constexpr size_t WS_DNQ = WS_GATE + (size_t)MP * 8192 * 2;
constexpr size_t WS_XBC = WS_DNQ + (size_t)MP * 1536 * 4;
constexpr size_t WS_SCAL = WS_XBC + (size_t)MP * 1536 * 4;
constexpr size_t WS_OBR = WS_SCAL + (size_t)MP * 32 * 4;
constexpr size_t SZ_OBR = (size_t)MP * 512 * 2;
constexpr size_t WS_SSQ = WS_OBR + 5 * SZ_OBR;
constexpr size_t WS_MG32 = WS_SSQ + (size_t)MP * 32 * 4;
constexpr size_t WS_MGB = WS_MG32 + (size_t)MP * DM * 4;
constexpr size_t WS_MIX = WS_MGB + (size_t)MP * DM * 2;
constexpr size_t WS_F = WS_MIX + (size_t)MP * DM * 4;
constexpr size_t WS_FD = WS_F + (size_t)MP * DFF * 2;
constexpr size_t WS_PART = WS_FD + (size_t)MP * DM * 4;
constexpr size_t WS_PR = WS_PART + (size_t)256 * 2048 * 4;
constexpr size_t WS_DNU = WS_PR + (size_t)256 * 16 * 4;
constexpr size_t WS_SSU = WS_DNU + (size_t)512 * 90368;
constexpr size_t WS_SSG = WS_SSU + (size_t)2048 * 16896;
constexpr size_t WS_MGS = WS_SSG + (size_t)256 * 49152;
constexpr size_t WS_OUTS = WS_MGS + (size_t)5 * TS * DM * 4;
constexpr size_t WS_UPS = WS_OUTS + (size_t)16 * TS * DM * 4;
constexpr size_t WS_DNS = WS_UPS + (size_t)4 * TS * DFF * 4;
constexpr size_t WS_RS = WS_DNS + (size_t)16 * TS * DM * 4;
constexpr size_t WS_DNSV = WS_RS + (size_t)MP * 2 * 4;
constexpr size_t WS_END = WS_DNSV + (size_t)512 * 49152;
static_assert(WS_WIN % 256 == 0 && WS_H % 256 == 0 && WS_UF % 256 == 0 && WS_OBR % 256 == 0 && WS_MG32 % 256 == 0 && WS_PART % 256 == 0, "ws alignment");

constexpr int CW_QUEUE = 64;
constexpr int CW_BAR = 4096;

constexpr int LDS_BYTES = 147456;
constexpr int RING_BYTES = 131072;
constexpr int MISC_OFF = RING_BYTES;

#define GAS __attribute__((address_space(1)))
#define LAS __attribute__((address_space(3)))
typedef unsigned short bf16;
typedef unsigned v4u __attribute__((ext_vector_type(4)));
typedef unsigned v2u __attribute__((ext_vector_type(2)));
typedef float f32x4 __attribute__((ext_vector_type(4)));
typedef float f32x2 __attribute__((ext_vector_type(2)));
typedef float f32x16 __attribute__((ext_vector_type(16)));
typedef short bf16x8 __attribute__((ext_vector_type(8)));
typedef __bf16 bf16x2_t __attribute__((ext_vector_type(2)));
__device__ __forceinline__ unsigned pk2(float lo, float hi) { const f32x2 v = {lo, hi}; return __builtin_bit_cast(unsigned, __builtin_convertvector(v, bf16x2_t)); }
__device__ __forceinline__ unsigned f2bf(float f) { return pk2(f, f) & 0xffffu; }
__device__ __forceinline__ float bflo(unsigned w) { return __builtin_bit_cast(float, w << 16); }
__device__ __forceinline__ float bfhi(unsigned w) { return __builtin_bit_cast(float, w & 0xffff0000u); }
__device__ __forceinline__ float row16_sum(float x) {
    x += __builtin_bit_cast(float, __builtin_amdgcn_update_dpp(0, __builtin_bit_cast(int, x), 0x128, 0xf, 0xf, false));
    x += __builtin_bit_cast(float, __builtin_amdgcn_update_dpp(0, __builtin_bit_cast(int, x), 0x124, 0xf, 0xf, false));
    x += __builtin_bit_cast(float, __builtin_amdgcn_update_dpp(0, __builtin_bit_cast(int, x), 0x122, 0xf, 0xf, false));
    x += __builtin_bit_cast(float, __builtin_amdgcn_update_dpp(0, __builtin_bit_cast(int, x), 0x121, 0xf, 0xf, false));
    return x;
}
__device__ __forceinline__ float rdlane(float x, int l) { return __builtin_bit_cast(float, __builtin_amdgcn_readlane(__builtin_bit_cast(int, x), l)); }
__device__ __forceinline__ float wave_sum(float v) { const float r = row16_sum(v); return (rdlane(r, 0) + rdlane(r, 16)) + (rdlane(r, 32) + rdlane(r, 48)); }
__device__ __forceinline__ float wave_scan(float x, int lane) {
    x += __builtin_bit_cast(float, __builtin_amdgcn_update_dpp(0, __builtin_bit_cast(int, x), 0x111, 0xf, 0xf, true));
    x += __builtin_bit_cast(float, __builtin_amdgcn_update_dpp(0, __builtin_bit_cast(int, x), 0x112, 0xf, 0xf, true));
    x += __builtin_bit_cast(float, __builtin_amdgcn_update_dpp(0, __builtin_bit_cast(int, x), 0x114, 0xf, 0xf, true));
    x += __builtin_bit_cast(float, __builtin_amdgcn_update_dpp(0, __builtin_bit_cast(int, x), 0x118, 0xf, 0xf, true));
    const float t0 = rdlane(x, 15), t1 = rdlane(x, 31), t2 = rdlane(x, 47);
    return x + (lane >= 48 ? (t0 + t1) + t2 : (lane >= 32 ? t0 + t1 : (lane >= 16 ? t0 : 0.f)));
}
__device__ __forceinline__ float fexp(float x) { return __builtin_amdgcn_exp2f(x * 1.4426950408889634f); }
__device__ __forceinline__ float sigmoidf_(float x) { return 1.0f / (1.0f + __expf(-x)); }
__device__ __forceinline__ float siluf_(float x) { return x / (1.0f + __expf(-x)); }
__device__ __forceinline__ float softplusf_(float x) { const float e = fexp(fminf(x, 20.f)); const float l = e < 0.01f ? e * (1.0f - e * (0.5f - e * 0.33333333f)) : __builtin_amdgcn_logf(1.0f + e) * 0.6931471805599453f; return x > 20.f ? x : l; }
__device__ __forceinline__ float ex2(float x) { return __builtin_amdgcn_exp2f(x); }
__device__ __forceinline__ float lg2(float x) { return __builtin_amdgcn_logf(x); }
#define XB_TMO      128
#define XB_XCNT(j)  (256  + 64 * (j))
#define XB_XSUB(j)  (1280 + 64 * (j))
#define XB_XGEN(j)  (2304 + 64 * (j))
#define XB_TOP      3328
#define XB_TOPGEN   3392
#define XCD_BAR_WORDS 3456
#define XB_SPIN_CAP (1u << 18)

__device__ __forceinline__ unsigned xb_ld(unsigned* p)              { return __hip_atomic_load(p, __ATOMIC_RELAXED, __HIP_MEMORY_SCOPE_AGENT); }
__device__ __forceinline__ unsigned xb_add(unsigned* p, unsigned v) { return __hip_atomic_fetch_add(p, v, __ATOMIC_RELAXED, __HIP_MEMORY_SCOPE_AGENT); }
__device__ __forceinline__ unsigned xb_xcc_id() { return (unsigned)__builtin_amdgcn_s_getreg((3 << 11) | 20) & 0xFu; }
#define XB_SPIN(cond, bar) do { unsigned _sp = 0; while (cond) { __builtin_amdgcn_s_sleep(1); \
    if ((++_sp & 255u) == 0u) { if (xb_ld(&(bar)[XB_TMO])) break; if (_sp > XB_SPIN_CAP) { atomicAdd(&(bar)[XB_TMO], 1u); break; } } } } while (0)

struct XcdBarrier {
    unsigned* bar; unsigned x;
    volatile LAS unsigned* st;
};

__device__ __forceinline__ XcdBarrier xcd_barrier_post(unsigned* bar, volatile LAS unsigned* st, const int tid) {
    XcdBarrier b; b.bar = bar; b.x = xb_xcc_id(); b.st = st;
    if (tid == 0) (void)xb_add(&bar[XB_XCNT(b.x)], 1u);
    return b;
}
__device__ __forceinline__ void xcd_barrier_complete(unsigned* bar, unsigned x, unsigned& nloc, unsigned& nx) {
    const unsigned G = gridDim.x * gridDim.y * gridDim.z;
    unsigned sum, cnt, mine, sp = 0u;
    for (;;) {
        sum = 0u; cnt = 0u; mine = 0u;
#pragma unroll
        for (unsigned j = 0; j < 16; ++j) { const unsigned c = xb_ld(&bar[XB_XCNT(j)]); sum += c; cnt += (c > 0u) ? 1u : 0u; mine = (j == x) ? c : mine; }
        if (sum == G) break;
        __builtin_amdgcn_s_sleep(1);
        if ((++sp & 255u) == 0u) { if (xb_ld(&bar[XB_TMO])) break; if (sp > XB_SPIN_CAP) { atomicAdd(&bar[XB_TMO], 1u); break; } }
    }
    nloc = mine > 0u ? mine : 1u; nx = cnt > 0u ? cnt : 1u;
}

__device__ __forceinline__ void xcd_barrier(const XcdBarrier& b, const int tid) {
    asm volatile("s_waitcnt vmcnt(0)" ::: "memory");
    __syncthreads();
    if (tid == 0) {
        unsigned* bar = b.bar;
        __builtin_amdgcn_s_waitcnt(0);
        unsigned nloc = b.st[0], nx = b.st[1];
        if (nloc == 0u) { xcd_barrier_complete(bar, b.x, nloc, nx); b.st[0] = nloc; b.st[1] = nx; }
        const unsigned old = xb_add(&bar[XB_XSUB(b.x)], 1u);
        const unsigned gen = old / nloc;
        if (old + 1u == (gen + 1u) * nloc) {
            __builtin_amdgcn_fence(__ATOMIC_RELEASE, "agent");
            asm volatile("s_waitcnt vmcnt(0)" ::: "memory");
            const unsigned og = xb_add(&bar[XB_TOP], 1u);
            const unsigned tg = og / nx;
            if (og + 1u == (tg + 1u) * nx) xb_add(&bar[XB_TOPGEN], 1u);
            else XB_SPIN(xb_ld(&bar[XB_TOPGEN]) == tg, bar);
            __builtin_amdgcn_fence(__ATOMIC_ACQUIRE, "agent");
            xb_add(&bar[XB_XGEN(b.x)], 1u);
            asm volatile("s_waitcnt vmcnt(0)" ::: "memory");
        } else {
            XB_SPIN(xb_ld(&bar[XB_XGEN(b.x)]) == gen, bar);
            __builtin_amdgcn_fence(__ATOMIC_ACQUIRE, "agent");
            asm volatile("s_waitcnt vmcnt(0)" ::: "memory");
        }
    }
    __syncthreads();
}

enum { I_XP = 0, I_XS, I_CK, I_CV, I_SPOOL, I_SDNC, I_SDNS, I_SSSC, I_SSSH, I_PT, I_NMPRE, I_NMPOST, I_NLPRE, I_NLPOST, I_WIN, I_POOLW, I_POOLSC, I_DNCW, I_DNALOG, I_DNDTB, I_DNNW, I_SBBIAS,
       I_SSCW, I_SSCB, I_SSALOG, I_SSDTB, I_SSD, I_SSNW, I_WBR, I_WOUT, I_WUP, I_WDN, N_IN };
struct Args { const void* in[N_IN]; float* out; unsigned char* ws; int ph_lo, ph_hi, li, pad; };
#define IN_F(i) ((const float*)A->in[i])
#define WSP(T, off) ((T*)(A->ws + (off)))
typedef const __attribute__((opencl_constant)) Args* CA;
__device__ __forceinline__ CA args_opaque() { auto p = __builtin_amdgcn_kernarg_segment_ptr(); asm volatile("" : "+s"(p)); return (CA)p; }

struct EpiIn {
    static constexpr bool PERM = true, AFTER_DRAIN = false, KEEP_ACC = false;
    float* UF; bf16* QKV; bf16* GATE; float *kp, *vp, *ks, *vs; float qscale;
    __device__ __forceinline__ void operator()(f32x4 (&acc)[2][2][4][2], const pg8::Unit& u, int wr, int wc, int fr, int fq) const {
        const int pn = u.pn, row0 = u.pm * 256 + wr * 64 + fr, cl = wc * 32 + 8 * fq;
        if (pn < 10 || (pn >= 16 && pn < 26) || pn == 58) {
            const int col0 = pn * 256 + (pn < 10 ? 0 : (pn < 26 ? -1536 : -9728)) + cl;
#pragma unroll
            for (int ai = 0; ai < 2; ++ai)
#pragma unroll
                for (int m = 0; m < 4; ++m) { float* rowp = UF + (size_t)(row0 + ai * 128 + m * 16) * UFW + col0;
#pragma unroll
                    for (int bj = 0; bj < 2; ++bj) { *(f32x4*)(rowp + bj * 128) = acc[ai][bj][m][0]; *(f32x4*)(rowp + bj * 128 + 4) = acc[ai][bj][m][1]; } }
        } else if (pn < 16) {
            const int which = (pn - 10) >> 1, c512 = ((pn - 10) & 1) * 256 + cl; const float sc = which == 0 ? qscale : 1.f;
#pragma unroll
            for (int ai = 0; ai < 2; ++ai)
#pragma unroll
                for (int m = 0; m < 4; ++m) { const int r = row0 + ai * 128 + m * 16; bf16* rowp = QKV + (size_t)r * 1536 + which * 512 + c512;
                    float* fo = nullptr;
                    if (which) { if (r < TP) fo = (which == 1 ? kp : vp) + (size_t)r * 512 + c512; else if (r < TT) fo = (which == 1 ? ks : vs) + (size_t)(r - TP) * 512 + c512; }
#pragma unroll
                    for (int bj = 0; bj < 2; ++bj) { const f32x4 v0 = acc[ai][bj][m][0], v1 = acc[ai][bj][m][1];
                        v4u w; w.x = pk2(v0[0] * sc, v0[1] * sc); w.y = pk2(v0[2] * sc, v0[3] * sc); w.z = pk2(v1[0] * sc, v1[1] * sc); w.w = pk2(v1[2] * sc, v1[3] * sc);
                        *(v4u*)(rowp + bj * 128) = w;
                        if (fo) { *(f32x4*)(fo + bj * 128) = v0; *(f32x4*)(fo + bj * 128 + 4) = v1; } } }
        } else {
            const int oc = (pn - 26) * 64 + wc * 16 + 4 * fq;
#pragma unroll
            for (int ai = 0; ai < 2; ++ai)
#pragma unroll
                for (int m = 0; m < 4; ++m) { const int r = row0 + ai * 128 + m * 16; bf16* rowp = GATE + (size_t)r * 8192 + oc;
                    f32x4 t[4];
#pragma unroll
                    for (int i = 0; i < 4; ++i)
#pragma unroll
                        for (int e = 0; e < 4; ++e) t[i][e] = 1.0f + fexp(-fminf(fmaxf(acc[ai][i >> 1][m][i & 1][e], -30.f), 30.f));
                    f32x4 o[4];
                    if (r < TP) {
#pragma unroll
                        for (int e = 0; e < 4; ++e) { const float i0 = __builtin_amdgcn_rcpf(t[0][e]), i1 = __builtin_amdgcn_rcpf(t[1][e]), i2 = __builtin_amdgcn_rcpf(t[2][e]), i3 = __builtin_amdgcn_rcpf(t[3][e]);
                            o[0][e] = t[1][e] * i0; o[1][e] = t[2][e] * i1; o[2][e] = t[3][e] * i2; o[3][e] = i3; }
                    } else {
#pragma unroll
                        for (int i = 0; i < 4; ++i)
#pragma unroll
                            for (int e = 0; e < 4; ++e) o[i][e] = __builtin_amdgcn_rcpf(t[i][e]);
                    }
#pragma unroll
                    for (int i = 0; i < 4; ++i) { v2u w; w.x = pk2(o[i][0], o[i][1]); w.y = pk2(o[i][2], o[i][3]); *(v2u*)(rowp + i * 2048) = w; } }
        }
    }
};
struct EpiMergeR {
    static constexpr bool PERM = true, AFTER_DRAIN = false, KEEP_ACC = true;
    const bf16* GATE; const float* RS; bf16* MGB;
    __device__ __forceinline__ void operator()(f32x4 (&acc)[2][2][4][2], const pg8::Unit& u, int wr, int wc, int fr, int fq) const {
        const unsigned row0 = (unsigned)(u.pm * 256 + wr * 64 + fr), col0 = (unsigned)(u.pn * 256 + wc * 32 + 8 * fq); const int seg = u.seg;
        const unsigned gofs = row0 * 8192u + (seg < 3 ? seg : 3) * 2048u + col0, oofs = row0 * 2048u + col0; const bool last = seg == 4;
        const float w2 = seg == 2 ? 1.f : 0.f, w3 = seg == 3 ? 1.f : 0.f, w4 = last ? 1.f : 0.f, w0 = 1.f - w2 - w3 - w4, ug = 1.f - w3;
#pragma unroll
        for (int ai = 0; ai < 2; ++ai)
#pragma unroll
            for (int m = 0; m < 4; ++m) { const unsigned rr = ai * 128 + m * 16; const f32x2 qq = *(const f32x2*)(RS + (row0 + rr) * 2u);
                const float r1 = __builtin_amdgcn_rsqf(qq[1]), rf = w0 + w2 * __builtin_amdgcn_sqrtf(qq[0]) + w3 * (__builtin_amdgcn_sqrtf(qq[1]) * __builtin_amdgcn_rsqf(qq[0])) + w4 * r1, rg = rf * ug, rc = rf * w3;
#pragma unroll
                for (int bj = 0; bj < 2; ++bj) { const v4u gg = *(const v4u*)(GATE + (gofs + rr * 8192u + bj * 128u));
                    f32x4& v0 = acc[ai][bj][m][0]; f32x4& v1 = acc[ai][bj][m][1];
                    v0[0] *= bflo(gg.x) * rg + rc; v0[1] *= bfhi(gg.x) * rg + rc; v0[2] *= bflo(gg.y) * rg + rc; v0[3] *= bfhi(gg.y) * rg + rc;
                    v1[0] *= bflo(gg.z) * rg + rc; v1[1] *= bfhi(gg.z) * rg + rc; v1[2] *= bflo(gg.w) * rg + rc; v1[3] *= bfhi(gg.w) * rg + rc;
                    if (last) { v4u w; w.x = pk2(v0[0], v0[1]); w.y = pk2(v0[2], v0[3]); w.z = pk2(v1[0], v1[1]); w.w = pk2(v1[2], v1[3]); *(v4u*)(MGB + (oofs + rr * 2048u + bj * 128u)) = w; } }
                asm volatile("" ::: "memory"); }
    }
};
struct EpiF32 {
    static constexpr bool PERM = true, AFTER_DRAIN = false, KEEP_ACC = false;
    float* C; int ldc;
    __device__ __forceinline__ void operator()(f32x4 (&acc)[2][2][4][2], const pg8::Unit& u, int wr, int wc, int fr, int fq) const {
        const int row0 = u.pm * 256 + wr * 64 + fr, col0 = u.pn * 256 + wc * 32 + 8 * fq;
#pragma unroll
        for (int ai = 0; ai < 2; ++ai)
#pragma unroll
            for (int m = 0; m < 4; ++m) { float* rowp = C + (size_t)(row0 + ai * 128 + m * 16) * ldc + col0;
#pragma unroll
                for (int bj = 0; bj < 2; ++bj) { *(f32x4*)(rowp + bj * 128) = acc[ai][bj][m][0]; *(f32x4*)(rowp + bj * 128 + 4) = acc[ai][bj][m][1]; } }
    }
};
struct EpiRelu2 {
    static constexpr bool PERM = true, AFTER_DRAIN = false, KEEP_ACC = false;
    bf16* O; int ldc;
    __device__ __forceinline__ void operator()(f32x4 (&acc)[2][2][4][2], const pg8::Unit& u, int wr, int wc, int fr, int fq) const {
        const int row0 = u.pm * 256 + wr * 64 + fr, col0 = u.pn * 256 + wc * 32 + 8 * fq;
#pragma unroll
        for (int ai = 0; ai < 2; ++ai)
#pragma unroll
            for (int m = 0; m < 4; ++m) { bf16* rowp = O + (size_t)(row0 + ai * 128 + m * 16) * ldc + col0;
#pragma unroll
                for (int bj = 0; bj < 2; ++bj) { f32x4 v0 = acc[ai][bj][m][0], v1 = acc[ai][bj][m][1];
#pragma unroll
                    for (int e = 0; e < 4; ++e) { const float a = fmaxf(v0[e], 0.f), b = fmaxf(v1[e], 0.f); v0[e] = a * a; v1[e] = b * b; }
                    v4u w; w.x = pk2(v0[0], v0[1]); w.y = pk2(v0[2], v0[3]); w.z = pk2(v1[0], v1[1]); w.w = pk2(v1[2], v1[3]); *(v4u*)(rowp + bj * 128) = w; } }
    }
};

__device__ __forceinline__ int win_src_col(int n) {
    if (n < 2560) return n;
    if (n < 6656) return n + 8;
    if (n < 14848) { const int t = n - 6656, pg = t >> 8, c = t & 255;
        return 6680 + (2 * (c >> 7) + ((c >> 2) & 1)) * 2048 + 64 * pg + 16 * ((c >> 5) & 3) + 4 * ((c >> 3) & 3) + (c & 3); }
    if (n < 14856) return n - 14848 + 2560;
    if (n < 14872) return n - 14856 + 6664;
    return -1;
}
template <int MODE>
__device__ __forceinline__ void transpose_item(const float* W, int ldw, int K, bf16* WT, int n0, int k0, const float* kscale, LAS unsigned* scr, int lane) {
    const int kq = lane >> 4, n4 = (lane & 15) * 4; const int sc = MODE ? win_src_col(n0 + n4) : n0 + n4;
#pragma unroll
    for (int i = 0; i < 8; ++i) { const int k = k0 + 8 * i + 2 * kq; f32x4 a = {0.f, 0.f, 0.f, 0.f}, b = {0.f, 0.f, 0.f, 0.f};
        if (sc >= 0) { a = *(const f32x4*)(W + (size_t)k * ldw + sc); b = *(const f32x4*)(W + (size_t)(k + 1) * ldw + sc); }
        if (kscale) { a = a * kscale[k]; b = b * kscale[k + 1]; }
        v4u w; w.x = pk2(a[0], b[0]); w.y = pk2(a[1], b[1]); w.z = pk2(a[2], b[2]); w.w = pk2(a[3], b[3]);
        *(LAS v4u*)(scr + (4 * i + kq) * 68 + n4) = w; }
    asm volatile("s_waitcnt lgkmcnt(0)" ::: "memory");
    const int part = lane & 7;
#pragma unroll
    for (int j = 0; j < 8; ++j) { const int nn = 8 * j + (lane >> 3); const LAS unsigned* s = scr + (4 * part) * 68 + nn;
        v4u o; o.x = s[0]; o.y = s[68]; o.z = s[136]; o.w = s[204];
        *(v4u*)(WT + (size_t)(n0 + nn) * K + k0 + 8 * part) = o; }
    asm volatile("s_waitcnt lgkmcnt(0)" ::: "memory");
}
__device__ __forceinline__ void p0_prologue(CA A, LAS unsigned char* lds, const int wv) {
    const int tid = tid_opaque(wv), lane = tid & 63, wave = tid >> 6, G = gridDim.x;
    LAS unsigned* scr = (LAS unsigned*)(lds + wave * 8704);
    const int gw = blk_opaque() * NWAVES + wave, NGW = G * NWAVES;
    constexpr int I_IN = (NIN / 64) * (DM / 64), I_BR = (DM / 64) * (512 / 64), I_OUT = (DM / 64) * (DM / 64), I_UP = (DFF / 64) * (DM / 64), I_DN = (DM / 64) * (DFF / 64);
    constexpr int PER_LAYER = I_IN + 4 * I_BR + I_OUT + I_UP + I_DN;
    for (int it = gw; it < 2 * PER_LAYER; it += NGW) {
        const int L = it / PER_LAYER; int r = it % PER_LAYER;
        if (r < I_IN) { const int nb = r % (NIN / 64), kb = r / (NIN / 64);
            transpose_item<1>(IN_F(I_WIN) + (size_t)L * DM * INCOLS, INCOLS, DM, WSP(bf16, WS_WIN) + (size_t)L * NIN * DM, nb * 64, kb * 64, nullptr, scr, lane); continue; }
        r -= I_IN;
        if (r < 4 * I_BR) { const int s = 1 + r / I_BR, q = r % I_BR, nb = q % (DM / 64), kb = q / (DM / 64);
            transpose_item<0>(IN_F(I_WBR) + ((size_t)L * 2560 + 512 * s) * DM, DM, OBW, WSP(bf16, WS_WBR) + (size_t)L * DM * OBW + 512 * s, nb * 64, kb * 64,
                              s >= 3 ? IN_F(I_SSNW) + L * 1024 + (s - 3) * 512 : nullptr, scr, lane); continue; }
        r -= 4 * I_BR;
        if (r < I_OUT) { const int nb = r % (DM / 64), kb = r / (DM / 64);
            transpose_item<0>(IN_F(I_WOUT) + (size_t)L * DM * DM, DM, DM, WSP(bf16, WS_WOUT) + (size_t)L * DM * DM, nb * 64, kb * 64, nullptr, scr, lane); continue; }
        r -= I_OUT;
        if (r < I_UP) { const int nb = r % (DFF / 64), kb = r / (DFF / 64);
            transpose_item<0>(IN_F(I_WUP) + (size_t)L * DM * DFF, DFF, DM, WSP(bf16, WS_WUP) + (size_t)L * DFF * DM, nb * 64, kb * 64, nullptr, scr, lane); continue; }
        r -= I_UP;
        { const int nb = r % (DM / 64), kb = r / (DM / 64);
            transpose_item<0>(IN_F(I_WDN) + (size_t)L * DFF * DM, DM, DFF, WSP(bf16, WS_WDN) + (size_t)L * DM * DFF, nb * 64, kb * 64, nullptr, scr, lane); }
    }
    for (int idx = blk_opaque() * NTHR + tid; idx < 2 * DM * 64; idx += G * NTHR) {
        const int L = idx / (DM * 64), q = idx % (DM * 64), n = q & (DM - 1), kc = q >> 11, k0 = kc * 8, g = k0 >> 7, c0 = k0 & 127;
        const float* pw = IN_F(I_POOLW) + ((size_t)(L * 4 + g) * 128 + c0) * 128; const float* psc = IN_F(I_POOLSC) + L * 512 + g * 128;
        const float* wb = IN_F(I_WBR) + ((size_t)L * 2560 + g * 128) * DM + n;
        float acc[8] = {0.f, 0.f, 0.f, 0.f, 0.f, 0.f, 0.f, 0.f};
        for (int d = 0; d < 128; ++d) { const float wv = wb[(size_t)d * DM] * psc[d];
#pragma unroll
            for (int i = 0; i < 8; ++i) acc[i] += pw[i * 128 + d] * wv; }
        v4u o; o.x = pk2(acc[0], acc[1]); o.y = pk2(acc[2], acc[3]); o.z = pk2(acc[4], acc[5]); o.w = pk2(acc[6], acc[7]);
        *(v4u*)(WSP(bf16, WS_WBR) + (size_t)L * DM * OBW + (size_t)n * OBW + k0) = o;
    }
}

__device__ __forceinline__ const float* xin_row(CA A, int m) { return m < TP ? IN_F(I_XP) + (size_t)m * DM : IN_F(I_XS) + (size_t)(m - TP) * DM; }
__device__ __forceinline__ void store_bf16_row(bf16* orow, const f32x4 (&v)[8], float rstd, const float* g, int lane) {
#pragma unroll
    for (int j = 0; j < 8; ++j) { const f32x4 gj = ((const f32x4*)g)[lane + 64 * j]; const f32x4 o = v[j] * rstd * gj;
        v2u w; w.x = pk2(o[0], o[1]); w.y = pk2(o[2], o[3]); ((v2u*)orow)[lane + 64 * j] = w; }
}
__device__ __forceinline__ void norm1_phase(CA A, const int wv) {
    const int tid = tid_opaque(wv), lane = tid & 63, gw = blk_opaque() * NWAVES + (tid >> 6), NGW = gridDim.x * NWAVES;
    bf16* H = WSP(bf16, WS_H);
    for (int m = gw; m < MP; m += NGW) {
        if (m >= TT) { for (int j = 0; j < 8; ++j) ((v2u*)(H + (size_t)m * DM))[lane + 64 * j] = (v2u){0u, 0u}; continue; }
        const f32x4* xr = (const f32x4*)xin_row(A, m); f32x4 v[8]; float s = 0.f;
#pragma unroll
        for (int j = 0; j < 8; ++j) { v[j] = xr[lane + 64 * j]; s += (v[j][0] * v[j][0] + v[j][1] * v[j][1]) + (v[j][2] * v[j][2] + v[j][3] * v[j][3]); }
        const float rstd = 1.0f / sqrtf(wave_sum(s) * (1.0f / DM) + RMS_EPS);
        store_bf16_row(H + (size_t)m * DM, v, rstd, IN_F(I_NMPRE), lane);
    }
}
__device__ __forceinline__ void resid_load(CA A, const float* Y, const float* PS, bool from_input, int m, int lane, f32x4 (&v)[8], f32x4 (&x)[8]) {
    const f32x4* xr = from_input ? (const f32x4*)xin_row(A, m) : (const f32x4*)(A->out + O_Y + (size_t)m * DM);
#pragma unroll
    for (int j = 0; j < 8; ++j) x[j] = xr[lane + 64 * j];
    if (m < TP) { const f32x4* yr = (const f32x4*)(Y + (size_t)m * DM);
#pragma unroll
        for (int j = 0; j < 8; ++j) v[j] = yr[lane + 64 * j];
    } else {
#pragma unroll
        for (int j = 0; j < 8; ++j) v[j] = (f32x4){0.f, 0.f, 0.f, 0.f};
        for (int sp = 0; sp < 16; ++sp) { const f32x4* pr = (const f32x4*)(PS + ((size_t)sp * TS + (m - TP)) * DM);
#pragma unroll
            for (int j = 0; j < 8; ++j) v[j] += pr[lane + 64 * j]; }
    }
}
__device__ __forceinline__ void resid_phase(CA A, const float* Y, const float* PS, const float* gpost, const float* gnext, bool from_input, const int wv) {
    const int tid = tid_opaque(wv), lane = tid & 63, gw = blk_opaque() * NWAVES + (tid >> 6), NGW = gridDim.x * NWAVES;
    bf16* H = WSP(bf16, WS_H);
    f32x4 v[8], x[8], vn[8], xn[8];
    int m = gw; if (m < TP) resid_load(A, Y, PS, from_input, m, lane, v, x);
    while (m < TT) {
        int mnext = m + NGW; if (m < TP && mnext >= TP) mnext = (gw < TS) ? TP + gw : TT;
        else if (m >= TP) mnext = TT;
        if (mnext < TT) resid_load(A, Y, PS, from_input, mnext, lane, vn, xn);
        float s = 0.f;
#pragma unroll
        for (int j = 0; j < 8; ++j) s += (v[j][0] * v[j][0] + v[j][1] * v[j][1]) + (v[j][2] * v[j][2] + v[j][3] * v[j][3]);
        const float rstd = __builtin_amdgcn_rsqf(wave_sum(s) * (1.0f / DM) + RMS_EPS); float s2 = 0.f;
        f32x4* orow = (f32x4*)(A->out + O_Y + (size_t)m * DM);
#pragma unroll
        for (int j = 0; j < 8; ++j) { const f32x4 gj = ((const f32x4*)gpost)[lane + 64 * j]; v[j] = x[j] + v[j] * rstd * gj; orow[lane + 64 * j] = v[j];
            s2 += (v[j][0] * v[j][0] + v[j][1] * v[j][1]) + (v[j][2] * v[j][2] + v[j][3] * v[j][3]); }
        if (gnext) { const float rstd2 = __builtin_amdgcn_rsqf(wave_sum(s2) * (1.0f / DM) + RMS_EPS); store_bf16_row(H + (size_t)m * DM, v, rstd2, gnext, lane); }
#pragma unroll
        for (int j = 0; j < 8; ++j) { v[j] = vn[j]; x[j] = xn[j]; }
        m = mnext;
    }
}

__device__ __forceinline__ float conv_tap(const float* UF, const float* state, int row, int j, int ucol, int c) {
    if (row < TP) { const int t = row & (SEQ - 1); return (t - 3 + j) >= 0 ? UF[(size_t)(row - 3 + j) * UFW + ucol + c] : 0.f; }
    const int s = row - TP, sb = s >> 2, e = (s & 3) + j;
    return e < 3 ? state[(size_t)(sb * 3 + e) * 1536 + c] : UF[(size_t)(TP + sb * 4 + e - 3) * UFW + ucol + c];
}
__device__ __forceinline__ void prep_phase(CA A, int layer, const int wv) {
    const int tid = tid_opaque(wv), lane = tid & 63, G = gridDim.x, gt = blk_opaque() * NTHR + tid, NGT = G * NTHR, gw = blk_opaque() * NWAVES + (tid >> 6), NGW = G * NWAVES;
    const float* UF = WSP(float, WS_UF); float* SC = WSP(float, WS_SCAL);
    for (int idx = gt; idx < TT * 24; idx += NGT) { const int row = idx / 24, j = idx % 24; const float u = UF[(size_t)row * UFW + UF_SMALL + j]; float r;
        if (j < 4) r = sigmoidf_(u);
        else if (j < 8) r = -fexp(IN_F(I_DNALOG)[layer * 4 + j - 4]) * softplusf_(u + IN_F(I_DNDTB)[layer * 4 + j - 4]);
        else r = softplusf_(u + IN_F(I_SSDTB)[layer * 16 + j - 8]);
        SC[(size_t)row * 32 + j] = r; }
    { bf16* O0 = WSP(bf16, WS_OBR); const float* spool = IN_F(I_SPOOL) + (size_t)layer * DBATCH * 15 * 512;
      for (int it = gw; it < (TP / 64 + DBATCH) * 4; it += NGW) { const int gi = it & 3, sc = it >> 2, w = 2 << gi, ch = gi * 128 + lane;
          if (sc < TP / 64) { const int row0 = sc * 64, t0 = row0 & (SEQ - 1); float s0 = 0.f, s1 = 0.f;
              for (int j = 1; j < w; ++j) if (t0 - j >= 0) { s0 += UF[(size_t)(row0 - j) * UFW + ch]; s1 += UF[(size_t)(row0 - j) * UFW + ch + 64]; }
#pragma unroll 8
              for (int i = 0; i < 64; ++i) { const int row = row0 + i, t = t0 + i; const float u0 = UF[(size_t)row * UFW + ch], u1 = UF[(size_t)row * UFW + ch + 64];
                  s0 += u0; s1 += u1; const float inv = 1.0f / (float)((t + 1) < w ? (t + 1) : w);
                  O0[(size_t)row * OBW + ch] = (bf16)f2bf(s0 * inv - u0); O0[(size_t)row * OBW + ch + 64] = (bf16)f2bf(s1 * inv - u1);
                  if (t - w + 1 >= 0) { s0 -= UF[(size_t)(row - w + 1) * UFW + ch]; s1 -= UF[(size_t)(row - w + 1) * UFW + ch + 64]; } } }
          else { const int sb = sc - TP / 64; const float inv = 1.0f / (float)w;
              for (int i = 0; i < DSEQ; ++i) { const int row = TP + sb * 4 + i, e = 15 + i; float s0 = 0.f, s1 = 0.f;
                  for (int j = 0; j < w; ++j) { const int ee = e - j; const float* src = ee < 15 ? spool + (size_t)(sb * 15 + ee) * 512 + ch : UF + (size_t)(TP + sb * 4 + ee - 15) * UFW + ch; s0 += src[0]; s1 += src[64]; }
                  O0[(size_t)row * OBW + ch] = (bf16)f2bf(s0 * inv - UF[(size_t)row * UFW + ch]); O0[(size_t)row * OBW + ch + 64] = (bf16)f2bf(s1 * inv - UF[(size_t)row * UFW + ch + 64]); } } } }
    for (int it0 = gw; it0 < DBATCH * 24; it0 += NGW) { const int it = it0 + (TP / 64) * 24; const int grp = it % 12, strm = (it / 12) & 1, sc = it / 24, c0 = grp * 128 + lane;
        const int ucol = strm ? UF_XBC : UF_DNQKV; float* OUTB = strm ? WSP(float, WS_XBC) : WSP(float, WS_DNQ);
        const float* cw = (strm ? IN_F(I_SSCW) : IN_F(I_DNCW)) + (size_t)layer * 4 * 1536; const float* st = (strm ? IN_F(I_SSSC) : IN_F(I_SDNC)) + (size_t)layer * DBATCH * 3 * 1536;
        const float wa0 = cw[c0], wa1 = cw[1536 + c0], wa2 = cw[3072 + c0], wa3 = cw[4608 + c0], wb0 = cw[c0 + 64], wb1 = cw[1536 + c0 + 64], wb2 = cw[3072 + c0 + 64], wb3 = cw[4608 + c0 + 64];
        const float ba = strm ? IN_F(I_SSCB)[layer * 1536 + c0] : 0.f, bb = strm ? IN_F(I_SSCB)[layer * 1536 + c0 + 64] : 0.f;
        const bool nrm = (strm == 0) && grp < 8; const float qs = grp < 4 ? 0.08838834764831845f : 1.0f;
        float ha0, ha1, ha2, hb0, hb1, hb2; int row0, n;
        if (sc < TP / 64) { row0 = sc * 64; n = 64; const int t0 = row0 & (SEQ - 1);
            if (t0 == 0) { ha0 = ha1 = ha2 = hb0 = hb1 = hb2 = 0.f; }
            else { const float* p = UF + (size_t)(row0 - 3) * UFW + ucol + c0; ha0 = p[0]; hb0 = p[64]; ha1 = p[UFW]; hb1 = p[UFW + 64]; ha2 = p[2 * UFW]; hb2 = p[2 * UFW + 64]; } }
        else { const int sb = sc - TP / 64; row0 = TP + sb * 4; n = DSEQ; const float* p = st + (size_t)(sb * 3) * 1536 + c0; ha0 = p[0]; hb0 = p[64]; ha1 = p[1536]; hb1 = p[1536 + 64]; ha2 = p[3072]; hb2 = p[3072 + 64]; }
#pragma unroll 8
        for (int i = 0; i < n; ++i) { const float* p = UF + (size_t)(row0 + i) * UFW + ucol + c0; const float ua = p[0], ub = p[64];
            float a = siluf_(ba + wa0 * ha0 + wa1 * ha1 + wa2 * ha2 + wa3 * ua), b = siluf_(bb + wb0 * hb0 + wb1 * hb1 + wb2 * hb2 + wb3 * ub);
            ha0 = ha1; ha1 = ha2; ha2 = ua; hb0 = hb1; hb1 = hb2; hb2 = ub;
            if (nrm) { const float rs = row16_sum(a * a + b * b);
                const float tot = (__builtin_bit_cast(float, __builtin_amdgcn_readlane(__builtin_bit_cast(int, rs), 0)) + __builtin_bit_cast(float, __builtin_amdgcn_readlane(__builtin_bit_cast(int, rs), 16)))
                                + (__builtin_bit_cast(float, __builtin_amdgcn_readlane(__builtin_bit_cast(int, rs), 32)) + __builtin_bit_cast(float, __builtin_amdgcn_readlane(__builtin_bit_cast(int, rs), 48)));
                const float sc2 = qs / sqrtf(tot + 1e-6f); a *= sc2; b *= sc2; }
            float* o = OUTB + (size_t)(row0 + i) * 1536 + c0; o[0] = a; o[64] = b; } }
    for (int idx = gt; idx < NBATCH * 3 * 1536; idx += NGT) { const int b = idx / (3 * 1536), q = idx % (3 * 1536), j = q / 1536, c = q % 1536; const size_t src = (size_t)(b * SEQ + SEQ - 3 + j) * UFW;
        A->out[O_DNCP + (size_t)layer * NBATCH * 3 * 1536 + idx] = UF[src + UF_DNQKV + c]; A->out[O_SSCP + (size_t)layer * NBATCH * 3 * 1536 + idx] = UF[src + UF_XBC + c]; }
    for (int idx = gt; idx < DBATCH * 3 * 1536; idx += NGT) { const int sb = idx / (3 * 1536), q = idx % (3 * 1536), j = q / 1536, c = q % 1536; const size_t src = (size_t)(TP + sb * 4 + 1 + j) * UFW;
        A->out[O_DNCS + (size_t)layer * DBATCH * 3 * 1536 + idx] = UF[src + UF_DNQKV + c]; A->out[O_SSCS + (size_t)layer * DBATCH * 3 * 1536 + idx] = UF[src + UF_XBC + c]; }
    for (int idx = gt; idx < NBATCH * 15 * 512; idx += NGT) { const int b = idx / (15 * 512), q = idx % (15 * 512), j = q >> 9, ch = q & 511;
        A->out[O_POOLP + (size_t)layer * NBATCH * 15 * 512 + idx] = UF[(size_t)(b * SEQ + SEQ - 15 + j) * UFW + ch]; }
    { const float* spool = IN_F(I_SPOOL) + (size_t)layer * DBATCH * 15 * 512;
      for (int idx = gt; idx < DBATCH * 15 * 512; idx += NGT) { const int sb = idx / (15 * 512), q = idx % (15 * 512), j = q >> 9, ch = q & 511, e = 4 + j;
          A->out[O_POOLS + (size_t)layer * DBATCH * 15 * 512 + idx] = e < 15 ? spool[(size_t)(sb * 15 + e) * 512 + ch] : UF[(size_t)(TP + sb * 4 + e - 15) * UFW + ch]; } }
}

__device__ __forceinline__ void dn_seq(CA A, LAS unsigned char* lds, int layer, int unit, const int wv) {
    const int tid = tid_opaque(wv), lane = tid & 63, wid = tid >> 6, v = tid & 127, kq = tid >> 7;
    int row0, L, h; const float* s0 = nullptr; float* sout;
    if (unit < 16) { const int b = unit >> 2; h = unit & 3; row0 = b * SEQ; L = SEQ; sout = A->out + O_DNSP + ((size_t)(layer * NBATCH + b) * 4 + h) * 16384; }
    else { const int u = unit - 16, sb = u >> 2; h = u & 3; row0 = TP + sb * 4; L = DSEQ; s0 = IN_F(I_SDNS) + ((size_t)(layer * DBATCH + sb) * 4 + h) * 16384; sout = A->out + O_DNSS + ((size_t)(layer * DBATCH + sb) * 4 + h) * 16384; }
    constexpr int CH = 32;
    LAS float* qs = (LAS float*)lds; LAS float* ks = qs + CH * 128; LAS float* vs = ks + CH * 128; LAS float* ob = vs + CH * 128;
    LAS float* red = ob + CH * 128;
    LAS float* egs = red + 2 * 2 * 4 * 128; LAS float* bts = egs + CH; LAS float* kqd = bts + CH;
    const float* DNQ = WSP(float, WS_DNQ); const float* SC = WSP(float, WS_SCAL); const float* UF = WSP(float, WS_UF); bf16* O1 = WSP(bf16, WS_OBR) + 512;
    const float* nw = IN_F(I_DNNW) + layer * 128;
    float S[32];
#pragma unroll
    for (int i = 0; i < 32; ++i) S[i] = s0 ? s0[(size_t)(32 * kq + i) * 128 + v] : 0.f;
    for (int c0 = 0; c0 < L; c0 += CH) {
        const int n = (L - c0) < CH ? (L - c0) : CH;
        __syncthreads();
        for (int idx = tid; idx < n * 128; idx += NTHR) { const int t = idx >> 7, c = idx & 127; const float* src = DNQ + (size_t)(row0 + c0 + t) * 1536 + h * 128 + c;
            qs[idx] = src[0]; ks[idx] = src[512]; vs[idx] = src[1024]; }
        if (tid < n) { const float* sc = SC + (size_t)(row0 + c0 + tid) * 32; bts[tid] = sc[h]; egs[tid] = fexp(sc[4 + h]); }
        __syncthreads();
        for (int t = wid; t < n; t += NWAVES) { const float s = wave_sum(ks[t * 128 + lane] * qs[t * 128 + lane] + ks[t * 128 + 64 + lane] * qs[t * 128 + 64 + lane]); if (lane == 0) kqd[t] = s; }
        __syncthreads();
        for (int t = 0; t < n; ++t) {
            const float eg = egs[t], bt = bts[t]; float kk[32]; float r = 0.f, pp = 0.f;
#pragma unroll
            for (int i4 = 0; i4 < 8; ++i4) { const f32x4 k4 = *(const LAS f32x4*)(ks + t * 128 + 32 * kq + 4 * i4), q4 = *(const LAS f32x4*)(qs + t * 128 + 32 * kq + 4 * i4);
#pragma unroll
                for (int e = 0; e < 4; ++e) { const int i = 4 * i4 + e; S[i] *= eg; kk[i] = k4[e]; r += S[i] * k4[e]; pp += S[i] * q4[e]; } }
            LAS float* rd = red + (t & 1) * 1024;
            rd[kq * 128 + v] = r; rd[512 + kq * 128 + v] = pp;
            __syncthreads();
            const float rt = (rd[v] + rd[128 + v]) + (rd[256 + v] + rd[384 + v]), pt = (rd[512 + v] + rd[640 + v]) + (rd[768 + v] + rd[896 + v]);
            const float dd = bt * (vs[t * 128 + v] - rt);
#pragma unroll
            for (int i = 0; i < 32; ++i) S[i] += kk[i] * dd;
            if (kq == 0) ob[t * 128 + v] = pt + kqd[t] * dd;
        }
        __syncthreads();
        for (int t = wid; t < n; t += NWAVES) { const int row = row0 + c0 + t; const float o0 = ob[t * 128 + lane], o1 = ob[t * 128 + 64 + lane];
            const float rstd = 1.0f / sqrtf(wave_sum(o0 * o0 + o1 * o1) * (1.0f / 128.0f) + RMS_EPS);
            const float z0 = UF[(size_t)row * UFW + UF_DNZ + h * 128 + lane], z1 = UF[(size_t)row * UFW + UF_DNZ + h * 128 + 64 + lane];
            O1[(size_t)row * OBW + h * 128 + lane] = (bf16)f2bf(o0 * rstd * nw[lane] * siluf_(z0)); O1[(size_t)row * OBW + h * 128 + 64 + lane] = (bf16)f2bf(o1 * rstd * nw[64 + lane] * siluf_(z1)); }
    }
#pragma unroll
    for (int i = 0; i < 32; ++i) sout[(size_t)(32 * kq + i) * 128 + v] = S[i];
    __syncthreads();
}

__device__ __forceinline__ void ssd_seq(CA A, LAS unsigned char* lds, int layer, int unit, const int wv) {
    const int tid = tid_opaque(wv), lane = tid & 63, wid = tid >> 6, p = tid >> 3, nq = tid & 7;
    int row0, L, hd; const float* h0 = nullptr; float* hout;
    if (unit < 64) { const int b = unit >> 4; hd = unit & 15; row0 = b * SEQ; L = SEQ; hout = A->out + O_SSHP + ((size_t)(layer * NBATCH + b) * 16 + hd) * 8192; }
    else { const int u = unit - 64, sb = u >> 4; hd = u & 15; row0 = TP + sb * 4; L = DSEQ; h0 = IN_F(I_SSSH) + ((size_t)(layer * DBATCH + sb) * 16 + hd) * 8192; hout = A->out + O_SSHS + ((size_t)(layer * DBATCH + sb) * 16 + hd) * 8192; }
    const int g = hd >> 3; constexpr int CH = 64;
    LAS float* Bs = (LAS float*)lds; LAS float* Cs = Bs + CH * 128; LAS float* xs = Cs + CH * 128; LAS float* yb = xs + CH * 64; LAS float* dts = yb + CH * 64;
    const float* XBC = WSP(float, WS_XBC); const float* SC = WSP(float, WS_SCAL); const float* UF = WSP(float, WS_UF); float* SSQ = WSP(float, WS_SSQ);
    bf16* Og = WSP(bf16, WS_OBR) + (3 + g) * 512;
    const float a = -fexp(IN_F(I_SSALOG)[layer * 16 + hd]), Dk = IN_F(I_SSD)[layer * 16 + hd];
    float hs[16];
#pragma unroll
    for (int j = 0; j < 16; ++j) hs[j] = h0 ? h0[(size_t)p * 128 + 16 * nq + j] : 0.f;
    for (int c0 = 0; c0 < L; c0 += CH) {
        const int n = (L - c0) < CH ? (L - c0) : CH;
        __syncthreads();
        for (int idx = tid; idx < n * 128; idx += NTHR) { const int t = idx >> 7, c = idx & 127; const float* src = XBC + (size_t)(row0 + c0 + t) * 1536; Bs[idx] = src[1024 + g * 128 + c]; Cs[idx] = src[1280 + g * 128 + c]; }
        for (int idx = tid; idx < n * 64; idx += NTHR) { const int t = idx >> 6, c = idx & 63; xs[idx] = XBC[(size_t)(row0 + c0 + t) * 1536 + hd * 64 + c]; }
        if (tid < n) dts[tid] = SC[(size_t)(row0 + c0 + tid) * 32 + 8 + hd];
        __syncthreads();
        for (int t = 0; t < n; ++t) {
            const float dt = dts[t], dA = fexp(dt * a), xv = xs[t * 64 + p], cx = dt * xv; float y = 0.f;
#pragma unroll
            for (int j4 = 0; j4 < 4; ++j4) { const f32x4 b4 = *(const LAS f32x4*)(Bs + t * 128 + 16 * nq + 4 * j4), c4 = *(const LAS f32x4*)(Cs + t * 128 + 16 * nq + 4 * j4);
#pragma unroll
                for (int e = 0; e < 4; ++e) { const int j = 4 * j4 + e; hs[j] = hs[j] * dA + cx * b4[e]; y += hs[j] * c4[e]; } }
            y += __shfl_xor(y, 1); y += __shfl_xor(y, 2); y += __shfl_xor(y, 4);
            if (nq == 0) yb[t * 64 + p] = y + Dk * xv;
        }
        __syncthreads();
        for (int t = wid; t < n; t += NWAVES) { const int row = row0 + c0 + t; const float z = UF[(size_t)row * UFW + UF_SSZ + hd * 64 + lane]; const float yg = yb[t * 64 + lane] * siluf_(z);
            const float ss = wave_sum(yg * yg); if (lane == 0) { SSQ[(size_t)row * 32 + hd * 2] = ss; SSQ[(size_t)row * 32 + hd * 2 + 1] = 0.f; }
            Og[(size_t)row * OBW + (hd & 7) * 64 + lane] = (bf16)f2bf(yg); }
    }
#pragma unroll
    for (int j = 0; j < 16; ++j) hout[(size_t)p * 128 + 16 * nq + j] = hs[j];
    __syncthreads();
}

constexpr size_t DNU_NW = 0, DNU_QG = 16384, DNU_AT = 32768, DNU_KGT = 40960, DNU_UP = 57344, DNU_EG = 90112, DNU_BYTES = 90368;
__device__ __forceinline__ float dpp_swap1(float x) { return __builtin_bit_cast(float, __builtin_amdgcn_mov_dpp(__builtin_bit_cast(int, x), 0xB1, 0xf, 0xf, true)); }
__device__ __forceinline__ void dn_chunk_unit(CA A, LAS unsigned char* lds, int layer, int unit, const int wv) {
    const int tid = tid_opaque(wv), lane = tid & 63, wid = tid >> 6, q4 = lane >> 4, l15 = lane & 15;
    const int bh = unit >> 5, ck = unit & 31, b = bh >> 2, h = bh & 3, row0 = b * SEQ + ck * 64;
    constexpr int FP = 132;
    LAS float* kf = (LAS float*)lds; LAS float* vf = kf + 64 * FP;
    LAS unsigned char* qb = lds + 2 * 64 * FP * 4; LAS unsigned char* kb = qb + 64 * 272;
    LAS float* Lp = (LAS float*)(kb + 64 * 272);
    LAS float* gcs = Lp + 2 * 64 * 32; LAS float* bts = gcs + 64;
    const float* SC = WSP(float, WS_SCAL);
    unsigned char* rec = A->ws + WS_DNU + (size_t)unit * DNU_BYTES;
    __syncthreads();
    if (tid < 64) { const float* sc = SC + (size_t)(row0 + tid) * 32; bts[tid] = sc[h]; gcs[tid] = wave_scan(sc[4 + h], lane); }
    __syncthreads();
    const float glast = gcs[63];
    if (tid == 0) *(float*)(rec + DNU_EG) = fexp(glast);
    { const float* UF = WSP(float, WS_UF); const float* cw = IN_F(I_DNCW) + (size_t)layer * 4 * 1536;
#pragma unroll
      for (int it = 0; it < 4; ++it) { const int idx = tid + 512 * it, t = idx >> 5, d4 = (idx & 31) * 4, tq = ck * 64 + t; f32x4 val[3];
#pragma unroll
          for (int sIdx = 0; sIdx < 3; ++sIdx) { const int col = sIdx * 512 + h * 128 + d4; f32x4 a = {0.f, 0.f, 0.f, 0.f};
#pragma unroll
              for (int j = 0; j < 4; ++j) if (tq - 3 + j >= 0) a += *(const f32x4*)(UF + (size_t)(row0 + t - 3 + j) * UFW + UF_DNQKV + col) * *(const f32x4*)(cw + j * 1536 + col);
#pragma unroll
              for (int e = 0; e < 4; ++e) a[e] = siluf_(a[e]);
              if (sIdx < 2) { float ss = row16_sum((a[0] * a[0] + a[1] * a[1]) + (a[2] * a[2] + a[3] * a[3])); ss += __shfl_xor(ss, 16);
                  const float sc = (sIdx == 0 ? 0.08838834764831845f : 1.0f) * __builtin_amdgcn_rsqf(ss + 1e-6f); a = a * sc; }
              val[sIdx] = a; }
          const f32x4 qv = val[0], kv = val[1], vv = val[2];
          *(LAS f32x4*)(kf + t * FP + d4) = kv; *(LAS f32x4*)(vf + t * FP + d4) = vv;
          v2u w; w.x = pk2(qv[0], qv[1]); w.y = pk2(qv[2], qv[3]); *(LAS v2u*)(qb + t * 272 + d4 * 2) = w;
          w.x = pk2(kv[0], kv[1]); w.y = pk2(kv[2], kv[3]); *(LAS v2u*)(kb + t * 272 + d4 * 2) = w;
          const float eg = fexp(gcs[t]); w.x = pk2(qv[0] * eg, qv[1] * eg); w.y = pk2(qv[2] * eg, qv[3] * eg); *(v2u*)(rec + DNU_QG + (size_t)(t * 128 + d4) * 2) = w; } }
    __syncthreads();
    { const int c = lane, dg = wid; const float f = fexp(glast - gcs[c]); bf16* KGT = (bf16*)(rec + DNU_KGT);
#pragma unroll
      for (int i = 0; i < 16; ++i) { const int d = dg * 16 + i; KGT[d * 64 + c] = (bf16)f2bf(kf[c * FP + d] * f); } }
    { const int ct = wid >> 1; bf16* AT = (bf16*)(rec + DNU_AT);
#pragma unroll
      for (int e2 = 0; e2 < 2; ++e2) { const int et = 2 * (wid & 1) + e2; f32x4 aKK = {0.f, 0.f, 0.f, 0.f}, aQK = {0.f, 0.f, 0.f, 0.f};
#pragma unroll
          for (int ks = 0; ks < 4; ++ks) { const bf16x8 bfr = *(const LAS bf16x8*)(kb + (16 * et + l15) * 272 + (32 * ks + 8 * q4) * 2);
              const bf16x8 ak = *(const LAS bf16x8*)(kb + (16 * ct + l15) * 272 + (32 * ks + 8 * q4) * 2), aq = *(const LAS bf16x8*)(qb + (16 * ct + l15) * 272 + (32 * ks + 8 * q4) * 2);
              aKK = __builtin_amdgcn_mfma_f32_16x16x32_bf16(ak, bfr, aKK, 0, 0, 0); aQK = __builtin_amdgcn_mfma_f32_16x16x32_bf16(aq, bfr, aQK, 0, 0, 0); }
          const int e = 16 * et + l15; const float ge = gcs[e];
#pragma unroll
          for (int r = 0; r < 4; ++r) { const int c = 16 * ct + 4 * q4 + r; const float dec = e <= c ? fexp(gcs[c] - ge) : 0.f;
              Lp[((e & 1) * 64 + c) * 32 + (e >> 1)] = e < c ? bts[c] * aKK[r] * dec : 0.f;
              AT[c * 64 + e] = (bf16)f2bf(aQK[r] * dec); } } }
    __syncthreads();
    { const int j = tid >> 1, par = tid & 1; float x[32];
#pragma unroll
      for (int i = 0; i < 32; ++i) x[i] = 0.f;
      const LAS float* src = j < 128 ? vf + j : kf + (j - 128);
      float* UP = (float*)(rec + DNU_UP); bf16* NW = (bf16*)(rec + DNU_NW);
#pragma unroll
      for (int c = 0; c < 64; ++c) {
          constexpr int dummy = 0; (void)dummy;
          const int ni = (c + 1) >> 1; float a0 = 0.f, a1 = 0.f, a2 = 0.f, a3 = 0.f;
#pragma unroll
          for (int i4 = 0; i4 < (ni + 3) / 4; ++i4) { const f32x4 l4 = *(const LAS f32x4*)(Lp + (par * 64 + c) * 32 + 4 * i4);
              a0 += l4[0] * x[4 * i4]; if (4 * i4 + 1 < ni) a1 += l4[1] * x[4 * i4 + 1]; if (4 * i4 + 2 < ni) a2 += l4[2] * x[4 * i4 + 2]; if (4 * i4 + 3 < ni) a3 += l4[3] * x[4 * i4 + 3]; }
          float acc = (a0 + a1) + (a2 + a3); acc += dpp_swap1(acc);
          float rhs = src[c * FP] * bts[c]; if (j >= 128) rhs *= fexp(gcs[c]);
          const float xc = rhs - acc;
          x[c >> 1] = ((c & 1) == par) ? xc : x[c >> 1];
          if (par == 0) { if (j < 128) UP[(((j >> 4) * 4 + (c >> 4)) * 4 + (c & 3)) * 64 + ((c >> 2) & 3) * 16 + (j & 15)] = xc; else NW[c * 128 + (j - 128)] = (bf16)f2bf(-xc); }
      } }
}

constexpr int D2_NW = 0, D2_KGT = 17408, D2_BUF = 35840;
__device__ __forceinline__ bf16x8 ld_frag_perm(const LAS unsigned char* p) {
    const v2u lo = *(const LAS v2u*)p, hi = *(const LAS v2u*)(p + 32); v4u w; w.x = lo.x; w.y = lo.y; w.z = hi.x; w.w = hi.y; return __builtin_bit_cast(bf16x8, w);
}
__device__ __forceinline__ bf16x8 pack_b(const f32x4& t0, const f32x4& t1) { v4u w; w.x = pk2(t0[0], t0[1]); w.y = pk2(t0[2], t0[3]); w.z = pk2(t1[0], t1[1]); w.w = pk2(t1[2], t1[3]); return __builtin_bit_cast(bf16x8, w); }
__device__ __forceinline__ void dn_seq2(CA A, LAS unsigned char* lds, int layer, int bh, const int wv) {
    const int tid = tid_opaque(wv), lane = tid & 63, w = tid >> 6, q4 = lane >> 4, l15 = lane & 15;
    const int b = bh >> 2, h = bh & 3;
    const unsigned char* recs = A->ws + WS_DNU + (size_t)(bh * 32) * DNU_BYTES;
    v4u* sav = (v4u*)(A->ws + WS_DNSV + (size_t)(bh * 32) * 49152) + (size_t)w * 6 * 64 + lane;
    f32x4 S[8];
#pragma unroll
    for (int i = 0; i < 8; ++i) S[i] = (f32x4){0.f, 0.f, 0.f, 0.f};
    v4u st[4];
#define D2_LOAD(rec_) do { const v4u* g_ = (const v4u*)(rec_); st[0] = g_[tid]; st[1] = g_[tid + 512]; st[2] = g_[tid + 2560]; st[3] = g_[tid + 3072]; } while (0)
#define D2_STORE(buf_) do { LAS unsigned char* b_ = lds + (buf_) * D2_BUF; \
        *(LAS v4u*)(b_ + D2_NW + (tid >> 4) * 272 + (tid & 15) * 16) = st[0]; *(LAS v4u*)(b_ + D2_NW + (32 + (tid >> 4)) * 272 + (tid & 15) * 16) = st[1]; \
        *(LAS v4u*)(b_ + D2_KGT + (tid >> 3) * 144 + (tid & 7) * 16) = st[2]; *(LAS v4u*)(b_ + D2_KGT + (64 + (tid >> 3)) * 144 + (tid & 7) * 16) = st[3]; } while (0)
    __syncthreads();
    D2_LOAD(recs); D2_STORE(0);
    f32x4 vnx[4]; float eglx = *(const float*)(recs + DNU_EG);
    { const float* UP0 = (const float*)(recs + DNU_UP) + (size_t)w * 1024 + lane;
#pragma unroll
      for (int mt = 0; mt < 4; ++mt)
#pragma unroll
          for (int r = 0; r < 4; ++r) vnx[mt][r] = UP0[(mt * 4 + r) * 64]; }
    __syncthreads();
    for (int ck = 0; ck < 32; ++ck) {
        const unsigned char* rec = recs + (size_t)ck * DNU_BYTES;
        const LAS unsigned char* bf = lds + (ck & 1) * D2_BUF;
        if (ck + 1 < 32) D2_LOAD(rec + DNU_BYTES);
        const float egl = eglx;
        f32x4 vn[4];
#pragma unroll
        for (int mt = 0; mt < 4; ++mt) vn[mt] = vnx[mt];
        if (ck + 1 < 32) { eglx = *(const float*)(rec + DNU_BYTES + DNU_EG); const float* UP = (const float*)(rec + DNU_BYTES + DNU_UP) + (size_t)w * 1024 + lane;
#pragma unroll
            for (int mt = 0; mt < 4; ++mt)
#pragma unroll
                for (int r = 0; r < 4; ++r) vnx[mt][r] = UP[(mt * 4 + r) * 64]; }
        bf16x8 Sb[4];
#pragma unroll
        for (int ks = 0; ks < 4; ++ks) { Sb[ks] = pack_b(S[2 * ks], S[2 * ks + 1]); sav[(size_t)ck * 3072 + ks * 64] = __builtin_bit_cast(v4u, Sb[ks]); }
        const int aoff = l15 * 272 + 8 * q4, aoff2 = l15 * 144 + 8 * q4;
#pragma unroll
        for (int mt = 0; mt < 4; ++mt)
#pragma unroll
            for (int ks = 0; ks < 4; ++ks) vn[mt] = __builtin_amdgcn_mfma_f32_16x16x32_bf16(ld_frag_perm(bf + D2_NW + mt * 16 * 272 + aoff + ks * 64), Sb[ks], vn[mt], 0, 0, 0);
        bf16x8 vb[2];
        vb[0] = pack_b(vn[0], vn[1]); vb[1] = pack_b(vn[2], vn[3]);
        sav[(size_t)ck * 3072 + 4 * 64] = __builtin_bit_cast(v4u, vb[0]); sav[(size_t)ck * 3072 + 5 * 64] = __builtin_bit_cast(v4u, vb[1]);
#pragma unroll
        for (int m8 = 0; m8 < 8; ++m8) { S[m8] = S[m8] * egl;
#pragma unroll
            for (int ke = 0; ke < 2; ++ke) S[m8] = __builtin_amdgcn_mfma_f32_16x16x32_bf16(ld_frag_perm(bf + D2_KGT + m8 * 16 * 144 + aoff2 + ke * 64), vb[ke], S[m8], 0, 0, 0); }
        if (ck + 1 < 32) D2_STORE((ck + 1) & 1);
        __syncthreads();
    }
    float* sout = A->out + O_DNSP + ((size_t)(layer * NBATCH + b) * 4 + h) * 16384;
#pragma unroll
    for (int m8 = 0; m8 < 8; ++m8)
#pragma unroll
        for (int r = 0; r < 4; ++r) sout[(size_t)(16 * m8 + 4 * q4 + r) * 128 + 16 * w + l15] = S[m8][r];
    __syncthreads();
#undef D2_LOAD
#undef D2_STORE
}
constexpr int D3_QG = 0, D3_AT = 17408, D3_RED = 26624;
__device__ __forceinline__ void dn_out_unit(CA A, LAS unsigned char* lds, int layer, int unit, const int wv) {
    const int tid = tid_opaque(wv), lane = tid & 63, w = tid >> 6, q4 = lane >> 4, l15 = lane & 15;
    const int bh = unit >> 5, ck = unit & 31, b = bh >> 2, h = bh & 3, row0 = b * SEQ + ck * 64;
    const unsigned char* rec = A->ws + WS_DNU + (size_t)unit * DNU_BYTES;
    const v4u* sav = (const v4u*)(A->ws + WS_DNSV + (size_t)unit * 49152) + (size_t)w * 6 * 64 + lane;
    const float* UF = WSP(float, WS_UF); bf16* O1 = WSP(bf16, WS_OBR) + 512; const float nwv = IN_F(I_DNNW)[layer * 128 + 16 * w + l15];
    LAS float* red = (LAS float*)(lds + D3_RED);
    __syncthreads();
    { const v4u* g_ = (const v4u*)rec; const v4u a0 = g_[tid + 1024], a1 = g_[tid + 1536], a2 = g_[tid + 2048];
      *(LAS v4u*)(lds + D3_QG + (tid >> 4) * 272 + (tid & 15) * 16) = a0; *(LAS v4u*)(lds + D3_QG + (32 + (tid >> 4)) * 272 + (tid & 15) * 16) = a1;
      *(LAS v4u*)(lds + D3_AT + (tid >> 3) * 144 + (tid & 7) * 16) = a2; }
    bf16x8 Sb[4], vb[2];
#pragma unroll
    for (int ks = 0; ks < 4; ++ks) Sb[ks] = __builtin_bit_cast(bf16x8, sav[ks * 64]);
    vb[0] = __builtin_bit_cast(bf16x8, sav[4 * 64]); vb[1] = __builtin_bit_cast(bf16x8, sav[5 * 64]);
    f32x4 zz[4];
#pragma unroll
    for (int mt = 0; mt < 4; ++mt)
#pragma unroll
        for (int r = 0; r < 4; ++r) zz[mt][r] = UF[(size_t)(row0 + 16 * mt + 4 * q4 + r) * UFW + UF_DNZ + h * 128 + 16 * w + l15];
    __syncthreads();
    const int aoff = l15 * 272 + 8 * q4, aoff2 = l15 * 144 + 8 * q4;
    f32x4 o[4];
#pragma unroll
    for (int mt = 0; mt < 4; ++mt) { o[mt] = (f32x4){0.f, 0.f, 0.f, 0.f};
#pragma unroll
        for (int ks = 0; ks < 4; ++ks) o[mt] = __builtin_amdgcn_mfma_f32_16x16x32_bf16(ld_frag_perm(lds + D3_QG + mt * 16 * 272 + aoff + ks * 64), Sb[ks], o[mt], 0, 0, 0);
#pragma unroll
        for (int ke = 0; ke < 2; ++ke) o[mt] = __builtin_amdgcn_mfma_f32_16x16x32_bf16(ld_frag_perm(lds + D3_AT + mt * 16 * 144 + aoff2 + ke * 64), vb[ke], o[mt], 0, 0, 0); }
#pragma unroll
    for (int mt = 0; mt < 4; ++mt)
#pragma unroll
        for (int r = 0; r < 4; ++r) red[(16 * mt + 4 * q4 + r) * 8 + w] = row16_sum(o[mt][r] * o[mt][r]);
    __syncthreads();
#pragma unroll
    for (int mt = 0; mt < 4; ++mt)
#pragma unroll
        for (int r = 0; r < 4; ++r) { const int c = 16 * mt + 4 * q4 + r; const f32x4 s0 = *(const LAS f32x4*)(red + c * 8), s1 = *(const LAS f32x4*)(red + c * 8 + 4);
            const float rstd = __builtin_amdgcn_rsqf(((s0[0] + s0[1]) + (s0[2] + s0[3]) + (s1[0] + s1[1]) + (s1[2] + s1[3])) * (1.0f / 128.0f) + RMS_EPS);
            const float zq = zz[mt][r]; O1[(size_t)(row0 + c) * OBW + h * 128 + 16 * w + l15] = (bf16)f2bf(o[mt][r] * rstd * nwv * zq * __builtin_amdgcn_rcpf(1.0f + fexp(-zq))); }
}

constexpr size_t SSU_XT = 0, SSU_XTW = 8192, SSU_CUM = 16384, SSU_DT = 16640, SSU_BYTES = 16896;
constexpr size_t SSG_C = 0, SSG_B = 16384, SSG_BT = 32768, SSG_BYTES = 49152;
__device__ __forceinline__ void ssd_prep_unit(CA A, LAS unsigned char* lds, int layer, int unit, const int wv) {
    const int tid = tid_opaque(wv), lane = tid & 63, w = tid >> 6;
    const int quad = unit & 3, bc = unit >> 2, b = bc >> 5, ck = bc & 31, g = quad >> 1, row0 = b * SEQ + ck * 64, tq0 = ck * 64;
    const float* SC = WSP(float, WS_SCAL); const float* UF = WSP(float, WS_UF); const float* cw = IN_F(I_SSCW) + (size_t)layer * 4 * 1536; const float* cb = IN_F(I_SSCB) + layer * 1536;
    LAS float* xl = (LAS float*)lds;
    LAS float* bl = xl + 4 * 64 * 65;
    LAS float* ws_ = bl + 64 * 129;
    const bool leader = (quad & 1) == 0;
    __syncthreads();
    if (w < 4) { const int hd = quad * 4 + w; unsigned char* rec = A->ws + WS_SSU + (size_t)(bc * 16 + hd) * SSU_BYTES; const float a = -fexp(IN_F(I_SSALOG)[layer * 16 + hd]);
        const float dt = SC[(size_t)(row0 + lane) * 32 + 8 + hd]; const float c = wave_scan(dt * a, lane); const float c63 = rdlane(c, 63); ws_[w * 64 + lane] = fexp(c63 - c) * dt;
        ((float*)(rec + SSU_CUM))[lane] = c; ((float*)(rec + SSU_DT))[lane] = dt; }
    { const int s = tid >> 3, p8 = (tid & 7) * 8;
#pragma unroll
      for (int hq = 0; hq < 4; ++hq) { const int col = (quad * 4 + hq) * 64 + p8; f32x4 x0 = *(const f32x4*)(cb + col), x1 = *(const f32x4*)(cb + col + 4);
#pragma unroll
          for (int j = 0; j < 4; ++j) if (tq0 + s - 3 + j >= 0) { const float* up = UF + (size_t)(row0 + s - 3 + j) * UFW + UF_XBC + col; x0 += *(const f32x4*)up * *(const f32x4*)(cw + j * 1536 + col); x1 += *(const f32x4*)(up + 4) * *(const f32x4*)(cw + j * 1536 + col + 4); }
#pragma unroll
          for (int e = 0; e < 4; ++e) { xl[(hq * 64 + s) * 65 + p8 + e] = siluf_(x0[e]); xl[(hq * 64 + s) * 65 + p8 + 4 + e] = siluf_(x1[e]); } } }
    unsigned char* grec = A->ws + WS_SSG + (size_t)(bc * 2 + g) * SSG_BYTES;
    if (leader) {
        const int s = tid >> 3, n16 = (tid & 7) * 16, colb = 1024 + g * 128 + n16;
        f32x4 bv[4], cv[4];
#pragma unroll
        for (int i = 0; i < 4; ++i) { bv[i] = *(const f32x4*)(cb + colb + 4 * i); cv[i] = *(const f32x4*)(cb + colb + 256 + 4 * i); }
#pragma unroll
        for (int j = 0; j < 4; ++j) if (tq0 + s - 3 + j >= 0) { const float* up = UF + (size_t)(row0 + s - 3 + j) * UFW + UF_XBC + colb; const float* wp = cw + j * 1536 + colb;
#pragma unroll
            for (int i = 0; i < 4; ++i) { bv[i] += *(const f32x4*)(up + 4 * i) * *(const f32x4*)(wp + 4 * i); cv[i] += *(const f32x4*)(up + 256 + 4 * i) * *(const f32x4*)(wp + 256 + 4 * i); } }
#pragma unroll
        for (int i = 0; i < 4; ++i)
#pragma unroll
            for (int e = 0; e < 4; ++e) { bv[i][e] = siluf_(bv[i][e]); cv[i][e] = siluf_(cv[i][e]); }
#pragma unroll
        for (int i = 0; i < 2; ++i) { v4u o; o.x = pk2(bv[2 * i][0], bv[2 * i][1]); o.y = pk2(bv[2 * i][2], bv[2 * i][3]); o.z = pk2(bv[2 * i + 1][0], bv[2 * i + 1][1]); o.w = pk2(bv[2 * i + 1][2], bv[2 * i + 1][3]);
            *(v4u*)(grec + SSG_B + (size_t)(s * 128 + n16 + 8 * i) * 2) = o;
            o.x = pk2(cv[2 * i][0], cv[2 * i][1]); o.y = pk2(cv[2 * i][2], cv[2 * i][3]); o.z = pk2(cv[2 * i + 1][0], cv[2 * i + 1][1]); o.w = pk2(cv[2 * i + 1][2], cv[2 * i + 1][3]);
            *(v4u*)(grec + SSG_C + (size_t)(s * 128 + n16 + 8 * i) * 2) = o; }
#pragma unroll
        for (int i = 0; i < 4; ++i)
#pragma unroll
            for (int e = 0; e < 4; ++e) bl[s * 129 + n16 + 4 * i + e] = bv[i][e];
    }
    __syncthreads();
    { const int p = tid >> 3, s8 = (tid & 7) * 8;
#pragma unroll
      for (int hq = 0; hq < 4; ++hq) { unsigned char* rec = A->ws + WS_SSU + (size_t)(bc * 16 + quad * 4 + hq) * SSU_BYTES; float xv[8], xw[8];
#pragma unroll
          for (int i = 0; i < 8; ++i) { xv[i] = xl[(hq * 64 + s8 + i) * 65 + p]; xw[i] = xv[i] * ws_[hq * 64 + s8 + i]; }
          v4u o; o.x = pk2(xv[0], xv[1]); o.y = pk2(xv[2], xv[3]); o.z = pk2(xv[4], xv[5]); o.w = pk2(xv[6], xv[7]); *(v4u*)(rec + SSU_XT + (size_t)(p * 64 + s8) * 2) = o;
          o.x = pk2(xw[0], xw[1]); o.y = pk2(xw[2], xw[3]); o.z = pk2(xw[4], xw[5]); o.w = pk2(xw[6], xw[7]); *(v4u*)(rec + SSU_XTW + (size_t)(p * 64 + s8) * 2) = o; } }
    if (leader) {
        const int n = tid >> 2, s16 = (tid & 3) * 16; float t[16];
#pragma unroll
        for (int i = 0; i < 16; ++i) t[i] = bl[(s16 + i) * 129 + n];
#pragma unroll
        for (int i = 0; i < 2; ++i) { v4u o; o.x = pk2(t[8 * i], t[8 * i + 1]); o.y = pk2(t[8 * i + 2], t[8 * i + 3]); o.z = pk2(t[8 * i + 4], t[8 * i + 5]); o.w = pk2(t[8 * i + 6], t[8 * i + 7]);
            *(v4u*)(grec + SSG_BT + (size_t)(n * 64 + s16 + 8 * i) * 2) = o; }
    }
}

constexpr int S2_C = 0, S2_B = 17408, S2_BT = 34816, S2_XT = 53248, S2_XTW = 62464, S2_WM = 71680, S2_HB = 80896, S2_YB = 98304, S2_CUM = 114688, S2_DT = 114944;
__device__ __forceinline__ void ssd_seq2(CA A, LAS unsigned char* lds, int layer, int unit, const int wv) {
    const int tid = tid_opaque(wv), lane = tid & 63, w = tid >> 6, q4 = lane >> 4, l15 = lane & 15;
    const int b = unit >> 4, hd = unit & 15, g = hd >> 3;
    const unsigned char* hrec = A->ws + WS_SSU + (size_t)((b * 32) * 16 + hd) * SSU_BYTES;
    const unsigned char* grec = A->ws + WS_SSG + (size_t)((b * 32) * 2 + g) * SSG_BYTES;
    const float* UF = WSP(float, WS_UF); float* SSQ = WSP(float, WS_SSQ); bf16* Og = WSP(bf16, WS_OBR) + (3 + g) * 512;
    const float Dk = IN_F(I_SSD)[layer * 16 + hd];
    LAS float* yb = (LAS float*)(lds + S2_YB); LAS float* cums = (LAS float*)(lds + S2_CUM); LAS float* dts = (LAS float*)(lds + S2_DT);
    f32x4 hacc[4];
#pragma unroll
    for (int i = 0; i < 4; ++i) hacc[i] = (f32x4){0.f, 0.f, 0.f, 0.f};
    v4u st[8]; float sc1 = 0.f;
#define S2_LOAD(ck_) do { const v4u* gg_ = (const v4u*)(grec + (size_t)(ck_) * 2 * SSG_BYTES); const v4u* hh_ = (const v4u*)(hrec + (size_t)(ck_) * 16 * SSU_BYTES); \
        st[0] = gg_[tid]; st[1] = gg_[tid + 512]; st[2] = gg_[tid + 1024]; st[3] = gg_[tid + 1536]; st[4] = gg_[tid + 2048]; st[5] = gg_[tid + 2560]; st[6] = hh_[tid]; st[7] = hh_[tid + 512]; \
        if (tid < 128) sc1 = ((const float*)(hrec + (size_t)(ck_) * 16 * SSU_BYTES + SSU_CUM))[tid]; } while (0)
#define S2_STORE() do { \
        *(LAS v4u*)(lds + S2_C + (tid >> 4) * 272 + (tid & 15) * 16) = st[0]; *(LAS v4u*)(lds + S2_C + (32 + (tid >> 4)) * 272 + (tid & 15) * 16) = st[1]; \
        *(LAS v4u*)(lds + S2_B + (tid >> 4) * 272 + (tid & 15) * 16) = st[2]; *(LAS v4u*)(lds + S2_B + (32 + (tid >> 4)) * 272 + (tid & 15) * 16) = st[3]; \
        *(LAS v4u*)(lds + S2_BT + (tid >> 3) * 144 + (tid & 7) * 16) = st[4]; *(LAS v4u*)(lds + S2_BT + (64 + (tid >> 3)) * 144 + (tid & 7) * 16) = st[5]; \
        *(LAS v4u*)(lds + S2_XT + (tid >> 3) * 144 + (tid & 7) * 16) = st[6]; *(LAS v4u*)(lds + S2_XTW + (tid >> 3) * 144 + (tid & 7) * 16) = st[7]; \
        if (tid < 128) cums[tid] = sc1; } while (0)
    S2_LOAD(0);
    const int tt = w >> 1, aoffC = l15 * 272 + 16 * q4, aoffS = l15 * 144 + 16 * q4;
    float zx[2][4];
#pragma unroll
    for (int e2 = 0; e2 < 2; ++e2)
#pragma unroll
        for (int r = 0; r < 4; ++r) zx[e2][r] = UF[(size_t)(b * SEQ + 16 * tt + 4 * q4 + r) * UFW + UF_SSZ + hd * 64 + 16 * (2 * (w & 1) + e2) + l15];
    for (int ck = 0; ck < 32; ++ck) {
        const int row0 = b * SEQ + ck * 64;
        __syncthreads();
        S2_STORE();
        __syncthreads();
        if (ck + 1 < 32) S2_LOAD(ck + 1);
        float zv[2][4];
#pragma unroll
        for (int e2 = 0; e2 < 2; ++e2)
#pragma unroll
            for (int r = 0; r < 4; ++r) zv[e2][r] = zx[e2][r];
        if (ck + 1 < 32) {
#pragma unroll
            for (int e2 = 0; e2 < 2; ++e2)
#pragma unroll
                for (int r = 0; r < 4; ++r) zx[e2][r] = UF[(size_t)(row0 + 64 + 16 * tt + 4 * q4 + r) * UFW + UF_SSZ + hd * 64 + 16 * (2 * (w & 1) + e2) + l15]; }
#pragma unroll
        for (int e2 = 0; e2 < 2; ++e2) { const int stl = 2 * (w & 1) + e2; f32x4 acc = {0.f, 0.f, 0.f, 0.f};
            if (stl <= tt) {
#pragma unroll
                for (int ks = 0; ks < 4; ++ks) acc = __builtin_amdgcn_mfma_f32_16x16x32_bf16(*(const LAS bf16x8*)(lds + S2_C + tt * 16 * 272 + aoffC + ks * 64), *(const LAS bf16x8*)(lds + S2_B + stl * 16 * 272 + aoffC + ks * 64), acc, 0, 0, 0); }
            const int s = 16 * stl + l15; const float cs = cums[s], ds = dts[s];
#pragma unroll
            for (int r = 0; r < 4; ++r) { const int t = 16 * tt + 4 * q4 + r; const float v = s <= t ? acc[r] * fexp(cums[t] - cs) * ds : 0.f;
                *(LAS unsigned short*)(lds + S2_WM + t * 144 + s * 2) = (unsigned short)f2bf(v); } }
#pragma unroll
        for (int mt = 0; mt < 4; ++mt)
#pragma unroll
            for (int r = 0; r < 4; ++r) *(LAS unsigned short*)(lds + S2_HB + (16 * mt + 4 * q4 + r) * 272 + (16 * w + l15) * 2) = (unsigned short)f2bf(hacc[mt][r]);
        __syncthreads();
        float ssq[4] = {0.f, 0.f, 0.f, 0.f};
#pragma unroll
        for (int e2 = 0; e2 < 2; ++e2) { const int pt = 2 * (w & 1) + e2; f32x4 y = {0.f, 0.f, 0.f, 0.f};
#pragma unroll
            for (int ks = 0; ks < 4; ++ks) y = __builtin_amdgcn_mfma_f32_16x16x32_bf16(*(const LAS bf16x8*)(lds + S2_C + tt * 16 * 272 + aoffC + ks * 64), *(const LAS bf16x8*)(lds + S2_HB + pt * 16 * 272 + aoffC + ks * 64), y, 0, 0, 0);
#pragma unroll
            for (int r = 0; r < 4; ++r) y[r] *= fexp(cums[16 * tt + 4 * q4 + r]);
#pragma unroll
            for (int ke = 0; ke < 2; ++ke) y = __builtin_amdgcn_mfma_f32_16x16x32_bf16(*(const LAS bf16x8*)(lds + S2_WM + tt * 16 * 144 + aoffS + ke * 64), *(const LAS bf16x8*)(lds + S2_XT + pt * 16 * 144 + aoffS + ke * 64), y, 0, 0, 0);
            const int p = 16 * pt + l15;
#pragma unroll
            for (int r = 0; r < 4; ++r) { const int t = 16 * tt + 4 * q4 + r; const float xv = bflo((unsigned)*(const LAS unsigned short*)(lds + S2_XT + p * 144 + t * 2));
                const float yg = (y[r] + Dk * xv) * siluf_(zv[e2][r]); ssq[r] += yg * yg;
                Og[(size_t)(row0 + t) * OBW + (hd & 7) * 64 + p] = (bf16)f2bf(yg); } }
#pragma unroll
        for (int r = 0; r < 4; ++r) { const float s = row16_sum(ssq[r]); if (l15 == 0) SSQ[(size_t)(row0 + 16 * tt + 4 * q4 + r) * 32 + hd * 2 + (w & 1)] = s; }
        { const float e63 = fexp(cums[63]);
#pragma unroll
          for (int mt = 0; mt < 4; ++mt) { hacc[mt] = hacc[mt] * e63;
#pragma unroll
              for (int ke = 0; ke < 2; ++ke) hacc[mt] = __builtin_amdgcn_mfma_f32_16x16x32_bf16(*(const LAS bf16x8*)(lds + S2_XTW + mt * 16 * 144 + aoffS + ke * 64), *(const LAS bf16x8*)(lds + S2_BT + w * 16 * 144 + aoffS + ke * 64), hacc[mt], 0, 0, 0); } }
    }
    float* hout = A->out + O_SSHP + ((size_t)(layer * NBATCH + b) * 16 + hd) * 8192;
#pragma unroll
    for (int mt = 0; mt < 4; ++mt)
#pragma unroll
        for (int r = 0; r < 4; ++r) hout[(size_t)(16 * mt + 4 * q4 + r) * 128 + 16 * w + l15] = hacc[mt][r];
    __syncthreads();
#undef S2_LOAD
#undef S2_STORE
}

struct ALBf16 { const bf16* A; int lda; __device__ __forceinline__ bf16x8 operator()(int row, int k) const { return *(const bf16x8*)(A + (size_t)row * lda + k); } };
template <class AL> __device__ __forceinline__ void sgemm_task(const AL& al, const bf16* Wt, int ldw, int n0, int k0, int nks, f32x4 (&acc)[2], int l15, int q4) {
    const bf16* bp = Wt + (size_t)(n0 + l15) * ldw + k0 + 8 * q4;
    int nks_ = nks; asm volatile("" : "+s"(nks_));
#pragma unroll 4
    for (int ks = 0; ks < nks_; ++ks) { const bf16x8 b = *(const bf16x8*)(bp + 32 * ks); const bf16x8 a0 = al(l15, k0 + 32 * ks + 8 * q4), a1 = al(16 + l15, k0 + 32 * ks + 8 * q4);
        acc[0] = __builtin_amdgcn_mfma_f32_16x16x32_bf16(a0, b, acc[0], 0, 0, 0); acc[1] = __builtin_amdgcn_mfma_f32_16x16x32_bf16(a1, b, acc[1], 0, 0, 0); }
}
#define SAMPLE_IDS() const int tid = tid_opaque(wv), lane = tid & 63, l15 = lane & 15, q4 = lane >> 4, NGW = gridDim.x * NWAVES, gw = (tid >> 6) * gridDim.x + blk_opaque()
__device__ __forceinline__ void sample_merge(CA A, LAS unsigned char* lds, int layer, const int wv) {
    const int tid = tid_opaque(wv), lane = tid & 63, l15 = lane & 15, q4 = lane >> 4, w = tid >> 6, G = gridDim.x;
    const bf16* GT = WSP(bf16, WS_GATE); const float* RS = WSP(float, WS_RS); bf16* MB = WSP(bf16, WS_MGB); LAS float* part = (LAS float*)lds;
    for (int strip = blk_opaque(); strip < 128; strip += G) { const int n0 = strip * 16, col = n0 + l15;
        __syncthreads();
        if (w < 5) { const int s = w, gs = s < 3 ? s : 3;
            f32x4 acc[2] = {{0.f, 0.f, 0.f, 0.f}, {0.f, 0.f, 0.f, 0.f}};
            ALBf16 al{WSP(bf16, WS_OBR) + (size_t)TP * OBW + s * 512, OBW};
            sgemm_task(al, WSP(bf16, WS_WBR) + (size_t)layer * DM * OBW + s * 512, OBW, n0, 0, 16, acc, l15, q4);
#pragma unroll
            for (int mt = 0; mt < 2; ++mt)
#pragma unroll
                for (int r = 0; r < 4; ++r) { const int row = 16 * mt + 4 * q4 + r, grow = TP + row; float rs = 1.f;
                    if (s >= 3) rs = 1.0f / sqrtf(RS[(size_t)grow * 2 + (s - 3)]);
                    part[(s * 32 + row) * 16 + l15] = acc[mt][r] * bflo((unsigned)GT[(size_t)grow * 8192 + gs * 2048 + col]) * rs; } }
        __syncthreads();
        { const int row = tid >> 4, c = tid & 15; const float v = (part[row * 16 + c] + part[(32 + row) * 16 + c]) + (part[(64 + row) * 16 + c] + part[(96 + row) * 16 + c]) + part[(128 + row) * 16 + c];
          MB[(size_t)(TP + row) * DM + n0 + c] = (bf16)f2bf(v); } }
}
__device__ __forceinline__ void sample_up(CA A, LAS unsigned char* lds, int layer, const int wv) {
    const int tid = tid_opaque(wv), lane = tid & 63, l15 = lane & 15, q4 = lane >> 4, w = tid >> 6, G = gridDim.x;
    bf16* F = WSP(bf16, WS_F); LAS float* part = (LAS float*)lds;
    for (int sp = blk_opaque(); sp < 256; sp += G) { const int n0 = (2 * sp + (w >> 2)) * 16, kq = w & 3;
        __syncthreads();
        f32x4 acc[2] = {{0.f, 0.f, 0.f, 0.f}, {0.f, 0.f, 0.f, 0.f}};
        ALBf16 al{WSP(bf16, WS_H) + (size_t)TP * DM, DM};
        sgemm_task(al, WSP(bf16, WS_WUP) + (size_t)layer * DFF * DM, DM, n0, kq * 512, 16, acc, l15, q4);
#pragma unroll
        for (int mt = 0; mt < 2; ++mt)
#pragma unroll
            for (int r = 0; r < 4; ++r) part[(w * 32 + 16 * mt + 4 * q4 + r) * 16 + l15] = acc[mt][r];
        __syncthreads();
#pragma unroll
        for (int h2 = 0; h2 < 2; ++h2) { const int idx = tid + 512 * h2, half = idx >> 9, row = (idx >> 4) & 31, c = idx & 15; const LAS float* p = part + (half * 4 * 32 + row) * 16 + c;
            const float v = fmaxf((p[0] + p[32 * 16]) + (p[2 * 32 * 16] + p[3 * 32 * 16]), 0.f);
            F[(size_t)(TP + row) * DFF + (2 * sp + half) * 16 + c] = (bf16)f2bf(v * v); } }
}
template <class AL> __device__ __forceinline__ void sample_splitk(const AL& al, const bf16* Wt, int ldw, int nstrips, int nsplit, int nks, float* PART, int ldp, const int wv) {
    SAMPLE_IDS();
    for (int it = gw; it < nstrips * nsplit; it += NGW) { const int ns = it % nstrips, sp = it / nstrips, n0 = ns * 16;
        f32x4 acc[2] = {{0.f, 0.f, 0.f, 0.f}, {0.f, 0.f, 0.f, 0.f}};
        sgemm_task(al, Wt, ldw, n0, sp * nks * 32, nks, acc, l15, q4);
#pragma unroll
        for (int mt = 0; mt < 2; ++mt)
#pragma unroll
            for (int r = 0; r < 4; ++r) PART[((size_t)sp * TS + 16 * mt + 4 * q4 + r) * ldp + n0 + l15] = acc[mt][r]; }
}

constexpr int KS_PITCH = 272, VT_PITCH = 136;
constexpr int ATT_KS = 0, ATT_VT = 64 * KS_PITCH;
__device__ __forceinline__ void attn_prompt_unit(CA A, LAS unsigned char* lds, int layer, int unit, const int wv) {
    const int tid = tid_opaque(wv), lane = tid & 63, wid = tid >> 6, r = lane & 31, hh = lane >> 5;
    const int qb = 7 - (unit >> 4), bh = unit & 15, b = bh >> 2, h = bh & 3;
    const int q0 = qb * 256 + wid * 32, qpos = q0 + r;
    const bf16* QKV = WSP(bf16, WS_QKV) + (size_t)(b * SEQ) * 1536;
    bf16x8 Qf[8];
    { const bf16* qrow = QKV + (size_t)qpos * 1536 + h * 128 + 8 * hh;
#pragma unroll
      for (int s = 0; s < 8; ++s) Qf[s] = *(const bf16x8*)(qrow + 16 * s); }
    f32x16 O[4];
#pragma unroll
    for (int d = 0; d < 4; ++d)
#pragma unroll
        for (int i = 0; i < 16; ++i) O[d][i] = 0.f;
    float R = 1.f;
    const float bias2 = IN_F(I_SBBIAS)[layer * 4 + h] * LOG2E;
    const int ntile = qb * 4 + 4, srow = tid >> 3, sch = tid & 7;
    LAS unsigned char* Ks = lds + ATT_KS; LAS unsigned char* Vt = lds + ATT_VT;
    v4u kreg[2], vreg[2];
    { const bf16* src = QKV + (size_t)((ntile - 1) * 64 + srow) * 1536 + h * 128 + sch * 8;
      kreg[0] = *(const v4u*)(src + 512); kreg[1] = *(const v4u*)(src + 512 + 64); vreg[0] = *(const v4u*)(src + 1024); vreg[1] = *(const v4u*)(src + 1024 + 64); }
    for (int kt = ntile - 1; kt >= 0; --kt) {
        __syncthreads();
#pragma unroll
        for (int i = 0; i < 2; ++i) { *(LAS v4u*)(Ks + srow * KS_PITCH + (sch + 8 * i) * 16) = kreg[i];
            LAS unsigned short* vt = (LAS unsigned short*)Vt + ((sch + 8 * i) * 8) * (VT_PITCH / 2) + srow;
            const unsigned w[4] = {vreg[i].x, vreg[i].y, vreg[i].z, vreg[i].w};
#pragma unroll
            for (int e = 0; e < 4; ++e) { vt[(2 * e) * (VT_PITCH / 2)] = (unsigned short)(w[e] & 0xffffu); vt[(2 * e + 1) * (VT_PITCH / 2)] = (unsigned short)(w[e] >> 16); } }
        __syncthreads();
        if (kt > 0) { const bf16* src = QKV + (size_t)((kt - 1) * 64 + srow) * 1536 + h * 128 + sch * 8;
            kreg[0] = *(const v4u*)(src + 512); kreg[1] = *(const v4u*)(src + 512 + 64); vreg[0] = *(const v4u*)(src + 1024); vreg[1] = *(const v4u*)(src + 1024 + 64); }
        if (kt * 64 > q0 + 30) continue;
        const bool diag = (kt * 64 + 63 >= q0);
        const int kbase = kt * 64 + 4 * hh;
        bf16x8 Pf[4];
#pragma unroll
        for (int sub = 1; sub >= 0; --sub) {
            f32x16 sa;
#pragma unroll
            for (int i = 0; i < 16; ++i) sa[i] = bias2;
#pragma unroll
            for (int s = 0; s < 8; ++s) { const bf16x8 a = *(const LAS bf16x8*)(Ks + (32 * sub + r) * KS_PITCH + (16 * s + 8 * hh) * 2);
                sa = __builtin_amdgcn_mfma_f32_32x32x16_bf16(a, Qf[s], sa, 0, 0, 0); }
            float sp[16], iv[16], Gs[4], Gp[4];
#pragma unroll
            for (int i = 0; i < 16; ++i) { const float e = ex2(fminf(sa[i], 60.f)); float inv = __builtin_amdgcn_rcpf(1.0f + e), bt = e * inv;
                if (diag && (kbase + 32 * sub + 8 * (i >> 2) + (i & 3) >= qpos)) { inv = 1.f; bt = 0.f; }
                iv[i] = inv; sp[i] = bt; }
#pragma unroll
            for (int g = 0; g < 4; ++g) { Gs[g] = (iv[4 * g] * iv[4 * g + 1]) * (iv[4 * g + 2] * iv[4 * g + 3]); Gp[g] = __shfl_xor(Gs[g], 32); }
            float run = R;
#pragma unroll
            for (int g = 3; g >= 0; --g) { float a = hh == 0 ? run * Gp[g] : run;
#pragma unroll
                for (int e = 3; e >= 0; --e) { const int i = 4 * g + e; sp[i] *= a; a *= iv[i]; }
                run *= Gs[g] * Gp[g]; }
            R = run;
#pragma unroll
            for (int q2 = 0; q2 < 2; ++q2) { const int bs = 8 * q2; v4u w;
                w.x = pk2(sp[bs + 0], sp[bs + 1]); w.y = pk2(sp[bs + 2], sp[bs + 3]); w.z = pk2(sp[bs + 4], sp[bs + 5]); w.w = pk2(sp[bs + 6], sp[bs + 7]);
                Pf[2 * sub + q2] = __builtin_bit_cast(bf16x8, w); }
        }
#pragma unroll
        for (int d = 0; d < 4; ++d)
#pragma unroll
            for (int s4 = 0; s4 < 4; ++s4) { const LAS unsigned char* vp = Vt + (32 * d + r) * VT_PITCH + (16 * s4 + 4 * hh) * 2;
                const v2u lo = *(const LAS v2u*)vp, hi = *(const LAS v2u*)(vp + 16); v4u w; w.x = lo.x; w.y = lo.y; w.z = hi.x; w.w = hi.y;
                O[d] = __builtin_amdgcn_mfma_f32_32x32x16_bf16(__builtin_bit_cast(bf16x8, w), Pf[s4], O[d], 0, 0, 0); }
    }
    bf16* orow = WSP(bf16, WS_OBR) + 1024 + (size_t)(b * SEQ + qpos) * OBW + h * 128 + 4 * hh;
#pragma unroll
    for (int d = 0; d < 4; ++d)
#pragma unroll
        for (int g = 0; g < 4; ++g) { v2u w; w.x = pk2(O[d][4 * g], O[d][4 * g + 1]); w.y = pk2(O[d][4 * g + 2], O[d][4 * g + 3]); *(v2u*)(orow + 32 * d + 8 * g) = w; }
}

__device__ __forceinline__ void attn_sample_unit(CA A, LAS unsigned char* lds, int layer, int unit, const int wv) {
    const int tid = tid_opaque(wv), lane = tid & 63, wid = tid >> 6, sb = unit >> 5, pg4 = unit & 31, hd = lane >> 4;
    const int lp = 4 * pg4 + (wid >> 1), phys = ((const int*)A->in[I_PT])[sb * NPAGES + lp];
    const size_t pbase = ((size_t)(layer * NPOOL + phys) * PAGE + (wid & 1) * 64) * 512 + lane * 8;
    const float* Kc = IN_F(I_CK) + pbase; const float* Vc = IN_F(I_CV) + pbase;
    const bf16* QKV = WSP(bf16, WS_QKV);
    float qf[4][8], O[4][8], R[4];
#pragma unroll
    for (int i = 0; i < 4; ++i) { const v4u w = *(const v4u*)(QKV + (size_t)(TP + sb * 4 + i) * 1536 + lane * 8);
        qf[i][0] = bflo(w.x); qf[i][1] = bfhi(w.x); qf[i][2] = bflo(w.y); qf[i][3] = bfhi(w.y); qf[i][4] = bflo(w.z); qf[i][5] = bfhi(w.z); qf[i][6] = bflo(w.w); qf[i][7] = bfhi(w.w);
        R[i] = 0.f;
#pragma unroll
        for (int j = 0; j < 8; ++j) O[i][j] = 0.f; }
    const float bias2 = IN_F(I_SBBIAS)[layer * 4 + hd] * LOG2E;
#pragma unroll 4
    for (int t = 63; t >= 0; --t) {
        const f32x4 k0 = *(const f32x4*)(Kc + (size_t)t * 512), k1 = *(const f32x4*)(Kc + (size_t)t * 512 + 4), v0 = *(const f32x4*)(Vc + (size_t)t * 512), v1 = *(const f32x4*)(Vc + (size_t)t * 512 + 4);
#pragma unroll
        for (int i = 0; i < 4; ++i) {
            float s = (qf[i][0] * k0[0] + qf[i][1] * k0[1]) + (qf[i][2] * k0[2] + qf[i][3] * k0[3]) + (qf[i][4] * k1[0] + qf[i][5] * k1[1]) + (qf[i][6] * k1[2] + qf[i][7] * k1[3]);
            s = row16_sum(s);
            const float z = fminf(s + bias2, 60.f), s1 = lg2(1.0f + ex2(z)), pv = ex2(z - s1 - R[i]); R[i] += s1;
#pragma unroll
            for (int e = 0; e < 4; ++e) { O[i][e] += pv * v0[e]; O[i][4 + e] += pv * v1[e]; } }
    }
    LAS float* Ow = (LAS float*)lds;
    LAS float* Rw = Ow + 8 * 4 * 512;
    __syncthreads();
#pragma unroll
    for (int i = 0; i < 4; ++i) { *(LAS f32x4*)(Ow + (wid * 4 + i) * 512 + lane * 8) = (f32x4){O[i][0], O[i][1], O[i][2], O[i][3]}; *(LAS f32x4*)(Ow + (wid * 4 + i) * 512 + lane * 8 + 4) = (f32x4){O[i][4], O[i][5], O[i][6], O[i][7]};
        if ((lane & 15) == 0) Rw[(wid * 4 + i) * 4 + hd] = R[i]; }
    __syncthreads();
    float* PART = WSP(float, WS_PART) + (size_t)unit * 2048; float* PR = WSP(float, WS_PR) + (size_t)unit * 16;
    for (int idx = tid; idx < 2048; idx += NTHR) { const int i = idx >> 9, c = idx & 511, hc = c >> 7; float acc = 0.f, racc = 0.f;
#pragma unroll
        for (int w = 7; w >= 0; --w) { acc += ex2(-racc) * Ow[(w * 4 + i) * 512 + c]; racc += Rw[(w * 4 + i) * 4 + hc]; }
        PART[idx] = acc; if ((c & 127) == 0) PR[i * 4 + hc] = racc; }
}
__device__ __forceinline__ void attn_sample_combine(CA A, int layer, const int wv) {
    {
      const int t0 = tid_opaque(wv), gt = blk_opaque() * NTHR + t0; const float* SQ = WSP(float, WS_SSQ); float* RS = WSP(float, WS_RS);
      for (int idx = gt; idx < TT * 2; idx += gridDim.x * NTHR) { const f32x4* sq = (const f32x4*)(SQ + (size_t)idx * 16); const f32x4 a = sq[0], b = sq[1], c = sq[2], d = sq[3];
          RS[idx] = (((a[0] + a[1]) + (a[2] + a[3]) + (b[0] + b[1]) + (b[2] + b[3])) + ((c[0] + c[1]) + (c[2] + c[3]) + (d[0] + d[1]) + (d[2] + d[3]))) * (1.0f / 512.0f) + RMS_EPS; } }
    const int tid = tid_opaque(wv), lane = tid & 63, gw = blk_opaque() * NWAVES + (tid >> 6), NGW = gridDim.x * NWAVES;
    const bf16* QKV = WSP(bf16, WS_QKV); const float* PART = WSP(float, WS_PART); const float* PR = WSP(float, WS_PR);
    const float* kn = A->out + O_KS + (size_t)layer * TS * 512; const float* vn = A->out + O_VS + (size_t)layer * TS * 512;
    bf16* O2 = WSP(bf16, WS_OBR) + 1024;
    for (int it = gw; it < TS * 4; it += NGW) { const int sb = it >> 4, i = (it >> 2) & 3, hd = it & 3, row = TP + sb * 4 + i, c = hd * 128 + 2 * lane;
        const unsigned qw = *(const unsigned*)(QKV + (size_t)row * 1536 + c); const float q0 = bflo(qw), q1 = bfhi(qw);
        const float bias2 = IN_F(I_SBBIAS)[layer * 4 + hd] * LOG2E; float o0 = 0.f, o1 = 0.f, racc = 0.f;
        for (int j = i - 1; j >= 0; --j) { const float* kr = kn + (size_t)(sb * 4 + j) * 512 + c; const float* vr = vn + (size_t)(sb * 4 + j) * 512 + c;
            const float z = fminf(wave_sum(q0 * kr[0] + q1 * kr[1]) + bias2, 60.f), s1 = lg2(1.0f + ex2(z)), pv = ex2(z - s1 - racc); racc += s1; o0 += pv * vr[0]; o1 += pv * vr[1]; }
        for (int u = 31; u >= 0; --u) { const float* pr = PART + ((size_t)(sb * 32 + u) * 4 + i) * 512 + c; const float sc = ex2(-racc); o0 += sc * pr[0]; o1 += sc * pr[1]; racc += PR[(size_t)(sb * 32 + u) * 16 + i * 4 + hd]; }
        *(unsigned*)(O2 + (size_t)row * OBW + c) = pk2(o0, o1); }
}

#ifndef MK_ONE_LAUNCH
#define MK_ONE_LAUNCH 1
#endif
#ifndef REP_P0
#define REP_P0 1
#endif
#ifndef REP_IN
#define REP_IN 1
#endif
#ifndef REP_PREP
#define REP_PREP 1
#endif
#ifndef REP_MIXA
#define REP_MIXA 1
#endif
#ifndef REP_MIXB
#define REP_MIXB 1
#endif
#ifndef REP_MERGE
#define REP_MERGE 1
#endif
#ifndef REP_OUT
#define REP_OUT 1
#endif
#ifndef REP_UP
#define REP_UP 1
#endif
#ifndef REP_DOWN
#define REP_DOWN 1
#endif
#ifndef REP_BAR
#define REP_BAR 1
#endif
#ifndef REP_RES1L0
#define REP_RES1L0 1
#endif
#ifndef REP_ADN
#define REP_ADN 1
#endif
#ifndef REP_ASSD
#define REP_ASSD 1
#endif
#ifndef REP_BDN
#define REP_BDN 1
#endif
#ifndef REP_BSSD
#define REP_BSSD 1
#endif
#ifndef REP_BSATT
#define REP_BSATT 1
#endif
constexpr int N_PHASES = 24;
__device__ __forceinline__ int queue_pop(unsigned* head, volatile LAS unsigned* slot, const int wv) {
    __syncthreads();
    if (tid_opaque(wv) == 0) *slot = __hip_atomic_fetch_add(head, 1u, __ATOMIC_RELAXED, __HIP_MEMORY_SCOPE_AGENT);
    __syncthreads();
    return (int)*slot;
}
__global__ void __launch_bounds__(NTHR, 2) mega(Args Araw) {
    extern __shared__ __attribute__((aligned(16))) unsigned char lds_raw[];
    LAS unsigned char* lds = (LAS unsigned char*)lds_raw;
    volatile LAS unsigned* MISC = (volatile LAS unsigned*)(lds + MISC_OFF);
    const int wv = __builtin_amdgcn_readfirstlane(threadIdx.x >> 6); const int tid = tid_opaque(wv), G = gridDim.x, blk = blk_opaque();
    if (tid < 16) MISC[tid] = 0u;
    __syncthreads();
    unsigned* ctl = (unsigned*)(Araw.ws + WS_CTL);
    XcdBarrier bar = xcd_barrier_post(ctl + CW_BAR + Araw.li * XCD_BAR_WORDS, MISC, tid);
    const int lo = Araw.ph_lo, hi = Araw.ph_hi;
#define IN(gp) (lo <= (gp) && (gp) < hi)
#define SEAM(gp) do { if (lo <= (gp) && (gp) + 1 < hi) for (int rb_ = 0; rb_ < REP_BAR; ++rb_) xcd_barrier(bar, tid_opaque(wv)); } while (0)

    if (IN(0)) for (int rep = 0; rep < REP_P0; ++rep) { CA A = args_opaque(); p0_prologue(A, lds, wv); }
    if (IN(0)) { CA A = args_opaque(); norm1_phase(A, wv); }
    SEAM(0);
    for (int layer = 0; layer < DEPTH; ++layer) {
        const int gb = 1 + 11 * layer;
        if (IN(gb + 1)) for (int rep = 0; rep < REP_IN; ++rep) { CA A = args_opaque();
            pg8::Gemm g{WSP(bf16, WS_H), WSP(bf16, WS_WIN) + (size_t)layer * NIN * DM, MP, NIN, DM, DM / 64, 0}; pg8::StaticOrder S; S.init(MP, NIN, G, blk_opaque());
            EpiIn E{WSP(float, WS_UF), WSP(bf16, WS_QKV), WSP(bf16, WS_GATE), A->out + O_KP + (size_t)layer * TP * 512, A->out + O_VP + (size_t)layer * TP * 512,
                    A->out + O_KS + (size_t)layer * TS * 512, A->out + O_VS + (size_t)layer * TS * 512, 0.08838834764831845f * LOG2E};
            pg8::gemm_phase<EpiIn, pg8::StaticOrder, true, true>(lds, g, S, E, wv);
        }
        SEAM(gb + 1);
        if (IN(gb + 2)) for (int rep = 0; rep < REP_PREP; ++rep) { CA A = args_opaque(); prep_phase(A, layer, wv); }
        SEAM(gb + 2);
        if (IN(gb + 3)) for (int rep = 0; rep < REP_MIXA; ++rep) { CA A = args_opaque();
            for (int r2 = 0; r2 < REP_ASSD; ++r2) { unsigned* qh = (unsigned*)(A->ws + WS_CTL) + CW_QUEUE + 64 * (layer * 4 + 3) + 1024 * rep + 2048 * r2;
              for (;;) { const int u = queue_pop(qh, MISC + 4, wv); if (u >= 512) break; ssd_prep_unit(A, lds, layer, u, wv); } }
            for (int r2 = 0; r2 < REP_ADN; ++r2) { unsigned* qh = (unsigned*)(A->ws + WS_CTL) + CW_QUEUE + 64 * (layer * 4 + 2) + 1024 * rep + 2048 * r2;
              for (;;) { const int u = queue_pop(qh, MISC + 4, wv); if (u >= 512) break; dn_chunk_unit(A, lds, layer, u, wv); } }
        }
        SEAM(gb + 3);
        if (IN(gb + 4)) for (int rep = 0; rep < REP_MIXB; ++rep) { CA A = args_opaque();
            for (int r2 = 0; r2 < REP_BDN; ++r2) for (int t = blk; t < 16; t += G) dn_seq2(A, lds, layer, t, wv);
            for (int r2 = 0; r2 < REP_BSSD; ++r2) for (int t = blk; t < 80; t += G) if (t >= 16) ssd_seq2(A, lds, layer, t - 16, wv);
            for (int t = blk; t < 112; t += G) if (t >= 80) dn_seq(A, lds, layer, t - 80 + 16, wv);
            for (int t = blk; t < 240; t += G) if (t >= 112) ssd_seq(A, lds, layer, t - 112 + 64, wv);
            { unsigned* qh = (unsigned*)(A->ws + WS_CTL) + CW_QUEUE + 64 * (layer * 4 + 0) + 1024 * rep;
              for (;;) { const int u = queue_pop(qh, MISC + 4, wv); if (u >= 128) break; attn_prompt_unit(A, lds, layer, u, wv); } }
            for (int r2 = 0; r2 < REP_BSATT; ++r2) { unsigned* qh = (unsigned*)(A->ws + WS_CTL) + CW_QUEUE + 64 * (layer * 4 + 1) + 1024 * rep + 2048 * r2;
              for (;;) { const int u = queue_pop(qh, MISC + 4, wv); if (u >= 256) break; attn_sample_unit(A, lds, layer, u, wv); } }
        }
        SEAM(gb + 4);
        if (IN(gb + 5)) { CA A = args_opaque(); attn_sample_combine(A, layer, wv);
            { unsigned* qh = (unsigned*)(A->ws + WS_CTL) + 16384 + 64 * layer;
              for (;;) { const int u = queue_pop(qh, MISC + 4, wv); if (u >= 512) break; dn_out_unit(A, lds, layer, u, wv); } } }
        SEAM(gb + 5);
        if (IN(gb + 6)) for (int rep = 0; rep < REP_MERGE; ++rep) { CA A = args_opaque();
            pg8::SegOrder<5> S; S.init(TP, DM, G, blk_opaque());
            pg8::Gemm g{WSP(bf16, WS_OBR), WSP(bf16, WS_WBR) + (size_t)layer * DM * OBW, TP, DM, OBW, 8, 1024};
            EpiMergeR E{WSP(bf16, WS_GATE), WSP(float, WS_RS), WSP(bf16, WS_MGB)};
            pg8::gemm_phase<EpiMergeR, pg8::SegOrder<5>, true, true>(lds, g, S, E, wv);
            sample_merge(A, lds, layer, wv);
        }
        SEAM(gb + 6);
        if (IN(gb + 7)) for (int rep = 0; rep < REP_OUT; ++rep) { CA A = args_opaque();
            pg8::Gemm g{WSP(bf16, WS_MGB), WSP(bf16, WS_WOUT) + (size_t)layer * DM * DM, TP, DM, DM, DM / 64, 0}; pg8::StaticOrder S; S.init(TP, DM, G, blk_opaque());
            EpiF32 E{WSP(float, WS_MIX), DM}; pg8::gemm_phase<EpiF32, pg8::StaticOrder, true, true>(lds, g, S, E, wv);
            { ALBf16 al{WSP(bf16, WS_MGB) + (size_t)TP * DM, DM}; sample_splitk(al, WSP(bf16, WS_WOUT) + (size_t)layer * DM * DM, DM, 128, 16, 4, WSP(float, WS_OUTS), DM, wv); }
        }
        SEAM(gb + 7);
        if (IN(gb + 8)) for (int rep = 0; rep < (layer == 0 ? REP_RES1L0 : 1); ++rep) { CA A = args_opaque(); resid_phase(A, WSP(float, WS_MIX), WSP(float, WS_OUTS), IN_F(I_NMPOST) + layer * DM, IN_F(I_NLPRE) + layer * DM, layer == 0, wv); }
        SEAM(gb + 8);
        if (IN(gb + 9)) for (int rep = 0; rep < REP_UP; ++rep) { CA A = args_opaque();
            pg8::Gemm g{WSP(bf16, WS_H), WSP(bf16, WS_WUP) + (size_t)layer * DFF * DM, TP, DFF, DM, DM / 64, 0}; pg8::StaticOrder S; S.init(TP, DFF, G, blk_opaque());
            EpiRelu2 E{WSP(bf16, WS_F), DFF}; pg8::gemm_phase<EpiRelu2, pg8::StaticOrder, true, true>(lds, g, S, E, wv);
            sample_up(A, lds, layer, wv);
        }
        SEAM(gb + 9);
        if (IN(gb + 10)) for (int rep = 0; rep < REP_DOWN; ++rep) { CA A = args_opaque();
            pg8::Gemm g{WSP(bf16, WS_F), WSP(bf16, WS_WDN) + (size_t)layer * DM * DFF, TP, DM, DFF, DFF / 64, 0}; pg8::StaticOrder S; S.init(TP, DM, G, blk_opaque());
            EpiF32 E{WSP(float, WS_FD), DM}; pg8::gemm_phase<EpiF32, pg8::StaticOrder, true, true>(lds, g, S, E, wv);
            { ALBf16 al{WSP(bf16, WS_F) + (size_t)TP * DFF, DFF}; sample_splitk(al, WSP(bf16, WS_WDN) + (size_t)layer * DM * DFF, DFF, 128, 16, 16, WSP(float, WS_DNS), DM, wv); }
        }
        SEAM(gb + 10);
        if (IN(gb + 11)) { CA A = args_opaque(); resid_phase(A, WSP(float, WS_FD), WSP(float, WS_DNS), IN_F(I_NLPOST) + layer * DM, layer + 1 < DEPTH ? IN_F(I_NMPRE) + (layer + 1) * DM : nullptr, false, wv); }
        SEAM(gb + 11);
    }
#undef IN
#undef SEAM
}

extern "C" void kernel_launch(void* const* d_in, const int* in_sizes, int n_in, void* d_out, int out_size, void* d_ws, size_t ws_size, hipStream_t stream) {
    static int grid = 0;
    if (grid == 0) {
        if (n_in != N_IN || (size_t)out_size != O_END || ws_size < WS_END) { fprintf(stderr, "kernel_launch: unexpected problem (n_in %d, out %d vs %zu, ws %zu vs %zu); nothing launched\n", n_in, out_size, (size_t)O_END, ws_size, (size_t)WS_END); grid = -1; return; }
        int dev = 0, cus = 0, per_cu = 0;
        if (hipGetDevice(&dev) != hipSuccess || hipDeviceGetAttribute(&cus, hipDeviceAttributeMultiprocessorCount, dev) != hipSuccess) { grid = -1; return; }
        if (hipFuncSetAttribute((const void*)mega, hipFuncAttributeMaxDynamicSharedMemorySize, LDS_BYTES) != hipSuccess) { fprintf(stderr, "kernel_launch: hipFuncSetAttribute failed\n"); grid = -1; return; }
        if (hipOccupancyMaxActiveBlocksPerMultiprocessor(&per_cu, (const void*)mega, NTHR, LDS_BYTES) != hipSuccess || per_cu < 1) fprintf(stderr, "kernel_launch: occupancy query says %d blocks per CU\n", per_cu);
        (void)hipGetLastError();
        grid = cus;
    }
    if (grid < 0) return;
    (void)in_sizes;
    hipMemsetAsync((char*)d_ws + WS_CTL, 0, CTL_BYTES, stream);
    Args a{};
    for (int i = 0; i < N_IN; ++i) a.in[i] = d_in[i];
    a.out = (float*)d_out; a.ws = (unsigned char*)d_ws; a.pad = 0;
#if MK_ONE_LAUNCH
    a.ph_lo = 0; a.ph_hi = N_PHASES; a.li = 0;
    hipLaunchKernelGGL(mega, dim3(grid), dim3(NTHR), LDS_BYTES, stream, a);
#else
    for (int gp = 0; gp < N_PHASES; ++gp) { a.ph_lo = gp; a.ph_hi = gp + 1; a.li = 0; hipLaunchKernelGGL(mega, dim3(grid), dim3(NTHR), LDS_BYTES, stream, a); }
#endif
}
```

```cpp
#include <hip/hip_runtime.h>
#include <cstdio>
#include <cstdint>
__device__ __forceinline__ int lane_opaque() { unsigned m = ~0u; asm volatile("" : "+s"(m)); return (int)__builtin_amdgcn_mbcnt_hi(m, __builtin_amdgcn_mbcnt_lo(m, 0u)); }
__device__ __forceinline__ int tid_opaque(int wv) { return wv * 64 + lane_opaque(); }
__device__ __forceinline__ int blk_opaque() { int t = blockIdx.x; asm volatile("" : "+s"(t)); return t; }
namespace pg8 {
#define PG8_LAS __attribute__((address_space(3)))
typedef unsigned short bf16_t;
typedef short bf16x8 __attribute__((ext_vector_type(8)));
typedef float f32x4 __attribute__((ext_vector_type(4)));
typedef unsigned u32x4 __attribute__((ext_vector_type(4)));
constexpr int BM = 256, BK = 64, HALF = 128, HTB = HALF * BK * 2  , STAGE_BYTES = 8 * HTB, NXCD = 8, WGM = 8;

__host__ __device__ __forceinline__ int lds_byte(int r, int c) { const int st = (r >> 4) * 2 + (c >> 5), rr = r & 15, cc = c & 31, ob = rr * 64 + cc * 2; return st * 1024 + (ob ^ (((ob >> 9) & 1) << 5)); }
__host__ __device__ __forceinline__ void stage_rc(int b, int& R, int& C) { const int st = b / 1024, sb = b % 1024, swz = sb ^ (((sb >> 9) & 1) << 5); R = (st >> 1) * 16 + swz / 64; C = (st & 1) * 32 + (swz % 64) / 2; }
__host__ __device__ __forceinline__ int perm32(int rho) { const int n = rho >> 4, i = rho & 15; return 8 * (i >> 2) + 4 * n + (i & 3); }

struct Unit { int pm, pn, seg; };
struct Gemm { const bf16_t* A; const bf16_t* Bt; int M, N, K, KT, SEGB; };

struct StaticOrder {
    int nM, nN, nwg, G, c;
    __host__ __device__ void init(int M, int N, int G_, int c_) { nM = M / BM; nN = N / BM; nwg = nM * nN; G = G_; c = c_; }
    __host__ __device__ bool next(int i, Unit& u) const {
        const long L = (long)i * G + c; if (L >= nwg) return false;
        int wgid = (int)L; { const int q = nwg / NXCD, r = nwg % NXCD, xcd = wgid % NXCD, off = wgid / NXCD; wgid = (xcd < r ? xcd * (q + 1) : r * (q + 1) + (xcd - r) * q) + off; }
        const int nig = WGM * nN, gid = wgid / nig, fm = gid * WGM, gsz = (nM - fm) < WGM ? (nM - fm) : WGM;
        u.pm = fm + ((wgid % nig) % gsz); u.pn = (wgid % nig) / gsz; u.seg = 0; return true;
    }
    __device__ __forceinline__ void a_ready(const Unit&) const {}
    __device__ __forceinline__ void done(const Unit&) const {}
};
template <int NSEG> struct SegOrder : StaticOrder {
    __host__ __device__ bool next(int i, Unit& u) const { if (!StaticOrder::next(i / NSEG, u)) return false; u.seg = i % NSEG; return true; }
};
__device__ __forceinline__ unsigned cvt_pk_bf16(float lo, float hi) { unsigned r; asm volatile("v_cvt_pk_bf16_f32 %0, %1, %2" : "=v"(r) : "v"(lo), "v"(hi)); return r; }
typedef float f32x2 __attribute__((ext_vector_type(2)));
template <class Epi, class Sched, bool ALIGN_EPI = false, bool SP2 = false>
__device__ __forceinline__ void gemm_phase(PG8_LAS unsigned char* lds, const Gemm g, const Sched& S, const Epi& E, const int wv) {
    int wvo = wv; asm volatile("" : "+s"(wvo));
    const int lane = lane_opaque(), tid = wvo * 64 + lane, wid = wvo, wr = wid >> 2, wc = wid & 3, fr = lane & 15, fq = lane >> 4;
    const int K = g.K, nt = g.KT;
    unsigned voffA[2], voffB[2];
#pragma unroll
    for (int i = 0; i < 2; ++i) { int R, C; stage_rc(tid * 16 + i * 8192, R, C); const int Rb = Epi::PERM ? ((R & ~31) + perm32(R & 31)) : R;
        voffA[i] = (unsigned)(R * K + C) * 2u; voffB[i] = (unsigned)(Rb * K + C) * 2u; }
    const size_t kstep = (size_t)(BK * 2);
    const size_t hstep = (size_t)HALF * K * 2;
    const size_t tstep = 2 * hstep;
    const unsigned ldsw = (unsigned)wid * 1024u;
    const int aoff = lds_byte(wr * 64 + fr, fq * 8), boff = lds_byte(wc * 32 + fr, fq * 8);
#define PG8_SA(b, h) (((b) * 2 + (h)) * HTB)
#define PG8_SB(b, h) ((4 + (b) * 2 + (h)) * HTB)
#define PG8_STAGE(bufoff, gbase, voff) do { _Pragma("unroll") for (int _i = 0; _i < 2; ++_i) \
        __builtin_amdgcn_global_load_lds((const unsigned*)((const char*)(gbase) + (voff)[_i]), (PG8_LAS unsigned*)(lds + (bufoff) + ldsw + _i * 8192), 16, 0, 0); } while (0)
#define PG8_LDA(dst, b, h) do { _Pragma("unroll") for (int m = 0; m < 4; ++m) _Pragma("unroll") for (int k = 0; k < 2; ++k) dst[m][k] = *(const PG8_LAS bf16x8*)(lds + PG8_SA(b, h) + aoff + m * 2048 + k * 1024); } while (0)
#define PG8_LDB(dst, b, h) do { _Pragma("unroll") for (int n = 0; n < 2; ++n) _Pragma("unroll") for (int k = 0; k < 2; ++k) dst[n][k] = *(const PG8_LAS bf16x8*)(lds + PG8_SB(b, h) + boff + n * 2048 + k * 1024); } while (0)
#define PG8_MMA(ai, bj, At, Bt) do { __builtin_amdgcn_s_setprio(1); _Pragma("unroll") for (int m = 0; m < 4; ++m) _Pragma("unroll") for (int n = 0; n < 2; ++n) _Pragma("unroll") for (int k = 0; k < 2; ++k) \
        acc[ai][bj][m][n] = __builtin_amdgcn_mfma_f32_16x16x32_bf16(Bt[n][k], At[m][k], acc[ai][bj][m][n], 0, 0, 0); __builtin_amdgcn_s_setprio(0); } while (0)
#define PG8_WAIT_V(n) asm volatile("s_waitcnt vmcnt(" #n ")" ::: "memory")
#define PG8_WAIT_L(n) asm volatile("s_waitcnt lgkmcnt(" #n ")" ::: "memory")
#define PG8_BAR __builtin_amdgcn_s_barrier()
#define PG8_SCHED __builtin_amdgcn_sched_barrier(0)
    Unit cur, nxt; int ui = 0;
    if (!S.next(0, cur)) return;
    f32x4 acc[2][2][4][2];
#pragma unroll
    for (int a = 0; a < 2; ++a)
#pragma unroll
        for (int b = 0; b < 2; ++b)
#pragma unroll
            for (int m = 0; m < 4; ++m)
#pragma unroll
                for (int n = 0; n < 2; ++n) acc[a][b][m][n] = (f32x4){0.f, 0.f, 0.f, 0.f};
    bf16x8 At[4][2], B0[2][2], B1[2][2];
    const char* cA = (const char*)g.A + (size_t)cur.pm * tstep + (size_t)cur.seg * g.SEGB; const char* cB = (const char*)g.Bt + (size_t)cur.pn * tstep + (size_t)cur.seg * g.SEGB;
    S.a_ready(cur);
    if constexpr (SP2) {
        PG8_STAGE(PG8_SB(0, 0), cB, voffB); PG8_STAGE(PG8_SB(0, 1), cB + hstep, voffB); PG8_STAGE(PG8_SA(0, 0), cA, voffA); PG8_STAGE(PG8_SA(0, 1), cA + hstep, voffA);
        if (wr == 1) PG8_BAR;
        PG8_WAIT_V(2); PG8_BAR;
        PG8_STAGE(PG8_SB(1, 0), cB + kstep, voffB); PG8_STAGE(PG8_SA(1, 0), cA + kstep, voffA); PG8_STAGE(PG8_SB(1, 1), cB + hstep + kstep, voffB);
        PG8_WAIT_V(6); PG8_BAR;
    } else {
        PG8_STAGE(PG8_SB(0, 0), cB, voffB); PG8_STAGE(PG8_SA(0, 0), cA, voffA); PG8_STAGE(PG8_SB(0, 1), cB + hstep, voffB); PG8_STAGE(PG8_SA(0, 1), cA + hstep, voffA);
        if (wr == 1) PG8_BAR;
        PG8_WAIT_V(4); PG8_BAR;
        PG8_STAGE(PG8_SB(1, 0), cB + kstep, voffB); PG8_STAGE(PG8_SA(1, 0), cA + kstep, voffA); PG8_STAGE(PG8_SB(1, 1), cB + hstep + kstep, voffB);
        PG8_WAIT_V(6); PG8_BAR;
    }
    for (;;) {
        const bool has_next = S.next(ui + 1, nxt);
        const char* nA = has_next ? (const char*)g.A + (size_t)nxt.pm * tstep + (size_t)nxt.seg * g.SEGB : cA; const char* nB = has_next ? (const char*)g.Bt + (size_t)nxt.pn * tstep + (size_t)nxt.seg * g.SEGB : cB;
        for (int t = 0; t < nt; t += 2) {
            const bool last = (t == nt - 2);
            const char* a1 = cA + (size_t)(t + 1) * kstep;
            const char* a2 = last ? nA : cA + (size_t)(t + 2) * kstep; const char* b2 = last ? nB : cB + (size_t)(t + 2) * kstep;
            const char* a3 = a2 + kstep; const char* b3 = b2 + kstep;
            if (last && has_next) S.a_ready(nxt);
            if constexpr (SP2) {
            PG8_LDB(B0, 0, 0); PG8_LDB(B1, 0, 1); PG8_SCHED; PG8_LDA(At, 0, 0); PG8_STAGE(PG8_SA(1, 1), a1 + hstep, voffA);
            PG8_WAIT_V(8); PG8_WAIT_L(0); PG8_BAR; PG8_MMA(0, 0, At, B0); PG8_MMA(0, 1, At, B1); PG8_BAR; PG8_SCHED;
            PG8_LDA(At, 0, 1); PG8_STAGE(PG8_SB(0, 0), b2, voffB); PG8_STAGE(PG8_SB(0, 1), b2 + hstep, voffB); PG8_STAGE(PG8_SA(0, 0), a2, voffA);
            PG8_WAIT_V(8); PG8_WAIT_L(0); PG8_BAR; PG8_MMA(1, 0, At, B0); PG8_MMA(1, 1, At, B1); PG8_BAR; PG8_SCHED;
            PG8_LDB(B0, 1, 0); PG8_LDB(B1, 1, 1); PG8_SCHED; PG8_LDA(At, 1, 0); PG8_STAGE(PG8_SA(0, 1), a2 + hstep, voffA);
            PG8_WAIT_V(8); PG8_WAIT_L(0); PG8_BAR; PG8_MMA(0, 0, At, B0); PG8_MMA(0, 1, At, B1); PG8_BAR; PG8_SCHED;
            PG8_LDA(At, 1, 1); PG8_STAGE(PG8_SB(1, 0), b3, voffB); PG8_STAGE(PG8_SB(1, 1), b3 + hstep, voffB); PG8_STAGE(PG8_SA(1, 0), a3, voffA);
            PG8_WAIT_V(8); PG8_WAIT_L(0); PG8_BAR; PG8_MMA(1, 0, At, B0); PG8_MMA(1, 1, At, B1); PG8_BAR; PG8_SCHED;
            } else {
            PG8_LDB(B0, 0, 0); PG8_SCHED; PG8_LDA(At, 0, 0); PG8_STAGE(PG8_SA(1, 1), a1 + hstep, voffA);
            PG8_WAIT_L(8); PG8_BAR; PG8_WAIT_L(0); PG8_MMA(0, 0, At, B0); PG8_BAR; PG8_SCHED;
            PG8_LDB(B1, 0, 1); PG8_STAGE(PG8_SB(0, 0), b2, voffB);
            PG8_BAR; PG8_WAIT_L(0); PG8_MMA(0, 1, At, B1); PG8_BAR;
            PG8_LDA(At, 0, 1); PG8_STAGE(PG8_SA(0, 0), a2, voffA);
            PG8_BAR; PG8_WAIT_L(0); PG8_MMA(1, 0, At, B0); PG8_BAR; PG8_SCHED;
            PG8_STAGE(PG8_SB(0, 1), b2 + hstep, voffB);
            PG8_WAIT_V(6); PG8_BAR; PG8_MMA(1, 1, At, B1); PG8_BAR;
            PG8_LDB(B0, 1, 0); PG8_SCHED; PG8_LDA(At, 1, 0); PG8_STAGE(PG8_SA(0, 1), a2 + hstep, voffA);
            PG8_WAIT_L(8); PG8_BAR; PG8_WAIT_L(0); PG8_MMA(0, 0, At, B0); PG8_BAR; PG8_SCHED;
            PG8_LDB(B1, 1, 1); PG8_STAGE(PG8_SB(1, 0), b3, voffB);
            PG8_BAR; PG8_WAIT_L(0); PG8_MMA(0, 1, At, B1); PG8_BAR;
            PG8_LDA(At, 1, 1); PG8_STAGE(PG8_SA(1, 0), a3, voffA);
            PG8_BAR; PG8_WAIT_L(0); PG8_MMA(1, 0, At, B0); PG8_BAR; PG8_SCHED;
            PG8_STAGE(PG8_SB(1, 1), b3 + hstep, voffB);
            PG8_WAIT_V(6); PG8_BAR; PG8_MMA(1, 1, At, B1); PG8_BAR;
            }
        }
        if constexpr (ALIGN_EPI) { if (wr == 0) PG8_BAR; }
        if constexpr (!Epi::AFTER_DRAIN) { E(acc, cur, wr, wc, fr, fq); S.done(cur); }
        if (!has_next) break;
        if (!(Epi::KEEP_ACC && nxt.seg != 0)) {
#pragma unroll
        for (int a = 0; a < 2; ++a)
#pragma unroll
            for (int b = 0; b < 2; ++b)
#pragma unroll
                for (int m = 0; m < 4; ++m)
#pragma unroll
                    for (int n = 0; n < 2; ++n) acc[a][b][m][n] = (f32x4){0.f, 0.f, 0.f, 0.f}; }
        cur = nxt; cA = nA; cB = nB; ++ui;
        if constexpr (ALIGN_EPI) { if (wr == 1) PG8_BAR; }
    }
    PG8_WAIT_V(0);
    if constexpr (!ALIGN_EPI) { if (wr == 0) PG8_BAR; }
    PG8_BAR;
    if constexpr (Epi::AFTER_DRAIN) { E.fused(acc, cur, wr, wc, fr, fq, lds, wid, lane); S.done(cur); }
#undef PG8_SA
#undef PG8_SB
#undef PG8_STAGE
#undef PG8_LDA
#undef PG8_LDB
#undef PG8_MMA
#undef PG8_WAIT_V
#undef PG8_WAIT_L
#undef PG8_BAR
#undef PG8_SCHED
}
}

constexpr int DM = 2048, NBATCH = 4, SEQ = 2048, DEPTH = 2, DBATCH = 8, DSEQ = 4, PAST = 16384, PAGE = 128;
constexpr int TP = NBATCH * SEQ;
constexpr int TS = DBATCH * DSEQ;
constexpr int TT = TP + TS;
constexpr int MP = 8448;
constexpr int NPAGES = PAST / PAGE;
constexpr int NPOOL = 1280;
constexpr int POOLW = 512, DNC = 1536, SBW = 512, SSI = 1024, SSC = 1536, DFF = 8192;
constexpr int INCOLS = 14872, NIN = 15104;
constexpr int OBW = 2560;
constexpr int UFW = 5376;
constexpr int UF_POOL = 0, UF_DNQKV = 512, UF_DNZ = 2048, UF_SSZ = 2560, UF_XBC = 3584, UF_SMALL = 5120;
constexpr float RMS_EPS = 1e-6f;
constexpr float LOG2E = 1.4426950408889634f;
constexpr int NWAVES = 8, NTHR = 512;

constexpr size_t O_Y = 0;
constexpr size_t O_KP = O_Y + (size_t)TT * DM;
constexpr size_t O_VP = O_KP + (size_t)DEPTH * TP * 512;
constexpr size_t O_POOLP = O_VP + (size_t)DEPTH * TP * 512;
constexpr size_t O_DNCP = O_POOLP + (size_t)DEPTH * NBATCH * 15 * 512;
constexpr size_t O_DNSP = O_DNCP + (size_t)DEPTH * NBATCH * 3 * 1536;
constexpr size_t O_SSCP = O_DNSP + (size_t)DEPTH * NBATCH * 4 * 128 * 128;
constexpr size_t O_SSHP = O_SSCP + (size_t)DEPTH * NBATCH * 3 * 1536;
constexpr size_t O_KS = O_SSHP + (size_t)DEPTH * NBATCH * 16 * 64 * 128;
constexpr size_t O_VS = O_KS + (size_t)DEPTH * TS * 512;
constexpr size_t O_POOLS = O_VS + (size_t)DEPTH * TS * 512;
constexpr size_t O_DNCS = O_POOLS + (size_t)DEPTH * DBATCH * 15 * 512;
constexpr size_t O_DNSS = O_DNCS + (size_t)DEPTH * DBATCH * 3 * 1536;
constexpr size_t O_SSCS = O_DNSS + (size_t)DEPTH * DBATCH * 4 * 128 * 128;
constexpr size_t O_SSHS = O_SSCS + (size_t)DEPTH * DBATCH * 3 * 1536;
constexpr size_t O_END = O_SSHS + (size_t)DEPTH * DBATCH * 16 * 64 * 128;

constexpr size_t al256(size_t x) { return (x + 255) & ~(size_t)255; }
constexpr size_t WS_CTL = 0, CTL_BYTES = 1u << 20;
constexpr size_t SZ_WIN = (size_t)NIN * DM * 2, SZ_WBR = (size_t)5 * DM * 512 * 2, SZ_WOUT = (size_t)DM * DM * 2, SZ_WUP = (size_t)DFF * DM * 2, SZ_WDN = (size_t)DM * DFF * 2;
constexpr size_t WS_WIN = WS_CTL + CTL_BYTES;
constexpr size_t WS_WBR = WS_WIN + 2 * SZ_WIN;
constexpr size_t WS_WOUT = WS_WBR + 2 * SZ_WBR;
constexpr size_t WS_WUP = WS_WOUT + 2 * SZ_WOUT;
constexpr size_t WS_WDN = WS_WUP + 2 * SZ_WUP;
constexpr size_t WS_H = WS_WDN + 2 * SZ_WDN;
constexpr size_t WS_UF = WS_H + (size_t)MP * DM * 2;
constexpr size_t WS_QKV = WS_UF + (size_t)MP * UFW * 4;
constexpr size_t WS_GATE = WS_QKV + (size_t)MP * 1536 * 2;
constexpr size_t WS_DNQ = WS_GATE + (size_t)MP * 8192 * 2;
constexpr size_t WS_XBC = WS_DNQ + (size_t)MP * 1536 * 4;
constexpr size_t WS_SCAL = WS_XBC + (size_t)MP * 1536 * 4;
constexpr size_t WS_OBR = WS_SCAL + (size_t)MP * 32 * 4;
constexpr size_t SZ_OBR = (size_t)MP * 512 * 2;
constexpr size_t WS_SSQ = WS_OBR + 5 * SZ_OBR;
constexpr size_t WS_MG32 = WS_SSQ + (size_t)MP * 32 * 4;
constexpr size_t WS_MGB = WS_MG32 + (size_t)MP * DM * 4;
constexpr size_t WS_MIX = WS_MGB + (size_t)MP * DM * 2;
constexpr size_t WS_F = WS_MIX + (size_t)MP * DM * 4;
constexpr size_t WS_FD = WS_F + (size_t)MP * DFF * 2;
constexpr size_t WS_PART = WS_FD + (size_t)MP * DM * 4;
constexpr size_t WS_PR = WS_PART + (size_t)256 * 2048 * 4;
constexpr size_t WS_DNU = WS_PR + (size_t)256 * 16 * 4;
constexpr size_t WS_SSU = WS_DNU + (size_t)512 * 90368;
constexpr size_t WS_SSG = WS_SSU + (size_t)2048 * 16896;
constexpr size_t WS_MGS = WS_SSG + (size_t)256 * 49152;
constexpr size_t WS_OUTS = WS_MGS + (size_t)5 * TS * DM * 4;
constexpr size_t WS_UPS = WS_OUTS + (size_t)16 * TS * DM * 4;
constexpr size_t WS_DNS = WS_UPS + (size_t)4 * TS * DFF * 4;
constexpr size_t WS_RS = WS_DNS + (size_t)16 * TS * DM * 4;
constexpr size_t WS_DNSV = WS_RS + (size_t)MP * 2 * 4;
constexpr size_t WS_END = WS_DNSV + (size_t)512 * 49152;
static_assert(WS_WIN % 256 == 0 && WS_H % 256 == 0 && WS_UF % 256 == 0 && WS_OBR % 256 == 0 && WS_MG32 % 256 == 0 && WS_PART % 256 == 0, "ws alignment");

constexpr int CW_QUEUE = 64;
constexpr int CW_BAR = 4096;

constexpr int LDS_BYTES = 147456;
constexpr int RING_BYTES = 131072;
constexpr int MISC_OFF = RING_BYTES;

#define GAS __attribute__((address_space(1)))
#define LAS __attribute__((address_space(3)))
typedef unsigned short bf16;
typedef unsigned v4u __attribute__((ext_vector_type(4)));
typedef unsigned v2u __attribute__((ext_vector_type(2)));
typedef float f32x4 __attribute__((ext_vector_type(4)));
typedef float f32x2 __attribute__((ext_vector_type(2)));
typedef float f32x16 __attribute__((ext_vector_type(16)));
typedef short bf16x8 __attribute__((ext_vector_type(8)));
typedef __bf16 bf16x2_t __attribute__((ext_vector_type(2)));
__device__ __forceinline__ unsigned pk2(float lo, float hi) { const f32x2 v = {lo, hi}; return __builtin_bit_cast(unsigned, __builtin_convertvector(v, bf16x2_t)); }
__device__ __forceinline__ unsigned f2bf(float f) { return pk2(f, f) & 0xffffu; }
__device__ __forceinline__ float bflo(unsigned w) { return __builtin_bit_cast(float, w << 16); }
__device__ __forceinline__ float bfhi(unsigned w) { return __builtin_bit_cast(float, w & 0xffff0000u); }
__device__ __forceinline__ float row16_sum(float x) {
    x += __builtin_bit_cast(float, __builtin_amdgcn_update_dpp(0, __builtin_bit_cast(int, x), 0x128, 0xf, 0xf, false));
    x += __builtin_bit_cast(float, __builtin_amdgcn_update_dpp(0, __builtin_bit_cast(int, x), 0x124, 0xf, 0xf, false));
    x += __builtin_bit_cast(float, __builtin_amdgcn_update_dpp(0, __builtin_bit_cast(int, x), 0x122, 0xf, 0xf, false));
    x += __builtin_bit_cast(float, __builtin_amdgcn_update_dpp(0, __builtin_bit_cast(int, x), 0x121, 0xf, 0xf, false));
    return x;
}
__device__ __forceinline__ float rdlane(float x, int l) { return __builtin_bit_cast(float, __builtin_amdgcn_readlane(__builtin_bit_cast(int, x), l)); }
__device__ __forceinline__ float wave_sum(float v) { const float r = row16_sum(v); return (rdlane(r, 0) + rdlane(r, 16)) + (rdlane(r, 32) + rdlane(r, 48)); }
__device__ __forceinline__ float wave_scan(float x, int lane) {
    x += __builtin_bit_cast(float, __builtin_amdgcn_update_dpp(0, __builtin_bit_cast(int, x), 0x111, 0xf, 0xf, true));
    x += __builtin_bit_cast(float, __builtin_amdgcn_update_dpp(0, __builtin_bit_cast(int, x), 0x112, 0xf, 0xf, true));
    x += __builtin_bit_cast(float, __builtin_amdgcn_update_dpp(0, __builtin_bit_cast(int, x), 0x114, 0xf, 0xf, true));
    x += __builtin_bit_cast(float, __builtin_amdgcn_update_dpp(0, __builtin_bit_cast(int, x), 0x118, 0xf, 0xf, true));
    const float t0 = rdlane(x, 15), t1 = rdlane(x, 31), t2 = rdlane(x, 47);
    return x + (lane >= 48 ? (t0 + t1) + t2 : (lane >= 32 ? t0 + t1 : (lane >= 16 ? t0 : 0.f)));
}
__device__ __forceinline__ float fexp(float x) { return __builtin_amdgcn_exp2f(x * 1.4426950408889634f); }
__device__ __forceinline__ float sigmoidf_(float x) { return 1.0f / (1.0f + __expf(-x)); }
__device__ __forceinline__ float siluf_(float x) { return x / (1.0f + __expf(-x)); }
__device__ __forceinline__ float softplusf_(float x) { const float e = fexp(fminf(x, 20.f)); const float l = e < 0.01f ? e * (1.0f - e * (0.5f - e * 0.33333333f)) : __builtin_amdgcn_logf(1.0f + e) * 0.6931471805599453f; return x > 20.f ? x : l; }
__device__ __forceinline__ float ex2(float x) { return __builtin_amdgcn_exp2f(x); }
__device__ __forceinline__ float lg2(float x) { return __builtin_amdgcn_logf(x); }
#define XB_TMO      128
#define XB_XCNT(j)  (256  + 64 * (j))
#define XB_XSUB(j)  (1280 + 64 * (j))
#define XB_XGEN(j)  (2304 + 64 * (j))
#define XB_TOP      3328
#define XB_TOPGEN   3392
#define XCD_BAR_WORDS 3456
#define XB_SPIN_CAP (1u << 18)

__device__ __forceinline__ unsigned xb_ld(unsigned* p)              { return __hip_atomic_load(p, __ATOMIC_RELAXED, __HIP_MEMORY_SCOPE_AGENT); }
__device__ __forceinline__ unsigned xb_add(unsigned* p, unsigned v) { return __hip_atomic_fetch_add(p, v, __ATOMIC_RELAXED, __HIP_MEMORY_SCOPE_AGENT); }
__device__ __forceinline__ unsigned xb_xcc_id() { return (unsigned)__builtin_amdgcn_s_getreg((3 << 11) | 20) & 0xFu; }
#define XB_SPIN(cond, bar) do { unsigned _sp = 0; while (cond) { __builtin_amdgcn_s_sleep(1); \
    if ((++_sp & 255u) == 0u) { if (xb_ld(&(bar)[XB_TMO])) break; if (_sp > XB_SPIN_CAP) { atomicAdd(&(bar)[XB_TMO], 1u); break; } } } } while (0)

struct XcdBarrier {
    unsigned* bar; unsigned x;
    volatile LAS unsigned* st;
};

__device__ __forceinline__ XcdBarrier xcd_barrier_post(unsigned* bar, volatile LAS unsigned* st, const int tid) {
    XcdBarrier b; b.bar = bar; b.x = xb_xcc_id(); b.st = st;
    if (tid == 0) (void)xb_add(&bar[XB_XCNT(b.x)], 1u);
    return b;
}
__device__ __forceinline__ void xcd_barrier_complete(unsigned* bar, unsigned x, unsigned& nloc, unsigned& nx) {
    const unsigned G = gridDim.x * gridDim.y * gridDim.z;
    unsigned sum, cnt, mine, sp = 0u;
    for (;;) {
        sum = 0u; cnt = 0u; mine = 0u;
#pragma unroll
        for (unsigned j = 0; j < 16; ++j) { const unsigned c = xb_ld(&bar[XB_XCNT(j)]); sum += c; cnt += (c > 0u) ? 1u : 0u; mine = (j == x) ? c : mine; }
        if (sum == G) break;
        __builtin_amdgcn_s_sleep(1);
        if ((++sp & 255u) == 0u) { if (xb_ld(&bar[XB_TMO])) break; if (sp > XB_SPIN_CAP) { atomicAdd(&bar[XB_TMO], 1u); break; } }
    }
    nloc = mine > 0u ? mine : 1u; nx = cnt > 0u ? cnt : 1u;
}

__device__ __forceinline__ void xcd_barrier(const XcdBarrier& b, const int tid) {
    asm volatile("s_waitcnt vmcnt(0)" ::: "memory");
    __syncthreads();
    if (tid == 0) {
        unsigned* bar = b.bar;
        __builtin_amdgcn_s_waitcnt(0);
        unsigned nloc = b.st[0], nx = b.st[1];
        if (nloc == 0u) { xcd_barrier_complete(bar, b.x, nloc, nx); b.st[0] = nloc; b.st[1] = nx; }
        const unsigned old = xb_add(&bar[XB_XSUB(b.x)], 1u);
        const unsigned gen = old / nloc;
        if (old + 1u == (gen + 1u) * nloc) {
            __builtin_amdgcn_fence(__ATOMIC_RELEASE, "agent");
            asm volatile("s_waitcnt vmcnt(0)" ::: "memory");
            const unsigned og = xb_add(&bar[XB_TOP], 1u);
            const unsigned tg = og / nx;
            if (og + 1u == (tg + 1u) * nx) xb_add(&bar[XB_TOPGEN], 1u);
            else XB_SPIN(xb_ld(&bar[XB_TOPGEN]) == tg, bar);
            __builtin_amdgcn_fence(__ATOMIC_ACQUIRE, "agent");
            xb_add(&bar[XB_XGEN(b.x)], 1u);
            asm volatile("s_waitcnt vmcnt(0)" ::: "memory");
        } else {
            XB_SPIN(xb_ld(&bar[XB_XGEN(b.x)]) == gen, bar);
            __builtin_amdgcn_fence(__ATOMIC_ACQUIRE, "agent");
            asm volatile("s_waitcnt vmcnt(0)" ::: "memory");
        }
    }
    __syncthreads();
}

enum { I_XP = 0, I_XS, I_CK, I_CV, I_SPOOL, I_SDNC, I_SDNS, I_SSSC, I_SSSH, I_PT, I_NMPRE, I_NMPOST, I_NLPRE, I_NLPOST, I_WIN, I_POOLW, I_POOLSC, I_DNCW, I_DNALOG, I_DNDTB, I_DNNW, I_SBBIAS,
       I_SSCW, I_SSCB, I_SSALOG, I_SSDTB, I_SSD, I_SSNW, I_WBR, I_WOUT, I_WUP, I_WDN, N_IN };
struct Args { const void* in[N_IN]; float* out; unsigned char* ws; int ph_lo, ph_hi, li, pad; };
#define IN_F(i) ((const float*)A->in[i])
#define WSP(T, off) ((T*)(A->ws + (off)))
typedef const __attribute__((opencl_constant)) Args* CA;
__device__ __forceinline__ CA args_opaque() { auto p = __builtin_amdgcn_kernarg_segment_ptr(); asm volatile("" : "+s"(p)); return (CA)p; }

struct EpiIn {
    static constexpr bool PERM = true, AFTER_DRAIN = false, KEEP_ACC = false;
    float* UF; bf16* QKV; bf16* GATE; float *kp, *vp, *ks, *vs; float qscale;
    __device__ __forceinline__ void operator()(f32x4 (&acc)[2][2][4][2], const pg8::Unit& u, int wr, int wc, int fr, int fq) const {
        const int pn = u.pn, row0 = u.pm * 256 + wr * 64 + fr, cl = wc * 32 + 8 * fq;
        if (pn < 10 || (pn >= 16 && pn < 26) || pn == 58) {
            const int col0 = pn * 256 + (pn < 10 ? 0 : (pn < 26 ? -1536 : -9728)) + cl;
#pragma unroll
            for (int ai = 0; ai < 2; ++ai)
#pragma unroll
                for (int m = 0; m < 4; ++m) { float* rowp = UF + (size_t)(row0 + ai * 128 + m * 16) * UFW + col0;
#pragma unroll
                    for (int bj = 0; bj < 2; ++bj) { *(f32x4*)(rowp + bj * 128) = acc[ai][bj][m][0]; *(f32x4*)(rowp + bj * 128 + 4) = acc[ai][bj][m][1]; } }
        } else if (pn < 16) {
            const int which = (pn - 10) >> 1, c512 = ((pn - 10) & 1) * 256 + cl; const float sc = which == 0 ? qscale : 1.f;
#pragma unroll
            for (int ai = 0; ai < 2; ++ai)
#pragma unroll
                for (int m = 0; m < 4; ++m) { const int r = row0 + ai * 128 + m * 16; bf16* rowp = QKV + (size_t)r * 1536 + which * 512 + c512;
                    float* fo = nullptr;
                    if (which) { if (r < TP) fo = (which == 1 ? kp : vp) + (size_t)r * 512 + c512; else if (r < TT) fo = (which == 1 ? ks : vs) + (size_t)(r - TP) * 512 + c512; }
#pragma unroll
                    for (int bj = 0; bj < 2; ++bj) { const f32x4 v0 = acc[ai][bj][m][0], v1 = acc[ai][bj][m][1];
                        v4u w; w.x = pk2(v0[0] * sc, v0[1] * sc); w.y = pk2(v0[2] * sc, v0[3] * sc); w.z = pk2(v1[0] * sc, v1[1] * sc); w.w = pk2(v1[2] * sc, v1[3] * sc);
                        *(v4u*)(rowp + bj * 128) = w;
                        if (fo) { *(f32x4*)(fo + bj * 128) = v0; *(f32x4*)(fo + bj * 128 + 4) = v1; } } }
        } else {
            const int oc = (pn - 26) * 64 + wc * 16 + 4 * fq;
#pragma unroll
            for (int ai = 0; ai < 2; ++ai)
#pragma unroll
                for (int m = 0; m < 4; ++m) { const int r = row0 + ai * 128 + m * 16; bf16* rowp = GATE + (size_t)r * 8192 + oc;
                    f32x4 t[4];
#pragma unroll
                    for (int i = 0; i < 4; ++i)
#pragma unroll
                        for (int e = 0; e < 4; ++e) t[i][e] = 1.0f + fexp(-fminf(fmaxf(acc[ai][i >> 1][m][i & 1][e], -30.f), 30.f));
                    f32x4 o[4];
                    if (r < TP) {
#pragma unroll
                        for (int e = 0; e < 4; ++e) { const float i0 = __builtin_amdgcn_rcpf(t[0][e]), i1 = __builtin_amdgcn_rcpf(t[1][e]), i2 = __builtin_amdgcn_rcpf(t[2][e]), i3 = __builtin_amdgcn_rcpf(t[3][e]);
                            o[0][e] = t[1][e] * i0; o[1][e] = t[2][e] * i1; o[2][e] = t[3][e] * i2; o[3][e] = i3; }
                    } else {
#pragma unroll
                        for (int i = 0; i < 4; ++i)
#pragma unroll
                            for (int e = 0; e < 4; ++e) o[i][e] = __builtin_amdgcn_rcpf(t[i][e]);
                    }
#pragma unroll
                    for (int i = 0; i < 4; ++i) { v2u w; w.x = pk2(o[i][0], o[i][1]); w.y = pk2(o[i][2], o[i][3]); *(v2u*)(rowp + i * 2048) = w; } }
        }
    }
};
struct EpiMergeR {
    static constexpr bool PERM = true, AFTER_DRAIN = false, KEEP_ACC = true;
    const bf16* GATE; const float* RS; bf16* MGB;
    __device__ __forceinline__ void operator()(f32x4 (&acc)[2][2][4][2], const pg8::Unit& u, int wr, int wc, int fr, int fq) const {
        const unsigned row0 = (unsigned)(u.pm * 256 + wr * 64 + fr), col0 = (unsigned)(u.pn * 256 + wc * 32 + 8 * fq); const int seg = u.seg;
        const unsigned gofs = row0 * 8192u + (seg < 3 ? seg : 3) * 2048u + col0, oofs = row0 * 2048u + col0; const bool last = seg == 4;
        const float w2 = seg == 2 ? 1.f : 0.f, w3 = seg == 3 ? 1.f : 0.f, w4 = last ? 1.f : 0.f, w0 = 1.f - w2 - w3 - w4, ug = 1.f - w3;
#pragma unroll
        for (int ai = 0; ai < 2; ++ai)
#pragma unroll
            for (int m = 0; m < 4; ++m) { const unsigned rr = ai * 128 + m * 16; const f32x2 qq = *(const f32x2*)(RS + (row0 + rr) * 2u);
                const float r1 = __builtin_amdgcn_rsqf(qq[1]), rf = w0 + w2 * __builtin_amdgcn_sqrtf(qq[0]) + w3 * (__builtin_amdgcn_sqrtf(qq[1]) * __builtin_amdgcn_rsqf(qq[0])) + w4 * r1, rg = rf * ug, rc = rf * w3;
#pragma unroll
                for (int bj = 0; bj < 2; ++bj) { const v4u gg = *(const v4u*)(GATE + (gofs + rr * 8192u + bj * 128u));
                    f32x4& v0 = acc[ai][bj][m][0]; f32x4& v1 = acc[ai][bj][m][1];
                    v0[0] *= bflo(gg.x) * rg + rc; v0[1] *= bfhi(gg.x) * rg + rc; v0[2] *= bflo(gg.y) * rg + rc; v0[3] *= bfhi(gg.y) * rg + rc;
                    v1[0] *= bflo(gg.z) * rg + rc; v1[1] *= bfhi(gg.z) * rg + rc; v1[2] *= bflo(gg.w) * rg + rc; v1[3] *= bfhi(gg.w) * rg + rc;
                    if (last) { v4u w; w.x = pk2(v0[0], v0[1]); w.y = pk2(v0[2], v0[3]); w.z = pk2(v1[0], v1[1]); w.w = pk2(v1[2], v1[3]); *(v4u*)(MGB + (oofs + rr * 2048u + bj * 128u)) = w; } }
                asm volatile("" ::: "memory"); }
    }
};
struct EpiF32 {
    static constexpr bool PERM = true, AFTER_DRAIN = false, KEEP_ACC = false;
    float* C; int ldc;
    __device__ __forceinline__ void operator()(f32x4 (&acc)[2][2][4][2], const pg8::Unit& u, int wr, int wc, int fr, int fq) const {
        const int row0 = u.pm * 256 + wr * 64 + fr, col0 = u.pn * 256 + wc * 32 + 8 * fq;
#pragma unroll
        for (int ai = 0; ai < 2; ++ai)
#pragma unroll
            for (int m = 0; m < 4; ++m) { float* rowp = C + (size_t)(row0 + ai * 128 + m * 16) * ldc + col0;
#pragma unroll
                for (int bj = 0; bj < 2; ++bj) { *(f32x4*)(rowp + bj * 128) = acc[ai][bj][m][0]; *(f32x4*)(rowp + bj * 128 + 4) = acc[ai][bj][m][1]; } }
    }
};
struct EpiRelu2 {
    static constexpr bool PERM = true, AFTER_DRAIN = false, KEEP_ACC = false;
    bf16* O; int ldc;
    __device__ __forceinline__ void operator()(f32x4 (&acc)[2][2][4][2], const pg8::Unit& u, int wr, int wc, int fr, int fq) const {
        const int row0 = u.pm * 256 + wr * 64 + fr, col0 = u.pn * 256 + wc * 32 + 8 * fq;
#pragma unroll
        for (int ai = 0; ai < 2; ++ai)
#pragma unroll
            for (int m = 0; m < 4; ++m) { bf16* rowp = O + (size_t)(row0 + ai * 128 + m * 16) * ldc + col0;
#pragma unroll
                for (int bj = 0; bj < 2; ++bj) { f32x4 v0 = acc[ai][bj][m][0], v1 = acc[ai][bj][m][1];
#pragma unroll
                    for (int e = 0; e < 4; ++e) { const float a = fmaxf(v0[e], 0.f), b = fmaxf(v1[e], 0.f); v0[e] = a * a; v1[e] = b * b; }
                    v4u w; w.x = pk2(v0[0], v0[1]); w.y = pk2(v0[2], v0[3]); w.z = pk2(v1[0], v1[1]); w.w = pk2(v1[2], v1[3]); *(v4u*)(rowp + bj * 128) = w; } }
    }
};

__device__ __forceinline__ int win_src_col(int n) {
    if (n < 2560) return n;
    if (n < 6656) return n + 8;
    if (n < 14848) { const int t = n - 6656, pg = t >> 8, c = t & 255;
        return 6680 + (2 * (c >> 7) + ((c >> 2) & 1)) * 2048 + 64 * pg + 16 * ((c >> 5) & 3) + 4 * ((c >> 3) & 3) + (c & 3); }
    if (n < 14856) return n - 14848 + 2560;
    if (n < 14872) return n - 14856 + 6664;
    return -1;
}
template <int MODE>
__device__ __forceinline__ void transpose_item(const float* W, int ldw, int K, bf16* WT, int n0, int k0, const float* kscale, LAS unsigned* scr, int lane) {
    const int kq = lane >> 4, n4 = (lane & 15) * 4; const int sc = MODE ? win_src_col(n0 + n4) : n0 + n4;
#pragma unroll
    for (int i = 0; i < 8; ++i) { const int k = k0 + 8 * i + 2 * kq; f32x4 a = {0.f, 0.f, 0.f, 0.f}, b = {0.f, 0.f, 0.f, 0.f};
        if (sc >= 0) { a = *(const f32x4*)(W + (size_t)k * ldw + sc); b = *(const f32x4*)(W + (size_t)(k + 1) * ldw + sc); }
        if (kscale) { a = a * kscale[k]; b = b * kscale[k + 1]; }
        v4u w; w.x = pk2(a[0], b[0]); w.y = pk2(a[1], b[1]); w.z = pk2(a[2], b[2]); w.w = pk2(a[3], b[3]);
        *(LAS v4u*)(scr + (4 * i + kq) * 68 + n4) = w; }
    asm volatile("s_waitcnt lgkmcnt(0)" ::: "memory");
    const int part = lane & 7;
#pragma unroll
    for (int j = 0; j < 8; ++j) { const int nn = 8 * j + (lane >> 3); const LAS unsigned* s = scr + (4 * part) * 68 + nn;
        v4u o; o.x = s[0]; o.y = s[68]; o.z = s[136]; o.w = s[204];
        *(v4u*)(WT + (size_t)(n0 + nn) * K + k0 + 8 * part) = o; }
    asm volatile("s_waitcnt lgkmcnt(0)" ::: "memory");
}
__device__ __forceinline__ void p0_prologue(CA A, LAS unsigned char* lds, const int wv) {
    const int tid = tid_opaque(wv), lane = tid & 63, wave = tid >> 6, G = gridDim.x;
    LAS unsigned* scr = (LAS unsigned*)(lds + wave * 8704);
    const int gw = blk_opaque() * NWAVES + wave, NGW = G * NWAVES;
    constexpr int I_IN = (NIN / 64) * (DM / 64), I_BR = (DM / 64) * (512 / 64), I_OUT = (DM / 64) * (DM / 64), I_UP = (DFF / 64) * (DM / 64), I_DN = (DM / 64) * (DFF / 64);
    constexpr int PER_LAYER = I_IN + 4 * I_BR + I_OUT + I_UP + I_DN;
    for (int it = gw; it < 2 * PER_LAYER; it += NGW) {
        const int L = it / PER_LAYER; int r = it % PER_LAYER;
        if (r < I_IN) { const int nb = r % (NIN / 64), kb = r / (NIN / 64);
            transpose_item<1>(IN_F(I_WIN) + (size_t)L * DM * INCOLS, INCOLS, DM, WSP(bf16, WS_WIN) + (size_t)L * NIN * DM, nb * 64, kb * 64, nullptr, scr, lane); continue; }
        r -= I_IN;
        if (r < 4 * I_BR) { const int s = 1 + r / I_BR, q = r % I_BR, nb = q % (DM / 64), kb = q / (DM / 64);
            transpose_item<0>(IN_F(I_WBR) + ((size_t)L * 2560 + 512 * s) * DM, DM, OBW, WSP(bf16, WS_WBR) + (size_t)L * DM * OBW + 512 * s, nb * 64, kb * 64,
                              s >= 3 ? IN_F(I_SSNW) + L * 1024 + (s - 3) * 512 : nullptr, scr, lane); continue; }
        r -= 4 * I_BR;
        if (r < I_OUT) { const int nb = r % (DM / 64), kb = r / (DM / 64);
            transpose_item<0>(IN_F(I_WOUT) + (size_t)L * DM * DM, DM, DM, WSP(bf16, WS_WOUT) + (size_t)L * DM * DM, nb * 64, kb * 64, nullptr, scr, lane); continue; }
        r -= I_OUT;
        if (r < I_UP) { const int nb = r % (DFF / 64), kb = r / (DFF / 64);
            transpose_item<0>(IN_F(I_WUP) + (size_t)L * DM * DFF, DFF, DM, WSP(bf16, WS_WUP) + (size_t)L * DFF * DM, nb * 64, kb * 64, nullptr, scr, lane); continue; }
        r -= I_UP;
        { const int nb = r % (DM / 64), kb = r / (DM / 64);
            transpose_item<0>(IN_F(I_WDN) + (size_t)L * DFF * DM, DM, DFF, WSP(bf16, WS_WDN) + (size_t)L * DM * DFF, nb * 64, kb * 64, nullptr, scr, lane); }
    }
    for (int idx = blk_opaque() * NTHR + tid; idx < 2 * DM * 64; idx += G * NTHR) {
        const int L = idx / (DM * 64), q = idx % (DM * 64), n = q & (DM - 1), kc = q >> 11, k0 = kc * 8, g = k0 >> 7, c0 = k0 & 127;
        const float* pw = IN_F(I_POOLW) + ((size_t)(L * 4 + g) * 128 + c0) * 128; const float* psc = IN_F(I_POOLSC) + L * 512 + g * 128;
        const float* wb = IN_F(I_WBR) + ((size_t)L * 2560 + g * 128) * DM + n;
        float acc[8] = {0.f, 0.f, 0.f, 0.f, 0.f, 0.f, 0.f, 0.f};
        for (int d = 0; d < 128; ++d) { const float wv = wb[(size_t)d * DM] * psc[d];
#pragma unroll
            for (int i = 0; i < 8; ++i) acc[i] += pw[i * 128 + d] * wv; }
        v4u o; o.x = pk2(acc[0], acc[1]); o.y = pk2(acc[2], acc[3]); o.z = pk2(acc[4], acc[5]); o.w = pk2(acc[6], acc[7]);
        *(v4u*)(WSP(bf16, WS_WBR) + (size_t)L * DM * OBW + (size_t)n * OBW + k0) = o;
    }
}

__device__ __forceinline__ const float* xin_row(CA A, int m) { return m < TP ? IN_F(I_XP) + (size_t)m * DM : IN_F(I_XS) + (size_t)(m - TP) * DM; }
__device__ __forceinline__ void store_bf16_row(bf16* orow, const f32x4 (&v)[8], float rstd, const float* g, int lane) {
#pragma unroll
    for (int j = 0; j < 8; ++j) { const f32x4 gj = ((const f32x4*)g)[lane + 64 * j]; const f32x4 o = v[j] * rstd * gj;
        v2u w; w.x = pk2(o[0], o[1]); w.y = pk2(o[2], o[3]); ((v2u*)orow)[lane + 64 * j] = w; }
}
__device__ __forceinline__ void norm1_phase(CA A, const int wv) {
    const int tid = tid_opaque(wv), lane = tid & 63, gw = blk_opaque() * NWAVES + (tid >> 6), NGW = gridDim.x * NWAVES;
    bf16* H = WSP(bf16, WS_H);
    for (int m = gw; m < MP; m += NGW) {
        if (m >= TT) { for (int j = 0; j < 8; ++j) ((v2u*)(H + (size_t)m * DM))[lane + 64 * j] = (v2u){0u, 0u}; continue; }
        const f32x4* xr = (const f32x4*)xin_row(A, m); f32x4 v[8]; float s = 0.f;
#pragma unroll
        for (int j = 0; j < 8; ++j) { v[j] = xr[lane + 64 * j]; s += (v[j][0] * v[j][0] + v[j][1] * v[j][1]) + (v[j][2] * v[j][2] + v[j][3] * v[j][3]); }
        const float rstd = 1.0f / sqrtf(wave_sum(s) * (1.0f / DM) + RMS_EPS);
        store_bf16_row(H + (size_t)m * DM, v, rstd, IN_F(I_NMPRE), lane);
    }
}
__device__ __forceinline__ void resid_load(CA A, const float* Y, const float* PS, bool from_input, int m, int lane, f32x4 (&v)[8], f32x4 (&x)[8]) {
    const f32x4* xr = from_input ? (const f32x4*)xin_row(A, m) : (const f32x4*)(A->out + O_Y + (size_t)m * DM);
#pragma unroll
    for (int j = 0; j < 8; ++j) x[j] = xr[lane + 64 * j];
    if (m < TP) { const f32x4* yr = (const f32x4*)(Y + (size_t)m * DM);
#pragma unroll
        for (int j = 0; j < 8; ++j) v[j] = yr[lane + 64 * j];
    } else {
#pragma unroll
        for (int j = 0; j < 8; ++j) v[j] = (f32x4){0.f, 0.f, 0.f, 0.f};
        for (int sp = 0; sp < 16; ++sp) { const f32x4* pr = (const f32x4*)(PS + ((size_t)sp * TS + (m - TP)) * DM);
#pragma unroll
            for (int j = 0; j < 8; ++j) v[j] += pr[lane + 64 * j]; }
    }
}
__device__ __forceinline__ void resid_phase(CA A, const float* Y, const float* PS, const float* gpost, const float* gnext, bool from_input, const int wv) {
    const int tid = tid_opaque(wv), lane = tid & 63, gw = blk_opaque() * NWAVES + (tid >> 6), NGW = gridDim.x * NWAVES;
    bf16* H = WSP(bf16, WS_H);
    f32x4 v[8], x[8], vn[8], xn[8];
    int m = gw; if (m < TP) resid_load(A, Y, PS, from_input, m, lane, v, x);
    while (m < TT) {
        int mnext = m + NGW; if (m < TP && mnext >= TP) mnext = (gw < TS) ? TP + gw : TT;
        else if (m >= TP) mnext = TT;
        if (mnext < TT) resid_load(A, Y, PS, from_input, mnext, lane, vn, xn);
        float s = 0.f;
#pragma unroll
        for (int j = 0; j < 8; ++j) s += (v[j][0] * v[j][0] + v[j][1] * v[j][1]) + (v[j][2] * v[j][2] + v[j][3] * v[j][3]);
        const float rstd = __builtin_amdgcn_rsqf(wave_sum(s) * (1.0f / DM) + RMS_EPS); float s2 = 0.f;
        f32x4* orow = (f32x4*)(A->out + O_Y + (size_t)m * DM);
#pragma unroll
        for (int j = 0; j < 8; ++j) { const f32x4 gj = ((const f32x4*)gpost)[lane + 64 * j]; v[j] = x[j] + v[j] * rstd * gj; orow[lane + 64 * j] = v[j];
            s2 += (v[j][0] * v[j][0] + v[j][1] * v[j][1]) + (v[j][2] * v[j][2] + v[j][3] * v[j][3]); }
        if (gnext) { const float rstd2 = __builtin_amdgcn_rsqf(wave_sum(s2) * (1.0f / DM) + RMS_EPS); store_bf16_row(H + (size_t)m * DM, v, rstd2, gnext, lane); }
#pragma unroll
        for (int j = 0; j < 8; ++j) { v[j] = vn[j]; x[j] = xn[j]; }
        m = mnext;
    }
}

__device__ __forceinline__ float conv_tap(const float* UF, const float* state, int row, int j, int ucol, int c) {
    if (row < TP) { const int t = row & (SEQ - 1); return (t - 3 + j) >= 0 ? UF[(size_t)(row - 3 + j) * UFW + ucol + c] : 0.f; }
    const int s = row - TP, sb = s >> 2, e = (s & 3) + j;
    return e < 3 ? state[(size_t)(sb * 3 + e) * 1536 + c] : UF[(size_t)(TP + sb * 4 + e - 3) * UFW + ucol + c];
}
__device__ __forceinline__ void prep_phase(CA A, int layer, const int wv) {
    const int tid = tid_opaque(wv), lane = tid & 63, G = gridDim.x, gt = blk_opaque() * NTHR + tid, NGT = G * NTHR, gw = blk_opaque() * NWAVES + (tid >> 6), NGW = G * NWAVES;
    const float* UF = WSP(float, WS_UF); float* SC = WSP(float, WS_SCAL);
    for (int idx = gt; idx < TT * 24; idx += NGT) { const int row = idx / 24, j = idx % 24; const float u = UF[(size_t)row * UFW + UF_SMALL + j]; float r;
        if (j < 4) r = sigmoidf_(u);
        else if (j < 8) r = -fexp(IN_F(I_DNALOG)[layer * 4 + j - 4]) * softplusf_(u + IN_F(I_DNDTB)[layer * 4 + j - 4]);
        else r = softplusf_(u + IN_F(I_SSDTB)[layer * 16 + j - 8]);
        SC[(size_t)row * 32 + j] = r; }
    { bf16* O0 = WSP(bf16, WS_OBR); const float* spool = IN_F(I_SPOOL) + (size_t)layer * DBATCH * 15 * 512;
      for (int it = gw; it < (TP / 64 + DBATCH) * 4; it += NGW) { const int gi = it & 3, sc = it >> 2, w = 2 << gi, ch = gi * 128 + lane;
          if (sc < TP / 64) { const int row0 = sc * 64, t0 = row0 & (SEQ - 1); float s0 = 0.f, s1 = 0.f;
              for (int j = 1; j < w; ++j) if (t0 - j >= 0) { s0 += UF[(size_t)(row0 - j) * UFW + ch]; s1 += UF[(size_t)(row0 - j) * UFW + ch + 64]; }
#pragma unroll 8
              for (int i = 0; i < 64; ++i) { const int row = row0 + i, t = t0 + i; const float u0 = UF[(size_t)row * UFW + ch], u1 = UF[(size_t)row * UFW + ch + 64];
                  s0 += u0; s1 += u1; const float inv = 1.0f / (float)((t + 1) < w ? (t + 1) : w);
                  O0[(size_t)row * OBW + ch] = (bf16)f2bf(s0 * inv - u0); O0[(size_t)row * OBW + ch + 64] = (bf16)f2bf(s1 * inv - u1);
                  if (t - w + 1 >= 0) { s0 -= UF[(size_t)(row - w + 1) * UFW + ch]; s1 -= UF[(size_t)(row - w + 1) * UFW + ch + 64]; } } }
          else { const int sb = sc - TP / 64; const float inv = 1.0f / (float)w;
              for (int i = 0; i < DSEQ; ++i) { const int row = TP + sb * 4 + i, e = 15 + i; float s0 = 0.f, s1 = 0.f;
                  for (int j = 0; j < w; ++j) { const int ee = e - j; const float* src = ee < 15 ? spool + (size_t)(sb * 15 + ee) * 512 + ch : UF + (size_t)(TP + sb * 4 + ee - 15) * UFW + ch; s0 += src[0]; s1 += src[64]; }
                  O0[(size_t)row * OBW + ch] = (bf16)f2bf(s0 * inv - UF[(size_t)row * UFW + ch]); O0[(size_t)row * OBW + ch + 64] = (bf16)f2bf(s1 * inv - UF[(size_t)row * UFW + ch + 64]); } } } }
    for (int it0 = gw; it0 < DBATCH * 24; it0 += NGW) { const int it = it0 + (TP / 64) * 24; const int grp = it % 12, strm = (it / 12) & 1, sc = it / 24, c0 = grp * 128 + lane;
        const int ucol = strm ? UF_XBC : UF_DNQKV; float* OUTB = strm ? WSP(float, WS_XBC) : WSP(float, WS_DNQ);
        const float* cw = (strm ? IN_F(I_SSCW) : IN_F(I_DNCW)) + (size_t)layer * 4 * 1536; const float* st = (strm ? IN_F(I_SSSC) : IN_F(I_SDNC)) + (size_t)layer * DBATCH * 3 * 1536;
        const float wa0 = cw[c0], wa1 = cw[1536 + c0], wa2 = cw[3072 + c0], wa3 = cw[4608 + c0], wb0 = cw[c0 + 64], wb1 = cw[1536 + c0 + 64], wb2 = cw[3072 + c0 + 64], wb3 = cw[4608 + c0 + 64];
        const float ba = strm ? IN_F(I_SSCB)[layer * 1536 + c0] : 0.f, bb = strm ? IN_F(I_SSCB)[layer * 1536 + c0 + 64] : 0.f;
        const bool nrm = (strm == 0) && grp < 8; const float qs = grp < 4 ? 0.08838834764831845f : 1.0f;
        float ha0, ha1, ha2, hb0, hb1, hb2; int row0, n;
        if (sc < TP / 64) { row0 = sc * 64; n = 64; const int t0 = row0 & (SEQ - 1);
            if (t0 == 0) { ha0 = ha1 = ha2 = hb0 = hb1 = hb2 = 0.f; }
            else { const float* p = UF + (size_t)(row0 - 3) * UFW + ucol + c0; ha0 = p[0]; hb0 = p[64]; ha1 = p[UFW]; hb1 = p[UFW + 64]; ha2 = p[2 * UFW]; hb2 = p[2 * UFW + 64]; } }
        else { const int sb = sc - TP / 64; row0 = TP + sb * 4; n = DSEQ; const float* p = st + (size_t)(sb * 3) * 1536 + c0; ha0 = p[0]; hb0 = p[64]; ha1 = p[1536]; hb1 = p[1536 + 64]; ha2 = p[3072]; hb2 = p[3072 + 64]; }
#pragma unroll 8
        for (int i = 0; i < n; ++i) { const float* p = UF + (size_t)(row0 + i) * UFW + ucol + c0; const float ua = p[0], ub = p[64];
            float a = siluf_(ba + wa0 * ha0 + wa1 * ha1 + wa2 * ha2 + wa3 * ua), b = siluf_(bb + wb0 * hb0 + wb1 * hb1 + wb2 * hb2 + wb3 * ub);
            ha0 = ha1; ha1 = ha2; ha2 = ua; hb0 = hb1; hb1 = hb2; hb2 = ub;
            if (nrm) { const float rs = row16_sum(a * a + b * b);
                const float tot = (__builtin_bit_cast(float, __builtin_amdgcn_readlane(__builtin_bit_cast(int, rs), 0)) + __builtin_bit_cast(float, __builtin_amdgcn_readlane(__builtin_bit_cast(int, rs), 16)))
                                + (__builtin_bit_cast(float, __builtin_amdgcn_readlane(__builtin_bit_cast(int, rs), 32)) + __builtin_bit_cast(float, __builtin_amdgcn_readlane(__builtin_bit_cast(int, rs), 48)));
                const float sc2 = qs / sqrtf(tot + 1e-6f); a *= sc2; b *= sc2; }
            float* o = OUTB + (size_t)(row0 + i) * 1536 + c0; o[0] = a; o[64] = b; } }
    for (int idx = gt; idx < NBATCH * 3 * 1536; idx += NGT) { const int b = idx / (3 * 1536), q = idx % (3 * 1536), j = q / 1536, c = q % 1536; const size_t src = (size_t)(b * SEQ + SEQ - 3 + j) * UFW;
        A->out[O_DNCP + (size_t)layer * NBATCH * 3 * 1536 + idx] = UF[src + UF_DNQKV + c]; A->out[O_SSCP + (size_t)layer * NBATCH * 3 * 1536 + idx] = UF[src + UF_XBC + c]; }
    for (int idx = gt; idx < DBATCH * 3 * 1536; idx += NGT) { const int sb = idx / (3 * 1536), q = idx % (3 * 1536), j = q / 1536, c = q % 1536; const size_t src = (size_t)(TP + sb * 4 + 1 + j) * UFW;
        A->out[O_DNCS + (size_t)layer * DBATCH * 3 * 1536 + idx] = UF[src + UF_DNQKV + c]; A->out[O_SSCS + (size_t)layer * DBATCH * 3 * 1536 + idx] = UF[src + UF_XBC + c]; }
    for (int idx = gt; idx < NBATCH * 15 * 512; idx += NGT) { const int b = idx / (15 * 512), q = idx % (15 * 512), j = q >> 9, ch = q & 511;
        A->out[O_POOLP + (size_t)layer * NBATCH * 15 * 512 + idx] = UF[(size_t)(b * SEQ + SEQ - 15 + j) * UFW + ch]; }
    { const float* spool = IN_F(I_SPOOL) + (size_t)layer * DBATCH * 15 * 512;
      for (int idx = gt; idx < DBATCH * 15 * 512; idx += NGT) { const int sb = idx / (15 * 512), q = idx % (15 * 512), j = q >> 9, ch = q & 511, e = 4 + j;
          A->out[O_POOLS + (size_t)layer * DBATCH * 15 * 512 + idx] = e < 15 ? spool[(size_t)(sb * 15 + e) * 512 + ch] : UF[(size_t)(TP + sb * 4 + e - 15) * UFW + ch]; } }
}

__device__ __forceinline__ void dn_seq(CA A, LAS unsigned char* lds, int layer, int unit, const int wv) {
    const int tid = tid_opaque(wv), lane = tid & 63, wid = tid >> 6, v = tid & 127, kq = tid >> 7;
    int row0, L, h; const float* s0 = nullptr; float* sout;
    if (unit < 16) { const int b = unit >> 2; h = unit & 3; row0 = b * SEQ; L = SEQ; sout = A->out + O_DNSP + ((size_t)(layer * NBATCH + b) * 4 + h) * 16384; }
    else { const int u = unit - 16, sb = u >> 2; h = u & 3; row0 = TP + sb * 4; L = DSEQ; s0 = IN_F(I_SDNS) + ((size_t)(layer * DBATCH + sb) * 4 + h) * 16384; sout = A->out + O_DNSS + ((size_t)(layer * DBATCH + sb) * 4 + h) * 16384; }
    constexpr int CH = 32;
    LAS float* qs = (LAS float*)lds; LAS float* ks = qs + CH * 128; LAS float* vs = ks + CH * 128; LAS float* ob = vs + CH * 128;
    LAS float* red = ob + CH * 128;
    LAS float* egs = red + 2 * 2 * 4 * 128; LAS float* bts = egs + CH; LAS float* kqd = bts + CH;
    const float* DNQ = WSP(float, WS_DNQ); const float* SC = WSP(float, WS_SCAL); const float* UF = WSP(float, WS_UF); bf16* O1 = WSP(bf16, WS_OBR) + 512;
    const float* nw = IN_F(I_DNNW) + layer * 128;
    float S[32];
#pragma unroll
    for (int i = 0; i < 32; ++i) S[i] = s0 ? s0[(size_t)(32 * kq + i) * 128 + v] : 0.f;
    for (int c0 = 0; c0 < L; c0 += CH) {
        const int n = (L - c0) < CH ? (L - c0) : CH;
        __syncthreads();
        for (int idx = tid; idx < n * 128; idx += NTHR) { const int t = idx >> 7, c = idx & 127; const float* src = DNQ + (size_t)(row0 + c0 + t) * 1536 + h * 128 + c;
            qs[idx] = src[0]; ks[idx] = src[512]; vs[idx] = src[1024]; }
        if (tid < n) { const float* sc = SC + (size_t)(row0 + c0 + tid) * 32; bts[tid] = sc[h]; egs[tid] = fexp(sc[4 + h]); }
        __syncthreads();
        for (int t = wid; t < n; t += NWAVES) { const float s = wave_sum(ks[t * 128 + lane] * qs[t * 128 + lane] + ks[t * 128 + 64 + lane] * qs[t * 128 + 64 + lane]); if (lane == 0) kqd[t] = s; }
        __syncthreads();
        for (int t = 0; t < n; ++t) {
            const float eg = egs[t], bt = bts[t]; float kk[32]; float r = 0.f, pp = 0.f;
#pragma unroll
            for (int i4 = 0; i4 < 8; ++i4) { const f32x4 k4 = *(const LAS f32x4*)(ks + t * 128 + 32 * kq + 4 * i4), q4 = *(const LAS f32x4*)(qs + t * 128 + 32 * kq + 4 * i4);
#pragma unroll
                for (int e = 0; e < 4; ++e) { const int i = 4 * i4 + e; S[i] *= eg; kk[i] = k4[e]; r += S[i] * k4[e]; pp += S[i] * q4[e]; } }
            LAS float* rd = red + (t & 1) * 1024;
            rd[kq * 128 + v] = r; rd[512 + kq * 128 + v] = pp;
            __syncthreads();
            const float rt = (rd[v] + rd[128 + v]) + (rd[256 + v] + rd[384 + v]), pt = (rd[512 + v] + rd[640 + v]) + (rd[768 + v] + rd[896 + v]);
            const float dd = bt * (vs[t * 128 + v] - rt);
#pragma unroll
            for (int i = 0; i < 32; ++i) S[i] += kk[i] * dd;
            if (kq == 0) ob[t * 128 + v] = pt + kqd[t] * dd;
        }
        __syncthreads();
        for (int t = wid; t < n; t += NWAVES) { const int row = row0 + c0 + t; const float o0 = ob[t * 128 + lane], o1 = ob[t * 128 + 64 + lane];
            const float rstd = 1.0f / sqrtf(wave_sum(o0 * o0 + o1 * o1) * (1.0f / 128.0f) + RMS_EPS);
            const float z0 = UF[(size_t)row * UFW + UF_DNZ + h * 128 + lane], z1 = UF[(size_t)row * UFW + UF_DNZ + h * 128 + 64 + lane];
            O1[(size_t)row * OBW + h * 128 + lane] = (bf16)f2bf(o0 * rstd * nw[lane] * siluf_(z0)); O1[(size_t)row * OBW + h * 128 + 64 + lane] = (bf16)f2bf(o1 * rstd * nw[64 + lane] * siluf_(z1)); }
    }
#pragma unroll
    for (int i = 0; i < 32; ++i) sout[(size_t)(32 * kq + i) * 128 + v] = S[i];
    __syncthreads();
}

__device__ __forceinline__ void ssd_seq(CA A, LAS unsigned char* lds, int layer, int unit, const int wv) {
    const int tid = tid_opaque(wv), lane = tid & 63, wid = tid >> 6, p = tid >> 3, nq = tid & 7;
    int row0, L, hd; const float* h0 = nullptr; float* hout;
    if (unit < 64) { const int b = unit >> 4; hd = unit & 15; row0 = b * SEQ; L = SEQ; hout = A->out + O_SSHP + ((size_t)(layer * NBATCH + b) * 16 + hd) * 8192; }
    else { const int u = unit - 64, sb = u >> 4; hd = u & 15; row0 = TP + sb * 4; L = DSEQ; h0 = IN_F(I_SSSH) + ((size_t)(layer * DBATCH + sb) * 16 + hd) * 8192; hout = A->out + O_SSHS + ((size_t)(layer * DBATCH + sb) * 16 + hd) * 8192; }
    const int g = hd >> 3; constexpr int CH = 64;
    LAS float* Bs = (LAS float*)lds; LAS float* Cs = Bs + CH * 128; LAS float* xs = Cs + CH * 128; LAS float* yb = xs + CH * 64; LAS float* dts = yb + CH * 64;
    const float* XBC = WSP(float, WS_XBC); const float* SC = WSP(float, WS_SCAL); const float* UF = WSP(float, WS_UF); float* SSQ = WSP(float, WS_SSQ);
    bf16* Og = WSP(bf16, WS_OBR) + (3 + g) * 512;
    const float a = -fexp(IN_F(I_SSALOG)[layer * 16 + hd]), Dk = IN_F(I_SSD)[layer * 16 + hd];
    float hs[16];
#pragma unroll
    for (int j = 0; j < 16; ++j) hs[j] = h0 ? h0[(size_t)p * 128 + 16 * nq + j] : 0.f;
    for (int c0 = 0; c0 < L; c0 += CH) {
        const int n = (L - c0) < CH ? (L - c0) : CH;
        __syncthreads();
        for (int idx = tid; idx < n * 128; idx += NTHR) { const int t = idx >> 7, c = idx & 127; const float* src = XBC + (size_t)(row0 + c0 + t) * 1536; Bs[idx] = src[1024 + g * 128 + c]; Cs[idx] = src[1280 + g * 128 + c]; }
        for (int idx = tid; idx < n * 64; idx += NTHR) { const int t = idx >> 6, c = idx & 63; xs[idx] = XBC[(size_t)(row0 + c0 + t) * 1536 + hd * 64 + c]; }
        if (tid < n) dts[tid] = SC[(size_t)(row0 + c0 + tid) * 32 + 8 + hd];
        __syncthreads();
        for (int t = 0; t < n; ++t) {
            const float dt = dts[t], dA = fexp(dt * a), xv = xs[t * 64 + p], cx = dt * xv; float y = 0.f;
#pragma unroll
            for (int j4 = 0; j4 < 4; ++j4) { const f32x4 b4 = *(const LAS f32x4*)(Bs + t * 128 + 16 * nq + 4 * j4), c4 = *(const LAS f32x4*)(Cs + t * 128 + 16 * nq + 4 * j4);
#pragma unroll
                for (int e = 0; e < 4; ++e) { const int j = 4 * j4 + e; hs[j] = hs[j] * dA + cx * b4[e]; y += hs[j] * c4[e]; } }
            y += __shfl_xor(y, 1); y += __shfl_xor(y, 2); y += __shfl_xor(y, 4);
            if (nq == 0) yb[t * 64 + p] = y + Dk * xv;
        }
        __syncthreads();
        for (int t = wid; t < n; t += NWAVES) { const int row = row0 + c0 + t; const float z = UF[(size_t)row * UFW + UF_SSZ + hd * 64 + lane]; const float yg = yb[t * 64 + lane] * siluf_(z);
            const float ss = wave_sum(yg * yg); if (lane == 0) { SSQ[(size_t)row * 32 + hd * 2] = ss; SSQ[(size_t)row * 32 + hd * 2 + 1] = 0.f; }
            Og[(size_t)row * OBW + (hd & 7) * 64 + lane] = (bf16)f2bf(yg); }
    }
#pragma unroll
    for (int j = 0; j < 16; ++j) hout[(size_t)p * 128 + 16 * nq + j] = hs[j];
    __syncthreads();
}

constexpr size_t DNU_NW = 0, DNU_QG = 16384, DNU_AT = 32768, DNU_KGT = 40960, DNU_UP = 57344, DNU_EG = 90112, DNU_BYTES = 90368;
__device__ __forceinline__ float dpp_swap1(float x) { return __builtin_bit_cast(float, __builtin_amdgcn_mov_dpp(__builtin_bit_cast(int, x), 0xB1, 0xf, 0xf, true)); }
__device__ __forceinline__ void dn_chunk_unit(CA A, LAS unsigned char* lds, int layer, int unit, const int wv) {
    const int tid = tid_opaque(wv), lane = tid & 63, wid = tid >> 6, q4 = lane >> 4, l15 = lane & 15;
    const int bh = unit >> 5, ck = unit & 31, b = bh >> 2, h = bh & 3, row0 = b * SEQ + ck * 64;
    constexpr int FP = 132;
    LAS float* kf = (LAS float*)lds; LAS float* vf = kf + 64 * FP;
    LAS unsigned char* qb = lds + 2 * 64 * FP * 4; LAS unsigned char* kb = qb + 64 * 272;
    LAS float* Lp = (LAS float*)(kb + 64 * 272);
    LAS float* gcs = Lp + 2 * 64 * 32; LAS float* bts = gcs + 64;
    unsigned char* rec = A->ws + WS_DNU + (size_t)unit * DNU_BYTES;
    __syncthreads();
    if (tid < 64) { const float* us = WSP(float, WS_UF) + (size_t)(row0 + tid) * UFW + UF_SMALL;
        bts[tid] = sigmoidf_(us[h]); gcs[tid] = wave_scan(-fexp(IN_F(I_DNALOG)[layer * 4 + h]) * softplusf_(us[4 + h] + IN_F(I_DNDTB)[layer * 4 + h]), lane); }
    __syncthreads();
    const float glast = gcs[63];
    if (tid == 0) *(float*)(rec + DNU_EG) = fexp(glast);
    { const float* UF = WSP(float, WS_UF); const float* cw = IN_F(I_DNCW) + (size_t)layer * 4 * 1536;
#pragma unroll
      for (int it = 0; it < 4; ++it) { const int idx = tid + 512 * it, t = idx >> 5, d4 = (idx & 31) * 4, tq = ck * 64 + t; f32x4 val[3];
#pragma unroll
          for (int sIdx = 0; sIdx < 3; ++sIdx) { const int col = sIdx * 512 + h * 128 + d4; f32x4 a = {0.f, 0.f, 0.f, 0.f};
#pragma unroll
              for (int j = 0; j < 4; ++j) if (tq - 3 + j >= 0) a += *(const f32x4*)(UF + (size_t)(row0 + t - 3 + j) * UFW + UF_DNQKV + col) * *(const f32x4*)(cw + j * 1536 + col);
#pragma unroll
              for (int e = 0; e < 4; ++e) a[e] = siluf_(a[e]);
              if (sIdx < 2) { float ss = row16_sum((a[0] * a[0] + a[1] * a[1]) + (a[2] * a[2] + a[3] * a[3])); ss += __shfl_xor(ss, 16);
                  const float sc = (sIdx == 0 ? 0.08838834764831845f : 1.0f) * __builtin_amdgcn_rsqf(ss + 1e-6f); a = a * sc; }
              val[sIdx] = a; }
          const f32x4 qv = val[0], kv = val[1], vv = val[2];
          *(LAS f32x4*)(kf + t * FP + d4) = kv; *(LAS f32x4*)(vf + t * FP + d4) = vv;
          v2u w; w.x = pk2(qv[0], qv[1]); w.y = pk2(qv[2], qv[3]); *(LAS v2u*)(qb + t * 272 + d4 * 2) = w;
          w.x = pk2(kv[0], kv[1]); w.y = pk2(kv[2], kv[3]); *(LAS v2u*)(kb + t * 272 + d4 * 2) = w;
          const float eg = fexp(gcs[t]); w.x = pk2(qv[0] * eg, qv[1] * eg); w.y = pk2(qv[2] * eg, qv[3] * eg); *(v2u*)(rec + DNU_QG + (size_t)(t * 128 + d4) * 2) = w; } }
    __syncthreads();
    { const int c = lane, dg = wid; const float f = fexp(glast - gcs[c]); bf16* KGT = (bf16*)(rec + DNU_KGT);
#pragma unroll
      for (int i = 0; i < 16; ++i) { const int d = dg * 16 + i; KGT[d * 64 + c] = (bf16)f2bf(kf[c * FP + d] * f); } }
    { const int ct = wid >> 1; bf16* AT = (bf16*)(rec + DNU_AT);
#pragma unroll
      for (int e2 = 0; e2 < 2; ++e2) { const int et = 2 * (wid & 1) + e2; f32x4 aKK = {0.f, 0.f, 0.f, 0.f}, aQK = {0.f, 0.f, 0.f, 0.f};
#pragma unroll
          for (int ks = 0; ks < 4; ++ks) { const bf16x8 bfr = *(const LAS bf16x8*)(kb + (16 * et + l15) * 272 + (32 * ks + 8 * q4) * 2);
              const bf16x8 ak = *(const LAS bf16x8*)(kb + (16 * ct + l15) * 272 + (32 * ks + 8 * q4) * 2), aq = *(const LAS bf16x8*)(qb + (16 * ct + l15) * 272 + (32 * ks + 8 * q4) * 2);
              aKK = __builtin_amdgcn_mfma_f32_16x16x32_bf16(ak, bfr, aKK, 0, 0, 0); aQK = __builtin_amdgcn_mfma_f32_16x16x32_bf16(aq, bfr, aQK, 0, 0, 0); }
          const int e = 16 * et + l15; const float ge = gcs[e];
#pragma unroll
          for (int r = 0; r < 4; ++r) { const int c = 16 * ct + 4 * q4 + r; const float dec = e <= c ? fexp(gcs[c] - ge) : 0.f;
              Lp[((e & 1) * 64 + c) * 32 + (e >> 1)] = e < c ? bts[c] * aKK[r] * dec : 0.f;
              AT[c * 64 + e] = (bf16)f2bf(aQK[r] * dec); } } }
    __syncthreads();
    { const int j = tid >> 1, par = tid & 1; float x[32];
#pragma unroll
      for (int i = 0; i < 32; ++i) x[i] = 0.f;
      const LAS float* src = j < 128 ? vf + j : kf + (j - 128);
      float* UP = (float*)(rec + DNU_UP); bf16* NW = (bf16*)(rec + DNU_NW);
#pragma unroll
      for (int c = 0; c < 64; ++c) {
          constexpr int dummy = 0; (void)dummy;
          const int ni = (c + 1) >> 1; float a0 = 0.f, a1 = 0.f, a2 = 0.f, a3 = 0.f;
#pragma unroll
          for (int i4 = 0; i4 < (ni + 3) / 4; ++i4) { const f32x4 l4 = *(const LAS f32x4*)(Lp + (par * 64 + c) * 32 + 4 * i4);
              a0 += l4[0] * x[4 * i4]; if (4 * i4 + 1 < ni) a1 += l4[1] * x[4 * i4 + 1]; if (4 * i4 + 2 < ni) a2 += l4[2] * x[4 * i4 + 2]; if (4 * i4 + 3 < ni) a3 += l4[3] * x[4 * i4 + 3]; }
          float acc = (a0 + a1) + (a2 + a3); acc += dpp_swap1(acc);
          float rhs = src[c * FP] * bts[c]; if (j >= 128) rhs *= fexp(gcs[c]);
          const float xc = rhs - acc;
          x[c >> 1] = ((c & 1) == par) ? xc : x[c >> 1];
          if (par == 0) { if (j < 128) UP[(((j >> 4) * 4 + (c >> 4)) * 4 + (c & 3)) * 64 + ((c >> 2) & 3) * 16 + (j & 15)] = xc; else NW[c * 128 + (j - 128)] = (bf16)f2bf(-xc); }
      } }
}

constexpr int D2_NW = 0, D2_KGT = 17408, D2_BUF = 35840;
__device__ __forceinline__ bf16x8 ld_frag_perm(const LAS unsigned char* p) {
    const v2u lo = *(const LAS v2u*)p, hi = *(const LAS v2u*)(p + 32); v4u w; w.x = lo.x; w.y = lo.y; w.z = hi.x; w.w = hi.y; return __builtin_bit_cast(bf16x8, w);
}
__device__ __forceinline__ bf16x8 pack_b(const f32x4& t0, const f32x4& t1) { v4u w; w.x = pk2(t0[0], t0[1]); w.y = pk2(t0[2], t0[3]); w.z = pk2(t1[0], t1[1]); w.w = pk2(t1[2], t1[3]); return __builtin_bit_cast(bf16x8, w); }
__device__ __forceinline__ void dn_seq2(CA A, LAS unsigned char* lds, int layer, int bh, const int wv) {
    const int tid = tid_opaque(wv), lane = tid & 63, w = tid >> 6, q4 = lane >> 4, l15 = lane & 15;
    const int b = bh >> 2, h = bh & 3;
    const unsigned char* recs = A->ws + WS_DNU + (size_t)(bh * 32) * DNU_BYTES;
    v4u* sav = (v4u*)(A->ws + WS_DNSV + (size_t)(bh * 32) * 49152) + (size_t)w * 6 * 64 + lane;
    f32x4 S[8];
#pragma unroll
    for (int i = 0; i < 8; ++i) S[i] = (f32x4){0.f, 0.f, 0.f, 0.f};
    v4u st[4];
#define D2_LOAD(rec_) do { const v4u* g_ = (const v4u*)(rec_); st[0] = g_[tid]; st[1] = g_[tid + 512]; st[2] = g_[tid + 2560]; st[3] = g_[tid + 3072]; } while (0)
#define D2_STORE(buf_) do { LAS unsigned char* b_ = lds + (buf_) * D2_BUF; \
        *(LAS v4u*)(b_ + D2_NW + (tid >> 4) * 272 + (tid & 15) * 16) = st[0]; *(LAS v4u*)(b_ + D2_NW + (32 + (tid >> 4)) * 272 + (tid & 15) * 16) = st[1]; \
        *(LAS v4u*)(b_ + D2_KGT + (tid >> 3) * 144 + (tid & 7) * 16) = st[2]; *(LAS v4u*)(b_ + D2_KGT + (64 + (tid >> 3)) * 144 + (tid & 7) * 16) = st[3]; } while (0)
    __syncthreads();
    D2_LOAD(recs); D2_STORE(0);
    f32x4 vnx[4]; float eglx = *(const float*)(recs + DNU_EG);
    { const float* UP0 = (const float*)(recs + DNU_UP) + (size_t)w * 1024 + lane;
#pragma unroll
      for (int mt = 0; mt < 4; ++mt)
#pragma unroll
          for (int r = 0; r < 4; ++r) vnx[mt][r] = UP0[(mt * 4 + r) * 64]; }
    __syncthreads();
    for (int ck = 0; ck < 32; ++ck) {
        const unsigned char* rec = recs + (size_t)ck * DNU_BYTES;
        const LAS unsigned char* bf = lds + (ck & 1) * D2_BUF;
        if (ck + 1 < 32) D2_LOAD(rec + DNU_BYTES);
        const float egl = eglx;
        f32x4 vn[4];
#pragma unroll
        for (int mt = 0; mt < 4; ++mt) vn[mt] = vnx[mt];
        if (ck + 1 < 32) { eglx = *(const float*)(rec + DNU_BYTES + DNU_EG); const float* UP = (const float*)(rec + DNU_BYTES + DNU_UP) + (size_t)w * 1024 + lane;
#pragma unroll
            for (int mt = 0; mt < 4; ++mt)
#pragma unroll
                for (int r = 0; r < 4; ++r) vnx[mt][r] = UP[(mt * 4 + r) * 64]; }
        bf16x8 Sb[4];
#pragma unroll
        for (int ks = 0; ks < 4; ++ks) { Sb[ks] = pack_b(S[2 * ks], S[2 * ks + 1]); sav[(size_t)ck * 3072 + ks * 64] = __builtin_bit_cast(v4u, Sb[ks]); }
        const int aoff = l15 * 272 + 8 * q4, aoff2 = l15 * 144 + 8 * q4;
#pragma unroll
        for (int mt = 0; mt < 4; ++mt)
#pragma unroll
            for (int ks = 0; ks < 4; ++ks) vn[mt] = __builtin_amdgcn_mfma_f32_16x16x32_bf16(ld_frag_perm(bf + D2_NW + mt * 16 * 272 + aoff + ks * 64), Sb[ks], vn[mt], 0, 0, 0);
        bf16x8 vb[2];
        vb[0] = pack_b(vn[0], vn[1]); vb[1] = pack_b(vn[2], vn[3]);
        sav[(size_t)ck * 3072 + 4 * 64] = __builtin_bit_cast(v4u, vb[0]); sav[(size_t)ck * 3072 + 5 * 64] = __builtin_bit_cast(v4u, vb[1]);
#pragma unroll
        for (int m8 = 0; m8 < 8; ++m8) { S[m8] = S[m8] * egl;
#pragma unroll
            for (int ke = 0; ke < 2; ++ke) S[m8] = __builtin_amdgcn_mfma_f32_16x16x32_bf16(ld_frag_perm(bf + D2_KGT + m8 * 16 * 144 + aoff2 + ke * 64), vb[ke], S[m8], 0, 0, 0); }
        if (ck + 1 < 32) D2_STORE((ck + 1) & 1);
        __syncthreads();
    }
    float* sout = A->out + O_DNSP + ((size_t)(layer * NBATCH + b) * 4 + h) * 16384;
#pragma unroll
    for (int m8 = 0; m8 < 8; ++m8)
#pragma unroll
        for (int r = 0; r < 4; ++r) sout[(size_t)(16 * m8 + 4 * q4 + r) * 128 + 16 * w + l15] = S[m8][r];
    __syncthreads();
#undef D2_LOAD
#undef D2_STORE
}
constexpr int D3_QG = 0, D3_AT = 17408, D3_RED = 26624;
__device__ __forceinline__ void dn_out_unit(CA A, LAS unsigned char* lds, int layer, int unit, const int wv) {
    const int tid = tid_opaque(wv), lane = tid & 63, w = tid >> 6, q4 = lane >> 4, l15 = lane & 15;
    const int bh = unit >> 5, ck = unit & 31, b = bh >> 2, h = bh & 3, row0 = b * SEQ + ck * 64;
    const unsigned char* rec = A->ws + WS_DNU + (size_t)unit * DNU_BYTES;
    const v4u* sav = (const v4u*)(A->ws + WS_DNSV + (size_t)unit * 49152) + (size_t)w * 6 * 64 + lane;
    const float* UF = WSP(float, WS_UF); bf16* O1 = WSP(bf16, WS_OBR) + 512; const float nwv = IN_F(I_DNNW)[layer * 128 + 16 * w + l15];
    LAS float* red = (LAS float*)(lds + D3_RED);
    __syncthreads();
    { const v4u* g_ = (const v4u*)rec; const v4u a0 = g_[tid + 1024], a1 = g_[tid + 1536], a2 = g_[tid + 2048];
      *(LAS v4u*)(lds + D3_QG + (tid >> 4) * 272 + (tid & 15) * 16) = a0; *(LAS v4u*)(lds + D3_QG + (32 + (tid >> 4)) * 272 + (tid & 15) * 16) = a1;
      *(LAS v4u*)(lds + D3_AT + (tid >> 3) * 144 + (tid & 7) * 16) = a2; }
    bf16x8 Sb[4], vb[2];
#pragma unroll
    for (int ks = 0; ks < 4; ++ks) Sb[ks] = __builtin_bit_cast(bf16x8, sav[ks * 64]);
    vb[0] = __builtin_bit_cast(bf16x8, sav[4 * 64]); vb[1] = __builtin_bit_cast(bf16x8, sav[5 * 64]);
    f32x4 zz[4];
#pragma unroll
    for (int mt = 0; mt < 4; ++mt)
#pragma unroll
        for (int r = 0; r < 4; ++r) zz[mt][r] = UF[(size_t)(row0 + 16 * mt + 4 * q4 + r) * UFW + UF_DNZ + h * 128 + 16 * w + l15];
    __syncthreads();
    const int aoff = l15 * 272 + 8 * q4, aoff2 = l15 * 144 + 8 * q4;
    f32x4 o[4];
#pragma unroll
    for (int mt = 0; mt < 4; ++mt) { o[mt] = (f32x4){0.f, 0.f, 0.f, 0.f};
#pragma unroll
        for (int ks = 0; ks < 4; ++ks) o[mt] = __builtin_amdgcn_mfma_f32_16x16x32_bf16(ld_frag_perm(lds + D3_QG + mt * 16 * 272 + aoff + ks * 64), Sb[ks], o[mt], 0, 0, 0);
#pragma unroll
        for (int ke = 0; ke < 2; ++ke) o[mt] = __builtin_amdgcn_mfma_f32_16x16x32_bf16(ld_frag_perm(lds + D3_AT + mt * 16 * 144 + aoff2 + ke * 64), vb[ke], o[mt], 0, 0, 0); }
#pragma unroll
    for (int mt = 0; mt < 4; ++mt)
#pragma unroll
        for (int r = 0; r < 4; ++r) red[(16 * mt + 4 * q4 + r) * 8 + w] = row16_sum(o[mt][r] * o[mt][r]);
    __syncthreads();
#pragma unroll
    for (int mt = 0; mt < 4; ++mt)
#pragma unroll
        for (int r = 0; r < 4; ++r) { const int c = 16 * mt + 4 * q4 + r; const f32x4 s0 = *(const LAS f32x4*)(red + c * 8), s1 = *(const LAS f32x4*)(red + c * 8 + 4);
            const float rstd = __builtin_amdgcn_rsqf(((s0[0] + s0[1]) + (s0[2] + s0[3]) + (s1[0] + s1[1]) + (s1[2] + s1[3])) * (1.0f / 128.0f) + RMS_EPS);
            const float zq = zz[mt][r]; O1[(size_t)(row0 + c) * OBW + h * 128 + 16 * w + l15] = (bf16)f2bf(o[mt][r] * rstd * nwv * zq * __builtin_amdgcn_rcpf(1.0f + fexp(-zq))); }
}

constexpr size_t SSU_XT = 0, SSU_XTW = 8192, SSU_CUM = 16384, SSU_DT = 16640, SSU_BYTES = 16896;
constexpr size_t SSG_C = 0, SSG_B = 16384, SSG_BT = 32768, SSG_BYTES = 49152;
__device__ __forceinline__ void ssd_prep_unit(CA A, LAS unsigned char* lds, int layer, int unit, const int wv) {
    const int tid = tid_opaque(wv), lane = tid & 63, w = tid >> 6;
    const int quad = unit & 3, bc = unit >> 2, b = bc >> 5, ck = bc & 31, g = quad >> 1, row0 = b * SEQ + ck * 64, tq0 = ck * 64;
    const float* UF = WSP(float, WS_UF); const float* cw = IN_F(I_SSCW) + (size_t)layer * 4 * 1536; const float* cb = IN_F(I_SSCB) + layer * 1536;
    LAS float* xl = (LAS float*)lds;
    LAS float* bl = xl + 4 * 64 * 65;
    LAS float* ws_ = bl + 64 * 129;
    const bool leader = (quad & 1) == 0;
    __syncthreads();
    if (w < 4) { const int hd = quad * 4 + w; unsigned char* rec = A->ws + WS_SSU + (size_t)(bc * 16 + hd) * SSU_BYTES; const float a = -fexp(IN_F(I_SSALOG)[layer * 16 + hd]);
        const float dt = softplusf_(UF[(size_t)(row0 + lane) * UFW + UF_SMALL + 8 + hd] + IN_F(I_SSDTB)[layer * 16 + hd]); const float c = wave_scan(dt * a, lane); const float c63 = rdlane(c, 63); ws_[w * 64 + lane] = fexp(c63 - c) * dt;
        ((float*)(rec + SSU_CUM))[lane] = c; ((float*)(rec + SSU_DT))[lane] = dt; }
    { const int s = tid >> 3, p8 = (tid & 7) * 8;
#pragma unroll
      for (int hq = 0; hq < 4; ++hq) { const int col = (quad * 4 + hq) * 64 + p8; f32x4 x0 = *(const f32x4*)(cb + col), x1 = *(const f32x4*)(cb + col + 4);
#pragma unroll
          for (int j = 0; j < 4; ++j) if (tq0 + s - 3 + j >= 0) { const float* up = UF + (size_t)(row0 + s - 3 + j) * UFW + UF_XBC + col; x0 += *(const f32x4*)up * *(const f32x4*)(cw + j * 1536 + col); x1 += *(const f32x4*)(up + 4) * *(const f32x4*)(cw + j * 1536 + col + 4); }
#pragma unroll
          for (int e = 0; e < 4; ++e) { xl[(hq * 64 + s) * 65 + p8 + e] = siluf_(x0[e]); xl[(hq * 64 + s) * 65 + p8 + 4 + e] = siluf_(x1[e]); } } }
    unsigned char* grec = A->ws + WS_SSG + (size_t)(bc * 2 + g) * SSG_BYTES;
    if (leader) {
        const int s = tid >> 3, n16 = (tid & 7) * 16, colb = 1024 + g * 128 + n16;
        f32x4 bv[4], cv[4];
#pragma unroll
        for (int i = 0; i < 4; ++i) { bv[i] = *(const f32x4*)(cb + colb + 4 * i); cv[i] = *(const f32x4*)(cb + colb + 256 + 4 * i); }
#pragma unroll
        for (int j = 0; j < 4; ++j) if (tq0 + s - 3 + j >= 0) { const float* up = UF + (size_t)(row0 + s - 3 + j) * UFW + UF_XBC + colb; const float* wp = cw + j * 1536 + colb;
#pragma unroll
            for (int i = 0; i < 4; ++i) { bv[i] += *(const f32x4*)(up + 4 * i) * *(const f32x4*)(wp + 4 * i); cv[i] += *(const f32x4*)(up + 256 + 4 * i) * *(const f32x4*)(wp + 256 + 4 * i); } }
#pragma unroll
        for (int i = 0; i < 4; ++i)
#pragma unroll
            for (int e = 0; e < 4; ++e) { bv[i][e] = siluf_(bv[i][e]); cv[i][e] = siluf_(cv[i][e]); }
#pragma unroll
        for (int i = 0; i < 2; ++i) { v4u o; o.x = pk2(bv[2 * i][0], bv[2 * i][1]); o.y = pk2(bv[2 * i][2], bv[2 * i][3]); o.z = pk2(bv[2 * i + 1][0], bv[2 * i + 1][1]); o.w = pk2(bv[2 * i + 1][2], bv[2 * i + 1][3]);
            *(v4u*)(grec + SSG_B + (size_t)(s * 128 + n16 + 8 * i) * 2) = o;
            o.x = pk2(cv[2 * i][0], cv[2 * i][1]); o.y = pk2(cv[2 * i][2], cv[2 * i][3]); o.z = pk2(cv[2 * i + 1][0], cv[2 * i + 1][1]); o.w = pk2(cv[2 * i + 1][2], cv[2 * i + 1][3]);
            *(v4u*)(grec + SSG_C + (size_t)(s * 128 + n16 + 8 * i) * 2) = o; }
#pragma unroll
        for (int i = 0; i < 4; ++i)
#pragma unroll
            for (int e = 0; e < 4; ++e) bl[s * 129 + n16 + 4 * i + e] = bv[i][e];
    }
    __syncthreads();
    { const int p = tid >> 3, s8 = (tid & 7) * 8;
#pragma unroll
      for (int hq = 0; hq < 4; ++hq) { unsigned char* rec = A->ws + WS_SSU + (size_t)(bc * 16 + quad * 4 + hq) * SSU_BYTES; float xv[8], xw[8];
#pragma unroll
          for (int i = 0; i < 8; ++i) { xv[i] = xl[(hq * 64 + s8 + i) * 65 + p]; xw[i] = xv[i] * ws_[hq * 64 + s8 + i]; }
          v4u o; o.x = pk2(xv[0], xv[1]); o.y = pk2(xv[2], xv[3]); o.z = pk2(xv[4], xv[5]); o.w = pk2(xv[6], xv[7]); *(v4u*)(rec + SSU_XT + (size_t)(p * 64 + s8) * 2) = o;
          o.x = pk2(xw[0], xw[1]); o.y = pk2(xw[2], xw[3]); o.z = pk2(xw[4], xw[5]); o.w = pk2(xw[6], xw[7]); *(v4u*)(rec + SSU_XTW + (size_t)(p * 64 + s8) * 2) = o; } }
    if (leader) {
        const int n = tid >> 2, s16 = (tid & 3) * 16; float t[16];
#pragma unroll
        for (int i = 0; i < 16; ++i) t[i] = bl[(s16 + i) * 129 + n];
#pragma unroll
        for (int i = 0; i < 2; ++i) { v4u o; o.x = pk2(t[8 * i], t[8 * i + 1]); o.y = pk2(t[8 * i + 2], t[8 * i + 3]); o.z = pk2(t[8 * i + 4], t[8 * i + 5]); o.w = pk2(t[8 * i + 6], t[8 * i + 7]);
            *(v4u*)(grec + SSG_BT + (size_t)(n * 64 + s16 + 8 * i) * 2) = o; }
    }
}

constexpr int S2_C = 0, S2_B = 17408, S2_BT = 34816, S2_XT = 53248, S2_XTW = 62464, S2_WM = 71680, S2_HB = 80896, S2_YB = 98304, S2_CUM = 114688, S2_DT = 114944;
__device__ __forceinline__ void ssd_seq2(CA A, LAS unsigned char* lds, int layer, int unit, const int wv) {
    const int tid = tid_opaque(wv), lane = tid & 63, w = tid >> 6, q4 = lane >> 4, l15 = lane & 15;
    const int b = unit >> 4, hd = unit & 15, g = hd >> 3;
    const unsigned char* hrec = A->ws + WS_SSU + (size_t)((b * 32) * 16 + hd) * SSU_BYTES;
    const unsigned char* grec = A->ws + WS_SSG + (size_t)((b * 32) * 2 + g) * SSG_BYTES;
    const float* UF = WSP(float, WS_UF); float* SSQ = WSP(float, WS_SSQ); bf16* Og = WSP(bf16, WS_OBR) + (3 + g) * 512;
    const float Dk = IN_F(I_SSD)[layer * 16 + hd];
    LAS float* yb = (LAS float*)(lds + S2_YB); LAS float* cums = (LAS float*)(lds + S2_CUM); LAS float* dts = (LAS float*)(lds + S2_DT);
    f32x4 hacc[4];
#pragma unroll
    for (int i = 0; i < 4; ++i) hacc[i] = (f32x4){0.f, 0.f, 0.f, 0.f};
    v4u st[8]; float sc1 = 0.f;
#define S2_LOAD(ck_) do { const v4u* gg_ = (const v4u*)(grec + (size_t)(ck_) * 2 * SSG_BYTES); const v4u* hh_ = (const v4u*)(hrec + (size_t)(ck_) * 16 * SSU_BYTES); \
        st[0] = gg_[tid]; st[1] = gg_[tid + 512]; st[2] = gg_[tid + 1024]; st[3] = gg_[tid + 1536]; st[4] = gg_[tid + 2048]; st[5] = gg_[tid + 2560]; st[6] = hh_[tid]; st[7] = hh_[tid + 512]; \
        if (tid < 128) sc1 = ((const float*)(hrec + (size_t)(ck_) * 16 * SSU_BYTES + SSU_CUM))[tid]; } while (0)
#define S2_STORE() do { \
        *(LAS v4u*)(lds + S2_C + (tid >> 4) * 272 + (tid & 15) * 16) = st[0]; *(LAS v4u*)(lds + S2_C + (32 + (tid >> 4)) * 272 + (tid & 15) * 16) = st[1]; \
        *(LAS v4u*)(lds + S2_B + (tid >> 4) * 272 + (tid & 15) * 16) = st[2]; *(LAS v4u*)(lds + S2_B + (32 + (tid >> 4)) * 272 + (tid & 15) * 16) = st[3]; \
        *(LAS v4u*)(lds + S2_BT + (tid >> 3) * 144 + (tid & 7) * 16) = st[4]; *(LAS v4u*)(lds + S2_BT + (64 + (tid >> 3)) * 144 + (tid & 7) * 16) = st[5]; \
        *(LAS v4u*)(lds + S2_XT + (tid >> 3) * 144 + (tid & 7) * 16) = st[6]; *(LAS v4u*)(lds + S2_XTW + (tid >> 3) * 144 + (tid & 7) * 16) = st[7]; \
        if (tid < 128) cums[tid] = sc1; } while (0)
    S2_LOAD(0);
    const int tt = w >> 1, aoffC = l15 * 272 + 16 * q4, aoffS = l15 * 144 + 16 * q4;
    float zx[2][4];
#pragma unroll
    for (int e2 = 0; e2 < 2; ++e2)
#pragma unroll
        for (int r = 0; r < 4; ++r) zx[e2][r] = UF[(size_t)(b * SEQ + 16 * tt + 4 * q4 + r) * UFW + UF_SSZ + hd * 64 + 16 * (2 * (w & 1) + e2) + l15];
    for (int ck = 0; ck < 32; ++ck) {
        const int row0 = b * SEQ + ck * 64;
        __syncthreads();
        S2_STORE();
        __syncthreads();
        if (ck + 1 < 32) S2_LOAD(ck + 1);
        float zv[2][4];
#pragma unroll
        for (int e2 = 0; e2 < 2; ++e2)
#pragma unroll
            for (int r = 0; r < 4; ++r) zv[e2][r] = zx[e2][r];
        if (ck + 1 < 32) {
#pragma unroll
            for (int e2 = 0; e2 < 2; ++e2)
#pragma unroll
                for (int r = 0; r < 4; ++r) zx[e2][r] = UF[(size_t)(row0 + 64 + 16 * tt + 4 * q4 + r) * UFW + UF_SSZ + hd * 64 + 16 * (2 * (w & 1) + e2) + l15]; }
#pragma unroll
        for (int e2 = 0; e2 < 2; ++e2) { const int stl = 2 * (w & 1) + e2; f32x4 acc = {0.f, 0.f, 0.f, 0.f};
            if (stl <= tt) {
#pragma unroll
                for (int ks = 0; ks < 4; ++ks) acc = __builtin_amdgcn_mfma_f32_16x16x32_bf16(*(const LAS bf16x8*)(lds + S2_C + tt * 16 * 272 + aoffC + ks * 64), *(const LAS bf16x8*)(lds + S2_B + stl * 16 * 272 + aoffC + ks * 64), acc, 0, 0, 0); }
            const int s = 16 * stl + l15; const float cs = cums[s], ds = dts[s];
#pragma unroll
            for (int r = 0; r < 4; ++r) { const int t = 16 * tt + 4 * q4 + r; const float v = s <= t ? acc[r] * fexp(cums[t] - cs) * ds : 0.f;
                *(LAS unsigned short*)(lds + S2_WM + t * 144 + s * 2) = (unsigned short)f2bf(v); } }
#pragma unroll
        for (int mt = 0; mt < 4; ++mt)
#pragma unroll
            for (int r = 0; r < 4; ++r) *(LAS unsigned short*)(lds + S2_HB + (16 * mt + 4 * q4 + r) * 272 + (16 * w + l15) * 2) = (unsigned short)f2bf(hacc[mt][r]);
        __syncthreads();
        float ssq[4] = {0.f, 0.f, 0.f, 0.f};
#pragma unroll
        for (int e2 = 0; e2 < 2; ++e2) { const int pt = 2 * (w & 1) + e2; f32x4 y = {0.f, 0.f, 0.f, 0.f};
#pragma unroll
            for (int ks = 0; ks < 4; ++ks) y = __builtin_amdgcn_mfma_f32_16x16x32_bf16(*(const LAS bf16x8*)(lds + S2_C + tt * 16 * 272 + aoffC + ks * 64), *(const LAS bf16x8*)(lds + S2_HB + pt * 16 * 272 + aoffC + ks * 64), y, 0, 0, 0);
#pragma unroll
            for (int r = 0; r < 4; ++r) y[r] *= fexp(cums[16 * tt + 4 * q4 + r]);
#pragma unroll
            for (int ke = 0; ke < 2; ++ke) y = __builtin_amdgcn_mfma_f32_16x16x32_bf16(*(const LAS bf16x8*)(lds + S2_WM + tt * 16 * 144 + aoffS + ke * 64), *(const LAS bf16x8*)(lds + S2_XT + pt * 16 * 144 + aoffS + ke * 64), y, 0, 0, 0);
            const int p = 16 * pt + l15;
#pragma unroll
            for (int r = 0; r < 4; ++r) { const int t = 16 * tt + 4 * q4 + r; const float xv = bflo((unsigned)*(const LAS unsigned short*)(lds + S2_XT + p * 144 + t * 2));
                const float yg = (y[r] + Dk * xv) * siluf_(zv[e2][r]); ssq[r] += yg * yg;
                Og[(size_t)(row0 + t) * OBW + (hd & 7) * 64 + p] = (bf16)f2bf(yg); } }
#pragma unroll
        for (int r = 0; r < 4; ++r) { const float s = row16_sum(ssq[r]); if (l15 == 0) SSQ[(size_t)(row0 + 16 * tt + 4 * q4 + r) * 32 + hd * 2 + (w & 1)] = s; }
        { const float e63 = fexp(cums[63]);
#pragma unroll
          for (int mt = 0; mt < 4; ++mt) { hacc[mt] = hacc[mt] * e63;
#pragma unroll
              for (int ke = 0; ke < 2; ++ke) hacc[mt] = __builtin_amdgcn_mfma_f32_16x16x32_bf16(*(const LAS bf16x8*)(lds + S2_XTW + mt * 16 * 144 + aoffS + ke * 64), *(const LAS bf16x8*)(lds + S2_BT + w * 16 * 144 + aoffS + ke * 64), hacc[mt], 0, 0, 0); } }
    }
    float* hout = A->out + O_SSHP + ((size_t)(layer * NBATCH + b) * 16 + hd) * 8192;
#pragma unroll
    for (int mt = 0; mt < 4; ++mt)
#pragma unroll
        for (int r = 0; r < 4; ++r) hout[(size_t)(16 * mt + 4 * q4 + r) * 128 + 16 * w + l15] = hacc[mt][r];
    __syncthreads();
#undef S2_LOAD
#undef S2_STORE
}

struct ALBf16 { const bf16* A; int lda; __device__ __forceinline__ bf16x8 operator()(int row, int k) const { return *(const bf16x8*)(A + (size_t)row * lda + k); } };
template <class AL> __device__ __forceinline__ void sgemm_task(const AL& al, const bf16* Wt, int ldw, int n0, int k0, int nks, f32x4 (&acc)[2], int l15, int q4) {
    const bf16* bp = Wt + (size_t)(n0 + l15) * ldw + k0 + 8 * q4;
    int nks_ = nks; asm volatile("" : "+s"(nks_));
#pragma unroll 4
    for (int ks = 0; ks < nks_; ++ks) { const bf16x8 b = *(const bf16x8*)(bp + 32 * ks); const bf16x8 a0 = al(l15, k0 + 32 * ks + 8 * q4), a1 = al(16 + l15, k0 + 32 * ks + 8 * q4);
        acc[0] = __builtin_amdgcn_mfma_f32_16x16x32_bf16(a0, b, acc[0], 0, 0, 0); acc[1] = __builtin_amdgcn_mfma_f32_16x16x32_bf16(a1, b, acc[1], 0, 0, 0); }
}
#define SAMPLE_IDS() const int tid = tid_opaque(wv), lane = tid & 63, l15 = lane & 15, q4 = lane >> 4, NGW = gridDim.x * NWAVES, gw = (tid >> 6) * gridDim.x + blk_opaque()
__device__ __forceinline__ void sample_merge(CA A, LAS unsigned char* lds, int layer, const int wv) {
    const int tid = tid_opaque(wv), lane = tid & 63, l15 = lane & 15, q4 = lane >> 4, w = tid >> 6, G = gridDim.x;
    const bf16* GT = WSP(bf16, WS_GATE); const float* RS = WSP(float, WS_RS); bf16* MB = WSP(bf16, WS_MGB); LAS float* part = (LAS float*)lds;
    for (int strip = blk_opaque(); strip < 128; strip += G) { const int n0 = strip * 16, col = n0 + l15;
        __syncthreads();
        if (w < 5) { const int s = w, gs = s < 3 ? s : 3;
            f32x4 acc[2] = {{0.f, 0.f, 0.f, 0.f}, {0.f, 0.f, 0.f, 0.f}};
            ALBf16 al{WSP(bf16, WS_OBR) + (size_t)TP * OBW + s * 512, OBW};
            sgemm_task(al, WSP(bf16, WS_WBR) + (size_t)layer * DM * OBW + s * 512, OBW, n0, 0, 16, acc, l15, q4);
#pragma unroll
            for (int mt = 0; mt < 2; ++mt)
#pragma unroll
                for (int r = 0; r < 4; ++r) { const int row = 16 * mt + 4 * q4 + r, grow = TP + row; float rs = 1.f;
                    if (s >= 3) rs = 1.0f / sqrtf(RS[(size_t)grow * 2 + (s - 3)]);
                    part[(s * 32 + row) * 16 + l15] = acc[mt][r] * bflo((unsigned)GT[(size_t)grow * 8192 + gs * 2048 + col]) * rs; } }
        __syncthreads();
        { const int row = tid >> 4, c = tid & 15; const float v = (part[row * 16 + c] + part[(32 + row) * 16 + c]) + (part[(64 + row) * 16 + c] + part[(96 + row) * 16 + c]) + part[(128 + row) * 16 + c];
          MB[(size_t)(TP + row) * DM + n0 + c] = (bf16)f2bf(v); } }
}
__device__ __forceinline__ void sample_up(CA A, LAS unsigned char* lds, int layer, const int wv) {
    const int tid = tid_opaque(wv), lane = tid & 63, l15 = lane & 15, q4 = lane >> 4, w = tid >> 6, G = gridDim.x;
    bf16* F = WSP(bf16, WS_F); LAS float* part = (LAS float*)lds;
    for (int sp = blk_opaque(); sp < 256; sp += G) { const int n0 = (2 * sp + (w >> 2)) * 16, kq = w & 3;
        __syncthreads();
        f32x4 acc[2] = {{0.f, 0.f, 0.f, 0.f}, {0.f, 0.f, 0.f, 0.f}};
        ALBf16 al{WSP(bf16, WS_H) + (size_t)TP * DM, DM};
        sgemm_task(al, WSP(bf16, WS_WUP) + (size_t)layer * DFF * DM, DM, n0, kq * 512, 16, acc, l15, q4);
#pragma unroll
        for (int mt = 0; mt < 2; ++mt)
#pragma unroll
            for (int r = 0; r < 4; ++r) part[(w * 32 + 16 * mt + 4 * q4 + r) * 16 + l15] = acc[mt][r];
        __syncthreads();
#pragma unroll
        for (int h2 = 0; h2 < 2; ++h2) { const int idx = tid + 512 * h2, half = idx >> 9, row = (idx >> 4) & 31, c = idx & 15; const LAS float* p = part + (half * 4 * 32 + row) * 16 + c;
            const float v = fmaxf((p[0] + p[32 * 16]) + (p[2 * 32 * 16] + p[3 * 32 * 16]), 0.f);
            F[(size_t)(TP + row) * DFF + (2 * sp + half) * 16 + c] = (bf16)f2bf(v * v); } }
}
template <class AL> __device__ __forceinline__ void sample_splitk(const AL& al, const bf16* Wt, int ldw, int nstrips, int nsplit, int nks, float* PART, int ldp, const int wv) {
    SAMPLE_IDS();
    for (int it = gw; it < nstrips * nsplit; it += NGW) { const int ns = it % nstrips, sp = it / nstrips, n0 = ns * 16;
        f32x4 acc[2] = {{0.f, 0.f, 0.f, 0.f}, {0.f, 0.f, 0.f, 0.f}};
        sgemm_task(al, Wt, ldw, n0, sp * nks * 32, nks, acc, l15, q4);
#pragma unroll
        for (int mt = 0; mt < 2; ++mt)
#pragma unroll
            for (int r = 0; r < 4; ++r) PART[((size_t)sp * TS + 16 * mt + 4 * q4 + r) * ldp + n0 + l15] = acc[mt][r]; }
}

constexpr int KS_PITCH = 272, VS_PITCH = 320;
typedef short v4i16_t __attribute__((ext_vector_type(4)));
constexpr int ATT_KS = 0, ATT_VT = 64 * KS_PITCH;
__device__ __forceinline__ void attn_prompt_unit(CA A, LAS unsigned char* lds, int layer, int unit, const int wv) {
    const int tid = tid_opaque(wv), lane = tid & 63, wid = tid >> 6, r = lane & 31, hh = lane >> 5;
    const int qb = 7 - (unit >> 4), bh = unit & 15, b = bh >> 2, h = bh & 3;
    const int q0 = qb * 256 + wid * 32, qpos = q0 + r;
    const bf16* QKV = WSP(bf16, WS_QKV) + (size_t)(b * SEQ) * 1536;
    bf16x8 Qf[8];
    { const bf16* qrow = QKV + (size_t)qpos * 1536 + h * 128 + 8 * hh;
#pragma unroll
      for (int s = 0; s < 8; ++s) Qf[s] = *(const bf16x8*)(qrow + 16 * s); }
    f32x16 O[4];
#pragma unroll
    for (int d = 0; d < 4; ++d)
#pragma unroll
        for (int i = 0; i < 16; ++i) O[d][i] = 0.f;
    float R = 1.f;
    const float bias2 = IN_F(I_SBBIAS)[layer * 4 + h] * LOG2E;
    const int ntile = qb * 4 + 4, srow = tid >> 3, sch = tid & 7;
    LAS unsigned char* Ks = lds + ATT_KS; LAS unsigned char* Vt = lds + ATT_VT;
    v4u kreg[2], vreg[2];
    { const bf16* src = QKV + (size_t)((ntile - 1) * 64 + srow) * 1536 + h * 128 + sch * 8;
      kreg[0] = *(const v4u*)(src + 512); kreg[1] = *(const v4u*)(src + 512 + 64); vreg[0] = *(const v4u*)(src + 1024); vreg[1] = *(const v4u*)(src + 1024 + 64); }
    for (int kt = ntile - 1; kt >= 0; --kt) {
        __syncthreads();
#pragma unroll
        for (int i = 0; i < 2; ++i) { *(LAS v4u*)(Ks + srow * KS_PITCH + (sch + 8 * i) * 16) = kreg[i]; *(LAS v4u*)(Vt + srow * VS_PITCH + (sch + 8 * i) * 16) = vreg[i]; }
        __syncthreads();
        if (kt > 0) { const bf16* src = QKV + (size_t)((kt - 1) * 64 + srow) * 1536 + h * 128 + sch * 8;
            kreg[0] = *(const v4u*)(src + 512); kreg[1] = *(const v4u*)(src + 512 + 64); vreg[0] = *(const v4u*)(src + 1024); vreg[1] = *(const v4u*)(src + 1024 + 64); }
        if (kt * 64 > q0 + 30) continue;
        const bool diag = (kt * 64 + 63 >= q0);
        const int kbase = kt * 64 + 4 * hh;
        bf16x8 Pf[4];
#pragma unroll
        for (int sub = 1; sub >= 0; --sub) {
            f32x16 sa;
#pragma unroll
            for (int i = 0; i < 16; ++i) sa[i] = bias2;
#pragma unroll
            for (int s = 0; s < 8; ++s) { const bf16x8 a = *(const LAS bf16x8*)(Ks + (32 * sub + r) * KS_PITCH + (16 * s + 8 * hh) * 2);
                sa = __builtin_amdgcn_mfma_f32_32x32x16_bf16(a, Qf[s], sa, 0, 0, 0); }
            float sp[16], iv[16], Gs[4], Gp[4];
#pragma unroll
            for (int i = 0; i < 16; ++i) { const float e = ex2(fminf(sa[i], 60.f)); float inv = __builtin_amdgcn_rcpf(1.0f + e), bt = e * inv;
                if (diag && (kbase + 32 * sub + 8 * (i >> 2) + (i & 3) >= qpos)) { inv = 1.f; bt = 0.f; }
                iv[i] = inv; sp[i] = bt; }
#pragma unroll
            for (int g = 0; g < 4; ++g) { Gs[g] = (iv[4 * g] * iv[4 * g + 1]) * (iv[4 * g + 2] * iv[4 * g + 3]); Gp[g] = __shfl_xor(Gs[g], 32); }
            float run = R;
#pragma unroll
            for (int g = 3; g >= 0; --g) { float a = hh == 0 ? run * Gp[g] : run;
#pragma unroll
                for (int e = 3; e >= 0; --e) { const int i = 4 * g + e; sp[i] *= a; a *= iv[i]; }
                run *= Gs[g] * Gp[g]; }
            R = run;
#pragma unroll
            for (int q2 = 0; q2 < 2; ++q2) { const int bs = 8 * q2; v4u w;
                w.x = pk2(sp[bs + 0], sp[bs + 1]); w.y = pk2(sp[bs + 2], sp[bs + 3]); w.z = pk2(sp[bs + 4], sp[bs + 5]); w.w = pk2(sp[bs + 6], sp[bs + 7]);
                Pf[2 * sub + q2] = __builtin_bit_cast(bf16x8, w); }
        }
#pragma unroll
        for (int d = 0; d < 4; ++d)
#pragma unroll
            for (int s4 = 0; s4 < 4; ++s4) {
                const LAS unsigned char* vp = Vt + (16 * s4 + 4 * hh + ((lane & 15) >> 2)) * VS_PITCH + (32 * d + 16 * ((lane >> 4) & 1) + 4 * (lane & 3)) * 2;
                const v4i16_t lo = __builtin_amdgcn_ds_read_tr16_b64_v4i16((LAS v4i16_t*)vp), hi = __builtin_amdgcn_ds_read_tr16_b64_v4i16((LAS v4i16_t*)(vp + 8 * VS_PITCH));
                const v2u lo2 = __builtin_bit_cast(v2u, lo), hi2 = __builtin_bit_cast(v2u, hi); v4u w; w.x = lo2.x; w.y = lo2.y; w.z = hi2.x; w.w = hi2.y;
                O[d] = __builtin_amdgcn_mfma_f32_32x32x16_bf16(__builtin_bit_cast(bf16x8, w), Pf[s4], O[d], 0, 0, 0); }
    }
    bf16* orow = WSP(bf16, WS_OBR) + 1024 + (size_t)(b * SEQ + qpos) * OBW + h * 128 + 4 * hh;
#pragma unroll
    for (int d = 0; d < 4; ++d)
#pragma unroll
        for (int g = 0; g < 4; ++g) { v2u w; w.x = pk2(O[d][4 * g], O[d][4 * g + 1]); w.y = pk2(O[d][4 * g + 2], O[d][4 * g + 3]); *(v2u*)(orow + 32 * d + 8 * g) = w; }
}

__device__ __forceinline__ void attn_sample_unit(CA A, LAS unsigned char* lds, int layer, int unit, const int wv) {
    const int tid = tid_opaque(wv), lane = tid & 63, wid = tid >> 6, sb = unit >> 5, pg4 = unit & 31, hd = lane >> 4;
    const int lp = 4 * pg4 + (wid >> 1), phys = ((const int*)A->in[I_PT])[sb * NPAGES + lp];
    const size_t pbase = ((size_t)(layer * NPOOL + phys) * PAGE + (wid & 1) * 64) * 512 + lane * 8;
    const float* Kc = IN_F(I_CK) + pbase; const float* Vc = IN_F(I_CV) + pbase;
    const bf16* QKV = WSP(bf16, WS_QKV);
    float qf[4][8], O[4][8], R[4];
#pragma unroll
    for (int i = 0; i < 4; ++i) { const v4u w = *(const v4u*)(QKV + (size_t)(TP + sb * 4 + i) * 1536 + lane * 8);
        qf[i][0] = bflo(w.x); qf[i][1] = bfhi(w.x); qf[i][2] = bflo(w.y); qf[i][3] = bfhi(w.y); qf[i][4] = bflo(w.z); qf[i][5] = bfhi(w.z); qf[i][6] = bflo(w.w); qf[i][7] = bfhi(w.w);
        R[i] = 0.f;
#pragma unroll
        for (int j = 0; j < 8; ++j) O[i][j] = 0.f; }
    const float bias2 = IN_F(I_SBBIAS)[layer * 4 + hd] * LOG2E;
#pragma unroll 4
    for (int t = 63; t >= 0; --t) {
        const f32x4 k0 = *(const f32x4*)(Kc + (size_t)t * 512), k1 = *(const f32x4*)(Kc + (size_t)t * 512 + 4), v0 = *(const f32x4*)(Vc + (size_t)t * 512), v1 = *(const f32x4*)(Vc + (size_t)t * 512 + 4);
#pragma unroll
        for (int i = 0; i < 4; ++i) {
            float s = (qf[i][0] * k0[0] + qf[i][1] * k0[1]) + (qf[i][2] * k0[2] + qf[i][3] * k0[3]) + (qf[i][4] * k1[0] + qf[i][5] * k1[1]) + (qf[i][6] * k1[2] + qf[i][7] * k1[3]);
            s = row16_sum(s);
            const float z = fminf(s + bias2, 60.f), s1 = lg2(1.0f + ex2(z)), pv = ex2(z - s1 - R[i]); R[i] += s1;
#pragma unroll
            for (int e = 0; e < 4; ++e) { O[i][e] += pv * v0[e]; O[i][4 + e] += pv * v1[e]; } }
    }
    LAS float* Ow = (LAS float*)lds;
    LAS float* Rw = Ow + 8 * 4 * 512;
    __syncthreads();
#pragma unroll
    for (int i = 0; i < 4; ++i) { *(LAS f32x4*)(Ow + (wid * 4 + i) * 512 + lane * 8) = (f32x4){O[i][0], O[i][1], O[i][2], O[i][3]}; *(LAS f32x4*)(Ow + (wid * 4 + i) * 512 + lane * 8 + 4) = (f32x4){O[i][4], O[i][5], O[i][6], O[i][7]};
        if ((lane & 15) == 0) Rw[(wid * 4 + i) * 4 + hd] = R[i]; }
    __syncthreads();
    float* PART = WSP(float, WS_PART) + (size_t)unit * 2048; float* PR = WSP(float, WS_PR) + (size_t)unit * 16;
    for (int idx = tid; idx < 2048; idx += NTHR) { const int i = idx >> 9, c = idx & 511, hc = c >> 7; float acc = 0.f, racc = 0.f;
#pragma unroll
        for (int w = 7; w >= 0; --w) { acc += ex2(-racc) * Ow[(w * 4 + i) * 512 + c]; racc += Rw[(w * 4 + i) * 4 + hc]; }
        PART[idx] = acc; if ((c & 127) == 0) PR[i * 4 + hc] = racc; }
}
__device__ __forceinline__ void attn_sample_combine(CA A, int layer, const int wv) {
    {
      const int t0 = tid_opaque(wv), gt = blk_opaque() * NTHR + t0; const float* SQ = WSP(float, WS_SSQ); float* RS = WSP(float, WS_RS);
      for (int idx = gt; idx < TT * 2; idx += gridDim.x * NTHR) { const f32x4* sq = (const f32x4*)(SQ + (size_t)idx * 16); const f32x4 a = sq[0], b = sq[1], c = sq[2], d = sq[3];
          RS[idx] = (((a[0] + a[1]) + (a[2] + a[3]) + (b[0] + b[1]) + (b[2] + b[3])) + ((c[0] + c[1]) + (c[2] + c[3]) + (d[0] + d[1]) + (d[2] + d[3]))) * (1.0f / 512.0f) + RMS_EPS; } }
    const int tid = tid_opaque(wv), lane = tid & 63, gw = blk_opaque() * NWAVES + (tid >> 6), NGW = gridDim.x * NWAVES;
    const bf16* QKV = WSP(bf16, WS_QKV); const float* PART = WSP(float, WS_PART); const float* PR = WSP(float, WS_PR);
    const float* kn = A->out + O_KS + (size_t)layer * TS * 512; const float* vn = A->out + O_VS + (size_t)layer * TS * 512;
    bf16* O2 = WSP(bf16, WS_OBR) + 1024;
    for (int it = gw; it < TS * 4; it += NGW) { const int sb = it >> 4, i = (it >> 2) & 3, hd = it & 3, row = TP + sb * 4 + i, c = hd * 128 + 2 * lane;
        const unsigned qw = *(const unsigned*)(QKV + (size_t)row * 1536 + c); const float q0 = bflo(qw), q1 = bfhi(qw);
        const float bias2 = IN_F(I_SBBIAS)[layer * 4 + hd] * LOG2E; float o0 = 0.f, o1 = 0.f, racc = 0.f;
        for (int j = i - 1; j >= 0; --j) { const float* kr = kn + (size_t)(sb * 4 + j) * 512 + c; const float* vr = vn + (size_t)(sb * 4 + j) * 512 + c;
            const float z = fminf(wave_sum(q0 * kr[0] + q1 * kr[1]) + bias2, 60.f), s1 = lg2(1.0f + ex2(z)), pv = ex2(z - s1 - racc); racc += s1; o0 += pv * vr[0]; o1 += pv * vr[1]; }
        for (int u = 31; u >= 0; --u) { const float* pr = PART + ((size_t)(sb * 32 + u) * 4 + i) * 512 + c; const float sc = ex2(-racc); o0 += sc * pr[0]; o1 += sc * pr[1]; racc += PR[(size_t)(sb * 32 + u) * 16 + i * 4 + hd]; }
        *(unsigned*)(O2 + (size_t)row * OBW + c) = pk2(o0, o1); }
}

#ifndef MK_ONE_LAUNCH
#define MK_ONE_LAUNCH 1
#endif
#ifndef REP_P0
#define REP_P0 1
#endif
#ifndef REP_IN
#define REP_IN 1
#endif
#ifndef REP_PREP
#define REP_PREP 1
#endif
#ifndef REP_MIXA
#define REP_MIXA 1
#endif
#ifndef REP_MIXB
#define REP_MIXB 1
#endif
#ifndef REP_MERGE
#define REP_MERGE 1
#endif
#ifndef REP_OUT
#define REP_OUT 1
#endif
#ifndef REP_UP
#define REP_UP 1
#endif
#ifndef REP_DOWN
#define REP_DOWN 1
#endif
#ifndef REP_BAR
#define REP_BAR 1
#endif
#ifndef REP_RES1L0
#define REP_RES1L0 1
#endif
#ifndef REP_ADN
#define REP_ADN 1
#endif
#ifndef REP_ASSD
#define REP_ASSD 1
#endif
#ifndef REP_BDN
#define REP_BDN 1
#endif
#ifndef REP_BSSD
#define REP_BSSD 1
#endif
#ifndef REP_BSATT
#define REP_BSATT 1
#endif
constexpr int N_PHASES = 24;
__device__ __forceinline__ int queue_pop(unsigned* head, volatile LAS unsigned* slot, const int wv) {
    __syncthreads();
    if (tid_opaque(wv) == 0) *slot = __hip_atomic_fetch_add(head, 1u, __ATOMIC_RELAXED, __HIP_MEMORY_SCOPE_AGENT);
    __syncthreads();
    return (int)*slot;
}
__global__ void __launch_bounds__(NTHR, 2) mega(Args Araw) {
    extern __shared__ __attribute__((aligned(16))) unsigned char lds_raw[];
    LAS unsigned char* lds = (LAS unsigned char*)lds_raw;
    volatile LAS unsigned* MISC = (volatile LAS unsigned*)(lds + MISC_OFF);
    const int wv = __builtin_amdgcn_readfirstlane(threadIdx.x >> 6); const int tid = tid_opaque(wv), G = gridDim.x, blk = blk_opaque();
    if (tid < 16) MISC[tid] = 0u;
    __syncthreads();
    unsigned* ctl = (unsigned*)(Araw.ws + WS_CTL);
    XcdBarrier bar = xcd_barrier_post(ctl + CW_BAR + Araw.li * XCD_BAR_WORDS, MISC, tid);
    const int lo = Araw.ph_lo, hi = Araw.ph_hi;
#define IN(gp) (lo <= (gp) && (gp) < hi)
#define SEAM(gp) do { if (lo <= (gp) && (gp) + 1 < hi) for (int rb_ = 0; rb_ < REP_BAR; ++rb_) xcd_barrier(bar, tid_opaque(wv)); } while (0)

    if (IN(0)) for (int rep = 0; rep < REP_P0; ++rep) { CA A = args_opaque(); p0_prologue(A, lds, wv); }
    if (IN(0)) { CA A = args_opaque(); norm1_phase(A, wv); }
    SEAM(0);
    for (int layer = 0; layer < DEPTH; ++layer) {
        const int gb = 1 + 11 * layer;
        if (IN(gb + 1)) for (int rep = 0; rep < REP_IN; ++rep) { CA A = args_opaque();
            pg8::Gemm g{WSP(bf16, WS_H), WSP(bf16, WS_WIN) + (size_t)layer * NIN * DM, MP, NIN, DM, DM / 64, 0}; pg8::StaticOrder S; S.init(MP, NIN, G, blk_opaque());
            EpiIn E{WSP(float, WS_UF), WSP(bf16, WS_QKV), WSP(bf16, WS_GATE), A->out + O_KP + (size_t)layer * TP * 512, A->out + O_VP + (size_t)layer * TP * 512,
                    A->out + O_KS + (size_t)layer * TS * 512, A->out + O_VS + (size_t)layer * TS * 512, 0.08838834764831845f * LOG2E};
            pg8::gemm_phase<EpiIn, pg8::StaticOrder, true, true>(lds, g, S, E, wv);
        }
        SEAM(gb + 1);
        if (IN(gb + 3)) for (int rep = 0; rep < REP_MIXA; ++rep) { CA A = args_opaque();
            for (int r3 = 0; r3 < REP_PREP; ++r3) prep_phase(A, layer, wv);
            for (int r2 = 0; r2 < REP_ASSD; ++r2) { unsigned* qh = (unsigned*)(A->ws + WS_CTL) + CW_QUEUE + 64 * (layer * 4 + 3) + 1024 * rep + 2048 * r2;
              for (;;) { const int u = queue_pop(qh, MISC + 4, wv); if (u >= 512) break; ssd_prep_unit(A, lds, layer, u, wv); } }
            for (int r2 = 0; r2 < REP_ADN; ++r2) { unsigned* qh = (unsigned*)(A->ws + WS_CTL) + CW_QUEUE + 64 * (layer * 4 + 2) + 1024 * rep + 2048 * r2;
              for (;;) { const int u = queue_pop(qh, MISC + 4, wv); if (u >= 512) break; dn_chunk_unit(A, lds, layer, u, wv); } }
        }
        SEAM(gb + 3);
        if (IN(gb + 4)) for (int rep = 0; rep < REP_MIXB; ++rep) { CA A = args_opaque();
            for (int r2 = 0; r2 < REP_BDN; ++r2) for (int t = blk; t < 16; t += G) dn_seq2(A, lds, layer, t, wv);
            for (int r2 = 0; r2 < REP_BSSD; ++r2) for (int t = blk; t < 80; t += G) if (t >= 16) ssd_seq2(A, lds, layer, t - 16, wv);
            for (int t = blk; t < 112; t += G) if (t >= 80) dn_seq(A, lds, layer, t - 80 + 16, wv);
            for (int t = blk; t < 240; t += G) if (t >= 112) ssd_seq(A, lds, layer, t - 112 + 64, wv);
            { unsigned* qh = (unsigned*)(A->ws + WS_CTL) + CW_QUEUE + 64 * (layer * 4 + 0) + 1024 * rep;
              for (;;) { const int u = queue_pop(qh, MISC + 4, wv); if (u >= 128) break; attn_prompt_unit(A, lds, layer, u, wv); } }
            for (int r2 = 0; r2 < REP_BSATT; ++r2) { unsigned* qh = (unsigned*)(A->ws + WS_CTL) + CW_QUEUE + 64 * (layer * 4 + 1) + 1024 * rep + 2048 * r2;
              for (;;) { const int u = queue_pop(qh, MISC + 4, wv); if (u >= 256) break; attn_sample_unit(A, lds, layer, u, wv); } }
        }
        SEAM(gb + 4);
        if (IN(gb + 5)) { CA A = args_opaque(); attn_sample_combine(A, layer, wv);
            { unsigned* qh = (unsigned*)(A->ws + WS_CTL) + 16384 + 64 * layer;
              for (;;) { const int u = queue_pop(qh, MISC + 4, wv); if (u >= 512) break; dn_out_unit(A, lds, layer, u, wv); } } }
        SEAM(gb + 5);
        if (IN(gb + 6)) for (int rep = 0; rep < REP_MERGE; ++rep) { CA A = args_opaque();
            pg8::SegOrder<5> S; S.init(TP, DM, G, blk_opaque());
            pg8::Gemm g{WSP(bf16, WS_OBR), WSP(bf16, WS_WBR) + (size_t)layer * DM * OBW, TP, DM, OBW, 8, 1024};
            EpiMergeR E{WSP(bf16, WS_GATE), WSP(float, WS_RS), WSP(bf16, WS_MGB)};
            pg8::gemm_phase<EpiMergeR, pg8::SegOrder<5>, true, true>(lds, g, S, E, wv);
            sample_merge(A, lds, layer, wv);
        }
        SEAM(gb + 6);
        if (IN(gb + 7)) for (int rep = 0; rep < REP_OUT; ++rep) { CA A = args_opaque();
            pg8::Gemm g{WSP(bf16, WS_MGB), WSP(bf16, WS_WOUT) + (size_t)layer * DM * DM, TP, DM, DM, DM / 64, 0}; pg8::StaticOrder S; S.init(TP, DM, G, blk_opaque());
            EpiF32 E{WSP(float, WS_MIX), DM}; pg8::gemm_phase<EpiF32, pg8::StaticOrder, true, true>(lds, g, S, E, wv);
            { ALBf16 al{WSP(bf16, WS_MGB) + (size_t)TP * DM, DM}; sample_splitk(al, WSP(bf16, WS_WOUT) + (size_t)layer * DM * DM, DM, 128, 16, 4, WSP(float, WS_OUTS), DM, wv); }
        }
        SEAM(gb + 7);
        if (IN(gb + 8)) for (int rep = 0; rep < (layer == 0 ? REP_RES1L0 : 1); ++rep) { CA A = args_opaque(); resid_phase(A, WSP(float, WS_MIX), WSP(float, WS_OUTS), IN_F(I_NMPOST) + layer * DM, IN_F(I_NLPRE) + layer * DM, layer == 0, wv); }
        SEAM(gb + 8);
        if (IN(gb + 9)) for (int rep = 0; rep < REP_UP; ++rep) { CA A = args_opaque();
            pg8::Gemm g{WSP(bf16, WS_H), WSP(bf16, WS_WUP) + (size_t)layer * DFF * DM, TP, DFF, DM, DM / 64, 0}; pg8::StaticOrder S; S.init(TP, DFF, G, blk_opaque());
            EpiRelu2 E{WSP(bf16, WS_F), DFF}; pg8::gemm_phase<EpiRelu2, pg8::StaticOrder, true, true>(lds, g, S, E, wv);
            sample_up(A, lds, layer, wv);
        }
        SEAM(gb + 9);
        if (IN(gb + 10)) for (int rep = 0; rep < REP_DOWN; ++rep) { CA A = args_opaque();
            pg8::Gemm g{WSP(bf16, WS_F), WSP(bf16, WS_WDN) + (size_t)layer * DM * DFF, TP, DM, DFF, DFF / 64, 0}; pg8::StaticOrder S; S.init(TP, DM, G, blk_opaque());
            EpiF32 E{WSP(float, WS_FD), DM}; pg8::gemm_phase<EpiF32, pg8::StaticOrder, true, true>(lds, g, S, E, wv);
            { ALBf16 al{WSP(bf16, WS_F) + (size_t)TP * DFF, DFF}; sample_splitk(al, WSP(bf16, WS_WDN) + (size_t)layer * DM * DFF, DFF, 128, 16, 16, WSP(float, WS_DNS), DM, wv); }
        }
        SEAM(gb + 10);
        if (IN(gb + 11)) { CA A = args_opaque(); resid_phase(A, WSP(float, WS_FD), WSP(float, WS_DNS), IN_F(I_NLPOST) + layer * DM, layer + 1 < DEPTH ? IN_F(I_NMPRE) + (layer + 1) * DM : nullptr, false, wv); }
        SEAM(gb + 11);
    }
#undef IN
#undef SEAM
}

extern "C" void kernel_launch(void* const* d_in, const int* in_sizes, int n_in, void* d_out, int out_size, void* d_ws, size_t ws_size, hipStream_t stream) {
    static int grid = 0;
    if (grid == 0) {
        if (n_in != N_IN || (size_t)out_size != O_END || ws_size < WS_END) { fprintf(stderr, "kernel_launch: unexpected problem (n_in %d, out %d vs %zu, ws %zu vs %zu); nothing launched\n", n_in, out_size, (size_t)O_END, ws_size, (size_t)WS_END); grid = -1; return; }
        int dev = 0, cus = 0, per_cu = 0;
        if (hipGetDevice(&dev) != hipSuccess || hipDeviceGetAttribute(&cus, hipDeviceAttributeMultiprocessorCount, dev) != hipSuccess) { grid = -1; return; }
        if (hipFuncSetAttribute((const void*)mega, hipFuncAttributeMaxDynamicSharedMemorySize, LDS_BYTES) != hipSuccess) { fprintf(stderr, "kernel_launch: hipFuncSetAttribute failed\n"); grid = -1; return; }
        if (hipOccupancyMaxActiveBlocksPerMultiprocessor(&per_cu, (const void*)mega, NTHR, LDS_BYTES) != hipSuccess || per_cu < 1) fprintf(stderr, "kernel_launch: occupancy query says %d blocks per CU\n", per_cu);
        (void)hipGetLastError();
        grid = cus;
    }
    if (grid < 0) return;
    (void)in_sizes;
    hipMemsetAsync((char*)d_ws + WS_CTL, 0, CTL_BYTES, stream);
    Args a{};
    for (int i = 0; i < N_IN; ++i) a.in[i] = d_in[i];
    a.out = (float*)d_out; a.ws = (unsigned char*)d_ws; a.pad = 0;
#if MK_ONE_LAUNCH
    a.ph_lo = 0; a.ph_hi = N_PHASES; a.li = 0;
    hipLaunchKernelGGL(mega, dim3(grid), dim3(NTHR), LDS_BYTES, stream, a);
#else
    for (int gp = 0; gp < N_PHASES; ++gp) { a.ph_lo = gp; a.ph_hi = gp + 1; a.li = 0; hipLaunchKernelGGL(mega, dim3(grid), dim3(NTHR), LDS_BYTES, stream, a); }
#endif
}
```

```cpp
#include <hip/hip_runtime.h>
#include <cstdio>
#include <cstdint>
__device__ __forceinline__ int lane_opaque() { unsigned m = ~0u; asm volatile("" : "+s"(m)); return (int)__builtin_amdgcn_mbcnt_hi(m, __builtin_amdgcn_mbcnt_lo(m, 0u)); }
__device__ __forceinline__ int tid_opaque(int wv) { return wv * 64 + lane_opaque(); }
__device__ __forceinline__ int blk_opaque() { int t = blockIdx.x; asm volatile("" : "+s"(t)); return t; }
namespace pg8 {
#define PG8_LAS __attribute__((address_space(3)))
typedef unsigned short bf16_t;
typedef short bf16x8 __attribute__((ext_vector_type(8)));
typedef float f32x4 __attribute__((ext_vector_type(4)));
typedef unsigned u32x4 __attribute__((ext_vector_type(4)));
constexpr int BM = 256, BK = 64, HALF = 128, HTB = HALF * BK * 2  , STAGE_BYTES = 8 * HTB, NXCD = 8, WGM = 8;

__host__ __device__ __forceinline__ int lds_byte(int r, int c) { const int st = (r >> 4) * 2 + (c >> 5), rr = r & 15, cc = c & 31, ob = rr * 64 + cc * 2; return st * 1024 + (ob ^ (((ob >> 9) & 1) << 5)); }
__host__ __device__ __forceinline__ void stage_rc(int b, int& R, int& C) { const int st = b / 1024, sb = b % 1024, swz = sb ^ (((sb >> 9) & 1) << 5); R = (st >> 1) * 16 + swz / 64; C = (st & 1) * 32 + (swz % 64) / 2; }
__host__ __device__ __forceinline__ int perm32(int rho) { const int n = rho >> 4, i = rho & 15; return 8 * (i >> 2) + 4 * n + (i & 3); }

struct Unit { int pm, pn, seg; };
struct Gemm { const bf16_t* A; const bf16_t* Bt; int M, N, K, KT, SEGB; };

struct StaticOrder {
    int nM, nN, nwg, G, c;
    __host__ __device__ void init(int M, int N, int G_, int c_) { nM = M / BM; nN = N / BM; nwg = nM * nN; G = G_; c = c_; }
    __host__ __device__ bool next(int i, Unit& u) const {
        const long L = (long)i * G + c; if (L >= nwg) return false;
        int wgid = (int)L; { const int q = nwg / NXCD, r = nwg % NXCD, xcd = wgid % NXCD, off = wgid / NXCD; wgid = (xcd < r ? xcd * (q + 1) : r * (q + 1) + (xcd - r) * q) + off; }
        const int nig = WGM * nN, gid = wgid / nig, fm = gid * WGM, gsz = (nM - fm) < WGM ? (nM - fm) : WGM;
        u.pm = fm + ((wgid % nig) % gsz); u.pn = (wgid % nig) / gsz; u.seg = 0; return true;
    }
    __device__ __forceinline__ void a_ready(const Unit&) const {}
    __device__ __forceinline__ void done(const Unit&) const {}
};
template <int NSEG> struct SegOrder : StaticOrder {
    __host__ __device__ bool next(int i, Unit& u) const { if (!StaticOrder::next(i / NSEG, u)) return false; u.seg = i % NSEG; return true; }
};
__device__ __forceinline__ unsigned cvt_pk_bf16(float lo, float hi) { unsigned r; asm volatile("v_cvt_pk_bf16_f32 %0, %1, %2" : "=v"(r) : "v"(lo), "v"(hi)); return r; }
typedef float f32x2 __attribute__((ext_vector_type(2)));
template <class Epi, class Sched, bool ALIGN_EPI = false, bool SP2 = false>
__device__ __forceinline__ void gemm_phase(PG8_LAS unsigned char* lds, const Gemm g, const Sched& S, const Epi& E, const int wv) {
    int wvo = wv; asm volatile("" : "+s"(wvo));
    const int lane = lane_opaque(), tid = wvo * 64 + lane, wid = wvo, wr = wid >> 2, wc = wid & 3, fr = lane & 15, fq = lane >> 4;
    const int K = g.K, nt = g.KT;
    unsigned voffA[2], voffB[2];
#pragma unroll
    for (int i = 0; i < 2; ++i) { int R, C; stage_rc(tid * 16 + i * 8192, R, C); const int Rb = Epi::PERM ? ((R & ~31) + perm32(R & 31)) : R;
        voffA[i] = (unsigned)(R * K + C) * 2u; voffB[i] = (unsigned)(Rb * K + C) * 2u; }
    const size_t kstep = (size_t)(BK * 2);
    const size_t hstep = (size_t)HALF * K * 2;
    const size_t tstep = 2 * hstep;
    const unsigned ldsw = (unsigned)wid * 1024u;
    const int aoff = lds_byte(wr * 64 + fr, fq * 8), boff = lds_byte(wc * 32 + fr, fq * 8);
#define PG8_SA(b, h) (((b) * 2 + (h)) * HTB)
#define PG8_SB(b, h) ((4 + (b) * 2 + (h)) * HTB)
#define PG8_STAGE(bufoff, gbase, voff) do { _Pragma("unroll") for (int _i = 0; _i < 2; ++_i) \
        __builtin_amdgcn_global_load_lds((const unsigned*)((const char*)(gbase) + (voff)[_i]), (PG8_LAS unsigned*)(lds + (bufoff) + ldsw + _i * 8192), 16, 0, 0); } while (0)
#define PG8_LDA(dst, b, h) do { _Pragma("unroll") for (int m = 0; m < 4; ++m) _Pragma("unroll") for (int k = 0; k < 2; ++k) dst[m][k] = *(const PG8_LAS bf16x8*)(lds + PG8_SA(b, h) + aoff + m * 2048 + k * 1024); } while (0)
#define PG8_LDB(dst, b, h) do { _Pragma("unroll") for (int n = 0; n < 2; ++n) _Pragma("unroll") for (int k = 0; k < 2; ++k) dst[n][k] = *(const PG8_LAS bf16x8*)(lds + PG8_SB(b, h) + boff + n * 2048 + k * 1024); } while (0)
#define PG8_MMA(ai, bj, At, Bt) do { __builtin_amdgcn_s_setprio(1); _Pragma("unroll") for (int m = 0; m < 4; ++m) _Pragma("unroll") for (int n = 0; n < 2; ++n) _Pragma("unroll") for (int k = 0; k < 2; ++k) \
        acc[ai][bj][m][n] = __builtin_amdgcn_mfma_f32_16x16x32_bf16(Bt[n][k], At[m][k], acc[ai][bj][m][n], 0, 0, 0); __builtin_amdgcn_s_setprio(0); } while (0)
#define PG8_WAIT_V(n) asm volatile("s_waitcnt vmcnt(" #n ")" ::: "memory")
#define PG8_WAIT_L(n) asm volatile("s_waitcnt lgkmcnt(" #n ")" ::: "memory")
#define PG8_BAR __builtin_amdgcn_s_barrier()
#define PG8_SCHED __builtin_amdgcn_sched_barrier(0)
    Unit cur, nxt; int ui = 0;
    if (!S.next(0, cur)) return;
    f32x4 acc[2][2][4][2];
#pragma unroll
    for (int a = 0; a < 2; ++a)
#pragma unroll
        for (int b = 0; b < 2; ++b)
#pragma unroll
            for (int m = 0; m < 4; ++m)
#pragma unroll
                for (int n = 0; n < 2; ++n) acc[a][b][m][n] = (f32x4){0.f, 0.f, 0.f, 0.f};
    bf16x8 At[4][2], B0[2][2], B1[2][2];
    const char* cA = (const char*)g.A + (size_t)cur.pm * tstep + (size_t)cur.seg * g.SEGB; const char* cB = (const char*)g.Bt + (size_t)cur.pn * tstep + (size_t)cur.seg * g.SEGB;
    S.a_ready(cur);
    if constexpr (SP2) {
        PG8_STAGE(PG8_SB(0, 0), cB, voffB); PG8_STAGE(PG8_SB(0, 1), cB + hstep, voffB); PG8_STAGE(PG8_SA(0, 0), cA, voffA); PG8_STAGE(PG8_SA(0, 1), cA + hstep, voffA);
        if (wr == 1) PG8_BAR;
        PG8_WAIT_V(2); PG8_BAR;
        PG8_STAGE(PG8_SB(1, 0), cB + kstep, voffB); PG8_STAGE(PG8_SA(1, 0), cA + kstep, voffA); PG8_STAGE(PG8_SB(1, 1), cB + hstep + kstep, voffB);
        PG8_WAIT_V(6); PG8_BAR;
    } else {
        PG8_STAGE(PG8_SB(0, 0), cB, voffB); PG8_STAGE(PG8_SA(0, 0), cA, voffA); PG8_STAGE(PG8_SB(0, 1), cB + hstep, voffB); PG8_STAGE(PG8_SA(0, 1), cA + hstep, voffA);
        if (wr == 1) PG8_BAR;
        PG8_WAIT_V(4); PG8_BAR;
        PG8_STAGE(PG8_SB(1, 0), cB + kstep, voffB); PG8_STAGE(PG8_SA(1, 0), cA + kstep, voffA); PG8_STAGE(PG8_SB(1, 1), cB + hstep + kstep, voffB);
        PG8_WAIT_V(6); PG8_BAR;
    }
    for (;;) {
        const bool has_next = S.next(ui + 1, nxt);
        const char* nA = has_next ? (const char*)g.A + (size_t)nxt.pm * tstep + (size_t)nxt.seg * g.SEGB : cA; const char* nB = has_next ? (const char*)g.Bt + (size_t)nxt.pn * tstep + (size_t)nxt.seg * g.SEGB : cB;
        for (int t = 0; t < nt; t += 2) {
            const bool last = (t == nt - 2);
            const char* a1 = cA + (size_t)(t + 1) * kstep;
            const char* a2 = last ? nA : cA + (size_t)(t + 2) * kstep; const char* b2 = last ? nB : cB + (size_t)(t + 2) * kstep;
            const char* a3 = a2 + kstep; const char* b3 = b2 + kstep;
            if (last && has_next) S.a_ready(nxt);
            if constexpr (SP2) {
            PG8_LDB(B0, 0, 0); PG8_LDB(B1, 0, 1); PG8_SCHED; PG8_LDA(At, 0, 0); PG8_STAGE(PG8_SA(1, 1), a1 + hstep, voffA);
            PG8_WAIT_V(8); PG8_WAIT_L(0); PG8_BAR; PG8_MMA(0, 0, At, B0); PG8_MMA(0, 1, At, B1); PG8_BAR; PG8_SCHED;
            PG8_LDA(At, 0, 1); PG8_STAGE(PG8_SB(0, 0), b2, voffB); PG8_STAGE(PG8_SB(0, 1), b2 + hstep, voffB); PG8_STAGE(PG8_SA(0, 0), a2, voffA);
            PG8_WAIT_V(8); PG8_WAIT_L(0); PG8_BAR; PG8_MMA(1, 0, At, B0); PG8_MMA(1, 1, At, B1); PG8_BAR; PG8_SCHED;
            PG8_LDB(B0, 1, 0); PG8_LDB(B1, 1, 1); PG8_SCHED; PG8_LDA(At, 1, 0); PG8_STAGE(PG8_SA(0, 1), a2 + hstep, voffA);
            PG8_WAIT_V(8); PG8_WAIT_L(0); PG8_BAR; PG8_MMA(0, 0, At, B0); PG8_MMA(0, 1, At, B1); PG8_BAR; PG8_SCHED;
            PG8_LDA(At, 1, 1); PG8_STAGE(PG8_SB(1, 0), b3, voffB); PG8_STAGE(PG8_SB(1, 1), b3 + hstep, voffB); PG8_STAGE(PG8_SA(1, 0), a3, voffA);
            PG8_WAIT_V(8); PG8_WAIT_L(0); PG8_BAR; PG8_MMA(1, 0, At, B0); PG8_MMA(1, 1, At, B1); PG8_BAR; PG8_SCHED;
            } else {
            PG8_LDB(B0, 0, 0); PG8_SCHED; PG8_LDA(At, 0, 0); PG8_STAGE(PG8_SA(1, 1), a1 + hstep, voffA);
            PG8_WAIT_L(8); PG8_BAR; PG8_WAIT_L(0); PG8_MMA(0, 0, At, B0); PG8_BAR; PG8_SCHED;
            PG8_LDB(B1, 0, 1); PG8_STAGE(PG8_SB(0, 0), b2, voffB);
            PG8_BAR; PG8_WAIT_L(0); PG8_MMA(0, 1, At, B1); PG8_BAR;
            PG8_LDA(At, 0, 1); PG8_STAGE(PG8_SA(0, 0), a2, voffA);
            PG8_BAR; PG8_WAIT_L(0); PG8_MMA(1, 0, At, B0); PG8_BAR; PG8_SCHED;
            PG8_STAGE(PG8_SB(0, 1), b2 + hstep, voffB);
            PG8_WAIT_V(6); PG8_BAR; PG8_MMA(1, 1, At, B1); PG8_BAR;
            PG8_LDB(B0, 1, 0); PG8_SCHED; PG8_LDA(At, 1, 0); PG8_STAGE(PG8_SA(0, 1), a2 + hstep, voffA);
            PG8_WAIT_L(8); PG8_BAR; PG8_WAIT_L(0); PG8_MMA(0, 0, At, B0); PG8_BAR; PG8_SCHED;
            PG8_LDB(B1, 1, 1); PG8_STAGE(PG8_SB(1, 0), b3, voffB);
            PG8_BAR; PG8_WAIT_L(0); PG8_MMA(0, 1, At, B1); PG8_BAR;
            PG8_LDA(At, 1, 1); PG8_STAGE(PG8_SA(1, 0), a3, voffA);
            PG8_BAR; PG8_WAIT_L(0); PG8_MMA(1, 0, At, B0); PG8_BAR; PG8_SCHED;
            PG8_STAGE(PG8_SB(1, 1), b3 + hstep, voffB);
            PG8_WAIT_V(6); PG8_BAR; PG8_MMA(1, 1, At, B1); PG8_BAR;
            }
        }
        if constexpr (ALIGN_EPI) { if (wr == 0) PG8_BAR; }
        if constexpr (!Epi::AFTER_DRAIN) { E(acc, cur, wr, wc, fr, fq); S.done(cur); }
        if (!has_next) break;
        if (!(Epi::KEEP_ACC && nxt.seg != 0)) {
#pragma unroll
        for (int a = 0; a < 2; ++a)
#pragma unroll
            for (int b = 0; b < 2; ++b)
#pragma unroll
                for (int m = 0; m < 4; ++m)
#pragma unroll
                    for (int n = 0; n < 2; ++n) acc[a][b][m][n] = (f32x4){0.f, 0.f, 0.f, 0.f}; }
        cur = nxt; cA = nA; cB = nB; ++ui;
        if constexpr (ALIGN_EPI) { if (wr == 1) PG8_BAR; }
    }
    PG8_WAIT_V(0);
    if constexpr (!ALIGN_EPI) { if (wr == 0) PG8_BAR; }
    PG8_BAR;
    if constexpr (Epi::AFTER_DRAIN) { E.fused(acc, cur, wr, wc, fr, fq, lds, wid, lane); S.done(cur); }
#undef PG8_SA
#undef PG8_SB
#undef PG8_STAGE
#undef PG8_LDA
#undef PG8_LDB
#undef PG8_MMA
#undef PG8_WAIT_V
#undef PG8_WAIT_L
#undef PG8_BAR
#undef PG8_SCHED
}
}

constexpr int DM = 2048, NBATCH = 4, SEQ = 2048, DEPTH = 2, DBATCH = 8, DSEQ = 4, PAST = 16384, PAGE = 128;
constexpr int TP = NBATCH * SEQ;
constexpr int TS = DBATCH * DSEQ;
constexpr int TT = TP + TS;
constexpr int MP = 8448;
constexpr int NPAGES = PAST / PAGE;
constexpr int NPOOL = 1280;
constexpr int POOLW = 512, DNC = 1536, SBW = 512, SSI = 1024, SSC = 1536, DFF = 8192;
constexpr int INCOLS = 14872, NIN = 15104;
constexpr int OBW = 2560;
constexpr int UFW = 5376;
constexpr int UF_POOL = 0, UF_DNQKV = 512, UF_DNZ = 2048, UF_SSZ = 2560, UF_XBC = 3584, UF_SMALL = 5120;
constexpr float RMS_EPS = 1e-6f;
constexpr float LOG2E = 1.4426950408889634f;
constexpr int NWAVES = 8, NTHR = 512;

constexpr size_t O_Y = 0;
constexpr size_t O_KP = O_Y + (size_t)TT * DM;
constexpr size_t O_VP = O_KP + (size_t)DEPTH * TP * 512;
constexpr size_t O_POOLP = O_VP + (size_t)DEPTH * TP * 512;
constexpr size_t O_DNCP = O_POOLP + (size_t)DEPTH * NBATCH * 15 * 512;
constexpr size_t O_DNSP = O_DNCP + (size_t)DEPTH * NBATCH * 3 * 1536;
constexpr size_t O_SSCP = O_DNSP + (size_t)DEPTH * NBATCH * 4 * 128 * 128;
constexpr size_t O_SSHP = O_SSCP + (size_t)DEPTH * NBATCH * 3 * 1536;
constexpr size_t O_KS = O_SSHP + (size_t)DEPTH * NBATCH * 16 * 64 * 128;
constexpr size_t O_VS = O_KS + (size_t)DEPTH * TS * 512;
constexpr size_t O_POOLS = O_VS + (size_t)DEPTH * TS * 512;
constexpr size_t O_DNCS = O_POOLS + (size_t)DEPTH * DBATCH * 15 * 512;
constexpr size_t O_DNSS = O_DNCS + (size_t)DEPTH * DBATCH * 3 * 1536;
constexpr size_t O_SSCS = O_DNSS + (size_t)DEPTH * DBATCH * 4 * 128 * 128;
constexpr size_t O_SSHS = O_SSCS + (size_t)DEPTH * DBATCH * 3 * 1536;
constexpr size_t O_END = O_SSHS + (size_t)DEPTH * DBATCH * 16 * 64 * 128;

constexpr size_t al256(size_t x) { return (x + 255) & ~(size_t)255; }
constexpr size_t WS_CTL = 0, CTL_BYTES = 1u << 20, CTL_ZERO = 1u << 17;
constexpr size_t SZ_WIN = (size_t)NIN * DM * 2, SZ_WBR = (size_t)5 * DM * 512 * 2, SZ_WOUT = (size_t)DM * DM * 2, SZ_WUP = (size_t)DFF * DM * 2, SZ_WDN = (size_t)DM * DFF * 2;
constexpr size_t WS_WIN = WS_CTL + CTL_BYTES;
constexpr size_t WS_WBR = WS_WIN + 2 * SZ_WIN;
constexpr size_t WS_WOUT = WS_WBR + 2 * SZ_WBR;
constexpr size_t WS_WUP = WS_WOUT + 2 * SZ_WOUT;
constexpr size_t WS_WDN = WS_WUP + 2 * SZ_WUP;
constexpr size_t WS_H = WS_WDN + 2 * SZ_WDN;
constexpr size_t WS_UF = WS_H + (size_t)MP * DM * 2;
constexpr size_t WS_QKV = WS_UF + (size_t)MP * UFW * 4;
constexpr size_t WS_GATE = WS_QKV + (size_t)MP * 1536 * 2;
constexpr size_t WS_DNQ = WS_GATE + (size_t)MP * 8192 * 2;
constexpr size_t WS_XBC = WS_DNQ + (size_t)MP * 1536 * 4;
constexpr size_t WS_SCAL = WS_XBC + (size_t)MP * 1536 * 4;
constexpr size_t WS_OBR = WS_SCAL + (size_t)MP * 32 * 4;
constexpr size_t SZ_OBR = (size_t)MP * 512 * 2;
constexpr size_t WS_SSQ = WS_OBR + 5 * SZ_OBR;
constexpr size_t WS_MG32 = WS_SSQ + (size_t)MP * 32 * 4;
constexpr size_t WS_MGB = WS_MG32 + (size_t)MP * DM * 4;
constexpr size_t WS_MIX = WS_MGB + (size_t)MP * DM * 2;
constexpr size_t WS_F = WS_MIX + (size_t)MP * DM * 4;
constexpr size_t WS_FD = WS_F + (size_t)MP * DFF * 2;
constexpr size_t WS_PART = WS_FD + (size_t)MP * DM * 4;
constexpr size_t WS_PR = WS_PART + (size_t)256 * 2048 * 4;
constexpr size_t WS_DNU = WS_PR + (size_t)256 * 16 * 4;
constexpr size_t WS_SSU = WS_DNU + (size_t)512 * 90368;
constexpr size_t WS_SSG = WS_SSU + (size_t)2048 * 16896;
constexpr size_t WS_MGS = WS_SSG + (size_t)256 * 49152;
constexpr size_t WS_OUTS = WS_MGS + (size_t)5 * TS * DM * 4;
constexpr size_t WS_UPS = WS_OUTS + (size_t)16 * TS * DM * 4;
constexpr size_t WS_DNS = WS_UPS + (size_t)4 * TS * DFF * 4;
constexpr size_t WS_RS = WS_DNS + (size_t)16 * TS * DM * 4;
constexpr size_t WS_DNSV = WS_RS + (size_t)MP * 2 * 4;
constexpr size_t WS_END = WS_DNSV + (size_t)512 * 49152;
static_assert(WS_WIN % 256 == 0 && WS_H % 256 == 0 && WS_UF % 256 == 0 && WS_OBR % 256 == 0 && WS_MG32 % 256 == 0 && WS_PART % 256 == 0, "ws alignment");

constexpr int CW_QUEUE = 64;
constexpr int CW_BAR = 4096;

constexpr int LDS_BYTES = 147456;
constexpr int RING_BYTES = 131072;
constexpr int MISC_OFF = RING_BYTES;

#define GAS __attribute__((address_space(1)))
#define LAS __attribute__((address_space(3)))
typedef unsigned short bf16;
typedef unsigned v4u __attribute__((ext_vector_type(4)));
typedef unsigned v2u __attribute__((ext_vector_type(2)));
typedef float f32x4 __attribute__((ext_vector_type(4)));
typedef float f32x2 __attribute__((ext_vector_type(2)));
typedef float f32x16 __attribute__((ext_vector_type(16)));
typedef short bf16x8 __attribute__((ext_vector_type(8)));
typedef __bf16 bf16x2_t __attribute__((ext_vector_type(2)));
__device__ __forceinline__ unsigned pk2(float lo, float hi) { const f32x2 v = {lo, hi}; return __builtin_bit_cast(unsigned, __builtin_convertvector(v, bf16x2_t)); }
__device__ __forceinline__ unsigned f2bf(float f) { return pk2(f, f) & 0xffffu; }
__device__ __forceinline__ float bflo(unsigned w) { return __builtin_bit_cast(float, w << 16); }
__device__ __forceinline__ float bfhi(unsigned w) { return __builtin_bit_cast(float, w & 0xffff0000u); }
__device__ __forceinline__ float row16_sum(float x) {
    x += __builtin_bit_cast(float, __builtin_amdgcn_update_dpp(0, __builtin_bit_cast(int, x), 0x128, 0xf, 0xf, false));
    x += __builtin_bit_cast(float, __builtin_amdgcn_update_dpp(0, __builtin_bit_cast(int, x), 0x124, 0xf, 0xf, false));
    x += __builtin_bit_cast(float, __builtin_amdgcn_update_dpp(0, __builtin_bit_cast(int, x), 0x122, 0xf, 0xf, false));
    x += __builtin_bit_cast(float, __builtin_amdgcn_update_dpp(0, __builtin_bit_cast(int, x), 0x121, 0xf, 0xf, false));
    return x;
}
__device__ __forceinline__ float rdlane(float x, int l) { return __builtin_bit_cast(float, __builtin_amdgcn_readlane(__builtin_bit_cast(int, x), l)); }
__device__ __forceinline__ float wave_sum(float v) { const float r = row16_sum(v); return (rdlane(r, 0) + rdlane(r, 16)) + (rdlane(r, 32) + rdlane(r, 48)); }
__device__ __forceinline__ float wave_scan(float x, int lane) {
    x += __builtin_bit_cast(float, __builtin_amdgcn_update_dpp(0, __builtin_bit_cast(int, x), 0x111, 0xf, 0xf, true));
    x += __builtin_bit_cast(float, __builtin_amdgcn_update_dpp(0, __builtin_bit_cast(int, x), 0x112, 0xf, 0xf, true));
    x += __builtin_bit_cast(float, __builtin_amdgcn_update_dpp(0, __builtin_bit_cast(int, x), 0x114, 0xf, 0xf, true));
    x += __builtin_bit_cast(float, __builtin_amdgcn_update_dpp(0, __builtin_bit_cast(int, x), 0x118, 0xf, 0xf, true));
    const float t0 = rdlane(x, 15), t1 = rdlane(x, 31), t2 = rdlane(x, 47);
    return x + (lane >= 48 ? (t0 + t1) + t2 : (lane >= 32 ? t0 + t1 : (lane >= 16 ? t0 : 0.f)));
}
__device__ __forceinline__ float fexp(float x) { return __builtin_amdgcn_exp2f(x * 1.4426950408889634f); }
__device__ __forceinline__ float sigmoidf_(float x) { return 1.0f / (1.0f + __expf(-x)); }
__device__ __forceinline__ float siluf_(float x) { return x / (1.0f + __expf(-x)); }
__device__ __forceinline__ float softplusf_(float x) { const float e = fexp(fminf(x, 20.f)); const float l = e < 0.01f ? e * (1.0f - e * (0.5f - e * 0.33333333f)) : __builtin_amdgcn_logf(1.0f + e) * 0.6931471805599453f; return x > 20.f ? x : l; }
__device__ __forceinline__ float ex2(float x) { return __builtin_amdgcn_exp2f(x); }
__device__ __forceinline__ float lg2(float x) { return __builtin_amdgcn_logf(x); }
#define XB_TMO      128
#define XB_XCNT(j)  (256  + 64 * (j))
#define XB_XSUB(j)  (1280 + 64 * (j))
#define XB_XGEN(j)  (2304 + 64 * (j))
#define XB_TOP      3328
#define XB_TOPGEN   3392
#define XCD_BAR_WORDS 3456
#define XB_SPIN_CAP (1u << 18)

__device__ __forceinline__ unsigned xb_ld(unsigned* p)              { return __hip_atomic_load(p, __ATOMIC_RELAXED, __HIP_MEMORY_SCOPE_AGENT); }
__device__ __forceinline__ unsigned xb_add(unsigned* p, unsigned v) { return __hip_atomic_fetch_add(p, v, __ATOMIC_RELAXED, __HIP_MEMORY_SCOPE_AGENT); }
__device__ __forceinline__ unsigned xb_xcc_id() { return (unsigned)__builtin_amdgcn_s_getreg((3 << 11) | 20) & 0xFu; }
#define XB_SPIN(cond, bar) do { unsigned _sp = 0; while (cond) { __builtin_amdgcn_s_sleep(1); \
    if ((++_sp & 255u) == 0u) { if (xb_ld(&(bar)[XB_TMO])) break; if (_sp > XB_SPIN_CAP) { atomicAdd(&(bar)[XB_TMO], 1u); break; } } } } while (0)

struct XcdBarrier {
    unsigned* bar; unsigned x;
    volatile LAS unsigned* st;
};

__device__ __forceinline__ XcdBarrier xcd_barrier_post(unsigned* bar, volatile LAS unsigned* st, const int tid) {
    XcdBarrier b; b.bar = bar; b.x = xb_xcc_id(); b.st = st;
    if (tid == 0) (void)xb_add(&bar[XB_XCNT(b.x)], 1u);
    return b;
}
__device__ __forceinline__ void xcd_barrier_complete(unsigned* bar, unsigned x, unsigned& nloc, unsigned& nx) {
    const unsigned G = gridDim.x * gridDim.y * gridDim.z;
    unsigned sum, cnt, mine, sp = 0u;
    for (;;) {
        sum = 0u; cnt = 0u; mine = 0u;
#pragma unroll
        for (unsigned j = 0; j < 16; ++j) { const unsigned c = xb_ld(&bar[XB_XCNT(j)]); sum += c; cnt += (c > 0u) ? 1u : 0u; mine = (j == x) ? c : mine; }
        if (sum == G) break;
        __builtin_amdgcn_s_sleep(1);
        if ((++sp & 255u) == 0u) { if (xb_ld(&bar[XB_TMO])) break; if (sp > XB_SPIN_CAP) { atomicAdd(&bar[XB_TMO], 1u); break; } }
    }
    nloc = mine > 0u ? mine : 1u; nx = cnt > 0u ? cnt : 1u;
}

__device__ __forceinline__ void xcd_barrier(const XcdBarrier& b, const int tid) {
    asm volatile("s_waitcnt vmcnt(0)" ::: "memory");
    __syncthreads();
    if (tid == 0) {
        unsigned* bar = b.bar;
        __builtin_amdgcn_s_waitcnt(0);
        unsigned nloc = b.st[0], nx = b.st[1];
        if (nloc == 0u) { xcd_barrier_complete(bar, b.x, nloc, nx); b.st[0] = nloc; b.st[1] = nx; }
        const unsigned old = xb_add(&bar[XB_XSUB(b.x)], 1u);
        const unsigned gen = old / nloc;
        if (old + 1u == (gen + 1u) * nloc) {
            __builtin_amdgcn_fence(__ATOMIC_RELEASE, "agent");
            asm volatile("s_waitcnt vmcnt(0)" ::: "memory");
            const unsigned og = xb_add(&bar[XB_TOP], 1u);
            const unsigned tg = og / nx;
            if (og + 1u == (tg + 1u) * nx) xb_add(&bar[XB_TOPGEN], 1u);
            else XB_SPIN(xb_ld(&bar[XB_TOPGEN]) == tg, bar);
            __builtin_amdgcn_fence(__ATOMIC_ACQUIRE, "agent");
            xb_add(&bar[XB_XGEN(b.x)], 1u);
            asm volatile("s_waitcnt vmcnt(0)" ::: "memory");
        } else {
            XB_SPIN(xb_ld(&bar[XB_XGEN(b.x)]) == gen, bar);
            __builtin_amdgcn_fence(__ATOMIC_ACQUIRE, "agent");
            asm volatile("s_waitcnt vmcnt(0)" ::: "memory");
        }
    }
    __syncthreads();
}

enum { I_XP = 0, I_XS, I_CK, I_CV, I_SPOOL, I_SDNC, I_SDNS, I_SSSC, I_SSSH, I_PT, I_NMPRE, I_NMPOST, I_NLPRE, I_NLPOST, I_WIN, I_POOLW, I_POOLSC, I_DNCW, I_DNALOG, I_DNDTB, I_DNNW, I_SBBIAS,
       I_SSCW, I_SSCB, I_SSALOG, I_SSDTB, I_SSD, I_SSNW, I_WBR, I_WOUT, I_WUP, I_WDN, N_IN };
struct Args { const void* in[N_IN]; float* out; unsigned char* ws; int ph_lo, ph_hi, li, pad; };
#define IN_F(i) ((const float*)A->in[i])
#define WSP(T, off) ((T*)(A->ws + (off)))
typedef const __attribute__((opencl_constant)) Args* CA;
__device__ __forceinline__ CA args_opaque() { auto p = __builtin_amdgcn_kernarg_segment_ptr(); asm volatile("" : "+s"(p)); return (CA)p; }

struct EpiIn {
    static constexpr bool PERM = true, AFTER_DRAIN = false, KEEP_ACC = false;
    float* UF; bf16* QKV; bf16* GATE; float *kp, *vp, *ks, *vs; float qscale;
    __device__ __forceinline__ void operator()(f32x4 (&acc)[2][2][4][2], const pg8::Unit& u, int wr, int wc, int fr, int fq) const {
        const int pn = u.pn, row0 = u.pm * 256 + wr * 64 + fr, cl = wc * 32 + 8 * fq;
        if (pn < 10 || (pn >= 16 && pn < 26) || pn == 58) {
            const int col0 = pn * 256 + (pn < 10 ? 0 : (pn < 26 ? -1536 : -9728)) + cl;
#pragma unroll
            for (int ai = 0; ai < 2; ++ai)
#pragma unroll
                for (int m = 0; m < 4; ++m) { float* rowp = UF + (size_t)(row0 + ai * 128 + m * 16) * UFW + col0;
#pragma unroll
                    for (int bj = 0; bj < 2; ++bj) { *(f32x4*)(rowp + bj * 128) = acc[ai][bj][m][0]; *(f32x4*)(rowp + bj * 128 + 4) = acc[ai][bj][m][1]; } }
        } else if (pn < 16) {
            const int which = (pn - 10) >> 1, c512 = ((pn - 10) & 1) * 256 + cl; const float sc = which == 0 ? qscale : 1.f;
#pragma unroll
            for (int ai = 0; ai < 2; ++ai)
#pragma unroll
                for (int m = 0; m < 4; ++m) { const int r = row0 + ai * 128 + m * 16; bf16* rowp = QKV + (size_t)r * 1536 + which * 512 + c512;
                    float* fo = nullptr;
                    if (which) { if (r < TP) fo = (which == 1 ? kp : vp) + (size_t)r * 512 + c512; else if (r < TT) fo = (which == 1 ? ks : vs) + (size_t)(r - TP) * 512 + c512; }
#pragma unroll
                    for (int bj = 0; bj < 2; ++bj) { const f32x4 v0 = acc[ai][bj][m][0], v1 = acc[ai][bj][m][1];
                        v4u w; w.x = pk2(v0[0] * sc, v0[1] * sc); w.y = pk2(v0[2] * sc, v0[3] * sc); w.z = pk2(v1[0] * sc, v1[1] * sc); w.w = pk2(v1[2] * sc, v1[3] * sc);
                        *(v4u*)(rowp + bj * 128) = w;
                        if (fo) { *(f32x4*)(fo + bj * 128) = v0; *(f32x4*)(fo + bj * 128 + 4) = v1; } } }
        } else {
            const int oc = (pn - 26) * 64 + wc * 16 + 4 * fq;
#pragma unroll
            for (int ai = 0; ai < 2; ++ai)
#pragma unroll
                for (int m = 0; m < 4; ++m) { const int r = row0 + ai * 128 + m * 16; bf16* rowp = GATE + (size_t)r * 8192 + oc;
                    f32x4 t[4];
#pragma unroll
                    for (int i = 0; i < 4; ++i)
#pragma unroll
                        for (int e = 0; e < 4; ++e) t[i][e] = 1.0f + fexp(-fminf(fmaxf(acc[ai][i >> 1][m][i & 1][e], -30.f), 30.f));
                    f32x4 o[4];
                    if (r < TP) {
#pragma unroll
                        for (int e = 0; e < 4; ++e) { const float i0 = __builtin_amdgcn_rcpf(t[0][e]), i1 = __builtin_amdgcn_rcpf(t[1][e]), i2 = __builtin_amdgcn_rcpf(t[2][e]), i3 = __builtin_amdgcn_rcpf(t[3][e]);
                            o[0][e] = t[1][e] * i0; o[1][e] = t[2][e] * i1; o[2][e] = t[3][e] * i2; o[3][e] = i3; }
                    } else {
#pragma unroll
                        for (int i = 0; i < 4; ++i)
#pragma unroll
                            for (int e = 0; e < 4; ++e) o[i][e] = __builtin_amdgcn_rcpf(t[i][e]);
                    }
#pragma unroll
                    for (int i = 0; i < 4; ++i) { v2u w; w.x = pk2(o[i][0], o[i][1]); w.y = pk2(o[i][2], o[i][3]); *(v2u*)(rowp + i * 2048) = w; } }
        }
    }
};
struct EpiMergeR {
    static constexpr bool PERM = true, AFTER_DRAIN = false, KEEP_ACC = true;
    const bf16* GATE; const float* RS; bf16* MGB;
    __device__ __forceinline__ void operator()(f32x4 (&acc)[2][2][4][2], const pg8::Unit& u, int wr, int wc, int fr, int fq) const {
        const unsigned row0 = (unsigned)(u.pm * 256 + wr * 64 + fr), col0 = (unsigned)(u.pn * 256 + wc * 32 + 8 * fq); const int seg = u.seg;
        const unsigned gofs = row0 * 8192u + (seg < 3 ? seg : 3) * 2048u + col0, oofs = row0 * 2048u + col0; const bool last = seg == 4;
        const float w2 = seg == 2 ? 1.f : 0.f, w3 = seg == 3 ? 1.f : 0.f, w4 = last ? 1.f : 0.f, w0 = 1.f - w2 - w3 - w4, ug = 1.f - w3;
#pragma unroll
        for (int ai = 0; ai < 2; ++ai)
#pragma unroll
            for (int m = 0; m < 4; ++m) { const unsigned rr = ai * 128 + m * 16; const f32x2 qq = *(const f32x2*)(RS + (row0 + rr) * 2u);
                const float r1 = __builtin_amdgcn_rsqf(qq[1]), rf = w0 + w2 * __builtin_amdgcn_sqrtf(qq[0]) + w3 * (__builtin_amdgcn_sqrtf(qq[1]) * __builtin_amdgcn_rsqf(qq[0])) + w4 * r1, rg = rf * ug, rc = rf * w3;
#pragma unroll
                for (int bj = 0; bj < 2; ++bj) { const v4u gg = *(const v4u*)(GATE + (gofs + rr * 8192u + bj * 128u));
                    f32x4& v0 = acc[ai][bj][m][0]; f32x4& v1 = acc[ai][bj][m][1];
                    v0[0] *= bflo(gg.x) * rg + rc; v0[1] *= bfhi(gg.x) * rg + rc; v0[2] *= bflo(gg.y) * rg + rc; v0[3] *= bfhi(gg.y) * rg + rc;
                    v1[0] *= bflo(gg.z) * rg + rc; v1[1] *= bfhi(gg.z) * rg + rc; v1[2] *= bflo(gg.w) * rg + rc; v1[3] *= bfhi(gg.w) * rg + rc;
                    if (last) { v4u w; w.x = pk2(v0[0], v0[1]); w.y = pk2(v0[2], v0[3]); w.z = pk2(v1[0], v1[1]); w.w = pk2(v1[2], v1[3]); *(v4u*)(MGB + (oofs + rr * 2048u + bj * 128u)) = w; } }
                asm volatile("" ::: "memory"); }
    }
};
struct EpiF32 {
    static constexpr bool PERM = true, AFTER_DRAIN = false, KEEP_ACC = false;
    float* C; int ldc;
    __device__ __forceinline__ void operator()(f32x4 (&acc)[2][2][4][2], const pg8::Unit& u, int wr, int wc, int fr, int fq) const {
        const int row0 = u.pm * 256 + wr * 64 + fr, col0 = u.pn * 256 + wc * 32 + 8 * fq;
#pragma unroll
        for (int ai = 0; ai < 2; ++ai)
#pragma unroll
            for (int m = 0; m < 4; ++m) { float* rowp = C + (size_t)(row0 + ai * 128 + m * 16) * ldc + col0;
#pragma unroll
                for (int bj = 0; bj < 2; ++bj) { *(f32x4*)(rowp + bj * 128) = acc[ai][bj][m][0]; *(f32x4*)(rowp + bj * 128 + 4) = acc[ai][bj][m][1]; } }
    }
};
struct EpiRelu2 {
    static constexpr bool PERM = true, AFTER_DRAIN = false, KEEP_ACC = false;
    bf16* O; int ldc;
    __device__ __forceinline__ void operator()(f32x4 (&acc)[2][2][4][2], const pg8::Unit& u, int wr, int wc, int fr, int fq) const {
        const int row0 = u.pm * 256 + wr * 64 + fr, col0 = u.pn * 256 + wc * 32 + 8 * fq;
#pragma unroll
        for (int ai = 0; ai < 2; ++ai)
#pragma unroll
            for (int m = 0; m < 4; ++m) { bf16* rowp = O + (size_t)(row0 + ai * 128 + m * 16) * ldc + col0;
#pragma unroll
                for (int bj = 0; bj < 2; ++bj) { f32x4 v0 = acc[ai][bj][m][0], v1 = acc[ai][bj][m][1];
#pragma unroll
                    for (int e = 0; e < 4; ++e) { const float a = fmaxf(v0[e], 0.f), b = fmaxf(v1[e], 0.f); v0[e] = a * a; v1[e] = b * b; }
                    v4u w; w.x = pk2(v0[0], v0[1]); w.y = pk2(v0[2], v0[3]); w.z = pk2(v1[0], v1[1]); w.w = pk2(v1[2], v1[3]); *(v4u*)(rowp + bj * 128) = w; } }
    }
};

__device__ __forceinline__ int win_src_col(int n) {
    if (n < 2560) return n;
    if (n < 6656) return n + 8;
    if (n < 14848) { const int t = n - 6656, pg = t >> 8, c = t & 255;
        return 6680 + (2 * (c >> 7) + ((c >> 2) & 1)) * 2048 + 64 * pg + 16 * ((c >> 5) & 3) + 4 * ((c >> 3) & 3) + (c & 3); }
    if (n < 14856) return n - 14848 + 2560;
    if (n < 14872) return n - 14856 + 6664;
    return -1;
}
template <int MODE>
__device__ __forceinline__ void transpose_item(const float* W, int ldw, int K, bf16* WT, int n0, int k0, const float* kscale, LAS unsigned* scr, int lane) {
    const int kq = lane >> 4, n4 = (lane & 15) * 4; const int sc = MODE ? win_src_col(n0 + n4) : n0 + n4;
#pragma unroll
    for (int i = 0; i < 8; ++i) { const int k = k0 + 8 * i + 2 * kq; f32x4 a = {0.f, 0.f, 0.f, 0.f}, b = {0.f, 0.f, 0.f, 0.f};
        if (sc >= 0) { a = *(const f32x4*)(W + (size_t)k * ldw + sc); b = *(const f32x4*)(W + (size_t)(k + 1) * ldw + sc); }
        if (kscale) { a = a * kscale[k]; b = b * kscale[k + 1]; }
        v4u w; w.x = pk2(a[0], b[0]); w.y = pk2(a[1], b[1]); w.z = pk2(a[2], b[2]); w.w = pk2(a[3], b[3]);
        *(LAS v4u*)(scr + (4 * i + kq) * 68 + n4) = w; }
    asm volatile("s_waitcnt lgkmcnt(0)" ::: "memory");
    const int part = lane & 7;
#pragma unroll
    for (int j = 0; j < 8; ++j) { const int nn = 8 * j + (lane >> 3); const LAS unsigned* s = scr + (4 * part) * 68 + nn;
        v4u o; o.x = s[0]; o.y = s[68]; o.z = s[136]; o.w = s[204];
        *(v4u*)(WT + (size_t)(n0 + nn) * K + k0 + 8 * part) = o; }
    asm volatile("s_waitcnt lgkmcnt(0)" ::: "memory");
}
__device__ __forceinline__ void p0_prologue(CA A, LAS unsigned char* lds, const int wv) {
    const int tid = tid_opaque(wv), lane = tid & 63, wave = tid >> 6, G = gridDim.x;
    LAS unsigned* scr = (LAS unsigned*)(lds + wave * 8704);
    const int gw = blk_opaque() * NWAVES + wave, NGW = G * NWAVES;
    constexpr int I_IN = (NIN / 64) * (DM / 64), I_BR = (DM / 64) * (512 / 64), I_OUT = (DM / 64) * (DM / 64), I_UP = (DFF / 64) * (DM / 64), I_DN = (DM / 64) * (DFF / 64);
    constexpr int PER_LAYER = I_IN + 4 * I_BR + I_OUT + I_UP + I_DN;
    for (int it = gw; it < 2 * PER_LAYER; it += NGW) {
        const int L = it / PER_LAYER; int r = it % PER_LAYER;
        if (r < I_IN) { const int nb = r % (NIN / 64), kb = r / (NIN / 64);
            transpose_item<1>(IN_F(I_WIN) + (size_t)L * DM * INCOLS, INCOLS, DM, WSP(bf16, WS_WIN) + (size_t)L * NIN * DM, nb * 64, kb * 64, nullptr, scr, lane); continue; }
        r -= I_IN;
        if (r < 4 * I_BR) { const int s = 1 + r / I_BR, q = r % I_BR, nb = q % (DM / 64), kb = q / (DM / 64);
            transpose_item<0>(IN_F(I_WBR) + ((size_t)L * 2560 + 512 * s) * DM, DM, OBW, WSP(bf16, WS_WBR) + (size_t)L * DM * OBW + 512 * s, nb * 64, kb * 64,
                              s >= 3 ? IN_F(I_SSNW) + L * 1024 + (s - 3) * 512 : nullptr, scr, lane); continue; }
        r -= 4 * I_BR;
        if (r < I_OUT) { const int nb = r % (DM / 64), kb = r / (DM / 64);
            transpose_item<0>(IN_F(I_WOUT) + (size_t)L * DM * DM, DM, DM, WSP(bf16, WS_WOUT) + (size_t)L * DM * DM, nb * 64, kb * 64, nullptr, scr, lane); continue; }
        r -= I_OUT;
        if (r < I_UP) { const int nb = r % (DFF / 64), kb = r / (DFF / 64);
            transpose_item<0>(IN_F(I_WUP) + (size_t)L * DM * DFF, DFF, DM, WSP(bf16, WS_WUP) + (size_t)L * DFF * DM, nb * 64, kb * 64, nullptr, scr, lane); continue; }
        r -= I_UP;
        { const int nb = r % (DM / 64), kb = r / (DM / 64);
            transpose_item<0>(IN_F(I_WDN) + (size_t)L * DFF * DM, DM, DFF, WSP(bf16, WS_WDN) + (size_t)L * DM * DFF, nb * 64, kb * 64, nullptr, scr, lane); }
    }
    for (int idx = blk_opaque() * NTHR + tid; idx < 2 * DM * 64; idx += G * NTHR) {
        const int L = idx / (DM * 64), q = idx % (DM * 64), n = q & (DM - 1), kc = q >> 11, k0 = kc * 8, g = k0 >> 7, c0 = k0 & 127;
        const float* pw = IN_F(I_POOLW) + ((size_t)(L * 4 + g) * 128 + c0) * 128; const float* psc = IN_F(I_POOLSC) + L * 512 + g * 128;
        const float* wb = IN_F(I_WBR) + ((size_t)L * 2560 + g * 128) * DM + n;
        float acc[8] = {0.f, 0.f, 0.f, 0.f, 0.f, 0.f, 0.f, 0.f};
        for (int d = 0; d < 128; ++d) { const float wv = wb[(size_t)d * DM] * psc[d];
#pragma unroll
            for (int i = 0; i < 8; ++i) acc[i] += pw[i * 128 + d] * wv; }
        v4u o; o.x = pk2(acc[0], acc[1]); o.y = pk2(acc[2], acc[3]); o.z = pk2(acc[4], acc[5]); o.w = pk2(acc[6], acc[7]);
        *(v4u*)(WSP(bf16, WS_WBR) + (size_t)L * DM * OBW + (size_t)n * OBW + k0) = o;
    }
}

__device__ __forceinline__ const float* xin_row(CA A, int m) { return m < TP ? IN_F(I_XP) + (size_t)m * DM : IN_F(I_XS) + (size_t)(m - TP) * DM; }
__device__ __forceinline__ void store_bf16_row(bf16* orow, const f32x4 (&v)[8], float rstd, const float* g, int lane) {
#pragma unroll
    for (int j = 0; j < 8; ++j) { const f32x4 gj = ((const f32x4*)g)[lane + 64 * j]; const f32x4 o = v[j] * rstd * gj;
        v2u w; w.x = pk2(o[0], o[1]); w.y = pk2(o[2], o[3]); ((v2u*)orow)[lane + 64 * j] = w; }
}
__device__ __forceinline__ void norm1_phase(CA A, const int wv) {
    const int tid = tid_opaque(wv), lane = tid & 63, gw = blk_opaque() * NWAVES + (tid >> 6), NGW = gridDim.x * NWAVES;
    bf16* H = WSP(bf16, WS_H);
    for (int m = gw; m < MP; m += NGW) {
        if (m >= TT) { for (int j = 0; j < 8; ++j) ((v2u*)(H + (size_t)m * DM))[lane + 64 * j] = (v2u){0u, 0u}; continue; }
        const f32x4* xr = (const f32x4*)xin_row(A, m); f32x4 v[8]; float s = 0.f;
#pragma unroll
        for (int j = 0; j < 8; ++j) { v[j] = xr[lane + 64 * j]; s += (v[j][0] * v[j][0] + v[j][1] * v[j][1]) + (v[j][2] * v[j][2] + v[j][3] * v[j][3]); }
        const float rstd = 1.0f / sqrtf(wave_sum(s) * (1.0f / DM) + RMS_EPS);
        store_bf16_row(H + (size_t)m * DM, v, rstd, IN_F(I_NMPRE), lane);
    }
}
__device__ __forceinline__ void resid_load(CA A, const float* Y, const float* PS, bool from_input, int m, int lane, f32x4 (&v)[8], f32x4 (&x)[8]) {
    const f32x4* xr = from_input ? (const f32x4*)xin_row(A, m) : (const f32x4*)(A->out + O_Y + (size_t)m * DM);
#pragma unroll
    for (int j = 0; j < 8; ++j) x[j] = xr[lane + 64 * j];
    if (m < TP) { const f32x4* yr = (const f32x4*)(Y + (size_t)m * DM);
#pragma unroll
        for (int j = 0; j < 8; ++j) v[j] = yr[lane + 64 * j];
    } else {
#pragma unroll
        for (int j = 0; j < 8; ++j) v[j] = (f32x4){0.f, 0.f, 0.f, 0.f};
        for (int sp = 0; sp < 16; ++sp) { const f32x4* pr = (const f32x4*)(PS + ((size_t)sp * TS + (m - TP)) * DM);
#pragma unroll
            for (int j = 0; j < 8; ++j) v[j] += pr[lane + 64 * j]; }
    }
}
__device__ __forceinline__ void resid_phase(CA A, const float* Y, const float* PS, const float* gpost, const float* gnext, bool from_input, const int wv) {
    const int tid = tid_opaque(wv), lane = tid & 63, gw = blk_opaque() * NWAVES + (tid >> 6), NGW = gridDim.x * NWAVES;
    bf16* H = WSP(bf16, WS_H);
    f32x4 v[8], x[8], vn[8], xn[8];
    int m = gw; if (m < TP) resid_load(A, Y, PS, from_input, m, lane, v, x);
    while (m < TT) {
        int mnext = m + NGW; if (m < TP && mnext >= TP) mnext = (gw < TS) ? TP + gw : TT;
        else if (m >= TP) mnext = TT;
        if (mnext < TT) resid_load(A, Y, PS, from_input, mnext, lane, vn, xn);
        float s = 0.f;
#pragma unroll
        for (int j = 0; j < 8; ++j) s += (v[j][0] * v[j][0] + v[j][1] * v[j][1]) + (v[j][2] * v[j][2] + v[j][3] * v[j][3]);
        const float rstd = __builtin_amdgcn_rsqf(wave_sum(s) * (1.0f / DM) + RMS_EPS); float s2 = 0.f;
        f32x4* orow = (f32x4*)(A->out + O_Y + (size_t)m * DM);
#pragma unroll
        for (int j = 0; j < 8; ++j) { const f32x4 gj = ((const f32x4*)gpost)[lane + 64 * j]; v[j] = x[j] + v[j] * rstd * gj; orow[lane + 64 * j] = v[j];
            s2 += (v[j][0] * v[j][0] + v[j][1] * v[j][1]) + (v[j][2] * v[j][2] + v[j][3] * v[j][3]); }
        if (gnext) { const float rstd2 = __builtin_amdgcn_rsqf(wave_sum(s2) * (1.0f / DM) + RMS_EPS); store_bf16_row(H + (size_t)m * DM, v, rstd2, gnext, lane); }
#pragma unroll
        for (int j = 0; j < 8; ++j) { v[j] = vn[j]; x[j] = xn[j]; }
        m = mnext;
    }
}

__device__ __forceinline__ float conv_tap(const float* UF, const float* state, int row, int j, int ucol, int c) {
    if (row < TP) { const int t = row & (SEQ - 1); return (t - 3 + j) >= 0 ? UF[(size_t)(row - 3 + j) * UFW + ucol + c] : 0.f; }
    const int s = row - TP, sb = s >> 2, e = (s & 3) + j;
    return e < 3 ? state[(size_t)(sb * 3 + e) * 1536 + c] : UF[(size_t)(TP + sb * 4 + e - 3) * UFW + ucol + c];
}
__device__ __forceinline__ void prep_phase(CA A, int layer, const int wv) {
    const int tid = tid_opaque(wv), lane = tid & 63, G = gridDim.x, gt = blk_opaque() * NTHR + tid, NGT = G * NTHR, gw = blk_opaque() * NWAVES + (tid >> 6), NGW = G * NWAVES;
    const float* UF = WSP(float, WS_UF); float* SC = WSP(float, WS_SCAL);
    for (int idx = gt; idx < TT * 24; idx += NGT) { const int row = idx / 24, j = idx % 24; const float u = UF[(size_t)row * UFW + UF_SMALL + j]; float r;
        if (j < 4) r = sigmoidf_(u);
        else if (j < 8) r = -fexp(IN_F(I_DNALOG)[layer * 4 + j - 4]) * softplusf_(u + IN_F(I_DNDTB)[layer * 4 + j - 4]);
        else r = softplusf_(u + IN_F(I_SSDTB)[layer * 16 + j - 8]);
        SC[(size_t)row * 32 + j] = r; }
    { bf16* O0 = WSP(bf16, WS_OBR); const float* spool = IN_F(I_SPOOL) + (size_t)layer * DBATCH * 15 * 512;
      for (int it = gw; it < (TP / 64 + DBATCH) * 4; it += NGW) { const int gi = it & 3, sc = it >> 2, w = 2 << gi, ch = gi * 128 + lane;
          if (sc < TP / 64) { const int row0 = sc * 64, t0 = row0 & (SEQ - 1); float s0 = 0.f, s1 = 0.f;
              for (int j = 1; j < w; ++j) if (t0 - j >= 0) { s0 += UF[(size_t)(row0 - j) * UFW + ch]; s1 += UF[(size_t)(row0 - j) * UFW + ch + 64]; }
#pragma unroll 8
              for (int i = 0; i < 64; ++i) { const int row = row0 + i, t = t0 + i; const float u0 = UF[(size_t)row * UFW + ch], u1 = UF[(size_t)row * UFW + ch + 64];
                  s0 += u0; s1 += u1; const float inv = 1.0f / (float)((t + 1) < w ? (t + 1) : w);
                  O0[(size_t)row * OBW + ch] = (bf16)f2bf(s0 * inv - u0); O0[(size_t)row * OBW + ch + 64] = (bf16)f2bf(s1 * inv - u1);
                  if (t - w + 1 >= 0) { s0 -= UF[(size_t)(row - w + 1) * UFW + ch]; s1 -= UF[(size_t)(row - w + 1) * UFW + ch + 64]; } } }
          else { const int sb = sc - TP / 64; const float inv = 1.0f / (float)w;
              for (int i = 0; i < DSEQ; ++i) { const int row = TP + sb * 4 + i, e = 15 + i; float s0 = 0.f, s1 = 0.f;
                  for (int j = 0; j < w; ++j) { const int ee = e - j; const float* src = ee < 15 ? spool + (size_t)(sb * 15 + ee) * 512 + ch : UF + (size_t)(TP + sb * 4 + ee - 15) * UFW + ch; s0 += src[0]; s1 += src[64]; }
                  O0[(size_t)row * OBW + ch] = (bf16)f2bf(s0 * inv - UF[(size_t)row * UFW + ch]); O0[(size_t)row * OBW + ch + 64] = (bf16)f2bf(s1 * inv - UF[(size_t)row * UFW + ch + 64]); } } } }
    for (int it0 = gw; it0 < DBATCH * 24; it0 += NGW) { const int it = it0 + (TP / 64) * 24; const int grp = it % 12, strm = (it / 12) & 1, sc = it / 24, c0 = grp * 128 + lane;
        const int ucol = strm ? UF_XBC : UF_DNQKV; float* OUTB = strm ? WSP(float, WS_XBC) : WSP(float, WS_DNQ);
        const float* cw = (strm ? IN_F(I_SSCW) : IN_F(I_DNCW)) + (size_t)layer * 4 * 1536; const float* st = (strm ? IN_F(I_SSSC) : IN_F(I_SDNC)) + (size_t)layer * DBATCH * 3 * 1536;
        const float wa0 = cw[c0], wa1 = cw[1536 + c0], wa2 = cw[3072 + c0], wa3 = cw[4608 + c0], wb0 = cw[c0 + 64], wb1 = cw[1536 + c0 + 64], wb2 = cw[3072 + c0 + 64], wb3 = cw[4608 + c0 + 64];
        const float ba = strm ? IN_F(I_SSCB)[layer * 1536 + c0] : 0.f, bb = strm ? IN_F(I_SSCB)[layer * 1536 + c0 + 64] : 0.f;
        const bool nrm = (strm == 0) && grp < 8; const float qs = grp < 4 ? 0.08838834764831845f : 1.0f;
        float ha0, ha1, ha2, hb0, hb1, hb2; int row0, n;
        if (sc < TP / 64) { row0 = sc * 64; n = 64; const int t0 = row0 & (SEQ - 1);
            if (t0 == 0) { ha0 = ha1 = ha2 = hb0 = hb1 = hb2 = 0.f; }
            else { const float* p = UF + (size_t)(row0 - 3) * UFW + ucol + c0; ha0 = p[0]; hb0 = p[64]; ha1 = p[UFW]; hb1 = p[UFW + 64]; ha2 = p[2 * UFW]; hb2 = p[2 * UFW + 64]; } }
        else { const int sb = sc - TP / 64; row0 = TP + sb * 4; n = DSEQ; const float* p = st + (size_t)(sb * 3) * 1536 + c0; ha0 = p[0]; hb0 = p[64]; ha1 = p[1536]; hb1 = p[1536 + 64]; ha2 = p[3072]; hb2 = p[3072 + 64]; }
#pragma unroll 8
        for (int i = 0; i < n; ++i) { const float* p = UF + (size_t)(row0 + i) * UFW + ucol + c0; const float ua = p[0], ub = p[64];
            float a = siluf_(ba + wa0 * ha0 + wa1 * ha1 + wa2 * ha2 + wa3 * ua), b = siluf_(bb + wb0 * hb0 + wb1 * hb1 + wb2 * hb2 + wb3 * ub);
            ha0 = ha1; ha1 = ha2; ha2 = ua; hb0 = hb1; hb1 = hb2; hb2 = ub;
            if (nrm) { const float rs = row16_sum(a * a + b * b);
                const float tot = (__builtin_bit_cast(float, __builtin_amdgcn_readlane(__builtin_bit_cast(int, rs), 0)) + __builtin_bit_cast(float, __builtin_amdgcn_readlane(__builtin_bit_cast(int, rs), 16)))
                                + (__builtin_bit_cast(float, __builtin_amdgcn_readlane(__builtin_bit_cast(int, rs), 32)) + __builtin_bit_cast(float, __builtin_amdgcn_readlane(__builtin_bit_cast(int, rs), 48)));
                const float sc2 = qs / sqrtf(tot + 1e-6f); a *= sc2; b *= sc2; }
            float* o = OUTB + (size_t)(row0 + i) * 1536 + c0; o[0] = a; o[64] = b; } }
    for (int idx = gt; idx < NBATCH * 3 * 1536; idx += NGT) { const int b = idx / (3 * 1536), q = idx % (3 * 1536), j = q / 1536, c = q % 1536; const size_t src = (size_t)(b * SEQ + SEQ - 3 + j) * UFW;
        A->out[O_DNCP + (size_t)layer * NBATCH * 3 * 1536 + idx] = UF[src + UF_DNQKV + c]; A->out[O_SSCP + (size_t)layer * NBATCH * 3 * 1536 + idx] = UF[src + UF_XBC + c]; }
    for (int idx = gt; idx < DBATCH * 3 * 1536; idx += NGT) { const int sb = idx / (3 * 1536), q = idx % (3 * 1536), j = q / 1536, c = q % 1536; const size_t src = (size_t)(TP + sb * 4 + 1 + j) * UFW;
        A->out[O_DNCS + (size_t)layer * DBATCH * 3 * 1536 + idx] = UF[src + UF_DNQKV + c]; A->out[O_SSCS + (size_t)layer * DBATCH * 3 * 1536 + idx] = UF[src + UF_XBC + c]; }
    for (int idx = gt; idx < NBATCH * 15 * 512; idx += NGT) { const int b = idx / (15 * 512), q = idx % (15 * 512), j = q >> 9, ch = q & 511;
        A->out[O_POOLP + (size_t)layer * NBATCH * 15 * 512 + idx] = UF[(size_t)(b * SEQ + SEQ - 15 + j) * UFW + ch]; }
    { const float* spool = IN_F(I_SPOOL) + (size_t)layer * DBATCH * 15 * 512;
      for (int idx = gt; idx < DBATCH * 15 * 512; idx += NGT) { const int sb = idx / (15 * 512), q = idx % (15 * 512), j = q >> 9, ch = q & 511, e = 4 + j;
          A->out[O_POOLS + (size_t)layer * DBATCH * 15 * 512 + idx] = e < 15 ? spool[(size_t)(sb * 15 + e) * 512 + ch] : UF[(size_t)(TP + sb * 4 + e - 15) * UFW + ch]; } }
}

__device__ __forceinline__ void dn_seq(CA A, LAS unsigned char* lds, int layer, int unit, const int wv) {
    const int tid = tid_opaque(wv), lane = tid & 63, wid = tid >> 6, v = tid & 127, kq = tid >> 7;
    int row0, L, h; const float* s0 = nullptr; float* sout;
    if (unit < 16) { const int b = unit >> 2; h = unit & 3; row0 = b * SEQ; L = SEQ; sout = A->out + O_DNSP + ((size_t)(layer * NBATCH + b) * 4 + h) * 16384; }
    else { const int u = unit - 16, sb = u >> 2; h = u & 3; row0 = TP + sb * 4; L = DSEQ; s0 = IN_F(I_SDNS) + ((size_t)(layer * DBATCH + sb) * 4 + h) * 16384; sout = A->out + O_DNSS + ((size_t)(layer * DBATCH + sb) * 4 + h) * 16384; }
    constexpr int CH = 32;
    LAS float* qs = (LAS float*)lds; LAS float* ks = qs + CH * 128; LAS float* vs = ks + CH * 128; LAS float* ob = vs + CH * 128;
    LAS float* red = ob + CH * 128;
    LAS float* egs = red + 2 * 2 * 4 * 128; LAS float* bts = egs + CH; LAS float* kqd = bts + CH;
    const float* DNQ = WSP(float, WS_DNQ); const float* SC = WSP(float, WS_SCAL); const float* UF = WSP(float, WS_UF); bf16* O1 = WSP(bf16, WS_OBR) + 512;
    const float* nw = IN_F(I_DNNW) + layer * 128;
    float S[32];
#pragma unroll
    for (int i = 0; i < 32; ++i) S[i] = s0 ? s0[(size_t)(32 * kq + i) * 128 + v] : 0.f;
    for (int c0 = 0; c0 < L; c0 += CH) {
        const int n = (L - c0) < CH ? (L - c0) : CH;
        __syncthreads();
        for (int idx = tid; idx < n * 128; idx += NTHR) { const int t = idx >> 7, c = idx & 127; const float* src = DNQ + (size_t)(row0 + c0 + t) * 1536 + h * 128 + c;
            qs[idx] = src[0]; ks[idx] = src[512]; vs[idx] = src[1024]; }
        if (tid < n) { const float* sc = SC + (size_t)(row0 + c0 + tid) * 32; bts[tid] = sc[h]; egs[tid] = fexp(sc[4 + h]); }
        __syncthreads();
        for (int t = wid; t < n; t += NWAVES) { const float s = wave_sum(ks[t * 128 + lane] * qs[t * 128 + lane] + ks[t * 128 + 64 + lane] * qs[t * 128 + 64 + lane]); if (lane == 0) kqd[t] = s; }
        __syncthreads();
        for (int t = 0; t < n; ++t) {
            const float eg = egs[t], bt = bts[t]; float kk[32]; float r = 0.f, pp = 0.f;
#pragma unroll
            for (int i4 = 0; i4 < 8; ++i4) { const f32x4 k4 = *(const LAS f32x4*)(ks + t * 128 + 32 * kq + 4 * i4), q4 = *(const LAS f32x4*)(qs + t * 128 + 32 * kq + 4 * i4);
#pragma unroll
                for (int e = 0; e < 4; ++e) { const int i = 4 * i4 + e; S[i] *= eg; kk[i] = k4[e]; r += S[i] * k4[e]; pp += S[i] * q4[e]; } }
            LAS float* rd = red + (t & 1) * 1024;
            rd[kq * 128 + v] = r; rd[512 + kq * 128 + v] = pp;
            __syncthreads();
            const float rt = (rd[v] + rd[128 + v]) + (rd[256 + v] + rd[384 + v]), pt = (rd[512 + v] + rd[640 + v]) + (rd[768 + v] + rd[896 + v]);
            const float dd = bt * (vs[t * 128 + v] - rt);
#pragma unroll
            for (int i = 0; i < 32; ++i) S[i] += kk[i] * dd;
            if (kq == 0) ob[t * 128 + v] = pt + kqd[t] * dd;
        }
        __syncthreads();
        for (int t = wid; t < n; t += NWAVES) { const int row = row0 + c0 + t; const float o0 = ob[t * 128 + lane], o1 = ob[t * 128 + 64 + lane];
            const float rstd = 1.0f / sqrtf(wave_sum(o0 * o0 + o1 * o1) * (1.0f / 128.0f) + RMS_EPS);
            const float z0 = UF[(size_t)row * UFW + UF_DNZ + h * 128 + lane], z1 = UF[(size_t)row * UFW + UF_DNZ + h * 128 + 64 + lane];
            O1[(size_t)row * OBW + h * 128 + lane] = (bf16)f2bf(o0 * rstd * nw[lane] * siluf_(z0)); O1[(size_t)row * OBW + h * 128 + 64 + lane] = (bf16)f2bf(o1 * rstd * nw[64 + lane] * siluf_(z1)); }
    }
#pragma unroll
    for (int i = 0; i < 32; ++i) sout[(size_t)(32 * kq + i) * 128 + v] = S[i];
    __syncthreads();
}

__device__ __forceinline__ void ssd_seq(CA A, LAS unsigned char* lds, int layer, int unit, const int wv) {
    const int tid = tid_opaque(wv), lane = tid & 63, wid = tid >> 6, p = tid >> 3, nq = tid & 7;
    int row0, L, hd; const float* h0 = nullptr; float* hout;
    if (unit < 64) { const int b = unit >> 4; hd = unit & 15; row0 = b * SEQ; L = SEQ; hout = A->out + O_SSHP + ((size_t)(layer * NBATCH + b) * 16 + hd) * 8192; }
    else { const int u = unit - 64, sb = u >> 4; hd = u & 15; row0 = TP + sb * 4; L = DSEQ; h0 = IN_F(I_SSSH) + ((size_t)(layer * DBATCH + sb) * 16 + hd) * 8192; hout = A->out + O_SSHS + ((size_t)(layer * DBATCH + sb) * 16 + hd) * 8192; }
    const int g = hd >> 3; constexpr int CH = 64;
    LAS float* Bs = (LAS float*)lds; LAS float* Cs = Bs + CH * 128; LAS float* xs = Cs + CH * 128; LAS float* yb = xs + CH * 64; LAS float* dts = yb + CH * 64;
    const float* XBC = WSP(float, WS_XBC); const float* SC = WSP(float, WS_SCAL); const float* UF = WSP(float, WS_UF); float* SSQ = WSP(float, WS_SSQ);
    bf16* Og = WSP(bf16, WS_OBR) + (3 + g) * 512;
    const float a = -fexp(IN_F(I_SSALOG)[layer * 16 + hd]), Dk = IN_F(I_SSD)[layer * 16 + hd];
    float hs[16];
#pragma unroll
    for (int j = 0; j < 16; ++j) hs[j] = h0 ? h0[(size_t)p * 128 + 16 * nq + j] : 0.f;
    for (int c0 = 0; c0 < L; c0 += CH) {
        const int n = (L - c0) < CH ? (L - c0) : CH;
        __syncthreads();
        for (int idx = tid; idx < n * 128; idx += NTHR) { const int t = idx >> 7, c = idx & 127; const float* src = XBC + (size_t)(row0 + c0 + t) * 1536; Bs[idx] = src[1024 + g * 128 + c]; Cs[idx] = src[1280 + g * 128 + c]; }
        for (int idx = tid; idx < n * 64; idx += NTHR) { const int t = idx >> 6, c = idx & 63; xs[idx] = XBC[(size_t)(row0 + c0 + t) * 1536 + hd * 64 + c]; }
        if (tid < n) dts[tid] = SC[(size_t)(row0 + c0 + tid) * 32 + 8 + hd];
        __syncthreads();
        for (int t = 0; t < n; ++t) {
            const float dt = dts[t], dA = fexp(dt * a), xv = xs[t * 64 + p], cx = dt * xv; float y = 0.f;
#pragma unroll
            for (int j4 = 0; j4 < 4; ++j4) { const f32x4 b4 = *(const LAS f32x4*)(Bs + t * 128 + 16 * nq + 4 * j4), c4 = *(const LAS f32x4*)(Cs + t * 128 + 16 * nq + 4 * j4);
#pragma unroll
                for (int e = 0; e < 4; ++e) { const int j = 4 * j4 + e; hs[j] = hs[j] * dA + cx * b4[e]; y += hs[j] * c4[e]; } }
            y += __shfl_xor(y, 1); y += __shfl_xor(y, 2); y += __shfl_xor(y, 4);
            if (nq == 0) yb[t * 64 + p] = y + Dk * xv;
        }
        __syncthreads();
        for (int t = wid; t < n; t += NWAVES) { const int row = row0 + c0 + t; const float z = UF[(size_t)row * UFW + UF_SSZ + hd * 64 + lane]; const float yg = yb[t * 64 + lane] * siluf_(z);
            const float ss = wave_sum(yg * yg); if (lane == 0) { SSQ[(size_t)row * 32 + hd * 2] = ss; SSQ[(size_t)row * 32 + hd * 2 + 1] = 0.f; }
            Og[(size_t)row * OBW + (hd & 7) * 64 + lane] = (bf16)f2bf(yg); }
    }
#pragma unroll
    for (int j = 0; j < 16; ++j) hout[(size_t)p * 128 + 16 * nq + j] = hs[j];
    __syncthreads();
}

constexpr size_t DNU_NW = 0, DNU_QG = 16384, DNU_AT = 32768, DNU_KGT = 40960, DNU_UP = 57344, DNU_EG = 90112, DNU_BYTES = 90368;
__device__ __forceinline__ float dpp_swap1(float x) { return __builtin_bit_cast(float, __builtin_amdgcn_mov_dpp(__builtin_bit_cast(int, x), 0xB1, 0xf, 0xf, true)); }
__device__ __forceinline__ void dn_chunk_unit(CA A, LAS unsigned char* lds, int layer, int unit, const int wv) {
    const int tid = tid_opaque(wv), lane = tid & 63, wid = tid >> 6, q4 = lane >> 4, l15 = lane & 15;
    const int bh = unit >> 5, ck = unit & 31, b = bh >> 2, h = bh & 3, row0 = b * SEQ + ck * 64;
    constexpr int FP = 132;
    LAS float* kf = (LAS float*)lds; LAS float* vf = kf + 64 * FP;
    LAS unsigned char* qb = lds + 2 * 64 * FP * 4; LAS unsigned char* kb = qb + 64 * 272;
    LAS float* Lp = (LAS float*)(kb + 64 * 272);
    LAS float* gcs = Lp + 2 * 64 * 32; LAS float* bts = gcs + 64;
    unsigned char* rec = A->ws + WS_DNU + (size_t)unit * DNU_BYTES;
    __syncthreads();
    if (tid < 64) { const float* us = WSP(float, WS_UF) + (size_t)(row0 + tid) * UFW + UF_SMALL;
        bts[tid] = sigmoidf_(us[h]); gcs[tid] = wave_scan(-fexp(IN_F(I_DNALOG)[layer * 4 + h]) * softplusf_(us[4 + h] + IN_F(I_DNDTB)[layer * 4 + h]), lane); }
    __syncthreads();
    const float glast = gcs[63];
    if (tid == 0) *(float*)(rec + DNU_EG) = fexp(glast);
    { const float* UF = WSP(float, WS_UF); const float* cw = IN_F(I_DNCW) + (size_t)layer * 4 * 1536;
      f32x4 wt[3][4];
#pragma unroll
      for (int sIdx = 0; sIdx < 3; ++sIdx)
#pragma unroll
          for (int j = 0; j < 4; ++j) wt[sIdx][j] = *(const f32x4*)(cw + j * 1536 + sIdx * 512 + h * 128 + (tid & 31) * 4);
#pragma unroll
      for (int it = 0; it < 4; ++it) { const int idx = tid + 512 * it, t = idx >> 5, d4 = (idx & 31) * 4, tq = ck * 64 + t; f32x4 val[3];
#pragma unroll
          for (int sIdx = 0; sIdx < 3; ++sIdx) { const int col = sIdx * 512 + h * 128 + d4; f32x4 a = {0.f, 0.f, 0.f, 0.f};
#pragma unroll
              for (int j = 0; j < 4; ++j) if (tq - 3 + j >= 0) a += *(const f32x4*)(UF + (size_t)(row0 + t - 3 + j) * UFW + UF_DNQKV + col) * wt[sIdx][j];
#pragma unroll
              for (int e = 0; e < 4; ++e) a[e] = siluf_(a[e]);
              if (sIdx < 2) { float ss = row16_sum((a[0] * a[0] + a[1] * a[1]) + (a[2] * a[2] + a[3] * a[3])); ss += __shfl_xor(ss, 16);
                  const float sc = (sIdx == 0 ? 0.08838834764831845f : 1.0f) * __builtin_amdgcn_rsqf(ss + 1e-6f); a = a * sc; }
              val[sIdx] = a; }
          const f32x4 qv = val[0], kv = val[1], vv = val[2];
          *(LAS f32x4*)(kf + t * FP + d4) = kv; *(LAS f32x4*)(vf + t * FP + d4) = vv;
          v2u w; w.x = pk2(qv[0], qv[1]); w.y = pk2(qv[2], qv[3]); *(LAS v2u*)(qb + t * 272 + d4 * 2) = w;
          w.x = pk2(kv[0], kv[1]); w.y = pk2(kv[2], kv[3]); *(LAS v2u*)(kb + t * 272 + d4 * 2) = w;
          const float eg = fexp(gcs[t]); w.x = pk2(qv[0] * eg, qv[1] * eg); w.y = pk2(qv[2] * eg, qv[3] * eg); *(v2u*)(rec + DNU_QG + (size_t)(t * 128 + d4) * 2) = w; } }
    __syncthreads();
    { const int c = lane, dg = wid; const float f = fexp(glast - gcs[c]); bf16* KGT = (bf16*)(rec + DNU_KGT);
#pragma unroll
      for (int i = 0; i < 16; ++i) { const int d = dg * 16 + i; KGT[d * 64 + c] = (bf16)f2bf(kf[c * FP + d] * f); } }
    { const int ct = wid >> 1; bf16* AT = (bf16*)(rec + DNU_AT);
#pragma unroll
      for (int e2 = 0; e2 < 2; ++e2) { const int et = 2 * (wid & 1) + e2; f32x4 aKK = {0.f, 0.f, 0.f, 0.f}, aQK = {0.f, 0.f, 0.f, 0.f};
#pragma unroll
          for (int ks = 0; ks < 4; ++ks) { const bf16x8 bfr = *(const LAS bf16x8*)(kb + (16 * et + l15) * 272 + (32 * ks + 8 * q4) * 2);
              const bf16x8 ak = *(const LAS bf16x8*)(kb + (16 * ct + l15) * 272 + (32 * ks + 8 * q4) * 2), aq = *(const LAS bf16x8*)(qb + (16 * ct + l15) * 272 + (32 * ks + 8 * q4) * 2);
              aKK = __builtin_amdgcn_mfma_f32_16x16x32_bf16(ak, bfr, aKK, 0, 0, 0); aQK = __builtin_amdgcn_mfma_f32_16x16x32_bf16(aq, bfr, aQK, 0, 0, 0); }
          const int e = 16 * et + l15; const float ge = gcs[e];
#pragma unroll
          for (int r = 0; r < 4; ++r) { const int c = 16 * ct + 4 * q4 + r; const float dec = e <= c ? fexp(gcs[c] - ge) : 0.f;
              Lp[((e & 1) * 64 + c) * 32 + (e >> 1)] = e < c ? bts[c] * aKK[r] * dec : 0.f;
              AT[c * 64 + e] = (bf16)f2bf(aQK[r] * dec); } } }
    __syncthreads();
    { const int j = tid >> 1, par = tid & 1; float x[32];
#pragma unroll
      for (int i = 0; i < 32; ++i) x[i] = 0.f;
      const LAS float* src = j < 128 ? vf + j : kf + (j - 128);
      float* UP = (float*)(rec + DNU_UP); bf16* NW = (bf16*)(rec + DNU_NW);
#pragma unroll
      for (int c = 0; c < 64; ++c) {
          constexpr int dummy = 0; (void)dummy;
          const int ni = (c + 1) >> 1; float a0 = 0.f, a1 = 0.f, a2 = 0.f, a3 = 0.f;
#pragma unroll
          for (int i4 = 0; i4 < (ni + 3) / 4; ++i4) { const f32x4 l4 = *(const LAS f32x4*)(Lp + (par * 64 + c) * 32 + 4 * i4);
              a0 += l4[0] * x[4 * i4]; if (4 * i4 + 1 < ni) a1 += l4[1] * x[4 * i4 + 1]; if (4 * i4 + 2 < ni) a2 += l4[2] * x[4 * i4 + 2]; if (4 * i4 + 3 < ni) a3 += l4[3] * x[4 * i4 + 3]; }
          float acc = (a0 + a1) + (a2 + a3); acc += dpp_swap1(acc);
          float rhs = src[c * FP] * bts[c]; if (j >= 128) rhs *= fexp(gcs[c]);
          const float xc = rhs - acc;
          x[c >> 1] = ((c & 1) == par) ? xc : x[c >> 1];
          if (par == 0) { if (j < 128) UP[(((j >> 4) * 4 + (c >> 4)) * 4 + (c & 3)) * 64 + ((c >> 2) & 3) * 16 + (j & 15)] = xc; else NW[c * 128 + (j - 128)] = (bf16)f2bf(-xc); }
      } }
}

constexpr int D2_NW = 0, D2_KGT = 17408, D2_BUF = 35840;
__device__ __forceinline__ bf16x8 ld_frag_perm(const LAS unsigned char* p) {
    const v2u lo = *(const LAS v2u*)p, hi = *(const LAS v2u*)(p + 32); v4u w; w.x = lo.x; w.y = lo.y; w.z = hi.x; w.w = hi.y; return __builtin_bit_cast(bf16x8, w);
}
__device__ __forceinline__ bf16x8 pack_b(const f32x4& t0, const f32x4& t1) { v4u w; w.x = pk2(t0[0], t0[1]); w.y = pk2(t0[2], t0[3]); w.z = pk2(t1[0], t1[1]); w.w = pk2(t1[2], t1[3]); return __builtin_bit_cast(bf16x8, w); }
__device__ __forceinline__ void dn_seq2(CA A, LAS unsigned char* lds, int layer, int bh, const int wv) {
    const int tid = tid_opaque(wv), lane = tid & 63, w = tid >> 6, q4 = lane >> 4, l15 = lane & 15;
    const int b = bh >> 2, h = bh & 3;
    const unsigned char* recs = A->ws + WS_DNU + (size_t)(bh * 32) * DNU_BYTES;
    v4u* sav = (v4u*)(A->ws + WS_DNSV + (size_t)(bh * 32) * 49152) + (size_t)w * 6 * 64 + lane;
    f32x4 S[8];
#pragma unroll
    for (int i = 0; i < 8; ++i) S[i] = (f32x4){0.f, 0.f, 0.f, 0.f};
    v4u st[4];
#define D2_LOAD(rec_) do { const v4u* g_ = (const v4u*)(rec_); st[0] = g_[tid]; st[1] = g_[tid + 512]; st[2] = g_[tid + 2560]; st[3] = g_[tid + 3072]; } while (0)
#define D2_STORE(buf_) do { LAS unsigned char* b_ = lds + (buf_) * D2_BUF; \
        *(LAS v4u*)(b_ + D2_NW + (tid >> 4) * 272 + (tid & 15) * 16) = st[0]; *(LAS v4u*)(b_ + D2_NW + (32 + (tid >> 4)) * 272 + (tid & 15) * 16) = st[1]; \
        *(LAS v4u*)(b_ + D2_KGT + (tid >> 3) * 144 + (tid & 7) * 16) = st[2]; *(LAS v4u*)(b_ + D2_KGT + (64 + (tid >> 3)) * 144 + (tid & 7) * 16) = st[3]; } while (0)
    __syncthreads();
    D2_LOAD(recs); D2_STORE(0);
    f32x4 vnx[4]; float eglx = *(const float*)(recs + DNU_EG);
    { const float* UP0 = (const float*)(recs + DNU_UP) + (size_t)w * 1024 + lane;
#pragma unroll
      for (int mt = 0; mt < 4; ++mt)
#pragma unroll
          for (int r = 0; r < 4; ++r) vnx[mt][r] = UP0[(mt * 4 + r) * 64]; }
    __syncthreads();
    for (int ck = 0; ck < 32; ++ck) {
        const unsigned char* rec = recs + (size_t)ck * DNU_BYTES;
        const LAS unsigned char* bf = lds + (ck & 1) * D2_BUF;
        if (ck + 1 < 32) D2_LOAD(rec + DNU_BYTES);
        const float egl = eglx;
        f32x4 vn[4];
#pragma unroll
        for (int mt = 0; mt < 4; ++mt) vn[mt] = vnx[mt];
        if (ck + 1 < 32) { eglx = *(const float*)(rec + DNU_BYTES + DNU_EG); const float* UP = (const float*)(rec + DNU_BYTES + DNU_UP) + (size_t)w * 1024 + lane;
#pragma unroll
            for (int mt = 0; mt < 4; ++mt)
#pragma unroll
                for (int r = 0; r < 4; ++r) vnx[mt][r] = UP[(mt * 4 + r) * 64]; }
        bf16x8 Sb[4];
#pragma unroll
        for (int ks = 0; ks < 4; ++ks) { Sb[ks] = pack_b(S[2 * ks], S[2 * ks + 1]); sav[(size_t)ck * 3072 + ks * 64] = __builtin_bit_cast(v4u, Sb[ks]); }
        const int aoff = l15 * 272 + 8 * q4, aoff2 = l15 * 144 + 8 * q4;
#pragma unroll
        for (int mt = 0; mt < 4; ++mt)
#pragma unroll
            for (int ks = 0; ks < 4; ++ks) vn[mt] = __builtin_amdgcn_mfma_f32_16x16x32_bf16(ld_frag_perm(bf + D2_NW + mt * 16 * 272 + aoff + ks * 64), Sb[ks], vn[mt], 0, 0, 0);
        bf16x8 vb[2];
        vb[0] = pack_b(vn[0], vn[1]); vb[1] = pack_b(vn[2], vn[3]);
        sav[(size_t)ck * 3072 + 4 * 64] = __builtin_bit_cast(v4u, vb[0]); sav[(size_t)ck * 3072 + 5 * 64] = __builtin_bit_cast(v4u, vb[1]);
#pragma unroll
        for (int m8 = 0; m8 < 8; ++m8) { S[m8] = S[m8] * egl;
#pragma unroll
            for (int ke = 0; ke < 2; ++ke) S[m8] = __builtin_amdgcn_mfma_f32_16x16x32_bf16(ld_frag_perm(bf + D2_KGT + m8 * 16 * 144 + aoff2 + ke * 64), vb[ke], S[m8], 0, 0, 0); }
        if (ck + 1 < 32) D2_STORE((ck + 1) & 1);
        __syncthreads();
    }
    float* sout = A->out + O_DNSP + ((size_t)(layer * NBATCH + b) * 4 + h) * 16384;
#pragma unroll
    for (int m8 = 0; m8 < 8; ++m8)
#pragma unroll
        for (int r = 0; r < 4; ++r) sout[(size_t)(16 * m8 + 4 * q4 + r) * 128 + 16 * w + l15] = S[m8][r];
    __syncthreads();
#undef D2_LOAD
#undef D2_STORE
}
constexpr int D3_QG = 0, D3_AT = 17408, D3_RED = 26624;
__device__ __forceinline__ void dn_out_unit(CA A, LAS unsigned char* lds, int layer, int unit, const int wv) {
    const int tid = tid_opaque(wv), lane = tid & 63, w = tid >> 6, q4 = lane >> 4, l15 = lane & 15;
    const int bh = unit >> 5, ck = unit & 31, b = bh >> 2, h = bh & 3, row0 = b * SEQ + ck * 64;
    const unsigned char* rec = A->ws + WS_DNU + (size_t)unit * DNU_BYTES;
    const v4u* sav = (const v4u*)(A->ws + WS_DNSV + (size_t)unit * 49152) + (size_t)w * 6 * 64 + lane;
    const float* UF = WSP(float, WS_UF); bf16* O1 = WSP(bf16, WS_OBR) + 512; const float nwv = IN_F(I_DNNW)[layer * 128 + 16 * w + l15];
    LAS float* red = (LAS float*)(lds + D3_RED);
    __syncthreads();
    { const v4u* g_ = (const v4u*)rec; const v4u a0 = g_[tid + 1024], a1 = g_[tid + 1536], a2 = g_[tid + 2048];
      *(LAS v4u*)(lds + D3_QG + (tid >> 4) * 272 + (tid & 15) * 16) = a0; *(LAS v4u*)(lds + D3_QG + (32 + (tid >> 4)) * 272 + (tid & 15) * 16) = a1;
      *(LAS v4u*)(lds + D3_AT + (tid >> 3) * 144 + (tid & 7) * 16) = a2; }
    bf16x8 Sb[4], vb[2];
#pragma unroll
    for (int ks = 0; ks < 4; ++ks) Sb[ks] = __builtin_bit_cast(bf16x8, sav[ks * 64]);
    vb[0] = __builtin_bit_cast(bf16x8, sav[4 * 64]); vb[1] = __builtin_bit_cast(bf16x8, sav[5 * 64]);
    f32x4 zz[4];
#pragma unroll
    for (int mt = 0; mt < 4; ++mt)
#pragma unroll
        for (int r = 0; r < 4; ++r) zz[mt][r] = UF[(size_t)(row0 + 16 * mt + 4 * q4 + r) * UFW + UF_DNZ + h * 128 + 16 * w + l15];
    __syncthreads();
    const int aoff = l15 * 272 + 8 * q4, aoff2 = l15 * 144 + 8 * q4;
    f32x4 o[4];
#pragma unroll
    for (int mt = 0; mt < 4; ++mt) { o[mt] = (f32x4){0.f, 0.f, 0.f, 0.f};
#pragma unroll
        for (int ks = 0; ks < 4; ++ks) o[mt] = __builtin_amdgcn_mfma_f32_16x16x32_bf16(ld_frag_perm(lds + D3_QG + mt * 16 * 272 + aoff + ks * 64), Sb[ks], o[mt], 0, 0, 0);
#pragma unroll
        for (int ke = 0; ke < 2; ++ke) o[mt] = __builtin_amdgcn_mfma_f32_16x16x32_bf16(ld_frag_perm(lds + D3_AT + mt * 16 * 144 + aoff2 + ke * 64), vb[ke], o[mt], 0, 0, 0); }
#pragma unroll
    for (int mt = 0; mt < 4; ++mt)
#pragma unroll
        for (int r = 0; r < 4; ++r) red[(16 * mt + 4 * q4 + r) * 8 + w] = row16_sum(o[mt][r] * o[mt][r]);
    __syncthreads();
#pragma unroll
    for (int mt = 0; mt < 4; ++mt)
#pragma unroll
        for (int r = 0; r < 4; ++r) { const int c = 16 * mt + 4 * q4 + r; const f32x4 s0 = *(const LAS f32x4*)(red + c * 8), s1 = *(const LAS f32x4*)(red + c * 8 + 4);
            const float rstd = __builtin_amdgcn_rsqf(((s0[0] + s0[1]) + (s0[2] + s0[3]) + (s1[0] + s1[1]) + (s1[2] + s1[3])) * (1.0f / 128.0f) + RMS_EPS);
            const float zq = zz[mt][r]; O1[(size_t)(row0 + c) * OBW + h * 128 + 16 * w + l15] = (bf16)f2bf(o[mt][r] * rstd * nwv * zq * __builtin_amdgcn_rcpf(1.0f + fexp(-zq))); }
}

constexpr size_t SSU_XT = 0, SSU_XTW = 8192, SSU_CUM = 16384, SSU_DT = 16640, SSU_BYTES = 16896;
constexpr size_t SSG_C = 0, SSG_B = 16384, SSG_BT = 32768, SSG_BYTES = 49152;
__device__ __forceinline__ void ssd_prep_unit(CA A, LAS unsigned char* lds, int layer, int unit, const int wv) {
    const int tid = tid_opaque(wv), lane = tid & 63, w = tid >> 6;
    const int quad = unit & 3, bc = unit >> 2, b = bc >> 5, ck = bc & 31, g = quad >> 1, row0 = b * SEQ + ck * 64, tq0 = ck * 64;
    const float* UF = WSP(float, WS_UF); const float* cw = IN_F(I_SSCW) + (size_t)layer * 4 * 1536; const float* cb = IN_F(I_SSCB) + layer * 1536;
    LAS float* xl = (LAS float*)lds;
    LAS float* bl = xl + 4 * 64 * 65;
    LAS float* ws_ = bl + 64 * 129;
    const bool leader = (quad & 1) == 0;
    __syncthreads();
    if (w < 4) { const int hd = quad * 4 + w; unsigned char* rec = A->ws + WS_SSU + (size_t)(bc * 16 + hd) * SSU_BYTES; const float a = -fexp(IN_F(I_SSALOG)[layer * 16 + hd]);
        const float dt = softplusf_(UF[(size_t)(row0 + lane) * UFW + UF_SMALL + 8 + hd] + IN_F(I_SSDTB)[layer * 16 + hd]); const float c = wave_scan(dt * a, lane); const float c63 = rdlane(c, 63); ws_[w * 64 + lane] = fexp(c63 - c) * dt;
        ((float*)(rec + SSU_CUM))[lane] = c; ((float*)(rec + SSU_DT))[lane] = dt; }
    { const int s = tid >> 3, p8 = (tid & 7) * 8;
#pragma unroll
      for (int hq = 0; hq < 4; ++hq) { const int col = (quad * 4 + hq) * 64 + p8; f32x4 x0 = *(const f32x4*)(cb + col), x1 = *(const f32x4*)(cb + col + 4);
#pragma unroll
          for (int j = 0; j < 4; ++j) if (tq0 + s - 3 + j >= 0) { const float* up = UF + (size_t)(row0 + s - 3 + j) * UFW + UF_XBC + col; x0 += *(const f32x4*)up * *(const f32x4*)(cw + j * 1536 + col); x1 += *(const f32x4*)(up + 4) * *(const f32x4*)(cw + j * 1536 + col + 4); }
#pragma unroll
          for (int e = 0; e < 4; ++e) { xl[(hq * 64 + s) * 65 + p8 + e] = siluf_(x0[e]); xl[(hq * 64 + s) * 65 + p8 + 4 + e] = siluf_(x1[e]); } } }
    unsigned char* grec = A->ws + WS_SSG + (size_t)(bc * 2 + g) * SSG_BYTES;
    if (leader) {
        const int s = tid >> 3, n16 = (tid & 7) * 16, colb = 1024 + g * 128 + n16;
        f32x4 bv[4], cv[4];
#pragma unroll
        for (int i = 0; i < 4; ++i) { bv[i] = *(const f32x4*)(cb + colb + 4 * i); cv[i] = *(const f32x4*)(cb + colb + 256 + 4 * i); }
#pragma unroll
        for (int j = 0; j < 4; ++j) if (tq0 + s - 3 + j >= 0) { const float* up = UF + (size_t)(row0 + s - 3 + j) * UFW + UF_XBC + colb; const float* wp = cw + j * 1536 + colb;
#pragma unroll
            for (int i = 0; i < 4; ++i) { bv[i] += *(const f32x4*)(up + 4 * i) * *(const f32x4*)(wp + 4 * i); cv[i] += *(const f32x4*)(up + 256 + 4 * i) * *(const f32x4*)(wp + 256 + 4 * i); } }
#pragma unroll
        for (int i = 0; i < 4; ++i)
#pragma unroll
            for (int e = 0; e < 4; ++e) { bv[i][e] = siluf_(bv[i][e]); cv[i][e] = siluf_(cv[i][e]); }
#pragma unroll
        for (int i = 0; i < 2; ++i) { v4u o; o.x = pk2(bv[2 * i][0], bv[2 * i][1]); o.y = pk2(bv[2 * i][2], bv[2 * i][3]); o.z = pk2(bv[2 * i + 1][0], bv[2 * i + 1][1]); o.w = pk2(bv[2 * i + 1][2], bv[2 * i + 1][3]);
            *(v4u*)(grec + SSG_B + (size_t)(s * 128 + n16 + 8 * i) * 2) = o;
            o.x = pk2(cv[2 * i][0], cv[2 * i][1]); o.y = pk2(cv[2 * i][2], cv[2 * i][3]); o.z = pk2(cv[2 * i + 1][0], cv[2 * i + 1][1]); o.w = pk2(cv[2 * i + 1][2], cv[2 * i + 1][3]);
            *(v4u*)(grec + SSG_C + (size_t)(s * 128 + n16 + 8 * i) * 2) = o; }
#pragma unroll
        for (int i = 0; i < 4; ++i)
#pragma unroll
            for (int e = 0; e < 4; ++e) bl[s * 129 + n16 + 4 * i + e] = bv[i][e];
    }
    __syncthreads();
    { const int p = tid >> 3, s8 = (tid & 7) * 8;
#pragma unroll
      for (int hq = 0; hq < 4; ++hq) { unsigned char* rec = A->ws + WS_SSU + (size_t)(bc * 16 + quad * 4 + hq) * SSU_BYTES; float xv[8], xw[8];
#pragma unroll
          for (int i = 0; i < 8; ++i) { xv[i] = xl[(hq * 64 + s8 + i) * 65 + p]; xw[i] = xv[i] * ws_[hq * 64 + s8 + i]; }
          v4u o; o.x = pk2(xv[0], xv[1]); o.y = pk2(xv[2], xv[3]); o.z = pk2(xv[4], xv[5]); o.w = pk2(xv[6], xv[7]); *(v4u*)(rec + SSU_XT + (size_t)(p * 64 + s8) * 2) = o;
          o.x = pk2(xw[0], xw[1]); o.y = pk2(xw[2], xw[3]); o.z = pk2(xw[4], xw[5]); o.w = pk2(xw[6], xw[7]); *(v4u*)(rec + SSU_XTW + (size_t)(p * 64 + s8) * 2) = o; } }
    if (leader) {
        const int n = tid >> 2, s16 = (tid & 3) * 16; float t[16];
#pragma unroll
        for (int i = 0; i < 16; ++i) t[i] = bl[(s16 + i) * 129 + n];
#pragma unroll
        for (int i = 0; i < 2; ++i) { v4u o; o.x = pk2(t[8 * i], t[8 * i + 1]); o.y = pk2(t[8 * i + 2], t[8 * i + 3]); o.z = pk2(t[8 * i + 4], t[8 * i + 5]); o.w = pk2(t[8 * i + 6], t[8 * i + 7]);
            *(v4u*)(grec + SSG_BT + (size_t)(n * 64 + s16 + 8 * i) * 2) = o; }
    }
}

constexpr int S2_C = 0, S2_B = 17408, S2_BT = 34816, S2_XT = 53248, S2_XTW = 62464, S2_WM = 71680, S2_HB = 80896, S2_YB = 98304, S2_CUM = 114688, S2_DT = 114944;
__device__ __forceinline__ void ssd_seq2(CA A, LAS unsigned char* lds, int layer, int unit, const int wv) {
    const int tid = tid_opaque(wv), lane = tid & 63, w = tid >> 6, q4 = lane >> 4, l15 = lane & 15;
    const int b = unit >> 4, hd = unit & 15, g = hd >> 3;
    const unsigned char* hrec = A->ws + WS_SSU + (size_t)((b * 32) * 16 + hd) * SSU_BYTES;
    const unsigned char* grec = A->ws + WS_SSG + (size_t)((b * 32) * 2 + g) * SSG_BYTES;
    const float* UF = WSP(float, WS_UF); float* SSQ = WSP(float, WS_SSQ); bf16* Og = WSP(bf16, WS_OBR) + (3 + g) * 512;
    const float Dk = IN_F(I_SSD)[layer * 16 + hd];
    LAS float* yb = (LAS float*)(lds + S2_YB); LAS float* cums = (LAS float*)(lds + S2_CUM); LAS float* dts = (LAS float*)(lds + S2_DT);
    f32x4 hacc[4];
#pragma unroll
    for (int i = 0; i < 4; ++i) hacc[i] = (f32x4){0.f, 0.f, 0.f, 0.f};
    v4u st[8]; float sc1 = 0.f;
#define S2_LOAD(ck_) do { const v4u* gg_ = (const v4u*)(grec + (size_t)(ck_) * 2 * SSG_BYTES); const v4u* hh_ = (const v4u*)(hrec + (size_t)(ck_) * 16 * SSU_BYTES); \
        st[0] = gg_[tid]; st[1] = gg_[tid + 512]; st[2] = gg_[tid + 1024]; st[3] = gg_[tid + 1536]; st[4] = gg_[tid + 2048]; st[5] = gg_[tid + 2560]; st[6] = hh_[tid]; st[7] = hh_[tid + 512]; \
        if (tid < 128) sc1 = ((const float*)(hrec + (size_t)(ck_) * 16 * SSU_BYTES + SSU_CUM))[tid]; } while (0)
#define S2_STORE() do { \
        *(LAS v4u*)(lds + S2_C + (tid >> 4) * 272 + (tid & 15) * 16) = st[0]; *(LAS v4u*)(lds + S2_C + (32 + (tid >> 4)) * 272 + (tid & 15) * 16) = st[1]; \
        *(LAS v4u*)(lds + S2_B + (tid >> 4) * 272 + (tid & 15) * 16) = st[2]; *(LAS v4u*)(lds + S2_B + (32 + (tid >> 4)) * 272 + (tid & 15) * 16) = st[3]; \
        *(LAS v4u*)(lds + S2_BT + (tid >> 3) * 144 + (tid & 7) * 16) = st[4]; *(LAS v4u*)(lds + S2_BT + (64 + (tid >> 3)) * 144 + (tid & 7) * 16) = st[5]; \
        *(LAS v4u*)(lds + S2_XT + (tid >> 3) * 144 + (tid & 7) * 16) = st[6]; *(LAS v4u*)(lds + S2_XTW + (tid >> 3) * 144 + (tid & 7) * 16) = st[7]; \
        if (tid < 128) cums[tid] = sc1; } while (0)
    S2_LOAD(0);
    const int tt = w >> 1, aoffC = l15 * 272 + 16 * q4, aoffS = l15 * 144 + 16 * q4;
    float zx[2][4];
#pragma unroll
    for (int e2 = 0; e2 < 2; ++e2)
#pragma unroll
        for (int r = 0; r < 4; ++r) zx[e2][r] = UF[(size_t)(b * SEQ + 16 * tt + 4 * q4 + r) * UFW + UF_SSZ + hd * 64 + 16 * (2 * (w & 1) + e2) + l15];
    for (int ck = 0; ck < 32; ++ck) {
        const int row0 = b * SEQ + ck * 64;
        __syncthreads();
        S2_STORE();
        __syncthreads();
        if (ck + 1 < 32) S2_LOAD(ck + 1);
        float zv[2][4];
#pragma unroll
        for (int e2 = 0; e2 < 2; ++e2)
#pragma unroll
            for (int r = 0; r < 4; ++r) zv[e2][r] = zx[e2][r];
        if (ck + 1 < 32) {
#pragma unroll
            for (int e2 = 0; e2 < 2; ++e2)
#pragma unroll
                for (int r = 0; r < 4; ++r) zx[e2][r] = UF[(size_t)(row0 + 64 + 16 * tt + 4 * q4 + r) * UFW + UF_SSZ + hd * 64 + 16 * (2 * (w & 1) + e2) + l15]; }
#pragma unroll
        for (int e2 = 0; e2 < 2; ++e2) { const int stl = 2 * (w & 1) + e2; f32x4 acc = {0.f, 0.f, 0.f, 0.f};
            if (stl <= tt) {
#pragma unroll
                for (int ks = 0; ks < 4; ++ks) acc = __builtin_amdgcn_mfma_f32_16x16x32_bf16(*(const LAS bf16x8*)(lds + S2_C + tt * 16 * 272 + aoffC + ks * 64), *(const LAS bf16x8*)(lds + S2_B + stl * 16 * 272 + aoffC + ks * 64), acc, 0, 0, 0); }
            const int s = 16 * stl + l15; const float cs = cums[s], ds = dts[s];
#pragma unroll
            for (int r = 0; r < 4; ++r) { const int t = 16 * tt + 4 * q4 + r; const float v = s <= t ? acc[r] * fexp(cums[t] - cs) * ds : 0.f;
                *(LAS unsigned short*)(lds + S2_WM + t * 144 + s * 2) = (unsigned short)f2bf(v); } }
#pragma unroll
        for (int mt = 0; mt < 4; ++mt)
#pragma unroll
            for (int r = 0; r < 4; ++r) *(LAS unsigned short*)(lds + S2_HB + (16 * mt + 4 * q4 + r) * 272 + (16 * w + l15) * 2) = (unsigned short)f2bf(hacc[mt][r]);
        __syncthreads();
        float ssq[4] = {0.f, 0.f, 0.f, 0.f};
#pragma unroll
        for (int e2 = 0; e2 < 2; ++e2) { const int pt = 2 * (w & 1) + e2; f32x4 y = {0.f, 0.f, 0.f, 0.f};
#pragma unroll
            for (int ks = 0; ks < 4; ++ks) y = __builtin_amdgcn_mfma_f32_16x16x32_bf16(*(const LAS bf16x8*)(lds + S2_C + tt * 16 * 272 + aoffC + ks * 64), *(const LAS bf16x8*)(lds + S2_HB + pt * 16 * 272 + aoffC + ks * 64), y, 0, 0, 0);
#pragma unroll
            for (int r = 0; r < 4; ++r) y[r] *= fexp(cums[16 * tt + 4 * q4 + r]);
#pragma unroll
            for (int ke = 0; ke < 2; ++ke) y = __builtin_amdgcn_mfma_f32_16x16x32_bf16(*(const LAS bf16x8*)(lds + S2_WM + tt * 16 * 144 + aoffS + ke * 64), *(const LAS bf16x8*)(lds + S2_XT + pt * 16 * 144 + aoffS + ke * 64), y, 0, 0, 0);
            const int p = 16 * pt + l15;
#pragma unroll
            for (int r = 0; r < 4; ++r) { const int t = 16 * tt + 4 * q4 + r; const float xv = bflo((unsigned)*(const LAS unsigned short*)(lds + S2_XT + p * 144 + t * 2));
                const float yg = (y[r] + Dk * xv) * siluf_(zv[e2][r]); ssq[r] += yg * yg;
                Og[(size_t)(row0 + t) * OBW + (hd & 7) * 64 + p] = (bf16)f2bf(yg); } }
#pragma unroll
        for (int r = 0; r < 4; ++r) { const float s = row16_sum(ssq[r]); if (l15 == 0) SSQ[(size_t)(row0 + 16 * tt + 4 * q4 + r) * 32 + hd * 2 + (w & 1)] = s; }
        { const float e63 = fexp(cums[63]);
#pragma unroll
          for (int mt = 0; mt < 4; ++mt) { hacc[mt] = hacc[mt] * e63;
#pragma unroll
              for (int ke = 0; ke < 2; ++ke) hacc[mt] = __builtin_amdgcn_mfma_f32_16x16x32_bf16(*(const LAS bf16x8*)(lds + S2_XTW + mt * 16 * 144 + aoffS + ke * 64), *(const LAS bf16x8*)(lds + S2_BT + w * 16 * 144 + aoffS + ke * 64), hacc[mt], 0, 0, 0); } }
    }
    float* hout = A->out + O_SSHP + ((size_t)(layer * NBATCH + b) * 16 + hd) * 8192;
#pragma unroll
    for (int mt = 0; mt < 4; ++mt)
#pragma unroll
        for (int r = 0; r < 4; ++r) hout[(size_t)(16 * mt + 4 * q4 + r) * 128 + 16 * w + l15] = hacc[mt][r];
    __syncthreads();
#undef S2_LOAD
#undef S2_STORE
}

struct ALBf16 { const bf16* A; int lda; __device__ __forceinline__ bf16x8 operator()(int row, int k) const { return *(const bf16x8*)(A + (size_t)row * lda + k); } };
template <class AL> __device__ __forceinline__ void sgemm_task(const AL& al, const bf16* Wt, int ldw, int n0, int k0, int nks, f32x4 (&acc)[2], int l15, int q4) {
    const bf16* bp = Wt + (size_t)(n0 + l15) * ldw + k0 + 8 * q4;
    int nks_ = nks; asm volatile("" : "+s"(nks_));
#pragma unroll 4
    for (int ks = 0; ks < nks_; ++ks) { const bf16x8 b = *(const bf16x8*)(bp + 32 * ks); const bf16x8 a0 = al(l15, k0 + 32 * ks + 8 * q4), a1 = al(16 + l15, k0 + 32 * ks + 8 * q4);
        acc[0] = __builtin_amdgcn_mfma_f32_16x16x32_bf16(a0, b, acc[0], 0, 0, 0); acc[1] = __builtin_amdgcn_mfma_f32_16x16x32_bf16(a1, b, acc[1], 0, 0, 0); }
}
#define SAMPLE_IDS() const int tid = tid_opaque(wv), lane = tid & 63, l15 = lane & 15, q4 = lane >> 4, NGW = gridDim.x * NWAVES, gw = (tid >> 6) * gridDim.x + blk_opaque()
__device__ __forceinline__ void sample_merge(CA A, LAS unsigned char* lds, int layer, const int wv) {
    const int tid = tid_opaque(wv), lane = tid & 63, l15 = lane & 15, q4 = lane >> 4, w = tid >> 6, G = gridDim.x;
    const bf16* GT = WSP(bf16, WS_GATE); const float* RS = WSP(float, WS_RS); bf16* MB = WSP(bf16, WS_MGB); LAS float* part = (LAS float*)lds;
    for (int strip = blk_opaque(); strip < 128; strip += G) { const int n0 = strip * 16, col = n0 + l15;
        __syncthreads();
        if (w < 5) { const int s = w, gs = s < 3 ? s : 3;
            f32x4 acc[2] = {{0.f, 0.f, 0.f, 0.f}, {0.f, 0.f, 0.f, 0.f}};
            ALBf16 al{WSP(bf16, WS_OBR) + (size_t)TP * OBW + s * 512, OBW};
            sgemm_task(al, WSP(bf16, WS_WBR) + (size_t)layer * DM * OBW + s * 512, OBW, n0, 0, 16, acc, l15, q4);
#pragma unroll
            for (int mt = 0; mt < 2; ++mt)
#pragma unroll
                for (int r = 0; r < 4; ++r) { const int row = 16 * mt + 4 * q4 + r, grow = TP + row; float rs = 1.f;
                    if (s >= 3) rs = 1.0f / sqrtf(RS[(size_t)grow * 2 + (s - 3)]);
                    part[(s * 32 + row) * 16 + l15] = acc[mt][r] * bflo((unsigned)GT[(size_t)grow * 8192 + gs * 2048 + col]) * rs; } }
        __syncthreads();
        { const int row = tid >> 4, c = tid & 15; const float v = (part[row * 16 + c] + part[(32 + row) * 16 + c]) + (part[(64 + row) * 16 + c] + part[(96 + row) * 16 + c]) + part[(128 + row) * 16 + c];
          MB[(size_t)(TP + row) * DM + n0 + c] = (bf16)f2bf(v); } }
}
__device__ __forceinline__ void sample_up(CA A, LAS unsigned char* lds, int layer, const int wv) {
    const int tid = tid_opaque(wv), lane = tid & 63, l15 = lane & 15, q4 = lane >> 4, w = tid >> 6, G = gridDim.x;
    bf16* F = WSP(bf16, WS_F); LAS float* part = (LAS float*)lds;
    for (int sp = blk_opaque(); sp < 256; sp += G) { const int n0 = (2 * sp + (w >> 2)) * 16, kq = w & 3;
        __syncthreads();
        f32x4 acc[2] = {{0.f, 0.f, 0.f, 0.f}, {0.f, 0.f, 0.f, 0.f}};
        ALBf16 al{WSP(bf16, WS_H) + (size_t)TP * DM, DM};
        sgemm_task(al, WSP(bf16, WS_WUP) + (size_t)layer * DFF * DM, DM, n0, kq * 512, 16, acc, l15, q4);
#pragma unroll
        for (int mt = 0; mt < 2; ++mt)
#pragma unroll
            for (int r = 0; r < 4; ++r) part[(w * 32 + 16 * mt + 4 * q4 + r) * 16 + l15] = acc[mt][r];
        __syncthreads();
#pragma unroll
        for (int h2 = 0; h2 < 2; ++h2) { const int idx = tid + 512 * h2, half = idx >> 9, row = (idx >> 4) & 31, c = idx & 15; const LAS float* p = part + (half * 4 * 32 + row) * 16 + c;
            const float v = fmaxf((p[0] + p[32 * 16]) + (p[2 * 32 * 16] + p[3 * 32 * 16]), 0.f);
            F[(size_t)(TP + row) * DFF + (2 * sp + half) * 16 + c] = (bf16)f2bf(v * v); } }
}
template <class AL> __device__ __forceinline__ void sample_splitk(const AL& al, const bf16* Wt, int ldw, int nstrips, int nsplit, int nks, float* PART, int ldp, const int wv) {
    SAMPLE_IDS();
    for (int it = gw; it < nstrips * nsplit; it += NGW) { const int ns = it % nstrips, sp = it / nstrips, n0 = ns * 16;
        f32x4 acc[2] = {{0.f, 0.f, 0.f, 0.f}, {0.f, 0.f, 0.f, 0.f}};
        sgemm_task(al, Wt, ldw, n0, sp * nks * 32, nks, acc, l15, q4);
#pragma unroll
        for (int mt = 0; mt < 2; ++mt)
#pragma unroll
            for (int r = 0; r < 4; ++r) PART[((size_t)sp * TS + 16 * mt + 4 * q4 + r) * ldp + n0 + l15] = acc[mt][r]; }
}

constexpr int KS_PITCH = 272, VS_PITCH = 320;
typedef short v4i16_t __attribute__((ext_vector_type(4)));
constexpr int ATT_KS = 0, ATT_VT = 64 * KS_PITCH;
__device__ __forceinline__ void attn_prompt_unit(CA A, LAS unsigned char* lds, int layer, int unit, const int wv) {
    const int tid = tid_opaque(wv), lane = tid & 63, wid = tid >> 6, r = lane & 31, hh = lane >> 5;
    const int qb = 7 - (unit >> 4), bh = unit & 15, b = bh >> 2, h = bh & 3;
    const int q0 = qb * 256 + wid * 32, qpos = q0 + r;
    const bf16* QKV = WSP(bf16, WS_QKV) + (size_t)(b * SEQ) * 1536;
    bf16x8 Qf[8];
    { const bf16* qrow = QKV + (size_t)qpos * 1536 + h * 128 + 8 * hh;
#pragma unroll
      for (int s = 0; s < 8; ++s) Qf[s] = *(const bf16x8*)(qrow + 16 * s); }
    f32x16 O[4];
#pragma unroll
    for (int d = 0; d < 4; ++d)
#pragma unroll
        for (int i = 0; i < 16; ++i) O[d][i] = 0.f;
    float R = 1.f;
    const float bias2 = IN_F(I_SBBIAS)[layer * 4 + h] * LOG2E;
    const int ntile = qb * 4 + 4, srow = tid >> 3, sch = tid & 7;
    LAS unsigned char* Ks = lds + ATT_KS; LAS unsigned char* Vt = lds + ATT_VT;
    v4u kreg[2], vreg[2];
    { const bf16* src = QKV + (size_t)((ntile - 1) * 64 + srow) * 1536 + h * 128 + sch * 8;
      kreg[0] = *(const v4u*)(src + 512); kreg[1] = *(const v4u*)(src + 512 + 64); vreg[0] = *(const v4u*)(src + 1024); vreg[1] = *(const v4u*)(src + 1024 + 64); }
    for (int kt = ntile - 1; kt >= 0; --kt) {
        __syncthreads();
#pragma unroll
        for (int i = 0; i < 2; ++i) { *(LAS v4u*)(Ks + srow * KS_PITCH + (sch + 8 * i) * 16) = kreg[i]; *(LAS v4u*)(Vt + srow * VS_PITCH + (sch + 8 * i) * 16) = vreg[i]; }
        __syncthreads();
        if (kt > 0) { const bf16* src = QKV + (size_t)((kt - 1) * 64 + srow) * 1536 + h * 128 + sch * 8;
            kreg[0] = *(const v4u*)(src + 512); kreg[1] = *(const v4u*)(src + 512 + 64); vreg[0] = *(const v4u*)(src + 1024); vreg[1] = *(const v4u*)(src + 1024 + 64); }
        if (kt * 64 > q0 + 30) continue;
        const bool diag = (kt * 64 + 63 >= q0);
        const int kbase = kt * 64 + 4 * hh;
        bf16x8 Pf[4];
#pragma unroll
        for (int sub = 1; sub >= 0; --sub) {
            f32x16 sa;
#pragma unroll
            for (int i = 0; i < 16; ++i) sa[i] = bias2;
#pragma unroll
            for (int s = 0; s < 8; ++s) { const bf16x8 a = *(const LAS bf16x8*)(Ks + (32 * sub + r) * KS_PITCH + (16 * s + 8 * hh) * 2);
                sa = __builtin_amdgcn_mfma_f32_32x32x16_bf16(a, Qf[s], sa, 0, 0, 0); }
            float sp[16], iv[16], Gs[4], Gp[4];
#pragma unroll
            for (int i = 0; i < 16; ++i) { const float e = ex2(fminf(sa[i], 60.f)); float inv = __builtin_amdgcn_rcpf(1.0f + e), bt = e * inv;
                if (diag && (kbase + 32 * sub + 8 * (i >> 2) + (i & 3) >= qpos)) { inv = 1.f; bt = 0.f; }
                iv[i] = inv; sp[i] = bt; }
#pragma unroll
            for (int g = 0; g < 4; ++g) { Gs[g] = (iv[4 * g] * iv[4 * g + 1]) * (iv[4 * g + 2] * iv[4 * g + 3]); Gp[g] = __shfl_xor(Gs[g], 32); }
            float run = R;
#pragma unroll
            for (int g = 3; g >= 0; --g) { float a = hh == 0 ? run * Gp[g] : run;
#pragma unroll
                for (int e = 3; e >= 0; --e) { const int i = 4 * g + e; sp[i] *= a; a *= iv[i]; }
                run *= Gs[g] * Gp[g]; }
            R = run;
#pragma unroll
            for (int q2 = 0; q2 < 2; ++q2) { const int bs = 8 * q2; v4u w;
                w.x = pk2(sp[bs + 0], sp[bs + 1]); w.y = pk2(sp[bs + 2], sp[bs + 3]); w.z = pk2(sp[bs + 4], sp[bs + 5]); w.w = pk2(sp[bs + 6], sp[bs + 7]);
                Pf[2 * sub + q2] = __builtin_bit_cast(bf16x8, w); }
        }
#pragma unroll
        for (int d = 0; d < 4; ++d)
#pragma unroll
            for (int s4 = 0; s4 < 4; ++s4) {
                const LAS unsigned char* vp = Vt + (16 * s4 + 4 * hh + ((lane & 15) >> 2)) * VS_PITCH + (32 * d + 16 * ((lane >> 4) & 1) + 4 * (lane & 3)) * 2;
                const v4i16_t lo = __builtin_amdgcn_ds_read_tr16_b64_v4i16((LAS v4i16_t*)vp), hi = __builtin_amdgcn_ds_read_tr16_b64_v4i16((LAS v4i16_t*)(vp + 8 * VS_PITCH));
                const v2u lo2 = __builtin_bit_cast(v2u, lo), hi2 = __builtin_bit_cast(v2u, hi); v4u w; w.x = lo2.x; w.y = lo2.y; w.z = hi2.x; w.w = hi2.y;
                O[d] = __builtin_amdgcn_mfma_f32_32x32x16_bf16(__builtin_bit_cast(bf16x8, w), Pf[s4], O[d], 0, 0, 0); }
    }
    bf16* orow = WSP(bf16, WS_OBR) + 1024 + (size_t)(b * SEQ + qpos) * OBW + h * 128 + 4 * hh;
#pragma unroll
    for (int d = 0; d < 4; ++d)
#pragma unroll
        for (int g = 0; g < 4; ++g) { v2u w; w.x = pk2(O[d][4 * g], O[d][4 * g + 1]); w.y = pk2(O[d][4 * g + 2], O[d][4 * g + 3]); *(v2u*)(orow + 32 * d + 8 * g) = w; }
}

__device__ __forceinline__ void attn_sample_unit(CA A, LAS unsigned char* lds, int layer, int unit, const int wv) {
    const int tid = tid_opaque(wv), lane = tid & 63, wid = tid >> 6, sb = unit >> 5, pg4 = unit & 31, hd = lane >> 4;
    const int lp = 4 * pg4 + (wid >> 1), phys = ((const int*)A->in[I_PT])[sb * NPAGES + lp];
    const size_t pbase = ((size_t)(layer * NPOOL + phys) * PAGE + (wid & 1) * 64) * 512 + lane * 8;
    const float* Kc = IN_F(I_CK) + pbase; const float* Vc = IN_F(I_CV) + pbase;
    const bf16* QKV = WSP(bf16, WS_QKV);
    float qf[4][8], O[4][8], R[4];
#pragma unroll
    for (int i = 0; i < 4; ++i) { const v4u w = *(const v4u*)(QKV + (size_t)(TP + sb * 4 + i) * 1536 + lane * 8);
        qf[i][0] = bflo(w.x); qf[i][1] = bfhi(w.x); qf[i][2] = bflo(w.y); qf[i][3] = bfhi(w.y); qf[i][4] = bflo(w.z); qf[i][5] = bfhi(w.z); qf[i][6] = bflo(w.w); qf[i][7] = bfhi(w.w);
        R[i] = 0.f;
#pragma unroll
        for (int j = 0; j < 8; ++j) O[i][j] = 0.f; }
    const float bias2 = IN_F(I_SBBIAS)[layer * 4 + hd] * LOG2E;
#pragma unroll 4
    for (int t = 63; t >= 0; --t) {
        const f32x4 k0 = *(const f32x4*)(Kc + (size_t)t * 512), k1 = *(const f32x4*)(Kc + (size_t)t * 512 + 4), v0 = *(const f32x4*)(Vc + (size_t)t * 512), v1 = *(const f32x4*)(Vc + (size_t)t * 512 + 4);
#pragma unroll
        for (int i = 0; i < 4; ++i) {
            float s = (qf[i][0] * k0[0] + qf[i][1] * k0[1]) + (qf[i][2] * k0[2] + qf[i][3] * k0[3]) + (qf[i][4] * k1[0] + qf[i][5] * k1[1]) + (qf[i][6] * k1[2] + qf[i][7] * k1[3]);
            s = row16_sum(s);
            const float z = fminf(s + bias2, 60.f), s1 = lg2(1.0f + ex2(z)), pv = ex2(z - s1 - R[i]); R[i] += s1;
#pragma unroll
            for (int e = 0; e < 4; ++e) { O[i][e] += pv * v0[e]; O[i][4 + e] += pv * v1[e]; } }
    }
    LAS float* Ow = (LAS float*)lds;
    LAS float* Rw = Ow + 8 * 4 * 512;
    __syncthreads();
#pragma unroll
    for (int i = 0; i < 4; ++i) { *(LAS f32x4*)(Ow + (wid * 4 + i) * 512 + lane * 8) = (f32x4){O[i][0], O[i][1], O[i][2], O[i][3]}; *(LAS f32x4*)(Ow + (wid * 4 + i) * 512 + lane * 8 + 4) = (f32x4){O[i][4], O[i][5], O[i][6], O[i][7]};
        if ((lane & 15) == 0) Rw[(wid * 4 + i) * 4 + hd] = R[i]; }
    __syncthreads();
    float* PART = WSP(float, WS_PART) + (size_t)unit * 2048; float* PR = WSP(float, WS_PR) + (size_t)unit * 16;
    for (int idx = tid; idx < 2048; idx += NTHR) { const int i = idx >> 9, c = idx & 511, hc = c >> 7; float acc = 0.f, racc = 0.f;
#pragma unroll
        for (int w = 7; w >= 0; --w) { acc += ex2(-racc) * Ow[(w * 4 + i) * 512 + c]; racc += Rw[(w * 4 + i) * 4 + hc]; }
        PART[idx] = acc; if ((c & 127) == 0) PR[i * 4 + hc] = racc; }
}
__device__ __forceinline__ void attn_sample_combine(CA A, int layer, const int wv) {
    {
      const int t0 = tid_opaque(wv), gt = blk_opaque() * NTHR + t0; const float* SQ = WSP(float, WS_SSQ); float* RS = WSP(float, WS_RS);
      for (int idx = gt; idx < TT * 2; idx += gridDim.x * NTHR) { const f32x4* sq = (const f32x4*)(SQ + (size_t)idx * 16); const f32x4 a = sq[0], b = sq[1], c = sq[2], d = sq[3];
          RS[idx] = (((a[0] + a[1]) + (a[2] + a[3]) + (b[0] + b[1]) + (b[2] + b[3])) + ((c[0] + c[1]) + (c[2] + c[3]) + (d[0] + d[1]) + (d[2] + d[3]))) * (1.0f / 512.0f) + RMS_EPS; } }
    const int tid = tid_opaque(wv), lane = tid & 63, gw = blk_opaque() * NWAVES + (tid >> 6), NGW = gridDim.x * NWAVES;
    const bf16* QKV = WSP(bf16, WS_QKV); const float* PART = WSP(float, WS_PART); const float* PR = WSP(float, WS_PR);
    const float* kn = A->out + O_KS + (size_t)layer * TS * 512; const float* vn = A->out + O_VS + (size_t)layer * TS * 512;
    bf16* O2 = WSP(bf16, WS_OBR) + 1024;
    for (int it = gw; it < TS * 4; it += NGW) { const int sb = it >> 4, i = (it >> 2) & 3, hd = it & 3, row = TP + sb * 4 + i, c = hd * 128 + 2 * lane;
        const unsigned qw = *(const unsigned*)(QKV + (size_t)row * 1536 + c); const float q0 = bflo(qw), q1 = bfhi(qw);
        const float bias2 = IN_F(I_SBBIAS)[layer * 4 + hd] * LOG2E; float o0 = 0.f, o1 = 0.f, racc = 0.f;
        for (int j = i - 1; j >= 0; --j) { const float* kr = kn + (size_t)(sb * 4 + j) * 512 + c; const float* vr = vn + (size_t)(sb * 4 + j) * 512 + c;
            const float z = fminf(wave_sum(q0 * kr[0] + q1 * kr[1]) + bias2, 60.f), s1 = lg2(1.0f + ex2(z)), pv = ex2(z - s1 - racc); racc += s1; o0 += pv * vr[0]; o1 += pv * vr[1]; }
        for (int u = 31; u >= 0; --u) { const float* pr = PART + ((size_t)(sb * 32 + u) * 4 + i) * 512 + c; const float sc = ex2(-racc); o0 += sc * pr[0]; o1 += sc * pr[1]; racc += PR[(size_t)(sb * 32 + u) * 16 + i * 4 + hd]; }
        *(unsigned*)(O2 + (size_t)row * OBW + c) = pk2(o0, o1); }
}

#ifndef MK_ONE_LAUNCH
#define MK_ONE_LAUNCH 1
#endif
#ifndef REP_P0
#define REP_P0 1
#endif
#ifndef REP_IN
#define REP_IN 1
#endif
#ifndef REP_PREP
#define REP_PREP 1
#endif
#ifndef REP_MIXA
#define REP_MIXA 1
#endif
#ifndef REP_MIXB
#define REP_MIXB 1
#endif
#ifndef REP_MERGE
#define REP_MERGE 1
#endif
#ifndef REP_OUT
#define REP_OUT 1
#endif
#ifndef REP_UP
#define REP_UP 1
#endif
#ifndef REP_DOWN
#define REP_DOWN 1
#endif
#ifndef REP_BAR
#define REP_BAR 1
#endif
#ifndef REP_RES1L0
#define REP_RES1L0 1
#endif
#ifndef REP_ADN
#define REP_ADN 1
#endif
#ifndef REP_ASSD
#define REP_ASSD 1
#endif
#ifndef REP_BDN
#define REP_BDN 1
#endif
#ifndef REP_BSSD
#define REP_BSSD 1
#endif
#ifndef REP_BSATT
#define REP_BSATT 1
#endif
constexpr int N_PHASES = 24;
__device__ __forceinline__ int queue_pop(unsigned* head, volatile LAS unsigned* slot, const int wv) {
    __syncthreads();
    if (tid_opaque(wv) == 0) *slot = __hip_atomic_fetch_add(head, 1u, __ATOMIC_RELAXED, __HIP_MEMORY_SCOPE_AGENT);
    __syncthreads();
    return (int)*slot;
}
__global__ void __launch_bounds__(NTHR, 2) mega(Args Araw) {
    extern __shared__ __attribute__((aligned(16))) unsigned char lds_raw[];
    LAS unsigned char* lds = (LAS unsigned char*)lds_raw;
    volatile LAS unsigned* MISC = (volatile LAS unsigned*)(lds + MISC_OFF);
    const int wv = __builtin_amdgcn_readfirstlane(threadIdx.x >> 6); const int tid = tid_opaque(wv), G = gridDim.x, blk = blk_opaque();
    if (tid < 16) MISC[tid] = 0u;
    __syncthreads();
    unsigned* ctl = (unsigned*)(Araw.ws + WS_CTL);
    XcdBarrier bar = xcd_barrier_post(ctl + CW_BAR + Araw.li * XCD_BAR_WORDS, MISC, tid);
    const int lo = Araw.ph_lo, hi = Araw.ph_hi;
#define IN(gp) (lo <= (gp) && (gp) < hi)
#define SEAM(gp) do { if (lo <= (gp) && (gp) + 1 < hi) for (int rb_ = 0; rb_ < REP_BAR; ++rb_) xcd_barrier(bar, tid_opaque(wv)); } while (0)

    if (IN(0)) for (int rep = 0; rep < REP_P0; ++rep) { CA A = args_opaque(); p0_prologue(A, lds, wv); }
    if (IN(0)) { CA A = args_opaque(); norm1_phase(A, wv); }
    SEAM(0);
    for (int layer = 0; layer < DEPTH; ++layer) {
        const int gb = 1 + 11 * layer;
        if (IN(gb + 1)) for (int rep = 0; rep < REP_IN; ++rep) { CA A = args_opaque();
            pg8::Gemm g{WSP(bf16, WS_H), WSP(bf16, WS_WIN) + (size_t)layer * NIN * DM, MP, NIN, DM, DM / 64, 0}; pg8::StaticOrder S; S.init(MP, NIN, G, blk_opaque());
            EpiIn E{WSP(float, WS_UF), WSP(bf16, WS_QKV), WSP(bf16, WS_GATE), A->out + O_KP + (size_t)layer * TP * 512, A->out + O_VP + (size_t)layer * TP * 512,
                    A->out + O_KS + (size_t)layer * TS * 512, A->out + O_VS + (size_t)layer * TS * 512, 0.08838834764831845f * LOG2E};
            pg8::gemm_phase<EpiIn, pg8::StaticOrder, true, true>(lds, g, S, E, wv);
        }
        SEAM(gb + 1);
        if (IN(gb + 3)) for (int rep = 0; rep < REP_MIXA; ++rep) { CA A = args_opaque();
            for (int r3 = 0; r3 < REP_PREP; ++r3) prep_phase(A, layer, wv);
            for (int r2 = 0; r2 < REP_ASSD; ++r2) { unsigned* qh = (unsigned*)(A->ws + WS_CTL) + CW_QUEUE + 64 * (layer * 4 + 3) + 1024 * rep + 2048 * r2;
              for (;;) { const int u = queue_pop(qh, MISC + 4, wv); if (u >= 512) break; ssd_prep_unit(A, lds, layer, u, wv); } }
            for (int r2 = 0; r2 < REP_ADN; ++r2) { unsigned* qh = (unsigned*)(A->ws + WS_CTL) + CW_QUEUE + 64 * (layer * 4 + 2) + 1024 * rep + 2048 * r2;
              for (;;) { const int u = queue_pop(qh, MISC + 4, wv); if (u >= 512) break; dn_chunk_unit(A, lds, layer, u, wv); } }
        }
        SEAM(gb + 3);
        if (IN(gb + 4)) for (int rep = 0; rep < REP_MIXB; ++rep) { CA A = args_opaque();
            for (int r2 = 0; r2 < REP_BDN; ++r2) for (int t = blk; t < 16; t += G) dn_seq2(A, lds, layer, t, wv);
            for (int r2 = 0; r2 < REP_BSSD; ++r2) for (int t = blk; t < 80; t += G) if (t >= 16) ssd_seq2(A, lds, layer, t - 16, wv);
            for (int t = blk; t < 112; t += G) if (t >= 80) dn_seq(A, lds, layer, t - 80 + 16, wv);
            for (int t = blk; t < 240; t += G) if (t >= 112) ssd_seq(A, lds, layer, t - 112 + 64, wv);
            { unsigned* qh = (unsigned*)(A->ws + WS_CTL) + CW_QUEUE + 64 * (layer * 4 + 0) + 1024 * rep;
              for (;;) { const int u = queue_pop(qh, MISC + 4, wv); if (u >= 128) break; attn_prompt_unit(A, lds, layer, u, wv); } }
            for (int r2 = 0; r2 < REP_BSATT; ++r2) { unsigned* qh = (unsigned*)(A->ws + WS_CTL) + CW_QUEUE + 64 * (layer * 4 + 1) + 1024 * rep + 2048 * r2;
              for (;;) { const int u = queue_pop(qh, MISC + 4, wv); if (u >= 256) break; attn_sample_unit(A, lds, layer, u, wv); } }
        }
        SEAM(gb + 4);
        if (IN(gb + 5)) { CA A = args_opaque(); attn_sample_combine(A, layer, wv);
            { unsigned* qh = (unsigned*)(A->ws + WS_CTL) + 16384 + 64 * layer;
              for (;;) { const int u = queue_pop(qh, MISC + 4, wv); if (u >= 512) break; dn_out_unit(A, lds, layer, u, wv); } } }
        SEAM(gb + 5);
        if (IN(gb + 6)) for (int rep = 0; rep < REP_MERGE; ++rep) { CA A = args_opaque();
            pg8::SegOrder<5> S; S.init(TP, DM, G, blk_opaque());
            pg8::Gemm g{WSP(bf16, WS_OBR), WSP(bf16, WS_WBR) + (size_t)layer * DM * OBW, TP, DM, OBW, 8, 1024};
            EpiMergeR E{WSP(bf16, WS_GATE), WSP(float, WS_RS), WSP(bf16, WS_MGB)};
            pg8::gemm_phase<EpiMergeR, pg8::SegOrder<5>, true, true>(lds, g, S, E, wv);
            sample_merge(A, lds, layer, wv);
        }
        SEAM(gb + 6);
        if (IN(gb + 7)) for (int rep = 0; rep < REP_OUT; ++rep) { CA A = args_opaque();
            pg8::Gemm g{WSP(bf16, WS_MGB), WSP(bf16, WS_WOUT) + (size_t)layer * DM * DM, TP, DM, DM, DM / 64, 0}; pg8::StaticOrder S; S.init(TP, DM, G, blk_opaque());
            EpiF32 E{WSP(float, WS_MIX), DM}; pg8::gemm_phase<EpiF32, pg8::StaticOrder, true, true>(lds, g, S, E, wv);
            { ALBf16 al{WSP(bf16, WS_MGB) + (size_t)TP * DM, DM}; sample_splitk(al, WSP(bf16, WS_WOUT) + (size_t)layer * DM * DM, DM, 128, 16, 4, WSP(float, WS_OUTS), DM, wv); }
        }
        SEAM(gb + 7);
        if (IN(gb + 8)) for (int rep = 0; rep < (layer == 0 ? REP_RES1L0 : 1); ++rep) { CA A = args_opaque(); resid_phase(A, WSP(float, WS_MIX), WSP(float, WS_OUTS), IN_F(I_NMPOST) + layer * DM, IN_F(I_NLPRE) + layer * DM, layer == 0, wv); }
        SEAM(gb + 8);
        if (IN(gb + 9)) for (int rep = 0; rep < REP_UP; ++rep) { CA A = args_opaque();
            pg8::Gemm g{WSP(bf16, WS_H), WSP(bf16, WS_WUP) + (size_t)layer * DFF * DM, TP, DFF, DM, DM / 64, 0}; pg8::StaticOrder S; S.init(TP, DFF, G, blk_opaque());
            EpiRelu2 E{WSP(bf16, WS_F), DFF}; pg8::gemm_phase<EpiRelu2, pg8::StaticOrder, true, true>(lds, g, S, E, wv);
            sample_up(A, lds, layer, wv);
        }
        SEAM(gb + 9);
        if (IN(gb + 10)) for (int rep = 0; rep < REP_DOWN; ++rep) { CA A = args_opaque();
            pg8::Gemm g{WSP(bf16, WS_F), WSP(bf16, WS_WDN) + (size_t)layer * DM * DFF, TP, DM, DFF, DFF / 64, 0}; pg8::StaticOrder S; S.init(TP, DM, G, blk_opaque());
            EpiF32 E{WSP(float, WS_FD), DM}; pg8::gemm_phase<EpiF32, pg8::StaticOrder, true, true>(lds, g, S, E, wv);
            { ALBf16 al{WSP(bf16, WS_F) + (size_t)TP * DFF, DFF}; sample_splitk(al, WSP(bf16, WS_WDN) + (size_t)layer * DM * DFF, DFF, 128, 16, 16, WSP(float, WS_DNS), DM, wv); }
        }
        SEAM(gb + 10);
        if (IN(gb + 11)) { CA A = args_opaque(); resid_phase(A, WSP(float, WS_FD), WSP(float, WS_DNS), IN_F(I_NLPOST) + layer * DM, layer + 1 < DEPTH ? IN_F(I_NMPRE) + (layer + 1) * DM : nullptr, false, wv); }
        SEAM(gb + 11);
    }
#undef IN
#undef SEAM
}

extern "C" void kernel_launch(void* const* d_in, const int* in_sizes, int n_in, void* d_out, int out_size, void* d_ws, size_t ws_size, hipStream_t stream) {
    static int grid = 0;
    if (grid == 0) {
        if (n_in != N_IN || (size_t)out_size != O_END || ws_size < WS_END) { fprintf(stderr, "kernel_launch: unexpected problem (n_in %d, out %d vs %zu, ws %zu vs %zu); nothing launched\n", n_in, out_size, (size_t)O_END, ws_size, (size_t)WS_END); grid = -1; return; }
        int dev = 0, cus = 0, per_cu = 0;
        if (hipGetDevice(&dev) != hipSuccess || hipDeviceGetAttribute(&cus, hipDeviceAttributeMultiprocessorCount, dev) != hipSuccess) { grid = -1; return; }
        if (hipFuncSetAttribute((const void*)mega, hipFuncAttributeMaxDynamicSharedMemorySize, LDS_BYTES) != hipSuccess) { fprintf(stderr, "kernel_launch: hipFuncSetAttribute failed\n"); grid = -1; return; }
        if (hipOccupancyMaxActiveBlocksPerMultiprocessor(&per_cu, (const void*)mega, NTHR, LDS_BYTES) != hipSuccess || per_cu < 1) fprintf(stderr, "kernel_launch: occupancy query says %d blocks per CU\n", per_cu);
        (void)hipGetLastError();
        grid = cus;
    }
    if (grid < 0) return;
    (void)in_sizes;
    (void)hipMemsetAsync((char*)d_ws + WS_CTL, 0, CTL_ZERO, stream);
    Args a{};
    for (int i = 0; i < N_IN; ++i) a.in[i] = d_in[i];
    a.out = (float*)d_out; a.ws = (unsigned char*)d_ws; a.pad = 0;
#if MK_ONE_LAUNCH
    a.ph_lo = 0; a.ph_hi = N_PHASES; a.li = 0;
    hipLaunchKernelGGL(mega, dim3(grid), dim3(NTHR), LDS_BYTES, stream, a);
#else
    for (int gp = 0; gp < N_PHASES; ++gp) { a.ph_lo = gp; a.ph_hi = gp + 1; a.li = 0; hipLaunchKernelGGL(mega, dim3(grid), dim3(NTHR), LDS_BYTES, stream, a); }
#endif
}
```
